# Optimizing an MI355X kernel written in HIP

```python
import jax, jax.numpy as jnp
from jax import lax
import numpy as np

D_MODEL = 1024
BATCH = 8
SEQ = 4096
DEPTH = 1

HEAD_DIM = 64
RWKV_WIDTH = D_MODEL // 2
RWKV_HEADS = RWKV_WIDTH // HEAD_DIM
ATTN_WIDTH = D_MODEL - RWKV_WIDTH
ATTN_Q_HEADS = ATTN_WIDTH // HEAD_DIM
ATTN_KV_HEADS = max(1, ATTN_Q_HEADS // 4)
ATTN_GROUP = ATTN_Q_HEADS // ATTN_KV_HEADS
WINDOW = 128
ATTN_BLOCK = WINDOW
DECAY_LORA = 64
ICLR_LORA = 64
GATE_LORA = 128
RWKV_COLS = 3 * RWKV_WIDTH + DECAY_LORA + ICLR_LORA + GATE_LORA
ATTN_COLS = ATTN_WIDTH + 2 * ATTN_KV_HEADS * HEAD_DIM
IN_COLS = RWKV_COLS + ATTN_COLS
RWKV_SPLITS = [RWKV_WIDTH, 2 * RWKV_WIDTH, 3 * RWKV_WIDTH,
               3 * RWKV_WIDTH + DECAY_LORA, 3 * RWKV_WIDTH + DECAY_LORA + ICLR_LORA]
ATTN_SPLITS = [ATTN_WIDTH, ATTN_WIDTH + ATTN_KV_HEADS * HEAD_DIM]
N_EXPERTS = 32
TOP_K = 4
D_EXPERT = D_MODEL
SWIGLU_ALPHA = 1.702
SWIGLU_LIMIT = 7.0
MOE_BLOCK = 128
NORM_EPS = 1e-6
GN_EPS = 64e-5

kernel_name = 'hybrid_rwkv7_swa_sink_moe_adaln'


def rms_norm(x, g):
    xf = x.astype(jnp.float32)
    y = xf * lax.rsqrt(jnp.mean(xf * xf, axis=-1, keepdims=True) + NORM_EPS)
    return (y * g.astype(jnp.float32)).astype(x.dtype)


def modulate(h, shift, scale):
    return h * (1 + scale[:, None, :]) + shift[:, None, :]


def token_shift(p):
    return jnp.pad(p[:, :-1], ((0, 0), (1, 0), (0, 0)))


def rwkv7_scan(r, decay, k, v, kk, b):
    Bsz, _, H, N = r.shape

    def step(S, inp):
        r_t, w_t, k_t, v_t, kk_t, b_t = inp
        sa = jnp.einsum('bhvk,bhk->bhv', S, -kk_t)
        S = (S * w_t[:, :, None, :] + sa[..., None] * b_t[:, :, None, :]
             + v_t[..., None] * k_t[:, :, None, :])
        y = jnp.einsum('bhvk,bhk->bhv', S, r_t)
        return S, y

    xs = tuple(jnp.moveaxis(t, 1, 0) for t in (r, decay, k, v, kk, b))
    S0 = jnp.zeros((Bsz, H, N, N), jnp.float32)
    _, ys = lax.scan(step, S0, xs)
    return jnp.moveaxis(ys, 0, 1)


def rwkv7_time_mix(p, mu, w0, w_up, a0, a_up, g_up, k_k, k_a, r_k, lnx_g, lnx_b):
    Bsz, T, _ = p.shape
    f32 = jnp.float32
    p = p + (token_shift(p) - p) * mu
    r, k, v, wd, ad, gd = jnp.split(p, RWKV_SPLITS, axis=-1)
    w_log = -jax.nn.softplus(-(w0 + jnp.tanh(wd) @ w_up).astype(f32)) - 0.5
    decay = jnp.exp(-jnp.exp(w_log))
    a = jax.nn.sigmoid(a0 + ad @ a_up)
    g = jax.nn.sigmoid(gd) @ g_up
    kk = k * k_k
    k = k * (1 + (a - 1) * k_a)
    heads = lambda t: t.reshape(Bsz, T, RWKV_HEADS, HEAD_DIM).astype(f32)
    r_h, k_h, v_h, a_h, w_h, kk_h = map(heads, (r, k, v, a, decay, kk))
    kk_h = kk_h / jnp.maximum(jnp.sqrt(jnp.sum(kk_h * kk_h, -1, keepdims=True)), 1e-12)
    y = rwkv7_scan(r_h, w_h, k_h, v_h, kk_h, kk_h * a_h)
    mean = jnp.mean(y, -1, keepdims=True)
    var = jnp.mean(jnp.square(y - mean), -1, keepdims=True)
    y = ((y - mean) * lax.rsqrt(var + GN_EPS)).reshape(Bsz, T, RWKV_WIDTH)
    y = y * lnx_g.astype(f32) + lnx_b.astype(f32)
    bonus = jnp.sum(r_h * k_h * r_k.astype(f32), -1, keepdims=True) * v_h
    y = y + bonus.reshape(Bsz, T, RWKV_WIDTH)
    return (y * g.astype(f32)).astype(p.dtype)


def swa_sink_attention(p, q_norm_g, k_norm_g, sinks):
    Bsz, T, _ = p.shape
    nb = T // ATTN_BLOCK
    q, k, v = jnp.split(p, ATTN_SPLITS, axis=-1)
    q = rms_norm(q.reshape(Bsz, T, ATTN_Q_HEADS, HEAD_DIM), q_norm_g)
    k = rms_norm(k.reshape(Bsz, T, ATTN_KV_HEADS, HEAD_DIM), k_norm_g)
    v = v.reshape(Bsz, T, ATTN_KV_HEADS, HEAD_DIM)
    qb = q.reshape(Bsz, nb, ATTN_BLOCK, ATTN_KV_HEADS, ATTN_GROUP, HEAD_DIM)

    def with_prev(t):
        tb = t.reshape(Bsz, nb, ATTN_BLOCK, ATTN_KV_HEADS, HEAD_DIM)
        prev = jnp.pad(tb[:, :-1], ((0, 0), (1, 0), (0, 0), (0, 0), (0, 0)))
        return jnp.concatenate([prev, tb], axis=2)

    kw, vw = with_prev(k), with_prev(v)
    scale = HEAD_DIM ** -0.5
    s = jnp.einsum('bnqkgd,bnskd->bnkgqs', qb, kw).astype(jnp.float32) * scale
    blk = jnp.arange(nb)[:, None] * ATTN_BLOCK
    qpos = blk + jnp.arange(ATTN_BLOCK)[None, :]
    kpos = blk - ATTN_BLOCK + jnp.arange(2 * ATTN_BLOCK)[None, :]
    diff = qpos[:, :, None] - kpos[:, None, :]
    mask = (diff >= 0) & (diff < WINDOW) & (kpos[:, None, :] >= 0)
    s = jnp.where(mask[None, :, None, None], s, -jnp.inf)
    sink = jnp.broadcast_to(
        sinks.astype(jnp.float32).reshape(ATTN_KV_HEADS, ATTN_GROUP)[None, None, :, :, None, None],
        s.shape[:-1] + (1,))
    prob = jax.nn.softmax(jnp.concatenate([s, sink], axis=-1), axis=-1)[..., :-1]
    o = jnp.einsum('bnkgqs,bnskd->bnqkgd', prob.astype(v.dtype), vw)
    return o.reshape(Bsz, T, ATTN_WIDTH)


def moe_ffn(h, w_router, b_router, w1, b1, w2, b2):
    Bsz, T, D = h.shape
    n_tok = Bsz * T
    hf = h.reshape(n_tok, D)
    logits = (hf @ w_router + b_router).astype(jnp.float32)
    top_val, top_idx = lax.top_k(logits, TOP_K)
    gate = jax.nn.softmax(top_val, axis=-1)
    n_asg = n_tok * TOP_K
    e_flat = top_idx.reshape(-1)
    tok_flat = jnp.arange(n_asg, dtype=jnp.int32) // TOP_K
    g_flat = gate.reshape(-1)
    order = jnp.argsort(e_flat)
    e_sorted = e_flat[order]
    counts = jnp.bincount(e_flat, length=N_EXPERTS)
    starts = jnp.cumsum(counts) - counts
    padded = (counts + MOE_BLOCK - 1) // MOE_BLOCK * MOE_BLOCK
    pad_ends = jnp.cumsum(padded)
    pad_starts = pad_ends - padded
    dest = pad_starts[e_sorted] + (jnp.arange(n_asg) - starts[e_sorted])
    n_blocks = -(-n_asg // MOE_BLOCK) + N_EXPERTS
    n_slots = n_blocks * MOE_BLOCK
    slot_tok = jnp.zeros((n_slots,), jnp.int32).at[dest].set(tok_flat[order])
    slot_gate = jnp.zeros((n_slots,), jnp.float32).at[dest].set(g_flat[order])
    block_expert = jnp.minimum(
        jnp.searchsorted(pad_ends, jnp.arange(n_blocks) * MOE_BLOCK, side='right'),
        N_EXPERTS - 1)
    xs = hf[slot_tok].reshape(n_blocks, MOE_BLOCK, D)

    def expert_block(args):
        xb, e = args
        hu = xb @ w1[e] + b1[e]
        glu = jnp.minimum(hu[:, :D_EXPERT], SWIGLU_LIMIT)
        lin = jnp.clip(hu[:, D_EXPERT:], -SWIGLU_LIMIT, SWIGLU_LIMIT)
        act = glu * jax.nn.sigmoid(SWIGLU_ALPHA * glu) * (lin + 1)
        return act @ w2[e] + b2[e]

    ys = lax.map(expert_block, (xs, block_expert)).reshape(n_slots, D)
    ys = ys * slot_gate[:, None].astype(ys.dtype)
    out = jax.ops.segment_sum(ys, slot_tok, num_segments=n_tok)
    return out.reshape(Bsz, T, D)


def setup_inputs(seed: int = 0) -> dict:
    key = jax.random.key(seed)
    ks = jax.random.split(key, 32)
    L, D, W = DEPTH, D_MODEL, RWKV_WIDTH
    nrm = lambda k, shape, s: jax.random.normal(k, shape, jnp.float32) * s
    return {
        'x': nrm(ks[0], (BATCH, SEQ, D), 1.0),
        'c': nrm(ks[1], (BATCH, D), 1.0),
        'w_ada': nrm(ks[2], (L, D, 6 * D), D ** -0.5),
        'b_ada': nrm(ks[3], (L, 6 * D), 0.02),
        'norm1_g': 1.0 + nrm(ks[4], (L, D), 0.02),
        'w_in': nrm(ks[5], (L, D, IN_COLS), D ** -0.5),
        'mu_shift': jax.random.uniform(ks[6], (L, RWKV_COLS), jnp.float32),
        'w0': jax.random.uniform(ks[7], (L, W), jnp.float32, -6.0, 1.0),
        'w_up': nrm(ks[8], (L, DECAY_LORA, W), 0.1 * DECAY_LORA ** -0.5),
        'a0': nrm(ks[9], (L, W), 0.1),
        'a_up': nrm(ks[10], (L, ICLR_LORA, W), 0.1 * ICLR_LORA ** -0.5),
        'g_up': nrm(ks[11], (L, GATE_LORA, W), GATE_LORA ** -0.5),
        'k_k': 0.85 + nrm(ks[12], (L, W), 0.02),
        'k_a': 1.0 + nrm(ks[13], (L, W), 0.02),
        'r_k': nrm(ks[14], (L, RWKV_HEADS, HEAD_DIM), 0.1),
        'lnx_g': 1.0 + nrm(ks[15], (L, W), 0.02),
        'lnx_b': nrm(ks[16], (L, W), 0.02),
        'q_norm_g': 1.0 + nrm(ks[17], (L, HEAD_DIM), 0.02),
        'k_norm_g': 1.0 + nrm(ks[18], (L, HEAD_DIM), 0.02),
        'sinks': nrm(ks[19], (L, ATTN_Q_HEADS), 0.5),
        'w_out': nrm(ks[20], (L, D, D), D ** -0.5),
        'norm2_g': 1.0 + nrm(ks[21], (L, D), 0.02),
        'w_router': nrm(ks[22], (L, D, N_EXPERTS), D ** -0.5),
        'b_router': nrm(ks[23], (L, N_EXPERTS), 0.01),
        'w1': nrm(ks[24], (L, N_EXPERTS, D, 2 * D_EXPERT), D ** -0.5),
        'b1': nrm(ks[25], (L, N_EXPERTS, 2 * D_EXPERT), 0.01),
        'w2': nrm(ks[26], (L, N_EXPERTS, D_EXPERT, D), D_EXPERT ** -0.5),
        'b2': nrm(ks[27], (L, N_EXPERTS, D), 0.01),
    }


def reference(x, c, w_ada, b_ada, norm1_g, w_in, mu_shift, w0, w_up, a0, a_up, g_up,
              k_k, k_a, r_k, lnx_g, lnx_b, q_norm_g, k_norm_g, sinks, w_out, norm2_g,
              w_router, b_router, w1, b1, w2, b2):
    for l in range(DEPTH):
        mod = jax.nn.silu(c) @ w_ada[l] + b_ada[l]
        sh1, sc1, gt1, sh2, sc2, gt2 = jnp.split(mod, 6, axis=-1)
        h = modulate(rms_norm(x, norm1_g[l]), sh1, sc1)
        p = h @ w_in[l]
        o_rwkv = rwkv7_time_mix(p[..., :RWKV_COLS], mu_shift[l], w0[l], w_up[l], a0[l],
                                a_up[l], g_up[l], k_k[l], k_a[l], r_k[l], lnx_g[l], lnx_b[l])
        o_attn = swa_sink_attention(p[..., RWKV_COLS:], q_norm_g[l], k_norm_g[l], sinks[l])
        mix = jnp.concatenate([o_rwkv, o_attn], axis=-1) @ w_out[l]
        x = x + gt1[:, None, :] * mix
        h = modulate(rms_norm(x, norm2_g[l]), sh2, sc2)
        x = x + gt2[:, None, :] * moe_ffn(h, w_router[l], b_router[l], w1[l], b1[l], w2[l], b2[l])
    return x
```

```cpp
#include <hip/hip_runtime.h>
#include <hip/hip_cooperative_groups.h>
#include <cstdio>
#include <cstdint>
namespace cg = cooperative_groups;

#ifndef MK_ONE_LAUNCH
#define MK_ONE_LAUNCH 0
#endif
#ifndef MK_LAST_PHASE
#define MK_LAST_PHASE 12
#endif

constexpr int D = 1024, NBATCH = 8, T = 4096, M = NBATCH * T;
constexpr int HD = 64, RW = 512, RH = 8, AW = 512, QH = 8, KVH = 2, WIN = 128;
constexpr int RWKV_COLS = 1792, IN_COLS = 2560;
constexpr int COL_Q = 1792, COL_K = 1792 + 512, COL_V = 1792 + 512 + 128;
constexpr int NE = 32, TOPK = 4, DE = 1024;
constexpr int MAX_TILES = 544;
constexpr int MAX_SLOTS = MAX_TILES * 256;
constexpr float NORM_EPS = 1e-6f, GN_EPS = 64e-5f;

#define GAS __attribute__((address_space(1)))
#define LAS __attribute__((address_space(3)))
typedef unsigned short bf16;
typedef short bf16x8 __attribute__((ext_vector_type(8)));
typedef float f32x4 __attribute__((ext_vector_type(4)));
typedef float f32x2 __attribute__((ext_vector_type(2)));
typedef float f32x16 __attribute__((ext_vector_type(16)));
typedef unsigned u32x4 __attribute__((ext_vector_type(4)));
typedef unsigned u32x2 __attribute__((ext_vector_type(2)));

constexpr size_t MiB = 1u << 20;
constexpr size_t WS_CTL = 0, CTL_BYTES = 64 * 1024;
constexpr size_t WS_MOD = 1 * MiB;
constexpr size_t WS_BON = 1 * MiB + 256 * 1024;
constexpr size_t WS_RT_E = 2 * MiB;
constexpr size_t WS_RT_LP = 2 * MiB + 512 * 1024;
constexpr size_t WS_RT_G = 3 * MiB;
constexpr size_t WS_TOKSLOT = 3 * MiB + 512 * 1024;
constexpr size_t WS_SLOTTOK = 4 * MiB;
constexpr size_t WS_SLOTGATE = 5 * MiB;
constexpr size_t WS_BLKCNT = 6 * MiB;
constexpr size_t WS_TILEE = 6 * MiB + 64 * 1024;
constexpr size_t WS_BONUS = 7 * MiB;
constexpr size_t WS_WIN = 10 * MiB;
constexpr size_t WS_WOUT = 16 * MiB;
constexpr size_t WS_W1 = 20 * MiB;
constexpr size_t WS_W2 = 148 * MiB;
constexpr size_t WS_H = 212 * MiB;
constexpr size_t WS_R2 = 276 * MiB;
constexpr size_t WS_P = WS_R2;
constexpr size_t WS_SW = WS_R2 + 160 * MiB;
constexpr size_t WS_SR = WS_SW + 64 * MiB, WS_SK = WS_SR + 64 * MiB, WS_SV = WS_SK + 64 * MiB, WS_SKK = WS_SV + 64 * MiB, WS_SB = WS_SKK + 64 * MiB;
constexpr size_t WS_G = WS_SB + 64 * MiB;
constexpr size_t WS_Y = WS_G + 32 * MiB;
constexpr size_t WS_CAT = WS_Y + 64 * MiB;
constexpr size_t WS_ACT = WS_R2;
constexpr size_t WS_YS = WS_R2 + 272 * MiB;
constexpr size_t WS_END = WS_CAT + 64 * MiB;
static_assert(WS_END <= 1024 * MiB, "workspace map");
static_assert(WS_YS + 272 * MiB <= WS_CAT, "YS must not overlay CAT");
constexpr int CW_NTILES = 16;
constexpr int CW_PADSTART = 64;

constexpr int LDS_BYTES = 140 * 1024;

__device__ __forceinline__ unsigned f2bf(float f) { unsigned u = __builtin_bit_cast(unsigned, f); return (u + 0x7fffu + ((u >> 16) & 1u)) >> 16; }
__device__ __forceinline__ unsigned pk2(float lo, float hi) { return f2bf(lo) | (f2bf(hi) << 16); }
__device__ __forceinline__ float bf2f(unsigned short b) { return __builtin_bit_cast(float, ((unsigned)b) << 16); }
__device__ __forceinline__ float bflo(unsigned u) { return __builtin_bit_cast(float, u << 16); }
__device__ __forceinline__ float bfhi(unsigned u) { return __builtin_bit_cast(float, u & 0xffff0000u); }
__device__ __forceinline__ float wave_sum(float v) {
#pragma unroll
    for (int o = 1; o < 64; o <<= 1) v += __shfl_xor(v, o);
    return v;
}
__device__ __forceinline__ float sigmoidf_(float x) { return 1.f / (1.f + __expf(-x)); }

namespace pg8 {
#define PG8_LAS __attribute__((address_space(3)))
constexpr int BM = 256, BK = 64, HALF = 128, HTB = HALF * BK * 2, STAGE_BYTES = 8 * HTB, NXCD = 8, WGM = 8;
__host__ __device__ __forceinline__ int lds_byte(int r, int c) { const int st = (r >> 4) * 2 + (c >> 5), rr = r & 15, cc = c & 31, ob = rr * 64 + cc * 2; return st * 1024 + (ob ^ (((ob >> 9) & 1) << 5)); }
__host__ __device__ __forceinline__ void stage_rc(int b, int& R, int& C) { const int st = b / 1024, sb = b % 1024, swz = sb ^ (((sb >> 9) & 1) << 5); R = (st >> 1) * 16 + swz / 64; C = (st & 1) * 32 + (swz % 64) / 2; }

struct Unit { int pm, pn, e; };
struct Gemm { const bf16* A; const bf16* Bt; int K, N; const int* rowmap; };

struct StaticOrder {
    int nM, nN, nwg, G, c;
    __device__ void init(int M_, int N_, int G_, int c_) { nM = M_ / BM; nN = N_ / BM; nwg = nM * nN; G = G_; c = c_; }
    __device__ bool next(int i, Unit& u) const {
        const long L = (long)i * G + c; if (L >= nwg) return false;
        int wgid = (int)L; { const int q = nwg / NXCD, r = nwg % NXCD, xcd = wgid % NXCD, off = wgid / NXCD; wgid = (xcd < r ? xcd * (q + 1) : r * (q + 1) + (xcd - r) * q) + off; }
        const int nig = WGM * nN, gid = wgid / nig, fm = gid * WGM, gsz = (nM - fm) < WGM ? (nM - fm) : WGM;
        u.pm = fm + ((wgid % nig) % gsz); u.pn = (wgid % nig) / gsz; u.e = 0; return true;
    }
};
struct MoeOrder {
    int nMt, nN, G, c; const int* tile_e;
    __device__ bool next(int i, Unit& u) const {
        const long L = (long)i * G + c; if (L >= (long)nMt * nN) return false;
        u.pm = (int)(L / nN); u.pn = (int)(L % nN); u.e = tile_e[u.pm]; return true;
    }
};

__device__ __forceinline__ unsigned cvt_pk_bf16(float lo, float hi) { unsigned r; asm volatile("v_cvt_pk_bf16_f32 %0, %1, %2" : "=v"(r) : "v"(lo), "v"(hi)); return r; }

struct EpiBf16P {
    bf16* O; int ldc;
    __device__ __forceinline__ void operator()(const f32x4 (&acc)[2][2][4][2], const Unit& u, int wr, int wc, int fr, int fq) const {
        const int row0 = u.pm * BM + wr * 64 + fr, col0 = u.pn * BM + wc * 32 + 8 * fq;
#pragma unroll
        for (int ai = 0; ai < 2; ++ai)
#pragma unroll
            for (int m = 0; m < 4; ++m) { bf16* rowp = O + (size_t)(row0 + ai * HALF + m * 16) * ldc + col0;
#pragma unroll
                for (int bj = 0; bj < 2; ++bj) { const f32x4 v0 = acc[ai][bj][m][0], v1 = acc[ai][bj][m][1];
                    u32x4 w; w.x = cvt_pk_bf16(v0[0], v0[1]); w.y = cvt_pk_bf16(v0[2], v0[3]); w.z = cvt_pk_bf16(v1[0], v1[1]); w.w = cvt_pk_bf16(v1[2], v1[3]);
                    *(u32x4*)(rowp + bj * HALF) = w; } }
    }
};
struct EpiOutProj {
    const float* x; float* out; const float* gate;
    __device__ __forceinline__ void operator()(const f32x4 (&acc)[2][2][4][2], const Unit& u, int wr, int wc, int fr, int fq) const {
        const int row0 = u.pm * BM + wr * 64 + fr, col0 = u.pn * BM + wc * 32 + 4 * fq;
        const int b = (u.pm * BM) / T;
        f32x4 gv[2][2];
#pragma unroll
        for (int bj = 0; bj < 2; ++bj)
#pragma unroll
            for (int n = 0; n < 2; ++n) gv[bj][n] = *(const f32x4*)(gate + (size_t)b * 6144 + col0 + bj * HALF + n * 16);
#pragma unroll
        for (int ai = 0; ai < 2; ++ai)
#pragma unroll
            for (int m = 0; m < 4; ++m) { const size_t ro = (size_t)(row0 + ai * HALF + m * 16) * D + col0;
#pragma unroll
                for (int bj = 0; bj < 2; ++bj)
#pragma unroll
                    for (int n = 0; n < 2; ++n) { const f32x4 xv = *(const f32x4*)(x + ro + bj * HALF + n * 16);
                        *(f32x4*)(out + ro + bj * HALF + n * 16) = xv + gv[bj][n] * acc[ai][bj][m][n]; } }
    }
};
struct EpiMoe1 {
    bf16* act; const float* b1;
    __device__ __forceinline__ void operator()(const f32x4 (&acc)[2][2][4][2], const Unit& u, int wr, int wc, int fr, int fq) const {
        const int row0 = u.pm * BM + wr * 64 + fr, j0 = u.pn * 128 + wc * 16 + 4 * fq;
        const float* bb = b1 + (size_t)u.e * 2048;
        f32x4 bg[2], bl[2];
#pragma unroll
        for (int bj = 0; bj < 2; ++bj) { bg[bj] = *(const f32x4*)(bb + j0 + bj * 64); bl[bj] = *(const f32x4*)(bb + 1024 + j0 + bj * 64); }
#pragma unroll
        for (int ai = 0; ai < 2; ++ai)
#pragma unroll
            for (int m = 0; m < 4; ++m) { bf16* rowp = act + (size_t)(row0 + ai * HALF + m * 16) * DE + j0;
#pragma unroll
                for (int bj = 0; bj < 2; ++bj) { const f32x4 g4 = acc[ai][bj][m][0] + bg[bj], l4 = acc[ai][bj][m][1] + bl[bj]; float a[4];
#pragma unroll
                    for (int q = 0; q < 4; ++q) { const float gl = fminf(g4[q], 7.0f), li = fminf(fmaxf(l4[q], -7.0f), 7.0f);
                        a[q] = gl * (1.f / (1.f + __expf(-1.702f * gl))) * (li + 1.f); }
                    u32x2 w; w.x = cvt_pk_bf16(a[0], a[1]); w.y = cvt_pk_bf16(a[2], a[3]);
                    *(u32x2*)(rowp + bj * 64) = w; } }
    }
};
struct EpiMoe2 {
    bf16* ys; const float* b2; const float* sgate;
    __device__ __forceinline__ void operator()(const f32x4 (&acc)[2][2][4][2], const Unit& u, int wr, int wc, int fr, int fq) const {
        const int row0 = u.pm * BM + wr * 64 + fr, col0 = u.pn * BM + wc * 32 + 8 * fq;
        const float* bb = b2 + (size_t)u.e * 1024;
        f32x4 bv[2][2];
#pragma unroll
        for (int bj = 0; bj < 2; ++bj)
#pragma unroll
            for (int n = 0; n < 2; ++n) bv[bj][n] = *(const f32x4*)(bb + col0 + bj * HALF + 4 * n);
#pragma unroll
        for (int ai = 0; ai < 2; ++ai)
#pragma unroll
            for (int m = 0; m < 4; ++m) { const int row = row0 + ai * HALF + m * 16; const float gt = sgate[row]; bf16* rowp = ys + (size_t)row * D + col0;
#pragma unroll
                for (int bj = 0; bj < 2; ++bj) { const f32x4 v0 = (acc[ai][bj][m][0] + bv[bj][0]) * gt, v1 = (acc[ai][bj][m][1] + bv[bj][1]) * gt;
                    u32x4 w; w.x = cvt_pk_bf16(v0[0], v0[1]); w.y = cvt_pk_bf16(v0[2], v0[3]); w.z = cvt_pk_bf16(v1[0], v1[1]); w.w = cvt_pk_bf16(v1[2], v1[3]);
                    *(u32x4*)(rowp + bj * HALF) = w; } }
    }
};

template <class Epi, class Sched, bool GATHER>
__device__ __forceinline__ void gemm_phase(PG8_LAS unsigned char* lds, const Gemm g, const Sched& S, const Epi& E) {
    const int tid = threadIdx.x, wid = __builtin_amdgcn_readfirstlane(tid >> 6), lane = tid & 63, wr = wid >> 2, wc = wid & 3, fr = lane & 15, fq = lane >> 4;
    const int K = g.K, nt = K / BK;
    int Rr[2], Cc[2]; unsigned voffB[2];
#pragma unroll
    for (int i = 0; i < 2; ++i) { stage_rc(tid * 16 + i * 8192, Rr[i], Cc[i]); voffB[i] = (unsigned)(Rr[i] * K + Cc[i]) * 2u; }
    const size_t kstep = (size_t)(BK * 2);
    const size_t hstep = (size_t)HALF * K * 2;
    const size_t tstep = 2 * hstep;
    const unsigned ldsw = (unsigned)wid * 1024u;
    const int aoff = lds_byte(wr * 64 + fr, fq * 8), boff = lds_byte(wc * 32 + fr, fq * 8);
#define PG8_SA(b, h) (((b) * 2 + (h)) * HTB)
#define PG8_SB(b, h) ((4 + (b) * 2 + (h)) * HTB)
#define PG8_STAGE(bufoff, gbase, voff) do { _Pragma("unroll") for (int _i = 0; _i < 2; ++_i) \
        __builtin_amdgcn_global_load_lds((const unsigned*)((const char*)(gbase) + (voff)[_i]), (PG8_LAS unsigned*)(lds + (bufoff) + ldsw + _i * 8192), 16, 0, 0); } while (0)
#define PG8_LDA(dst, b, h) do { _Pragma("unroll") for (int m = 0; m < 4; ++m) _Pragma("unroll") for (int k = 0; k < 2; ++k) dst[m][k] = *(const PG8_LAS bf16x8*)(lds + PG8_SA(b, h) + aoff + m * 2048 + k * 1024); } while (0)
#define PG8_LDB(dst, b, h) do { _Pragma("unroll") for (int n = 0; n < 2; ++n) _Pragma("unroll") for (int k = 0; k < 2; ++k) dst[n][k] = *(const PG8_LAS bf16x8*)(lds + PG8_SB(b, h) + boff + n * 2048 + k * 1024); } while (0)
#define PG8_MMA(ai, bj, At, Bt) do { __builtin_amdgcn_s_setprio(1); _Pragma("unroll") for (int m = 0; m < 4; ++m) _Pragma("unroll") for (int n = 0; n < 2; ++n) _Pragma("unroll") for (int k = 0; k < 2; ++k) \
        acc[ai][bj][m][n] = __builtin_amdgcn_mfma_f32_16x16x32_bf16(Bt[n][k], At[m][k], acc[ai][bj][m][n], 0, 0, 0); __builtin_amdgcn_s_setprio(0); } while (0)
#define PG8_WAIT_V(n) asm volatile("s_waitcnt vmcnt(" #n ")" ::: "memory")
#define PG8_WAIT_L(n) asm volatile("s_waitcnt lgkmcnt(" #n ")" ::: "memory")
#define PG8_BAR __builtin_amdgcn_s_barrier()
#define PG8_SCHED __builtin_amdgcn_sched_barrier(0)
#define PG8_AOFFS(dst, u) do { _Pragma("unroll") for (int _h = 0; _h < 2; ++_h) _Pragma("unroll") for (int _i = 0; _i < 2; ++_i) { \
        if constexpr (GATHER) { const int _tok = g.rowmap[(u).pm * BM + _h * HALF + Rr[_i]]; dst[_h][_i] = (unsigned)(_tok * K + Cc[_i]) * 2u; } \
        else dst[_h][_i] = (unsigned)((_h * HALF + Rr[_i]) * K + Cc[_i]) * 2u; } } while (0)
#define PG8_ABASE(u) (GATHER ? (const char*)g.A : (const char*)g.A + (size_t)(u).pm * tstep)
#define PG8_BBASE(u) ((const char*)g.Bt + ((size_t)(u).e * g.N + (size_t)(u).pn * BM) * K * 2)
    Unit cur, nxt, nn; int ui = 0;
    if (!S.next(0, cur)) return;
    bool has_next = S.next(1, nxt);
    unsigned curA[2][2], nxtA[2][2];
    PG8_AOFFS(curA, cur);
    if (has_next) PG8_AOFFS(nxtA, nxt); else {
#pragma unroll
        for (int h = 0; h < 2; ++h)
#pragma unroll
            for (int i = 0; i < 2; ++i) nxtA[h][i] = curA[h][i]; }
    f32x4 acc[2][2][4][2];
#pragma unroll
    for (int a = 0; a < 2; ++a)
#pragma unroll
        for (int b = 0; b < 2; ++b)
#pragma unroll
            for (int m = 0; m < 4; ++m)
#pragma unroll
                for (int n = 0; n < 2; ++n) acc[a][b][m][n] = (f32x4){0.f, 0.f, 0.f, 0.f};
    bf16x8 At[4][2], B0[2][2], B1[2][2];
    const char* cA = PG8_ABASE(cur); const char* cB = PG8_BBASE(cur);
    PG8_STAGE(PG8_SB(0, 0), cB, voffB); PG8_STAGE(PG8_SB(0, 1), cB + hstep, voffB); PG8_STAGE(PG8_SA(0, 0), cA, curA[0]); PG8_STAGE(PG8_SA(0, 1), cA, curA[1]);
    if (wr == 1) PG8_BAR;
    PG8_WAIT_V(2); PG8_BAR;
    PG8_STAGE(PG8_SB(1, 0), cB + kstep, voffB); PG8_STAGE(PG8_SA(1, 0), cA + kstep, curA[0]); PG8_STAGE(PG8_SB(1, 1), cB + hstep + kstep, voffB);
    PG8_WAIT_V(6); PG8_BAR;
    for (;;) {
        const char* nA = has_next ? PG8_ABASE(nxt) : cA; const char* nB = has_next ? PG8_BBASE(nxt) : cB;
        for (int t = 0; t < nt; t += 2) {
            const bool last = (t == nt - 2);
            const char* a1 = cA + (size_t)(t + 1) * kstep;
            const char* a2 = last ? nA : cA + (size_t)(t + 2) * kstep; const char* b2 = last ? nB : cB + (size_t)(t + 2) * kstep;
            const char* a3 = a2 + kstep; const char* b3 = b2 + kstep;
            unsigned o2[2][2];
#pragma unroll
            for (int h = 0; h < 2; ++h)
#pragma unroll
                for (int i = 0; i < 2; ++i) o2[h][i] = last ? nxtA[h][i] : curA[h][i];
            PG8_LDB(B0, 0, 0); PG8_LDB(B1, 0, 1); PG8_SCHED; PG8_LDA(At, 0, 0); PG8_STAGE(PG8_SA(1, 1), a1, curA[1]);
            PG8_WAIT_V(8); PG8_WAIT_L(0); PG8_BAR; PG8_MMA(0, 0, At, B0); PG8_MMA(0, 1, At, B1); PG8_BAR; PG8_SCHED;
            PG8_LDA(At, 0, 1); PG8_STAGE(PG8_SB(0, 0), b2, voffB); PG8_STAGE(PG8_SB(0, 1), b2 + hstep, voffB); PG8_STAGE(PG8_SA(0, 0), a2, o2[0]);
            PG8_WAIT_V(8); PG8_WAIT_L(0); PG8_BAR; PG8_MMA(1, 0, At, B0); PG8_MMA(1, 1, At, B1); PG8_BAR; PG8_SCHED;
            PG8_LDB(B0, 1, 0); PG8_LDB(B1, 1, 1); PG8_SCHED; PG8_LDA(At, 1, 0); PG8_STAGE(PG8_SA(0, 1), a2, o2[1]);
            PG8_WAIT_V(8); PG8_WAIT_L(0); PG8_BAR; PG8_MMA(0, 0, At, B0); PG8_MMA(0, 1, At, B1); PG8_BAR; PG8_SCHED;
            PG8_LDA(At, 1, 1); PG8_STAGE(PG8_SB(1, 0), b3, voffB); PG8_STAGE(PG8_SB(1, 1), b3 + hstep, voffB); PG8_STAGE(PG8_SA(1, 0), a3, o2[0]);
            PG8_WAIT_V(8); PG8_WAIT_L(0); PG8_BAR; PG8_MMA(1, 0, At, B0); PG8_MMA(1, 1, At, B1); PG8_BAR; PG8_SCHED;
        }
        if (wr == 0) PG8_BAR;
        const bool has_nn = has_next && S.next(ui + 2, nn);
        unsigned nnA[2][2];
        if (has_nn) PG8_AOFFS(nnA, nn);
        E(acc, cur, wr, wc, fr, fq);
        if (!has_next) break;
#pragma unroll
        for (int a = 0; a < 2; ++a)
#pragma unroll
            for (int b = 0; b < 2; ++b)
#pragma unroll
                for (int m = 0; m < 4; ++m)
#pragma unroll
                    for (int n = 0; n < 2; ++n) acc[a][b][m][n] = (f32x4){0.f, 0.f, 0.f, 0.f};
        cur = nxt; cA = nA; cB = nB; ++ui;
#pragma unroll
        for (int h = 0; h < 2; ++h)
#pragma unroll
            for (int i = 0; i < 2; ++i) { curA[h][i] = nxtA[h][i]; if (has_nn) nxtA[h][i] = nnA[h][i]; }
        nxt = nn; has_next = has_nn;
        if (wr == 1) PG8_BAR;
    }
    PG8_WAIT_V(0);
    PG8_BAR;
#undef PG8_SA
#undef PG8_SB
#undef PG8_STAGE
#undef PG8_LDA
#undef PG8_LDB
#undef PG8_MMA
#undef PG8_WAIT_V
#undef PG8_WAIT_L
#undef PG8_BAR
#undef PG8_SCHED
#undef PG8_AOFFS
#undef PG8_ABASE
#undef PG8_BBASE
}
}

struct Frame {
    LAS unsigned char* lds;
    int tid, lane, wave, vcu, G;
    const float* in[28];
    float* out;
    unsigned char* ws;
};
template <class Tp> __device__ __forceinline__ Tp* wsp(const Frame& F, size_t off) { return (Tp*)(F.ws + off); }

__device__ __forceinline__ int dest_row(int mode, int s) {
    if (mode == 0) return s;
    if (mode == 1) return (s & ~31) | (((s >> 2) & 1) << 4) | (((s >> 3) & 3) << 2) | (s & 3);
    const int half = s >> 10, j = s & 1023;
    return ((j >> 7) << 8) | (((j >> 6) & 1) << 7) | (((j >> 4) & 3) << 5) | (half << 4) | (j & 15);
}
__device__ __forceinline__ void transpose_item(const float* W, int K, int N, bf16* WT, int mode, LAS float* scr, int item, int lane) {
    const int nblk = N / 32, kb = item / nblk, nb = item % nblk, k0 = 64 * kb, n0 = 32 * nb;
#pragma unroll 8
    for (int i = 0; i < 32; ++i) { const int kk = 2 * i + (lane >> 5); scr[kk * 33 + (lane & 31)] = W[(size_t)(k0 + kk) * N + n0 + (lane & 31)]; }
    asm volatile("s_waitcnt lgkmcnt(0)" ::: "memory");
    const int c = lane & 7;
#pragma unroll
    for (int j = 0; j < 4; ++j) { const int n = (lane >> 3) + 8 * j; const LAS float* s = scr + (8 * c) * 33 + n;
        u32x4 o; o.x = pk2(s[0 * 33], s[1 * 33]); o.y = pk2(s[2 * 33], s[3 * 33]); o.z = pk2(s[4 * 33], s[5 * 33]); o.w = pk2(s[6 * 33], s[7 * 33]);
        *(u32x4*)(WT + (size_t)dest_row(mode, n0 + n) * K + k0 + 8 * c) = o; }
    asm volatile("s_waitcnt lgkmcnt(0)" ::: "memory");
}
__device__ __forceinline__ void phase0(const Frame& F) {
    if (F.vcu < 192) {
        LAS float* sl = (LAS float*)F.lds;
        LAS float* red = (LAS float*)(F.lds + 32768);
        const float* c = F.in[1];
        for (int idx = F.tid; idx < 8192; idx += 512) { const int b = idx & 7, k = idx >> 3; const float cv = c[b * 1024 + k]; sl[idx] = cv / (1.f + __expf(-cv)); }
        __syncthreads();
        const int cl = F.tid & 31, ks = F.tid >> 5, col = F.vcu * 32 + cl;
        const float* wa = F.in[2];
        float acc[8];
#pragma unroll
        for (int b = 0; b < 8; ++b) acc[b] = 0.f;
#pragma unroll 4
        for (int kk = 0; kk < 64; ++kk) { const int k = ks * 64 + kk; const float w = wa[(size_t)k * 6144 + col];
            const f32x4 s0 = *(const LAS f32x4*)(sl + k * 8), s1 = *(const LAS f32x4*)(sl + k * 8 + 4);
            acc[0] += s0[0] * w; acc[1] += s0[1] * w; acc[2] += s0[2] * w; acc[3] += s0[3] * w;
            acc[4] += s1[0] * w; acc[5] += s1[1] * w; acc[6] += s1[2] * w; acc[7] += s1[3] * w; }
#pragma unroll
        for (int b = 0; b < 8; ++b) red[(ks * 32 + cl) * 8 + b] = acc[b];
        __syncthreads();
        if (F.tid < 256) { const int b = F.tid >> 5; float s = F.in[3][col];
            for (int q = 0; q < 16; ++q) s += red[(q * 32 + cl) * 8 + b];
            wsp<float>(F, WS_MOD)[b * 6144 + col] = s; }
    }
    LAS float* scr = (LAS float*)(F.lds + 49152 + F.wave * 8704);
    const int gw = F.vcu * 8 + F.wave, NGW = F.G * 8;
    constexpr int I_IN = 16 * 80, I_OUT = 16 * 32, I_1 = 16 * 64, I_2 = 16 * 32;
    constexpr int NITEMS = I_IN + I_OUT + NE * I_1 + NE * I_2;
    for (int it = gw; it < NITEMS; it += NGW) {
        int r = it;
        if (r < I_IN) { transpose_item(F.in[5], 1024, 2560, wsp<bf16>(F, WS_WIN), 1, scr, r, F.lane); continue; } r -= I_IN;
        if (r < I_OUT) { transpose_item(F.in[20], 1024, 1024, wsp<bf16>(F, WS_WOUT), 0, scr, r, F.lane); continue; } r -= I_OUT;
        if (r < NE * I_1) { const int e = r / I_1; transpose_item(F.in[24] + (size_t)e * 1024 * 2048, 1024, 2048, wsp<bf16>(F, WS_W1) + (size_t)e * 2048 * 1024, 2, scr, r % I_1, F.lane); continue; } r -= NE * I_1;
        { const int e = r / I_2; transpose_item(F.in[26] + (size_t)e * 1024 * 1024, 1024, 1024, wsp<bf16>(F, WS_W2) + (size_t)e * 1024 * 1024, 1, scr, r % I_2, F.lane); }
    }
}

__device__ __forceinline__ void norm_row(const Frame& F, const float* xrow, const float* g, const float* shift, const float* scale, bf16* orow, f32x4 (&h)[4]) {
    const f32x4* xr = (const f32x4*)xrow + F.lane;
    float ss = 0.f;
#pragma unroll
    for (int j = 0; j < 4; ++j) { h[j] = xr[64 * j]; ss += (h[j][0] * h[j][0] + h[j][1] * h[j][1]) + (h[j][2] * h[j][2] + h[j][3] * h[j][3]); }
    const float rstd = rsqrtf(wave_sum(ss) * (1.f / D) + NORM_EPS);
    u32x2* o8 = (u32x2*)orow + F.lane;
#pragma unroll
    for (int j = 0; j < 4; ++j) { const int col = 4 * F.lane + 256 * j;
        const f32x4 gv = *(const f32x4*)(g + col), sh = *(const f32x4*)(shift + col), sc = *(const f32x4*)(scale + col);
        h[j] = h[j] * rstd * gv * (sc + 1.f) + sh;
        u32x2 w; w.x = pk2(h[j][0], h[j][1]); w.y = pk2(h[j][2], h[j][3]); o8[64 * j] = w; }
}
__device__ __forceinline__ void phase1(const Frame& F) {
    const int gw = F.vcu * 8 + F.wave, NGW = F.G * 8;
    const float* mod = wsp<float>(F, WS_MOD);
    for (int row = gw; row < M; row += NGW) { const int b = row / T; f32x4 h[4];
        norm_row(F, F.in[0] + (size_t)row * D, F.in[4], mod + b * 6144, mod + b * 6144 + 1024, wsp<bf16>(F, WS_H) + (size_t)row * D, h); }
}

__device__ __forceinline__ float lerp_col(const bf16* P, int row, int t, int col, const float* mu) {
    const float cur = bf2f(P[(size_t)row * IN_COLS + col]);
    const float prev = t > 0 ? bf2f(P[(size_t)(row - 1) * IN_COLS + col]) : 0.f;
    return cur + (prev - cur) * mu[col];
}
__device__ __forceinline__ void phase3(const Frame& F) {
    const bf16* P = wsp<bf16>(F, WS_P);
    const float* mu = F.in[6]; const float* w0 = F.in[7]; const float* w_up = F.in[8]; const float* a0 = F.in[9]; const float* a_up = F.in[10]; const float* g_up = F.in[11];
    const float* k_k = F.in[12]; const float* k_a = F.in[13]; const float* r_k = F.in[14];
    LAS float* la = (LAS float*)F.lds;
    const int c = F.tid, hh = c >> 6, n = c & 63;
    float* SW = wsp<float>(F, WS_SW); float* SR = wsp<float>(F, WS_SR); float* SK = wsp<float>(F, WS_SK); float* SV = wsp<float>(F, WS_SV);
    float* SKK = wsp<float>(F, WS_SKK); float* SB = wsp<float>(F, WS_SB); bf16* G = wsp<bf16>(F, WS_G); float* BON = wsp<float>(F, WS_BONUS);
    for (int tile = F.vcu; tile < M / 16; tile += F.G) {
        const int r0 = tile * 16;
        __syncthreads();
        for (int idx = F.tid; idx < 16 * 256; idx += 512) { const int i = idx >> 8, cc = idx & 255, row = r0 + i, t = row % T;
            const float xv = lerp_col(P, row, t, 1536 + cc, mu);
            la[idx] = cc < 64 ? tanhf(xv) : (cc < 128 ? xv : sigmoidf_(xv)); }
        __syncthreads();
        float accw[16], acca[16], accg[16];
#pragma unroll
        for (int i = 0; i < 16; ++i) { accw[i] = 0.f; acca[i] = 0.f; accg[i] = 0.f; }
        for (int k4 = 0; k4 < 16; ++k4) {
            float wv[4], av[4];
#pragma unroll
            for (int q = 0; q < 4; ++q) { wv[q] = w_up[(4 * k4 + q) * 512 + c]; av[q] = a_up[(4 * k4 + q) * 512 + c]; }
#pragma unroll
            for (int i = 0; i < 16; ++i) { const f32x4 x1 = *(const LAS f32x4*)(la + i * 256 + 4 * k4), x2 = *(const LAS f32x4*)(la + i * 256 + 64 + 4 * k4);
                accw[i] += x1[0] * wv[0] + x1[1] * wv[1] + x1[2] * wv[2] + x1[3] * wv[3];
                acca[i] += x2[0] * av[0] + x2[1] * av[1] + x2[2] * av[2] + x2[3] * av[3]; }
        }
        for (int k4 = 0; k4 < 32; ++k4) {
            float gv[4];
#pragma unroll
            for (int q = 0; q < 4; ++q) gv[q] = g_up[(4 * k4 + q) * 512 + c];
#pragma unroll
            for (int i = 0; i < 16; ++i) { const f32x4 x3 = *(const LAS f32x4*)(la + i * 256 + 128 + 4 * k4);
                accg[i] += x3[0] * gv[0] + x3[1] * gv[1] + x3[2] * gv[2] + x3[3] * gv[3]; }
        }
        const float w0c = w0[c], a0c = a0[c], kkc = k_k[c], kac = k_a[c], rkc = r_k[c];
#pragma unroll
        for (int i = 0; i < 16; ++i) { const int row = r0 + i, t = row % T, b = row / T;
            const float r = lerp_col(P, row, t, c, mu), kr = lerp_col(P, row, t, 512 + c, mu), v = lerp_col(P, row, t, 1024 + c, mu);
            const float decay = __expf(-0.60653066f * sigmoidf_(w0c + accw[i]));
            const float a = sigmoidf_(a0c + acca[i]);
            const float kk = kr * kkc;
            const float ssq = wave_sum(kk * kk);
            const float kkn = kk / fmaxf(sqrtf(ssq), 1e-12f);
            const float k = kr * (1.f + (a - 1.f) * kac);
            const float bon = wave_sum(r * k * rkc);
            const size_t so = ((size_t)(b * RH + hh) * T + t) * 64 + n;
            SW[so] = decay; SR[so] = r; SK[so] = k; SV[so] = v; SKK[so] = kkn; SB[so] = kkn * a;
            G[(size_t)row * 512 + c] = (bf16)f2bf(accg[i]);
            if (n == 0) BON[row * 8 + hh] = bon; }
    }
}

constexpr int SCH = 32;
__device__ __forceinline__ void phase4_scan(const Frame& F) {
    if (F.vcu >= NBATCH * RH) return;
    const int bh = F.vcu;
    const float* src[6] = { wsp<float>(F, WS_SW) + (size_t)bh * T * 64, wsp<float>(F, WS_SKK) + (size_t)bh * T * 64, wsp<float>(F, WS_SB) + (size_t)bh * T * 64,
                            wsp<float>(F, WS_SK) + (size_t)bh * T * 64, wsp<float>(F, WS_SR) + (size_t)bh * T * 64, wsp<float>(F, WS_SV) + (size_t)bh * T * 64 };
    float* Y = wsp<float>(F, WS_Y);
    const int b = bh / RH, hh = bh % RH;
    LAS float* buf0 = (LAS float*)F.lds; LAS float* buf1 = (LAS float*)(F.lds + 6 * SCH * 64 * 4);
    f32x4 pre[6];
#define SC_LOAD(cidx) do { _Pragma("unroll") for (int a = 0; a < 6; ++a) pre[a] = *(const f32x4*)(src[a] + (size_t)(cidx) * SCH * 64 + 4 * F.tid); } while (0)
#define SC_STORE(bufp) do { _Pragma("unroll") for (int a = 0; a < 6; ++a) *(LAS f32x4*)((bufp) + a * SCH * 64 + 4 * F.tid) = pre[a]; } while (0)
    SC_LOAD(0); SC_STORE(buf0);
    __syncthreads();
    float S[64];
#pragma unroll
    for (int k = 0; k < 64; ++k) S[k] = 0.f;
    constexpr int NCH = T / SCH;
    for (int ch = 0; ch < NCH; ++ch) {
        LAS float* cb = (ch & 1) ? buf1 : buf0; LAS float* nb = (ch & 1) ? buf0 : buf1;
        if (ch + 1 < NCH) SC_LOAD(ch + 1);
        if (F.wave == 0) {
            for (int s = 0; s < SCH; ++s) {
                const LAS float* pw = cb + s * 64; const LAS float* pkk = cb + SCH * 64 + s * 64; const LAS float* pb = cb + 2 * SCH * 64 + s * 64;
                const LAS float* pk = cb + 3 * SCH * 64 + s * 64; const LAS float* pr = cb + 4 * SCH * 64 + s * 64;
                const float v = cb[5 * SCH * 64 + s * 64 + F.lane];
                float sa0 = 0.f, sa1 = 0.f, sa2 = 0.f, sa3 = 0.f;
#pragma unroll
                for (int k = 0; k < 64; k += 4) { const f32x4 q = *(const LAS f32x4*)(pkk + k); sa0 += S[k] * q[0]; sa1 += S[k + 1] * q[1]; sa2 += S[k + 2] * q[2]; sa3 += S[k + 3] * q[3]; }
                const float sa = -((sa0 + sa1) + (sa2 + sa3));
                float y0 = 0.f, y1 = 0.f, y2 = 0.f, y3 = 0.f;
#pragma unroll
                for (int k = 0; k < 64; k += 4) { const f32x4 w4 = *(const LAS f32x4*)(pw + k), b4 = *(const LAS f32x4*)(pb + k), k4 = *(const LAS f32x4*)(pk + k), r4 = *(const LAS f32x4*)(pr + k);
                    S[k] = S[k] * w4[0] + sa * b4[0] + v * k4[0]; S[k + 1] = S[k + 1] * w4[1] + sa * b4[1] + v * k4[1];
                    S[k + 2] = S[k + 2] * w4[2] + sa * b4[2] + v * k4[2]; S[k + 3] = S[k + 3] * w4[3] + sa * b4[3] + v * k4[3];
                    y0 += S[k] * r4[0]; y1 += S[k + 1] * r4[1]; y2 += S[k + 2] * r4[2]; y3 += S[k + 3] * r4[3]; }
                Y[((size_t)b * T + ch * SCH + s) * 512 + hh * 64 + F.lane] = (y0 + y1) + (y2 + y3);
            }
        }
        if (ch + 1 < NCH) SC_STORE(nb);
        __syncthreads();
    }
#undef SC_LOAD
#undef SC_STORE
}

constexpr int KLD = 72;
constexpr int VLD = 260;
__device__ __forceinline__ void phase5_attn(const Frame& F) {
    const bf16* P = wsp<bf16>(F, WS_P);
    bf16* CAT = wsp<bf16>(F, WS_CAT);
    const float* qg = F.in[17]; const float* kg = F.in[18]; const float* sinks = F.in[19];
    LAS bf16* Kl = (LAS bf16*)F.lds;
    LAS bf16* Vt = (LAS bf16*)(F.lds + 256 * KLD * 2);
    const int lane = F.lane, r = lane & 31, h = lane >> 5;
    for (int unit = F.vcu; unit < NBATCH * KVH * (T / 128); unit += F.G) {
        const int blk = unit % (T / 128), kvh = (unit / (T / 128)) % KVH, b = unit / (T / 128 * KVH);
        const int kpos0 = blk * 128 - 128;
        __syncthreads();
        for (int ch = F.tid; ch < 2048; ch += 512) { const int key = ch >> 3, dc = ch & 7, kpos = kpos0 + key;
            u32x4 kraw = (u32x4){0u, 0u, 0u, 0u}, vraw = (u32x4){0u, 0u, 0u, 0u};
            if (kpos >= 0) { const size_t ro = (size_t)(b * T + kpos) * IN_COLS; kraw = *(const u32x4*)(P + ro + COL_K + kvh * 64 + dc * 8); vraw = *(const u32x4*)(P + ro + COL_V + kvh * 64 + dc * 8); }
            float kf[8]; kf[0] = bflo(kraw.x); kf[1] = bfhi(kraw.x); kf[2] = bflo(kraw.y); kf[3] = bfhi(kraw.y); kf[4] = bflo(kraw.z); kf[5] = bfhi(kraw.z); kf[6] = bflo(kraw.w); kf[7] = bfhi(kraw.w);
            float ss = 0.f;
#pragma unroll
            for (int j = 0; j < 8; ++j) ss += kf[j] * kf[j];
            ss += __shfl_xor(ss, 1); ss += __shfl_xor(ss, 2); ss += __shfl_xor(ss, 4);
            const float rstd = rsqrtf(ss * (1.f / 64.f) + NORM_EPS);
            const f32x4 g0 = *(const f32x4*)(kg + dc * 8), g1 = *(const f32x4*)(kg + dc * 8 + 4);
            u32x4 ko; ko.x = pk2(kf[0] * rstd * g0[0], kf[1] * rstd * g0[1]); ko.y = pk2(kf[2] * rstd * g0[2], kf[3] * rstd * g0[3]);
            ko.z = pk2(kf[4] * rstd * g1[0], kf[5] * rstd * g1[1]); ko.w = pk2(kf[6] * rstd * g1[2], kf[7] * rstd * g1[3]);
            *(LAS u32x4*)(Kl + key * KLD + dc * 8) = ko;
            const unsigned vv[4] = {vraw.x, vraw.y, vraw.z, vraw.w};
#pragma unroll
            for (int j = 0; j < 4; ++j) { Vt[(dc * 8 + 2 * j) * VLD + key] = (bf16)(vv[j] & 0xffffu); Vt[(dc * 8 + 2 * j + 1) * VLD + key] = (bf16)(vv[j] >> 16); }
        }
        __syncthreads();
        for (int task = F.wave; task < 16; task += 8) {
            const int g = task & 3, qs = task >> 2, head = kvh * 4 + g;
            const int qrow = b * T + blk * 128 + qs * 32 + r;
            float qf[4][8]; float ss = 0.f;
#pragma unroll
            for (int s = 0; s < 4; ++s) { const u32x4 qr = *(const u32x4*)(P + (size_t)qrow * IN_COLS + COL_Q + head * 64 + 16 * s + 8 * h);
                qf[s][0] = bflo(qr.x); qf[s][1] = bfhi(qr.x); qf[s][2] = bflo(qr.y); qf[s][3] = bfhi(qr.y); qf[s][4] = bflo(qr.z); qf[s][5] = bfhi(qr.z); qf[s][6] = bflo(qr.w); qf[s][7] = bfhi(qr.w);
#pragma unroll
                for (int j = 0; j < 8; ++j) ss += qf[s][j] * qf[s][j]; }
            ss += __shfl_xor(ss, 32);
            const float qscale = rsqrtf(ss * (1.f / 64.f) + NORM_EPS) * 0.125f;
            bf16x8 qb[4];
#pragma unroll
            for (int s = 0; s < 4; ++s) { u32x4 w;
                const f32x4 g0 = *(const f32x4*)(qg + 16 * s + 8 * h), g1 = *(const f32x4*)(qg + 16 * s + 8 * h + 4);
                w.x = pk2(qf[s][0] * qscale * g0[0], qf[s][1] * qscale * g0[1]); w.y = pk2(qf[s][2] * qscale * g0[2], qf[s][3] * qscale * g0[3]);
                w.z = pk2(qf[s][4] * qscale * g1[0], qf[s][5] * qscale * g1[1]); w.w = pk2(qf[s][6] * qscale * g1[2], qf[s][7] * qscale * g1[3]);
                qb[s] = __builtin_bit_cast(bf16x8, w); }
            f32x16 st[5];
#pragma unroll
            for (int kt = 0; kt < 5; ++kt) {
#pragma unroll
                for (int i = 0; i < 16; ++i) st[kt][i] = 0.f;
#pragma unroll
                for (int s = 0; s < 4; ++s) { const bf16x8 ka = *(const LAS bf16x8*)(Kl + (32 * (qs + kt) + r) * KLD + 16 * s + 8 * h);
                    st[kt] = __builtin_amdgcn_mfma_f32_32x32x16_bf16(ka, qb[s], st[kt], 0, 0, 0); }
            }
            const int iq = 32 * qs + r;
            const float sink = sinks[head];
            float mx = sink;
#pragma unroll
            for (int kt = 0; kt < 5; ++kt)
#pragma unroll
                for (int i = 0; i < 16; ++i) { const int jw = 32 * (qs + kt) + (i & 3) + 8 * (i >> 2) + 4 * h;
                    const bool ok = (jw >= iq + 1) && (jw <= iq + 128) && (kpos0 + jw >= 0);
                    st[kt][i] = ok ? st[kt][i] : -INFINITY; mx = fmaxf(mx, st[kt][i]); }
            mx = fmaxf(mx, __shfl_xor(mx, 32));
            float lsum = 0.f;
#pragma unroll
            for (int kt = 0; kt < 5; ++kt)
#pragma unroll
                for (int i = 0; i < 16; ++i) { const float p = __expf(st[kt][i] - mx); st[kt][i] = p; lsum += p; }
            lsum += __shfl_xor(lsum, 32);
            const float linv = 1.f / (lsum + __expf(sink - mx));
            f32x16 o[2];
#pragma unroll
            for (int dt = 0; dt < 2; ++dt)
#pragma unroll
                for (int i = 0; i < 16; ++i) o[dt][i] = 0.f;
#pragma unroll
            for (int kt = 0; kt < 5; ++kt)
#pragma unroll
                for (int sp = 0; sp < 2; ++sp) { u32x4 pw;
                    pw.x = pk2(st[kt][8 * sp + 0] * linv, st[kt][8 * sp + 1] * linv); pw.y = pk2(st[kt][8 * sp + 2] * linv, st[kt][8 * sp + 3] * linv);
                    pw.z = pk2(st[kt][8 * sp + 4] * linv, st[kt][8 * sp + 5] * linv); pw.w = pk2(st[kt][8 * sp + 6] * linv, st[kt][8 * sp + 7] * linv);
                    const bf16x8 pa = __builtin_bit_cast(bf16x8, pw);
                    const int kb = 32 * (qs + kt) + 16 * sp + 4 * h;
#pragma unroll
                    for (int dt = 0; dt < 2; ++dt) { const LAS bf16* vp = Vt + (32 * dt + r) * VLD + kb;
                        const u32x2 lo = *(const LAS u32x2*)vp, hi = *(const LAS u32x2*)(vp + 8);
                        u32x4 vw; vw.x = lo.x; vw.y = lo.y; vw.z = hi.x; vw.w = hi.y;
                        o[dt] = __builtin_amdgcn_mfma_f32_32x32x16_bf16(pa, __builtin_bit_cast(bf16x8, vw), o[dt], 0, 0, 0); } }
#pragma unroll
            for (int dt = 0; dt < 2; ++dt)
#pragma unroll
                for (int i = 0; i < 16; ++i) { const int qr = (i & 3) + 8 * (i >> 2) + 4 * h;
                    CAT[(size_t)(b * T + blk * 128 + qs * 32 + qr) * D + 512 + head * 64 + 32 * dt + r] = (bf16)f2bf(o[dt][i]); }
        }
    }
}

__device__ __forceinline__ void phase6(const Frame& F) {
    const int gw = F.vcu * 8 + F.wave, NGW = F.G * 8;
    const float* Y = wsp<float>(F, WS_Y); const float* SV = wsp<float>(F, WS_SV); const bf16* G = wsp<bf16>(F, WS_G); const float* BON = wsp<float>(F, WS_BONUS);
    bf16* CAT = wsp<bf16>(F, WS_CAT);
    const float* lg = F.in[15]; const float* lb = F.in[16];
    const int hh = F.lane >> 3, n0 = (F.lane & 7) * 8, c0 = F.lane * 8;
    for (int row = gw; row < M; row += NGW) { const int b = row / T, t = row % T;
        const f32x4 y0 = *(const f32x4*)(Y + (size_t)row * 512 + c0), y1 = *(const f32x4*)(Y + (size_t)row * 512 + c0 + 4);
        float yv[8] = {y0[0], y0[1], y0[2], y0[3], y1[0], y1[1], y1[2], y1[3]};
        float s = 0.f;
#pragma unroll
        for (int j = 0; j < 8; ++j) s += yv[j];
        s += __shfl_xor(s, 1); s += __shfl_xor(s, 2); s += __shfl_xor(s, 4);
        const float mean = s * (1.f / 64.f); float q = 0.f;
#pragma unroll
        for (int j = 0; j < 8; ++j) { yv[j] -= mean; q += yv[j] * yv[j]; }
        q += __shfl_xor(q, 1); q += __shfl_xor(q, 2); q += __shfl_xor(q, 4);
        const float rstd = rsqrtf(q * (1.f / 64.f) + GN_EPS);
        const float bon = BON[row * 8 + hh];
        const float* vp = SV + ((size_t)(b * RH + hh) * T + t) * 64 + n0;
        const f32x4 v0 = *(const f32x4*)vp, v1 = *(const f32x4*)(vp + 4);
        const float vv[8] = {v0[0], v0[1], v0[2], v0[3], v1[0], v1[1], v1[2], v1[3]};
        const u32x4 graw = *(const u32x4*)(G + (size_t)row * 512 + c0);
        const float gg[8] = {bflo(graw.x), bfhi(graw.x), bflo(graw.y), bfhi(graw.y), bflo(graw.z), bfhi(graw.z), bflo(graw.w), bfhi(graw.w)};
        float ov[8];
#pragma unroll
        for (int j = 0; j < 8; ++j) ov[j] = (yv[j] * rstd * lg[c0 + j] + lb[c0 + j] + bon * vv[j]) * gg[j];
        u32x4 w; w.x = pk2(ov[0], ov[1]); w.y = pk2(ov[2], ov[3]); w.z = pk2(ov[4], ov[5]); w.w = pk2(ov[6], ov[7]);
        *(u32x4*)(CAT + (size_t)row * D + c0) = w; }
}

__device__ __forceinline__ void phase8(const Frame& F) {
    const float* mod = wsp<float>(F, WS_MOD); const float* x1 = F.out;
    const float* wr_ = F.in[22]; const float* br = F.in[23];
    LAS float* part = (LAS float*)(F.lds + F.wave * 8704);
    LAS float* lg32 = (LAS float*)(F.lds + 8 * 8704 + F.wave * 256);
    LAS int* cnt = (LAS int*)(F.lds + 8 * 8704 + 8 * 256);
    if (F.tid < 32) cnt[F.tid] = 0;
    __syncthreads();
    int* RT_E = wsp<int>(F, WS_RT_E); int* RT_LP = wsp<int>(F, WS_RT_LP); float* RT_G = wsp<float>(F, WS_RT_G);
    for (int i = 0; i < 16; ++i) { const int row = F.vcu * 128 + F.wave * 16 + i, b = row / T;
        f32x4 h[4];
        norm_row(F, x1 + (size_t)row * D, F.in[21], mod + b * 6144 + 3072, mod + b * 6144 + 4096, wsp<bf16>(F, WS_H) + (size_t)row * D, h);
        float pa[32];
#pragma unroll
        for (int e = 0; e < 32; ++e) pa[e] = 0.f;
#pragma unroll
        for (int j = 0; j < 4; ++j)
#pragma unroll
            for (int q = 0; q < 4; ++q) { const int col = 4 * F.lane + 256 * j + q; const float hv = h[j][q];
#pragma unroll
                for (int e4 = 0; e4 < 8; ++e4) { const f32x4 w4 = *(const f32x4*)(wr_ + (size_t)col * 32 + 4 * e4);
                    pa[4 * e4] += hv * w4[0]; pa[4 * e4 + 1] += hv * w4[1]; pa[4 * e4 + 2] += hv * w4[2]; pa[4 * e4 + 3] += hv * w4[3]; } }
#pragma unroll
        for (int e = 0; e < 32; ++e) part[e * 65 + F.lane] = pa[e];
        asm volatile("s_waitcnt lgkmcnt(0)" ::: "memory");
        const int e = F.lane & 31, hf = F.lane >> 5; float s = 0.f;
#pragma unroll 8
        for (int q = 0; q < 32; ++q) s += part[e * 65 + hf * 32 + q];
        s += __shfl_xor(s, 32);
        const float logit = s + br[e];
        if (F.lane < 32) lg32[e] = logit;
        asm volatile("s_waitcnt lgkmcnt(0)" ::: "memory");
        int rank = 0;
#pragma unroll 8
        for (int q = 0; q < 32; ++q) { const float o = lg32[q]; rank += (o > logit || (o == logit && q < e)) ? 1 : 0; }
        if (F.lane < 32 && rank < 4) lg32[32 + rank] = logit;
        asm volatile("s_waitcnt lgkmcnt(0)" ::: "memory");
        const float t0 = lg32[32], t1 = lg32[33], t2 = lg32[34], t3 = lg32[35];
        const float den = 1.f + __expf(t1 - t0) + __expf(t2 - t0) + __expf(t3 - t0);
        if (F.lane < 32 && rank < 4) { const int lp = atomicAdd((int*)&cnt[e], 1);
            RT_E[row * 4 + rank] = e; RT_LP[row * 4 + rank] = lp; RT_G[row * 4 + rank] = __expf(logit - t0) / den; }
        asm volatile("s_waitcnt lgkmcnt(0)" ::: "memory");
    }
    __syncthreads();
    if (F.tid < 32) wsp<int>(F, WS_BLKCNT)[F.vcu * 32 + F.tid] = cnt[F.tid];
}

__device__ __forceinline__ void phase9(const Frame& F) {
    LAS int* base = (LAS int*)F.lds;
    LAS int* tot = base + 32;
    LAS int* pst = base + 64;
    const int* BC = wsp<int>(F, WS_BLKCNT);
    if (F.tid < 32) { int s = 0, mine = 0; for (int bk = 0; bk < F.G; ++bk) { if (bk == F.vcu) mine = s; s += BC[bk * 32 + F.tid]; } base[F.tid] = mine; tot[F.tid] = s; }
    __syncthreads();
    if (F.tid == 0) { int s = 0; for (int e = 0; e < 32; ++e) { pst[e] = s; s += (tot[e] + 255) / 256 * 256; } pst[32] = s; }
    __syncthreads();
    int* SLOT_TOK = wsp<int>(F, WS_SLOTTOK); float* SLOT_GATE = wsp<float>(F, WS_SLOTGATE); int* TOK_SLOT = wsp<int>(F, WS_TOKSLOT);
    const int* RT_E = wsp<int>(F, WS_RT_E); const int* RT_LP = wsp<int>(F, WS_RT_LP); const float* RT_G = wsp<float>(F, WS_RT_G);
    { const int idx = F.vcu * 512 + F.tid;
        const int e = RT_E[idx], slot = pst[e] + base[e] + RT_LP[idx];
        SLOT_TOK[slot] = idx >> 2; SLOT_GATE[slot] = RT_G[idx]; TOK_SLOT[idx] = slot; }
    if (F.vcu < 32) { const int e = F.vcu; for (int s = pst[e] + tot[e] + F.tid; s < pst[e + 1]; s += 512) { SLOT_TOK[s] = 0; SLOT_GATE[s] = 0.f; } }
    if (F.vcu == 0) { unsigned* ctl = wsp<unsigned>(F, WS_CTL);
        if (F.tid == 0) ctl[CW_NTILES] = (unsigned)(pst[32] / 256);
        if (F.tid < 33) ctl[CW_PADSTART + F.tid] = (unsigned)pst[F.tid];
        int* TE = wsp<int>(F, WS_TILEE);
        for (int tl = F.tid; tl < MAX_TILES; tl += 512) { int e = 31; for (int q = 0; q < 32; ++q) if (tl * 256 < pst[q + 1]) { e = q; break; } TE[tl] = e; } }
}

__device__ __forceinline__ void phase12(const Frame& F) {
    const int gw = F.vcu * 8 + F.wave, NGW = F.G * 8;
    const float* mod = wsp<float>(F, WS_MOD); const bf16* YS = wsp<bf16>(F, WS_YS); const int* TOK_SLOT = wsp<int>(F, WS_TOKSLOT);
    for (int row = gw; row < M; row += NGW) { const int b = row / T;
        int sl[4];
#pragma unroll
        for (int k = 0; k < 4; ++k) sl[k] = TOK_SLOT[row * 4 + k];
#pragma unroll
        for (int j = 0; j < 2; ++j) { const int col = 8 * F.lane + 512 * j;
            float a[8];
#pragma unroll
            for (int q = 0; q < 8; ++q) a[q] = 0.f;
#pragma unroll
            for (int k = 0; k < 4; ++k) { const u32x4 v = *(const u32x4*)(YS + (size_t)sl[k] * D + col);
                a[0] += bflo(v.x); a[1] += bfhi(v.x); a[2] += bflo(v.y); a[3] += bfhi(v.y); a[4] += bflo(v.z); a[5] += bfhi(v.z); a[6] += bflo(v.w); a[7] += bfhi(v.w); }
            const float* gp = mod + b * 6144 + 5120 + col;
            const f32x4 g0 = *(const f32x4*)gp, g1 = *(const f32x4*)(gp + 4);
            float* op = F.out + (size_t)row * D + col;
            f32x4 x0 = *(const f32x4*)op, x1v = *(const f32x4*)(op + 4);
            x0[0] += g0[0] * a[0]; x0[1] += g0[1] * a[1]; x0[2] += g0[2] * a[2]; x0[3] += g0[3] * a[3];
            x1v[0] += g1[0] * a[4]; x1v[1] += g1[1] * a[5]; x1v[2] += g1[2] * a[6]; x1v[3] += g1[3] * a[7];
            *(f32x4*)op = x0; *(f32x4*)(op + 4) = x1v; } }
}

__device__ __forceinline__ void copy_x_to_out(const Frame& F) {
    const size_t n4 = (size_t)M * D / 4; const f32x4* s = (const f32x4*)F.in[0]; f32x4* d = (f32x4*)F.out;
    for (size_t i = (size_t)blockIdx.x * 512 + F.tid; i < n4; i += (size_t)gridDim.x * 512) d[i] = s[i];
}

struct Args { const float* in[28]; float* out; unsigned char* ws; int ph_lo, ph_hi; };
constexpr int N_PHASES = 13;

__global__ void __launch_bounds__(512, 2) mk_fwd(Args args) {
    extern __shared__ __attribute__((aligned(16))) unsigned char lds_raw[];
    Frame F;
    F.lds = (LAS unsigned char*)lds_raw;
    F.tid = threadIdx.x; F.lane = F.tid & 63; F.wave = __builtin_amdgcn_readfirstlane(F.tid >> 6);
    F.G = gridDim.x; { const int bx = blockIdx.x; F.vcu = (F.G % 8 == 0) ? (bx % 8) * (F.G / 8) + bx / 8 : bx; }
#pragma unroll
    for (int i = 0; i < 28; ++i) F.in[i] = args.in[i];
    F.out = args.out; F.ws = args.ws;
    cg::grid_group grid = cg::this_grid();
    const int lo = args.ph_lo, hi = args.ph_hi;
#define IN(k) (lo <= (k) && (k) < hi)
#define SEAM(k) do { if (IN(k) && IN((k) + 1)) grid.sync(); } while (0)

    if (IN(0)) { phase0(F); } SEAM(0);
    if (IN(1)) { phase1(F); } SEAM(1);
    if (IN(2)) {
        pg8::Gemm g{wsp<bf16>(F, WS_H), wsp<bf16>(F, WS_WIN), D, IN_COLS, nullptr};
        pg8::StaticOrder S; S.init(M, IN_COLS, F.G, (int)blockIdx.x);
        pg8::EpiBf16P E{wsp<bf16>(F, WS_P), IN_COLS};
        pg8::gemm_phase<pg8::EpiBf16P, pg8::StaticOrder, false>(F.lds, g, S, E);
    } SEAM(2);
    if (IN(3)) { phase3(F); } SEAM(3);
    if (IN(4)) { phase4_scan(F); } SEAM(4);
    if (IN(5)) { phase5_attn(F); } SEAM(5);
    if (IN(6)) { phase6(F); } SEAM(6);
    if (IN(7)) {
#if MK_LAST_PHASE >= 7
        pg8::Gemm g{wsp<bf16>(F, WS_CAT), wsp<bf16>(F, WS_WOUT), D, D, nullptr};
        pg8::StaticOrder S; S.init(M, D, F.G, (int)blockIdx.x);
        pg8::EpiOutProj E{F.in[0], F.out, wsp<float>(F, WS_MOD) + 2048};
        pg8::gemm_phase<pg8::EpiOutProj, pg8::StaticOrder, false>(F.lds, g, S, E);
#else
        copy_x_to_out(F);
#endif
    } SEAM(7);
    if (IN(8)) { phase8(F); } SEAM(8);
    if (IN(9)) { phase9(F); } SEAM(9);
    if (IN(10)) {
        const unsigned* ctl = wsp<unsigned>(F, WS_CTL);
        pg8::Gemm g{wsp<bf16>(F, WS_H), wsp<bf16>(F, WS_W1), D, 2 * DE, wsp<int>(F, WS_SLOTTOK)};
        pg8::MoeOrder S{(int)ctl[CW_NTILES], 8, F.G, F.vcu, wsp<int>(F, WS_TILEE)};
        pg8::EpiMoe1 E{wsp<bf16>(F, WS_ACT), F.in[25]};
        pg8::gemm_phase<pg8::EpiMoe1, pg8::MoeOrder, true>(F.lds, g, S, E);
    } SEAM(10);
    if (IN(11)) {
        const unsigned* ctl = wsp<unsigned>(F, WS_CTL);
        pg8::Gemm g{wsp<bf16>(F, WS_ACT), wsp<bf16>(F, WS_W2), DE, D, nullptr};
        pg8::MoeOrder S{(int)ctl[CW_NTILES], 4, F.G, F.vcu, wsp<int>(F, WS_TILEE)};
        pg8::EpiMoe2 E{wsp<bf16>(F, WS_YS), F.in[27], wsp<float>(F, WS_SLOTGATE)};
        pg8::gemm_phase<pg8::EpiMoe2, pg8::MoeOrder, false>(F.lds, g, S, E);
    } SEAM(11);
    if (IN(12)) { phase12(F); }
#undef IN
#undef SEAM
}

extern "C" void kernel_launch(void* const* d_in, const int* in_sizes, int n_in, void* d_out, int out_size, void* d_ws, size_t ws_size, hipStream_t stream) {
    static int grid = 0;
    if (grid == 0) {
        if (n_in != 28 || out_size != M * D || ws_size < WS_END) { fprintf(stderr, "kernel_launch: unexpected sizes (n_in %d out %d ws %zu, need %zu)\n", n_in, out_size, ws_size, (size_t)WS_END); grid = -1; return; }
        int dev = 0, cus = 0, per_cu = 0;
        (void)hipGetDevice(&dev); (void)hipDeviceGetAttribute(&cus, hipDeviceAttributeMultiprocessorCount, dev);
        (void)hipFuncSetAttribute((const void*)mk_fwd, hipFuncAttributeMaxDynamicSharedMemorySize, LDS_BYTES);
        (void)hipOccupancyMaxActiveBlocksPerMultiprocessor(&per_cu, (const void*)mk_fwd, 512, LDS_BYTES);
        if (per_cu < 1 || cus != 256) { fprintf(stderr, "kernel_launch: occupancy %d, CUs %d: this build needs 256 CUs x 1 block\n", per_cu, cus); grid = -1; return; }
        grid = cus;
    }
    if (grid < 0) return;
    (void)hipMemsetAsync((char*)d_ws + WS_CTL, 0, CTL_BYTES, stream);
    Args a{};
    for (int i = 0; i < 28; ++i) a.in[i] = (const float*)d_in[i];
    a.out = (float*)d_out; a.ws = (unsigned char*)d_ws;
    const int last = MK_LAST_PHASE + 1;
#if MK_ONE_LAUNCH
    a.ph_lo = 0; a.ph_hi = last;
    void* kargs[] = {&a};
    hipError_t e = hipLaunchCooperativeKernel((const void*)mk_fwd, dim3(grid), dim3(512), kargs, LDS_BYTES, stream);
    if (e != hipSuccess) fprintf(stderr, "cooperative launch failed: %s\n", hipGetErrorString(e));
#else
    for (int p = 0; p < last; ++p) { a.ph_lo = p; a.ph_hi = p + 1; hipLaunchKernelGGL(mk_fwd, dim3(grid), dim3(512), LDS_BYTES, stream, a); }
#endif
}
```

```cpp
#include <hip/hip_runtime.h>
#include <hip/hip_cooperative_groups.h>
#include <cstdio>
#include <cstdint>
namespace cg = cooperative_groups;

#ifndef MK_ONE_LAUNCH
#define MK_ONE_LAUNCH 1
#endif
#ifndef MK_LAST_PHASE
#define MK_LAST_PHASE 12
#endif

constexpr int D = 1024, NBATCH = 8, T = 4096, M = NBATCH * T;
constexpr int HD = 64, RW = 512, RH = 8, AW = 512, QH = 8, KVH = 2, WIN = 128;
constexpr int RWKV_COLS = 1792, IN_COLS = 2560;
constexpr int COL_Q = 1792, COL_K = 1792 + 512, COL_V = 1792 + 512 + 128;
constexpr int NE = 32, TOPK = 4, DE = 1024;
constexpr int MAX_TILES = 544;
constexpr int MAX_SLOTS = MAX_TILES * 256;
constexpr float NORM_EPS = 1e-6f, GN_EPS = 64e-5f;

#define GAS __attribute__((address_space(1)))
#define LAS __attribute__((address_space(3)))
typedef unsigned short bf16;
typedef short bf16x8 __attribute__((ext_vector_type(8)));
typedef float f32x4 __attribute__((ext_vector_type(4)));
typedef float f32x2 __attribute__((ext_vector_type(2)));
typedef float f32x16 __attribute__((ext_vector_type(16)));
typedef unsigned u32x4 __attribute__((ext_vector_type(4)));
typedef unsigned u32x2 __attribute__((ext_vector_type(2)));

constexpr size_t MiB = 1u << 20;
constexpr size_t WS_CTL = 0, CTL_BYTES = 64 * 1024;
constexpr size_t WS_MOD = 1 * MiB;
constexpr size_t WS_BON = 1 * MiB + 256 * 1024;
constexpr size_t WS_RT_E = 2 * MiB;
constexpr size_t WS_RT_LP = 2 * MiB + 512 * 1024;
constexpr size_t WS_RT_G = 3 * MiB;
constexpr size_t WS_TOKSLOT = 3 * MiB + 512 * 1024;
constexpr size_t WS_SLOTTOK = 4 * MiB;
constexpr size_t WS_SLOTGATE = 5 * MiB;
constexpr size_t WS_BLKCNT = 6 * MiB;
constexpr size_t WS_TILEE = 6 * MiB + 64 * 1024;
constexpr size_t WS_BONUS = 7 * MiB;
constexpr size_t WS_WIN = 10 * MiB;
constexpr size_t WS_WOUT = 16 * MiB;
constexpr size_t WS_W1 = 20 * MiB;
constexpr size_t WS_W2 = 148 * MiB;
constexpr size_t WS_H = 212 * MiB;
constexpr size_t WS_R2 = 276 * MiB;
constexpr size_t WS_P = WS_R2;
constexpr size_t WS_SCN = WS_R2 + 160 * MiB;
constexpr size_t WS_SV = WS_SCN + 320 * MiB;
constexpr size_t WS_G = WS_SV + 64 * MiB;
constexpr size_t WS_Y = WS_G + 32 * MiB;
constexpr size_t WS_CAT = WS_Y + 64 * MiB;
constexpr size_t WS_ACT = WS_R2;
constexpr size_t WS_YS = WS_R2 + 272 * MiB;
constexpr size_t WS_END = WS_CAT + 64 * MiB;
static_assert(WS_END <= 1024 * MiB, "workspace map");
static_assert(WS_YS + 272 * MiB <= WS_CAT, "YS must not overlay CAT");
constexpr int CW_NTILES = 16;
constexpr int CW_PADSTART = 64;

constexpr int LDS_BYTES = 156 * 1024;

__device__ __forceinline__ unsigned f2bf(float f) { unsigned u = __builtin_bit_cast(unsigned, f); return (u + 0x7fffu + ((u >> 16) & 1u)) >> 16; }
__device__ __forceinline__ unsigned pk2(float lo, float hi) { return f2bf(lo) | (f2bf(hi) << 16); }
__device__ __forceinline__ float bf2f(unsigned short b) { return __builtin_bit_cast(float, ((unsigned)b) << 16); }
__device__ __forceinline__ float bflo(unsigned u) { return __builtin_bit_cast(float, u << 16); }
__device__ __forceinline__ float bfhi(unsigned u) { return __builtin_bit_cast(float, u & 0xffff0000u); }
__device__ __forceinline__ float wave_sum(float v) {
#pragma unroll
    for (int o = 1; o < 64; o <<= 1) v += __shfl_xor(v, o);
    return v;
}
__device__ __forceinline__ float sigmoidf_(float x) { return 1.f / (1.f + __expf(-x)); }

namespace pg8 {
#define PG8_LAS __attribute__((address_space(3)))
constexpr int BM = 256, BK = 64, HALF = 128, HTB = HALF * BK * 2, STAGE_BYTES = 8 * HTB, NXCD = 8, WGM = 8;
__host__ __device__ __forceinline__ int lds_byte(int r, int c) { const int st = (r >> 4) * 2 + (c >> 5), rr = r & 15, cc = c & 31, ob = rr * 64 + cc * 2; return st * 1024 + (ob ^ (((ob >> 9) & 1) << 5)); }
__host__ __device__ __forceinline__ void stage_rc(int b, int& R, int& C) { const int st = b / 1024, sb = b % 1024, swz = sb ^ (((sb >> 9) & 1) << 5); R = (st >> 1) * 16 + swz / 64; C = (st & 1) * 32 + (swz % 64) / 2; }

struct Unit { int pm, pn, e; };
struct Gemm { const bf16* A; const bf16* Bt; int K, N; const int* rowmap; };

struct StaticOrder {
    int nM, nN, nwg, G, c;
    __device__ void init(int M_, int N_, int G_, int c_) { nM = M_ / BM; nN = N_ / BM; nwg = nM * nN; G = G_; c = c_; }
    __device__ bool next(int i, Unit& u) const {
        const long L = (long)i * G + c; if (L >= nwg) return false;
        int wgid = (int)L; { const int q = nwg / NXCD, r = nwg % NXCD, xcd = wgid % NXCD, off = wgid / NXCD; wgid = (xcd < r ? xcd * (q + 1) : r * (q + 1) + (xcd - r) * q) + off; }
        const int nig = WGM * nN, gid = wgid / nig, fm = gid * WGM, gsz = (nM - fm) < WGM ? (nM - fm) : WGM;
        u.pm = fm + ((wgid % nig) % gsz); u.pn = (wgid % nig) / gsz; u.e = 0; return true;
    }
};
struct MoeOrder {
    int nMt, nN, G, c; const int* tile_e;
    __device__ bool next(int i, Unit& u) const {
        const long L = (long)i * G + c; if (L >= (long)nMt * nN) return false;
        u.pm = (int)(L / nN); u.pn = (int)(L % nN); u.e = tile_e[u.pm]; return true;
    }
};

__device__ __forceinline__ unsigned cvt_pk_bf16(float lo, float hi) { unsigned r; asm volatile("v_cvt_pk_bf16_f32 %0, %1, %2" : "=v"(r) : "v"(lo), "v"(hi)); return r; }

struct EpiBf16P {
    bf16* O; int ldc;
    __device__ __forceinline__ void operator()(const f32x4 (&acc)[2][2][4][2], const Unit& u, int wr, int wc, int fr, int fq) const {
        const int row0 = u.pm * BM + wr * 64 + fr, col0 = u.pn * BM + wc * 32 + 8 * fq;
#pragma unroll
        for (int ai = 0; ai < 2; ++ai)
#pragma unroll
            for (int m = 0; m < 4; ++m) { bf16* rowp = O + (size_t)(row0 + ai * HALF + m * 16) * ldc + col0;
#pragma unroll
                for (int bj = 0; bj < 2; ++bj) { const f32x4 v0 = acc[ai][bj][m][0], v1 = acc[ai][bj][m][1];
                    u32x4 w; w.x = cvt_pk_bf16(v0[0], v0[1]); w.y = cvt_pk_bf16(v0[2], v0[3]); w.z = cvt_pk_bf16(v1[0], v1[1]); w.w = cvt_pk_bf16(v1[2], v1[3]);
                    *(u32x4*)(rowp + bj * HALF) = w; } }
    }
};
struct EpiOutProj {
    const float* x; float* out; const float* gate;
    __device__ __forceinline__ void operator()(const f32x4 (&acc)[2][2][4][2], const Unit& u, int wr, int wc, int fr, int fq) const {
        const int row0 = u.pm * BM + wr * 64 + fr, col0 = u.pn * BM + wc * 32 + 4 * fq;
        const int b = (u.pm * BM) / T;
        f32x4 gv[2][2];
#pragma unroll
        for (int bj = 0; bj < 2; ++bj)
#pragma unroll
            for (int n = 0; n < 2; ++n) gv[bj][n] = *(const f32x4*)(gate + (size_t)b * 6144 + col0 + bj * HALF + n * 16);
#pragma unroll
        for (int ai = 0; ai < 2; ++ai)
#pragma unroll
            for (int m = 0; m < 4; ++m) { const size_t ro = (size_t)(row0 + ai * HALF + m * 16) * D + col0;
#pragma unroll
                for (int bj = 0; bj < 2; ++bj)
#pragma unroll
                    for (int n = 0; n < 2; ++n) { const f32x4 xv = *(const f32x4*)(x + ro + bj * HALF + n * 16);
                        *(f32x4*)(out + ro + bj * HALF + n * 16) = xv + gv[bj][n] * acc[ai][bj][m][n]; } }
    }
};
struct EpiMoe1 {
    bf16* act; const float* b1;
    __device__ __forceinline__ void operator()(const f32x4 (&acc)[2][2][4][2], const Unit& u, int wr, int wc, int fr, int fq) const {
        const int row0 = u.pm * BM + wr * 64 + fr, j0 = u.pn * 128 + wc * 16 + 4 * fq;
        const float* bb = b1 + (size_t)u.e * 2048;
        f32x4 bg[2], bl[2];
#pragma unroll
        for (int bj = 0; bj < 2; ++bj) { bg[bj] = *(const f32x4*)(bb + j0 + bj * 64); bl[bj] = *(const f32x4*)(bb + 1024 + j0 + bj * 64); }
#pragma unroll
        for (int ai = 0; ai < 2; ++ai)
#pragma unroll
            for (int m = 0; m < 4; ++m) { bf16* rowp = act + (size_t)(row0 + ai * HALF + m * 16) * DE + j0;
#pragma unroll
                for (int bj = 0; bj < 2; ++bj) { const f32x4 g4 = acc[ai][bj][m][0] + bg[bj], l4 = acc[ai][bj][m][1] + bl[bj]; float a[4];
#pragma unroll
                    for (int q = 0; q < 4; ++q) { const float gl = fminf(g4[q], 7.0f), li = fminf(fmaxf(l4[q], -7.0f), 7.0f);
                        a[q] = gl * (1.f / (1.f + __expf(-1.702f * gl))) * (li + 1.f); }
                    u32x2 w; w.x = cvt_pk_bf16(a[0], a[1]); w.y = cvt_pk_bf16(a[2], a[3]);
                    *(u32x2*)(rowp + bj * 64) = w; } }
    }
};
struct EpiMoe2 {
    bf16* ys; const float* b2; const float* sgate;
    __device__ __forceinline__ void operator()(const f32x4 (&acc)[2][2][4][2], const Unit& u, int wr, int wc, int fr, int fq) const {
        const int row0 = u.pm * BM + wr * 64 + fr, col0 = u.pn * BM + wc * 32 + 8 * fq;
        const float* bb = b2 + (size_t)u.e * 1024;
        f32x4 bv[2][2];
#pragma unroll
        for (int bj = 0; bj < 2; ++bj)
#pragma unroll
            for (int n = 0; n < 2; ++n) bv[bj][n] = *(const f32x4*)(bb + col0 + bj * HALF + 4 * n);
#pragma unroll
        for (int ai = 0; ai < 2; ++ai)
#pragma unroll
            for (int m = 0; m < 4; ++m) { const int row = row0 + ai * HALF + m * 16; const float gt = sgate[row]; bf16* rowp = ys + (size_t)row * D + col0;
#pragma unroll
                for (int bj = 0; bj < 2; ++bj) { const f32x4 v0 = (acc[ai][bj][m][0] + bv[bj][0]) * gt, v1 = (acc[ai][bj][m][1] + bv[bj][1]) * gt;
                    u32x4 w; w.x = cvt_pk_bf16(v0[0], v0[1]); w.y = cvt_pk_bf16(v0[2], v0[3]); w.z = cvt_pk_bf16(v1[0], v1[1]); w.w = cvt_pk_bf16(v1[2], v1[3]);
                    *(u32x4*)(rowp + bj * HALF) = w; } }
    }
};

template <class Epi, class Sched, bool GATHER>
__device__ __forceinline__ void gemm_phase(PG8_LAS unsigned char* lds, const Gemm g, const Sched& S, const Epi& E) {
    const int tid = threadIdx.x, wid = __builtin_amdgcn_readfirstlane(tid >> 6), lane = tid & 63, wr = wid >> 2, wc = wid & 3, fr = lane & 15, fq = lane >> 4;
    const int K = g.K, nt = K / BK;
    int Rr[2], Cc[2]; unsigned voffB[2];
#pragma unroll
    for (int i = 0; i < 2; ++i) { stage_rc(tid * 16 + i * 8192, Rr[i], Cc[i]); voffB[i] = (unsigned)(Rr[i] * K + Cc[i]) * 2u; }
    const size_t kstep = (size_t)(BK * 2);
    const size_t hstep = (size_t)HALF * K * 2;
    const size_t tstep = 2 * hstep;
    const unsigned ldsw = (unsigned)wid * 1024u;
    const int aoff = lds_byte(wr * 64 + fr, fq * 8), boff = lds_byte(wc * 32 + fr, fq * 8);
#define PG8_SA(b, h) (((b) * 2 + (h)) * HTB)
#define PG8_SB(b, h) ((4 + (b) * 2 + (h)) * HTB)
#define PG8_STAGE(bufoff, gbase, voff) do { _Pragma("unroll") for (int _i = 0; _i < 2; ++_i) \
        __builtin_amdgcn_global_load_lds((const unsigned*)((const char*)(gbase) + (voff)[_i]), (PG8_LAS unsigned*)(lds + (bufoff) + ldsw + _i * 8192), 16, 0, 0); } while (0)
#define PG8_LDA(dst, b, h) do { _Pragma("unroll") for (int m = 0; m < 4; ++m) _Pragma("unroll") for (int k = 0; k < 2; ++k) dst[m][k] = *(const PG8_LAS bf16x8*)(lds + PG8_SA(b, h) + aoff + m * 2048 + k * 1024); } while (0)
#define PG8_LDB(dst, b, h) do { _Pragma("unroll") for (int n = 0; n < 2; ++n) _Pragma("unroll") for (int k = 0; k < 2; ++k) dst[n][k] = *(const PG8_LAS bf16x8*)(lds + PG8_SB(b, h) + boff + n * 2048 + k * 1024); } while (0)
#define PG8_MMA(ai, bj, At, Bt) do { __builtin_amdgcn_s_setprio(1); _Pragma("unroll") for (int m = 0; m < 4; ++m) _Pragma("unroll") for (int n = 0; n < 2; ++n) _Pragma("unroll") for (int k = 0; k < 2; ++k) \
        acc[ai][bj][m][n] = __builtin_amdgcn_mfma_f32_16x16x32_bf16(Bt[n][k], At[m][k], acc[ai][bj][m][n], 0, 0, 0); __builtin_amdgcn_s_setprio(0); } while (0)
#define PG8_WAIT_V(n) asm volatile("s_waitcnt vmcnt(" #n ")" ::: "memory")
#define PG8_WAIT_L(n) asm volatile("s_waitcnt lgkmcnt(" #n ")" ::: "memory")
#define PG8_BAR __builtin_amdgcn_s_barrier()
#define PG8_SCHED __builtin_amdgcn_sched_barrier(0)
#define PG8_AOFFS(dst, u) do { _Pragma("unroll") for (int _h = 0; _h < 2; ++_h) _Pragma("unroll") for (int _i = 0; _i < 2; ++_i) { \
        if constexpr (GATHER) { const int _tok = g.rowmap[(u).pm * BM + _h * HALF + Rr[_i]]; dst[_h][_i] = (unsigned)(_tok * K + Cc[_i]) * 2u; } \
        else dst[_h][_i] = (unsigned)((_h * HALF + Rr[_i]) * K + Cc[_i]) * 2u; } } while (0)
#define PG8_ABASE(u) (GATHER ? (const char*)g.A : (const char*)g.A + (size_t)(u).pm * tstep)
#define PG8_BBASE(u) ((const char*)g.Bt + ((size_t)(u).e * g.N + (size_t)(u).pn * BM) * K * 2)
    Unit cur, nxt, nn; int ui = 0;
    if (!S.next(0, cur)) return;
    bool has_next = S.next(1, nxt);
    unsigned curA[2][2], nxtA[2][2];
    PG8_AOFFS(curA, cur);
    if (has_next) PG8_AOFFS(nxtA, nxt); else {
#pragma unroll
        for (int h = 0; h < 2; ++h)
#pragma unroll
            for (int i = 0; i < 2; ++i) nxtA[h][i] = curA[h][i]; }
    f32x4 acc[2][2][4][2];
#pragma unroll
    for (int a = 0; a < 2; ++a)
#pragma unroll
        for (int b = 0; b < 2; ++b)
#pragma unroll
            for (int m = 0; m < 4; ++m)
#pragma unroll
                for (int n = 0; n < 2; ++n) acc[a][b][m][n] = (f32x4){0.f, 0.f, 0.f, 0.f};
    bf16x8 At[4][2], B0[2][2], B1[2][2];
    const char* cA = PG8_ABASE(cur); const char* cB = PG8_BBASE(cur);
    PG8_STAGE(PG8_SB(0, 0), cB, voffB); PG8_STAGE(PG8_SB(0, 1), cB + hstep, voffB); PG8_STAGE(PG8_SA(0, 0), cA, curA[0]); PG8_STAGE(PG8_SA(0, 1), cA, curA[1]);
    if (wr == 1) PG8_BAR;
    PG8_WAIT_V(2); PG8_BAR;
    PG8_STAGE(PG8_SB(1, 0), cB + kstep, voffB); PG8_STAGE(PG8_SA(1, 0), cA + kstep, curA[0]); PG8_STAGE(PG8_SB(1, 1), cB + hstep + kstep, voffB);
    PG8_WAIT_V(6); PG8_BAR;
    for (;;) {
        const char* nA = has_next ? PG8_ABASE(nxt) : cA; const char* nB = has_next ? PG8_BBASE(nxt) : cB;
        for (int t = 0; t < nt; t += 2) {
            const bool last = (t == nt - 2);
            const char* a1 = cA + (size_t)(t + 1) * kstep;
            const char* a2 = last ? nA : cA + (size_t)(t + 2) * kstep; const char* b2 = last ? nB : cB + (size_t)(t + 2) * kstep;
            const char* a3 = a2 + kstep; const char* b3 = b2 + kstep;
            unsigned o2[2][2];
#pragma unroll
            for (int h = 0; h < 2; ++h)
#pragma unroll
                for (int i = 0; i < 2; ++i) o2[h][i] = last ? nxtA[h][i] : curA[h][i];
            PG8_LDB(B0, 0, 0); PG8_LDB(B1, 0, 1); PG8_SCHED; PG8_LDA(At, 0, 0); PG8_STAGE(PG8_SA(1, 1), a1, curA[1]);
            PG8_WAIT_V(8); PG8_WAIT_L(0); PG8_BAR; PG8_MMA(0, 0, At, B0); PG8_MMA(0, 1, At, B1); PG8_BAR; PG8_SCHED;
            PG8_LDA(At, 0, 1); PG8_STAGE(PG8_SB(0, 0), b2, voffB); PG8_STAGE(PG8_SB(0, 1), b2 + hstep, voffB); PG8_STAGE(PG8_SA(0, 0), a2, o2[0]);
            PG8_WAIT_V(8); PG8_WAIT_L(0); PG8_BAR; PG8_MMA(1, 0, At, B0); PG8_MMA(1, 1, At, B1); PG8_BAR; PG8_SCHED;
            PG8_LDB(B0, 1, 0); PG8_LDB(B1, 1, 1); PG8_SCHED; PG8_LDA(At, 1, 0); PG8_STAGE(PG8_SA(0, 1), a2, o2[1]);
            PG8_WAIT_V(8); PG8_WAIT_L(0); PG8_BAR; PG8_MMA(0, 0, At, B0); PG8_MMA(0, 1, At, B1); PG8_BAR; PG8_SCHED;
            PG8_LDA(At, 1, 1); PG8_STAGE(PG8_SB(1, 0), b3, voffB); PG8_STAGE(PG8_SB(1, 1), b3 + hstep, voffB); PG8_STAGE(PG8_SA(1, 0), a3, o2[0]);
            PG8_WAIT_V(8); PG8_WAIT_L(0); PG8_BAR; PG8_MMA(1, 0, At, B0); PG8_MMA(1, 1, At, B1); PG8_BAR; PG8_SCHED;
        }
        if (wr == 0) PG8_BAR;
        const bool has_nn = has_next && S.next(ui + 2, nn);
        unsigned nnA[2][2];
        if (has_nn) PG8_AOFFS(nnA, nn);
        E(acc, cur, wr, wc, fr, fq);
        if (!has_next) break;
#pragma unroll
        for (int a = 0; a < 2; ++a)
#pragma unroll
            for (int b = 0; b < 2; ++b)
#pragma unroll
                for (int m = 0; m < 4; ++m)
#pragma unroll
                    for (int n = 0; n < 2; ++n) acc[a][b][m][n] = (f32x4){0.f, 0.f, 0.f, 0.f};
        cur = nxt; cA = nA; cB = nB; ++ui;
#pragma unroll
        for (int h = 0; h < 2; ++h)
#pragma unroll
            for (int i = 0; i < 2; ++i) { curA[h][i] = nxtA[h][i]; if (has_nn) nxtA[h][i] = nnA[h][i]; }
        nxt = nn; has_next = has_nn;
        if (wr == 1) PG8_BAR;
    }
    PG8_WAIT_V(0);
    PG8_BAR;
#undef PG8_SA
#undef PG8_SB
#undef PG8_STAGE
#undef PG8_LDA
#undef PG8_LDB
#undef PG8_MMA
#undef PG8_WAIT_V
#undef PG8_WAIT_L
#undef PG8_BAR
#undef PG8_SCHED
#undef PG8_AOFFS
#undef PG8_ABASE
#undef PG8_BBASE
}
}

struct Frame {
    LAS unsigned char* lds;
    int tid, lane, wave, vcu, G;
    const float* in[28];
    float* out;
    unsigned char* ws;
};
template <class Tp> __device__ __forceinline__ Tp* wsp(const Frame& F, size_t off) { return (Tp*)(F.ws + off); }

__device__ __forceinline__ int dest_row(int mode, int s) {
    if (mode == 0) return s;
    if (mode == 1) return (s & ~31) | (((s >> 2) & 1) << 4) | (((s >> 3) & 3) << 2) | (s & 3);
    const int half = s >> 10, j = s & 1023;
    return ((j >> 7) << 8) | (((j >> 6) & 1) << 7) | (((j >> 4) & 3) << 5) | (half << 4) | (j & 15);
}
__device__ __forceinline__ void transpose_item(const float* W, int K, int N, bf16* WT, int mode, LAS float* scr, int item, int lane) {
    const int nblk = N / 32, kb = item / nblk, nb = item % nblk, k0 = 64 * kb, n0 = 32 * nb;
#pragma unroll 8
    for (int i = 0; i < 32; ++i) { const int kk = 2 * i + (lane >> 5); scr[kk * 33 + (lane & 31)] = W[(size_t)(k0 + kk) * N + n0 + (lane & 31)]; }
    asm volatile("s_waitcnt lgkmcnt(0)" ::: "memory");
    const int c = lane & 7;
#pragma unroll
    for (int j = 0; j < 4; ++j) { const int n = (lane >> 3) + 8 * j; const LAS float* s = scr + (8 * c) * 33 + n;
        u32x4 o; o.x = pk2(s[0 * 33], s[1 * 33]); o.y = pk2(s[2 * 33], s[3 * 33]); o.z = pk2(s[4 * 33], s[5 * 33]); o.w = pk2(s[6 * 33], s[7 * 33]);
        *(u32x4*)(WT + (size_t)dest_row(mode, n0 + n) * K + k0 + 8 * c) = o; }
    asm volatile("s_waitcnt lgkmcnt(0)" ::: "memory");
}
__device__ __forceinline__ void phase0(const Frame& F) {
    if (F.vcu < 192) {
        LAS float* sl = (LAS float*)F.lds;
        LAS float* red = (LAS float*)(F.lds + 32768);
        const float* c = F.in[1];
        for (int idx = F.tid; idx < 8192; idx += 512) { const int b = idx & 7, k = idx >> 3; const float cv = c[b * 1024 + k]; sl[idx] = cv / (1.f + __expf(-cv)); }
        __syncthreads();
        const int cl = F.tid & 31, ks = F.tid >> 5, col = F.vcu * 32 + cl;
        const float* wa = F.in[2];
        float acc[8];
#pragma unroll
        for (int b = 0; b < 8; ++b) acc[b] = 0.f;
#pragma unroll 4
        for (int kk = 0; kk < 64; ++kk) { const int k = ks * 64 + kk; const float w = wa[(size_t)k * 6144 + col];
            const f32x4 s0 = *(const LAS f32x4*)(sl + k * 8), s1 = *(const LAS f32x4*)(sl + k * 8 + 4);
            acc[0] += s0[0] * w; acc[1] += s0[1] * w; acc[2] += s0[2] * w; acc[3] += s0[3] * w;
            acc[4] += s1[0] * w; acc[5] += s1[1] * w; acc[6] += s1[2] * w; acc[7] += s1[3] * w; }
#pragma unroll
        for (int b = 0; b < 8; ++b) red[(ks * 32 + cl) * 8 + b] = acc[b];
        __syncthreads();
        if (F.tid < 256) { const int b = F.tid >> 5; float s = F.in[3][col];
            for (int q = 0; q < 16; ++q) s += red[(q * 32 + cl) * 8 + b];
            wsp<float>(F, WS_MOD)[b * 6144 + col] = s; }
    }
    LAS float* scr = (LAS float*)(F.lds + 49152 + F.wave * 8704);
    const int gw = F.vcu * 8 + F.wave, NGW = F.G * 8;
    constexpr int I_IN = 16 * 80, I_OUT = 16 * 32;
    constexpr int NITEMS = I_IN + I_OUT;
    for (int it = gw; it < NITEMS; it += NGW) {
        int r = it;
        if (r < I_IN) { transpose_item(F.in[5], 1024, 2560, wsp<bf16>(F, WS_WIN), 1, scr, r, F.lane); continue; } r -= I_IN;
        transpose_item(F.in[20], 1024, 1024, wsp<bf16>(F, WS_WOUT), 0, scr, r, F.lane);
    }
}
constexpr int MOE_I1 = 16 * 64, MOE_I2 = 16 * 32, MOE_ITEMS = NE * (MOE_I1 + MOE_I2);
__device__ __forceinline__ void moe_weight_item(const Frame& F, LAS float* scr, int it) {
    if (it < NE * MOE_I1) { const int e = it / MOE_I1; transpose_item(F.in[24] + (size_t)e * 1024 * 2048, 1024, 2048, wsp<bf16>(F, WS_W1) + (size_t)e * 2048 * 1024, 2, scr, it % MOE_I1, F.lane); }
    else { const int r = it - NE * MOE_I1, e = r / MOE_I2; transpose_item(F.in[26] + (size_t)e * 1024 * 1024, 1024, 1024, wsp<bf16>(F, WS_W2) + (size_t)e * 1024 * 1024, 1, scr, r % MOE_I2, F.lane); }
}

__device__ __forceinline__ void norm_row(const Frame& F, const float* xrow, const float* g, const float* shift, const float* scale, bf16* orow, f32x4 (&h)[4]) {
    const f32x4* xr = (const f32x4*)xrow + F.lane;
    float ss = 0.f;
#pragma unroll
    for (int j = 0; j < 4; ++j) { h[j] = xr[64 * j]; ss += (h[j][0] * h[j][0] + h[j][1] * h[j][1]) + (h[j][2] * h[j][2] + h[j][3] * h[j][3]); }
    const float rstd = rsqrtf(wave_sum(ss) * (1.f / D) + NORM_EPS);
    u32x2* o8 = (u32x2*)orow + F.lane;
#pragma unroll
    for (int j = 0; j < 4; ++j) { const int col = 4 * F.lane + 256 * j;
        const f32x4 gv = *(const f32x4*)(g + col), sh = *(const f32x4*)(shift + col), sc = *(const f32x4*)(scale + col);
        h[j] = h[j] * rstd * gv * (sc + 1.f) + sh;
        u32x2 w; w.x = pk2(h[j][0], h[j][1]); w.y = pk2(h[j][2], h[j][3]); o8[64 * j] = w; }
}
__device__ __forceinline__ void phase1(const Frame& F) {
    const int gw = F.vcu * 8 + F.wave, NGW = F.G * 8;
    const float* mod = wsp<float>(F, WS_MOD);
    for (int row = gw; row < M; row += NGW) { const int b = row / T; f32x4 h[4];
        norm_row(F, F.in[0] + (size_t)row * D, F.in[4], mod + b * 6144, mod + b * 6144 + 1024, wsp<bf16>(F, WS_H) + (size_t)row * D, h); }
}

__device__ __forceinline__ float lerp_col(const bf16* P, int row, int t, int col, const float* mu) {
    const float cur = bf2f(P[(size_t)row * IN_COLS + col]);
    const float prev = t > 0 ? bf2f(P[(size_t)(row - 1) * IN_COLS + col]) : 0.f;
    return cur + (prev - cur) * mu[col];
}
__device__ __forceinline__ void phase3(const Frame& F) {
    const bf16* P = wsp<bf16>(F, WS_P);
    const float* mu = F.in[6]; const float* w0 = F.in[7]; const float* w_up = F.in[8]; const float* a0 = F.in[9]; const float* a_up = F.in[10]; const float* g_up = F.in[11];
    const float* k_k = F.in[12]; const float* k_a = F.in[13]; const float* r_k = F.in[14];
    LAS float* la = (LAS float*)F.lds;
    const int c = F.tid, hh = c >> 6, n = c & 63;
    float* SCN = wsp<float>(F, WS_SCN); float* SV = wsp<float>(F, WS_SV); bf16* G = wsp<bf16>(F, WS_G); float* BON = wsp<float>(F, WS_BONUS);
    for (int tile = F.vcu; tile < M / 16; tile += F.G) {
        const int r0 = tile * 16;
        __syncthreads();
        for (int idx = F.tid; idx < 16 * 256; idx += 512) { const int i = idx >> 8, cc = idx & 255, row = r0 + i, t = row % T;
            const float xv = lerp_col(P, row, t, 1536 + cc, mu);
            la[idx] = cc < 64 ? tanhf(xv) : (cc < 128 ? xv : sigmoidf_(xv)); }
        __syncthreads();
        float accw[16], acca[16], accg[16];
#pragma unroll
        for (int i = 0; i < 16; ++i) { accw[i] = 0.f; acca[i] = 0.f; accg[i] = 0.f; }
        for (int k4 = 0; k4 < 16; ++k4) {
            float wv[4], av[4];
#pragma unroll
            for (int q = 0; q < 4; ++q) { wv[q] = w_up[(4 * k4 + q) * 512 + c]; av[q] = a_up[(4 * k4 + q) * 512 + c]; }
#pragma unroll
            for (int i = 0; i < 16; ++i) { const f32x4 x1 = *(const LAS f32x4*)(la + i * 256 + 4 * k4), x2 = *(const LAS f32x4*)(la + i * 256 + 64 + 4 * k4);
                accw[i] += x1[0] * wv[0] + x1[1] * wv[1] + x1[2] * wv[2] + x1[3] * wv[3];
                acca[i] += x2[0] * av[0] + x2[1] * av[1] + x2[2] * av[2] + x2[3] * av[3]; }
        }
        for (int k4 = 0; k4 < 32; ++k4) {
            float gv[4];
#pragma unroll
            for (int q = 0; q < 4; ++q) gv[q] = g_up[(4 * k4 + q) * 512 + c];
#pragma unroll
            for (int i = 0; i < 16; ++i) { const f32x4 x3 = *(const LAS f32x4*)(la + i * 256 + 128 + 4 * k4);
                accg[i] += x3[0] * gv[0] + x3[1] * gv[1] + x3[2] * gv[2] + x3[3] * gv[3]; }
        }
        const float w0c = w0[c], a0c = a0[c], kkc = k_k[c], kac = k_a[c], rkc = r_k[c];
#pragma unroll
        for (int i = 0; i < 16; ++i) { const int row = r0 + i, t = row % T, b = row / T;
            const float r = lerp_col(P, row, t, c, mu), kr = lerp_col(P, row, t, 512 + c, mu), v = lerp_col(P, row, t, 1024 + c, mu);
            const float decay = __expf(-0.60653066f * sigmoidf_(w0c + accw[i]));
            const float a = sigmoidf_(a0c + acca[i]);
            const float kk = kr * kkc;
            const float ssq = wave_sum(kk * kk);
            const float kkn = kk / fmaxf(sqrtf(ssq), 1e-12f);
            const float k = kr * (1.f + (a - 1.f) * kac);
            const float bon = wave_sum(r * k * rkc);
            const size_t so = ((size_t)(b * RH + hh) * T + t) * 64 + n;
            float* sc = SCN + so * 5 - (size_t)n * 4;
            sc[0] = decay; sc[64] = kkn; sc[128] = kkn * a; sc[192] = k; sc[256] = r; SV[so] = v;
            G[(size_t)row * 512 + c] = (bf16)f2bf(accg[i]);
            if (n == 0) BON[row * 8 + hh] = bon; }
    }
}

constexpr int SC_STEPS = 16, SC_NSLOT = 6, SC_SHARED = SC_STEPS * 1280, SC_SLOT = SC_SHARED + SC_STEPS * 64, SC_RING = SC_NSLOT * SC_SLOT;
constexpr int SC_FLAGS = SC_RING, SC_CONV = SC_RING + 256, SC_NCH = T / SC_STEPS;
static_assert(SC_CONV + 3 * 8704 <= LDS_BYTES, "scan LDS map");
template <int CTRL> __device__ __forceinline__ float dpp_mov(float v) { return __builtin_bit_cast(float, __builtin_amdgcn_update_dpp(0, __builtin_bit_cast(int, v), CTRL, 0xf, 0xf, false)); }
__device__ __forceinline__ float reduce16(float v) { v += dpp_mov<0xB1>(v); v += dpp_mov<0x4E>(v); v += dpp_mov<0x141>(v); v += dpp_mov<0x140>(v); return v; }
#define SC_SPIN_CAP (1 << 24)
__device__ __forceinline__ void phase4_scan(const Frame& F) {
    volatile LAS unsigned* READY = (volatile LAS unsigned*)(F.lds + SC_FLAGS);
    volatile LAS unsigned* DONE = (volatile LAS unsigned*)(F.lds + SC_FLAGS + 64);
    __syncthreads();
    if (F.tid < 64) ((LAS unsigned*)(F.lds + SC_FLAGS))[F.tid] = 0u;
    __syncthreads();
    const int bh = F.vcu >> 2, rg = F.vcu & 3, b = bh / RH, hh = bh % RH;
    if (F.wave < 4) {
        const int rl = F.lane >> 4, ks = F.lane & 15, rowl = F.wave * 4 + rl;
        float* yp = wsp<float>(F, WS_Y) + (size_t)b * T * 512 + hh * 64 + rg * 16 + rowl;
        f32x4 S = (f32x4){0.f, 0.f, 0.f, 0.f};
        int slot = 0;
        for (int c = 0; c < SC_NCH; ++c) {
            { int sp = 0; while (READY[slot] < (unsigned)(c + 1)) { if (++sp > SC_SPIN_CAP) break; } }
            __builtin_amdgcn_fence(__ATOMIC_ACQUIRE, "workgroup");
            const LAS unsigned char* sb = F.lds + slot * SC_SLOT;
            const LAS unsigned char* op = sb + ks * 16; const LAS float* vp = (const LAS float*)(sb + SC_SHARED) + rowl;
            f32x4 w4 = *(const LAS f32x4*)(op), kk4 = *(const LAS f32x4*)(op + 256), b4 = *(const LAS f32x4*)(op + 512), k4 = *(const LAS f32x4*)(op + 768), r4 = *(const LAS f32x4*)(op + 1024);
            float v = vp[0];
#pragma unroll
            for (int s = 0; s < SC_STEPS; ++s) {
                const f32x4 cw = w4, ckk = kk4, cb = b4, ck = k4, cr = r4; const float cv = v;
                if (s + 1 < SC_STEPS) { const LAS unsigned char* o2 = op + (s + 1) * 1280;
                    w4 = *(const LAS f32x4*)(o2); kk4 = *(const LAS f32x4*)(o2 + 256); b4 = *(const LAS f32x4*)(o2 + 512); k4 = *(const LAS f32x4*)(o2 + 768); r4 = *(const LAS f32x4*)(o2 + 1024);
                    v = vp[(s + 1) * 16]; }
                if (s == SC_STEPS - 1) { asm volatile("s_waitcnt lgkmcnt(0)" ::: "memory"); if (F.lane == 0) DONE[F.wave] = (unsigned)(c + 1); }
                float p = (S[0] * ckk[0] + S[1] * ckk[1]) + (S[2] * ckk[2] + S[3] * ckk[3]);
                p = reduce16(p);
                const f32x4 tt = S * cw + ck * cv;
                S = tt - cb * p;
                float q = (S[0] * cr[0] + S[1] * cr[1]) + (S[2] * cr[2] + S[3] * cr[3]);
                q = reduce16(q);
                if (ks == 0) yp[(size_t)(c * SC_STEPS + s) * 512] = q;
            }
            slot = (slot + 1 == SC_NSLOT) ? 0 : slot + 1;
        }
    } else if (F.wave == 4) {
        const unsigned char* gs = (const unsigned char*)(wsp<float>(F, WS_SCN) + (size_t)bh * T * 320) + F.lane * 16;
        const unsigned char* gv = (const unsigned char*)(wsp<float>(F, WS_SV) + (size_t)bh * T * 64 + (F.lane >> 2) * 64 + rg * 16 + (F.lane & 3) * 4);
        int slot = 0;
        for (int c = 0; c < SC_NCH; ++c) {
            if (c >= SC_NSLOT) { const unsigned need = (unsigned)(c - SC_NSLOT + 1); int sp = 0;
                while (DONE[0] < need || DONE[1] < need || DONE[2] < need || DONE[3] < need) { __builtin_amdgcn_s_sleep(1); if (++sp > SC_SPIN_CAP) break; }
                __builtin_amdgcn_fence(__ATOMIC_ACQUIRE, "workgroup"); }
            LAS unsigned char* dst = F.lds + slot * SC_SLOT;
            const unsigned char* src = gs + (size_t)c * SC_SHARED;
#pragma unroll
            for (int j = 0; j < SC_SHARED / 1024; ++j) __builtin_amdgcn_global_load_lds((const unsigned*)(src + j * 1024), (LAS unsigned*)(dst + j * 1024), 16, 0, 0);
            __builtin_amdgcn_global_load_lds((const unsigned*)(gv + (size_t)c * SC_STEPS * 256), (LAS unsigned*)(dst + SC_SHARED), 16, 0, 0);
            if (c >= 2) { asm volatile("s_waitcnt vmcnt(42)" ::: "memory"); const int ps = (slot >= 2) ? slot - 2 : slot + SC_NSLOT - 2; if (F.lane == 0) READY[ps] = (unsigned)(c - 1); }
            slot = (slot + 1 == SC_NSLOT) ? 0 : slot + 1;
        }
        { asm volatile("s_waitcnt vmcnt(21)" ::: "memory"); const int ps = (slot >= 2) ? slot - 2 : slot + SC_NSLOT - 2; if (F.lane == 0) READY[ps] = (unsigned)(SC_NCH - 1); }
        { asm volatile("s_waitcnt vmcnt(0)" ::: "memory"); const int ps = (slot >= 1) ? slot - 1 : SC_NSLOT - 1; if (F.lane == 0) READY[ps] = (unsigned)(SC_NCH); }
    } else {
        LAS float* scr = (LAS float*)(F.lds + SC_CONV + (F.wave - 5) * 8704);
        for (int it = F.vcu * 3 + (F.wave - 5); it < MOE_ITEMS; it += F.G * 3) moe_weight_item(F, scr, it);
    }
    __syncthreads();
}

constexpr int KLD = 72;
constexpr int VLD = 260;
__device__ __forceinline__ void phase5_attn(const Frame& F) {
    const bf16* P = wsp<bf16>(F, WS_P);
    bf16* CAT = wsp<bf16>(F, WS_CAT);
    const float* qg = F.in[17]; const float* kg = F.in[18]; const float* sinks = F.in[19];
    LAS bf16* Kl = (LAS bf16*)F.lds;
    LAS bf16* Vt = (LAS bf16*)(F.lds + 256 * KLD * 2);
    const int lane = F.lane, r = lane & 31, h = lane >> 5;
    for (int unit = F.vcu; unit < NBATCH * KVH * (T / 128); unit += F.G) {
        const int blk = unit % (T / 128), kvh = (unit / (T / 128)) % KVH, b = unit / (T / 128 * KVH);
        const int kpos0 = blk * 128 - 128;
        __syncthreads();
        for (int ch = F.tid; ch < 2048; ch += 512) { const int key = ch >> 3, dc = ch & 7, kpos = kpos0 + key;
            u32x4 kraw = (u32x4){0u, 0u, 0u, 0u}, vraw = (u32x4){0u, 0u, 0u, 0u};
            if (kpos >= 0) { const size_t ro = (size_t)(b * T + kpos) * IN_COLS; kraw = *(const u32x4*)(P + ro + COL_K + kvh * 64 + dc * 8); vraw = *(const u32x4*)(P + ro + COL_V + kvh * 64 + dc * 8); }
            float kf[8]; kf[0] = bflo(kraw.x); kf[1] = bfhi(kraw.x); kf[2] = bflo(kraw.y); kf[3] = bfhi(kraw.y); kf[4] = bflo(kraw.z); kf[5] = bfhi(kraw.z); kf[6] = bflo(kraw.w); kf[7] = bfhi(kraw.w);
            float ss = 0.f;
#pragma unroll
            for (int j = 0; j < 8; ++j) ss += kf[j] * kf[j];
            ss += __shfl_xor(ss, 1); ss += __shfl_xor(ss, 2); ss += __shfl_xor(ss, 4);
            const float rstd = rsqrtf(ss * (1.f / 64.f) + NORM_EPS);
            const f32x4 g0 = *(const f32x4*)(kg + dc * 8), g1 = *(const f32x4*)(kg + dc * 8 + 4);
            u32x4 ko; ko.x = pk2(kf[0] * rstd * g0[0], kf[1] * rstd * g0[1]); ko.y = pk2(kf[2] * rstd * g0[2], kf[3] * rstd * g0[3]);
            ko.z = pk2(kf[4] * rstd * g1[0], kf[5] * rstd * g1[1]); ko.w = pk2(kf[6] * rstd * g1[2], kf[7] * rstd * g1[3]);
            *(LAS u32x4*)(Kl + key * KLD + dc * 8) = ko;
            const unsigned vv[4] = {vraw.x, vraw.y, vraw.z, vraw.w};
#pragma unroll
            for (int j = 0; j < 4; ++j) { Vt[(dc * 8 + 2 * j) * VLD + key] = (bf16)(vv[j] & 0xffffu); Vt[(dc * 8 + 2 * j + 1) * VLD + key] = (bf16)(vv[j] >> 16); }
        }
        __syncthreads();
        for (int task = F.wave; task < 16; task += 8) {
            const int g = task & 3, qs = task >> 2, head = kvh * 4 + g;
            const int qrow = b * T + blk * 128 + qs * 32 + r;
            float qf[4][8]; float ss = 0.f;
#pragma unroll
            for (int s = 0; s < 4; ++s) { const u32x4 qr = *(const u32x4*)(P + (size_t)qrow * IN_COLS + COL_Q + head * 64 + 16 * s + 8 * h);
                qf[s][0] = bflo(qr.x); qf[s][1] = bfhi(qr.x); qf[s][2] = bflo(qr.y); qf[s][3] = bfhi(qr.y); qf[s][4] = bflo(qr.z); qf[s][5] = bfhi(qr.z); qf[s][6] = bflo(qr.w); qf[s][7] = bfhi(qr.w);
#pragma unroll
                for (int j = 0; j < 8; ++j) ss += qf[s][j] * qf[s][j]; }
            ss += __shfl_xor(ss, 32);
            const float qscale = rsqrtf(ss * (1.f / 64.f) + NORM_EPS) * 0.125f;
            bf16x8 qb[4];
#pragma unroll
            for (int s = 0; s < 4; ++s) { u32x4 w;
                const f32x4 g0 = *(const f32x4*)(qg + 16 * s + 8 * h), g1 = *(const f32x4*)(qg + 16 * s + 8 * h + 4);
                w.x = pk2(qf[s][0] * qscale * g0[0], qf[s][1] * qscale * g0[1]); w.y = pk2(qf[s][2] * qscale * g0[2], qf[s][3] * qscale * g0[3]);
                w.z = pk2(qf[s][4] * qscale * g1[0], qf[s][5] * qscale * g1[1]); w.w = pk2(qf[s][6] * qscale * g1[2], qf[s][7] * qscale * g1[3]);
                qb[s] = __builtin_bit_cast(bf16x8, w); }
            f32x16 st[5];
#pragma unroll
            for (int kt = 0; kt < 5; ++kt) {
#pragma unroll
                for (int i = 0; i < 16; ++i) st[kt][i] = 0.f;
#pragma unroll
                for (int s = 0; s < 4; ++s) { const bf16x8 ka = *(const LAS bf16x8*)(Kl + (32 * (qs + kt) + r) * KLD + 16 * s + 8 * h);
                    st[kt] = __builtin_amdgcn_mfma_f32_32x32x16_bf16(ka, qb[s], st[kt], 0, 0, 0); }
            }
            const int iq = 32 * qs + r;
            const float sink = sinks[head];
            float mx = sink;
#pragma unroll
            for (int kt = 0; kt < 5; ++kt)
#pragma unroll
                for (int i = 0; i < 16; ++i) { const int jw = 32 * (qs + kt) + (i & 3) + 8 * (i >> 2) + 4 * h;
                    const bool ok = (jw >= iq + 1) && (jw <= iq + 128) && (kpos0 + jw >= 0);
                    st[kt][i] = ok ? st[kt][i] : -INFINITY; mx = fmaxf(mx, st[kt][i]); }
            mx = fmaxf(mx, __shfl_xor(mx, 32));
            float lsum = 0.f;
#pragma unroll
            for (int kt = 0; kt < 5; ++kt)
#pragma unroll
                for (int i = 0; i < 16; ++i) { const float p = __expf(st[kt][i] - mx); st[kt][i] = p; lsum += p; }
            lsum += __shfl_xor(lsum, 32);
            const float linv = 1.f / (lsum + __expf(sink - mx));
            f32x16 o[2];
#pragma unroll
            for (int dt = 0; dt < 2; ++dt)
#pragma unroll
                for (int i = 0; i < 16; ++i) o[dt][i] = 0.f;
#pragma unroll
            for (int kt = 0; kt < 5; ++kt)
#pragma unroll
                for (int sp = 0; sp < 2; ++sp) { u32x4 pw;
                    pw.x = pk2(st[kt][8 * sp + 0] * linv, st[kt][8 * sp + 1] * linv); pw.y = pk2(st[kt][8 * sp + 2] * linv, st[kt][8 * sp + 3] * linv);
                    pw.z = pk2(st[kt][8 * sp + 4] * linv, st[kt][8 * sp + 5] * linv); pw.w = pk2(st[kt][8 * sp + 6] * linv, st[kt][8 * sp + 7] * linv);
                    const bf16x8 pa = __builtin_bit_cast(bf16x8, pw);
                    const int kb = 32 * (qs + kt) + 16 * sp + 4 * h;
#pragma unroll
                    for (int dt = 0; dt < 2; ++dt) { const LAS bf16* vp = Vt + (32 * dt + r) * VLD + kb;
                        const u32x2 lo = *(const LAS u32x2*)vp, hi = *(const LAS u32x2*)(vp + 8);
                        u32x4 vw; vw.x = lo.x; vw.y = lo.y; vw.z = hi.x; vw.w = hi.y;
                        o[dt] = __builtin_amdgcn_mfma_f32_32x32x16_bf16(pa, __builtin_bit_cast(bf16x8, vw), o[dt], 0, 0, 0); } }
#pragma unroll
            for (int dt = 0; dt < 2; ++dt)
#pragma unroll
                for (int i = 0; i < 16; ++i) { const int qr = (i & 3) + 8 * (i >> 2) + 4 * h;
                    CAT[(size_t)(b * T + blk * 128 + qs * 32 + qr) * D + 512 + head * 64 + 32 * dt + r] = (bf16)f2bf(o[dt][i]); }
        }
    }
}

__device__ __forceinline__ void phase6(const Frame& F) {
    const int gw = F.vcu * 8 + F.wave, NGW = F.G * 8;
    const float* Y = wsp<float>(F, WS_Y); const float* SV = wsp<float>(F, WS_SV); const bf16* G = wsp<bf16>(F, WS_G); const float* BON = wsp<float>(F, WS_BONUS);
    bf16* CAT = wsp<bf16>(F, WS_CAT);
    const float* lg = F.in[15]; const float* lb = F.in[16];
    const int hh = F.lane >> 3, n0 = (F.lane & 7) * 8, c0 = F.lane * 8;
    for (int row = gw; row < M; row += NGW) { const int b = row / T, t = row % T;
        const f32x4 y0 = *(const f32x4*)(Y + (size_t)row * 512 + c0), y1 = *(const f32x4*)(Y + (size_t)row * 512 + c0 + 4);
        float yv[8] = {y0[0], y0[1], y0[2], y0[3], y1[0], y1[1], y1[2], y1[3]};
        float s = 0.f;
#pragma unroll
        for (int j = 0; j < 8; ++j) s += yv[j];
        s += __shfl_xor(s, 1); s += __shfl_xor(s, 2); s += __shfl_xor(s, 4);
        const float mean = s * (1.f / 64.f); float q = 0.f;
#pragma unroll
        for (int j = 0; j < 8; ++j) { yv[j] -= mean; q += yv[j] * yv[j]; }
        q += __shfl_xor(q, 1); q += __shfl_xor(q, 2); q += __shfl_xor(q, 4);
        const float rstd = rsqrtf(q * (1.f / 64.f) + GN_EPS);
        const float bon = BON[row * 8 + hh];
        const float* vp = SV + ((size_t)(b * RH + hh) * T + t) * 64 + n0;
        const f32x4 v0 = *(const f32x4*)vp, v1 = *(const f32x4*)(vp + 4);
        const float vv[8] = {v0[0], v0[1], v0[2], v0[3], v1[0], v1[1], v1[2], v1[3]};
        const u32x4 graw = *(const u32x4*)(G + (size_t)row * 512 + c0);
        const float gg[8] = {bflo(graw.x), bfhi(graw.x), bflo(graw.y), bfhi(graw.y), bflo(graw.z), bfhi(graw.z), bflo(graw.w), bfhi(graw.w)};
        float ov[8];
#pragma unroll
        for (int j = 0; j < 8; ++j) ov[j] = (yv[j] * rstd * lg[c0 + j] + lb[c0 + j] + bon * vv[j]) * gg[j];
        u32x4 w; w.x = pk2(ov[0], ov[1]); w.y = pk2(ov[2], ov[3]); w.z = pk2(ov[4], ov[5]); w.w = pk2(ov[6], ov[7]);
        *(u32x4*)(CAT + (size_t)row * D + c0) = w; }
}

__device__ __forceinline__ void phase8(const Frame& F) {
    const float* mod = wsp<float>(F, WS_MOD); const float* x1 = F.out;
    const float* wr_ = F.in[22]; const float* br = F.in[23];
    LAS float* part = (LAS float*)(F.lds + F.wave * 8704);
    LAS float* lg32 = (LAS float*)(F.lds + 8 * 8704 + F.wave * 256);
    LAS int* cnt = (LAS int*)(F.lds + 8 * 8704 + 8 * 256);
    if (F.tid < 32) cnt[F.tid] = 0;
    __syncthreads();
    int* RT_E = wsp<int>(F, WS_RT_E); int* RT_LP = wsp<int>(F, WS_RT_LP); float* RT_G = wsp<float>(F, WS_RT_G);
    for (int i = 0; i < 16; ++i) { const int row = F.vcu * 128 + F.wave * 16 + i, b = row / T;
        f32x4 h[4];
        norm_row(F, x1 + (size_t)row * D, F.in[21], mod + b * 6144 + 3072, mod + b * 6144 + 4096, wsp<bf16>(F, WS_H) + (size_t)row * D, h);
        float pa[32];
#pragma unroll
        for (int e = 0; e < 32; ++e) pa[e] = 0.f;
#pragma unroll
        for (int j = 0; j < 4; ++j)
#pragma unroll
            for (int q = 0; q < 4; ++q) { const int col = 4 * F.lane + 256 * j + q; const float hv = h[j][q];
#pragma unroll
                for (int e4 = 0; e4 < 8; ++e4) { const f32x4 w4 = *(const f32x4*)(wr_ + (size_t)col * 32 + 4 * e4);
                    pa[4 * e4] += hv * w4[0]; pa[4 * e4 + 1] += hv * w4[1]; pa[4 * e4 + 2] += hv * w4[2]; pa[4 * e4 + 3] += hv * w4[3]; } }
#pragma unroll
        for (int e = 0; e < 32; ++e) part[e * 65 + F.lane] = pa[e];
        asm volatile("s_waitcnt lgkmcnt(0)" ::: "memory");
        const int e = F.lane & 31, hf = F.lane >> 5; float s = 0.f;
#pragma unroll 8
        for (int q = 0; q < 32; ++q) s += part[e * 65 + hf * 32 + q];
        s += __shfl_xor(s, 32);
        const float logit = s + br[e];
        if (F.lane < 32) lg32[e] = logit;
        asm volatile("s_waitcnt lgkmcnt(0)" ::: "memory");
        int rank = 0;
#pragma unroll 8
        for (int q = 0; q < 32; ++q) { const float o = lg32[q]; rank += (o > logit || (o == logit && q < e)) ? 1 : 0; }
        if (F.lane < 32 && rank < 4) lg32[32 + rank] = logit;
        asm volatile("s_waitcnt lgkmcnt(0)" ::: "memory");
        const float t0 = lg32[32], t1 = lg32[33], t2 = lg32[34], t3 = lg32[35];
        const float den = 1.f + __expf(t1 - t0) + __expf(t2 - t0) + __expf(t3 - t0);
        if (F.lane < 32 && rank < 4) { const int lp = atomicAdd((int*)&cnt[e], 1);
            RT_E[row * 4 + rank] = e; RT_LP[row * 4 + rank] = lp; RT_G[row * 4 + rank] = __expf(logit - t0) / den; }
        asm volatile("s_waitcnt lgkmcnt(0)" ::: "memory");
    }
    __syncthreads();
    if (F.tid < 32) wsp<int>(F, WS_BLKCNT)[F.vcu * 32 + F.tid] = cnt[F.tid];
}

__device__ __forceinline__ void phase9(const Frame& F) {
    LAS int* base = (LAS int*)F.lds;
    LAS int* tot = base + 32;
    LAS int* pst = base + 64;
    const int* BC = wsp<int>(F, WS_BLKCNT);
    if (F.tid < 32) { int s = 0, mine = 0; for (int bk = 0; bk < F.G; ++bk) { if (bk == F.vcu) mine = s; s += BC[bk * 32 + F.tid]; } base[F.tid] = mine; tot[F.tid] = s; }
    __syncthreads();
    if (F.tid == 0) { int s = 0; for (int e = 0; e < 32; ++e) { pst[e] = s; s += (tot[e] + 255) / 256 * 256; } pst[32] = s; }
    __syncthreads();
    int* SLOT_TOK = wsp<int>(F, WS_SLOTTOK); float* SLOT_GATE = wsp<float>(F, WS_SLOTGATE); int* TOK_SLOT = wsp<int>(F, WS_TOKSLOT);
    const int* RT_E = wsp<int>(F, WS_RT_E); const int* RT_LP = wsp<int>(F, WS_RT_LP); const float* RT_G = wsp<float>(F, WS_RT_G);
    { const int idx = F.vcu * 512 + F.tid;
        const int e = RT_E[idx], slot = pst[e] + base[e] + RT_LP[idx];
        SLOT_TOK[slot] = idx >> 2; SLOT_GATE[slot] = RT_G[idx]; TOK_SLOT[idx] = slot; }
    if (F.vcu < 32) { const int e = F.vcu; for (int s = pst[e] + tot[e] + F.tid; s < pst[e + 1]; s += 512) { SLOT_TOK[s] = 0; SLOT_GATE[s] = 0.f; } }
    if (F.vcu == 0) { unsigned* ctl = wsp<unsigned>(F, WS_CTL);
        if (F.tid == 0) ctl[CW_NTILES] = (unsigned)(pst[32] / 256);
        if (F.tid < 33) ctl[CW_PADSTART + F.tid] = (unsigned)pst[F.tid];
        int* TE = wsp<int>(F, WS_TILEE);
        for (int tl = F.tid; tl < MAX_TILES; tl += 512) { int e = 31; for (int q = 0; q < 32; ++q) if (tl * 256 < pst[q + 1]) { e = q; break; } TE[tl] = e; } }
}

__device__ __forceinline__ void phase12(const Frame& F) {
    const int gw = F.vcu * 8 + F.wave, NGW = F.G * 8;
    const float* mod = wsp<float>(F, WS_MOD); const bf16* YS = wsp<bf16>(F, WS_YS); const int* TOK_SLOT = wsp<int>(F, WS_TOKSLOT);
    for (int row = gw; row < M; row += NGW) { const int b = row / T;
        int sl[4];
#pragma unroll
        for (int k = 0; k < 4; ++k) sl[k] = TOK_SLOT[row * 4 + k];
#pragma unroll
        for (int j = 0; j < 2; ++j) { const int col = 8 * F.lane + 512 * j;
            float a[8];
#pragma unroll
            for (int q = 0; q < 8; ++q) a[q] = 0.f;
#pragma unroll
            for (int k = 0; k < 4; ++k) { const u32x4 v = *(const u32x4*)(YS + (size_t)sl[k] * D + col);
                a[0] += bflo(v.x); a[1] += bfhi(v.x); a[2] += bflo(v.y); a[3] += bfhi(v.y); a[4] += bflo(v.z); a[5] += bfhi(v.z); a[6] += bflo(v.w); a[7] += bfhi(v.w); }
            const float* gp = mod + b * 6144 + 5120 + col;
            const f32x4 g0 = *(const f32x4*)gp, g1 = *(const f32x4*)(gp + 4);
            float* op = F.out + (size_t)row * D + col;
            f32x4 x0 = *(const f32x4*)op, x1v = *(const f32x4*)(op + 4);
            x0[0] += g0[0] * a[0]; x0[1] += g0[1] * a[1]; x0[2] += g0[2] * a[2]; x0[3] += g0[3] * a[3];
            x1v[0] += g1[0] * a[4]; x1v[1] += g1[1] * a[5]; x1v[2] += g1[2] * a[6]; x1v[3] += g1[3] * a[7];
            *(f32x4*)op = x0; *(f32x4*)(op + 4) = x1v; } }
}

__device__ __forceinline__ void copy_x_to_out(const Frame& F) {
    const size_t n4 = (size_t)M * D / 4; const f32x4* s = (const f32x4*)F.in[0]; f32x4* d = (f32x4*)F.out;
    for (size_t i = (size_t)blockIdx.x * 512 + F.tid; i < n4; i += (size_t)gridDim.x * 512) d[i] = s[i];
}

struct Args { const float* in[28]; float* out; unsigned char* ws; int ph_lo, ph_hi; };
constexpr int N_PHASES = 13;

__global__ void __launch_bounds__(512, 2) mk_fwd(Args args) {
    extern __shared__ __attribute__((aligned(16))) unsigned char lds_raw[];
    Frame F;
    F.lds = (LAS unsigned char*)lds_raw;
    F.tid = threadIdx.x; F.lane = F.tid & 63; F.wave = __builtin_amdgcn_readfirstlane(F.tid >> 6);
    F.G = gridDim.x; { const int bx = blockIdx.x; F.vcu = (F.G % 8 == 0) ? (bx % 8) * (F.G / 8) + bx / 8 : bx; }
#pragma unroll
    for (int i = 0; i < 28; ++i) F.in[i] = args.in[i];
    F.out = args.out; F.ws = args.ws;
    cg::grid_group grid = cg::this_grid();
    const int lo = args.ph_lo, hi = args.ph_hi;
#define IN(k) (lo <= (k) && (k) < hi)
#define SEAM(k) do { if (IN(k) && IN((k) + 1)) grid.sync(); } while (0)

    if (IN(0)) { phase0(F); } SEAM(0);
    if (IN(1)) { phase1(F); } SEAM(1);
    if (IN(2)) {
        pg8::Gemm g{wsp<bf16>(F, WS_H), wsp<bf16>(F, WS_WIN), D, IN_COLS, nullptr};
        pg8::StaticOrder S; S.init(M, IN_COLS, F.G, (int)blockIdx.x);
        pg8::EpiBf16P E{wsp<bf16>(F, WS_P), IN_COLS};
        pg8::gemm_phase<pg8::EpiBf16P, pg8::StaticOrder, false>(F.lds, g, S, E);
    } SEAM(2);
    if (IN(3)) { phase3(F); } SEAM(3);
    if (IN(4)) { phase4_scan(F); } SEAM(4);
    if (IN(5)) { phase5_attn(F); } SEAM(5);
    if (IN(6)) { phase6(F); } SEAM(6);
    if (IN(7)) {
#if MK_LAST_PHASE >= 7
        pg8::Gemm g{wsp<bf16>(F, WS_CAT), wsp<bf16>(F, WS_WOUT), D, D, nullptr};
        pg8::StaticOrder S; S.init(M, D, F.G, (int)blockIdx.x);
        pg8::EpiOutProj E{F.in[0], F.out, wsp<float>(F, WS_MOD) + 2048};
        pg8::gemm_phase<pg8::EpiOutProj, pg8::StaticOrder, false>(F.lds, g, S, E);
#else
        copy_x_to_out(F);
#endif
    } SEAM(7);
    if (IN(8)) { phase8(F); } SEAM(8);
    if (IN(9)) { phase9(F); } SEAM(9);
    if (IN(10)) {
        const unsigned* ctl = wsp<unsigned>(F, WS_CTL);
        pg8::Gemm g{wsp<bf16>(F, WS_H), wsp<bf16>(F, WS_W1), D, 2 * DE, wsp<int>(F, WS_SLOTTOK)};
        pg8::MoeOrder S{(int)ctl[CW_NTILES], 8, F.G, F.vcu, wsp<int>(F, WS_TILEE)};
        pg8::EpiMoe1 E{wsp<bf16>(F, WS_ACT), F.in[25]};
        pg8::gemm_phase<pg8::EpiMoe1, pg8::MoeOrder, true>(F.lds, g, S, E);
    } SEAM(10);
    if (IN(11)) {
        const unsigned* ctl = wsp<unsigned>(F, WS_CTL);
        pg8::Gemm g{wsp<bf16>(F, WS_ACT), wsp<bf16>(F, WS_W2), DE, D, nullptr};
        pg8::MoeOrder S{(int)ctl[CW_NTILES], 4, F.G, F.vcu, wsp<int>(F, WS_TILEE)};
        pg8::EpiMoe2 E{wsp<bf16>(F, WS_YS), F.in[27], wsp<float>(F, WS_SLOTGATE)};
        pg8::gemm_phase<pg8::EpiMoe2, pg8::MoeOrder, false>(F.lds, g, S, E);
    } SEAM(11);
    if (IN(12)) { phase12(F); }
#undef IN
#undef SEAM
}

extern "C" void kernel_launch(void* const* d_in, const int* in_sizes, int n_in, void* d_out, int out_size, void* d_ws, size_t ws_size, hipStream_t stream) {
    static int grid = 0;
    if (grid == 0) {
        if (n_in != 28 || out_size != M * D || ws_size < WS_END) { fprintf(stderr, "kernel_launch: unexpected sizes (n_in %d out %d ws %zu, need %zu)\n", n_in, out_size, ws_size, (size_t)WS_END); grid = -1; return; }
        int dev = 0, cus = 0, per_cu = 0;
        (void)hipGetDevice(&dev); (void)hipDeviceGetAttribute(&cus, hipDeviceAttributeMultiprocessorCount, dev);
        (void)hipFuncSetAttribute((const void*)mk_fwd, hipFuncAttributeMaxDynamicSharedMemorySize, LDS_BYTES);
        (void)hipOccupancyMaxActiveBlocksPerMultiprocessor(&per_cu, (const void*)mk_fwd, 512, LDS_BYTES);
        if (per_cu < 1 || cus != 256) { fprintf(stderr, "kernel_launch: occupancy %d, CUs %d: this build needs 256 CUs x 1 block\n", per_cu, cus); grid = -1; return; }
        grid = cus;
    }
    if (grid < 0) return;
    (void)hipMemsetAsync((char*)d_ws + WS_CTL, 0, CTL_BYTES, stream);
    Args a{};
    for (int i = 0; i < 28; ++i) a.in[i] = (const float*)d_in[i];
    a.out = (float*)d_out; a.ws = (unsigned char*)d_ws;
    const int last = MK_LAST_PHASE + 1;
#if MK_ONE_LAUNCH
    a.ph_lo = 0; a.ph_hi = last;
    void* kargs[] = {&a};
    hipError_t e = hipLaunchCooperativeKernel((const void*)mk_fwd, dim3(grid), dim3(512), kargs, LDS_BYTES, stream);
    if (e != hipSuccess) fprintf(stderr, "cooperative launch failed: %s\n", hipGetErrorString(e));
#else
    for (int p = 0; p < last; ++p) { a.ph_lo = p; a.ph_hi = p + 1; hipLaunchKernelGGL(mk_fwd, dim3(grid), dim3(512), LDS_BYTES, stream, a); }
#endif
}
```

```cpp
#include <hip/hip_runtime.h>
#include <hip/hip_cooperative_groups.h>
#include <cstdio>
#include <cstdint>
namespace cg = cooperative_groups;

#ifndef MK_ONE_LAUNCH
#define MK_ONE_LAUNCH 1
#endif
#ifndef MK_REPEAT_MASK
#define MK_REPEAT_MASK 0
#endif
#ifndef MK_CONV_IN_SCAN
#define MK_CONV_IN_SCAN 1
#endif
#ifndef MK_LAST_PHASE
#define MK_LAST_PHASE 12
#endif

constexpr int D = 1024, NBATCH = 8, T = 4096, M = NBATCH * T;
constexpr int HD = 64, RW = 512, RH = 8, AW = 512, QH = 8, KVH = 2, WIN = 128;
constexpr int RWKV_COLS = 1792, IN_COLS = 2560;
constexpr int COL_Q = 1792, COL_K = 1792 + 512, COL_V = 1792 + 512 + 128;
constexpr int NE = 32, TOPK = 4, DE = 1024;
constexpr int MAX_TILES = 544;
constexpr int MAX_SLOTS = MAX_TILES * 256;
constexpr float NORM_EPS = 1e-6f, GN_EPS = 64e-5f;

#define GAS __attribute__((address_space(1)))
#define LAS __attribute__((address_space(3)))
typedef unsigned short bf16;
typedef short bf16x8 __attribute__((ext_vector_type(8)));
typedef float f32x4 __attribute__((ext_vector_type(4)));
typedef float f32x2 __attribute__((ext_vector_type(2)));
typedef float f32x16 __attribute__((ext_vector_type(16)));
typedef unsigned u32x4 __attribute__((ext_vector_type(4)));
typedef unsigned u32x2 __attribute__((ext_vector_type(2)));

constexpr size_t MiB = 1u << 20;
constexpr size_t WS_CTL = 0, CTL_BYTES = 64 * 1024;
constexpr size_t WS_MOD = 1 * MiB;
constexpr size_t WS_BON = 1 * MiB + 256 * 1024;
constexpr size_t WS_RT_E = 2 * MiB;
constexpr size_t WS_RT_LP = 2 * MiB + 512 * 1024;
constexpr size_t WS_RT_G = 3 * MiB;
constexpr size_t WS_TOKSLOT = 3 * MiB + 512 * 1024;
constexpr size_t WS_SLOTTOK = 4 * MiB;
constexpr size_t WS_SLOTGATE = 5 * MiB;
constexpr size_t WS_BLKCNT = 6 * MiB;
constexpr size_t WS_TILEE = 6 * MiB + 64 * 1024;
constexpr size_t WS_BONUS = 7 * MiB;
constexpr size_t WS_LW = 9 * MiB;
constexpr size_t WS_WIN = 10 * MiB;
constexpr size_t WS_WOUT = 16 * MiB;
constexpr size_t WS_W1 = 20 * MiB;
constexpr size_t WS_W2 = 148 * MiB;
constexpr size_t WS_H = 212 * MiB;
constexpr size_t WS_R2 = 276 * MiB;
constexpr size_t WS_P = WS_R2;
constexpr size_t WS_SCN = WS_R2 + 160 * MiB;
constexpr size_t WS_SV = WS_SCN + 320 * MiB;
constexpr size_t WS_G = WS_SV + 64 * MiB;
constexpr size_t WS_Y = WS_G + 32 * MiB;
constexpr size_t WS_CAT = WS_Y + 64 * MiB;
constexpr size_t WS_ACT = WS_R2;
constexpr size_t WS_YS = WS_R2 + 272 * MiB;
constexpr size_t WS_END = WS_CAT + 64 * MiB;
static_assert(WS_END <= 1024 * MiB, "workspace map");
static_assert(WS_YS + 272 * MiB <= WS_CAT, "YS must not overlay CAT");
constexpr int CW_NTILES = 16;
constexpr int CW_PADSTART = 64;

constexpr int LDS_BYTES = 156 * 1024;

__device__ __forceinline__ unsigned f2bf(float f) { unsigned u = __builtin_bit_cast(unsigned, f); return (u + 0x7fffu + ((u >> 16) & 1u)) >> 16; }
__device__ __forceinline__ unsigned pk2(float lo, float hi) { return f2bf(lo) | (f2bf(hi) << 16); }
__device__ __forceinline__ float bf2f(unsigned short b) { return __builtin_bit_cast(float, ((unsigned)b) << 16); }
__device__ __forceinline__ float bflo(unsigned u) { return __builtin_bit_cast(float, u << 16); }
__device__ __forceinline__ float bfhi(unsigned u) { return __builtin_bit_cast(float, u & 0xffff0000u); }
__device__ __forceinline__ float wave_sum(float v) {
#pragma unroll
    for (int o = 1; o < 64; o <<= 1) v += __shfl_xor(v, o);
    return v;
}
__device__ __forceinline__ float sigmoidf_(float x) { return 1.f / (1.f + __expf(-x)); }

namespace pg8 {
#define PG8_LAS __attribute__((address_space(3)))
constexpr int BM = 256, BK = 64, HALF = 128, HTB = HALF * BK * 2, STAGE_BYTES = 8 * HTB, NXCD = 8, WGM = 8;
__host__ __device__ __forceinline__ int lds_byte(int r, int c) { const int st = (r >> 4) * 2 + (c >> 5), rr = r & 15, cc = c & 31, ob = rr * 64 + cc * 2; return st * 1024 + (ob ^ (((ob >> 9) & 1) << 5)); }
__host__ __device__ __forceinline__ void stage_rc(int b, int& R, int& C) { const int st = b / 1024, sb = b % 1024, swz = sb ^ (((sb >> 9) & 1) << 5); R = (st >> 1) * 16 + swz / 64; C = (st & 1) * 32 + (swz % 64) / 2; }

struct Unit { int pm, pn, e; };
struct Gemm { const bf16* A; const bf16* Bt; int K, N; const int* rowmap; };

struct StaticOrder {
    int nM, nN, nwg, G, c;
    __device__ void init(int M_, int N_, int G_, int c_) { nM = M_ / BM; nN = N_ / BM; nwg = nM * nN; G = G_; c = c_; }
    __device__ bool next(int i, Unit& u) const {
        const long L = (long)i * G + c; if (L >= nwg) return false;
        int wgid = (int)L; { const int q = nwg / NXCD, r = nwg % NXCD, xcd = wgid % NXCD, off = wgid / NXCD; wgid = (xcd < r ? xcd * (q + 1) : r * (q + 1) + (xcd - r) * q) + off; }
        const int nig = WGM * nN, gid = wgid / nig, fm = gid * WGM, gsz = (nM - fm) < WGM ? (nM - fm) : WGM;
        u.pm = fm + ((wgid % nig) % gsz); u.pn = (wgid % nig) / gsz; u.e = 0; return true;
    }
};
struct MoeOrder {
    int nMt, nN, G, c; const int* tile_e;
    __device__ bool next(int i, Unit& u) const {
        const long L = (long)i * G + c; if (L >= (long)nMt * nN) return false;
        u.pm = (int)(L / nN); u.pn = (int)(L % nN); u.e = tile_e[u.pm]; return true;
    }
};

__device__ __forceinline__ unsigned cvt_pk_bf16(float lo, float hi) { unsigned r; asm volatile("v_cvt_pk_bf16_f32 %0, %1, %2" : "=v"(r) : "v"(lo), "v"(hi)); return r; }

struct EpiBf16P {
    bf16* O; int ldc;
    __device__ __forceinline__ void operator()(const f32x4 (&acc)[2][2][4][2], const Unit& u, int wr, int wc, int fr, int fq) const {
        const int row0 = u.pm * BM + wr * 64 + fr, col0 = u.pn * BM + wc * 32 + 8 * fq;
#pragma unroll
        for (int ai = 0; ai < 2; ++ai)
#pragma unroll
            for (int m = 0; m < 4; ++m) { bf16* rowp = O + (size_t)(row0 + ai * HALF + m * 16) * ldc + col0;
#pragma unroll
                for (int bj = 0; bj < 2; ++bj) { const f32x4 v0 = acc[ai][bj][m][0], v1 = acc[ai][bj][m][1];
                    u32x4 w; w.x = cvt_pk_bf16(v0[0], v0[1]); w.y = cvt_pk_bf16(v0[2], v0[3]); w.z = cvt_pk_bf16(v1[0], v1[1]); w.w = cvt_pk_bf16(v1[2], v1[3]);
                    *(u32x4*)(rowp + bj * HALF) = w; } }
    }
};
struct EpiOutProj {
    const float* x; float* out; const float* gate;
    __device__ __forceinline__ void operator()(const f32x4 (&acc)[2][2][4][2], const Unit& u, int wr, int wc, int fr, int fq) const {
        const int row0 = u.pm * BM + wr * 64 + fr, col0 = u.pn * BM + wc * 32 + 4 * fq;
        const int b = (u.pm * BM) / T;
        f32x4 gv[2][2];
#pragma unroll
        for (int bj = 0; bj < 2; ++bj)
#pragma unroll
            for (int n = 0; n < 2; ++n) gv[bj][n] = *(const f32x4*)(gate + (size_t)b * 6144 + col0 + bj * HALF + n * 16);
#pragma unroll
        for (int ai = 0; ai < 2; ++ai)
#pragma unroll
            for (int m = 0; m < 4; ++m) { const size_t ro = (size_t)(row0 + ai * HALF + m * 16) * D + col0;
#pragma unroll
                for (int bj = 0; bj < 2; ++bj)
#pragma unroll
                    for (int n = 0; n < 2; ++n) { const f32x4 xv = *(const f32x4*)(x + ro + bj * HALF + n * 16);
                        *(f32x4*)(out + ro + bj * HALF + n * 16) = xv + gv[bj][n] * acc[ai][bj][m][n]; } }
    }
};
struct EpiMoe1 {
    bf16* act; const float* b1;
    __device__ __forceinline__ void operator()(const f32x4 (&acc)[2][2][4][2], const Unit& u, int wr, int wc, int fr, int fq) const {
        const int row0 = u.pm * BM + wr * 64 + fr, j0 = u.pn * 128 + wc * 16 + 4 * fq;
        const float* bb = b1 + (size_t)u.e * 2048;
        f32x4 bg[2], bl[2];
#pragma unroll
        for (int bj = 0; bj < 2; ++bj) { bg[bj] = *(const f32x4*)(bb + j0 + bj * 64); bl[bj] = *(const f32x4*)(bb + 1024 + j0 + bj * 64); }
#pragma unroll
        for (int ai = 0; ai < 2; ++ai)
#pragma unroll
            for (int m = 0; m < 4; ++m) { bf16* rowp = act + (size_t)(row0 + ai * HALF + m * 16) * DE + j0;
#pragma unroll
                for (int bj = 0; bj < 2; ++bj) { const f32x4 g4 = acc[ai][bj][m][0] + bg[bj], l4 = acc[ai][bj][m][1] + bl[bj]; float a[4];
#pragma unroll
                    for (int q = 0; q < 4; ++q) { const float gl = fminf(g4[q], 7.0f), li = fminf(fmaxf(l4[q], -7.0f), 7.0f);
                        a[q] = gl * (1.f / (1.f + __expf(-1.702f * gl))) * (li + 1.f); }
                    u32x2 w; w.x = cvt_pk_bf16(a[0], a[1]); w.y = cvt_pk_bf16(a[2], a[3]);
                    *(u32x2*)(rowp + bj * 64) = w; } }
    }
};
struct EpiMoe2 {
    bf16* ys; const float* b2; const float* sgate;
    __device__ __forceinline__ void operator()(const f32x4 (&acc)[2][2][4][2], const Unit& u, int wr, int wc, int fr, int fq) const {
        const int row0 = u.pm * BM + wr * 64 + fr, col0 = u.pn * BM + wc * 32 + 8 * fq;
        const float* bb = b2 + (size_t)u.e * 1024;
        f32x4 bv[2][2];
#pragma unroll
        for (int bj = 0; bj < 2; ++bj)
#pragma unroll
            for (int n = 0; n < 2; ++n) bv[bj][n] = *(const f32x4*)(bb + col0 + bj * HALF + 4 * n);
#pragma unroll
        for (int ai = 0; ai < 2; ++ai)
#pragma unroll
            for (int m = 0; m < 4; ++m) { const int row = row0 + ai * HALF + m * 16; const float gt = sgate[row]; bf16* rowp = ys + (size_t)row * D + col0;
#pragma unroll
                for (int bj = 0; bj < 2; ++bj) { const f32x4 v0 = (acc[ai][bj][m][0] + bv[bj][0]) * gt, v1 = (acc[ai][bj][m][1] + bv[bj][1]) * gt;
                    u32x4 w; w.x = cvt_pk_bf16(v0[0], v0[1]); w.y = cvt_pk_bf16(v0[2], v0[3]); w.z = cvt_pk_bf16(v1[0], v1[1]); w.w = cvt_pk_bf16(v1[2], v1[3]);
                    *(u32x4*)(rowp + bj * HALF) = w; } }
    }
};

template <class Epi, class Sched, bool GATHER>
__device__ __forceinline__ void gemm_phase(PG8_LAS unsigned char* lds, const Gemm g, const Sched& S, const Epi& E) {
    const int tid = threadIdx.x, wid = __builtin_amdgcn_readfirstlane(tid >> 6), lane = tid & 63, wr = wid >> 2, wc = wid & 3, fr = lane & 15, fq = lane >> 4;
    const int K = g.K, nt = K / BK;
    int Rr[2], Cc[2]; unsigned voffB[2];
#pragma unroll
    for (int i = 0; i < 2; ++i) { stage_rc(tid * 16 + i * 8192, Rr[i], Cc[i]); voffB[i] = (unsigned)(Rr[i] * K + Cc[i]) * 2u; }
    const size_t kstep = (size_t)(BK * 2);
    const size_t hstep = (size_t)HALF * K * 2;
    const size_t tstep = 2 * hstep;
    const unsigned ldsw = (unsigned)wid * 1024u;
    const int aoff = lds_byte(wr * 64 + fr, fq * 8), boff = lds_byte(wc * 32 + fr, fq * 8);
#define PG8_SA(b, h) (((b) * 2 + (h)) * HTB)
#define PG8_SB(b, h) ((4 + (b) * 2 + (h)) * HTB)
#define PG8_STAGE(bufoff, gbase, voff) do { _Pragma("unroll") for (int _i = 0; _i < 2; ++_i) \
        __builtin_amdgcn_global_load_lds((const unsigned*)((const char*)(gbase) + (voff)[_i]), (PG8_LAS unsigned*)(lds + (bufoff) + ldsw + _i * 8192), 16, 0, 0); } while (0)
#define PG8_LDA(dst, b, h) do { _Pragma("unroll") for (int m = 0; m < 4; ++m) _Pragma("unroll") for (int k = 0; k < 2; ++k) dst[m][k] = *(const PG8_LAS bf16x8*)(lds + PG8_SA(b, h) + aoff + m * 2048 + k * 1024); } while (0)
#define PG8_LDB(dst, b, h) do { _Pragma("unroll") for (int n = 0; n < 2; ++n) _Pragma("unroll") for (int k = 0; k < 2; ++k) dst[n][k] = *(const PG8_LAS bf16x8*)(lds + PG8_SB(b, h) + boff + n * 2048 + k * 1024); } while (0)
#define PG8_MMA(ai, bj, At, Bt) do { __builtin_amdgcn_s_setprio(1); _Pragma("unroll") for (int m = 0; m < 4; ++m) _Pragma("unroll") for (int n = 0; n < 2; ++n) _Pragma("unroll") for (int k = 0; k < 2; ++k) \
        acc[ai][bj][m][n] = __builtin_amdgcn_mfma_f32_16x16x32_bf16(Bt[n][k], At[m][k], acc[ai][bj][m][n], 0, 0, 0); __builtin_amdgcn_s_setprio(0); } while (0)
#define PG8_WAIT_V(n) asm volatile("s_waitcnt vmcnt(" #n ")" ::: "memory")
#define PG8_WAIT_L(n) asm volatile("s_waitcnt lgkmcnt(" #n ")" ::: "memory")
#define PG8_BAR __builtin_amdgcn_s_barrier()
#define PG8_SCHED __builtin_amdgcn_sched_barrier(0)
#define PG8_AOFFS(dst, u) do { _Pragma("unroll") for (int _h = 0; _h < 2; ++_h) _Pragma("unroll") for (int _i = 0; _i < 2; ++_i) { \
        if constexpr (GATHER) { const int _tok = g.rowmap[(u).pm * BM + _h * HALF + Rr[_i]]; dst[_h][_i] = (unsigned)(_tok * K + Cc[_i]) * 2u; } \
        else dst[_h][_i] = (unsigned)((_h * HALF + Rr[_i]) * K + Cc[_i]) * 2u; } } while (0)
#define PG8_ABASE(u) (GATHER ? (const char*)g.A : (const char*)g.A + (size_t)(u).pm * tstep)
#define PG8_BBASE(u) ((const char*)g.Bt + ((size_t)(u).e * g.N + (size_t)(u).pn * BM) * K * 2)
    Unit cur, nxt, nn; int ui = 0;
    if (!S.next(0, cur)) return;
    bool has_next = S.next(1, nxt);
    unsigned curA[2][2], nxtA[2][2];
    PG8_AOFFS(curA, cur);
    if (has_next) PG8_AOFFS(nxtA, nxt); else {
#pragma unroll
        for (int h = 0; h < 2; ++h)
#pragma unroll
            for (int i = 0; i < 2; ++i) nxtA[h][i] = curA[h][i]; }
    f32x4 acc[2][2][4][2];
#pragma unroll
    for (int a = 0; a < 2; ++a)
#pragma unroll
        for (int b = 0; b < 2; ++b)
#pragma unroll
            for (int m = 0; m < 4; ++m)
#pragma unroll
                for (int n = 0; n < 2; ++n) acc[a][b][m][n] = (f32x4){0.f, 0.f, 0.f, 0.f};
    bf16x8 At[4][2], B0[2][2], B1[2][2];
    const char* cA = PG8_ABASE(cur); const char* cB = PG8_BBASE(cur);
    PG8_STAGE(PG8_SB(0, 0), cB, voffB); PG8_STAGE(PG8_SB(0, 1), cB + hstep, voffB); PG8_STAGE(PG8_SA(0, 0), cA, curA[0]); PG8_STAGE(PG8_SA(0, 1), cA, curA[1]);
    if (wr == 1) PG8_BAR;
    PG8_WAIT_V(2); PG8_BAR;
    PG8_STAGE(PG8_SB(1, 0), cB + kstep, voffB); PG8_STAGE(PG8_SA(1, 0), cA + kstep, curA[0]); PG8_STAGE(PG8_SB(1, 1), cB + hstep + kstep, voffB);
    PG8_WAIT_V(6); PG8_BAR;
    for (;;) {
        const char* nA = has_next ? PG8_ABASE(nxt) : cA; const char* nB = has_next ? PG8_BBASE(nxt) : cB;
        for (int t = 0; t < nt; t += 2) {
            const bool last = (t == nt - 2);
            const char* a1 = cA + (size_t)(t + 1) * kstep;
            const char* a2 = last ? nA : cA + (size_t)(t + 2) * kstep; const char* b2 = last ? nB : cB + (size_t)(t + 2) * kstep;
            const char* a3 = a2 + kstep; const char* b3 = b2 + kstep;
            unsigned o2[2][2];
#pragma unroll
            for (int h = 0; h < 2; ++h)
#pragma unroll
                for (int i = 0; i < 2; ++i) o2[h][i] = last ? nxtA[h][i] : curA[h][i];
            PG8_LDB(B0, 0, 0); PG8_LDB(B1, 0, 1); PG8_SCHED; PG8_LDA(At, 0, 0); PG8_STAGE(PG8_SA(1, 1), a1, curA[1]);
            PG8_WAIT_V(8); PG8_WAIT_L(0); PG8_BAR; PG8_MMA(0, 0, At, B0); PG8_MMA(0, 1, At, B1); PG8_BAR; PG8_SCHED;
            PG8_LDA(At, 0, 1); PG8_STAGE(PG8_SB(0, 0), b2, voffB); PG8_STAGE(PG8_SB(0, 1), b2 + hstep, voffB); PG8_STAGE(PG8_SA(0, 0), a2, o2[0]);
            PG8_WAIT_V(8); PG8_WAIT_L(0); PG8_BAR; PG8_MMA(1, 0, At, B0); PG8_MMA(1, 1, At, B1); PG8_BAR; PG8_SCHED;
            PG8_LDB(B0, 1, 0); PG8_LDB(B1, 1, 1); PG8_SCHED; PG8_LDA(At, 1, 0); PG8_STAGE(PG8_SA(0, 1), a2, o2[1]);
            PG8_WAIT_V(8); PG8_WAIT_L(0); PG8_BAR; PG8_MMA(0, 0, At, B0); PG8_MMA(0, 1, At, B1); PG8_BAR; PG8_SCHED;
            PG8_LDA(At, 1, 1); PG8_STAGE(PG8_SB(1, 0), b3, voffB); PG8_STAGE(PG8_SB(1, 1), b3 + hstep, voffB); PG8_STAGE(PG8_SA(1, 0), a3, o2[0]);
            PG8_WAIT_V(8); PG8_WAIT_L(0); PG8_BAR; PG8_MMA(1, 0, At, B0); PG8_MMA(1, 1, At, B1); PG8_BAR; PG8_SCHED;
        }
        if (wr == 0) PG8_BAR;
        const bool has_nn = has_next && S.next(ui + 2, nn);
        unsigned nnA[2][2];
        if (has_nn) PG8_AOFFS(nnA, nn);
        E(acc, cur, wr, wc, fr, fq);
        if (!has_next) break;
#pragma unroll
        for (int a = 0; a < 2; ++a)
#pragma unroll
            for (int b = 0; b < 2; ++b)
#pragma unroll
                for (int m = 0; m < 4; ++m)
#pragma unroll
                    for (int n = 0; n < 2; ++n) acc[a][b][m][n] = (f32x4){0.f, 0.f, 0.f, 0.f};
        cur = nxt; cA = nA; cB = nB; ++ui;
#pragma unroll
        for (int h = 0; h < 2; ++h)
#pragma unroll
            for (int i = 0; i < 2; ++i) { curA[h][i] = nxtA[h][i]; if (has_nn) nxtA[h][i] = nnA[h][i]; }
        nxt = nn; has_next = has_nn;
        if (wr == 1) PG8_BAR;
    }
    PG8_WAIT_V(0);
    PG8_BAR;
#undef PG8_SA
#undef PG8_SB
#undef PG8_STAGE
#undef PG8_LDA
#undef PG8_LDB
#undef PG8_MMA
#undef PG8_WAIT_V
#undef PG8_WAIT_L
#undef PG8_BAR
#undef PG8_SCHED
#undef PG8_AOFFS
#undef PG8_ABASE
#undef PG8_BBASE
}
}

struct Frame {
    LAS unsigned char* lds;
    int tid, lane, wave, vcu, G;
    const float* in[28];
    float* out;
    unsigned char* ws;
};
template <class Tp> __device__ __forceinline__ Tp* wsp(const Frame& F, size_t off) { return (Tp*)(F.ws + off); }

__device__ __forceinline__ int dest_row(int mode, int s) {
    if (mode == 0) return s;
    if (mode == 1) return (s & ~31) | (((s >> 2) & 1) << 4) | (((s >> 3) & 3) << 2) | (s & 3);
    const int half = s >> 10, j = s & 1023;
    return ((j >> 7) << 8) | (((j >> 6) & 1) << 7) | (((j >> 4) & 3) << 5) | (half << 4) | (j & 15);
}
__device__ __forceinline__ void transpose_item(const float* W, int K, int N, bf16* WT, int mode, int item, int lane) {
    const int nblk = N / 64, kb = item / nblk, nb = item % nblk, k0 = 64 * kb, n0 = 64 * nb;
    const float* src = W + (size_t)k0 * N + n0 + lane;
    float v[64];
#pragma unroll
    for (int i = 0; i < 64; ++i) v[i] = src[(size_t)i * N];
    bf16* dst = WT + (size_t)dest_row(mode, n0 + lane) * K + k0;
#pragma unroll
    for (int j = 0; j < 8; ++j) { u32x4 o; o.x = pk2(v[8 * j], v[8 * j + 1]); o.y = pk2(v[8 * j + 2], v[8 * j + 3]); o.z = pk2(v[8 * j + 4], v[8 * j + 5]); o.w = pk2(v[8 * j + 6], v[8 * j + 7]);
        *(u32x4*)(dst + 8 * j) = o; }
}
constexpr int MOE_I1 = 16 * 32, MOE_I2 = 16 * 16, MOE_ITEMS = NE * (MOE_I1 + MOE_I2);
__device__ __forceinline__ void moe_weight_item(const Frame& F, int it) {
    if (it < NE * MOE_I1) { const int e = it / MOE_I1; transpose_item(F.in[24] + (size_t)e * 1024 * 2048, 1024, 2048, wsp<bf16>(F, WS_W1) + (size_t)e * 2048 * 1024, 2, it % MOE_I1, F.lane); }
    else { const int r = it - NE * MOE_I1, e = r / MOE_I2; transpose_item(F.in[26] + (size_t)e * 1024 * 1024, 1024, 1024, wsp<bf16>(F, WS_W2) + (size_t)e * 1024 * 1024, 1, r % MOE_I2, F.lane); }
}

__device__ __forceinline__ void phase0(const Frame& F) {
    if (F.vcu < 192) {
        LAS float* sl = (LAS float*)F.lds;
        LAS float* red = (LAS float*)(F.lds + 32768);
        const float* c = F.in[1];
        for (int idx = F.tid; idx < 8192; idx += 512) { const int b = idx & 7, k = idx >> 3; const float cv = c[b * 1024 + k]; sl[idx] = cv / (1.f + __expf(-cv)); }
        __syncthreads();
        const int cl = F.tid & 31, ks = F.tid >> 5, col = F.vcu * 32 + cl;
        const float* wa = F.in[2];
        float acc[8];
#pragma unroll
        for (int b = 0; b < 8; ++b) acc[b] = 0.f;
#pragma unroll 4
        for (int kk = 0; kk < 64; ++kk) { const int k = ks * 64 + kk; const float w = wa[(size_t)k * 6144 + col];
            const f32x4 s0 = *(const LAS f32x4*)(sl + k * 8), s1 = *(const LAS f32x4*)(sl + k * 8 + 4);
            acc[0] += s0[0] * w; acc[1] += s0[1] * w; acc[2] += s0[2] * w; acc[3] += s0[3] * w;
            acc[4] += s1[0] * w; acc[5] += s1[1] * w; acc[6] += s1[2] * w; acc[7] += s1[3] * w; }
#pragma unroll
        for (int b = 0; b < 8; ++b) red[(ks * 32 + cl) * 8 + b] = acc[b];
        __syncthreads();
        if (F.tid < 256) { const int b = F.tid >> 5; float s = F.in[3][col];
            for (int q = 0; q < 16; ++q) s += red[(q * 32 + cl) * 8 + b];
            wsp<float>(F, WS_MOD)[b * 6144 + col] = s; }
    }
    const int gw = F.vcu * 8 + F.wave, NGW = F.G * 8;
    constexpr int I_IN = 16 * 40, I_OUT = 16 * 16;
    constexpr int NITEMS = I_IN + I_OUT;
    for (int it = gw; it < NITEMS; it += NGW) {
        int r = it;
        if (r < I_IN) { transpose_item(F.in[5], 1024, 2560, wsp<bf16>(F, WS_WIN), 1, r, F.lane); continue; } r -= I_IN;
        transpose_item(F.in[20], 1024, 1024, wsp<bf16>(F, WS_WOUT), 0, r, F.lane);
    }
#if !MK_CONV_IN_SCAN
    for (int it = gw; it < MOE_ITEMS; it += NGW) moe_weight_item(F, it);
#endif
    { bf16* LW = wsp<bf16>(F, WS_LW);
        for (int idx = F.vcu * 512 + F.tid; idx < 256 * 512; idx += F.G * 512) { const int k = idx >> 9, c = idx & 511;
            const float v = k < 64 ? F.in[8][k * 512 + c] : (k < 128 ? F.in[10][(k - 64) * 512 + c] : F.in[11][(k - 128) * 512 + c]);
            LW[c * 256 + k] = (bf16)f2bf(v); } }
}
__device__ __forceinline__ void norm_row(const Frame& F, const float* xrow, const float* g, const float* shift, const float* scale, bf16* orow, f32x4 (&h)[4]) {
    const f32x4* xr = (const f32x4*)xrow + F.lane;
    float ss = 0.f;
#pragma unroll
    for (int j = 0; j < 4; ++j) { h[j] = xr[64 * j]; ss += (h[j][0] * h[j][0] + h[j][1] * h[j][1]) + (h[j][2] * h[j][2] + h[j][3] * h[j][3]); }
    const float rstd = rsqrtf(wave_sum(ss) * (1.f / D) + NORM_EPS);
    u32x2* o8 = (u32x2*)orow + F.lane;
#pragma unroll
    for (int j = 0; j < 4; ++j) { const int col = 4 * F.lane + 256 * j;
        const f32x4 gv = *(const f32x4*)(g + col), sh = *(const f32x4*)(shift + col), sc = *(const f32x4*)(scale + col);
        h[j] = h[j] * rstd * gv * (sc + 1.f) + sh;
        u32x2 w; w.x = pk2(h[j][0], h[j][1]); w.y = pk2(h[j][2], h[j][3]); o8[64 * j] = w; }
}
__device__ __forceinline__ void phase1(const Frame& F) {
    const int gw = F.vcu * 8 + F.wave, NGW = F.G * 8;
    const float* mod = wsp<float>(F, WS_MOD);
    for (int row = gw; row < M; row += NGW) { const int b = row / T; f32x4 h[4];
        norm_row(F, F.in[0] + (size_t)row * D, F.in[4], mod + b * 6144, mod + b * 6144 + 1024, wsp<bf16>(F, WS_H) + (size_t)row * D, h); }
}

template <int CTRL> __device__ __forceinline__ float dpp_mov(float v) { return __builtin_bit_cast(float, __builtin_amdgcn_update_dpp(0, __builtin_bit_cast(int, v), CTRL, 0xf, 0xf, false)); }
__device__ __forceinline__ float reduce16(float v) { v += dpp_mov<0xB1>(v); v += dpp_mov<0x4E>(v); v += dpp_mov<0x141>(v); v += dpp_mov<0x140>(v); return v; }
__device__ __forceinline__ void lerp8(const bf16* P, const float* mu, int tok, int t, int col, float (&x)[8]) {
    const u32x4 c = *(const u32x4*)(P + (size_t)tok * IN_COLS + col);
    u32x4 p = (u32x4){0u, 0u, 0u, 0u};
    if (t > 0) p = *(const u32x4*)(P + (size_t)(tok - 1) * IN_COLS + col);
    const f32x4 m0 = *(const f32x4*)(mu + col), m1 = *(const f32x4*)(mu + col + 4);
    const float cf[8] = {bflo(c.x), bfhi(c.x), bflo(c.y), bfhi(c.y), bflo(c.z), bfhi(c.z), bflo(c.w), bfhi(c.w)};
    const float pf[8] = {bflo(p.x), bfhi(p.x), bflo(p.y), bfhi(p.y), bflo(p.z), bfhi(p.z), bflo(p.w), bfhi(p.w)};
    const float mf[8] = {m0[0], m0[1], m0[2], m0[3], m1[0], m1[1], m1[2], m1[3]};
#pragma unroll
    for (int j = 0; j < 8; ++j) x[j] = cf[j] + (pf[j] - cf[j]) * mf[j];
}
__device__ __forceinline__ f32x4 lerp4(const bf16* P, const float* mu, int tok, int t, int col) {
    const u32x2 c = *(const u32x2*)(P + (size_t)tok * IN_COLS + col);
    u32x2 p = (u32x2){0u, 0u};
    if (t > 0) p = *(const u32x2*)(P + (size_t)(tok - 1) * IN_COLS + col);
    const f32x4 m = *(const f32x4*)(mu + col);
    const f32x4 cf = (f32x4){bflo(c.x), bfhi(c.x), bflo(c.y), bfhi(c.y)}, pf = (f32x4){bflo(p.x), bfhi(p.x), bflo(p.y), bfhi(p.y)};
    return cf + (pf - cf) * m;
}
__device__ __forceinline__ bf16x8 pack8(const float (&x)[8]) { u32x4 w; w.x = pk2(x[0], x[1]); w.y = pk2(x[2], x[3]); w.z = pk2(x[4], x[5]); w.w = pk2(x[6], x[7]); return __builtin_bit_cast(bf16x8, w); }
__device__ __forceinline__ void phase3(const Frame& F) {
    const bf16* P = wsp<bf16>(F, WS_P); const bf16* LW = wsp<bf16>(F, WS_LW);
    const float* mu = F.in[6]; const float* w0 = F.in[7]; const float* a0 = F.in[9];
    const float* k_k = F.in[12]; const float* k_a = F.in[13]; const float* r_k = F.in[14];
    float* SCN = wsp<float>(F, WS_SCN); float* SV = wsp<float>(F, WS_SV); bf16* G = wsp<bf16>(F, WS_G); float* BON = wsp<float>(F, WS_BONUS);
    const int gw = F.vcu * 8 + F.wave, NGW = F.G * 8;
    const int cl = F.lane & 15, q = F.lane >> 4;
    for (int tile = gw; tile < M / 16; tile += NGW) {
        bf16x8 Aw[2], Aa[2], Ag[4];
        { const int tok = tile * 16 + cl, t = tok % T; float x[8];
#pragma unroll
            for (int s = 0; s < 2; ++s) { lerp8(P, mu, tok, t, 1536 + 32 * s + 8 * q, x);
#pragma unroll
                for (int j = 0; j < 8; ++j) x[j] = tanhf(x[j]);
                Aw[s] = pack8(x);
                lerp8(P, mu, tok, t, 1600 + 32 * s + 8 * q, x); Aa[s] = pack8(x); }
#pragma unroll
            for (int s = 0; s < 4; ++s) { lerp8(P, mu, tok, t, 1664 + 32 * s + 8 * q, x);
#pragma unroll
                for (int j = 0; j < 8; ++j) x[j] = sigmoidf_(x[j]);
                Ag[s] = pack8(x); } }
        const int tk0 = tile * 16 + 4 * q, b = tk0 / T, t0 = tk0 % T;
#pragma unroll 1
        for (int hh = 0; hh < RH; ++hh) {
            const int c0 = hh * 64 + cl * 4;
            f32x4 accw[4], acca[4], accg[4];
#pragma unroll
            for (int ct = 0; ct < 4; ++ct) { const bf16* lw = LW + (size_t)(c0 + ct) * 256 + 8 * q;
                f32x4 aw = (f32x4){0.f, 0.f, 0.f, 0.f}, aa = aw, ag = aw;
#pragma unroll
                for (int s = 0; s < 2; ++s) { aw = __builtin_amdgcn_mfma_f32_16x16x32_bf16(Aw[s], *(const bf16x8*)(lw + 32 * s), aw, 0, 0, 0);
                    aa = __builtin_amdgcn_mfma_f32_16x16x32_bf16(Aa[s], *(const bf16x8*)(lw + 64 + 32 * s), aa, 0, 0, 0); }
#pragma unroll
                for (int s = 0; s < 4; ++s) ag = __builtin_amdgcn_mfma_f32_16x16x32_bf16(Ag[s], *(const bf16x8*)(lw + 128 + 32 * s), ag, 0, 0, 0);
                accw[ct] = aw; acca[ct] = aa; accg[ct] = ag; }
            const f32x4 w0v = *(const f32x4*)(w0 + c0), a0v = *(const f32x4*)(a0 + c0), kkv = *(const f32x4*)(k_k + c0), kav = *(const f32x4*)(k_a + c0), rkv = *(const f32x4*)(r_k + c0);
#pragma unroll
            for (int i = 0; i < 4; ++i) { const int tk = tk0 + i, t = t0 + i;
                const f32x4 r4 = lerp4(P, mu, tk, t, c0), kr4 = lerp4(P, mu, tk, t, 512 + c0), v4 = lerp4(P, mu, tk, t, 1024 + c0);
                f32x4 dec, av, gv, kk4, k4;
                float ssq = 0.f, bon = 0.f;
#pragma unroll
                for (int ct = 0; ct < 4; ++ct) {
                    dec[ct] = __expf(-0.60653066f * sigmoidf_(w0v[ct] + accw[ct][i]));
                    av[ct] = sigmoidf_(a0v[ct] + acca[ct][i]);
                    gv[ct] = accg[ct][i];
                    kk4[ct] = kr4[ct] * kkv[ct]; ssq += kk4[ct] * kk4[ct];
                    k4[ct] = kr4[ct] * (1.f + (av[ct] - 1.f) * kav[ct]);
                    bon += r4[ct] * k4[ct] * rkv[ct]; }
                ssq = reduce16(ssq); bon = reduce16(bon);
                const float inv = 1.f / fmaxf(sqrtf(ssq), 1e-12f);
                const f32x4 kkn = kk4 * inv, bb = kkn * av;
                const size_t so = ((size_t)(b * RH + hh) * T + t) * 64 + cl * 4;
                float* sc = SCN + ((size_t)(b * RH + hh) * T + t) * 320 + cl * 4;
                *(f32x4*)(sc) = dec; *(f32x4*)(sc + 64) = kkn; *(f32x4*)(sc + 128) = bb; *(f32x4*)(sc + 192) = k4; *(f32x4*)(sc + 256) = r4;
                *(f32x4*)(SV + so) = v4;
                u32x2 gw2; gw2.x = pk2(gv[0], gv[1]); gw2.y = pk2(gv[2], gv[3]);
                *(u32x2*)(G + (size_t)tk * 512 + c0) = gw2;
                if (cl == 0) BON[tk * 8 + hh] = bon; }
        }
    }
}

constexpr int SC_STEPS = 16, SC_NSLOT = 6, SC_SHARED = SC_STEPS * 1280, SC_SLOT = SC_SHARED + SC_STEPS * 64, SC_RING = SC_NSLOT * SC_SLOT;
constexpr int SC_FLAGS = SC_RING, SC_CONV = SC_RING + 256, SC_NCH = T / SC_STEPS;
static_assert(SC_CONV + 3 * 8704 <= LDS_BYTES, "scan LDS map");
#define SC_SPIN_CAP (1 << 24)
__device__ __forceinline__ void phase4_scan(const Frame& F) {
    volatile LAS unsigned* READY = (volatile LAS unsigned*)(F.lds + SC_FLAGS);
    volatile LAS unsigned* DONE = (volatile LAS unsigned*)(F.lds + SC_FLAGS + 64);
    __syncthreads();
    if (F.tid < 64) ((LAS unsigned*)(F.lds + SC_FLAGS))[F.tid] = 0u;
    __syncthreads();
    const int bh = F.vcu >> 2, rg = F.vcu & 3, b = bh / RH, hh = bh % RH;
    if (F.wave < 4) {
        const int rl = F.lane >> 4, ks = F.lane & 15, rowl = F.wave * 4 + rl;
        float* yp = wsp<float>(F, WS_Y) + (size_t)b * T * 512 + hh * 64 + rg * 16 + rowl;
        f32x4 S = (f32x4){0.f, 0.f, 0.f, 0.f};
        int slot = 0;
        for (int c = 0; c < SC_NCH; ++c) {
            { int sp = 0; while (READY[slot] < (unsigned)(c + 1)) { if (++sp > SC_SPIN_CAP) break; } }
            __builtin_amdgcn_fence(__ATOMIC_ACQUIRE, "workgroup");
            const LAS unsigned char* sb = F.lds + slot * SC_SLOT;
            const LAS unsigned char* op = sb + ks * 16; const LAS float* vp = (const LAS float*)(sb + SC_SHARED) + rowl;
            f32x4 w4 = *(const LAS f32x4*)(op), kk4 = *(const LAS f32x4*)(op + 256), b4 = *(const LAS f32x4*)(op + 512), k4 = *(const LAS f32x4*)(op + 768), r4 = *(const LAS f32x4*)(op + 1024);
            float v = vp[0];
            float ykeep = 0.f;
#pragma unroll
            for (int s = 0; s < SC_STEPS; ++s) {
                const f32x4 cw = w4, ckk = kk4, cb = b4, ck = k4, cr = r4; const float cv = v;
                if (s + 1 < SC_STEPS) { const LAS unsigned char* o2 = op + (s + 1) * 1280;
                    w4 = *(const LAS f32x4*)(o2); kk4 = *(const LAS f32x4*)(o2 + 256); b4 = *(const LAS f32x4*)(o2 + 512); k4 = *(const LAS f32x4*)(o2 + 768); r4 = *(const LAS f32x4*)(o2 + 1024);
                    v = vp[(s + 1) * 16]; }
                if (s == SC_STEPS - 1) { asm volatile("s_waitcnt lgkmcnt(0)" ::: "memory"); if (F.lane == 0) DONE[F.wave] = (unsigned)(c + 1); }
                float p = (S[0] * ckk[0] + S[1] * ckk[1]) + (S[2] * ckk[2] + S[3] * ckk[3]);
                p = reduce16(p);
                const f32x4 tt = S * cw + ck * cv;
                S = tt - cb * p;
                float q = (S[0] * cr[0] + S[1] * cr[1]) + (S[2] * cr[2] + S[3] * cr[3]);
                q = reduce16(q);
                ykeep = (ks == s) ? q : ykeep;
            }
            yp[(size_t)(c * SC_STEPS + ks) * 512] = ykeep;
            slot = (slot + 1 == SC_NSLOT) ? 0 : slot + 1;
        }
    } else if (F.wave == 4) {
        const unsigned char* gs = (const unsigned char*)(wsp<float>(F, WS_SCN) + (size_t)bh * T * 320) + F.lane * 16;
        const unsigned char* gv = (const unsigned char*)(wsp<float>(F, WS_SV) + (size_t)bh * T * 64 + (F.lane >> 2) * 64 + rg * 16 + (F.lane & 3) * 4);
        int slot = 0;
        for (int c = 0; c < SC_NCH; ++c) {
            if (c >= SC_NSLOT) { const unsigned need = (unsigned)(c - SC_NSLOT + 1); int sp = 0;
                while (DONE[0] < need || DONE[1] < need || DONE[2] < need || DONE[3] < need) { __builtin_amdgcn_s_sleep(1); if (++sp > SC_SPIN_CAP) break; }
                __builtin_amdgcn_fence(__ATOMIC_ACQUIRE, "workgroup"); }
            LAS unsigned char* dst = F.lds + slot * SC_SLOT;
            const unsigned char* src = gs + (size_t)c * SC_SHARED;
#pragma unroll
            for (int j = 0; j < SC_SHARED / 1024; ++j) __builtin_amdgcn_global_load_lds((const unsigned*)(src + j * 1024), (LAS unsigned*)(dst + j * 1024), 16, 0, 0);
            __builtin_amdgcn_global_load_lds((const unsigned*)(gv + (size_t)c * SC_STEPS * 256), (LAS unsigned*)(dst + SC_SHARED), 16, 0, 0);
            if (c >= 2) { asm volatile("s_waitcnt vmcnt(42)" ::: "memory"); const int ps = (slot >= 2) ? slot - 2 : slot + SC_NSLOT - 2; if (F.lane == 0) READY[ps] = (unsigned)(c - 1); }
            slot = (slot + 1 == SC_NSLOT) ? 0 : slot + 1;
        }
        { asm volatile("s_waitcnt vmcnt(21)" ::: "memory"); const int ps = (slot >= 2) ? slot - 2 : slot + SC_NSLOT - 2; if (F.lane == 0) READY[ps] = (unsigned)(SC_NCH - 1); }
        { asm volatile("s_waitcnt vmcnt(0)" ::: "memory"); const int ps = (slot >= 1) ? slot - 1 : SC_NSLOT - 1; if (F.lane == 0) READY[ps] = (unsigned)(SC_NCH); }
    } else {
#if MK_CONV_IN_SCAN
        for (int it = F.vcu * 3 + (F.wave - 5); it < MOE_ITEMS; it += F.G * 3) moe_weight_item(F, it);
#endif
    }
    __syncthreads();
}

constexpr int KLD = 72;
constexpr int VLD = 260;
__device__ __forceinline__ void phase5_attn(const Frame& F) {
    const bf16* P = wsp<bf16>(F, WS_P);
    bf16* CAT = wsp<bf16>(F, WS_CAT);
    const float* qg = F.in[17]; const float* kg = F.in[18]; const float* sinks = F.in[19];
    LAS bf16* Kl = (LAS bf16*)F.lds;
    LAS bf16* Vt = (LAS bf16*)(F.lds + 256 * KLD * 2);
    const int lane = F.lane, r = lane & 31, h = lane >> 5;
    for (int unit = F.vcu; unit < NBATCH * KVH * (T / 128); unit += F.G) {
        const int blk = unit % (T / 128), kvh = (unit / (T / 128)) % KVH, b = unit / (T / 128 * KVH);
        const int kpos0 = blk * 128 - 128;
        __syncthreads();
        for (int ch = F.tid; ch < 2048; ch += 512) { const int key = ch >> 3, dc = ch & 7, kpos = kpos0 + key;
            u32x4 kraw = (u32x4){0u, 0u, 0u, 0u}, vraw = (u32x4){0u, 0u, 0u, 0u};
            if (kpos >= 0) { const size_t ro = (size_t)(b * T + kpos) * IN_COLS; kraw = *(const u32x4*)(P + ro + COL_K + kvh * 64 + dc * 8); vraw = *(const u32x4*)(P + ro + COL_V + kvh * 64 + dc * 8); }
            float kf[8]; kf[0] = bflo(kraw.x); kf[1] = bfhi(kraw.x); kf[2] = bflo(kraw.y); kf[3] = bfhi(kraw.y); kf[4] = bflo(kraw.z); kf[5] = bfhi(kraw.z); kf[6] = bflo(kraw.w); kf[7] = bfhi(kraw.w);
            float ss = 0.f;
#pragma unroll
            for (int j = 0; j < 8; ++j) ss += kf[j] * kf[j];
            ss += __shfl_xor(ss, 1); ss += __shfl_xor(ss, 2); ss += __shfl_xor(ss, 4);
            const float rstd = rsqrtf(ss * (1.f / 64.f) + NORM_EPS);
            const f32x4 g0 = *(const f32x4*)(kg + dc * 8), g1 = *(const f32x4*)(kg + dc * 8 + 4);
            u32x4 ko; ko.x = pk2(kf[0] * rstd * g0[0], kf[1] * rstd * g0[1]); ko.y = pk2(kf[2] * rstd * g0[2], kf[3] * rstd * g0[3]);
            ko.z = pk2(kf[4] * rstd * g1[0], kf[5] * rstd * g1[1]); ko.w = pk2(kf[6] * rstd * g1[2], kf[7] * rstd * g1[3]);
            *(LAS u32x4*)(Kl + key * KLD + dc * 8) = ko;
            const unsigned vv[4] = {vraw.x, vraw.y, vraw.z, vraw.w};
#pragma unroll
            for (int j = 0; j < 4; ++j) { Vt[(dc * 8 + 2 * j) * VLD + key] = (bf16)(vv[j] & 0xffffu); Vt[(dc * 8 + 2 * j + 1) * VLD + key] = (bf16)(vv[j] >> 16); }
        }
        __syncthreads();
        for (int task = F.wave; task < 16; task += 8) {
            const int g = task & 3, qs = task >> 2, head = kvh * 4 + g;
            const int qrow = b * T + blk * 128 + qs * 32 + r;
            float qf[4][8]; float ss = 0.f;
#pragma unroll
            for (int s = 0; s < 4; ++s) { const u32x4 qr = *(const u32x4*)(P + (size_t)qrow * IN_COLS + COL_Q + head * 64 + 16 * s + 8 * h);
                qf[s][0] = bflo(qr.x); qf[s][1] = bfhi(qr.x); qf[s][2] = bflo(qr.y); qf[s][3] = bfhi(qr.y); qf[s][4] = bflo(qr.z); qf[s][5] = bfhi(qr.z); qf[s][6] = bflo(qr.w); qf[s][7] = bfhi(qr.w);
#pragma unroll
                for (int j = 0; j < 8; ++j) ss += qf[s][j] * qf[s][j]; }
            ss += __shfl_xor(ss, 32);
            const float qscale = rsqrtf(ss * (1.f / 64.f) + NORM_EPS) * 0.125f;
            bf16x8 qb[4];
#pragma unroll
            for (int s = 0; s < 4; ++s) { u32x4 w;
                const f32x4 g0 = *(const f32x4*)(qg + 16 * s + 8 * h), g1 = *(const f32x4*)(qg + 16 * s + 8 * h + 4);
                w.x = pk2(qf[s][0] * qscale * g0[0], qf[s][1] * qscale * g0[1]); w.y = pk2(qf[s][2] * qscale * g0[2], qf[s][3] * qscale * g0[3]);
                w.z = pk2(qf[s][4] * qscale * g1[0], qf[s][5] * qscale * g1[1]); w.w = pk2(qf[s][6] * qscale * g1[2], qf[s][7] * qscale * g1[3]);
                qb[s] = __builtin_bit_cast(bf16x8, w); }
            f32x16 st[5];
#pragma unroll
            for (int kt = 0; kt < 5; ++kt) {
#pragma unroll
                for (int i = 0; i < 16; ++i) st[kt][i] = 0.f;
#pragma unroll
                for (int s = 0; s < 4; ++s) { const bf16x8 ka = *(const LAS bf16x8*)(Kl + (32 * (qs + kt) + r) * KLD + 16 * s + 8 * h);
                    st[kt] = __builtin_amdgcn_mfma_f32_32x32x16_bf16(ka, qb[s], st[kt], 0, 0, 0); }
            }
            const int iq = 32 * qs + r;
            const float sink = sinks[head];
            float mx = sink;
#pragma unroll
            for (int kt = 0; kt < 5; ++kt)
#pragma unroll
                for (int i = 0; i < 16; ++i) { const int jw = 32 * (qs + kt) + (i & 3) + 8 * (i >> 2) + 4 * h;
                    const bool ok = (jw >= iq + 1) && (jw <= iq + 128) && (kpos0 + jw >= 0);
                    st[kt][i] = ok ? st[kt][i] : -INFINITY; mx = fmaxf(mx, st[kt][i]); }
            mx = fmaxf(mx, __shfl_xor(mx, 32));
            float lsum = 0.f;
#pragma unroll
            for (int kt = 0; kt < 5; ++kt)
#pragma unroll
                for (int i = 0; i < 16; ++i) { const float p = __expf(st[kt][i] - mx); st[kt][i] = p; lsum += p; }
            lsum += __shfl_xor(lsum, 32);
            const float linv = 1.f / (lsum + __expf(sink - mx));
            f32x16 o[2];
#pragma unroll
            for (int dt = 0; dt < 2; ++dt)
#pragma unroll
                for (int i = 0; i < 16; ++i) o[dt][i] = 0.f;
#pragma unroll
            for (int kt = 0; kt < 5; ++kt)
#pragma unroll
                for (int sp = 0; sp < 2; ++sp) { u32x4 pw;
                    pw.x = pk2(st[kt][8 * sp + 0] * linv, st[kt][8 * sp + 1] * linv); pw.y = pk2(st[kt][8 * sp + 2] * linv, st[kt][8 * sp + 3] * linv);
                    pw.z = pk2(st[kt][8 * sp + 4] * linv, st[kt][8 * sp + 5] * linv); pw.w = pk2(st[kt][8 * sp + 6] * linv, st[kt][8 * sp + 7] * linv);
                    const bf16x8 pa = __builtin_bit_cast(bf16x8, pw);
                    const int kb = 32 * (qs + kt) + 16 * sp + 4 * h;
#pragma unroll
                    for (int dt = 0; dt < 2; ++dt) { const LAS bf16* vp = Vt + (32 * dt + r) * VLD + kb;
                        const u32x2 lo = *(const LAS u32x2*)vp, hi = *(const LAS u32x2*)(vp + 8);
                        u32x4 vw; vw.x = lo.x; vw.y = lo.y; vw.z = hi.x; vw.w = hi.y;
                        o[dt] = __builtin_amdgcn_mfma_f32_32x32x16_bf16(pa, __builtin_bit_cast(bf16x8, vw), o[dt], 0, 0, 0); } }
#pragma unroll
            for (int dt = 0; dt < 2; ++dt)
#pragma unroll
                for (int i = 0; i < 16; ++i) { const int qr = (i & 3) + 8 * (i >> 2) + 4 * h;
                    CAT[(size_t)(b * T + blk * 128 + qs * 32 + qr) * D + 512 + head * 64 + 32 * dt + r] = (bf16)f2bf(o[dt][i]); }
        }
    }
}

__device__ __forceinline__ void phase6(const Frame& F) {
    const int gw = F.vcu * 8 + F.wave, NGW = F.G * 8;
    const float* Y = wsp<float>(F, WS_Y); const float* SV = wsp<float>(F, WS_SV); const bf16* G = wsp<bf16>(F, WS_G); const float* BON = wsp<float>(F, WS_BONUS);
    bf16* CAT = wsp<bf16>(F, WS_CAT);
    const float* lg = F.in[15]; const float* lb = F.in[16];
    const int hh = F.lane >> 3, n0 = (F.lane & 7) * 8, c0 = F.lane * 8;
    for (int row = gw; row < M; row += NGW) { const int b = row / T, t = row % T;
        const f32x4 y0 = *(const f32x4*)(Y + (size_t)row * 512 + c0), y1 = *(const f32x4*)(Y + (size_t)row * 512 + c0 + 4);
        float yv[8] = {y0[0], y0[1], y0[2], y0[3], y1[0], y1[1], y1[2], y1[3]};
        float s = 0.f;
#pragma unroll
        for (int j = 0; j < 8; ++j) s += yv[j];
        s += __shfl_xor(s, 1); s += __shfl_xor(s, 2); s += __shfl_xor(s, 4);
        const float mean = s * (1.f / 64.f); float q = 0.f;
#pragma unroll
        for (int j = 0; j < 8; ++j) { yv[j] -= mean; q += yv[j] * yv[j]; }
        q += __shfl_xor(q, 1); q += __shfl_xor(q, 2); q += __shfl_xor(q, 4);
        const float rstd = rsqrtf(q * (1.f / 64.f) + GN_EPS);
        const float bon = BON[row * 8 + hh];
        const float* vp = SV + ((size_t)(b * RH + hh) * T + t) * 64 + n0;
        const f32x4 v0 = *(const f32x4*)vp, v1 = *(const f32x4*)(vp + 4);
        const float vv[8] = {v0[0], v0[1], v0[2], v0[3], v1[0], v1[1], v1[2], v1[3]};
        const u32x4 graw = *(const u32x4*)(G + (size_t)row * 512 + c0);
        const float gg[8] = {bflo(graw.x), bfhi(graw.x), bflo(graw.y), bfhi(graw.y), bflo(graw.z), bfhi(graw.z), bflo(graw.w), bfhi(graw.w)};
        float ov[8];
#pragma unroll
        for (int j = 0; j < 8; ++j) ov[j] = (yv[j] * rstd * lg[c0 + j] + lb[c0 + j] + bon * vv[j]) * gg[j];
        u32x4 w; w.x = pk2(ov[0], ov[1]); w.y = pk2(ov[2], ov[3]); w.z = pk2(ov[4], ov[5]); w.w = pk2(ov[6], ov[7]);
        *(u32x4*)(CAT + (size_t)row * D + c0) = w; }
}

__device__ __forceinline__ float reduce32x64(float (&v)[32], int lane) {
#pragma unroll
    for (int i = 0; i < 16; ++i) { const bool hi = lane & 16; const float send = hi ? v[i] : v[i + 16], keep = hi ? v[i + 16] : v[i]; v[i] = keep + __shfl_xor(send, 16); }
#pragma unroll
    for (int i = 0; i < 8; ++i) { const bool hi = lane & 8; const float send = hi ? v[i] : v[i + 8], keep = hi ? v[i + 8] : v[i]; v[i] = keep + __shfl_xor(send, 8); }
#pragma unroll
    for (int i = 0; i < 4; ++i) { const bool hi = lane & 4; const float send = hi ? v[i] : v[i + 4], keep = hi ? v[i + 4] : v[i]; v[i] = keep + __shfl_xor(send, 4); }
#pragma unroll
    for (int i = 0; i < 2; ++i) { const bool hi = lane & 2; const float send = hi ? v[i] : v[i + 2], keep = hi ? v[i + 2] : v[i]; v[i] = keep + __shfl_xor(send, 2); }
    { const bool hi = lane & 1; const float send = hi ? v[0] : v[1], keep = hi ? v[1] : v[0]; v[0] = keep + __shfl_xor(send, 1); }
    return v[0] + __shfl_xor(v[0], 32);
}
__device__ __forceinline__ void phase8(const Frame& F) {
    const float* mod = wsp<float>(F, WS_MOD); const float* x1 = F.out;
    const float* wr_ = F.in[22]; const float* br = F.in[23];
    LAS float* Wt = (LAS float*)F.lds;
    LAS float* lgw = (LAS float*)(F.lds + 131072 + F.wave * 512);
    LAS int* cnt = (LAS int*)(F.lds + 131072 + 4096);
    __syncthreads();
    for (int idx = F.tid; idx < 8192; idx += 512) { const int k = idx >> 3, e4 = idx & 7; const f32x4 w = *(const f32x4*)(wr_ + k * 32 + e4 * 4);
        Wt[(4 * e4 + 0) * 1024 + k] = w[0]; Wt[(4 * e4 + 1) * 1024 + k] = w[1]; Wt[(4 * e4 + 2) * 1024 + k] = w[2]; Wt[(4 * e4 + 3) * 1024 + k] = w[3]; }
    if (F.tid < 32) cnt[F.tid] = 0;
    __syncthreads();
    int* RT_E = wsp<int>(F, WS_RT_E); int* RT_LP = wsp<int>(F, WS_RT_LP); float* RT_G = wsp<float>(F, WS_RT_G);
    const int e = F.lane & 31;
    const float bre = br[e];
    for (int pr = 0; pr < 8; ++pr) { const int row0 = F.vcu * 128 + F.wave * 16 + 2 * pr, b = row0 / T;
        f32x4 h0[4], h1[4];
        norm_row(F, x1 + (size_t)row0 * D, F.in[21], mod + b * 6144 + 3072, mod + b * 6144 + 4096, wsp<bf16>(F, WS_H) + (size_t)row0 * D, h0);
        norm_row(F, x1 + (size_t)(row0 + 1) * D, F.in[21], mod + b * 6144 + 3072, mod + b * 6144 + 4096, wsp<bf16>(F, WS_H) + (size_t)(row0 + 1) * D, h1);
        float pa0[32], pa1[32];
#pragma unroll
        for (int q = 0; q < 32; ++q) { float s0 = 0.f, s1 = 0.f;
#pragma unroll
            for (int j = 0; j < 4; ++j) { const f32x4 w4 = *(const LAS f32x4*)(Wt + q * 1024 + 4 * F.lane + 256 * j);
                s0 += (h0[j][0] * w4[0] + h0[j][1] * w4[1]) + (h0[j][2] * w4[2] + h0[j][3] * w4[3]);
                s1 += (h1[j][0] * w4[0] + h1[j][1] * w4[1]) + (h1[j][2] * w4[2] + h1[j][3] * w4[3]); }
            pa0[q] = s0; pa1[q] = s1; }
        const float lg0 = reduce32x64(pa0, F.lane) + bre, lg1 = reduce32x64(pa1, F.lane) + bre;
#pragma unroll
        for (int q = 0; q < 2; ++q) { const float logit = q ? lg1 : lg0; const int row = row0 + q; LAS float* lg32 = lgw + q * 64;
            if (F.lane < 32) lg32[e] = logit;
            asm volatile("s_waitcnt lgkmcnt(0)" ::: "memory");
            int rank = 0;
#pragma unroll 8
            for (int o = 0; o < 32; ++o) { const float ov = lg32[o]; rank += (ov > logit || (ov == logit && o < e)) ? 1 : 0; }
            if (F.lane < 32 && rank < 4) lg32[32 + rank] = logit;
            asm volatile("s_waitcnt lgkmcnt(0)" ::: "memory");
            const float t0 = lg32[32], t1 = lg32[33], t2 = lg32[34], t3 = lg32[35];
            const float den = 1.f + __expf(t1 - t0) + __expf(t2 - t0) + __expf(t3 - t0);
            if (F.lane < 32 && rank < 4) { const int lp = atomicAdd((int*)&cnt[e], 1);
                RT_E[row * 4 + rank] = e; RT_LP[row * 4 + rank] = lp; RT_G[row * 4 + rank] = __expf(logit - t0) / den; }
            asm volatile("s_waitcnt lgkmcnt(0)" ::: "memory"); }
    }
    __syncthreads();
    if (F.tid < 32) wsp<int>(F, WS_BLKCNT)[F.vcu * 32 + F.tid] = cnt[F.tid];
}

__device__ __forceinline__ void phase9(const Frame& F) {
    LAS int* base = (LAS int*)F.lds;
    LAS int* tot = base + 32;
    LAS int* pst = base + 64;
    const int* BC = wsp<int>(F, WS_BLKCNT);
    if (F.tid < 32) { int s = 0, mine = 0; for (int bk = 0; bk < F.G; ++bk) { if (bk == F.vcu) mine = s; s += BC[bk * 32 + F.tid]; } base[F.tid] = mine; tot[F.tid] = s; }
    __syncthreads();
    if (F.tid == 0) { int s = 0; for (int e = 0; e < 32; ++e) { pst[e] = s; s += (tot[e] + 255) / 256 * 256; } pst[32] = s; }
    __syncthreads();
    int* SLOT_TOK = wsp<int>(F, WS_SLOTTOK); float* SLOT_GATE = wsp<float>(F, WS_SLOTGATE); int* TOK_SLOT = wsp<int>(F, WS_TOKSLOT);
    const int* RT_E = wsp<int>(F, WS_RT_E); const int* RT_LP = wsp<int>(F, WS_RT_LP); const float* RT_G = wsp<float>(F, WS_RT_G);
    { const int idx = F.vcu * 512 + F.tid;
        const int e = RT_E[idx], slot = pst[e] + base[e] + RT_LP[idx];
        SLOT_TOK[slot] = idx >> 2; SLOT_GATE[slot] = RT_G[idx]; TOK_SLOT[idx] = slot; }
    if (F.vcu < 32) { const int e = F.vcu; for (int s = pst[e] + tot[e] + F.tid; s < pst[e + 1]; s += 512) { SLOT_TOK[s] = 0; SLOT_GATE[s] = 0.f; } }
    if (F.vcu == 0) { unsigned* ctl = wsp<unsigned>(F, WS_CTL);
        if (F.tid == 0) ctl[CW_NTILES] = (unsigned)(pst[32] / 256);
        if (F.tid < 33) ctl[CW_PADSTART + F.tid] = (unsigned)pst[F.tid];
        int* TE = wsp<int>(F, WS_TILEE);
        for (int tl = F.tid; tl < MAX_TILES; tl += 512) { int e = 31; for (int q = 0; q < 32; ++q) if (tl * 256 < pst[q + 1]) { e = q; break; } TE[tl] = e; } }
}

__device__ __forceinline__ void phase12(const Frame& F) {
    const int gw = F.vcu * 8 + F.wave, NGW = F.G * 8;
    const float* mod = wsp<float>(F, WS_MOD); const bf16* YS = wsp<bf16>(F, WS_YS); const int* TOK_SLOT = wsp<int>(F, WS_TOKSLOT);
    for (int row = gw; row < M; row += NGW) { const int b = row / T;
        int sl[4];
#pragma unroll
        for (int k = 0; k < 4; ++k) sl[k] = TOK_SLOT[row * 4 + k];
#pragma unroll
        for (int j = 0; j < 2; ++j) { const int col = 8 * F.lane + 512 * j;
            float a[8];
#pragma unroll
            for (int q = 0; q < 8; ++q) a[q] = 0.f;
#pragma unroll
            for (int k = 0; k < 4; ++k) { const u32x4 v = *(const u32x4*)(YS + (size_t)sl[k] * D + col);
                a[0] += bflo(v.x); a[1] += bfhi(v.x); a[2] += bflo(v.y); a[3] += bfhi(v.y); a[4] += bflo(v.z); a[5] += bfhi(v.z); a[6] += bflo(v.w); a[7] += bfhi(v.w); }
            const float* gp = mod + b * 6144 + 5120 + col;
            const f32x4 g0 = *(const f32x4*)gp, g1 = *(const f32x4*)(gp + 4);
            float* op = F.out + (size_t)row * D + col;
            f32x4 x0 = *(const f32x4*)op, x1v = *(const f32x4*)(op + 4);
            x0[0] += g0[0] * a[0]; x0[1] += g0[1] * a[1]; x0[2] += g0[2] * a[2]; x0[3] += g0[3] * a[3];
            x1v[0] += g1[0] * a[4]; x1v[1] += g1[1] * a[5]; x1v[2] += g1[2] * a[6]; x1v[3] += g1[3] * a[7];
            *(f32x4*)op = x0; *(f32x4*)(op + 4) = x1v; } }
}

__device__ __forceinline__ void copy_x_to_out(const Frame& F) {
    const size_t n4 = (size_t)M * D / 4; const f32x4* s = (const f32x4*)F.in[0]; f32x4* d = (f32x4*)F.out;
    for (size_t i = (size_t)blockIdx.x * 512 + F.tid; i < n4; i += (size_t)gridDim.x * 512) d[i] = s[i];
}

struct Args { const float* in[28]; float* out; unsigned char* ws; int ph_lo, ph_hi; };
constexpr int N_PHASES = 13;

__global__ void __launch_bounds__(512, 2) mk_fwd(Args args) {
    extern __shared__ __attribute__((aligned(16))) unsigned char lds_raw[];
    Frame F;
    F.lds = (LAS unsigned char*)lds_raw;
    F.tid = threadIdx.x; F.lane = F.tid & 63; F.wave = __builtin_amdgcn_readfirstlane(F.tid >> 6);
    F.G = gridDim.x; { const int bx = blockIdx.x; F.vcu = (F.G % 8 == 0) ? (bx % 8) * (F.G / 8) + bx / 8 : bx; }
#pragma unroll
    for (int i = 0; i < 28; ++i) F.in[i] = args.in[i];
    F.out = args.out; F.ws = args.ws;
    cg::grid_group grid = cg::this_grid();
    const int lo = args.ph_lo, hi = args.ph_hi;
#define IN(k) (lo <= (k) && (k) < hi)
#define REP(k) for (int rep_ = 0; rep_ < 1 + ((MK_REPEAT_MASK >> (k)) & 1); ++rep_)
#define SEAM(k) do { if (IN(k) && IN((k) + 1)) grid.sync(); } while (0)

    if (IN(0)) REP(0) { phase0(F); } SEAM(0);
    if (IN(1)) REP(1) { phase1(F); } SEAM(1);
    if (IN(2)) REP(2) {
        pg8::Gemm g{wsp<bf16>(F, WS_H), wsp<bf16>(F, WS_WIN), D, IN_COLS, nullptr};
        pg8::StaticOrder S; S.init(M, IN_COLS, F.G, (int)blockIdx.x);
        pg8::EpiBf16P E{wsp<bf16>(F, WS_P), IN_COLS};
        pg8::gemm_phase<pg8::EpiBf16P, pg8::StaticOrder, false>(F.lds, g, S, E);
    } SEAM(2);
    if (IN(3)) REP(3) { phase3(F); } SEAM(3);
    if (IN(4)) REP(4) { phase4_scan(F); } SEAM(4);
    if (IN(5)) REP(5) { phase5_attn(F); } SEAM(5);
    if (IN(6)) REP(6) { phase6(F); } SEAM(6);
    if (IN(7)) REP(7) {
#if MK_LAST_PHASE >= 7
        pg8::Gemm g{wsp<bf16>(F, WS_CAT), wsp<bf16>(F, WS_WOUT), D, D, nullptr};
        pg8::StaticOrder S; S.init(M, D, F.G, (int)blockIdx.x);
        pg8::EpiOutProj E{F.in[0], F.out, wsp<float>(F, WS_MOD) + 2048};
        pg8::gemm_phase<pg8::EpiOutProj, pg8::StaticOrder, false>(F.lds, g, S, E);
#else
        copy_x_to_out(F);
#endif
    } SEAM(7);
    if (IN(8)) REP(8) { phase8(F); } SEAM(8);
    if (IN(9)) REP(9) { phase9(F); } SEAM(9);
    if (IN(10)) REP(10) {
        const unsigned* ctl = wsp<unsigned>(F, WS_CTL);
        pg8::Gemm g{wsp<bf16>(F, WS_H), wsp<bf16>(F, WS_W1), D, 2 * DE, wsp<int>(F, WS_SLOTTOK)};
        pg8::MoeOrder S{(int)ctl[CW_NTILES], 8, F.G, F.vcu, wsp<int>(F, WS_TILEE)};
        pg8::EpiMoe1 E{wsp<bf16>(F, WS_ACT), F.in[25]};
        pg8::gemm_phase<pg8::EpiMoe1, pg8::MoeOrder, true>(F.lds, g, S, E);
    } SEAM(10);
    if (IN(11)) REP(11) {
        const unsigned* ctl = wsp<unsigned>(F, WS_CTL);
        pg8::Gemm g{wsp<bf16>(F, WS_ACT), wsp<bf16>(F, WS_W2), DE, D, nullptr};
        pg8::MoeOrder S{(int)ctl[CW_NTILES], 4, F.G, F.vcu, wsp<int>(F, WS_TILEE)};
        pg8::EpiMoe2 E{wsp<bf16>(F, WS_YS), F.in[27], wsp<float>(F, WS_SLOTGATE)};
        pg8::gemm_phase<pg8::EpiMoe2, pg8::MoeOrder, false>(F.lds, g, S, E);
    } SEAM(11);
    if (IN(12)) { phase12(F); }
#undef IN
#undef SEAM
}

extern "C" void kernel_launch(void* const* d_in, const int* in_sizes, int n_in, void* d_out, int out_size, void* d_ws, size_t ws_size, hipStream_t stream) {
    static int grid = 0;
    if (grid == 0) {
        if (n_in != 28 || out_size != M * D || ws_size < WS_END) { fprintf(stderr, "kernel_launch: unexpected sizes (n_in %d out %d ws %zu, need %zu)\n", n_in, out_size, ws_size, (size_t)WS_END); grid = -1; return; }
        int dev = 0, cus = 0, per_cu = 0;
        (void)hipGetDevice(&dev); (void)hipDeviceGetAttribute(&cus, hipDeviceAttributeMultiprocessorCount, dev);
        (void)hipFuncSetAttribute((const void*)mk_fwd, hipFuncAttributeMaxDynamicSharedMemorySize, LDS_BYTES);
        (void)hipOccupancyMaxActiveBlocksPerMultiprocessor(&per_cu, (const void*)mk_fwd, 512, LDS_BYTES);
        if (per_cu < 1 || cus != 256) { fprintf(stderr, "kernel_launch: occupancy %d, CUs %d: this build needs 256 CUs x 1 block\n", per_cu, cus); grid = -1; return; }
        grid = cus;
    }
    if (grid < 0) return;
    (void)hipMemsetAsync((char*)d_ws + WS_CTL, 0, CTL_BYTES, stream);
    Args a{};
    for (int i = 0; i < 28; ++i) a.in[i] = (const float*)d_in[i];
    a.out = (float*)d_out; a.ws = (unsigned char*)d_ws;
    const int last = MK_LAST_PHASE + 1;
#if MK_ONE_LAUNCH
    a.ph_lo = 0; a.ph_hi = last;
    void* kargs[] = {&a};
    hipError_t e = hipLaunchCooperativeKernel((const void*)mk_fwd, dim3(grid), dim3(512), kargs, LDS_BYTES, stream);
    if (e != hipSuccess) fprintf(stderr, "cooperative launch failed: %s\n", hipGetErrorString(e));
#else
    for (int p = 0; p < last; ++p) { a.ph_lo = p; a.ph_hi = p + 1; hipLaunchKernelGGL(mk_fwd, dim3(grid), dim3(512), LDS_BYTES, stream, a); }
#endif
}
```

```cpp
#include <hip/hip_runtime.h>
#include <hip/hip_cooperative_groups.h>
#include <cstdio>
#include <cstdint>
namespace cg = cooperative_groups;

#ifndef MK_ONE_LAUNCH
#define MK_ONE_LAUNCH 1
#endif
#ifndef MK_REPEAT_MASK
#define MK_REPEAT_MASK 0
#endif
#ifndef MK_CONV_IN_SCAN
#define MK_CONV_IN_SCAN 1
#endif
#ifndef MK_CG_SEAMS
#define MK_CG_SEAMS 0
#endif
#ifndef MK_COOP
#define MK_COOP 0
#endif
#ifndef MK_LAST_PHASE
#define MK_LAST_PHASE 12
#endif

constexpr int D = 1024, NBATCH = 8, T = 4096, M = NBATCH * T;
constexpr int HD = 64, RW = 512, RH = 8, AW = 512, QH = 8, KVH = 2, WIN = 128;
constexpr int RWKV_COLS = 1792, IN_COLS = 2560;
constexpr int COL_Q = 1792, COL_K = 1792 + 512, COL_V = 1792 + 512 + 128;
constexpr int NE = 32, TOPK = 4, DE = 1024;
constexpr int MAX_TILES = 544;
constexpr int MAX_SLOTS = MAX_TILES * 256;
constexpr float NORM_EPS = 1e-6f, GN_EPS = 64e-5f;

#define GAS __attribute__((address_space(1)))
#define LAS __attribute__((address_space(3)))
typedef unsigned short bf16;
typedef short bf16x8 __attribute__((ext_vector_type(8)));
typedef float f32x4 __attribute__((ext_vector_type(4)));
typedef float f32x2 __attribute__((ext_vector_type(2)));
typedef float f32x16 __attribute__((ext_vector_type(16)));
typedef unsigned u32x4 __attribute__((ext_vector_type(4)));
typedef unsigned u32x2 __attribute__((ext_vector_type(2)));

constexpr size_t MiB = 1u << 20;
constexpr size_t WS_CTL = 0, CTL_BYTES = 64 * 1024;
constexpr size_t WS_MOD = 1 * MiB;
constexpr size_t WS_BON = 1 * MiB + 256 * 1024;
constexpr size_t WS_RT_E = 2 * MiB;
constexpr size_t WS_RT_LP = 2 * MiB + 512 * 1024;
constexpr size_t WS_RT_G = 3 * MiB;
constexpr size_t WS_TOKSLOT = 3 * MiB + 512 * 1024;
constexpr size_t WS_SLOTTOK = 4 * MiB;
constexpr size_t WS_SLOTGATE = 5 * MiB;
constexpr size_t WS_BLKCNT = 6 * MiB;
constexpr size_t WS_TILEE = 6 * MiB + 64 * 1024;
constexpr size_t WS_BONUS = 7 * MiB;
constexpr size_t WS_LW = 9 * MiB;
constexpr size_t WS_WIN = 10 * MiB;
constexpr size_t WS_WOUT = 16 * MiB;
constexpr size_t WS_W1 = 20 * MiB;
constexpr size_t WS_W2 = 148 * MiB;
constexpr size_t WS_H = 212 * MiB;
constexpr size_t WS_R2 = 276 * MiB;
constexpr size_t WS_P = WS_R2;
constexpr size_t WS_SCN = WS_R2 + 160 * MiB;
constexpr size_t WS_SV = WS_SCN + 320 * MiB;
constexpr size_t WS_G = WS_SV + 64 * MiB;
constexpr size_t WS_Y = WS_G + 32 * MiB;
constexpr size_t WS_CAT = WS_Y + 64 * MiB;
constexpr size_t WS_ACT = WS_R2;
constexpr size_t WS_YS = WS_R2 + 272 * MiB;
constexpr size_t WS_END = WS_CAT + 64 * MiB;
static_assert(WS_END <= 1024 * MiB, "workspace map");
static_assert(WS_YS + 272 * MiB <= WS_CAT, "YS must not overlay CAT");
constexpr int CW_NTILES = 16;
constexpr int CW_PADSTART = 64;
constexpr int CW_BAR = 4096;
constexpr int MISC_OFF = 156 * 1024 - 64;

constexpr int LDS_BYTES = 156 * 1024;

__device__ __forceinline__ unsigned f2bf(float f) { unsigned u = __builtin_bit_cast(unsigned, f); return (u + 0x7fffu + ((u >> 16) & 1u)) >> 16; }
__device__ __forceinline__ unsigned pk2(float lo, float hi) { return f2bf(lo) | (f2bf(hi) << 16); }
__device__ __forceinline__ float bf2f(unsigned short b) { return __builtin_bit_cast(float, ((unsigned)b) << 16); }
__device__ __forceinline__ float bflo(unsigned u) { return __builtin_bit_cast(float, u << 16); }
__device__ __forceinline__ float bfhi(unsigned u) { return __builtin_bit_cast(float, u & 0xffff0000u); }
__device__ __forceinline__ float wave_sum(float v) {
#pragma unroll
    for (int o = 1; o < 64; o <<= 1) v += __shfl_xor(v, o);
    return v;
}
__device__ __forceinline__ float sigmoidf_(float x) { return 1.f / (1.f + __expf(-x)); }

namespace pg8 {
#define PG8_LAS __attribute__((address_space(3)))
constexpr int BM = 256, BK = 64, HALF = 128, HTB = HALF * BK * 2, STAGE_BYTES = 8 * HTB, NXCD = 8, WGM = 8;
__host__ __device__ __forceinline__ int lds_byte(int r, int c) { const int st = (r >> 4) * 2 + (c >> 5), rr = r & 15, cc = c & 31, ob = rr * 64 + cc * 2; return st * 1024 + (ob ^ (((ob >> 9) & 1) << 5)); }
__host__ __device__ __forceinline__ void stage_rc(int b, int& R, int& C) { const int st = b / 1024, sb = b % 1024, swz = sb ^ (((sb >> 9) & 1) << 5); R = (st >> 1) * 16 + swz / 64; C = (st & 1) * 32 + (swz % 64) / 2; }

struct Unit { int pm, pn, e; };
struct Gemm { const bf16* A; const bf16* Bt; int K, N; const int* rowmap; };

struct StaticOrder {
    int nM, nN, nwg, G, c;
    __device__ void init(int M_, int N_, int G_, int c_) { nM = M_ / BM; nN = N_ / BM; nwg = nM * nN; G = G_; c = c_; }
    __device__ bool next(int i, Unit& u) const {
        const long L = (long)i * G + c; if (L >= nwg) return false;
        int wgid = (int)L; { const int q = nwg / NXCD, r = nwg % NXCD, xcd = wgid % NXCD, off = wgid / NXCD; wgid = (xcd < r ? xcd * (q + 1) : r * (q + 1) + (xcd - r) * q) + off; }
        const int nig = WGM * nN, gid = wgid / nig, fm = gid * WGM, gsz = (nM - fm) < WGM ? (nM - fm) : WGM;
        u.pm = fm + ((wgid % nig) % gsz); u.pn = (wgid % nig) / gsz; u.e = 0; return true;
    }
};
struct MoeOrder {
    int nMt, nN, G, c; const int* tile_e;
    __device__ bool next(int i, Unit& u) const {
        const long L = (long)i * G + c; if (L >= (long)nMt * nN) return false;
        u.pm = (int)(L / nN); u.pn = (int)(L % nN); u.e = tile_e[u.pm]; return true;
    }
};

__device__ __forceinline__ unsigned cvt_pk_bf16(float lo, float hi) { unsigned r; asm volatile("v_cvt_pk_bf16_f32 %0, %1, %2" : "=v"(r) : "v"(lo), "v"(hi)); return r; }

struct EpiBf16P {
    bf16* O; int ldc;
    __device__ __forceinline__ void operator()(const f32x4 (&acc)[2][2][4][2], const Unit& u, int wr, int wc, int fr, int fq) const {
        const int row0 = u.pm * BM + wr * 64 + fr, col0 = u.pn * BM + wc * 32 + 8 * fq;
#pragma unroll
        for (int ai = 0; ai < 2; ++ai)
#pragma unroll
            for (int m = 0; m < 4; ++m) { bf16* rowp = O + (size_t)(row0 + ai * HALF + m * 16) * ldc + col0;
#pragma unroll
                for (int bj = 0; bj < 2; ++bj) { const f32x4 v0 = acc[ai][bj][m][0], v1 = acc[ai][bj][m][1];
                    u32x4 w; w.x = cvt_pk_bf16(v0[0], v0[1]); w.y = cvt_pk_bf16(v0[2], v0[3]); w.z = cvt_pk_bf16(v1[0], v1[1]); w.w = cvt_pk_bf16(v1[2], v1[3]);
                    *(u32x4*)(rowp + bj * HALF) = w; } }
    }
};
struct EpiOutProj {
    const float* x; float* out; const float* gate;
    __device__ __forceinline__ void operator()(const f32x4 (&acc)[2][2][4][2], const Unit& u, int wr, int wc, int fr, int fq) const {
        const int row0 = u.pm * BM + wr * 64 + fr, col0 = u.pn * BM + wc * 32 + 4 * fq;
        const int b = (u.pm * BM) / T;
        f32x4 gv[2][2];
#pragma unroll
        for (int bj = 0; bj < 2; ++bj)
#pragma unroll
            for (int n = 0; n < 2; ++n) gv[bj][n] = *(const f32x4*)(gate + (size_t)b * 6144 + col0 + bj * HALF + n * 16);
#pragma unroll
        for (int ai = 0; ai < 2; ++ai)
#pragma unroll
            for (int m = 0; m < 4; ++m) { const size_t ro = (size_t)(row0 + ai * HALF + m * 16) * D + col0;
#pragma unroll
                for (int bj = 0; bj < 2; ++bj)
#pragma unroll
                    for (int n = 0; n < 2; ++n) { const f32x4 xv = *(const f32x4*)(x + ro + bj * HALF + n * 16);
                        *(f32x4*)(out + ro + bj * HALF + n * 16) = xv + gv[bj][n] * acc[ai][bj][m][n]; } }
    }
};
struct EpiMoe1 {
    bf16* act; const float* b1;
    __device__ __forceinline__ void operator()(const f32x4 (&acc)[2][2][4][2], const Unit& u, int wr, int wc, int fr, int fq) const {
        const int row0 = u.pm * BM + wr * 64 + fr, j0 = u.pn * 128 + wc * 16 + 4 * fq;
        const float* bb = b1 + (size_t)u.e * 2048;
        f32x4 bg[2], bl[2];
#pragma unroll
        for (int bj = 0; bj < 2; ++bj) { bg[bj] = *(const f32x4*)(bb + j0 + bj * 64); bl[bj] = *(const f32x4*)(bb + 1024 + j0 + bj * 64); }
#pragma unroll
        for (int ai = 0; ai < 2; ++ai)
#pragma unroll
            for (int m = 0; m < 4; ++m) { bf16* rowp = act + (size_t)(row0 + ai * HALF + m * 16) * DE + j0;
#pragma unroll
                for (int bj = 0; bj < 2; ++bj) { const f32x4 g4 = acc[ai][bj][m][0] + bg[bj], l4 = acc[ai][bj][m][1] + bl[bj]; float a[4];
#pragma unroll
                    for (int q = 0; q < 4; ++q) { const float gl = fminf(g4[q], 7.0f), li = fminf(fmaxf(l4[q], -7.0f), 7.0f);
                        a[q] = gl * (1.f / (1.f + __expf(-1.702f * gl))) * (li + 1.f); }
                    u32x2 w; w.x = cvt_pk_bf16(a[0], a[1]); w.y = cvt_pk_bf16(a[2], a[3]);
                    *(u32x2*)(rowp + bj * 64) = w; } }
    }
};
struct EpiMoe2 {
    bf16* ys; const float* b2; const float* sgate;
    __device__ __forceinline__ void operator()(const f32x4 (&acc)[2][2][4][2], const Unit& u, int wr, int wc, int fr, int fq) const {
        const int row0 = u.pm * BM + wr * 64 + fr, col0 = u.pn * BM + wc * 32 + 8 * fq;
        const float* bb = b2 + (size_t)u.e * 1024;
        f32x4 bv[2][2];
#pragma unroll
        for (int bj = 0; bj < 2; ++bj)
#pragma unroll
            for (int n = 0; n < 2; ++n) bv[bj][n] = *(const f32x4*)(bb + col0 + bj * HALF + 4 * n);
#pragma unroll
        for (int ai = 0; ai < 2; ++ai)
#pragma unroll
            for (int m = 0; m < 4; ++m) { const int row = row0 + ai * HALF + m * 16; const float gt = sgate[row]; bf16* rowp = ys + (size_t)row * D + col0;
#pragma unroll
                for (int bj = 0; bj < 2; ++bj) { const f32x4 v0 = (acc[ai][bj][m][0] + bv[bj][0]) * gt, v1 = (acc[ai][bj][m][1] + bv[bj][1]) * gt;
                    u32x4 w; w.x = cvt_pk_bf16(v0[0], v0[1]); w.y = cvt_pk_bf16(v0[2], v0[3]); w.z = cvt_pk_bf16(v1[0], v1[1]); w.w = cvt_pk_bf16(v1[2], v1[3]);
                    *(u32x4*)(rowp + bj * HALF) = w; } }
    }
};

template <class Epi, class Sched, bool GATHER>
__device__ __forceinline__ void gemm_phase(PG8_LAS unsigned char* lds, const Gemm g, const Sched& S, const Epi& E) {
    const int tid = threadIdx.x, wid = __builtin_amdgcn_readfirstlane(tid >> 6), lane = tid & 63, wr = wid >> 2, wc = wid & 3, fr = lane & 15, fq = lane >> 4;
    const int K = g.K, nt = K / BK;
    int Rr[2], Cc[2]; unsigned voffB[2];
#pragma unroll
    for (int i = 0; i < 2; ++i) { stage_rc(tid * 16 + i * 8192, Rr[i], Cc[i]); voffB[i] = (unsigned)(Rr[i] * K + Cc[i]) * 2u; }
    const size_t kstep = (size_t)(BK * 2);
    const size_t hstep = (size_t)HALF * K * 2;
    const size_t tstep = 2 * hstep;
    const unsigned ldsw = (unsigned)wid * 1024u;
    const int aoff = lds_byte(wr * 64 + fr, fq * 8), boff = lds_byte(wc * 32 + fr, fq * 8);
#define PG8_SA(b, h) (((b) * 2 + (h)) * HTB)
#define PG8_SB(b, h) ((4 + (b) * 2 + (h)) * HTB)
#define PG8_STAGE(bufoff, gbase, voff) do { _Pragma("unroll") for (int _i = 0; _i < 2; ++_i) \
        __builtin_amdgcn_global_load_lds((const unsigned*)((const char*)(gbase) + (voff)[_i]), (PG8_LAS unsigned*)(lds + (bufoff) + ldsw + _i * 8192), 16, 0, 0); } while (0)
#define PG8_LDA(dst, b, h) do { _Pragma("unroll") for (int m = 0; m < 4; ++m) _Pragma("unroll") for (int k = 0; k < 2; ++k) dst[m][k] = *(const PG8_LAS bf16x8*)(lds + PG8_SA(b, h) + aoff + m * 2048 + k * 1024); } while (0)
#define PG8_LDB(dst, b, h) do { _Pragma("unroll") for (int n = 0; n < 2; ++n) _Pragma("unroll") for (int k = 0; k < 2; ++k) dst[n][k] = *(const PG8_LAS bf16x8*)(lds + PG8_SB(b, h) + boff + n * 2048 + k * 1024); } while (0)
#define PG8_MMA(ai, bj, At, Bt) do { __builtin_amdgcn_s_setprio(1); _Pragma("unroll") for (int m = 0; m < 4; ++m) _Pragma("unroll") for (int n = 0; n < 2; ++n) _Pragma("unroll") for (int k = 0; k < 2; ++k) \
        acc[ai][bj][m][n] = __builtin_amdgcn_mfma_f32_16x16x32_bf16(Bt[n][k], At[m][k], acc[ai][bj][m][n], 0, 0, 0); __builtin_amdgcn_s_setprio(0); } while (0)
#define PG8_WAIT_V(n) asm volatile("s_waitcnt vmcnt(" #n ")" ::: "memory")
#define PG8_WAIT_L(n) asm volatile("s_waitcnt lgkmcnt(" #n ")" ::: "memory")
#define PG8_BAR __builtin_amdgcn_s_barrier()
#define PG8_SCHED __builtin_amdgcn_sched_barrier(0)
#define PG8_AOFFS(dst, u) do { _Pragma("unroll") for (int _h = 0; _h < 2; ++_h) _Pragma("unroll") for (int _i = 0; _i < 2; ++_i) { \
        if constexpr (GATHER) { const int _tok = g.rowmap[(u).pm * BM + _h * HALF + Rr[_i]]; dst[_h][_i] = (unsigned)(_tok * K + Cc[_i]) * 2u; } \
        else dst[_h][_i] = (unsigned)((_h * HALF + Rr[_i]) * K + Cc[_i]) * 2u; } } while (0)
#define PG8_ABASE(u) (GATHER ? (const char*)g.A : (const char*)g.A + (size_t)(u).pm * tstep)
#define PG8_BBASE(u) ((const char*)g.Bt + ((size_t)(u).e * g.N + (size_t)(u).pn * BM) * K * 2)
    Unit cur, nxt, nn; int ui = 0;
    if (!S.next(0, cur)) return;
    bool has_next = S.next(1, nxt);
    unsigned curA[2][2], nxtA[2][2];
    PG8_AOFFS(curA, cur);
    if (has_next) PG8_AOFFS(nxtA, nxt); else {
#pragma unroll
        for (int h = 0; h < 2; ++h)
#pragma unroll
            for (int i = 0; i < 2; ++i) nxtA[h][i] = curA[h][i]; }
    f32x4 acc[2][2][4][2];
#pragma unroll
    for (int a = 0; a < 2; ++a)
#pragma unroll
        for (int b = 0; b < 2; ++b)
#pragma unroll
            for (int m = 0; m < 4; ++m)
#pragma unroll
                for (int n = 0; n < 2; ++n) acc[a][b][m][n] = (f32x4){0.f, 0.f, 0.f, 0.f};
    bf16x8 At[4][2], B0[2][2], B1[2][2];
    const char* cA = PG8_ABASE(cur); const char* cB = PG8_BBASE(cur);
    PG8_STAGE(PG8_SB(0, 0), cB, voffB); PG8_STAGE(PG8_SB(0, 1), cB + hstep, voffB); PG8_STAGE(PG8_SA(0, 0), cA, curA[0]); PG8_STAGE(PG8_SA(0, 1), cA, curA[1]);
    if (wr == 1) PG8_BAR;
    PG8_WAIT_V(2); PG8_BAR;
    PG8_STAGE(PG8_SB(1, 0), cB + kstep, voffB); PG8_STAGE(PG8_SA(1, 0), cA + kstep, curA[0]); PG8_STAGE(PG8_SB(1, 1), cB + hstep + kstep, voffB);
    PG8_WAIT_V(6); PG8_BAR;
    for (;;) {
        const char* nA = has_next ? PG8_ABASE(nxt) : cA; const char* nB = has_next ? PG8_BBASE(nxt) : cB;
        for (int t = 0; t < nt; t += 2) {
            const bool last = (t == nt - 2);
            const char* a1 = cA + (size_t)(t + 1) * kstep;
            const char* a2 = last ? nA : cA + (size_t)(t + 2) * kstep; const char* b2 = last ? nB : cB + (size_t)(t + 2) * kstep;
            const char* a3 = a2 + kstep; const char* b3 = b2 + kstep;
            unsigned o2[2][2];
#pragma unroll
            for (int h = 0; h < 2; ++h)
#pragma unroll
                for (int i = 0; i < 2; ++i) o2[h][i] = last ? nxtA[h][i] : curA[h][i];
            PG8_LDB(B0, 0, 0); PG8_LDB(B1, 0, 1); PG8_SCHED; PG8_LDA(At, 0, 0); PG8_STAGE(PG8_SA(1, 1), a1, curA[1]);
            PG8_WAIT_V(8); PG8_WAIT_L(0); PG8_BAR; PG8_MMA(0, 0, At, B0); PG8_MMA(0, 1, At, B1); PG8_BAR; PG8_SCHED;
            PG8_LDA(At, 0, 1); PG8_STAGE(PG8_SB(0, 0), b2, voffB); PG8_STAGE(PG8_SB(0, 1), b2 + hstep, voffB); PG8_STAGE(PG8_SA(0, 0), a2, o2[0]);
            PG8_WAIT_V(8); PG8_WAIT_L(0); PG8_BAR; PG8_MMA(1, 0, At, B0); PG8_MMA(1, 1, At, B1); PG8_BAR; PG8_SCHED;
            PG8_LDB(B0, 1, 0); PG8_LDB(B1, 1, 1); PG8_SCHED; PG8_LDA(At, 1, 0); PG8_STAGE(PG8_SA(0, 1), a2, o2[1]);
            PG8_WAIT_V(8); PG8_WAIT_L(0); PG8_BAR; PG8_MMA(0, 0, At, B0); PG8_MMA(0, 1, At, B1); PG8_BAR; PG8_SCHED;
            PG8_LDA(At, 1, 1); PG8_STAGE(PG8_SB(1, 0), b3, voffB); PG8_STAGE(PG8_SB(1, 1), b3 + hstep, voffB); PG8_STAGE(PG8_SA(1, 0), a3, o2[0]);
            PG8_WAIT_V(8); PG8_WAIT_L(0); PG8_BAR; PG8_MMA(1, 0, At, B0); PG8_MMA(1, 1, At, B1); PG8_BAR; PG8_SCHED;
        }
        if (wr == 0) PG8_BAR;
        const bool has_nn = has_next && S.next(ui + 2, nn);
        unsigned nnA[2][2];
        if (has_nn) PG8_AOFFS(nnA, nn);
        E(acc, cur, wr, wc, fr, fq);
        if (!has_next) break;
#pragma unroll
        for (int a = 0; a < 2; ++a)
#pragma unroll
            for (int b = 0; b < 2; ++b)
#pragma unroll
                for (int m = 0; m < 4; ++m)
#pragma unroll
                    for (int n = 0; n < 2; ++n) acc[a][b][m][n] = (f32x4){0.f, 0.f, 0.f, 0.f};
        cur = nxt; cA = nA; cB = nB; ++ui;
#pragma unroll
        for (int h = 0; h < 2; ++h)
#pragma unroll
            for (int i = 0; i < 2; ++i) { curA[h][i] = nxtA[h][i]; if (has_nn) nxtA[h][i] = nnA[h][i]; }
        nxt = nn; has_next = has_nn;
        if (wr == 1) PG8_BAR;
    }
    PG8_WAIT_V(0);
    PG8_BAR;
#undef PG8_SA
#undef PG8_SB
#undef PG8_STAGE
#undef PG8_LDA
#undef PG8_LDB
#undef PG8_MMA
#undef PG8_WAIT_V
#undef PG8_WAIT_L
#undef PG8_BAR
#undef PG8_SCHED
#undef PG8_AOFFS
#undef PG8_ABASE
#undef PG8_BBASE
}
}

struct Frame {
    LAS unsigned char* lds;
    int tid, lane, wave, vcu, G;
    const float* in[28];
    float* out;
    unsigned char* ws;
};
template <class Tp> __device__ __forceinline__ Tp* wsp(const Frame& F, size_t off) { return (Tp*)(F.ws + off); }

__device__ __forceinline__ int dest_row(int mode, int s) {
    if (mode == 0) return s;
    if (mode == 1) return (s & ~31) | (((s >> 2) & 1) << 4) | (((s >> 3) & 3) << 2) | (s & 3);
    const int half = s >> 10, j = s & 1023;
    return ((j >> 7) << 8) | (((j >> 6) & 1) << 7) | (((j >> 4) & 3) << 5) | (half << 4) | (j & 15);
}
__device__ __forceinline__ void transpose_item(const float* W, int K, int N, bf16* WT, int mode, int item, int lane) {
    const int nblk = N / 64, kb = item / nblk, nb = item % nblk, k0 = 64 * kb, n0 = 64 * nb;
    const float* src = W + (size_t)k0 * N + n0 + lane;
    float v[64];
#pragma unroll
    for (int i = 0; i < 64; ++i) v[i] = src[(size_t)i * N];
    bf16* dst = WT + (size_t)dest_row(mode, n0 + lane) * K + k0;
#pragma unroll
    for (int j = 0; j < 8; ++j) { u32x4 o; o.x = pk2(v[8 * j], v[8 * j + 1]); o.y = pk2(v[8 * j + 2], v[8 * j + 3]); o.z = pk2(v[8 * j + 4], v[8 * j + 5]); o.w = pk2(v[8 * j + 6], v[8 * j + 7]);
        *(u32x4*)(dst + 8 * j) = o; }
}
constexpr int MOE_I1 = 16 * 32, MOE_I2 = 16 * 16, MOE_ITEMS = NE * (MOE_I1 + MOE_I2);
__device__ __forceinline__ void moe_weight_item(const Frame& F, int it) {
    if (it < NE * MOE_I1) { const int e = it / MOE_I1; transpose_item(F.in[24] + (size_t)e * 1024 * 2048, 1024, 2048, wsp<bf16>(F, WS_W1) + (size_t)e * 2048 * 1024, 2, it % MOE_I1, F.lane); }
    else { const int r = it - NE * MOE_I1, e = r / MOE_I2; transpose_item(F.in[26] + (size_t)e * 1024 * 1024, 1024, 1024, wsp<bf16>(F, WS_W2) + (size_t)e * 1024 * 1024, 1, r % MOE_I2, F.lane); }
}

__device__ __forceinline__ void phase0(const Frame& F) {
    if (F.vcu < 192) {
        LAS float* sl = (LAS float*)F.lds;
        LAS float* red = (LAS float*)(F.lds + 32768);
        const float* c = F.in[1];
        for (int idx = F.tid; idx < 8192; idx += 512) { const int b = idx & 7, k = idx >> 3; const float cv = c[b * 1024 + k]; sl[idx] = cv / (1.f + __expf(-cv)); }
        __syncthreads();
        const int cl = F.tid & 31, ks = F.tid >> 5, col = F.vcu * 32 + cl;
        const float* wa = F.in[2];
        float acc[8];
#pragma unroll
        for (int b = 0; b < 8; ++b) acc[b] = 0.f;
#pragma unroll 4
        for (int kk = 0; kk < 64; ++kk) { const int k = ks * 64 + kk; const float w = wa[(size_t)k * 6144 + col];
            const f32x4 s0 = *(const LAS f32x4*)(sl + k * 8), s1 = *(const LAS f32x4*)(sl + k * 8 + 4);
            acc[0] += s0[0] * w; acc[1] += s0[1] * w; acc[2] += s0[2] * w; acc[3] += s0[3] * w;
            acc[4] += s1[0] * w; acc[5] += s1[1] * w; acc[6] += s1[2] * w; acc[7] += s1[3] * w; }
#pragma unroll
        for (int b = 0; b < 8; ++b) red[(ks * 32 + cl) * 8 + b] = acc[b];
        __syncthreads();
        if (F.tid < 256) { const int b = F.tid >> 5; float s = F.in[3][col];
            for (int q = 0; q < 16; ++q) s += red[(q * 32 + cl) * 8 + b];
            wsp<float>(F, WS_MOD)[b * 6144 + col] = s; }
    }
    const int gw = F.vcu * 8 + F.wave, NGW = F.G * 8;
    constexpr int I_IN = 16 * 40, I_OUT = 16 * 16;
    constexpr int NITEMS = I_IN + I_OUT;
    for (int it = gw; it < NITEMS; it += NGW) {
        int r = it;
        if (r < I_IN) { transpose_item(F.in[5], 1024, 2560, wsp<bf16>(F, WS_WIN), 1, r, F.lane); continue; } r -= I_IN;
        transpose_item(F.in[20], 1024, 1024, wsp<bf16>(F, WS_WOUT), 0, r, F.lane);
    }
#if !MK_CONV_IN_SCAN
    for (int it = gw; it < MOE_ITEMS; it += NGW) moe_weight_item(F, it);
#endif
    { bf16* LW = wsp<bf16>(F, WS_LW);
        for (int idx = F.vcu * 512 + F.tid; idx < 256 * 512; idx += F.G * 512) { const int k = idx >> 9, c = idx & 511;
            const float v = k < 64 ? F.in[8][k * 512 + c] : (k < 128 ? F.in[10][(k - 64) * 512 + c] : F.in[11][(k - 128) * 512 + c]);
            LW[c * 256 + k] = (bf16)f2bf(v); } }
}
__device__ __forceinline__ void norm_row(const Frame& F, const float* xrow, const float* g, const float* shift, const float* scale, bf16* orow, f32x4 (&h)[4]) {
    const f32x4* xr = (const f32x4*)xrow + F.lane;
    float ss = 0.f;
#pragma unroll
    for (int j = 0; j < 4; ++j) { h[j] = xr[64 * j]; ss += (h[j][0] * h[j][0] + h[j][1] * h[j][1]) + (h[j][2] * h[j][2] + h[j][3] * h[j][3]); }
    const float rstd = rsqrtf(wave_sum(ss) * (1.f / D) + NORM_EPS);
    u32x2* o8 = (u32x2*)orow + F.lane;
#pragma unroll
    for (int j = 0; j < 4; ++j) { const int col = 4 * F.lane + 256 * j;
        const f32x4 gv = *(const f32x4*)(g + col), sh = *(const f32x4*)(shift + col), sc = *(const f32x4*)(scale + col);
        h[j] = h[j] * rstd * gv * (sc + 1.f) + sh;
        u32x2 w; w.x = pk2(h[j][0], h[j][1]); w.y = pk2(h[j][2], h[j][3]); o8[64 * j] = w; }
}
__device__ __forceinline__ void phase1(const Frame& F) {
    const int gw = F.vcu * 8 + F.wave, NGW = F.G * 8;
    const float* mod = wsp<float>(F, WS_MOD);
    for (int row = gw; row < M; row += NGW) { const int b = row / T; f32x4 h[4];
        norm_row(F, F.in[0] + (size_t)row * D, F.in[4], mod + b * 6144, mod + b * 6144 + 1024, wsp<bf16>(F, WS_H) + (size_t)row * D, h); }
}

template <int CTRL> __device__ __forceinline__ float dpp_mov(float v) { return __builtin_bit_cast(float, __builtin_amdgcn_update_dpp(0, __builtin_bit_cast(int, v), CTRL, 0xf, 0xf, false)); }
__device__ __forceinline__ float reduce16(float v) { v += dpp_mov<0xB1>(v); v += dpp_mov<0x4E>(v); v += dpp_mov<0x141>(v); v += dpp_mov<0x140>(v); return v; }
__device__ __forceinline__ void lerp8(const bf16* P, const float* mu, int tok, int t, int col, float (&x)[8]) {
    const u32x4 c = *(const u32x4*)(P + (size_t)tok * IN_COLS + col);
    u32x4 p = (u32x4){0u, 0u, 0u, 0u};
    if (t > 0) p = *(const u32x4*)(P + (size_t)(tok - 1) * IN_COLS + col);
    const f32x4 m0 = *(const f32x4*)(mu + col), m1 = *(const f32x4*)(mu + col + 4);
    const float cf[8] = {bflo(c.x), bfhi(c.x), bflo(c.y), bfhi(c.y), bflo(c.z), bfhi(c.z), bflo(c.w), bfhi(c.w)};
    const float pf[8] = {bflo(p.x), bfhi(p.x), bflo(p.y), bfhi(p.y), bflo(p.z), bfhi(p.z), bflo(p.w), bfhi(p.w)};
    const float mf[8] = {m0[0], m0[1], m0[2], m0[3], m1[0], m1[1], m1[2], m1[3]};
#pragma unroll
    for (int j = 0; j < 8; ++j) x[j] = cf[j] + (pf[j] - cf[j]) * mf[j];
}
__device__ __forceinline__ f32x4 lerp4(const bf16* P, const float* mu, int tok, int t, int col) {
    const u32x2 c = *(const u32x2*)(P + (size_t)tok * IN_COLS + col);
    u32x2 p = (u32x2){0u, 0u};
    if (t > 0) p = *(const u32x2*)(P + (size_t)(tok - 1) * IN_COLS + col);
    const f32x4 m = *(const f32x4*)(mu + col);
    const f32x4 cf = (f32x4){bflo(c.x), bfhi(c.x), bflo(c.y), bfhi(c.y)}, pf = (f32x4){bflo(p.x), bfhi(p.x), bflo(p.y), bfhi(p.y)};
    return cf + (pf - cf) * m;
}
__device__ __forceinline__ bf16x8 pack8(const float (&x)[8]) { u32x4 w; w.x = pk2(x[0], x[1]); w.y = pk2(x[2], x[3]); w.z = pk2(x[4], x[5]); w.w = pk2(x[6], x[7]); return __builtin_bit_cast(bf16x8, w); }
__device__ __forceinline__ void phase3(const Frame& F) {
    const bf16* P = wsp<bf16>(F, WS_P); const bf16* LW = wsp<bf16>(F, WS_LW);
    const float* mu = F.in[6]; const float* w0 = F.in[7]; const float* a0 = F.in[9];
    const float* k_k = F.in[12]; const float* k_a = F.in[13]; const float* r_k = F.in[14];
    float* SCN = wsp<float>(F, WS_SCN); float* SV = wsp<float>(F, WS_SV); bf16* G = wsp<bf16>(F, WS_G); float* BON = wsp<float>(F, WS_BONUS);
    const int gw = F.vcu * 8 + F.wave, NGW = F.G * 8;
    const int cl = F.lane & 15, q = F.lane >> 4;
    for (int tile = gw; tile < M / 16; tile += NGW) {
        bf16x8 Aw[2], Aa[2], Ag[4];
        { const int tok = tile * 16 + cl, t = tok % T; float x[8];
#pragma unroll
            for (int s = 0; s < 2; ++s) { lerp8(P, mu, tok, t, 1536 + 32 * s + 8 * q, x);
#pragma unroll
                for (int j = 0; j < 8; ++j) x[j] = tanhf(x[j]);
                Aw[s] = pack8(x);
                lerp8(P, mu, tok, t, 1600 + 32 * s + 8 * q, x); Aa[s] = pack8(x); }
#pragma unroll
            for (int s = 0; s < 4; ++s) { lerp8(P, mu, tok, t, 1664 + 32 * s + 8 * q, x);
#pragma unroll
                for (int j = 0; j < 8; ++j) x[j] = sigmoidf_(x[j]);
                Ag[s] = pack8(x); } }
        const int tk0 = tile * 16 + 4 * q, b = tk0 / T, t0 = tk0 % T;
#pragma unroll 1
        for (int hh = 0; hh < RH; ++hh) {
            const int c0 = hh * 64 + cl * 4;
            f32x4 accw[4], acca[4], accg[4];
#pragma unroll
            for (int ct = 0; ct < 4; ++ct) { const bf16* lw = LW + (size_t)(c0 + ct) * 256 + 8 * q;
                f32x4 aw = (f32x4){0.f, 0.f, 0.f, 0.f}, aa = aw, ag = aw;
#pragma unroll
                for (int s = 0; s < 2; ++s) { aw = __builtin_amdgcn_mfma_f32_16x16x32_bf16(Aw[s], *(const bf16x8*)(lw + 32 * s), aw, 0, 0, 0);
                    aa = __builtin_amdgcn_mfma_f32_16x16x32_bf16(Aa[s], *(const bf16x8*)(lw + 64 + 32 * s), aa, 0, 0, 0); }
#pragma unroll
                for (int s = 0; s < 4; ++s) ag = __builtin_amdgcn_mfma_f32_16x16x32_bf16(Ag[s], *(const bf16x8*)(lw + 128 + 32 * s), ag, 0, 0, 0);
                accw[ct] = aw; acca[ct] = aa; accg[ct] = ag; }
            const f32x4 w0v = *(const f32x4*)(w0 + c0), a0v = *(const f32x4*)(a0 + c0), kkv = *(const f32x4*)(k_k + c0), kav = *(const f32x4*)(k_a + c0), rkv = *(const f32x4*)(r_k + c0);
#pragma unroll
            for (int i = 0; i < 4; ++i) { const int tk = tk0 + i, t = t0 + i;
                const f32x4 r4 = lerp4(P, mu, tk, t, c0), kr4 = lerp4(P, mu, tk, t, 512 + c0), v4 = lerp4(P, mu, tk, t, 1024 + c0);
                f32x4 dec, av, gv, kk4, k4;
                float ssq = 0.f, bon = 0.f;
#pragma unroll
                for (int ct = 0; ct < 4; ++ct) {
                    dec[ct] = __expf(-0.60653066f * sigmoidf_(w0v[ct] + accw[ct][i]));
                    av[ct] = sigmoidf_(a0v[ct] + acca[ct][i]);
                    gv[ct] = accg[ct][i];
                    kk4[ct] = kr4[ct] * kkv[ct]; ssq += kk4[ct] * kk4[ct];
                    k4[ct] = kr4[ct] * (1.f + (av[ct] - 1.f) * kav[ct]);
                    bon += r4[ct] * k4[ct] * rkv[ct]; }
                ssq = reduce16(ssq); bon = reduce16(bon);
                const float inv = 1.f / fmaxf(sqrtf(ssq), 1e-12f);
                const f32x4 kkn = kk4 * inv, bb = kkn * av;
                const size_t so = ((size_t)(b * RH + hh) * T + t) * 64 + cl * 4;
                float* sc = SCN + ((size_t)(b * RH + hh) * T + t) * 320 + cl * 4;
                *(f32x4*)(sc) = dec; *(f32x4*)(sc + 64) = kkn; *(f32x4*)(sc + 128) = bb; *(f32x4*)(sc + 192) = k4; *(f32x4*)(sc + 256) = r4;
                *(f32x4*)(SV + so) = v4;
                u32x2 gw2; gw2.x = pk2(gv[0], gv[1]); gw2.y = pk2(gv[2], gv[3]);
                *(u32x2*)(G + (size_t)tk * 512 + c0) = gw2;
                if (cl == 0) BON[tk * 8 + hh] = bon; }
        }
    }
}

constexpr int SC_STEPS = 16, SC_NSLOT = 6, SC_SHARED = SC_STEPS * 1280, SC_SLOT = SC_SHARED + SC_STEPS * 64, SC_RING = SC_NSLOT * SC_SLOT;
constexpr int SC_FLAGS = SC_RING, SC_CONV = SC_RING + 256, SC_NCH = T / SC_STEPS;
static_assert(SC_CONV + 3 * 8704 <= LDS_BYTES, "scan LDS map");
#define SC_SPIN_CAP (1 << 24)
__device__ __forceinline__ void phase4_scan(const Frame& F) {
    volatile LAS unsigned* READY = (volatile LAS unsigned*)(F.lds + SC_FLAGS);
    volatile LAS unsigned* DONE = (volatile LAS unsigned*)(F.lds + SC_FLAGS + 64);
    __syncthreads();
    if (F.tid < 64) ((LAS unsigned*)(F.lds + SC_FLAGS))[F.tid] = 0u;
    __syncthreads();
    const int bh = F.vcu >> 2, rg = F.vcu & 3, b = bh / RH, hh = bh % RH;
    if (F.wave < 4) {
        const int rl = F.lane >> 4, ks = F.lane & 15, rowl = F.wave * 4 + rl;
        float* yp = wsp<float>(F, WS_Y) + (size_t)b * T * 512 + hh * 64 + rg * 16 + rowl;
        f32x4 S = (f32x4){0.f, 0.f, 0.f, 0.f};
        int slot = 0;
        for (int c = 0; c < SC_NCH; ++c) {
            { int sp = 0; while (READY[slot] < (unsigned)(c + 1)) { if (++sp > SC_SPIN_CAP) break; } }
            __builtin_amdgcn_fence(__ATOMIC_ACQUIRE, "workgroup");
            const LAS unsigned char* sb = F.lds + slot * SC_SLOT;
            const LAS unsigned char* op = sb + ks * 16; const LAS float* vp = (const LAS float*)(sb + SC_SHARED) + rowl;
            f32x4 w4 = *(const LAS f32x4*)(op), kk4 = *(const LAS f32x4*)(op + 256), b4 = *(const LAS f32x4*)(op + 512), k4 = *(const LAS f32x4*)(op + 768), r4 = *(const LAS f32x4*)(op + 1024);
            float v = vp[0];
            float ykeep = 0.f;
#pragma unroll
            for (int s = 0; s < SC_STEPS; ++s) {
                const f32x4 cw = w4, ckk = kk4, cb = b4, ck = k4, cr = r4; const float cv = v;
                if (s + 1 < SC_STEPS) { const LAS unsigned char* o2 = op + (s + 1) * 1280;
                    w4 = *(const LAS f32x4*)(o2); kk4 = *(const LAS f32x4*)(o2 + 256); b4 = *(const LAS f32x4*)(o2 + 512); k4 = *(const LAS f32x4*)(o2 + 768); r4 = *(const LAS f32x4*)(o2 + 1024);
                    v = vp[(s + 1) * 16]; }
                if (s == SC_STEPS - 1) { asm volatile("s_waitcnt lgkmcnt(0)" ::: "memory"); if (F.lane == 0) DONE[F.wave] = (unsigned)(c + 1); }
                float p = (S[0] * ckk[0] + S[1] * ckk[1]) + (S[2] * ckk[2] + S[3] * ckk[3]);
                p = reduce16(p);
                const f32x4 tt = S * cw + ck * cv;
                S = tt - cb * p;
                float q = (S[0] * cr[0] + S[1] * cr[1]) + (S[2] * cr[2] + S[3] * cr[3]);
                q = reduce16(q);
                ykeep = (ks == s) ? q : ykeep;
            }
            yp[(size_t)(c * SC_STEPS + ks) * 512] = ykeep;
            slot = (slot + 1 == SC_NSLOT) ? 0 : slot + 1;
        }
    } else if (F.wave == 4) {
        const unsigned char* gs = (const unsigned char*)(wsp<float>(F, WS_SCN) + (size_t)bh * T * 320) + F.lane * 16;
        const unsigned char* gv = (const unsigned char*)(wsp<float>(F, WS_SV) + (size_t)bh * T * 64 + (F.lane >> 2) * 64 + rg * 16 + (F.lane & 3) * 4);
        int slot = 0;
        for (int c = 0; c < SC_NCH; ++c) {
            if (c >= SC_NSLOT) { const unsigned need = (unsigned)(c - SC_NSLOT + 1); int sp = 0;
                while (DONE[0] < need || DONE[1] < need || DONE[2] < need || DONE[3] < need) { __builtin_amdgcn_s_sleep(1); if (++sp > SC_SPIN_CAP) break; }
                __builtin_amdgcn_fence(__ATOMIC_ACQUIRE, "workgroup"); }
            LAS unsigned char* dst = F.lds + slot * SC_SLOT;
            const unsigned char* src = gs + (size_t)c * SC_SHARED;
#pragma unroll
            for (int j = 0; j < SC_SHARED / 1024; ++j) __builtin_amdgcn_global_load_lds((const unsigned*)(src + j * 1024), (LAS unsigned*)(dst + j * 1024), 16, 0, 0);
            __builtin_amdgcn_global_load_lds((const unsigned*)(gv + (size_t)c * SC_STEPS * 256), (LAS unsigned*)(dst + SC_SHARED), 16, 0, 0);
            if (c >= 2) { asm volatile("s_waitcnt vmcnt(42)" ::: "memory"); const int ps = (slot >= 2) ? slot - 2 : slot + SC_NSLOT - 2; if (F.lane == 0) READY[ps] = (unsigned)(c - 1); }
            slot = (slot + 1 == SC_NSLOT) ? 0 : slot + 1;
        }
        { asm volatile("s_waitcnt vmcnt(21)" ::: "memory"); const int ps = (slot >= 2) ? slot - 2 : slot + SC_NSLOT - 2; if (F.lane == 0) READY[ps] = (unsigned)(SC_NCH - 1); }
        { asm volatile("s_waitcnt vmcnt(0)" ::: "memory"); const int ps = (slot >= 1) ? slot - 1 : SC_NSLOT - 1; if (F.lane == 0) READY[ps] = (unsigned)(SC_NCH); }
    } else {
#if MK_CONV_IN_SCAN
        for (int it = F.vcu * 3 + (F.wave - 5); it < MOE_ITEMS; it += F.G * 3) moe_weight_item(F, it);
#endif
    }
    __syncthreads();
}

constexpr int KLD = 72;
constexpr int VLD = 260;
__device__ __forceinline__ void phase5_attn(const Frame& F) {
    const bf16* P = wsp<bf16>(F, WS_P);
    bf16* CAT = wsp<bf16>(F, WS_CAT);
    const float* qg = F.in[17]; const float* kg = F.in[18]; const float* sinks = F.in[19];
    LAS bf16* Kl = (LAS bf16*)F.lds;
    LAS bf16* Vt = (LAS bf16*)(F.lds + 256 * KLD * 2);
    const int lane = F.lane, r = lane & 31, h = lane >> 5;
    for (int unit = F.vcu; unit < NBATCH * KVH * (T / 128); unit += F.G) {
        const int blk = unit % (T / 128), kvh = (unit / (T / 128)) % KVH, b = unit / (T / 128 * KVH);
        const int kpos0 = blk * 128 - 128;
        __syncthreads();
        for (int ch = F.tid; ch < 2048; ch += 512) { const int key = ch >> 3, dc = ch & 7, kpos = kpos0 + key;
            u32x4 kraw = (u32x4){0u, 0u, 0u, 0u}, vraw = (u32x4){0u, 0u, 0u, 0u};
            if (kpos >= 0) { const size_t ro = (size_t)(b * T + kpos) * IN_COLS; kraw = *(const u32x4*)(P + ro + COL_K + kvh * 64 + dc * 8); vraw = *(const u32x4*)(P + ro + COL_V + kvh * 64 + dc * 8); }
            float kf[8]; kf[0] = bflo(kraw.x); kf[1] = bfhi(kraw.x); kf[2] = bflo(kraw.y); kf[3] = bfhi(kraw.y); kf[4] = bflo(kraw.z); kf[5] = bfhi(kraw.z); kf[6] = bflo(kraw.w); kf[7] = bfhi(kraw.w);
            float ss = 0.f;
#pragma unroll
            for (int j = 0; j < 8; ++j) ss += kf[j] * kf[j];
            ss += __shfl_xor(ss, 1); ss += __shfl_xor(ss, 2); ss += __shfl_xor(ss, 4);
            const float rstd = rsqrtf(ss * (1.f / 64.f) + NORM_EPS);
            const f32x4 g0 = *(const f32x4*)(kg + dc * 8), g1 = *(const f32x4*)(kg + dc * 8 + 4);
            u32x4 ko; ko.x = pk2(kf[0] * rstd * g0[0], kf[1] * rstd * g0[1]); ko.y = pk2(kf[2] * rstd * g0[2], kf[3] * rstd * g0[3]);
            ko.z = pk2(kf[4] * rstd * g1[0], kf[5] * rstd * g1[1]); ko.w = pk2(kf[6] * rstd * g1[2], kf[7] * rstd * g1[3]);
            *(LAS u32x4*)(Kl + key * KLD + dc * 8) = ko;
            const unsigned vv[4] = {vraw.x, vraw.y, vraw.z, vraw.w};
#pragma unroll
            for (int j = 0; j < 4; ++j) { Vt[(dc * 8 + 2 * j) * VLD + key] = (bf16)(vv[j] & 0xffffu); Vt[(dc * 8 + 2 * j + 1) * VLD + key] = (bf16)(vv[j] >> 16); }
        }
        __syncthreads();
        for (int task = F.wave; task < 16; task += 8) {
            const int g = task & 3, qs = task >> 2, head = kvh * 4 + g;
            const int qrow = b * T + blk * 128 + qs * 32 + r;
            float qf[4][8]; float ss = 0.f;
#pragma unroll
            for (int s = 0; s < 4; ++s) { const u32x4 qr = *(const u32x4*)(P + (size_t)qrow * IN_COLS + COL_Q + head * 64 + 16 * s + 8 * h);
                qf[s][0] = bflo(qr.x); qf[s][1] = bfhi(qr.x); qf[s][2] = bflo(qr.y); qf[s][3] = bfhi(qr.y); qf[s][4] = bflo(qr.z); qf[s][5] = bfhi(qr.z); qf[s][6] = bflo(qr.w); qf[s][7] = bfhi(qr.w);
#pragma unroll
                for (int j = 0; j < 8; ++j) ss += qf[s][j] * qf[s][j]; }
            ss += __shfl_xor(ss, 32);
            const float qscale = rsqrtf(ss * (1.f / 64.f) + NORM_EPS) * 0.125f;
            bf16x8 qb[4];
#pragma unroll
            for (int s = 0; s < 4; ++s) { u32x4 w;
                const f32x4 g0 = *(const f32x4*)(qg + 16 * s + 8 * h), g1 = *(const f32x4*)(qg + 16 * s + 8 * h + 4);
                w.x = pk2(qf[s][0] * qscale * g0[0], qf[s][1] * qscale * g0[1]); w.y = pk2(qf[s][2] * qscale * g0[2], qf[s][3] * qscale * g0[3]);
                w.z = pk2(qf[s][4] * qscale * g1[0], qf[s][5] * qscale * g1[1]); w.w = pk2(qf[s][6] * qscale * g1[2], qf[s][7] * qscale * g1[3]);
                qb[s] = __builtin_bit_cast(bf16x8, w); }
            f32x16 st[5];
#pragma unroll
            for (int kt = 0; kt < 5; ++kt) {
#pragma unroll
                for (int i = 0; i < 16; ++i) st[kt][i] = 0.f;
#pragma unroll
                for (int s = 0; s < 4; ++s) { const bf16x8 ka = *(const LAS bf16x8*)(Kl + (32 * (qs + kt) + r) * KLD + 16 * s + 8 * h);
                    st[kt] = __builtin_amdgcn_mfma_f32_32x32x16_bf16(ka, qb[s], st[kt], 0, 0, 0); }
            }
            const int iq = 32 * qs + r;
            const float sink = sinks[head];
            float mx = sink;
#pragma unroll
            for (int kt = 0; kt < 5; ++kt)
#pragma unroll
                for (int i = 0; i < 16; ++i) { const int jw = 32 * (qs + kt) + (i & 3) + 8 * (i >> 2) + 4 * h;
                    const bool ok = (jw >= iq + 1) && (jw <= iq + 128) && (kpos0 + jw >= 0);
                    st[kt][i] = ok ? st[kt][i] : -INFINITY; mx = fmaxf(mx, st[kt][i]); }
            mx = fmaxf(mx, __shfl_xor(mx, 32));
            float lsum = 0.f;
#pragma unroll
            for (int kt = 0; kt < 5; ++kt)
#pragma unroll
                for (int i = 0; i < 16; ++i) { const float p = __expf(st[kt][i] - mx); st[kt][i] = p; lsum += p; }
            lsum += __shfl_xor(lsum, 32);
            const float linv = 1.f / (lsum + __expf(sink - mx));
            f32x16 o[2];
#pragma unroll
            for (int dt = 0; dt < 2; ++dt)
#pragma unroll
                for (int i = 0; i < 16; ++i) o[dt][i] = 0.f;
#pragma unroll
            for (int kt = 0; kt < 5; ++kt)
#pragma unroll
                for (int sp = 0; sp < 2; ++sp) { u32x4 pw;
                    pw.x = pk2(st[kt][8 * sp + 0] * linv, st[kt][8 * sp + 1] * linv); pw.y = pk2(st[kt][8 * sp + 2] * linv, st[kt][8 * sp + 3] * linv);
                    pw.z = pk2(st[kt][8 * sp + 4] * linv, st[kt][8 * sp + 5] * linv); pw.w = pk2(st[kt][8 * sp + 6] * linv, st[kt][8 * sp + 7] * linv);
                    const bf16x8 pa = __builtin_bit_cast(bf16x8, pw);
                    const int kb = 32 * (qs + kt) + 16 * sp + 4 * h;
#pragma unroll
                    for (int dt = 0; dt < 2; ++dt) { const LAS bf16* vp = Vt + (32 * dt + r) * VLD + kb;
                        const u32x2 lo = *(const LAS u32x2*)vp, hi = *(const LAS u32x2*)(vp + 8);
                        u32x4 vw; vw.x = lo.x; vw.y = lo.y; vw.z = hi.x; vw.w = hi.y;
                        o[dt] = __builtin_amdgcn_mfma_f32_32x32x16_bf16(pa, __builtin_bit_cast(bf16x8, vw), o[dt], 0, 0, 0); } }
#pragma unroll
            for (int dt = 0; dt < 2; ++dt)
#pragma unroll
                for (int i = 0; i < 16; ++i) { const int qr = (i & 3) + 8 * (i >> 2) + 4 * h;
                    CAT[(size_t)(b * T + blk * 128 + qs * 32 + qr) * D + 512 + head * 64 + 32 * dt + r] = (bf16)f2bf(o[dt][i]); }
        }
    }
}

__device__ __forceinline__ void phase6(const Frame& F) {
    const int gw = F.vcu * 8 + F.wave, NGW = F.G * 8;
    const float* Y = wsp<float>(F, WS_Y); const float* SV = wsp<float>(F, WS_SV); const bf16* G = wsp<bf16>(F, WS_G); const float* BON = wsp<float>(F, WS_BONUS);
    bf16* CAT = wsp<bf16>(F, WS_CAT);
    const float* lg = F.in[15]; const float* lb = F.in[16];
    const int hh = F.lane >> 3, n0 = (F.lane & 7) * 8, c0 = F.lane * 8;
    for (int row = gw; row < M; row += NGW) { const int b = row / T, t = row % T;
        const f32x4 y0 = *(const f32x4*)(Y + (size_t)row * 512 + c0), y1 = *(const f32x4*)(Y + (size_t)row * 512 + c0 + 4);
        float yv[8] = {y0[0], y0[1], y0[2], y0[3], y1[0], y1[1], y1[2], y1[3]};
        float s = 0.f;
#pragma unroll
        for (int j = 0; j < 8; ++j) s += yv[j];
        s += __shfl_xor(s, 1); s += __shfl_xor(s, 2); s += __shfl_xor(s, 4);
        const float mean = s * (1.f / 64.f); float q = 0.f;
#pragma unroll
        for (int j = 0; j < 8; ++j) { yv[j] -= mean; q += yv[j] * yv[j]; }
        q += __shfl_xor(q, 1); q += __shfl_xor(q, 2); q += __shfl_xor(q, 4);
        const float rstd = rsqrtf(q * (1.f / 64.f) + GN_EPS);
        const float bon = BON[row * 8 + hh];
        const float* vp = SV + ((size_t)(b * RH + hh) * T + t) * 64 + n0;
        const f32x4 v0 = *(const f32x4*)vp, v1 = *(const f32x4*)(vp + 4);
        const float vv[8] = {v0[0], v0[1], v0[2], v0[3], v1[0], v1[1], v1[2], v1[3]};
        const u32x4 graw = *(const u32x4*)(G + (size_t)row * 512 + c0);
        const float gg[8] = {bflo(graw.x), bfhi(graw.x), bflo(graw.y), bfhi(graw.y), bflo(graw.z), bfhi(graw.z), bflo(graw.w), bfhi(graw.w)};
        float ov[8];
#pragma unroll
        for (int j = 0; j < 8; ++j) ov[j] = (yv[j] * rstd * lg[c0 + j] + lb[c0 + j] + bon * vv[j]) * gg[j];
        u32x4 w; w.x = pk2(ov[0], ov[1]); w.y = pk2(ov[2], ov[3]); w.z = pk2(ov[4], ov[5]); w.w = pk2(ov[6], ov[7]);
        *(u32x4*)(CAT + (size_t)row * D + c0) = w; }
}

__device__ __forceinline__ float reduce32x64(float (&v)[32], int lane) {
#pragma unroll
    for (int i = 0; i < 16; ++i) { const bool hi = lane & 16; const float send = hi ? v[i] : v[i + 16], keep = hi ? v[i + 16] : v[i]; v[i] = keep + __shfl_xor(send, 16); }
#pragma unroll
    for (int i = 0; i < 8; ++i) { const bool hi = lane & 8; const float send = hi ? v[i] : v[i + 8], keep = hi ? v[i + 8] : v[i]; v[i] = keep + __shfl_xor(send, 8); }
#pragma unroll
    for (int i = 0; i < 4; ++i) { const bool hi = lane & 4; const float send = hi ? v[i] : v[i + 4], keep = hi ? v[i + 4] : v[i]; v[i] = keep + __shfl_xor(send, 4); }
#pragma unroll
    for (int i = 0; i < 2; ++i) { const bool hi = lane & 2; const float send = hi ? v[i] : v[i + 2], keep = hi ? v[i + 2] : v[i]; v[i] = keep + __shfl_xor(send, 2); }
    { const bool hi = lane & 1; const float send = hi ? v[0] : v[1], keep = hi ? v[1] : v[0]; v[0] = keep + __shfl_xor(send, 1); }
    return v[0] + __shfl_xor(v[0], 32);
}
__device__ __forceinline__ void phase8(const Frame& F) {
    const float* mod = wsp<float>(F, WS_MOD); const float* x1 = F.out;
    const float* wr_ = F.in[22]; const float* br = F.in[23];
    LAS float* Wt = (LAS float*)F.lds;
    LAS float* lgw = (LAS float*)(F.lds + 131072 + F.wave * 512);
    LAS int* cnt = (LAS int*)(F.lds + 131072 + 4096);
    __syncthreads();
    for (int idx = F.tid; idx < 8192; idx += 512) { const int k = idx >> 3, e4 = idx & 7; const f32x4 w = *(const f32x4*)(wr_ + k * 32 + e4 * 4);
        Wt[(4 * e4 + 0) * 1024 + k] = w[0]; Wt[(4 * e4 + 1) * 1024 + k] = w[1]; Wt[(4 * e4 + 2) * 1024 + k] = w[2]; Wt[(4 * e4 + 3) * 1024 + k] = w[3]; }
    if (F.tid < 32) cnt[F.tid] = 0;
    __syncthreads();
    int* RT_E = wsp<int>(F, WS_RT_E); int* RT_LP = wsp<int>(F, WS_RT_LP); float* RT_G = wsp<float>(F, WS_RT_G);
    const int e = F.lane & 31;
    const float bre = br[e];
    for (int pr = 0; pr < 8; ++pr) { const int row0 = F.vcu * 128 + F.wave * 16 + 2 * pr, b = row0 / T;
        f32x4 h0[4], h1[4];
        norm_row(F, x1 + (size_t)row0 * D, F.in[21], mod + b * 6144 + 3072, mod + b * 6144 + 4096, wsp<bf16>(F, WS_H) + (size_t)row0 * D, h0);
        norm_row(F, x1 + (size_t)(row0 + 1) * D, F.in[21], mod + b * 6144 + 3072, mod + b * 6144 + 4096, wsp<bf16>(F, WS_H) + (size_t)(row0 + 1) * D, h1);
        float pa0[32], pa1[32];
#pragma unroll
        for (int q = 0; q < 32; ++q) { float s0 = 0.f, s1 = 0.f;
#pragma unroll
            for (int j = 0; j < 4; ++j) { const f32x4 w4 = *(const LAS f32x4*)(Wt + q * 1024 + 4 * F.lane + 256 * j);
                s0 += (h0[j][0] * w4[0] + h0[j][1] * w4[1]) + (h0[j][2] * w4[2] + h0[j][3] * w4[3]);
                s1 += (h1[j][0] * w4[0] + h1[j][1] * w4[1]) + (h1[j][2] * w4[2] + h1[j][3] * w4[3]); }
            pa0[q] = s0; pa1[q] = s1; }
        const float lg0 = reduce32x64(pa0, F.lane) + bre, lg1 = reduce32x64(pa1, F.lane) + bre;
#pragma unroll
        for (int q = 0; q < 2; ++q) { const float logit = q ? lg1 : lg0; const int row = row0 + q; LAS float* lg32 = lgw + q * 64;
            if (F.lane < 32) lg32[e] = logit;
            asm volatile("s_waitcnt lgkmcnt(0)" ::: "memory");
            int rank = 0;
#pragma unroll 8
            for (int o = 0; o < 32; ++o) { const float ov = lg32[o]; rank += (ov > logit || (ov == logit && o < e)) ? 1 : 0; }
            if (F.lane < 32 && rank < 4) lg32[32 + rank] = logit;
            asm volatile("s_waitcnt lgkmcnt(0)" ::: "memory");
            const float t0 = lg32[32], t1 = lg32[33], t2 = lg32[34], t3 = lg32[35];
            const float den = 1.f + __expf(t1 - t0) + __expf(t2 - t0) + __expf(t3 - t0);
            if (F.lane < 32 && rank < 4) { const int lp = atomicAdd((int*)&cnt[e], 1);
                RT_E[row * 4 + rank] = e; RT_LP[row * 4 + rank] = lp; RT_G[row * 4 + rank] = __expf(logit - t0) / den; }
            asm volatile("s_waitcnt lgkmcnt(0)" ::: "memory"); }
    }
    __syncthreads();
    if (F.tid < 32) wsp<int>(F, WS_BLKCNT)[F.vcu * 32 + F.tid] = cnt[F.tid];
}

__device__ __forceinline__ void phase9(const Frame& F) {
    LAS int* base = (LAS int*)F.lds;
    LAS int* tot = base + 32;
    LAS int* pst = base + 64;
    const int* BC = wsp<int>(F, WS_BLKCNT);
    if (F.tid < 32) { int s = 0, mine = 0; for (int bk = 0; bk < F.G; ++bk) { if (bk == F.vcu) mine = s; s += BC[bk * 32 + F.tid]; } base[F.tid] = mine; tot[F.tid] = s; }
    __syncthreads();
    if (F.tid == 0) { int s = 0; for (int e = 0; e < 32; ++e) { pst[e] = s; s += (tot[e] + 255) / 256 * 256; } pst[32] = s; }
    __syncthreads();
    int* SLOT_TOK = wsp<int>(F, WS_SLOTTOK); float* SLOT_GATE = wsp<float>(F, WS_SLOTGATE); int* TOK_SLOT = wsp<int>(F, WS_TOKSLOT);
    const int* RT_E = wsp<int>(F, WS_RT_E); const int* RT_LP = wsp<int>(F, WS_RT_LP); const float* RT_G = wsp<float>(F, WS_RT_G);
    { const int idx = F.vcu * 512 + F.tid;
        const int e = RT_E[idx], slot = pst[e] + base[e] + RT_LP[idx];
        SLOT_TOK[slot] = idx >> 2; SLOT_GATE[slot] = RT_G[idx]; TOK_SLOT[idx] = slot; }
    if (F.vcu < 32) { const int e = F.vcu; for (int s = pst[e] + tot[e] + F.tid; s < pst[e + 1]; s += 512) { SLOT_TOK[s] = 0; SLOT_GATE[s] = 0.f; } }
    if (F.vcu == 0) { unsigned* ctl = wsp<unsigned>(F, WS_CTL);
        if (F.tid == 0) ctl[CW_NTILES] = (unsigned)(pst[32] / 256);
        if (F.tid < 33) ctl[CW_PADSTART + F.tid] = (unsigned)pst[F.tid];
        int* TE = wsp<int>(F, WS_TILEE);
        for (int tl = F.tid; tl < MAX_TILES; tl += 512) { int e = 31; for (int q = 0; q < 32; ++q) if (tl * 256 < pst[q + 1]) { e = q; break; } TE[tl] = e; } }
}

__device__ __forceinline__ void phase12(const Frame& F) {
    const int gw = F.vcu * 8 + F.wave, NGW = F.G * 8;
    const float* mod = wsp<float>(F, WS_MOD); const bf16* YS = wsp<bf16>(F, WS_YS); const int* TOK_SLOT = wsp<int>(F, WS_TOKSLOT);
    for (int row = gw; row < M; row += NGW) { const int b = row / T;
        int sl[4];
#pragma unroll
        for (int k = 0; k < 4; ++k) sl[k] = TOK_SLOT[row * 4 + k];
#pragma unroll
        for (int j = 0; j < 2; ++j) { const int col = 8 * F.lane + 512 * j;
            float a[8];
#pragma unroll
            for (int q = 0; q < 8; ++q) a[q] = 0.f;
#pragma unroll
            for (int k = 0; k < 4; ++k) { const u32x4 v = *(const u32x4*)(YS + (size_t)sl[k] * D + col);
                a[0] += bflo(v.x); a[1] += bfhi(v.x); a[2] += bflo(v.y); a[3] += bfhi(v.y); a[4] += bflo(v.z); a[5] += bfhi(v.z); a[6] += bflo(v.w); a[7] += bfhi(v.w); }
            const float* gp = mod + b * 6144 + 5120 + col;
            const f32x4 g0 = *(const f32x4*)gp, g1 = *(const f32x4*)(gp + 4);
            float* op = F.out + (size_t)row * D + col;
            f32x4 x0 = *(const f32x4*)op, x1v = *(const f32x4*)(op + 4);
            x0[0] += g0[0] * a[0]; x0[1] += g0[1] * a[1]; x0[2] += g0[2] * a[2]; x0[3] += g0[3] * a[3];
            x1v[0] += g1[0] * a[4]; x1v[1] += g1[1] * a[5]; x1v[2] += g1[2] * a[6]; x1v[3] += g1[3] * a[7];
            *(f32x4*)op = x0; *(f32x4*)(op + 4) = x1v; } }
}

__device__ __forceinline__ void copy_x_to_out(const Frame& F) {
    const size_t n4 = (size_t)M * D / 4; const f32x4* s = (const f32x4*)F.in[0]; f32x4* d = (f32x4*)F.out;
    for (size_t i = (size_t)blockIdx.x * 512 + F.tid; i < n4; i += (size_t)gridDim.x * 512) d[i] = s[i];
}


#define XB_TMO      128
#define XB_XCNT(j)  (256  + 64 * (j))
#define XB_XSUB(j)  (1280 + 64 * (j))
#define XB_XGEN(j)  (2304 + 64 * (j))
#define XB_TOP      3328
#define XB_TOPGEN   3392
#define XCD_BAR_WORDS 3456
#define XB_SPIN_CAP (1u << 18)
__device__ __forceinline__ unsigned xb_ld(unsigned* p)              { return __hip_atomic_load(p, __ATOMIC_RELAXED, __HIP_MEMORY_SCOPE_AGENT); }
__device__ __forceinline__ unsigned xb_add(unsigned* p, unsigned v) { return __hip_atomic_fetch_add(p, v, __ATOMIC_RELAXED, __HIP_MEMORY_SCOPE_AGENT); }
__device__ __forceinline__ unsigned xb_xcc_id() { return (unsigned)__builtin_amdgcn_s_getreg((3 << 11) | 20) & 0xFu; }
#define XB_SPIN(cond, bar) do { unsigned _sp = 0; while (cond) { __builtin_amdgcn_s_sleep(1); \
    if ((++_sp & 255u) == 0u) { if (xb_ld(&(bar)[XB_TMO])) break; if (_sp > XB_SPIN_CAP) { atomicAdd(&(bar)[XB_TMO], 1u); break; } } } } while (0)
struct XcdBarrier { unsigned* bar; unsigned x; volatile LAS unsigned* st; };
__device__ __forceinline__ XcdBarrier xcd_barrier_post(unsigned* bar, volatile LAS unsigned* st) {
    XcdBarrier b; b.bar = bar; b.x = xb_xcc_id(); b.st = st;
    if (threadIdx.x == 0) (void)xb_add(&bar[XB_XCNT(b.x)], 1u);
    return b;
}
__device__ __forceinline__ void xcd_barrier_complete(unsigned* bar, unsigned x, unsigned& nloc, unsigned& nx) {
    const unsigned G = gridDim.x * gridDim.y * gridDim.z;
    unsigned sum, cnt, mine, sp = 0u;
    for (;;) {
        sum = 0u; cnt = 0u; mine = 0u;
#pragma unroll
        for (unsigned j = 0; j < 16; ++j) { const unsigned c = xb_ld(&bar[XB_XCNT(j)]); sum += c; cnt += (c > 0u) ? 1u : 0u; mine = (j == x) ? c : mine; }
        if (sum == G) break;
        __builtin_amdgcn_s_sleep(1);
        if ((++sp & 255u) == 0u) { if (xb_ld(&bar[XB_TMO])) break; if (sp > XB_SPIN_CAP) { atomicAdd(&bar[XB_TMO], 1u); break; } }
    }
    nloc = mine > 0u ? mine : 1u; nx = cnt > 0u ? cnt : 1u;
}
__device__ __forceinline__ void xcd_barrier(const XcdBarrier& b) {
    asm volatile("s_waitcnt vmcnt(0)" ::: "memory");
    __syncthreads();
    if (threadIdx.x == 0) {
        unsigned* bar = b.bar;
        __builtin_amdgcn_s_waitcnt(0);
        unsigned nloc = b.st[0], nx = b.st[1];
        if (nloc == 0u) { xcd_barrier_complete(bar, b.x, nloc, nx); b.st[0] = nloc; b.st[1] = nx; }
        const unsigned old = xb_add(&bar[XB_XSUB(b.x)], 1u);
        const unsigned gen = old / nloc;
        if (old + 1u == (gen + 1u) * nloc) {
            __builtin_amdgcn_fence(__ATOMIC_RELEASE, "agent");
            asm volatile("s_waitcnt vmcnt(0)" ::: "memory");
            const unsigned og = xb_add(&bar[XB_TOP], 1u);
            const unsigned tg = og / nx;
            if (og + 1u == (tg + 1u) * nx) xb_add(&bar[XB_TOPGEN], 1u);
            else XB_SPIN(xb_ld(&bar[XB_TOPGEN]) == tg, bar);
            __builtin_amdgcn_fence(__ATOMIC_ACQUIRE, "agent");
            xb_add(&bar[XB_XGEN(b.x)], 1u);
            asm volatile("s_waitcnt vmcnt(0)" ::: "memory");
        } else {
            XB_SPIN(xb_ld(&bar[XB_XGEN(b.x)]) == gen, bar);
            __builtin_amdgcn_fence(__ATOMIC_ACQUIRE, "agent");
            asm volatile("s_waitcnt vmcnt(0)" ::: "memory");
        }
    }
    __syncthreads();
}

struct Args { const float* in[28]; float* out; unsigned char* ws; int ph_lo, ph_hi; };
constexpr int N_PHASES = 13;

__global__ void __launch_bounds__(512, 2) mk_fwd(Args args) {
    extern __shared__ __attribute__((aligned(16))) unsigned char lds_raw[];
    Frame F;
    F.lds = (LAS unsigned char*)lds_raw;
    F.tid = threadIdx.x; F.lane = F.tid & 63; F.wave = __builtin_amdgcn_readfirstlane(F.tid >> 6);
    F.G = gridDim.x; { const int bx = blockIdx.x; F.vcu = (F.G % 8 == 0) ? (bx % 8) * (F.G / 8) + bx / 8 : bx; }
#pragma unroll
    for (int i = 0; i < 28; ++i) F.in[i] = args.in[i];
    F.out = args.out; F.ws = args.ws;
    cg::grid_group grid = cg::this_grid();
    const int lo = args.ph_lo, hi = args.ph_hi;
    volatile LAS unsigned* MISC = (volatile LAS unsigned*)(F.lds + MISC_OFF);
    if (F.tid < 16) MISC[F.tid] = 0u;
    __syncthreads();
    XcdBarrier bar; bar.bar = wsp<unsigned>(F, WS_CTL) + CW_BAR; bar.x = 0; bar.st = MISC;
    if (hi - lo > 1) bar = xcd_barrier_post(wsp<unsigned>(F, WS_CTL) + CW_BAR, MISC);
#define IN(k) (lo <= (k) && (k) < hi)
#define REP(k) for (int rep_ = 0; rep_ < 1 + ((MK_REPEAT_MASK >> (k)) & 1); ++rep_)
#define SEAM(k) do { if (IN(k) && IN((k) + 1)) { if ((MK_CG_SEAMS >> (k)) & 1) grid.sync(); else xcd_barrier(bar); } } while (0)

    if (IN(0)) REP(0) { phase0(F); } SEAM(0);
    if (IN(1)) REP(1) { phase1(F); } SEAM(1);
    if (IN(2)) REP(2) {
        pg8::Gemm g{wsp<bf16>(F, WS_H), wsp<bf16>(F, WS_WIN), D, IN_COLS, nullptr};
        pg8::StaticOrder S; S.init(M, IN_COLS, F.G, (int)blockIdx.x);
        pg8::EpiBf16P E{wsp<bf16>(F, WS_P), IN_COLS};
        pg8::gemm_phase<pg8::EpiBf16P, pg8::StaticOrder, false>(F.lds, g, S, E);
    } SEAM(2);
    if (IN(3)) REP(3) { phase3(F); } SEAM(3);
    if (IN(4)) REP(4) { phase4_scan(F); } SEAM(4);
    if (IN(5)) REP(5) { phase5_attn(F); } SEAM(5);
    if (IN(6)) REP(6) { phase6(F); } SEAM(6);
    if (IN(7)) REP(7) {
#if MK_LAST_PHASE >= 7
        pg8::Gemm g{wsp<bf16>(F, WS_CAT), wsp<bf16>(F, WS_WOUT), D, D, nullptr};
        pg8::StaticOrder S; S.init(M, D, F.G, (int)blockIdx.x);
        pg8::EpiOutProj E{F.in[0], F.out, wsp<float>(F, WS_MOD) + 2048};
        pg8::gemm_phase<pg8::EpiOutProj, pg8::StaticOrder, false>(F.lds, g, S, E);
#else
        copy_x_to_out(F);
#endif
    } SEAM(7);
    if (IN(8)) REP(8) { phase8(F); } SEAM(8);
    if (IN(9)) REP(9) { phase9(F); } SEAM(9);
    if (IN(10)) REP(10) {
        const unsigned* ctl = wsp<unsigned>(F, WS_CTL);
        pg8::Gemm g{wsp<bf16>(F, WS_H), wsp<bf16>(F, WS_W1), D, 2 * DE, wsp<int>(F, WS_SLOTTOK)};
        pg8::MoeOrder S{(int)ctl[CW_NTILES], 8, F.G, F.vcu, wsp<int>(F, WS_TILEE)};
        pg8::EpiMoe1 E{wsp<bf16>(F, WS_ACT), F.in[25]};
        pg8::gemm_phase<pg8::EpiMoe1, pg8::MoeOrder, true>(F.lds, g, S, E);
    } SEAM(10);
    if (IN(11)) REP(11) {
        const unsigned* ctl = wsp<unsigned>(F, WS_CTL);
        pg8::Gemm g{wsp<bf16>(F, WS_ACT), wsp<bf16>(F, WS_W2), DE, D, nullptr};
        pg8::MoeOrder S{(int)ctl[CW_NTILES], 4, F.G, F.vcu, wsp<int>(F, WS_TILEE)};
        pg8::EpiMoe2 E{wsp<bf16>(F, WS_YS), F.in[27], wsp<float>(F, WS_SLOTGATE)};
        pg8::gemm_phase<pg8::EpiMoe2, pg8::MoeOrder, false>(F.lds, g, S, E);
    } SEAM(11);
    if (IN(12)) { phase12(F); }
#undef IN
#undef SEAM
}

extern "C" void kernel_launch(void* const* d_in, const int* in_sizes, int n_in, void* d_out, int out_size, void* d_ws, size_t ws_size, hipStream_t stream) {
    static int grid = 0;
    if (grid == 0) {
        if (n_in != 28 || out_size != M * D || ws_size < WS_END) { fprintf(stderr, "kernel_launch: unexpected sizes (n_in %d out %d ws %zu, need %zu)\n", n_in, out_size, ws_size, (size_t)WS_END); grid = -1; return; }
        int dev = 0, cus = 0, per_cu = 0;
        (void)hipGetDevice(&dev); (void)hipDeviceGetAttribute(&cus, hipDeviceAttributeMultiprocessorCount, dev);
        (void)hipFuncSetAttribute((const void*)mk_fwd, hipFuncAttributeMaxDynamicSharedMemorySize, LDS_BYTES);
        (void)hipOccupancyMaxActiveBlocksPerMultiprocessor(&per_cu, (const void*)mk_fwd, 512, LDS_BYTES);
        if (per_cu < 1 || cus != 256) { fprintf(stderr, "kernel_launch: occupancy %d, CUs %d: this build needs 256 CUs x 1 block\n", per_cu, cus); grid = -1; return; }
        grid = cus;
    }
    if (grid < 0) return;
    (void)hipMemsetAsync((char*)d_ws + WS_CTL, 0, CTL_BYTES, stream);
    Args a{};
    for (int i = 0; i < 28; ++i) a.in[i] = (const float*)d_in[i];
    a.out = (float*)d_out; a.ws = (unsigned char*)d_ws;
    const int last = MK_LAST_PHASE + 1;
#if MK_ONE_LAUNCH
    a.ph_lo = 0; a.ph_hi = last;
#if MK_COOP
    void* kargs[] = {&a};
    hipError_t e = hipLaunchCooperativeKernel((const void*)mk_fwd, dim3(grid), dim3(512), kargs, LDS_BYTES, stream);
    if (e != hipSuccess) fprintf(stderr, "cooperative launch failed: %s\n", hipGetErrorString(e));
#else
    hipLaunchKernelGGL(mk_fwd, dim3(grid), dim3(512), LDS_BYTES, stream, a);
#endif
#else
    for (int p = 0; p < last; ++p) { a.ph_lo = p; a.ph_hi = p + 1; hipLaunchKernelGGL(mk_fwd, dim3(grid), dim3(512), LDS_BYTES, stream, a); }
#endif
}
```

```cpp
#include <hip/hip_runtime.h>
#include <hip/hip_cooperative_groups.h>
#include <cstdio>
#include <cstdint>
namespace cg = cooperative_groups;

#ifndef MK_ONE_LAUNCH
#define MK_ONE_LAUNCH 1
#endif
#ifndef MK_REPEAT_MASK
#define MK_REPEAT_MASK 0
#endif
#ifndef MK_CONV_WHERE
#define MK_CONV_WHERE 9
#endif
#define MK_CONV_IN_SCAN (MK_CONV_WHERE == 4)
#ifndef MK_RWKV_MODE
#define MK_RWKV_MODE 2
#endif
#ifndef MK_FP8
#define MK_FP8 1
#endif
#ifndef MK_REP4
#define MK_REP4 0
#endif
#ifndef MK_CG_SEAMS
#define MK_CG_SEAMS 0
#endif
#ifndef MK_COOP
#define MK_COOP 0
#endif
#ifndef MK_LAST_PHASE
#define MK_LAST_PHASE 12
#endif

constexpr int D = 1024, NBATCH = 8, T = 4096, M = NBATCH * T;
constexpr int HD = 64, RW = 512, RH = 8, AW = 512, QH = 8, KVH = 2, WIN = 128;
constexpr int RWKV_COLS = 1792, IN_COLS = 2560;
constexpr int COL_Q = 1792, COL_K = 1792 + 512, COL_V = 1792 + 512 + 128;
constexpr int NE = 32, TOPK = 4, DE = 1024;
constexpr int MAX_TILES = 544;
constexpr int MAX_SLOTS = MAX_TILES * 256;
constexpr float NORM_EPS = 1e-6f, GN_EPS = 64e-5f;

#define GAS __attribute__((address_space(1)))
#define LAS __attribute__((address_space(3)))
typedef unsigned short bf16;
typedef short bf16x8 __attribute__((ext_vector_type(8)));
typedef float f32x4 __attribute__((ext_vector_type(4)));
typedef float f32x2 __attribute__((ext_vector_type(2)));
typedef float f32x16 __attribute__((ext_vector_type(16)));
typedef unsigned u32x4 __attribute__((ext_vector_type(4)));
typedef unsigned u32x2 __attribute__((ext_vector_type(2)));
typedef int i32x8 __attribute__((ext_vector_type(8)));
typedef int i32x4 __attribute__((ext_vector_type(4)));

constexpr size_t MiB = 1u << 20;
constexpr size_t WS_CTL = 0, CTL_BYTES = 64 * 1024;
constexpr size_t WS_MOD = 1 * MiB;
constexpr size_t WS_BON = 1 * MiB + 256 * 1024;
constexpr size_t WS_RT_E = 2 * MiB;
constexpr size_t WS_RT_LP = 2 * MiB + 512 * 1024;
constexpr size_t WS_RT_G = 3 * MiB;
constexpr size_t WS_TOKSLOT = 3 * MiB + 512 * 1024;
constexpr size_t WS_SLOTTOK = 4 * MiB;
constexpr size_t WS_SLOTGATE = 5 * MiB;
constexpr size_t WS_BLKCNT = 6 * MiB;
constexpr size_t WS_TILEE = 6 * MiB + 64 * 1024;
constexpr size_t WS_BONUS = 7 * MiB;
constexpr size_t WS_LW = 9 * MiB;
constexpr size_t WS_WIN = 10 * MiB;
constexpr size_t WS_WOUT = 16 * MiB;
constexpr size_t WS_W1 = 20 * MiB;
constexpr size_t WS_W2 = 148 * MiB;
constexpr size_t WS_H = 212 * MiB;
constexpr size_t WS_R2 = 276 * MiB;
constexpr size_t WS_P = WS_R2;
constexpr size_t WS_SCN = WS_R2 + 160 * MiB;
constexpr size_t WS_SV = WS_SCN + 320 * MiB;
constexpr size_t WS_G = WS_SV + 64 * MiB;
constexpr size_t WS_Y = WS_G + 32 * MiB;
constexpr size_t WS_CAT = WS_Y + 64 * MiB;
constexpr size_t WS_ACT = WS_R2;
constexpr size_t WS_YS = WS_R2 + 272 * MiB;
constexpr size_t WS_END = 1012 * MiB;
constexpr size_t WS_PT = 20 * MiB;
constexpr size_t WS_ZV = 84 * MiB;
constexpr size_t WS_Z0 = 212 * MiB;
constexpr size_t WS_RYT = 980 * MiB;
constexpr size_t WS_YVT = WS_Y;
static_assert(WS_END <= 1024 * MiB, "workspace map");
static_assert(WS_YS + 272 * MiB <= WS_CAT, "YS must not overlay CAT");
constexpr int CW_NTILES = 16;
constexpr int CW_PADSTART = 64;
constexpr int CW_BAR = 4096;
constexpr int MISC_OFF = 156 * 1024 - 64;

constexpr int LDS_BYTES = 156 * 1024;

__device__ __forceinline__ unsigned f2bf(float f) { unsigned u = __builtin_bit_cast(unsigned, f); return (u + 0x7fffu + ((u >> 16) & 1u)) >> 16; }
typedef __bf16 bf16x2_t __attribute__((ext_vector_type(2)));
__device__ __forceinline__ unsigned pk2(float lo, float hi) { const f32x2 v = {lo, hi}; return __builtin_bit_cast(unsigned, __builtin_convertvector(v, bf16x2_t)); }
__device__ __forceinline__ float bf2f(unsigned short b) { return __builtin_bit_cast(float, ((unsigned)b) << 16); }
__device__ __forceinline__ float bflo(unsigned u) { return __builtin_bit_cast(float, u << 16); }
__device__ __forceinline__ float bfhi(unsigned u) { return __builtin_bit_cast(float, u & 0xffff0000u); }
__device__ __forceinline__ float wave_sum(float v) {
#pragma unroll
    for (int o = 1; o < 64; o <<= 1) v += __shfl_xor(v, o);
    return v;
}
__device__ __forceinline__ float sigmoidf_(float x) { return 1.f / (1.f + __expf(-x)); }

namespace pg8 {
#define PG8_LAS __attribute__((address_space(3)))
constexpr int BM = 256, BK = 64, HALF = 128, HTB = HALF * BK * 2, STAGE_BYTES = 8 * HTB, NXCD = 8, WGM = 8;
__host__ __device__ __forceinline__ int lds_byte(int r, int c) { const int st = (r >> 4) * 2 + (c >> 5), rr = r & 15, cc = c & 31, ob = rr * 64 + cc * 2; return st * 1024 + (ob ^ (((ob >> 9) & 1) << 5)); }
__host__ __device__ __forceinline__ void stage_rc(int b, int& R, int& C) { const int st = b / 1024, sb = b % 1024, swz = sb ^ (((sb >> 9) & 1) << 5); R = (st >> 1) * 16 + swz / 64; C = (st & 1) * 32 + (swz % 64) / 2; }

struct Unit { int pm, pn, e; };
struct Gemm { const bf16* A; const bf16* Bt; int K, N; const int* rowmap; };

struct StaticOrder {
    int nM, nN, nwg, G, c;
    __device__ void init(int M_, int N_, int G_, int c_) { nM = M_ / BM; nN = N_ / BM; nwg = nM * nN; G = G_; c = c_; }
    __device__ bool next(int i, Unit& u) const {
        const long L = (long)i * G + c; if (L >= nwg) return false;
        int wgid = (int)L; { const int q = nwg / NXCD, r = nwg % NXCD, xcd = wgid % NXCD, off = wgid / NXCD; wgid = (xcd < r ? xcd * (q + 1) : r * (q + 1) + (xcd - r) * q) + off; }
        const int nig = WGM * nN, gid = wgid / nig, fm = gid * WGM, gsz = (nM - fm) < WGM ? (nM - fm) : WGM;
        u.pm = fm + ((wgid % nig) % gsz); u.pn = (wgid % nig) / gsz; u.e = 0; return true;
    }
};
struct MoeOrder {
    int nMt, nN, G, c; const int* tile_e;
    __device__ bool next(int i, Unit& u) const {
        const long L = (long)i * G + c; if (L >= (long)nMt * nN) return false;
        u.pm = (int)(L / nN); u.pn = (int)(L % nN); u.e = tile_e[u.pm]; return true;
    }
};

__device__ __forceinline__ unsigned cvt_pk_bf16(float lo, float hi) { unsigned r; asm volatile("v_cvt_pk_bf16_f32 %0, %1, %2" : "=v"(r) : "v"(lo), "v"(hi)); return r; }

struct EpiBf16P {
    bf16* O; int ldc;
    __device__ __forceinline__ void operator()(const f32x4 (&acc)[2][2][4][2], const Unit& u, int wr, int wc, int fr, int fq) const {
        const int row0 = u.pm * BM + wr * 64 + fr, col0 = u.pn * BM + wc * 32 + 8 * fq;
#pragma unroll
        for (int ai = 0; ai < 2; ++ai)
#pragma unroll
            for (int m = 0; m < 4; ++m) { bf16* rowp = O + (size_t)(row0 + ai * HALF + m * 16) * ldc + col0;
#pragma unroll
                for (int bj = 0; bj < 2; ++bj) { const f32x4 v0 = acc[ai][bj][m][0], v1 = acc[ai][bj][m][1];
                    u32x4 w; w.x = cvt_pk_bf16(v0[0], v0[1]); w.y = cvt_pk_bf16(v0[2], v0[3]); w.z = cvt_pk_bf16(v1[0], v1[1]); w.w = cvt_pk_bf16(v1[2], v1[3]);
                    *(u32x4*)(rowp + bj * HALF) = w; } }
    }
};
struct EpiOutProj {
    const float* x; float* out; const float* gate;
    __device__ __forceinline__ void operator()(const f32x4 (&acc)[2][2][4][2], const Unit& u, int wr, int wc, int fr, int fq) const {
        const int row0 = u.pm * BM + wr * 64 + fr, col0 = u.pn * BM + wc * 32 + 4 * fq;
        const int b = (u.pm * BM) / T;
        f32x4 gv[2][2];
#pragma unroll
        for (int bj = 0; bj < 2; ++bj)
#pragma unroll
            for (int n = 0; n < 2; ++n) gv[bj][n] = *(const f32x4*)(gate + (size_t)b * 6144 + col0 + bj * HALF + n * 16);
#pragma unroll
        for (int ai = 0; ai < 2; ++ai)
#pragma unroll
            for (int m = 0; m < 4; ++m) { const size_t ro = (size_t)(row0 + ai * HALF + m * 16) * D + col0;
#pragma unroll
                for (int bj = 0; bj < 2; ++bj)
#pragma unroll
                    for (int n = 0; n < 2; ++n) { const f32x4 xv = *(const f32x4*)(x + ro + bj * HALF + n * 16);
                        *(f32x4*)(out + ro + bj * HALF + n * 16) = xv + gv[bj][n] * acc[ai][bj][m][n]; } }
    }
};
__device__ __forceinline__ unsigned pk4_fp8(float a, float b, float c, float d) { int w = 0; w = __builtin_amdgcn_cvt_pk_fp8_f32(a, b, w, false); w = __builtin_amdgcn_cvt_pk_fp8_f32(c, d, w, true); return (unsigned)w; }
constexpr float W8_SCALE = 32.f, W8_INV = 1.f / 32.f;
struct EpiMoe1 {
    unsigned char* act; const float* b1;
    __device__ __forceinline__ void operator()(const f32x4 (&acc)[2][2][4][2], const Unit& u, int wr, int wc, int fr, int fq) const {
        const int row0 = u.pm * BM + wr * 64 + fr, j0 = u.pn * 128 + wc * 16 + 4 * fq;
        const float* bb = b1 + (size_t)u.e * 2048;
        f32x4 bg[2], bl[2];
#pragma unroll
        for (int bj = 0; bj < 2; ++bj) { bg[bj] = *(const f32x4*)(bb + j0 + bj * 64); bl[bj] = *(const f32x4*)(bb + 1024 + j0 + bj * 64); }
#pragma unroll
        for (int ai = 0; ai < 2; ++ai)
#pragma unroll
            for (int m = 0; m < 4; ++m) { unsigned char* rowp = act + ((size_t)(row0 + ai * HALF + m * 16) * DE + j0) * (MK_FP8 ? 1 : 2);
#pragma unroll
                for (int bj = 0; bj < 2; ++bj) { const f32x4 g4 = acc[ai][bj][m][0] * (MK_FP8 ? W8_INV : 1.f) + bg[bj], l4 = acc[ai][bj][m][1] * (MK_FP8 ? W8_INV : 1.f) + bl[bj]; float a[4];
#pragma unroll
                    for (int q = 0; q < 4; ++q) { const float gl = fminf(g4[q], 7.0f), li = fminf(fmaxf(l4[q], -7.0f), 7.0f);
                        a[q] = gl * (1.f / (1.f + __expf(-1.702f * gl))) * (li + 1.f); }
#if MK_FP8
                    *(unsigned*)(rowp + bj * 64) = pk4_fp8(a[0], a[1], a[2], a[3]);
#else
                    u32x2 w; w.x = cvt_pk_bf16(a[0], a[1]); w.y = cvt_pk_bf16(a[2], a[3]); *(u32x2*)(rowp + bj * 128) = w;
#endif
                } }
    }
};
struct EpiMoe2 {
    bf16* ys; const float* b2; const float* sgate;
    __device__ __forceinline__ void operator()(const f32x4 (&acc)[2][2][4][2], const Unit& u, int wr, int wc, int fr, int fq) const {
        const int row0 = u.pm * BM + wr * 64 + fr, col0 = u.pn * BM + wc * 32 + 8 * fq;
        const float* bb = b2 + (size_t)u.e * 1024;
        f32x4 bv[2][2];
#pragma unroll
        for (int bj = 0; bj < 2; ++bj)
#pragma unroll
            for (int n = 0; n < 2; ++n) bv[bj][n] = *(const f32x4*)(bb + col0 + bj * HALF + 4 * n);
#pragma unroll
        for (int ai = 0; ai < 2; ++ai)
#pragma unroll
            for (int m = 0; m < 4; ++m) { const int row = row0 + ai * HALF + m * 16; const float gt = sgate[row]; bf16* rowp = ys + (size_t)row * D + col0;
#pragma unroll
                for (int bj = 0; bj < 2; ++bj) { const f32x4 v0 = (acc[ai][bj][m][0] * (MK_FP8 ? W8_INV : 1.f) + bv[bj][0]) * gt, v1 = (acc[ai][bj][m][1] * (MK_FP8 ? W8_INV : 1.f) + bv[bj][1]) * gt;
                    u32x4 w; w.x = cvt_pk_bf16(v0[0], v0[1]); w.y = cvt_pk_bf16(v0[2], v0[3]); w.z = cvt_pk_bf16(v1[0], v1[1]); w.w = cvt_pk_bf16(v1[2], v1[3]);
                    *(u32x4*)(rowp + bj * HALF) = w; } }
    }
};

template <class Epi, class Sched, bool GATHER, bool FP8 = false>
__device__ __forceinline__ void gemm_phase(PG8_LAS unsigned char* lds, const Gemm g, const Sched& S, const Epi& E) {
    const int tid = threadIdx.x, wid = __builtin_amdgcn_readfirstlane(tid >> 6), lane = tid & 63, wr = wid >> 2, wc = wid & 3, fr = lane & 15, fq = lane >> 4;
    const int K = g.K, nt = K / BK;
    int Rr[2], Cc[2]; unsigned voffB[2];
#pragma unroll
    for (int i = 0; i < 2; ++i) { stage_rc(tid * 16 + i * 8192, Rr[i], Cc[i]); voffB[i] = (unsigned)(Rr[i] * K + Cc[i]) * 2u; }
    const size_t kstep = (size_t)(BK * 2);
    const size_t hstep = (size_t)HALF * K * 2;
    const size_t tstep = 2 * hstep;
    const unsigned ldsw = (unsigned)wid * 1024u;
    const int aoff = lds_byte(wr * 64 + fr, fq * 8), boff = lds_byte(wc * 32 + fr, fq * 8);
#define PG8_SA(b, h) (((b) * 2 + (h)) * HTB)
#define PG8_SB(b, h) ((4 + (b) * 2 + (h)) * HTB)
#define PG8_STAGE(bufoff, gbase, voff) do { _Pragma("unroll") for (int _i = 0; _i < 2; ++_i) \
        __builtin_amdgcn_global_load_lds((const unsigned*)((const char*)(gbase) + (voff)[_i]), (PG8_LAS unsigned*)(lds + (bufoff) + ldsw + _i * 8192), 16, 0, 0); } while (0)
#define PG8_LDA(dst, b, h) do { _Pragma("unroll") for (int m = 0; m < 4; ++m) { const PG8_LAS i32x4* _p = (const PG8_LAS i32x4*)(lds + PG8_SA(b, h) + aoff + m * 2048); \
        dst[m] = __builtin_shufflevector(_p[0], _p[64], 0, 1, 2, 3, 4, 5, 6, 7); } } while (0)
#define PG8_LDB(dst, b, h) do { _Pragma("unroll") for (int n = 0; n < 2; ++n) { const PG8_LAS i32x4* _p = (const PG8_LAS i32x4*)(lds + PG8_SB(b, h) + boff + n * 2048); \
        dst[n] = __builtin_shufflevector(_p[0], _p[64], 0, 1, 2, 3, 4, 5, 6, 7); } } while (0)
#define PG8_MMA(ai, bj, At, Bt) do { __builtin_amdgcn_s_setprio(1); _Pragma("unroll") for (int m = 0; m < 4; ++m) _Pragma("unroll") for (int n = 0; n < 2; ++n) { \
        if constexpr (FP8)   \
            asm volatile("v_mfma_scale_f32_16x16x128_f8f6f4 %0, %1, %2, %0, %3, %3 op_sel_hi:[0,0,0]" : "+v"(acc[ai][bj][m][n]) : "v"(Bt[n]), "v"(At[m]), "v"(0x7F7F7F7F)); \
        else { acc[ai][bj][m][n] = __builtin_amdgcn_mfma_f32_16x16x32_bf16(__builtin_bit_cast(bf16x8, __builtin_shufflevector(Bt[n], Bt[n], 0, 1, 2, 3)), __builtin_bit_cast(bf16x8, __builtin_shufflevector(At[m], At[m], 0, 1, 2, 3)), acc[ai][bj][m][n], 0, 0, 0); \
               acc[ai][bj][m][n] = __builtin_amdgcn_mfma_f32_16x16x32_bf16(__builtin_bit_cast(bf16x8, __builtin_shufflevector(Bt[n], Bt[n], 4, 5, 6, 7)), __builtin_bit_cast(bf16x8, __builtin_shufflevector(At[m], At[m], 4, 5, 6, 7)), acc[ai][bj][m][n], 0, 0, 0); } } \
        __builtin_amdgcn_s_setprio(0); \
        if constexpr (FP8) asm volatile("" : "+v"(acc[ai][bj][0][0]), "+v"(acc[ai][bj][0][1]), "+v"(acc[ai][bj][1][0]), "+v"(acc[ai][bj][1][1]), "+v"(acc[ai][bj][2][0]), "+v"(acc[ai][bj][2][1]), "+v"(acc[ai][bj][3][0]), "+v"(acc[ai][bj][3][1]));   \
        } while (0)
#define PG8_WAIT_V(n) asm volatile("s_waitcnt vmcnt(" #n ")" ::: "memory")
#define PG8_WAIT_L(n) asm volatile("s_waitcnt lgkmcnt(" #n ")" ::: "memory")
#define PG8_BAR __builtin_amdgcn_s_barrier()
#define PG8_SCHED __builtin_amdgcn_sched_barrier(0)
#define PG8_AOFFS(dst, u) do { _Pragma("unroll") for (int _h = 0; _h < 2; ++_h) _Pragma("unroll") for (int _i = 0; _i < 2; ++_i) { int _R, _C; stage_rc((int)threadIdx.x * 16 + _i * 8192, _R, _C); \
        if constexpr (GATHER) { const int _tok = g.rowmap[(u).pm * BM + _h * HALF + _R]; dst[_h][_i] = (unsigned)(_tok * K + _C) * 2u; } \
        else dst[_h][_i] = (unsigned)((_h * HALF + _R) * K + _C) * 2u; } } while (0)
#define PG8_ABASE(u) (GATHER ? (const char*)g.A : (const char*)g.A + (size_t)(u).pm * tstep)
#define PG8_BBASE(u) ((const char*)g.Bt + ((size_t)(u).e * g.N + (size_t)(u).pn * BM) * K * 2)
    Unit cur, nxt, nn; int ui = 0;
    if (!S.next(0, cur)) return;
    bool has_next = S.next(1, nxt);
    unsigned curA[2][2], nxtA[2][2];
    PG8_AOFFS(curA, cur);
    if (has_next) PG8_AOFFS(nxtA, nxt); else {
#pragma unroll
        for (int h = 0; h < 2; ++h)
#pragma unroll
            for (int i = 0; i < 2; ++i) nxtA[h][i] = curA[h][i]; }
    f32x4 acc[2][2][4][2];
#pragma unroll
    for (int a = 0; a < 2; ++a)
#pragma unroll
        for (int b = 0; b < 2; ++b)
#pragma unroll
            for (int m = 0; m < 4; ++m)
#pragma unroll
                for (int n = 0; n < 2; ++n) acc[a][b][m][n] = (f32x4){0.f, 0.f, 0.f, 0.f};
    i32x8 At[4], B0[2], B1[2];
    const char* cA = PG8_ABASE(cur); const char* cB = PG8_BBASE(cur);
    PG8_STAGE(PG8_SB(0, 0), cB, voffB); PG8_STAGE(PG8_SB(0, 1), cB + hstep, voffB); PG8_STAGE(PG8_SA(0, 0), cA, curA[0]); PG8_STAGE(PG8_SA(0, 1), cA, curA[1]);
    if (wr == 1) PG8_BAR;
    PG8_WAIT_V(2); PG8_BAR;
    PG8_STAGE(PG8_SB(1, 0), cB + kstep, voffB); PG8_STAGE(PG8_SA(1, 0), cA + kstep, curA[0]); PG8_STAGE(PG8_SB(1, 1), cB + hstep + kstep, voffB);
    PG8_WAIT_V(6); PG8_BAR;
    for (;;) {
        const char* nA = has_next ? PG8_ABASE(nxt) : cA; const char* nB = has_next ? PG8_BBASE(nxt) : cB;
#pragma unroll 1
        for (int t = 0; t < nt; t += 2) {
            const bool last = (t == nt - 2);
            const char* a1 = cA + (size_t)(t + 1) * kstep;
            const char* a2 = last ? nA : cA + (size_t)(t + 2) * kstep; const char* b2 = last ? nB : cB + (size_t)(t + 2) * kstep;
            const char* a3 = a2 + kstep; const char* b3 = b2 + kstep;
            unsigned o2[2][2];
#pragma unroll
            for (int h = 0; h < 2; ++h)
#pragma unroll
                for (int i = 0; i < 2; ++i) o2[h][i] = last ? nxtA[h][i] : curA[h][i];
            PG8_LDB(B0, 0, 0); PG8_LDB(B1, 0, 1); PG8_SCHED; PG8_LDA(At, 0, 0); PG8_STAGE(PG8_SA(1, 1), a1, curA[1]);
            PG8_WAIT_V(8); PG8_WAIT_L(0); PG8_BAR; PG8_MMA(0, 0, At, B0); PG8_MMA(0, 1, At, B1); PG8_BAR; PG8_SCHED;
            PG8_LDA(At, 0, 1); PG8_STAGE(PG8_SB(0, 0), b2, voffB); PG8_STAGE(PG8_SB(0, 1), b2 + hstep, voffB); PG8_STAGE(PG8_SA(0, 0), a2, o2[0]);
            PG8_WAIT_V(8); PG8_WAIT_L(0); PG8_BAR; PG8_MMA(1, 0, At, B0); PG8_MMA(1, 1, At, B1); PG8_BAR; PG8_SCHED;
            PG8_LDB(B0, 1, 0); PG8_LDB(B1, 1, 1); PG8_SCHED; PG8_LDA(At, 1, 0); PG8_STAGE(PG8_SA(0, 1), a2, o2[1]);
            PG8_WAIT_V(8); PG8_WAIT_L(0); PG8_BAR; PG8_MMA(0, 0, At, B0); PG8_MMA(0, 1, At, B1); PG8_BAR; PG8_SCHED;
            PG8_LDA(At, 1, 1); PG8_STAGE(PG8_SB(1, 0), b3, voffB); PG8_STAGE(PG8_SB(1, 1), b3 + hstep, voffB); PG8_STAGE(PG8_SA(1, 0), a3, o2[0]);
            PG8_WAIT_V(8); PG8_WAIT_L(0); PG8_BAR; PG8_MMA(1, 0, At, B0); PG8_MMA(1, 1, At, B1); PG8_BAR; PG8_SCHED;
        }
        if constexpr (FP8) asm volatile("s_nop 15\n\ts_nop 15" ::: "memory");
        if (wr == 0) PG8_BAR;
        const bool has_nn = has_next && S.next(ui + 2, nn);
        unsigned nnA[2][2];
        if (has_nn) PG8_AOFFS(nnA, nn);
        E(acc, cur, wr, wc, fr, fq);
        if (!has_next) break;
#pragma unroll
        for (int a = 0; a < 2; ++a)
#pragma unroll
            for (int b = 0; b < 2; ++b)
#pragma unroll
                for (int m = 0; m < 4; ++m)
#pragma unroll
                    for (int n = 0; n < 2; ++n) acc[a][b][m][n] = (f32x4){0.f, 0.f, 0.f, 0.f};
        cur = nxt; cA = nA; cB = nB; ++ui;
#pragma unroll
        for (int h = 0; h < 2; ++h)
#pragma unroll
            for (int i = 0; i < 2; ++i) { curA[h][i] = nxtA[h][i]; if (has_nn) nxtA[h][i] = nnA[h][i]; }
        nxt = nn; has_next = has_nn;
        if (wr == 1) PG8_BAR;
    }
    PG8_WAIT_V(0);
    PG8_BAR;
#undef PG8_SA
#undef PG8_SB
#undef PG8_STAGE
#undef PG8_LDA
#undef PG8_LDB
#undef PG8_MMA
#undef PG8_WAIT_V
#undef PG8_WAIT_L
#undef PG8_BAR
#undef PG8_SCHED
#undef PG8_AOFFS
#undef PG8_ABASE
#undef PG8_BBASE
}
}

struct Frame {
    LAS unsigned char* lds;
    int tid, lane, wave, vcu, G;
    const float* const* in;
    float* out;
    unsigned char* ws;
};
template <class Tp> __device__ __forceinline__ Tp* wsp(const Frame& F, size_t off) { return (Tp*)(F.ws + off); }

__device__ __forceinline__ int dest_row(int mode, int s) {
    if (mode == 0) return s;
    if (mode == 1) return (s & ~31) | (((s >> 2) & 1) << 4) | (((s >> 3) & 3) << 2) | (s & 3);
    const int half = s >> 10, j = s & 1023;
    return ((j >> 7) << 8) | (((j >> 6) & 1) << 7) | (((j >> 4) & 3) << 5) | (half << 4) | (j & 15);
}
__device__ __forceinline__ void transpose_item(const float* W, int K, int N, bf16* WT, int mode, int item, int lane) {
    const int nblk = N / 64, kb = item / nblk, nb = item % nblk, k0 = 64 * kb, n0 = 64 * nb;
    const float* src = W + (size_t)k0 * N + n0 + lane;
    float v[64];
#pragma unroll
    for (int i = 0; i < 64; ++i) v[i] = src[(size_t)i * N];
    bf16* dst = WT + (size_t)dest_row(mode, n0 + lane) * K + k0;
#pragma unroll
    for (int j = 0; j < 8; ++j) { u32x4 o; o.x = pk2(v[8 * j], v[8 * j + 1]); o.y = pk2(v[8 * j + 2], v[8 * j + 3]); o.z = pk2(v[8 * j + 4], v[8 * j + 5]); o.w = pk2(v[8 * j + 6], v[8 * j + 7]);
        *(u32x4*)(dst + 8 * j) = o; }
}
__device__ __forceinline__ void transpose_item8(const float* W, int K, int N, unsigned char* WT, int mode, int item, int lane) {
    const int nblk = N / 64, kb = item / nblk, nb = item % nblk, k0 = 64 * kb, n0 = 64 * nb;
    const float* src = W + (size_t)k0 * N + n0 + lane;
    float v[64];
#pragma unroll
    for (int i = 0; i < 64; ++i) v[i] = src[(size_t)i * N] * 32.f;
    unsigned char* dst = WT + (size_t)dest_row(mode, n0 + lane) * K + k0;
#pragma unroll
    for (int j = 0; j < 4; ++j) { u32x4 o; o.x = pg8::pk4_fp8(v[16 * j], v[16 * j + 1], v[16 * j + 2], v[16 * j + 3]); o.y = pg8::pk4_fp8(v[16 * j + 4], v[16 * j + 5], v[16 * j + 6], v[16 * j + 7]);
        o.z = pg8::pk4_fp8(v[16 * j + 8], v[16 * j + 9], v[16 * j + 10], v[16 * j + 11]); o.w = pg8::pk4_fp8(v[16 * j + 12], v[16 * j + 13], v[16 * j + 14], v[16 * j + 15]);
        *(u32x4*)(dst + 16 * j) = o; }
}
constexpr int MOE_I1 = 16 * 32, MOE_I2 = 16 * 16, MOE_ITEMS = NE * (MOE_I1 + MOE_I2);
__device__ __forceinline__ void moe_weight_item(const Frame& F, int it) {
#if !MK_FP8
    if (it < NE * MOE_I1) { const int e = it / MOE_I1; transpose_item(F.in[24] + (size_t)e * 1024 * 2048, 1024, 2048, wsp<bf16>(F, WS_W1) + (size_t)e * 2048 * 1024, 2, it % MOE_I1, F.lane); }
    else { const int r = it - NE * MOE_I1, e = r / MOE_I2; transpose_item(F.in[26] + (size_t)e * 1024 * 1024, 1024, 1024, wsp<bf16>(F, WS_W2) + (size_t)e * 1024 * 1024, 1, r % MOE_I2, F.lane); }
#else
    if (it < NE * MOE_I1) { const int e = it / MOE_I1; transpose_item8(F.in[24] + (size_t)e * 1024 * 2048, 1024, 2048, wsp<unsigned char>(F, WS_W1) + (size_t)e * 2048 * 1024, 2, it % MOE_I1, F.lane); }
    else { const int r = it - NE * MOE_I1, e = r / MOE_I2; transpose_item8(F.in[26] + (size_t)e * 1024 * 1024, 1024, 1024, wsp<unsigned char>(F, WS_W2) + (size_t)e * 1024 * 1024, 1, r % MOE_I2, F.lane); }
#endif
}

__device__ __forceinline__ void phase0(const Frame& F) {
    if (F.vcu < 192) {
        LAS float* sl = (LAS float*)F.lds;
        LAS float* red = (LAS float*)(F.lds + 32768);
        const float* c = F.in[1];
        for (int idx = F.tid; idx < 8192; idx += 512) { const int b = idx & 7, k = idx >> 3; const float cv = c[b * 1024 + k]; sl[idx] = cv / (1.f + __expf(-cv)); }
        __syncthreads();
        const int cl = F.tid & 31, ks = F.tid >> 5, col = F.vcu * 32 + cl;
        const float* wa = F.in[2];
        float acc[8];
#pragma unroll
        for (int b = 0; b < 8; ++b) acc[b] = 0.f;
#pragma unroll 4
        for (int kk = 0; kk < 64; ++kk) { const int k = ks * 64 + kk; const float w = wa[(size_t)k * 6144 + col];
            const f32x4 s0 = *(const LAS f32x4*)(sl + k * 8), s1 = *(const LAS f32x4*)(sl + k * 8 + 4);
            acc[0] += s0[0] * w; acc[1] += s0[1] * w; acc[2] += s0[2] * w; acc[3] += s0[3] * w;
            acc[4] += s1[0] * w; acc[5] += s1[1] * w; acc[6] += s1[2] * w; acc[7] += s1[3] * w; }
#pragma unroll
        for (int b = 0; b < 8; ++b) red[(ks * 32 + cl) * 8 + b] = acc[b];
        __syncthreads();
        if (F.tid < 256) { const int b = F.tid >> 5; float s = F.in[3][col];
            for (int q = 0; q < 16; ++q) s += red[(q * 32 + cl) * 8 + b];
            wsp<float>(F, WS_MOD)[b * 6144 + col] = s; }
    }
    const int gw = F.vcu * 8 + F.wave, NGW = F.G * 8;
    constexpr int I_IN = 16 * 40, I_OUT = 16 * 16;
    constexpr int NITEMS = I_IN + I_OUT;
    for (int it = gw; it < NITEMS; it += NGW) {
        int r = it;
        if (r < I_IN) { transpose_item(F.in[5], 1024, 2560, wsp<bf16>(F, WS_WIN), 1, r, F.lane); continue; } r -= I_IN;
        transpose_item(F.in[20], 1024, 1024, wsp<bf16>(F, WS_WOUT), 0, r, F.lane);
    }
#if MK_CONV_WHERE == 0
    for (int it = gw; it < MOE_ITEMS; it += NGW) moe_weight_item(F, it);
#endif
    { bf16* LW = wsp<bf16>(F, WS_LW);
        for (int idx = F.vcu * 512 + F.tid; idx < 256 * 512; idx += F.G * 512) { const int k = idx >> 9, c = idx & 511;
            const float v = k < 64 ? F.in[8][k * 512 + c] : (k < 128 ? F.in[10][(k - 64) * 512 + c] : F.in[11][(k - 128) * 512 + c]);
            LW[c * 256 + k] = (bf16)f2bf(v); } }
}
template <bool OUT8 = false>
__device__ __forceinline__ void norm_row(const Frame& F, const float* xrow, const float* g, const float* shift, const float* scale, bf16* orow, f32x4 (&h)[4]) {
    const f32x4* xr = (const f32x4*)xrow + F.lane;
    float ss = 0.f;
#pragma unroll
    for (int j = 0; j < 4; ++j) { h[j] = xr[64 * j]; ss += (h[j][0] * h[j][0] + h[j][1] * h[j][1]) + (h[j][2] * h[j][2] + h[j][3] * h[j][3]); }
    const float rstd = rsqrtf(wave_sum(ss) * (1.f / D) + NORM_EPS);
    u32x2* o8 = (u32x2*)orow + F.lane;
#pragma unroll
    for (int j = 0; j < 4; ++j) { const int col = 4 * F.lane + 256 * j;
        const f32x4 gv = *(const f32x4*)(g + col), sh = *(const f32x4*)(shift + col), sc = *(const f32x4*)(scale + col);
        h[j] = h[j] * rstd * gv * (sc + 1.f) + sh;
        if constexpr (OUT8) ((unsigned*)orow)[F.lane + 64 * j] = pg8::pk4_fp8(h[j][0], h[j][1], h[j][2], h[j][3]);
        else { u32x2 w; w.x = pk2(h[j][0], h[j][1]); w.y = pk2(h[j][2], h[j][3]); o8[64 * j] = w; } }
}
__device__ __forceinline__ void phase1(const Frame& F) {
    const int gw = F.vcu * 8 + F.wave, NGW = F.G * 8;
    const float* mod = wsp<float>(F, WS_MOD);
    for (int row = gw; row < M; row += NGW) { const int b = row / T; f32x4 h[4];
        norm_row(F, F.in[0] + (size_t)row * D, F.in[4], mod + b * 6144, mod + b * 6144 + 1024, wsp<bf16>(F, WS_H) + (size_t)row * D, h); }
}

template <int CTRL> __device__ __forceinline__ float dpp_mov(float v) { return __builtin_bit_cast(float, __builtin_amdgcn_update_dpp(0, __builtin_bit_cast(int, v), CTRL, 0xf, 0xf, false)); }
__device__ __forceinline__ float reduce16(float v) { v += dpp_mov<0xB1>(v); v += dpp_mov<0x4E>(v); v += dpp_mov<0x141>(v); v += dpp_mov<0x140>(v); return v; }
__device__ __forceinline__ void lerp8(const bf16* P, const float* mu, int tok, int t, int col, float (&x)[8]) {
    const u32x4 c = *(const u32x4*)(P + (size_t)tok * IN_COLS + col);
    u32x4 p = (u32x4){0u, 0u, 0u, 0u};
    if (t > 0) p = *(const u32x4*)(P + (size_t)(tok - 1) * IN_COLS + col);
    const f32x4 m0 = *(const f32x4*)(mu + col), m1 = *(const f32x4*)(mu + col + 4);
    const float cf[8] = {bflo(c.x), bfhi(c.x), bflo(c.y), bfhi(c.y), bflo(c.z), bfhi(c.z), bflo(c.w), bfhi(c.w)};
    const float pf[8] = {bflo(p.x), bfhi(p.x), bflo(p.y), bfhi(p.y), bflo(p.z), bfhi(p.z), bflo(p.w), bfhi(p.w)};
    const float mf[8] = {m0[0], m0[1], m0[2], m0[3], m1[0], m1[1], m1[2], m1[3]};
#pragma unroll
    for (int j = 0; j < 8; ++j) x[j] = cf[j] + (pf[j] - cf[j]) * mf[j];
}
__device__ __forceinline__ f32x4 lerp4(const bf16* P, const float* mu, int tok, int t, int col) {
    const u32x2 c = *(const u32x2*)(P + (size_t)tok * IN_COLS + col);
    u32x2 p = (u32x2){0u, 0u};
    if (t > 0) p = *(const u32x2*)(P + (size_t)(tok - 1) * IN_COLS + col);
    const f32x4 m = *(const f32x4*)(mu + col);
    const f32x4 cf = (f32x4){bflo(c.x), bfhi(c.x), bflo(c.y), bfhi(c.y)}, pf = (f32x4){bflo(p.x), bfhi(p.x), bflo(p.y), bfhi(p.y)};
    return cf + (pf - cf) * m;
}
__device__ __forceinline__ bf16x8 pack8(const float (&x)[8]) { u32x4 w; w.x = pk2(x[0], x[1]); w.y = pk2(x[2], x[3]); w.z = pk2(x[4], x[5]); w.w = pk2(x[6], x[7]); return __builtin_bit_cast(bf16x8, w); }
__device__ __forceinline__ void phase3(const Frame& F) {
    const bf16* P = wsp<bf16>(F, WS_P); const bf16* LW = wsp<bf16>(F, WS_LW);
    const float* mu = F.in[6]; const float* w0 = F.in[7]; const float* a0 = F.in[9];
    const float* k_k = F.in[12]; const float* k_a = F.in[13]; const float* r_k = F.in[14];
    float* SCN = wsp<float>(F, WS_SCN); float* SV = wsp<float>(F, WS_SV); bf16* G = wsp<bf16>(F, WS_G); float* BON = wsp<float>(F, WS_BONUS);
    const int gw = F.vcu * 8 + F.wave, NGW = F.G * 8;
    const int cl = F.lane & 15, q = F.lane >> 4;
    for (int tile = gw; tile < M / 16; tile += NGW) {
        bf16x8 Aw[2], Aa[2], Ag[4];
        { const int tok = tile * 16 + cl, t = tok % T; float x[8];
#pragma unroll
            for (int s = 0; s < 2; ++s) { lerp8(P, mu, tok, t, 1536 + 32 * s + 8 * q, x);
#pragma unroll
                for (int j = 0; j < 8; ++j) x[j] = tanhf(x[j]);
                Aw[s] = pack8(x);
                lerp8(P, mu, tok, t, 1600 + 32 * s + 8 * q, x); Aa[s] = pack8(x); }
#pragma unroll
            for (int s = 0; s < 4; ++s) { lerp8(P, mu, tok, t, 1664 + 32 * s + 8 * q, x);
#pragma unroll
                for (int j = 0; j < 8; ++j) x[j] = sigmoidf_(x[j]);
                Ag[s] = pack8(x); } }
        const int tk0 = tile * 16 + 4 * q, b = tk0 / T, t0 = tk0 % T;
#pragma unroll 1
        for (int hh = 0; hh < RH; ++hh) {
            const int c0 = hh * 64 + cl * 4;
            f32x4 accw[4], acca[4], accg[4];
#pragma unroll
            for (int ct = 0; ct < 4; ++ct) { const bf16* lw = LW + (size_t)(c0 + ct) * 256 + 8 * q;
                f32x4 aw = (f32x4){0.f, 0.f, 0.f, 0.f}, aa = aw, ag = aw;
#pragma unroll
                for (int s = 0; s < 2; ++s) { aw = __builtin_amdgcn_mfma_f32_16x16x32_bf16(Aw[s], *(const bf16x8*)(lw + 32 * s), aw, 0, 0, 0);
                    aa = __builtin_amdgcn_mfma_f32_16x16x32_bf16(Aa[s], *(const bf16x8*)(lw + 64 + 32 * s), aa, 0, 0, 0); }
#pragma unroll
                for (int s = 0; s < 4; ++s) ag = __builtin_amdgcn_mfma_f32_16x16x32_bf16(Ag[s], *(const bf16x8*)(lw + 128 + 32 * s), ag, 0, 0, 0);
                accw[ct] = aw; acca[ct] = aa; accg[ct] = ag; }
            const f32x4 w0v = *(const f32x4*)(w0 + c0), a0v = *(const f32x4*)(a0 + c0), kkv = *(const f32x4*)(k_k + c0), kav = *(const f32x4*)(k_a + c0), rkv = *(const f32x4*)(r_k + c0);
#pragma unroll
            for (int i = 0; i < 4; ++i) { const int tk = tk0 + i, t = t0 + i;
                const f32x4 r4 = lerp4(P, mu, tk, t, c0), kr4 = lerp4(P, mu, tk, t, 512 + c0), v4 = lerp4(P, mu, tk, t, 1024 + c0);
                f32x4 dec, av, gv, kk4, k4;
                float ssq = 0.f, bon = 0.f;
#pragma unroll
                for (int ct = 0; ct < 4; ++ct) {
                    dec[ct] = __expf(-0.60653066f * sigmoidf_(w0v[ct] + accw[ct][i]));
                    av[ct] = sigmoidf_(a0v[ct] + acca[ct][i]);
                    gv[ct] = accg[ct][i];
                    kk4[ct] = kr4[ct] * kkv[ct]; ssq += kk4[ct] * kk4[ct];
                    k4[ct] = kr4[ct] * (1.f + (av[ct] - 1.f) * kav[ct]);
                    bon += r4[ct] * k4[ct] * rkv[ct]; }
                ssq = reduce16(ssq); bon = reduce16(bon);
                const float inv = 1.f / fmaxf(sqrtf(ssq), 1e-12f);
                const f32x4 kkn = kk4 * inv, bb = kkn * av;
                const size_t so = ((size_t)(b * RH + hh) * T + t) * 64 + cl * 4;
                float* sc = SCN + ((size_t)(b * RH + hh) * T + t) * 320 + cl * 4;
                *(f32x4*)(sc) = dec; *(f32x4*)(sc + 64) = kkn; *(f32x4*)(sc + 128) = bb; *(f32x4*)(sc + 192) = k4; *(f32x4*)(sc + 256) = r4;
                *(f32x4*)(SV + so) = v4;
                u32x2 gw2; gw2.x = pk2(gv[0], gv[1]); gw2.y = pk2(gv[2], gv[3]);
                *(u32x2*)(G + (size_t)tk * 512 + c0) = gw2;
                if (cl == 0) BON[tk * 8 + hh] = bon; }
        }
    }
}

constexpr int CK = 32, NCHK = T / CK;
#define SC_SPIN_CAP (1 << 24)
#define MFMA32(a, b, c) __builtin_amdgcn_mfma_f32_32x32x16_bf16((a), (b), (c), 0, 0, 0)
__device__ __forceinline__ int crow(int i, int h) { return (i & 3) + 8 * (i >> 2) + 4 * h; }
template <int S_> __device__ __forceinline__ bf16x8 pack_acc(const f32x16& x) { u32x4 w; w.x = pk2(x[8 * S_], x[8 * S_ + 1]); w.y = pk2(x[8 * S_ + 2], x[8 * S_ + 3]); w.z = pk2(x[8 * S_ + 4], x[8 * S_ + 5]); w.w = pk2(x[8 * S_ + 6], x[8 * S_ + 7]); return __builtin_bit_cast(bf16x8, w); }
__device__ __forceinline__ bf16x8 rd_nat(const LAS bf16* img, int stride, int row, int k0) { return *(const LAS bf16x8*)(img + row * stride + k0); }
__device__ __forceinline__ bf16x8 rd_perm(const LAS bf16* img, int stride, int row, int kb, int h) {
    const u32x2 lo = *(const LAS u32x2*)(img + row * stride + kb + 4 * h), hi = *(const LAS u32x2*)(img + row * stride + kb + 8 + 4 * h);
    u32x4 w; w.x = lo.x; w.y = lo.y; w.z = hi.x; w.w = hi.y; return __builtin_bit_cast(bf16x8, w);
}
__device__ __forceinline__ f32x16 zero16() { f32x16 z; for (int i = 0; i < 16; ++i) z[i] = 0.f; return z; }
constexpr int CL_A = 0, CL_B = 4608, CL_K = 9216, CL_R = 13824, CL_AT = 18432, CL_BHT = 23552, CL_KHT = 28672, CL_VT = 33792, CL_GTOT = 38912, CL_GC = 39936,
              CL_L = 40192, CL_T = 44800, CL_FNRB = 47360, CL_CNRK = 49408, CL_FQM = 53504, CL_GROUP = 57600;
constexpr int RMS = 72, TRS = 40, LST = 36;
__device__ __forceinline__ void phase4a_summaries(const Frame& F) {
    const float* SCN = wsp<float>(F, WS_SCN); const float* SV = wsp<float>(F, WS_SV);
    bf16x8* PT = wsp<bf16x8>(F, WS_PT); f32x4* ZV = wsp<f32x4>(F, WS_ZV); bf16x8* RYT = wsp<bf16x8>(F, WS_RYT); f32x4* YVT = wsp<f32x4>(F, WS_YVT);
    const int grp = F.tid >> 8, gt = F.tid & 255, w4 = F.wave & 3, lane = F.lane, r = lane & 31, h = lane >> 5;
    LAS unsigned char* gl = F.lds + grp * CL_GROUP;
    LAS bf16* iA = (LAS bf16*)(gl + CL_A); LAS bf16* iB = (LAS bf16*)(gl + CL_B); LAS bf16* iK = (LAS bf16*)(gl + CL_K); LAS bf16* iR = (LAS bf16*)(gl + CL_R);
    LAS bf16* iAT = (LAS bf16*)(gl + CL_AT); LAS bf16* iBHT = (LAS bf16*)(gl + CL_BHT); LAS bf16* iKHT = (LAS bf16*)(gl + CL_KHT); LAS bf16* iVT = (LAS bf16*)(gl + CL_VT);
    LAS float* gtot = (LAS float*)(gl + CL_GTOT); LAS float* gcv = (LAS float*)(gl + CL_GC); LAS float* Lm = (LAS float*)(gl + CL_L); LAS bf16* Tm = (LAS bf16*)(gl + CL_T);
    LAS bf16x8* fnrb = (LAS bf16x8*)(gl + CL_FNRB); LAS float* cnrk = (LAS float*)(gl + CL_CNRK); LAS bf16x8* fqm = (LAS bf16x8*)(gl + CL_FQM);
    constexpr int NCHUNKS = NBATCH * RH * NCHK;
    for (int it = F.vcu; it < NCHUNKS / 2; it += F.G) {
        const int chunk = it * 2 + grp, bh = chunk / NCHK, c = chunk % NCHK, t0 = c * CK;
        __syncthreads();
        { const int k = gt & 63, tq = gt >> 6;
            float wv[8], kkv[8], bv[8], kv[8], rv[8], vv[8], lp[8];
#pragma unroll
            for (int i = 0; i < 8; ++i) { const size_t row = (size_t)bh * T + t0 + 8 * tq + i; const float* sc = SCN + row * 320 + k;
                wv[i] = sc[0]; kkv[i] = sc[64]; bv[i] = sc[128]; kv[i] = sc[192]; rv[i] = sc[256]; vv[i] = SV[row * 64 + k]; }
            lp[0] = wv[0];
#pragma unroll
            for (int i = 1; i < 8; ++i) lp[i] = lp[i - 1] * wv[i];
            gtot[tq * 64 + k] = lp[7];
            __syncthreads();
            const float g0 = gtot[k], g1 = gtot[64 + k], g2 = gtot[128 + k], g3 = gtot[192 + k];
            const float pre = tq == 0 ? 1.f : (tq == 1 ? g0 : (tq == 2 ? g0 * g1 : g0 * g1 * g2)), gC = (g0 * g1) * (g2 * g3);
            float at[8], bh8[8], kh8[8];
#pragma unroll
            for (int i = 0; i < 8; ++i) { const float g = pre * lp[i], gp = i == 0 ? pre : pre * lp[i - 1], ig = 1.f / g;
                const float bt = bv[i] * ig, kt = kv[i] * ig; at[i] = -kkv[i] * gp; bh8[i] = bt * gC; kh8[i] = kt * gC;
                const int ro = (8 * tq + i) * RMS + k;
                iA[ro] = (bf16)f2bf(at[i]); iB[ro] = (bf16)f2bf(bt); iK[ro] = (bf16)f2bf(kt); iR[ro] = (bf16)f2bf(rv[i] * g); }
            *(LAS bf16x8*)(iAT + k * TRS + 8 * tq) = pack8(at); *(LAS bf16x8*)(iBHT + k * TRS + 8 * tq) = pack8(bh8); *(LAS bf16x8*)(iKHT + k * TRS + 8 * tq) = pack8(kh8);
            *(LAS bf16x8*)(iVT + k * TRS + 8 * tq) = pack8(vv);
            if (tq == 0) gcv[k] = gC; }
        __syncthreads();
        f32x16 lak = zero16();
        { const LAS bf16* ia = (w4 < 2) ? iA : (w4 == 2 ? iB : iK); const LAS bf16* ib = (w4 == 0) ? iB : (w4 == 1 ? iK : iR);
            f32x16 acc = zero16();
#pragma unroll
            for (int ks = 0; ks < 4; ++ks) acc = MFMA32(rd_nat(ia, RMS, r, 16 * ks + 8 * h), rd_nat(ib, RMS, r, 16 * ks + 8 * h), acc);
#pragma unroll
            for (int i = 0; i < 16; ++i) { const int row = crow(i, h); const bool keep = (w4 < 2) ? (r < row) : (row <= r); acc[i] = keep ? acc[i] : 0.f; }
            if (w4 == 0) {
#pragma unroll
                for (int i = 0; i < 16; ++i) Lm[crow(i, h) * LST + r] = acc[i]; }
            else if (w4 == 1) lak = acc;
            else if (w4 == 2) { fnrb[lane] = pack_acc<0>(acc); fnrb[64 + lane] = pack_acc<1>(acc); }
            else {
#pragma unroll
                for (int i = 0; i < 16; ++i) cnrk[i * 64 + lane] = acc[i]; } }
        __syncthreads();
        if (w4 == 0) { float Tr[32];
#pragma unroll
            for (int t = 0; t < 32; ++t) { float acc = (t == r) ? 1.f : 0.f;
#pragma unroll
                for (int s4 = 0; s4 < (t + 3) / 4; ++s4) { const f32x4 l4 = *(const LAS f32x4*)(Lm + t * LST + 4 * s4);
#pragma unroll
                    for (int q = 0; q < 4; ++q) if (4 * s4 + q < t) acc += l4[q] * Tr[4 * s4 + q]; }
                Tr[t] = acc; }
            if (lane < 32) {
#pragma unroll
                for (int t = 0; t < 32; ++t) Tm[t * TRS + r] = (bf16)f2bf(Tr[t]); } }
        __syncthreads();
        if (w4 == 0 || w4 == 2) { const int a = w4 >> 1;
            f32x16 x1 = zero16();
#pragma unroll
            for (int ks = 0; ks < 2; ++ks) x1 = MFMA32(rd_nat(Tm, TRS, r, 16 * ks + 8 * h), rd_nat(iAT, TRS, 32 * a + r, 16 * ks + 8 * h), x1);
            const bf16x8 xf0 = pack_acc<0>(x1), xf1 = pack_acc<1>(x1);
#pragma unroll
            for (int b = 0; b < 2; ++b) { f32x16 p = zero16();
                p = MFMA32(xf0, rd_perm(iBHT, TRS, 32 * b + r, 0, h), p); p = MFMA32(xf1, rd_perm(iBHT, TRS, 32 * b + r, 16, h), p);
                if (a == b) { const float gc = gcv[32 * a + r];
#pragma unroll
                    for (int i = 0; i < 16; ++i) p[i] += (crow(i, h) == r) ? gc : 0.f; }
                bf16x8* dst = PT + ((size_t)(chunk * 2 + a) * 2 + b) * 2 * 64 + lane; dst[0] = pack_acc<0>(p); dst[64] = pack_acc<1>(p); }
            f32x16 ry;
#pragma unroll
            for (int g = 0; g < 4; ++g) { const u32x2 rr = *(const LAS u32x2*)(iR + r * RMS + 32 * a + 8 * g + 4 * h);
                ry[4 * g] = bflo(rr.x); ry[4 * g + 1] = bfhi(rr.x); ry[4 * g + 2] = bflo(rr.y); ry[4 * g + 3] = bfhi(rr.y); }
            ry = MFMA32(xf0, fnrb[lane], ry); ry = MFMA32(xf1, fnrb[64 + lane], ry);
            bf16x8* dr = RYT + (size_t)(chunk * 2 + a) * 2 * 64 + lane; dr[0] = pack_acc<0>(ry); dr[64] = pack_acc<1>(ry);
        } else if (w4 == 1) {
            f32x16 x2 = zero16();
            x2 = MFMA32(rd_perm(Tm, TRS, r, 0, h), pack_acc<0>(lak), x2); x2 = MFMA32(rd_perm(Tm, TRS, r, 16, h), pack_acc<1>(lak), x2);
            const bf16x8 xf0 = pack_acc<0>(x2), xf1 = pack_acc<1>(x2);
#pragma unroll
            for (int b = 0; b < 2; ++b) { f32x16 qm;
#pragma unroll
                for (int g = 0; g < 4; ++g) { const u32x2 kk2 = *(const LAS u32x2*)(iKHT + (32 * b + r) * TRS + 8 * g + 4 * h);
                    qm[4 * g] = bflo(kk2.x); qm[4 * g + 1] = bfhi(kk2.x); qm[4 * g + 2] = bflo(kk2.y); qm[4 * g + 3] = bfhi(kk2.y); }
                qm = MFMA32(xf0, rd_perm(iBHT, TRS, 32 * b + r, 0, h), qm); qm = MFMA32(xf1, rd_perm(iBHT, TRS, 32 * b + r, 16, h), qm);
                fqm[(b * 2 + 0) * 64 + lane] = pack_acc<0>(qm); fqm[(b * 2 + 1) * 64 + lane] = pack_acc<1>(qm); }
            f32x16 gy;
#pragma unroll
            for (int i = 0; i < 16; ++i) gy[i] = cnrk[i * 64 + lane];
            gy = MFMA32(xf0, fnrb[lane], gy); gy = MFMA32(xf1, fnrb[64 + lane], gy);
            const bf16x8 gf0 = pack_acc<0>(gy), gf1 = pack_acc<1>(gy);
#pragma unroll
            for (int vh = 0; vh < 2; ++vh) { f32x16 yv = zero16();
                yv = MFMA32(rd_perm(iVT, TRS, 32 * vh + r, 0, h), gf0, yv); yv = MFMA32(rd_perm(iVT, TRS, 32 * vh + r, 16, h), gf1, yv);
                f32x4* dy = YVT + ((size_t)(chunk * 2 + vh) * 64 + lane) * 4;
#pragma unroll
                for (int g = 0; g < 4; ++g) dy[g] = (f32x4){yv[4 * g], yv[4 * g + 1], yv[4 * g + 2], yv[4 * g + 3]}; }
        }
        __syncthreads();
        if (w4 == 3) {
#pragma unroll
            for (int b = 0; b < 2; ++b)
#pragma unroll
                for (int vh = 0; vh < 2; ++vh) { f32x16 zv = zero16();
                    zv = MFMA32(fqm[(b * 2 + 0) * 64 + lane], rd_perm(iVT, TRS, 32 * vh + r, 0, h), zv); zv = MFMA32(fqm[(b * 2 + 1) * 64 + lane], rd_perm(iVT, TRS, 32 * vh + r, 16, h), zv);
                    f32x4* dz = ZV + (((size_t)(chunk * 2 + b) * 2 + vh) * 64 + lane) * 4;
#pragma unroll
                    for (int g = 0; g < 4; ++g) dz[g] = (f32x4){zv[4 * g], zv[4 * g + 1], zv[4 * g + 2], zv[4 * g + 3]}; }
        }
    }
}
constexpr int SB_SLOT = 16384, SB_NSLOT = 7, SB_FLAGS = SB_NSLOT * SB_SLOT;
__device__ __forceinline__ void phase4b_states(const Frame& F) {
    volatile LAS unsigned* FULL = (volatile LAS unsigned*)(F.lds + SB_FLAGS);
    volatile LAS unsigned* DONEC = (volatile LAS unsigned*)(F.lds + SB_FLAGS + 64);
    __syncthreads();
    if (F.tid < 32) ((LAS unsigned*)(F.lds + SB_FLAGS))[F.tid] = 0u;
    __syncthreads();
    if (F.vcu < 128) {
        const int bh = F.vcu >> 1, vh = F.vcu & 1, lane = F.lane;
        if (F.wave == 0) {
            bf16x8* Z0 = wsp<bf16x8>(F, WS_Z0);
            f32x16 z0 = zero16(), z1 = zero16();
            int slot = 0;
            for (int c = 0; c < NCHK; ++c) { const int chunk = bh * NCHK + c;
                const bf16x8 f00 = pack_acc<0>(z0), f01 = pack_acc<1>(z0), f10 = pack_acc<0>(z1), f11 = pack_acc<1>(z1);
                bf16x8* dz = Z0 + (size_t)(chunk * 2 + vh) * 4 * 64 + lane; dz[0] = f00; dz[64] = f01; dz[128] = f10; dz[192] = f11;
                { int sp = 0; while (FULL[slot] < (unsigned)(c + 1)) { if (++sp > SC_SPIN_CAP) break; } }
                __builtin_amdgcn_fence(__ATOMIC_ACQUIRE, "workgroup");
                const LAS unsigned char* sb = F.lds + slot * SB_SLOT;
                const LAS bf16x8* p = (const LAS bf16x8*)sb + lane;
                const LAS f32x4* s0 = (const LAS f32x4*)(sb + 8192) + lane * 4; const LAS f32x4* s1 = (const LAS f32x4*)(sb + 12288) + lane * 4;
                f32x16 n0, n1;
#pragma unroll
                for (int g = 0; g < 4; ++g) { const f32x4 u = s0[g], w = s1[g]; n0[4 * g] = u[0]; n0[4 * g + 1] = u[1]; n0[4 * g + 2] = u[2]; n0[4 * g + 3] = u[3]; n1[4 * g] = w[0]; n1[4 * g + 1] = w[1]; n1[4 * g + 2] = w[2]; n1[4 * g + 3] = w[3]; }
                const bf16x8 p000 = p[0 * 64], p001 = p[1 * 64], p010 = p[2 * 64], p011 = p[3 * 64], p100 = p[4 * 64], p101 = p[5 * 64], p110 = p[6 * 64], p111 = p[7 * 64];
                asm volatile("s_waitcnt lgkmcnt(0)" ::: "memory");
                if (lane == 0) DONEC[0] = (unsigned)(c + 1);
                n0 = MFMA32(p000, f00, n0); n0 = MFMA32(p001, f01, n0); n0 = MFMA32(p100, f10, n0); n0 = MFMA32(p101, f11, n0);
                n1 = MFMA32(p010, f00, n1); n1 = MFMA32(p011, f01, n1); n1 = MFMA32(p110, f10, n1); n1 = MFMA32(p111, f11, n1);
                z0 = n0; z1 = n1;
                slot = (slot + 1 == SB_NSLOT) ? 0 : slot + 1; }
        } else {
            const int slot = F.wave - 1;
            const unsigned char* gpt = (const unsigned char*)wsp<bf16x8>(F, WS_PT) + lane * 16;
            const unsigned char* gzv = (const unsigned char*)wsp<f32x4>(F, WS_ZV) + lane * 16;
            LAS unsigned char* dst = F.lds + slot * SB_SLOT;
            for (int c = slot; c < NCHK; c += SB_NSLOT) { const int chunk = bh * NCHK + c;
                if (c >= SB_NSLOT) { const unsigned need = (unsigned)(c - SB_NSLOT + 1); int sp = 0;
                    while (DONEC[0] < need) { __builtin_amdgcn_s_sleep(1); if (++sp > SC_SPIN_CAP) break; }
                    __builtin_amdgcn_fence(__ATOMIC_ACQUIRE, "workgroup"); }
                const unsigned char* sp_ = gpt + (size_t)chunk * 8192;
#pragma unroll
                for (int j = 0; j < 8; ++j) __builtin_amdgcn_global_load_lds((const unsigned*)(sp_ + j * 1024), (LAS unsigned*)(dst + j * 1024), 16, 0, 0);
                const unsigned char* sz0 = gzv + ((size_t)(chunk * 2 + 0) * 2 + vh) * 4096; const unsigned char* sz1 = gzv + ((size_t)(chunk * 2 + 1) * 2 + vh) * 4096;
#pragma unroll
                for (int j = 0; j < 4; ++j) { __builtin_amdgcn_global_load_lds((const unsigned*)(sz0 + j * 1024), (LAS unsigned*)(dst + 8192 + j * 1024), 16, 0, 0);
                    __builtin_amdgcn_global_load_lds((const unsigned*)(sz1 + j * 1024), (LAS unsigned*)(dst + 12288 + j * 1024), 16, 0, 0); }
                asm volatile("s_waitcnt vmcnt(0)" ::: "memory");
                if (lane == 0) FULL[slot] = (unsigned)(c + 1); }
        }
    }
    __syncthreads();
}

__device__ __forceinline__ void phase4c_output(const Frame& F) {
    const bf16x8* Z0 = wsp<bf16x8>(F, WS_Z0); const bf16x8* RYT = wsp<bf16x8>(F, WS_RYT); const f32x4* YVT = wsp<f32x4>(F, WS_YVT);
    const float* SV = wsp<float>(F, WS_SV); const bf16* G = wsp<bf16>(F, WS_G); const float* BON = wsp<float>(F, WS_BONUS); bf16* CAT = wsp<bf16>(F, WS_CAT);
    const float* lg = F.in[15]; const float* lb = F.in[16];
    const int gw = F.vcu * 8 + F.wave, NGW = F.G * 8, lane = F.lane, r = lane & 31, h = lane >> 5;
    for (int chunk = gw; chunk < NBATCH * RH * NCHK; chunk += NGW) {
        const int bh = chunk / NCHK, c = chunk % NCHK, b = bh / RH, hh = bh % RH, t = c * CK + r, row = b * T + t;
        const bf16x8* rf = RYT + (size_t)chunk * 4 * 64 + lane;
        f32x16 y[2];
#pragma unroll
        for (int vh = 0; vh < 2; ++vh) { const f32x4* sy = YVT + ((size_t)(chunk * 2 + vh) * 64 + lane) * 4;
#pragma unroll
            for (int g = 0; g < 4; ++g) { const f32x4 u = sy[g]; y[vh][4 * g] = u[0]; y[vh][4 * g + 1] = u[1]; y[vh][4 * g + 2] = u[2]; y[vh][4 * g + 3] = u[3]; }
            const bf16x8* zf = Z0 + (size_t)(chunk * 2 + vh) * 4 * 64 + lane;
#pragma unroll
            for (int q = 0; q < 4; ++q) y[vh] = MFMA32(zf[q * 64], rf[q * 64], y[vh]); }
        float sm = 0.f;
#pragma unroll
        for (int vh = 0; vh < 2; ++vh)
#pragma unroll
            for (int i = 0; i < 16; ++i) sm += y[vh][i];
        sm += __shfl_xor(sm, 32);
        const float mean = sm * (1.f / 64.f); float qv = 0.f;
#pragma unroll
        for (int vh = 0; vh < 2; ++vh)
#pragma unroll
            for (int i = 0; i < 16; ++i) { y[vh][i] -= mean; qv += y[vh][i] * y[vh][i]; }
        qv += __shfl_xor(qv, 32);
        const float rstd = rsqrtf(qv * (1.f / 64.f) + GN_EPS);
        const float bon = BON[row * 8 + hh];
#pragma unroll
        for (int vh = 0; vh < 2; ++vh)
#pragma unroll
            for (int g = 0; g < 4; ++g) { const int v0 = 32 * vh + 8 * g + 4 * h, c0 = hh * 64 + v0;
                const f32x4 vv = *(const f32x4*)(SV + ((size_t)bh * T + t) * 64 + v0), lg4 = *(const f32x4*)(lg + c0), lb4 = *(const f32x4*)(lb + c0);
                const u32x2 gr = *(const u32x2*)(G + (size_t)row * 512 + c0);
                const float gg[4] = {bflo(gr.x), bfhi(gr.x), bflo(gr.y), bfhi(gr.y)}; float o[4];
#pragma unroll
                for (int q = 0; q < 4; ++q) o[q] = (y[vh][4 * g + q] * rstd * lg4[q] + lb4[q] + bon * vv[q]) * gg[q];
                u32x2 w; w.x = pk2(o[0], o[1]); w.y = pk2(o[2], o[3]);
                *(u32x2*)(CAT + (size_t)row * D + c0) = w; }
    }
}

constexpr int SC_STEPS = 16, SC_NSLOT = 6, SC_SHARED = SC_STEPS * 1280, SC_SLOT = SC_SHARED + SC_STEPS * 64, SC_RING = SC_NSLOT * SC_SLOT;
constexpr int SC_FLAGS = SC_RING, SC_CONV = SC_RING + 256, SC_NCH = T / SC_STEPS;
static_assert(SC_CONV + 3 * 8704 <= LDS_BYTES, "scan LDS map");
__device__ __forceinline__ void phase4_scan(const Frame& F) {
    volatile LAS unsigned* READY = (volatile LAS unsigned*)(F.lds + SC_FLAGS);
    volatile LAS unsigned* DONE = (volatile LAS unsigned*)(F.lds + SC_FLAGS + 64);
    __syncthreads();
    if (F.tid < 64) ((LAS unsigned*)(F.lds + SC_FLAGS))[F.tid] = 0u;
    __syncthreads();
    const int bh = F.vcu >> 2, rg = F.vcu & 3, b = bh / RH, hh = bh % RH;
    if (F.wave < 4) {
        const int rl = F.lane >> 4, ks = F.lane & 15, rowl = F.wave * 4 + rl;
        float* yp = wsp<float>(F, WS_Y) + (size_t)b * T * 512 + hh * 64 + rg * 16 + rowl;
        f32x4 S = (f32x4){0.f, 0.f, 0.f, 0.f};
        int slot = 0;
        for (int c = 0; c < SC_NCH; ++c) {
#if MK_RWKV_MODE == 1
            if ((c & 1) == 0) {
                const int v = rg * 16 + rowl, chunk = bh * NCHK + (c >> 1);
                const bf16* zp = wsp<bf16>(F, WS_Z0) + ((((size_t)chunk * 2 + (v >> 5)) * 2 + (ks >> 3)) * 2 + ((ks >> 2) & 1)) * 512 + ((v & 31) + 32 * (ks & 1)) * 8 + 4 * ((ks >> 1) & 1);
                const u32x2 zz = *(const u32x2*)zp;
                S = (f32x4){bflo(zz.x), bfhi(zz.x), bflo(zz.y), bfhi(zz.y)}; }
#endif
            { int sp = 0; while (READY[slot] < (unsigned)(c + 1)) { if (++sp > SC_SPIN_CAP) break; } }
            __builtin_amdgcn_fence(__ATOMIC_ACQUIRE, "workgroup");
            const LAS unsigned char* sb = F.lds + slot * SC_SLOT;
            const LAS unsigned char* op = sb + ks * 16; const LAS float* vp = (const LAS float*)(sb + SC_SHARED) + rowl;
            f32x4 w4 = *(const LAS f32x4*)(op), kk4 = *(const LAS f32x4*)(op + 256), b4 = *(const LAS f32x4*)(op + 512), k4 = *(const LAS f32x4*)(op + 768), r4 = *(const LAS f32x4*)(op + 1024);
            float v = vp[0];
            float ykeep = 0.f;
#pragma unroll
            for (int s = 0; s < SC_STEPS; ++s) {
                const f32x4 cw = w4, ckk = kk4, cb = b4, ck = k4, cr = r4; const float cv = v;
                if (s + 1 < SC_STEPS) { const LAS unsigned char* o2 = op + (s + 1) * 1280;
                    w4 = *(const LAS f32x4*)(o2); kk4 = *(const LAS f32x4*)(o2 + 256); b4 = *(const LAS f32x4*)(o2 + 512); k4 = *(const LAS f32x4*)(o2 + 768); r4 = *(const LAS f32x4*)(o2 + 1024);
                    v = vp[(s + 1) * 16]; }
                if (s == SC_STEPS - 1) { asm volatile("s_waitcnt lgkmcnt(0)" ::: "memory"); if (F.lane == 0) DONE[F.wave] = (unsigned)(c + 1); }
                float p = (S[0] * ckk[0] + S[1] * ckk[1]) + (S[2] * ckk[2] + S[3] * ckk[3]);
                p = reduce16(p);
                const f32x4 tt = S * cw + ck * cv;
                S = tt - cb * p;
                float q = (S[0] * cr[0] + S[1] * cr[1]) + (S[2] * cr[2] + S[3] * cr[3]);
                q = reduce16(q);
                ykeep = (ks == s) ? q : ykeep;
            }
            yp[(size_t)(c * SC_STEPS + ks) * 512] = ykeep;
            slot = (slot + 1 == SC_NSLOT) ? 0 : slot + 1;
        }
    } else if (F.wave == 4) {
        const unsigned char* gs = (const unsigned char*)(wsp<float>(F, WS_SCN) + (size_t)bh * T * 320) + F.lane * 16;
        const unsigned char* gv = (const unsigned char*)(wsp<float>(F, WS_SV) + (size_t)bh * T * 64 + (F.lane >> 2) * 64 + rg * 16 + (F.lane & 3) * 4);
        int slot = 0;
        for (int c = 0; c < SC_NCH; ++c) {
            if (c >= SC_NSLOT) { const unsigned need = (unsigned)(c - SC_NSLOT + 1); int sp = 0;
                while (DONE[0] < need || DONE[1] < need || DONE[2] < need || DONE[3] < need) { __builtin_amdgcn_s_sleep(1); if (++sp > SC_SPIN_CAP) break; }
                __builtin_amdgcn_fence(__ATOMIC_ACQUIRE, "workgroup"); }
            LAS unsigned char* dst = F.lds + slot * SC_SLOT;
            const unsigned char* src = gs + (size_t)c * SC_SHARED;
#pragma unroll
            for (int j = 0; j < SC_SHARED / 1024; ++j) __builtin_amdgcn_global_load_lds((const unsigned*)(src + j * 1024), (LAS unsigned*)(dst + j * 1024), 16, 0, 0);
            __builtin_amdgcn_global_load_lds((const unsigned*)(gv + (size_t)c * SC_STEPS * 256), (LAS unsigned*)(dst + SC_SHARED), 16, 0, 0);
            if (c >= 2) { asm volatile("s_waitcnt vmcnt(42)" ::: "memory"); const int ps = (slot >= 2) ? slot - 2 : slot + SC_NSLOT - 2; if (F.lane == 0) READY[ps] = (unsigned)(c - 1); }
            slot = (slot + 1 == SC_NSLOT) ? 0 : slot + 1;
        }
        { asm volatile("s_waitcnt vmcnt(21)" ::: "memory"); const int ps = (slot >= 2) ? slot - 2 : slot + SC_NSLOT - 2; if (F.lane == 0) READY[ps] = (unsigned)(SC_NCH - 1); }
        { asm volatile("s_waitcnt vmcnt(0)" ::: "memory"); const int ps = (slot >= 1) ? slot - 1 : SC_NSLOT - 1; if (F.lane == 0) READY[ps] = (unsigned)(SC_NCH); }
    } else {
#if MK_CONV_IN_SCAN
        for (int it = F.vcu * 3 + (F.wave - 5); it < MOE_ITEMS; it += F.G * 3) moe_weight_item(F, it);
#endif
    }
    __syncthreads();
}

constexpr int KLD = 72;
constexpr int VLD = 260;
__device__ __forceinline__ void phase5_attn(const Frame& F) {
    const bf16* P = wsp<bf16>(F, WS_P);
    bf16* CAT = wsp<bf16>(F, WS_CAT);
    const float* qg = F.in[17]; const float* kg = F.in[18]; const float* sinks = F.in[19];
    LAS bf16* Kl = (LAS bf16*)F.lds;
    LAS bf16* Vt = (LAS bf16*)(F.lds + 256 * KLD * 2);
    const int lane = F.lane, r = lane & 31, h = lane >> 5;
    for (int unit = F.vcu; unit < NBATCH * KVH * (T / 128); unit += F.G) {
        const int blk = unit % (T / 128), kvh = (unit / (T / 128)) % KVH, b = unit / (T / 128 * KVH);
        const int kpos0 = blk * 128 - 128;
        __syncthreads();
        for (int ch = F.tid; ch < 2048; ch += 512) { const int key = ch >> 3, dc = ch & 7, kpos = kpos0 + key;
            u32x4 kraw = (u32x4){0u, 0u, 0u, 0u}, vraw = (u32x4){0u, 0u, 0u, 0u};
            if (kpos >= 0) { const size_t ro = (size_t)(b * T + kpos) * IN_COLS; kraw = *(const u32x4*)(P + ro + COL_K + kvh * 64 + dc * 8); vraw = *(const u32x4*)(P + ro + COL_V + kvh * 64 + dc * 8); }
            float kf[8]; kf[0] = bflo(kraw.x); kf[1] = bfhi(kraw.x); kf[2] = bflo(kraw.y); kf[3] = bfhi(kraw.y); kf[4] = bflo(kraw.z); kf[5] = bfhi(kraw.z); kf[6] = bflo(kraw.w); kf[7] = bfhi(kraw.w);
            float ss = 0.f;
#pragma unroll
            for (int j = 0; j < 8; ++j) ss += kf[j] * kf[j];
            ss += __shfl_xor(ss, 1); ss += __shfl_xor(ss, 2); ss += __shfl_xor(ss, 4);
            const float rstd = rsqrtf(ss * (1.f / 64.f) + NORM_EPS);
            const f32x4 g0 = *(const f32x4*)(kg + dc * 8), g1 = *(const f32x4*)(kg + dc * 8 + 4);
            u32x4 ko; ko.x = pk2(kf[0] * rstd * g0[0], kf[1] * rstd * g0[1]); ko.y = pk2(kf[2] * rstd * g0[2], kf[3] * rstd * g0[3]);
            ko.z = pk2(kf[4] * rstd * g1[0], kf[5] * rstd * g1[1]); ko.w = pk2(kf[6] * rstd * g1[2], kf[7] * rstd * g1[3]);
            *(LAS u32x4*)(Kl + key * KLD + dc * 8) = ko;
            const unsigned vv[4] = {vraw.x, vraw.y, vraw.z, vraw.w};
#pragma unroll
            for (int j = 0; j < 4; ++j) { Vt[(dc * 8 + 2 * j) * VLD + key] = (bf16)(vv[j] & 0xffffu); Vt[(dc * 8 + 2 * j + 1) * VLD + key] = (bf16)(vv[j] >> 16); }
        }
        __syncthreads();
        for (int task = F.wave; task < 16; task += 8) {
            const int g = task & 3, qs = task >> 2, head = kvh * 4 + g;
            const int qrow = b * T + blk * 128 + qs * 32 + r;
            float qf[4][8]; float ss = 0.f;
#pragma unroll
            for (int s = 0; s < 4; ++s) { const u32x4 qr = *(const u32x4*)(P + (size_t)qrow * IN_COLS + COL_Q + head * 64 + 16 * s + 8 * h);
                qf[s][0] = bflo(qr.x); qf[s][1] = bfhi(qr.x); qf[s][2] = bflo(qr.y); qf[s][3] = bfhi(qr.y); qf[s][4] = bflo(qr.z); qf[s][5] = bfhi(qr.z); qf[s][6] = bflo(qr.w); qf[s][7] = bfhi(qr.w);
#pragma unroll
                for (int j = 0; j < 8; ++j) ss += qf[s][j] * qf[s][j]; }
            ss += __shfl_xor(ss, 32);
            const float qscale = rsqrtf(ss * (1.f / 64.f) + NORM_EPS) * 0.125f;
            bf16x8 qb[4];
#pragma unroll
            for (int s = 0; s < 4; ++s) { u32x4 w;
                const f32x4 g0 = *(const f32x4*)(qg + 16 * s + 8 * h), g1 = *(const f32x4*)(qg + 16 * s + 8 * h + 4);
                w.x = pk2(qf[s][0] * qscale * g0[0], qf[s][1] * qscale * g0[1]); w.y = pk2(qf[s][2] * qscale * g0[2], qf[s][3] * qscale * g0[3]);
                w.z = pk2(qf[s][4] * qscale * g1[0], qf[s][5] * qscale * g1[1]); w.w = pk2(qf[s][6] * qscale * g1[2], qf[s][7] * qscale * g1[3]);
                qb[s] = __builtin_bit_cast(bf16x8, w); }
            f32x16 st[5];
#pragma unroll
            for (int kt = 0; kt < 5; ++kt) {
#pragma unroll
                for (int i = 0; i < 16; ++i) st[kt][i] = 0.f;
#pragma unroll
                for (int s = 0; s < 4; ++s) { const bf16x8 ka = *(const LAS bf16x8*)(Kl + (32 * (qs + kt) + r) * KLD + 16 * s + 8 * h);
                    st[kt] = __builtin_amdgcn_mfma_f32_32x32x16_bf16(ka, qb[s], st[kt], 0, 0, 0); }
            }
            const int iq = 32 * qs + r;
            const float sink = sinks[head];
            float mx = sink;
#pragma unroll
            for (int kt = 0; kt < 5; ++kt)
#pragma unroll
                for (int i = 0; i < 16; ++i) { const int jw = 32 * (qs + kt) + (i & 3) + 8 * (i >> 2) + 4 * h;
                    const bool ok = (jw >= iq + 1) && (jw <= iq + 128) && (kpos0 + jw >= 0);
                    st[kt][i] = ok ? st[kt][i] : -INFINITY; mx = fmaxf(mx, st[kt][i]); }
            mx = fmaxf(mx, __shfl_xor(mx, 32));
            float lsum = 0.f;
#pragma unroll
            for (int kt = 0; kt < 5; ++kt)
#pragma unroll
                for (int i = 0; i < 16; ++i) { const float p = __expf(st[kt][i] - mx); st[kt][i] = p; lsum += p; }
            lsum += __shfl_xor(lsum, 32);
            const float linv = 1.f / (lsum + __expf(sink - mx));
            f32x16 o[2];
#pragma unroll
            for (int dt = 0; dt < 2; ++dt)
#pragma unroll
                for (int i = 0; i < 16; ++i) o[dt][i] = 0.f;
#pragma unroll
            for (int kt = 0; kt < 5; ++kt)
#pragma unroll
                for (int sp = 0; sp < 2; ++sp) { u32x4 pw;
                    pw.x = pk2(st[kt][8 * sp + 0] * linv, st[kt][8 * sp + 1] * linv); pw.y = pk2(st[kt][8 * sp + 2] * linv, st[kt][8 * sp + 3] * linv);
                    pw.z = pk2(st[kt][8 * sp + 4] * linv, st[kt][8 * sp + 5] * linv); pw.w = pk2(st[kt][8 * sp + 6] * linv, st[kt][8 * sp + 7] * linv);
                    const bf16x8 pa = __builtin_bit_cast(bf16x8, pw);
                    const int kb = 32 * (qs + kt) + 16 * sp + 4 * h;
#pragma unroll
                    for (int dt = 0; dt < 2; ++dt) { const LAS bf16* vp = Vt + (32 * dt + r) * VLD + kb;
                        const u32x2 lo = *(const LAS u32x2*)vp, hi = *(const LAS u32x2*)(vp + 8);
                        u32x4 vw; vw.x = lo.x; vw.y = lo.y; vw.z = hi.x; vw.w = hi.y;
                        o[dt] = __builtin_amdgcn_mfma_f32_32x32x16_bf16(pa, __builtin_bit_cast(bf16x8, vw), o[dt], 0, 0, 0); } }
#pragma unroll
            for (int dt = 0; dt < 2; ++dt)
#pragma unroll
                for (int i = 0; i < 16; ++i) { const int qr = (i & 3) + 8 * (i >> 2) + 4 * h;
                    CAT[(size_t)(b * T + blk * 128 + qs * 32 + qr) * D + 512 + head * 64 + 32 * dt + r] = (bf16)f2bf(o[dt][i]); }
        }
    }
}

__device__ __forceinline__ void phase6(const Frame& F) {
    const int gw = F.vcu * 8 + F.wave, NGW = F.G * 8;
    const float* Y = wsp<float>(F, WS_Y); const float* SV = wsp<float>(F, WS_SV); const bf16* G = wsp<bf16>(F, WS_G); const float* BON = wsp<float>(F, WS_BONUS);
    bf16* CAT = wsp<bf16>(F, WS_CAT);
    const float* lg = F.in[15]; const float* lb = F.in[16];
    const int hh = F.lane >> 3, n0 = (F.lane & 7) * 8, c0 = F.lane * 8;
    for (int row = gw; row < M; row += NGW) { const int b = row / T, t = row % T;
        const f32x4 y0 = *(const f32x4*)(Y + (size_t)row * 512 + c0), y1 = *(const f32x4*)(Y + (size_t)row * 512 + c0 + 4);
        float yv[8] = {y0[0], y0[1], y0[2], y0[3], y1[0], y1[1], y1[2], y1[3]};
        float s = 0.f;
#pragma unroll
        for (int j = 0; j < 8; ++j) s += yv[j];
        s += __shfl_xor(s, 1); s += __shfl_xor(s, 2); s += __shfl_xor(s, 4);
        const float mean = s * (1.f / 64.f); float q = 0.f;
#pragma unroll
        for (int j = 0; j < 8; ++j) { yv[j] -= mean; q += yv[j] * yv[j]; }
        q += __shfl_xor(q, 1); q += __shfl_xor(q, 2); q += __shfl_xor(q, 4);
        const float rstd = rsqrtf(q * (1.f / 64.f) + GN_EPS);
        const float bon = BON[row * 8 + hh];
        const float* vp = SV + ((size_t)(b * RH + hh) * T + t) * 64 + n0;
        const f32x4 v0 = *(const f32x4*)vp, v1 = *(const f32x4*)(vp + 4);
        const float vv[8] = {v0[0], v0[1], v0[2], v0[3], v1[0], v1[1], v1[2], v1[3]};
        const u32x4 graw = *(const u32x4*)(G + (size_t)row * 512 + c0);
        const float gg[8] = {bflo(graw.x), bfhi(graw.x), bflo(graw.y), bfhi(graw.y), bflo(graw.z), bfhi(graw.z), bflo(graw.w), bfhi(graw.w)};
        float ov[8];
#pragma unroll
        for (int j = 0; j < 8; ++j) ov[j] = (yv[j] * rstd * lg[c0 + j] + lb[c0 + j] + bon * vv[j]) * gg[j];
        u32x4 w; w.x = pk2(ov[0], ov[1]); w.y = pk2(ov[2], ov[3]); w.z = pk2(ov[4], ov[5]); w.w = pk2(ov[6], ov[7]);
        *(u32x4*)(CAT + (size_t)row * D + c0) = w; }
}

__device__ __forceinline__ float reduce32x64(float (&v)[32], int lane) {
#pragma unroll
    for (int i = 0; i < 16; ++i) { const bool hi = lane & 16; const float send = hi ? v[i] : v[i + 16], keep = hi ? v[i + 16] : v[i]; v[i] = keep + __shfl_xor(send, 16); }
#pragma unroll
    for (int i = 0; i < 8; ++i) { const bool hi = lane & 8; const float send = hi ? v[i] : v[i + 8], keep = hi ? v[i + 8] : v[i]; v[i] = keep + __shfl_xor(send, 8); }
#pragma unroll
    for (int i = 0; i < 4; ++i) { const bool hi = lane & 4; const float send = hi ? v[i] : v[i + 4], keep = hi ? v[i + 4] : v[i]; v[i] = keep + __shfl_xor(send, 4); }
#pragma unroll
    for (int i = 0; i < 2; ++i) { const bool hi = lane & 2; const float send = hi ? v[i] : v[i + 2], keep = hi ? v[i + 2] : v[i]; v[i] = keep + __shfl_xor(send, 2); }
    { const bool hi = lane & 1; const float send = hi ? v[0] : v[1], keep = hi ? v[1] : v[0]; v[0] = keep + __shfl_xor(send, 1); }
    return v[0] + __shfl_xor(v[0], 32);
}
__device__ __forceinline__ void phase8(const Frame& F) {
    const float* mod = wsp<float>(F, WS_MOD); const float* x1 = F.out;
    const float* wr_ = F.in[22]; const float* br = F.in[23];
    LAS float* Wt = (LAS float*)F.lds;
    LAS float* lgw = (LAS float*)(F.lds + 131072 + F.wave * 512);
    LAS int* cnt = (LAS int*)(F.lds + 131072 + 4096);
    __syncthreads();
    for (int idx = F.tid; idx < 8192; idx += 512) { const int k = idx >> 3, e4 = idx & 7; const f32x4 w = *(const f32x4*)(wr_ + k * 32 + e4 * 4);
        Wt[(4 * e4 + 0) * 1024 + k] = w[0]; Wt[(4 * e4 + 1) * 1024 + k] = w[1]; Wt[(4 * e4 + 2) * 1024 + k] = w[2]; Wt[(4 * e4 + 3) * 1024 + k] = w[3]; }
    if (F.tid < 32) cnt[F.tid] = 0;
    __syncthreads();
    int* RT_E = wsp<int>(F, WS_RT_E); int* RT_LP = wsp<int>(F, WS_RT_LP); float* RT_G = wsp<float>(F, WS_RT_G);
    const int e = F.lane & 31;
    const float bre = br[e];
    for (int pr = 0; pr < 8; ++pr) { const int row0 = F.vcu * 128 + F.wave * 16 + 2 * pr, b = row0 / T;
        f32x4 h0[4], h1[4];
        norm_row<MK_FP8>(F, x1 + (size_t)row0 * D, F.in[21], mod + b * 6144 + 3072, mod + b * 6144 + 4096, (bf16*)(wsp<unsigned char>(F, WS_H) + (size_t)row0 * D * (MK_FP8 ? 1 : 2)), h0);
        norm_row<MK_FP8>(F, x1 + (size_t)(row0 + 1) * D, F.in[21], mod + b * 6144 + 3072, mod + b * 6144 + 4096, (bf16*)(wsp<unsigned char>(F, WS_H) + (size_t)(row0 + 1) * D * (MK_FP8 ? 1 : 2)), h1);
        float pa0[32], pa1[32];
#pragma unroll
        for (int q = 0; q < 32; ++q) { float s0 = 0.f, s1 = 0.f;
#pragma unroll
            for (int j = 0; j < 4; ++j) { const f32x4 w4 = *(const LAS f32x4*)(Wt + q * 1024 + 4 * F.lane + 256 * j);
                s0 += (h0[j][0] * w4[0] + h0[j][1] * w4[1]) + (h0[j][2] * w4[2] + h0[j][3] * w4[3]);
                s1 += (h1[j][0] * w4[0] + h1[j][1] * w4[1]) + (h1[j][2] * w4[2] + h1[j][3] * w4[3]); }
            pa0[q] = s0; pa1[q] = s1; }
        const float lg0 = reduce32x64(pa0, F.lane) + bre, lg1 = reduce32x64(pa1, F.lane) + bre;
#pragma unroll
        for (int q = 0; q < 2; ++q) { const float logit = q ? lg1 : lg0; const int row = row0 + q; LAS float* lg32 = lgw + q * 64;
            if (F.lane < 32) lg32[e] = logit;
            asm volatile("s_waitcnt lgkmcnt(0)" ::: "memory");
            int rank = 0;
#pragma unroll 8
            for (int o = 0; o < 32; ++o) { const float ov = lg32[o]; rank += (ov > logit || (ov == logit && o < e)) ? 1 : 0; }
            if (F.lane < 32 && rank < 4) lg32[32 + rank] = logit;
            asm volatile("s_waitcnt lgkmcnt(0)" ::: "memory");
            const float t0 = lg32[32], t1 = lg32[33], t2 = lg32[34], t3 = lg32[35];
            const float den = 1.f + __expf(t1 - t0) + __expf(t2 - t0) + __expf(t3 - t0);
            if (F.lane < 32 && rank < 4) { const int lp = atomicAdd((int*)&cnt[e], 1);
                RT_E[row * 4 + rank] = e; RT_LP[row * 4 + rank] = lp; RT_G[row * 4 + rank] = __expf(logit - t0) / den; }
            asm volatile("s_waitcnt lgkmcnt(0)" ::: "memory"); }
    }
    __syncthreads();
    if (F.tid < 32) wsp<int>(F, WS_BLKCNT)[F.vcu * 32 + F.tid] = cnt[F.tid];
}

__device__ __forceinline__ void phase9(const Frame& F) {
    LAS int* base = (LAS int*)F.lds;
    LAS int* tot = base + 32;
    LAS int* pst = base + 64;
    const int* BC = wsp<int>(F, WS_BLKCNT);
    if (F.tid < 32) { int s = 0, mine = 0; for (int bk = 0; bk < F.G; ++bk) { if (bk == F.vcu) mine = s; s += BC[bk * 32 + F.tid]; } base[F.tid] = mine; tot[F.tid] = s; }
    __syncthreads();
    if (F.tid == 0) { int s = 0; for (int e = 0; e < 32; ++e) { pst[e] = s; s += (tot[e] + 255) / 256 * 256; } pst[32] = s; }
    __syncthreads();
    int* SLOT_TOK = wsp<int>(F, WS_SLOTTOK); float* SLOT_GATE = wsp<float>(F, WS_SLOTGATE); int* TOK_SLOT = wsp<int>(F, WS_TOKSLOT);
    const int* RT_E = wsp<int>(F, WS_RT_E); const int* RT_LP = wsp<int>(F, WS_RT_LP); const float* RT_G = wsp<float>(F, WS_RT_G);
    { const int idx = F.vcu * 512 + F.tid;
        const int e = RT_E[idx], slot = pst[e] + base[e] + RT_LP[idx];
        SLOT_TOK[slot] = idx >> 2; SLOT_GATE[slot] = RT_G[idx]; TOK_SLOT[idx] = slot; }
    if (F.vcu < 32) { const int e = F.vcu; for (int s = pst[e] + tot[e] + F.tid; s < pst[e + 1]; s += 512) { SLOT_TOK[s] = 0; SLOT_GATE[s] = 0.f; } }
    if (F.vcu == 0) { unsigned* ctl = wsp<unsigned>(F, WS_CTL);
        if (F.tid == 0) ctl[CW_NTILES] = (unsigned)(pst[32] / 256);
        if (F.tid < 33) ctl[CW_PADSTART + F.tid] = (unsigned)pst[F.tid];
        int* TE = wsp<int>(F, WS_TILEE);
        for (int tl = F.tid; tl < MAX_TILES; tl += 512) { int e = 31; for (int q = 0; q < 32; ++q) if (tl * 256 < pst[q + 1]) { e = q; break; } TE[tl] = e; } }
#if MK_CONV_WHERE == 9
    for (int it = F.vcu * 8 + F.wave; it < MOE_ITEMS; it += F.G * 8) moe_weight_item(F, it);
#endif
}

__device__ __forceinline__ void phase12(const Frame& F) {
    const int gw = F.vcu * 8 + F.wave, NGW = F.G * 8;
    const float* mod = wsp<float>(F, WS_MOD); const bf16* YS = wsp<bf16>(F, WS_YS); const int* TOK_SLOT = wsp<int>(F, WS_TOKSLOT);
    for (int row = gw; row < M; row += NGW) { const int b = row / T;
        int sl[4];
#pragma unroll
        for (int k = 0; k < 4; ++k) sl[k] = TOK_SLOT[row * 4 + k];
#pragma unroll
        for (int j = 0; j < 2; ++j) { const int col = 8 * F.lane + 512 * j;
            float a[8];
#pragma unroll
            for (int q = 0; q < 8; ++q) a[q] = 0.f;
#pragma unroll
            for (int k = 0; k < 4; ++k) { const u32x4 v = *(const u32x4*)(YS + (size_t)sl[k] * D + col);
                a[0] += bflo(v.x); a[1] += bfhi(v.x); a[2] += bflo(v.y); a[3] += bfhi(v.y); a[4] += bflo(v.z); a[5] += bfhi(v.z); a[6] += bflo(v.w); a[7] += bfhi(v.w); }
            const float* gp = mod + b * 6144 + 5120 + col;
            const f32x4 g0 = *(const f32x4*)gp, g1 = *(const f32x4*)(gp + 4);
            float* op = F.out + (size_t)row * D + col;
            f32x4 x0 = *(const f32x4*)op, x1v = *(const f32x4*)(op + 4);
            x0[0] += g0[0] * a[0]; x0[1] += g0[1] * a[1]; x0[2] += g0[2] * a[2]; x0[3] += g0[3] * a[3];
            x1v[0] += g1[0] * a[4]; x1v[1] += g1[1] * a[5]; x1v[2] += g1[2] * a[6]; x1v[3] += g1[3] * a[7];
            *(f32x4*)op = x0; *(f32x4*)(op + 4) = x1v; } }
}

__device__ __forceinline__ void copy_x_to_out(const Frame& F) {
    const size_t n4 = (size_t)M * D / 4; const f32x4* s = (const f32x4*)F.in[0]; f32x4* d = (f32x4*)F.out;
    for (size_t i = (size_t)blockIdx.x * 512 + F.tid; i < n4; i += (size_t)gridDim.x * 512) d[i] = s[i];
}


#define XB_TMO      128
#define XB_XCNT(j)  (256  + 64 * (j))
#define XB_XSUB(j)  (1280 + 64 * (j))
#define XB_XGEN(j)  (2304 + 64 * (j))
#define XB_TOP      3328
#define XB_TOPGEN   3392
#define XCD_BAR_WORDS 3456
#define XB_SPIN_CAP (1u << 18)
__device__ __forceinline__ unsigned xb_ld(unsigned* p)              { return __hip_atomic_load(p, __ATOMIC_RELAXED, __HIP_MEMORY_SCOPE_AGENT); }
__device__ __forceinline__ unsigned xb_add(unsigned* p, unsigned v) { return __hip_atomic_fetch_add(p, v, __ATOMIC_RELAXED, __HIP_MEMORY_SCOPE_AGENT); }
__device__ __forceinline__ unsigned xb_xcc_id() { return (unsigned)__builtin_amdgcn_s_getreg((3 << 11) | 20) & 0xFu; }
#define XB_SPIN(cond, bar) do { unsigned _sp = 0; while (cond) { __builtin_amdgcn_s_sleep(1); \
    if ((++_sp & 255u) == 0u) { if (xb_ld(&(bar)[XB_TMO])) break; if (_sp > XB_SPIN_CAP) { atomicAdd(&(bar)[XB_TMO], 1u); break; } } } } while (0)
struct XcdBarrier { unsigned* bar; unsigned x; volatile LAS unsigned* st; };
__device__ __forceinline__ XcdBarrier xcd_barrier_post(unsigned* bar, volatile LAS unsigned* st) {
    XcdBarrier b; b.bar = bar; b.x = xb_xcc_id(); b.st = st;
    if (threadIdx.x == 0) (void)xb_add(&bar[XB_XCNT(b.x)], 1u);
    return b;
}
__device__ __forceinline__ void xcd_barrier_complete(unsigned* bar, unsigned x, unsigned& nloc, unsigned& nx) {
    const unsigned G = gridDim.x * gridDim.y * gridDim.z;
    unsigned sum, cnt, mine, sp = 0u;
    for (;;) {
        sum = 0u; cnt = 0u; mine = 0u;
#pragma unroll
        for (unsigned j = 0; j < 16; ++j) { const unsigned c = xb_ld(&bar[XB_XCNT(j)]); sum += c; cnt += (c > 0u) ? 1u : 0u; mine = (j == x) ? c : mine; }
        if (sum == G) break;
        __builtin_amdgcn_s_sleep(1);
        if ((++sp & 255u) == 0u) { if (xb_ld(&bar[XB_TMO])) break; if (sp > XB_SPIN_CAP) { atomicAdd(&bar[XB_TMO], 1u); break; } }
    }
    nloc = mine > 0u ? mine : 1u; nx = cnt > 0u ? cnt : 1u;
}
__device__ __forceinline__ void xcd_barrier(const XcdBarrier& b) {
    asm volatile("s_waitcnt vmcnt(0)" ::: "memory");
    __syncthreads();
    if (threadIdx.x == 0) {
        unsigned* bar = b.bar;
        __builtin_amdgcn_s_waitcnt(0);
        unsigned nloc = b.st[0], nx = b.st[1];
        if (nloc == 0u) { xcd_barrier_complete(bar, b.x, nloc, nx); b.st[0] = nloc; b.st[1] = nx; }
        const unsigned old = xb_add(&bar[XB_XSUB(b.x)], 1u);
        const unsigned gen = old / nloc;
        if (old + 1u == (gen + 1u) * nloc) {
            __builtin_amdgcn_fence(__ATOMIC_RELEASE, "agent");
            asm volatile("s_waitcnt vmcnt(0)" ::: "memory");
            const unsigned og = xb_add(&bar[XB_TOP], 1u);
            const unsigned tg = og / nx;
            if (og + 1u == (tg + 1u) * nx) xb_add(&bar[XB_TOPGEN], 1u);
            else XB_SPIN(xb_ld(&bar[XB_TOPGEN]) == tg, bar);
            __builtin_amdgcn_fence(__ATOMIC_ACQUIRE, "agent");
            xb_add(&bar[XB_XGEN(b.x)], 1u);
            asm volatile("s_waitcnt vmcnt(0)" ::: "memory");
        } else {
            XB_SPIN(xb_ld(&bar[XB_XGEN(b.x)]) == gen, bar);
            __builtin_amdgcn_fence(__ATOMIC_ACQUIRE, "agent");
            asm volatile("s_waitcnt vmcnt(0)" ::: "memory");
        }
    }
    __syncthreads();
}

struct Args { const float* in[28]; float* out; unsigned char* ws; int ph_lo, ph_hi; };
constexpr int N_PHASES = 13;

__global__ void __launch_bounds__(512, 2) mk_fwd(Args args) {
    extern __shared__ __attribute__((aligned(16))) unsigned char lds_raw[];
    Frame F;
    F.lds = (LAS unsigned char*)lds_raw;
    F.tid = threadIdx.x; F.lane = F.tid & 63; F.wave = __builtin_amdgcn_readfirstlane(F.tid >> 6);
    F.G = gridDim.x; { const int bx = blockIdx.x; F.vcu = (F.G % 8 == 0) ? (bx % 8) * (F.G / 8) + bx / 8 : bx; }
    F.in = args.in;
    F.out = args.out; F.ws = args.ws;
    cg::grid_group grid = cg::this_grid();
    const int lo = args.ph_lo, hi = args.ph_hi;
    volatile LAS unsigned* MISC = (volatile LAS unsigned*)(F.lds + MISC_OFF);
    if (F.tid < 16) MISC[F.tid] = 0u;
    __syncthreads();
    XcdBarrier bar; bar.bar = wsp<unsigned>(F, WS_CTL) + CW_BAR; bar.x = 0; bar.st = MISC;
    if (hi - lo > 1) bar = xcd_barrier_post(wsp<unsigned>(F, WS_CTL) + CW_BAR, MISC);
#define IN(k) (lo <= (k) && (k) < hi)
#define REP(k) for (int rep_ = 0; rep_ < 1 + ((MK_REPEAT_MASK >> (k)) & 1); ++rep_)
#define SEAM(k) do { if (IN(k) && IN((k) + 1)) { if ((MK_CG_SEAMS >> (k)) & 1) grid.sync(); else xcd_barrier(bar); } } while (0)

    if (IN(0)) REP(0) { phase0(F); } SEAM(0);
    if (IN(1)) REP(1) { phase1(F); } SEAM(1);
    if (IN(2)) REP(2) {
        pg8::Gemm g{wsp<bf16>(F, WS_H), wsp<bf16>(F, WS_WIN), D, IN_COLS, nullptr};
        pg8::StaticOrder S; S.init(M, IN_COLS, F.G, (int)blockIdx.x);
        pg8::EpiBf16P E{wsp<bf16>(F, WS_P), IN_COLS};
        pg8::gemm_phase<pg8::EpiBf16P, pg8::StaticOrder, false>(F.lds, g, S, E);
    } SEAM(2);
    if (IN(3)) REP(3) { phase3(F); } SEAM(3);
    if (IN(4)) REP(4) {
#if MK_RWKV_MODE >= 1
        for (int q_ = 0; q_ < 1 + (MK_REP4 & 1); ++q_) { phase4a_summaries(F); xcd_barrier(bar); }
        for (int q_ = 0; q_ < 1 + ((MK_REP4 >> 1) & 1); ++q_) { phase4b_states(F); xcd_barrier(bar); }
#endif
#if MK_RWKV_MODE == 2
        for (int q_ = 0; q_ < 1 + ((MK_REP4 >> 2) & 1); ++q_) phase4c_output(F);
#else
        phase4_scan(F);
#endif
        } SEAM(4);
    if (IN(5)) REP(5) { phase5_attn(F); } SEAM(5);
#if MK_RWKV_MODE != 2
    if (IN(6)) REP(6) { phase6(F); } SEAM(6);
#endif
    if (IN(7)) REP(7) {
#if MK_LAST_PHASE >= 7
        pg8::Gemm g{wsp<bf16>(F, WS_CAT), wsp<bf16>(F, WS_WOUT), D, D, nullptr};
        pg8::StaticOrder S; S.init(M, D, F.G, (int)blockIdx.x);
        pg8::EpiOutProj E{F.in[0], F.out, wsp<float>(F, WS_MOD) + 2048};
        pg8::gemm_phase<pg8::EpiOutProj, pg8::StaticOrder, false>(F.lds, g, S, E);
#else
        copy_x_to_out(F);
#endif
    } SEAM(7);
    if (IN(8)) REP(8) { phase8(F); } SEAM(8);
    if (IN(9)) REP(9) { phase9(F); } SEAM(9);
    if (IN(10)) REP(10) {
        const unsigned* ctl = wsp<unsigned>(F, WS_CTL);
        pg8::Gemm g{wsp<bf16>(F, WS_H), wsp<bf16>(F, WS_W1), MK_FP8 ? D / 2 : D, 2 * DE, wsp<int>(F, WS_SLOTTOK)};
        pg8::MoeOrder S{(int)ctl[CW_NTILES], 8, F.G, F.vcu, wsp<int>(F, WS_TILEE)};
        pg8::EpiMoe1 E{wsp<unsigned char>(F, WS_ACT), F.in[25]};
        pg8::gemm_phase<pg8::EpiMoe1, pg8::MoeOrder, true, MK_FP8 != 0>(F.lds, g, S, E);
    } SEAM(10);
    if (IN(11)) REP(11) {
        const unsigned* ctl = wsp<unsigned>(F, WS_CTL);
        pg8::Gemm g{wsp<bf16>(F, WS_ACT), wsp<bf16>(F, WS_W2), MK_FP8 ? DE / 2 : DE, D, nullptr};
        pg8::MoeOrder S{(int)ctl[CW_NTILES], 4, F.G, F.vcu, wsp<int>(F, WS_TILEE)};
        pg8::EpiMoe2 E{wsp<bf16>(F, WS_YS), F.in[27], wsp<float>(F, WS_SLOTGATE)};
        pg8::gemm_phase<pg8::EpiMoe2, pg8::MoeOrder, false, MK_FP8 != 0>(F.lds, g, S, E);
    } SEAM(11);
    if (IN(12)) { phase12(F); }
#undef IN
#undef SEAM
}

extern "C" void kernel_launch(void* const* d_in, const int* in_sizes, int n_in, void* d_out, int out_size, void* d_ws, size_t ws_size, hipStream_t stream) {
    static int grid = 0;
    if (grid == 0) {
        if (n_in != 28 || out_size != M * D || ws_size < WS_END) { fprintf(stderr, "kernel_launch: unexpected sizes (n_in %d out %d ws %zu, need %zu)\n", n_in, out_size, ws_size, (size_t)WS_END); grid = -1; return; }
        int dev = 0, cus = 0, per_cu = 0;
        (void)hipGetDevice(&dev); (void)hipDeviceGetAttribute(&cus, hipDeviceAttributeMultiprocessorCount, dev);
        (void)hipFuncSetAttribute((const void*)mk_fwd, hipFuncAttributeMaxDynamicSharedMemorySize, LDS_BYTES);
        (void)hipOccupancyMaxActiveBlocksPerMultiprocessor(&per_cu, (const void*)mk_fwd, 512, LDS_BYTES);
        if (per_cu < 1 || cus != 256) { fprintf(stderr, "kernel_launch: occupancy %d, CUs %d: this build needs 256 CUs x 1 block\n", per_cu, cus); grid = -1; return; }
        grid = cus;
    }
    if (grid < 0) return;
    (void)hipMemsetAsync((char*)d_ws + WS_CTL, 0, CTL_BYTES, stream);
    Args a{};
    for (int i = 0; i < 28; ++i) a.in[i] = (const float*)d_in[i];
    a.out = (float*)d_out; a.ws = (unsigned char*)d_ws;
    const int last = MK_LAST_PHASE + 1;
#if MK_ONE_LAUNCH
    a.ph_lo = 0; a.ph_hi = last;
#if MK_COOP
    void* kargs[] = {&a};
    hipError_t e = hipLaunchCooperativeKernel((const void*)mk_fwd, dim3(grid), dim3(512), kargs, LDS_BYTES, stream);
    if (e != hipSuccess) fprintf(stderr, "cooperative launch failed: %s\n", hipGetErrorString(e));
#else
    hipLaunchKernelGGL(mk_fwd, dim3(grid), dim3(512), LDS_BYTES, stream, a);
#endif
#else
    for (int p = 0; p < last; ++p) { a.ph_lo = p; a.ph_hi = p + 1; hipLaunchKernelGGL(mk_fwd, dim3(grid), dim3(512), LDS_BYTES, stream, a); }
#endif
}
```

```cpp
#include <hip/hip_runtime.h>
#include <hip/hip_cooperative_groups.h>
#include <cstdio>
#include <cstdint>
namespace cg = cooperative_groups;

#ifndef MK_ONE_LAUNCH
#define MK_ONE_LAUNCH 1
#endif
#ifndef MK_REPEAT_MASK
#define MK_REPEAT_MASK 0
#endif
#ifndef MK_CONV_WHERE
#define MK_CONV_WHERE 9
#endif
#define MK_CONV_IN_SCAN (MK_CONV_WHERE == 4)
#ifndef MK_RWKV_MODE
#define MK_RWKV_MODE 3
#endif
#ifndef MK_FP8
#define MK_FP8 1
#endif
#ifndef MK_DUP
#define MK_DUP 0
#endif
#ifndef MK_REP4
#define MK_REP4 0
#endif
#ifndef MK_CG_SEAMS
#define MK_CG_SEAMS 0
#endif
#ifndef MK_COOP
#define MK_COOP 0
#endif
#ifndef MK_LAST_PHASE
#define MK_LAST_PHASE 12
#endif

constexpr int D = 1024, NBATCH = 8, T = 4096, M = NBATCH * T;
constexpr int HD = 64, RW = 512, RH = 8, AW = 512, QH = 8, KVH = 2, WIN = 128;
constexpr int RWKV_COLS = 1792, IN_COLS = 2560;
constexpr int COL_Q = 1792, COL_K = 1792 + 512, COL_V = 1792 + 512 + 128;
constexpr int NE = 32, TOPK = 4, DE = 1024;
constexpr int MAX_TILES = 544;
constexpr int MAX_SLOTS = MAX_TILES * 256;
constexpr float NORM_EPS = 1e-6f, GN_EPS = 64e-5f;

#define GAS __attribute__((address_space(1)))
#define LAS __attribute__((address_space(3)))
typedef unsigned short bf16;
typedef short bf16x8 __attribute__((ext_vector_type(8)));
typedef float f32x4 __attribute__((ext_vector_type(4)));
typedef float f32x2 __attribute__((ext_vector_type(2)));
typedef float f32x16 __attribute__((ext_vector_type(16)));
typedef unsigned u32x4 __attribute__((ext_vector_type(4)));
typedef unsigned u32x2 __attribute__((ext_vector_type(2)));
typedef int i32x8 __attribute__((ext_vector_type(8)));
typedef int i32x4 __attribute__((ext_vector_type(4)));

constexpr size_t MiB = 1u << 20;
constexpr size_t WS_CTL = 0, CTL_BYTES = 64 * 1024;
constexpr size_t WS_MOD = 1 * MiB;
constexpr size_t WS_BON = 1 * MiB + 256 * 1024;
constexpr size_t WS_RT_E = 2 * MiB;
constexpr size_t WS_RT_LP = 2 * MiB + 512 * 1024;
constexpr size_t WS_RT_G = 3 * MiB;
constexpr size_t WS_TOKSLOT = 3 * MiB + 512 * 1024;
constexpr size_t WS_SLOTTOK = 4 * MiB;
constexpr size_t WS_SLOTGATE = 5 * MiB;
constexpr size_t WS_BLKCNT = 6 * MiB;
constexpr size_t WS_TILEE = 6 * MiB + 64 * 1024;
constexpr size_t WS_BONUS = 7 * MiB;
constexpr size_t WS_LW = 9 * MiB;
constexpr size_t WS_WIN = 10 * MiB;
constexpr size_t WS_WOUT = 16 * MiB;
constexpr size_t WS_W1 = 20 * MiB;
constexpr size_t WS_W2 = 148 * MiB;
constexpr size_t WS_H = 212 * MiB;
constexpr size_t WS_R2 = 276 * MiB;
constexpr size_t WS_P = WS_R2;
constexpr size_t WS_SCN = WS_R2 + 160 * MiB;
constexpr size_t WS_SV = WS_SCN + 320 * MiB;
constexpr size_t WS_G = WS_SV + 64 * MiB;
constexpr size_t WS_Y = WS_G + 32 * MiB;
constexpr size_t WS_CAT = WS_Y + 64 * MiB;
constexpr size_t WS_ACT = WS_R2;
constexpr size_t WS_YS = WS_R2 + 272 * MiB;
constexpr size_t WS_END = 1012 * MiB;
constexpr size_t WS_PT = 436 * MiB;
constexpr size_t WS_ZV = 500 * MiB;
constexpr size_t WS_Z0 = 628 * MiB;
constexpr size_t WS_RYT = 692 * MiB;
constexpr size_t WS_YVT = WS_Y;
static_assert(WS_END <= 1024 * MiB, "workspace map");
static_assert(WS_YS + 272 * MiB <= WS_CAT, "YS must not overlay CAT");
constexpr int CW_NTILES = 16;
constexpr int CW_PADSTART = 64;
constexpr int CW_BAR = 4096;
constexpr int MISC_OFF = 156 * 1024 - 64;

constexpr int LDS_BYTES = 156 * 1024;

__device__ __forceinline__ unsigned f2bf(float f) { unsigned u = __builtin_bit_cast(unsigned, f); return (u + 0x7fffu + ((u >> 16) & 1u)) >> 16; }
typedef __bf16 bf16x2_t __attribute__((ext_vector_type(2)));
__device__ __forceinline__ unsigned pk2(float lo, float hi) { const f32x2 v = {lo, hi}; return __builtin_bit_cast(unsigned, __builtin_convertvector(v, bf16x2_t)); }
__device__ __forceinline__ float bf2f(unsigned short b) { return __builtin_bit_cast(float, ((unsigned)b) << 16); }
__device__ __forceinline__ float bflo(unsigned u) { return __builtin_bit_cast(float, u << 16); }
__device__ __forceinline__ float bfhi(unsigned u) { return __builtin_bit_cast(float, u & 0xffff0000u); }
__device__ __forceinline__ float wave_sum(float v) {
#pragma unroll
    for (int o = 1; o < 64; o <<= 1) v += __shfl_xor(v, o);
    return v;
}
__device__ __forceinline__ void lds_barrier() { asm volatile("s_waitcnt lgkmcnt(0)" ::: "memory"); __builtin_amdgcn_s_barrier(); asm volatile("" ::: "memory"); }
__device__ __forceinline__ float sigmoidf_(float x) { return __builtin_amdgcn_rcpf(1.f + __expf(-x)); }

namespace pg8 {
#define PG8_LAS __attribute__((address_space(3)))
constexpr int BM = 256, BK = 64, HALF = 128, HTB = HALF * BK * 2, STAGE_BYTES = 8 * HTB, NXCD = 8, WGM = 8;
__host__ __device__ __forceinline__ int lds_byte(int r, int c) { const int st = (r >> 4) * 2 + (c >> 5), rr = r & 15, cc = c & 31, ob = rr * 64 + cc * 2; return st * 1024 + (ob ^ (((ob >> 9) & 1) << 5)); }
__host__ __device__ __forceinline__ void stage_rc(int b, int& R, int& C) { const int st = b / 1024, sb = b % 1024, swz = sb ^ (((sb >> 9) & 1) << 5); R = (st >> 1) * 16 + swz / 64; C = (st & 1) * 32 + (swz % 64) / 2; }

struct Unit { int pm, pn, e; };
struct Gemm { const bf16* A; const bf16* Bt; int K, N; const int* rowmap; };

struct StaticOrder {
    int nM, nN, nwg, G, c;
    __device__ void init(int M_, int N_, int G_, int c_) { nM = M_ / BM; nN = N_ / BM; nwg = nM * nN; G = G_; c = c_; }
    __device__ bool next(int i, Unit& u) const {
        const long L = (long)i * G + c; if (L >= nwg) return false;
        int wgid = (int)L; { const int q = nwg / NXCD, r = nwg % NXCD, xcd = wgid % NXCD, off = wgid / NXCD; wgid = (xcd < r ? xcd * (q + 1) : r * (q + 1) + (xcd - r) * q) + off; }
        const int nig = WGM * nN, gid = wgid / nig, fm = gid * WGM, gsz = (nM - fm) < WGM ? (nM - fm) : WGM;
        u.pm = fm + ((wgid % nig) % gsz); u.pn = (wgid % nig) / gsz; u.e = 0; return true;
    }
};
struct MoeOrder {
    int nMt, nN, G, c; const int* tile_e;
    __device__ bool next(int i, Unit& u) const {
        const long L = (long)i * G + c; if (L >= (long)nMt * nN) return false;
        u.pm = (int)(L / nN); u.pn = (int)(L % nN); u.e = tile_e[u.pm]; return true;
    }
};

__device__ __forceinline__ unsigned cvt_pk_bf16(float lo, float hi) { unsigned r; asm volatile("v_cvt_pk_bf16_f32 %0, %1, %2" : "=v"(r) : "v"(lo), "v"(hi)); return r; }

struct EpiBf16P {
    bf16* O; int ldc;
    __device__ __forceinline__ void operator()(const f32x4 (&acc)[2][2][4][2], const Unit& u, int wr, int wc, int fr, int fq) const {
        const int row0 = u.pm * BM + wr * 64 + fr, col0 = u.pn * BM + wc * 32 + 8 * fq;
#pragma unroll
        for (int ai = 0; ai < 2; ++ai)
#pragma unroll
            for (int m = 0; m < 4; ++m) { bf16* rowp = O + (size_t)(row0 + ai * HALF + m * 16) * ldc + col0;
#pragma unroll
                for (int bj = 0; bj < 2; ++bj) { const f32x4 v0 = acc[ai][bj][m][0], v1 = acc[ai][bj][m][1];
                    u32x4 w; w.x = cvt_pk_bf16(v0[0], v0[1]); w.y = cvt_pk_bf16(v0[2], v0[3]); w.z = cvt_pk_bf16(v1[0], v1[1]); w.w = cvt_pk_bf16(v1[2], v1[3]);
                    *(u32x4*)(rowp + bj * HALF) = w; } }
    }
};
struct EpiOutProj {
    const float* x; float* out; const float* gate;
    __device__ __forceinline__ void operator()(const f32x4 (&acc)[2][2][4][2], const Unit& u, int wr, int wc, int fr, int fq) const {
        const int row0 = u.pm * BM + wr * 64 + fr, col0 = u.pn * BM + wc * 32 + 4 * fq;
        const int b = (u.pm * BM) / T;
        f32x4 gv[2][2];
#pragma unroll
        for (int bj = 0; bj < 2; ++bj)
#pragma unroll
            for (int n = 0; n < 2; ++n) gv[bj][n] = *(const f32x4*)(gate + (size_t)b * 6144 + col0 + bj * HALF + n * 16);
#pragma unroll
        for (int ai = 0; ai < 2; ++ai)
#pragma unroll
            for (int m = 0; m < 4; ++m) { const size_t ro = (size_t)(row0 + ai * HALF + m * 16) * D + col0;
#pragma unroll
                for (int bj = 0; bj < 2; ++bj)
#pragma unroll
                    for (int n = 0; n < 2; ++n) { const f32x4 xv = *(const f32x4*)(x + ro + bj * HALF + n * 16);
                        *(f32x4*)(out + ro + bj * HALF + n * 16) = xv + gv[bj][n] * acc[ai][bj][m][n]; } }
    }
};
__device__ __forceinline__ unsigned pk4_fp8(float a, float b, float c, float d) { int w = 0; w = __builtin_amdgcn_cvt_pk_fp8_f32(a, b, w, false); w = __builtin_amdgcn_cvt_pk_fp8_f32(c, d, w, true); return (unsigned)w; }
constexpr float W8_SCALE = 32.f, W8_INV = 1.f / 32.f;
struct EpiMoe1 {
    unsigned char* act; const float* b1;
    __device__ __forceinline__ void operator()(const f32x4 (&acc)[2][2][4][2], const Unit& u, int wr, int wc, int fr, int fq) const {
        const int row0 = u.pm * BM + wr * 64 + fr, j0 = u.pn * 128 + wc * 16 + 4 * fq;
        const float* bb = b1 + (size_t)u.e * 2048;
        f32x4 bg[2], bl[2];
#pragma unroll
        for (int bj = 0; bj < 2; ++bj) { bg[bj] = *(const f32x4*)(bb + j0 + bj * 64); bl[bj] = *(const f32x4*)(bb + 1024 + j0 + bj * 64); }
#pragma unroll
        for (int ai = 0; ai < 2; ++ai)
#pragma unroll
            for (int m = 0; m < 4; ++m) { unsigned char* rowp = act + ((size_t)(row0 + ai * HALF + m * 16) * DE + j0) * (MK_FP8 ? 1 : 2);
#pragma unroll
                for (int bj = 0; bj < 2; ++bj) { const f32x4 g4 = acc[ai][bj][m][0] * (MK_FP8 ? W8_INV : 1.f) + bg[bj], l4 = acc[ai][bj][m][1] * (MK_FP8 ? W8_INV : 1.f) + bl[bj]; float a[4];
#pragma unroll
                    for (int q = 0; q < 4; ++q) { const float gl = fminf(g4[q], 7.0f), li = fminf(fmaxf(l4[q], -7.0f), 7.0f);
                        a[q] = gl * __builtin_amdgcn_rcpf(1.f + __expf(-1.702f * gl)) * (li + 1.f); }
#if MK_FP8
                    *(unsigned*)(rowp + bj * 64) = pk4_fp8(a[0], a[1], a[2], a[3]);
#else
                    u32x2 w; w.x = cvt_pk_bf16(a[0], a[1]); w.y = cvt_pk_bf16(a[2], a[3]); *(u32x2*)(rowp + bj * 128) = w;
#endif
                } }
    }
};
struct EpiMoe2 {
    bf16* ys; const float* b2; const float* sgate;
    __device__ __forceinline__ void operator()(const f32x4 (&acc)[2][2][4][2], const Unit& u, int wr, int wc, int fr, int fq) const {
        const int row0 = u.pm * BM + wr * 64 + fr, col0 = u.pn * BM + wc * 32 + 8 * fq;
        const float* bb = b2 + (size_t)u.e * 1024;
        f32x4 bv[2][2];
#pragma unroll
        for (int bj = 0; bj < 2; ++bj)
#pragma unroll
            for (int n = 0; n < 2; ++n) bv[bj][n] = *(const f32x4*)(bb + col0 + bj * HALF + 4 * n);
#pragma unroll
        for (int ai = 0; ai < 2; ++ai)
#pragma unroll
            for (int m = 0; m < 4; ++m) { const int row = row0 + ai * HALF + m * 16; const float gt = sgate[row]; bf16* rowp = ys + (size_t)row * D + col0;
#pragma unroll
                for (int bj = 0; bj < 2; ++bj) { const f32x4 v0 = (acc[ai][bj][m][0] * (MK_FP8 ? W8_INV : 1.f) + bv[bj][0]) * gt, v1 = (acc[ai][bj][m][1] * (MK_FP8 ? W8_INV : 1.f) + bv[bj][1]) * gt;
                    u32x4 w; w.x = cvt_pk_bf16(v0[0], v0[1]); w.y = cvt_pk_bf16(v0[2], v0[3]); w.z = cvt_pk_bf16(v1[0], v1[1]); w.w = cvt_pk_bf16(v1[2], v1[3]);
                    *(u32x4*)(rowp + bj * HALF) = w; } }
    }
};

template <class Epi, class Sched, bool GATHER, bool FP8 = false>
__device__ __forceinline__ void gemm_phase(PG8_LAS unsigned char* lds, const Gemm g, const Sched& S, const Epi& E) {
    const int tid = threadIdx.x, wid = __builtin_amdgcn_readfirstlane(tid >> 6), lane = tid & 63, wr = wid >> 2, wc = wid & 3, fr = lane & 15, fq = lane >> 4;
    const int K = g.K, nt = K / BK;
    int Rr[2], Cc[2]; unsigned voffB[2];
#pragma unroll
    for (int i = 0; i < 2; ++i) { stage_rc(tid * 16 + i * 8192, Rr[i], Cc[i]); voffB[i] = (unsigned)(Rr[i] * K + Cc[i]) * 2u; }
    const size_t kstep = (size_t)(BK * 2);
    const size_t hstep = (size_t)HALF * K * 2;
    const size_t tstep = 2 * hstep;
    const unsigned ldsw = (unsigned)wid * 1024u;
    const int aoff = lds_byte(wr * 64 + fr, fq * 8), boff = lds_byte(wc * 32 + fr, fq * 8);
#define PG8_SA(b, h) (((b) * 2 + (h)) * HTB)
#define PG8_SB(b, h) ((4 + (b) * 2 + (h)) * HTB)
#define PG8_STAGE(bufoff, gbase, voff) do { _Pragma("unroll") for (int _i = 0; _i < 2; ++_i) \
        __builtin_amdgcn_global_load_lds((const unsigned*)((const char*)(gbase) + (voff)[_i]), (PG8_LAS unsigned*)(lds + (bufoff) + ldsw + _i * 8192), 16, 0, 0); } while (0)
#define PG8_LDA(dst, b, h) do { _Pragma("unroll") for (int m = 0; m < 4; ++m) { const PG8_LAS i32x4* _p = (const PG8_LAS i32x4*)(lds + PG8_SA(b, h) + aoff + m * 2048); \
        dst[m] = __builtin_shufflevector(_p[0], _p[64], 0, 1, 2, 3, 4, 5, 6, 7); } } while (0)
#define PG8_LDB(dst, b, h) do { _Pragma("unroll") for (int n = 0; n < 2; ++n) { const PG8_LAS i32x4* _p = (const PG8_LAS i32x4*)(lds + PG8_SB(b, h) + boff + n * 2048); \
        dst[n] = __builtin_shufflevector(_p[0], _p[64], 0, 1, 2, 3, 4, 5, 6, 7); } } while (0)
#define PG8_MMA(ai, bj, At, Bt) do { __builtin_amdgcn_s_setprio(1); _Pragma("unroll") for (int m = 0; m < 4; ++m) _Pragma("unroll") for (int n = 0; n < 2; ++n) { \
        if constexpr (FP8)   \
            asm volatile("v_mfma_scale_f32_16x16x128_f8f6f4 %0, %1, %2, %0, %3, %3 op_sel_hi:[0,0,0]" : "+v"(acc[ai][bj][m][n]) : "v"(Bt[n]), "v"(At[m]), "v"(0x7F7F7F7F)); \
        else { acc[ai][bj][m][n] = __builtin_amdgcn_mfma_f32_16x16x32_bf16(__builtin_bit_cast(bf16x8, __builtin_shufflevector(Bt[n], Bt[n], 0, 1, 2, 3)), __builtin_bit_cast(bf16x8, __builtin_shufflevector(At[m], At[m], 0, 1, 2, 3)), acc[ai][bj][m][n], 0, 0, 0); \
               acc[ai][bj][m][n] = __builtin_amdgcn_mfma_f32_16x16x32_bf16(__builtin_bit_cast(bf16x8, __builtin_shufflevector(Bt[n], Bt[n], 4, 5, 6, 7)), __builtin_bit_cast(bf16x8, __builtin_shufflevector(At[m], At[m], 4, 5, 6, 7)), acc[ai][bj][m][n], 0, 0, 0); } } \
        __builtin_amdgcn_s_setprio(0); \
        if constexpr (FP8) asm volatile("" : "+v"(acc[ai][bj][0][0]), "+v"(acc[ai][bj][0][1]), "+v"(acc[ai][bj][1][0]), "+v"(acc[ai][bj][1][1]), "+v"(acc[ai][bj][2][0]), "+v"(acc[ai][bj][2][1]), "+v"(acc[ai][bj][3][0]), "+v"(acc[ai][bj][3][1]));   \
        } while (0)
#define PG8_WAIT_V(n) asm volatile("s_waitcnt vmcnt(" #n ")" ::: "memory")
#define PG8_WAIT_L(n) asm volatile("s_waitcnt lgkmcnt(" #n ")" ::: "memory")
#define PG8_BAR __builtin_amdgcn_s_barrier()
#define PG8_SCHED __builtin_amdgcn_sched_barrier(0)
#define PG8_AOFFS(dst, u) do { _Pragma("unroll") for (int _h = 0; _h < 2; ++_h) _Pragma("unroll") for (int _i = 0; _i < 2; ++_i) { int _R, _C; stage_rc((int)threadIdx.x * 16 + _i * 8192, _R, _C); \
        if constexpr (GATHER) { const int _tok = g.rowmap[(u).pm * BM + _h * HALF + _R]; dst[_h][_i] = (unsigned)(_tok * K + _C) * 2u; } \
        else dst[_h][_i] = (unsigned)((_h * HALF + _R) * K + _C) * 2u; } } while (0)
#define PG8_ABASE(u) (GATHER ? (const char*)g.A : (const char*)g.A + (size_t)(u).pm * tstep)
#define PG8_BBASE(u) ((const char*)g.Bt + ((size_t)(u).e * g.N + (size_t)(u).pn * BM) * K * 2)
    Unit cur, nxt, nn; int ui = 0;
    if (!S.next(0, cur)) return;
    bool has_next = S.next(1, nxt);
    unsigned curA[2][2], nxtA[2][2];
    PG8_AOFFS(curA, cur);
    if (has_next) PG8_AOFFS(nxtA, nxt); else {
#pragma unroll
        for (int h = 0; h < 2; ++h)
#pragma unroll
            for (int i = 0; i < 2; ++i) nxtA[h][i] = curA[h][i]; }
    f32x4 acc[2][2][4][2];
#pragma unroll
    for (int a = 0; a < 2; ++a)
#pragma unroll
        for (int b = 0; b < 2; ++b)
#pragma unroll
            for (int m = 0; m < 4; ++m)
#pragma unroll
                for (int n = 0; n < 2; ++n) acc[a][b][m][n] = (f32x4){0.f, 0.f, 0.f, 0.f};
    i32x8 At[4], B0[2], B1[2];
    const char* cA = PG8_ABASE(cur); const char* cB = PG8_BBASE(cur);
    PG8_STAGE(PG8_SB(0, 0), cB, voffB); PG8_STAGE(PG8_SB(0, 1), cB + hstep, voffB); PG8_STAGE(PG8_SA(0, 0), cA, curA[0]); PG8_STAGE(PG8_SA(0, 1), cA, curA[1]);
    if (wr == 1) PG8_BAR;
    PG8_WAIT_V(2); PG8_BAR;
    PG8_STAGE(PG8_SB(1, 0), cB + kstep, voffB); PG8_STAGE(PG8_SA(1, 0), cA + kstep, curA[0]); PG8_STAGE(PG8_SB(1, 1), cB + hstep + kstep, voffB);
    PG8_WAIT_V(6); PG8_BAR;
    for (;;) {
        const char* nA = has_next ? PG8_ABASE(nxt) : cA; const char* nB = has_next ? PG8_BBASE(nxt) : cB;
#pragma unroll 1
        for (int t = 0; t < nt; t += 2) {
            const bool last = (t == nt - 2);
            const char* a1 = cA + (size_t)(t + 1) * kstep;
            const char* a2 = last ? nA : cA + (size_t)(t + 2) * kstep; const char* b2 = last ? nB : cB + (size_t)(t + 2) * kstep;
            const char* a3 = a2 + kstep; const char* b3 = b2 + kstep;
            unsigned o2[2][2];
#pragma unroll
            for (int h = 0; h < 2; ++h)
#pragma unroll
                for (int i = 0; i < 2; ++i) o2[h][i] = last ? nxtA[h][i] : curA[h][i];
            PG8_LDB(B0, 0, 0); PG8_LDB(B1, 0, 1); PG8_SCHED; PG8_LDA(At, 0, 0); PG8_STAGE(PG8_SA(1, 1), a1, curA[1]);
            PG8_WAIT_V(8); PG8_WAIT_L(0); PG8_BAR; PG8_MMA(0, 0, At, B0); PG8_MMA(0, 1, At, B1); PG8_BAR; PG8_SCHED;
            PG8_LDA(At, 0, 1); PG8_STAGE(PG8_SB(0, 0), b2, voffB); PG8_STAGE(PG8_SB(0, 1), b2 + hstep, voffB); PG8_STAGE(PG8_SA(0, 0), a2, o2[0]);
            PG8_WAIT_V(8); PG8_WAIT_L(0); PG8_BAR; PG8_MMA(1, 0, At, B0); PG8_MMA(1, 1, At, B1); PG8_BAR; PG8_SCHED;
            PG8_LDB(B0, 1, 0); PG8_LDB(B1, 1, 1); PG8_SCHED; PG8_LDA(At, 1, 0); PG8_STAGE(PG8_SA(0, 1), a2, o2[1]);
            PG8_WAIT_V(8); PG8_WAIT_L(0); PG8_BAR; PG8_MMA(0, 0, At, B0); PG8_MMA(0, 1, At, B1); PG8_BAR; PG8_SCHED;
            PG8_LDA(At, 1, 1); PG8_STAGE(PG8_SB(1, 0), b3, voffB); PG8_STAGE(PG8_SB(1, 1), b3 + hstep, voffB); PG8_STAGE(PG8_SA(1, 0), a3, o2[0]);
            PG8_WAIT_V(8); PG8_WAIT_L(0); PG8_BAR; PG8_MMA(1, 0, At, B0); PG8_MMA(1, 1, At, B1); PG8_BAR; PG8_SCHED;
        }
        if constexpr (FP8) asm volatile("s_nop 15\n\ts_nop 15" ::: "memory");
        if (wr == 0) PG8_BAR;
        const bool has_nn = has_next && S.next(ui + 2, nn);
        unsigned nnA[2][2];
        if (has_nn) PG8_AOFFS(nnA, nn);
        E(acc, cur, wr, wc, fr, fq);
        if (!has_next) break;
#pragma unroll
        for (int a = 0; a < 2; ++a)
#pragma unroll
            for (int b = 0; b < 2; ++b)
#pragma unroll
                for (int m = 0; m < 4; ++m)
#pragma unroll
                    for (int n = 0; n < 2; ++n) acc[a][b][m][n] = (f32x4){0.f, 0.f, 0.f, 0.f};
        cur = nxt; cA = nA; cB = nB; ++ui;
#pragma unroll
        for (int h = 0; h < 2; ++h)
#pragma unroll
            for (int i = 0; i < 2; ++i) { curA[h][i] = nxtA[h][i]; if (has_nn) nxtA[h][i] = nnA[h][i]; }
        nxt = nn; has_next = has_nn;
        if (wr == 1) PG8_BAR;
    }
    PG8_WAIT_V(0);
    PG8_BAR;
#undef PG8_SA
#undef PG8_SB
#undef PG8_STAGE
#undef PG8_LDA
#undef PG8_LDB
#undef PG8_MMA
#undef PG8_WAIT_V
#undef PG8_WAIT_L
#undef PG8_BAR
#undef PG8_SCHED
#undef PG8_AOFFS
#undef PG8_ABASE
#undef PG8_BBASE
}
}

struct Frame {
    LAS unsigned char* lds;
    int tid, lane, wave, vcu, G;
    const float* const* in;
    float* out;
    unsigned char* ws;
};
template <class Tp> __device__ __forceinline__ Tp* wsp(const Frame& F, size_t off) { return (Tp*)(F.ws + off); }

__device__ __forceinline__ int dest_row(int mode, int s) {
    if (mode == 0) return s;
    if (mode == 1) return (s & ~31) | (((s >> 2) & 1) << 4) | (((s >> 3) & 3) << 2) | (s & 3);
    const int half = s >> 10, j = s & 1023;
    return ((j >> 7) << 8) | (((j >> 6) & 1) << 7) | (((j >> 4) & 3) << 5) | (half << 4) | (j & 15);
}
__device__ __forceinline__ void transpose_item(const float* W, int K, int N, bf16* WT, int mode, int item, int lane) {
    const int nblk = N / 64, kb = item / nblk, nb = item % nblk, k0 = 64 * kb, n0 = 64 * nb;
    const float* src = W + (size_t)k0 * N + n0 + lane;
    float v[64];
#pragma unroll
    for (int i = 0; i < 64; ++i) v[i] = src[(size_t)i * N];
    bf16* dst = WT + (size_t)dest_row(mode, n0 + lane) * K + k0;
#pragma unroll
    for (int j = 0; j < 8; ++j) { u32x4 o; o.x = pk2(v[8 * j], v[8 * j + 1]); o.y = pk2(v[8 * j + 2], v[8 * j + 3]); o.z = pk2(v[8 * j + 4], v[8 * j + 5]); o.w = pk2(v[8 * j + 6], v[8 * j + 7]);
        *(u32x4*)(dst + 8 * j) = o; }
}
__device__ __forceinline__ void transpose_item8(const float* W, int K, int N, unsigned char* WT, int mode, int item, int lane) {
    const int nblk = N / 64, kb = item / nblk, nb = item % nblk, k0 = 64 * kb, n0 = 64 * nb;
    const float* src = W + (size_t)k0 * N + n0 + lane;
    float v[64];
#pragma unroll
    for (int i = 0; i < 64; ++i) v[i] = src[(size_t)i * N] * 32.f;
    unsigned char* dst = WT + (size_t)dest_row(mode, n0 + lane) * K + k0;
#pragma unroll
    for (int j = 0; j < 4; ++j) { u32x4 o; o.x = pg8::pk4_fp8(v[16 * j], v[16 * j + 1], v[16 * j + 2], v[16 * j + 3]); o.y = pg8::pk4_fp8(v[16 * j + 4], v[16 * j + 5], v[16 * j + 6], v[16 * j + 7]);
        o.z = pg8::pk4_fp8(v[16 * j + 8], v[16 * j + 9], v[16 * j + 10], v[16 * j + 11]); o.w = pg8::pk4_fp8(v[16 * j + 12], v[16 * j + 13], v[16 * j + 14], v[16 * j + 15]);
        *(u32x4*)(dst + 16 * j) = o; }
}
constexpr int MOE_I1 = 16 * 32, MOE_I2 = 16 * 16, MOE_ITEMS = NE * (MOE_I1 + MOE_I2);
__device__ __forceinline__ void moe_weight_item(const Frame& F, int it) {
#if !MK_FP8
    if (it < NE * MOE_I1) { const int e = it / MOE_I1; transpose_item(F.in[24] + (size_t)e * 1024 * 2048, 1024, 2048, wsp<bf16>(F, WS_W1) + (size_t)e * 2048 * 1024, 2, it % MOE_I1, F.lane); }
    else { const int r = it - NE * MOE_I1, e = r / MOE_I2; transpose_item(F.in[26] + (size_t)e * 1024 * 1024, 1024, 1024, wsp<bf16>(F, WS_W2) + (size_t)e * 1024 * 1024, 1, r % MOE_I2, F.lane); }
#else
    if (it < NE * MOE_I1) { const int e = it / MOE_I1; transpose_item8(F.in[24] + (size_t)e * 1024 * 2048, 1024, 2048, wsp<unsigned char>(F, WS_W1) + (size_t)e * 2048 * 1024, 2, it % MOE_I1, F.lane); }
    else { const int r = it - NE * MOE_I1, e = r / MOE_I2; transpose_item8(F.in[26] + (size_t)e * 1024 * 1024, 1024, 1024, wsp<unsigned char>(F, WS_W2) + (size_t)e * 1024 * 1024, 1, r % MOE_I2, F.lane); }
#endif
}

__device__ __forceinline__ void phase0(const Frame& F) {
    if (F.vcu < 192) {
        LAS float* sl = (LAS float*)F.lds;
        LAS float* red = (LAS float*)(F.lds + 32768);
        const float* c = F.in[1];
        for (int idx = F.tid; idx < 8192; idx += 512) { const int b = idx & 7, k = idx >> 3; const float cv = c[b * 1024 + k]; sl[idx] = cv / (1.f + __expf(-cv)); }
        __syncthreads();
        const int cl = F.tid & 31, ks = F.tid >> 5, col = F.vcu * 32 + cl;
        const float* wa = F.in[2];
        float acc[8];
#pragma unroll
        for (int b = 0; b < 8; ++b) acc[b] = 0.f;
#pragma unroll 4
        for (int kk = 0; kk < 64; ++kk) { const int k = ks * 64 + kk; const float w = wa[(size_t)k * 6144 + col];
            const f32x4 s0 = *(const LAS f32x4*)(sl + k * 8), s1 = *(const LAS f32x4*)(sl + k * 8 + 4);
            acc[0] += s0[0] * w; acc[1] += s0[1] * w; acc[2] += s0[2] * w; acc[3] += s0[3] * w;
            acc[4] += s1[0] * w; acc[5] += s1[1] * w; acc[6] += s1[2] * w; acc[7] += s1[3] * w; }
#pragma unroll
        for (int b = 0; b < 8; ++b) red[(ks * 32 + cl) * 8 + b] = acc[b];
        __syncthreads();
        if (F.tid < 256) { const int b = F.tid >> 5; float s = F.in[3][col];
            for (int q = 0; q < 16; ++q) s += red[(q * 32 + cl) * 8 + b];
            wsp<float>(F, WS_MOD)[b * 6144 + col] = s; }
    }
    const int gw = F.vcu * 8 + F.wave, NGW = F.G * 8;
    constexpr int I_IN = 16 * 40, I_OUT = 16 * 16;
    constexpr int NITEMS = I_IN + I_OUT;
    for (int it = gw; it < NITEMS; it += NGW) {
        int r = it;
        if (r < I_IN) { transpose_item(F.in[5], 1024, 2560, wsp<bf16>(F, WS_WIN), 1, r, F.lane); continue; } r -= I_IN;
        transpose_item(F.in[20], 1024, 1024, wsp<bf16>(F, WS_WOUT), 0, r, F.lane);
    }
#if MK_CONV_WHERE == 0
    for (int it = gw; it < MOE_ITEMS; it += NGW) moe_weight_item(F, it);
#endif
    { bf16* LW = wsp<bf16>(F, WS_LW);
        for (int idx = F.vcu * 512 + F.tid; idx < 256 * 512; idx += F.G * 512) { const int k = idx >> 9, c = idx & 511;
            const float v = k < 64 ? F.in[8][k * 512 + c] : (k < 128 ? F.in[10][(k - 64) * 512 + c] : F.in[11][(k - 128) * 512 + c]);
            LW[c * 256 + k] = (bf16)f2bf(v); } }
}
template <bool OUT8 = false>
__device__ __forceinline__ void norm_row(const Frame& F, const float* xrow, const float* g, const float* shift, const float* scale, bf16* orow, f32x4 (&h)[4]) {
    const f32x4* xr = (const f32x4*)xrow + F.lane;
    float ss = 0.f;
#pragma unroll
    for (int j = 0; j < 4; ++j) { h[j] = xr[64 * j]; ss += (h[j][0] * h[j][0] + h[j][1] * h[j][1]) + (h[j][2] * h[j][2] + h[j][3] * h[j][3]); }
    const float rstd = rsqrtf(wave_sum(ss) * (1.f / D) + NORM_EPS);
    u32x2* o8 = (u32x2*)orow + F.lane;
#pragma unroll
    for (int j = 0; j < 4; ++j) { const int col = 4 * F.lane + 256 * j;
        const f32x4 gv = *(const f32x4*)(g + col), sh = *(const f32x4*)(shift + col), sc = *(const f32x4*)(scale + col);
        h[j] = h[j] * rstd * gv * (sc + 1.f) + sh;
        if constexpr (OUT8) ((unsigned*)orow)[F.lane + 64 * j] = pg8::pk4_fp8(h[j][0], h[j][1], h[j][2], h[j][3]);
        else { u32x2 w; w.x = pk2(h[j][0], h[j][1]); w.y = pk2(h[j][2], h[j][3]); o8[64 * j] = w; } }
}
__device__ __forceinline__ void phase1(const Frame& F) {
    const int gw = F.vcu * 8 + F.wave, NGW = F.G * 8;
    const float* mod = wsp<float>(F, WS_MOD);
    for (int row = gw; row < M; row += NGW) { const int b = row / T; f32x4 h[4];
        norm_row(F, F.in[0] + (size_t)row * D, F.in[4], mod + b * 6144, mod + b * 6144 + 1024, wsp<bf16>(F, WS_H) + (size_t)row * D, h); }
}

template <int CTRL> __device__ __forceinline__ float dpp_mov(float v) { return __builtin_bit_cast(float, __builtin_amdgcn_update_dpp(0, __builtin_bit_cast(int, v), CTRL, 0xf, 0xf, false)); }
__device__ __forceinline__ float reduce16(float v) { v += dpp_mov<0xB1>(v); v += dpp_mov<0x4E>(v); v += dpp_mov<0x141>(v); v += dpp_mov<0x140>(v); return v; }
__device__ __forceinline__ void lerp8(const bf16* P, const float* mu, int tok, int t, int col, float (&x)[8]) {
    const u32x4 c = *(const u32x4*)(P + (size_t)tok * IN_COLS + col);
    u32x4 p = (u32x4){0u, 0u, 0u, 0u};
    if (t > 0) p = *(const u32x4*)(P + (size_t)(tok - 1) * IN_COLS + col);
    const f32x4 m0 = *(const f32x4*)(mu + col), m1 = *(const f32x4*)(mu + col + 4);
    const float cf[8] = {bflo(c.x), bfhi(c.x), bflo(c.y), bfhi(c.y), bflo(c.z), bfhi(c.z), bflo(c.w), bfhi(c.w)};
    const float pf[8] = {bflo(p.x), bfhi(p.x), bflo(p.y), bfhi(p.y), bflo(p.z), bfhi(p.z), bflo(p.w), bfhi(p.w)};
    const float mf[8] = {m0[0], m0[1], m0[2], m0[3], m1[0], m1[1], m1[2], m1[3]};
#pragma unroll
    for (int j = 0; j < 8; ++j) x[j] = cf[j] + (pf[j] - cf[j]) * mf[j];
}
__device__ __forceinline__ f32x4 lerp4(const bf16* P, const float* mu, int tok, int t, int col) {
    const u32x2 c = *(const u32x2*)(P + (size_t)tok * IN_COLS + col);
    u32x2 p = (u32x2){0u, 0u};
    if (t > 0) p = *(const u32x2*)(P + (size_t)(tok - 1) * IN_COLS + col);
    const f32x4 m = *(const f32x4*)(mu + col);
    const f32x4 cf = (f32x4){bflo(c.x), bfhi(c.x), bflo(c.y), bfhi(c.y)}, pf = (f32x4){bflo(p.x), bfhi(p.x), bflo(p.y), bfhi(p.y)};
    return cf + (pf - cf) * m;
}
__device__ __forceinline__ bf16x8 pack8(const float (&x)[8]) { u32x4 w; w.x = pk2(x[0], x[1]); w.y = pk2(x[2], x[3]); w.z = pk2(x[4], x[5]); w.w = pk2(x[6], x[7]); return __builtin_bit_cast(bf16x8, w); }
__device__ __forceinline__ void phase3(const Frame& F) {
    const bf16* P = wsp<bf16>(F, WS_P); const bf16* LW = wsp<bf16>(F, WS_LW);
    const float* mu = F.in[6]; const float* w0 = F.in[7]; const float* a0 = F.in[9];
    const float* k_k = F.in[12]; const float* k_a = F.in[13]; const float* r_k = F.in[14];
    float* SCN = wsp<float>(F, WS_SCN); float* SV = wsp<float>(F, WS_SV); bf16* G = wsp<bf16>(F, WS_G); float* BON = wsp<float>(F, WS_BONUS);
    const int gw = F.vcu * 8 + F.wave, NGW = F.G * 8;
    const int cl = F.lane & 15, q = F.lane >> 4;
    for (int tile = gw; tile < M / 16; tile += NGW) {
        bf16x8 Aw[2], Aa[2], Ag[4];
        { const int tok = tile * 16 + cl, t = tok % T; float x[8];
#pragma unroll
            for (int s = 0; s < 2; ++s) { lerp8(P, mu, tok, t, 1536 + 32 * s + 8 * q, x);
#pragma unroll
                for (int j = 0; j < 8; ++j) x[j] = tanhf(x[j]);
                Aw[s] = pack8(x);
                lerp8(P, mu, tok, t, 1600 + 32 * s + 8 * q, x); Aa[s] = pack8(x); }
#pragma unroll
            for (int s = 0; s < 4; ++s) { lerp8(P, mu, tok, t, 1664 + 32 * s + 8 * q, x);
#pragma unroll
                for (int j = 0; j < 8; ++j) x[j] = sigmoidf_(x[j]);
                Ag[s] = pack8(x); } }
        const int tk0 = tile * 16 + 4 * q, b = tk0 / T, t0 = tk0 % T;
#pragma unroll 1
        for (int hh = 0; hh < RH; ++hh) {
            const int c0 = hh * 64 + cl * 4;
            f32x4 accw[4], acca[4], accg[4];
#pragma unroll
            for (int ct = 0; ct < 4; ++ct) { const bf16* lw = LW + (size_t)(c0 + ct) * 256 + 8 * q;
                f32x4 aw = (f32x4){0.f, 0.f, 0.f, 0.f}, aa = aw, ag = aw;
#pragma unroll
                for (int s = 0; s < 2; ++s) { aw = __builtin_amdgcn_mfma_f32_16x16x32_bf16(Aw[s], *(const bf16x8*)(lw + 32 * s), aw, 0, 0, 0);
                    aa = __builtin_amdgcn_mfma_f32_16x16x32_bf16(Aa[s], *(const bf16x8*)(lw + 64 + 32 * s), aa, 0, 0, 0); }
#pragma unroll
                for (int s = 0; s < 4; ++s) ag = __builtin_amdgcn_mfma_f32_16x16x32_bf16(Ag[s], *(const bf16x8*)(lw + 128 + 32 * s), ag, 0, 0, 0);
                accw[ct] = aw; acca[ct] = aa; accg[ct] = ag; }
            const f32x4 w0v = *(const f32x4*)(w0 + c0), a0v = *(const f32x4*)(a0 + c0), kkv = *(const f32x4*)(k_k + c0), kav = *(const f32x4*)(k_a + c0), rkv = *(const f32x4*)(r_k + c0);
#pragma unroll
            for (int i = 0; i < 4; ++i) { const int tk = tk0 + i, t = t0 + i;
                const f32x4 r4 = lerp4(P, mu, tk, t, c0), kr4 = lerp4(P, mu, tk, t, 512 + c0), v4 = lerp4(P, mu, tk, t, 1024 + c0);
                f32x4 dec, av, gv, kk4, k4;
                float ssq = 0.f, bon = 0.f;
#pragma unroll
                for (int ct = 0; ct < 4; ++ct) {
                    dec[ct] = __expf(-0.60653066f * sigmoidf_(w0v[ct] + accw[ct][i]));
                    av[ct] = sigmoidf_(a0v[ct] + acca[ct][i]);
                    gv[ct] = accg[ct][i];
                    kk4[ct] = kr4[ct] * kkv[ct]; ssq += kk4[ct] * kk4[ct];
                    k4[ct] = kr4[ct] * (1.f + (av[ct] - 1.f) * kav[ct]);
                    bon += r4[ct] * k4[ct] * rkv[ct]; }
                ssq = reduce16(ssq); bon = reduce16(bon);
                const float inv = __builtin_amdgcn_rcpf(fmaxf(sqrtf(ssq), 1e-12f));
                const f32x4 kkn = kk4 * inv, bb = kkn * av;
                const size_t so = ((size_t)(b * RH + hh) * T + t) * 64 + cl * 4;
                float* sc = SCN + ((size_t)(b * RH + hh) * T + t) * 320 + cl * 4;
                *(f32x4*)(sc) = dec; *(f32x4*)(sc + 64) = kkn; *(f32x4*)(sc + 128) = bb; *(f32x4*)(sc + 192) = k4; *(f32x4*)(sc + 256) = r4;
                *(f32x4*)(SV + so) = v4;
                u32x2 gw2; gw2.x = pk2(gv[0], gv[1]); gw2.y = pk2(gv[2], gv[3]);
                *(u32x2*)(G + (size_t)tk * 512 + c0) = gw2;
                if (cl == 0) BON[tk * 8 + hh] = bon; }
        }
    }
}

constexpr int CK = 32, NCHK = T / CK;
#define SC_SPIN_CAP (1 << 24)
#define MFMA32(a, b, c) __builtin_amdgcn_mfma_f32_32x32x16_bf16((a), (b), (c), 0, 0, 0)
__device__ __forceinline__ int crow(int i, int h) { return (i & 3) + 8 * (i >> 2) + 4 * h; }
template <int S_> __device__ __forceinline__ bf16x8 pack_acc(const f32x16& x) { u32x4 w; w.x = pk2(x[8 * S_], x[8 * S_ + 1]); w.y = pk2(x[8 * S_ + 2], x[8 * S_ + 3]); w.z = pk2(x[8 * S_ + 4], x[8 * S_ + 5]); w.w = pk2(x[8 * S_ + 6], x[8 * S_ + 7]); return __builtin_bit_cast(bf16x8, w); }
__device__ __forceinline__ bf16x8 rd_nat(const LAS bf16* img, int stride, int row, int k0) { return *(const LAS bf16x8*)(img + row * stride + k0); }
__device__ __forceinline__ bf16x8 rd_perm(const LAS bf16* img, int stride, int row, int kb, int h) {
    const u32x2 lo = *(const LAS u32x2*)(img + row * stride + kb + 4 * h), hi = *(const LAS u32x2*)(img + row * stride + kb + 8 + 4 * h);
    u32x4 w; w.x = lo.x; w.y = lo.y; w.z = hi.x; w.w = hi.y; return __builtin_bit_cast(bf16x8, w);
}
__device__ __forceinline__ f32x16 zero16() { f32x16 z; for (int i = 0; i < 16; ++i) z[i] = 0.f; return z; }
constexpr int CL_A = 0, CL_B = 4608, CL_K = 9216, CL_R = 13824, CL_AT = 18432, CL_BHT = 23552, CL_KHT = 28672, CL_VT = 33792, CL_GTOT = 38912, CL_GC = 39936,
              CL_L = 40192, CL_T = 44800, CL_FNRB = 47360, CL_CNRK = 49408, CL_FQM = 53504, CL_GROUP = 57600;
constexpr int RMS = 72, TRS = 40, LST = 36;
__device__ __forceinline__ void phase4a_summaries(const Frame& F) {
    const float* SCN = wsp<float>(F, WS_SCN); const float* SV = wsp<float>(F, WS_SV);
    bf16x8* PT = wsp<bf16x8>(F, WS_PT); f32x4* ZV = wsp<f32x4>(F, WS_ZV); bf16x8* RYT = wsp<bf16x8>(F, WS_RYT); f32x4* YVT = wsp<f32x4>(F, WS_YVT);
    const int grp = F.tid >> 8, gt = F.tid & 255, w4 = F.wave & 3, lane = F.lane, r = lane & 31, h = lane >> 5;
    LAS unsigned char* gl = F.lds + grp * CL_GROUP;
    LAS bf16* iA = (LAS bf16*)(gl + CL_A); LAS bf16* iB = (LAS bf16*)(gl + CL_B); LAS bf16* iK = (LAS bf16*)(gl + CL_K); LAS bf16* iR = (LAS bf16*)(gl + CL_R);
    LAS bf16* iAT = (LAS bf16*)(gl + CL_AT); LAS bf16* iBHT = (LAS bf16*)(gl + CL_BHT); LAS bf16* iKHT = (LAS bf16*)(gl + CL_KHT); LAS bf16* iVT = (LAS bf16*)(gl + CL_VT);
    LAS float* gtot = (LAS float*)(gl + CL_GTOT); LAS float* gcv = (LAS float*)(gl + CL_GC); LAS float* Lm = (LAS float*)(gl + CL_L); LAS bf16* Tm = (LAS bf16*)(gl + CL_T);
    LAS bf16x8* fnrb = (LAS bf16x8*)(gl + CL_FNRB); LAS float* cnrk = (LAS float*)(gl + CL_CNRK); LAS bf16x8* fqm = (LAS bf16x8*)(gl + CL_FQM);
    constexpr int NCHUNKS = NBATCH * RH * NCHK;
    for (int it = F.vcu; it < NCHUNKS / 2; it += F.G) {
        const int chunk = it * 2 + grp, bh = chunk / NCHK, c = chunk % NCHK, t0 = c * CK;
        __syncthreads();
        { const int k = gt & 63, tq = gt >> 6;
            float wv[8], kkv[8], bv[8], kv[8], rv[8], vv[8], lp[8];
#pragma unroll
            for (int i = 0; i < 8; ++i) { const size_t row = (size_t)bh * T + t0 + 8 * tq + i; const float* sc = SCN + row * 320 + k;
                wv[i] = sc[0]; kkv[i] = sc[64]; bv[i] = sc[128]; kv[i] = sc[192]; rv[i] = sc[256]; vv[i] = SV[row * 64 + k]; }
            lp[0] = wv[0];
#pragma unroll
            for (int i = 1; i < 8; ++i) lp[i] = lp[i - 1] * wv[i];
            gtot[tq * 64 + k] = lp[7];
            __syncthreads();
            const float g0 = gtot[k], g1 = gtot[64 + k], g2 = gtot[128 + k], g3 = gtot[192 + k];
            const float pre = tq == 0 ? 1.f : (tq == 1 ? g0 : (tq == 2 ? g0 * g1 : g0 * g1 * g2)), gC = (g0 * g1) * (g2 * g3);
            float at[8], bh8[8], kh8[8];
#pragma unroll
            for (int i = 0; i < 8; ++i) { const float g = pre * lp[i], gp = i == 0 ? pre : pre * lp[i - 1], ig = __builtin_amdgcn_rcpf(g);
                const float bt = bv[i] * ig, kt = kv[i] * ig; at[i] = -kkv[i] * gp; bh8[i] = bt * gC; kh8[i] = kt * gC;
                const int ro = (8 * tq + i) * RMS + k;
                iA[ro] = (bf16)f2bf(at[i]); iB[ro] = (bf16)f2bf(bt); iK[ro] = (bf16)f2bf(kt); iR[ro] = (bf16)f2bf(rv[i] * g); }
            *(LAS bf16x8*)(iAT + k * TRS + 8 * tq) = pack8(at); *(LAS bf16x8*)(iBHT + k * TRS + 8 * tq) = pack8(bh8); *(LAS bf16x8*)(iKHT + k * TRS + 8 * tq) = pack8(kh8);
            *(LAS bf16x8*)(iVT + k * TRS + 8 * tq) = pack8(vv);
            if (tq == 0) gcv[k] = gC; }
        __syncthreads();
        f32x16 lak = zero16();
        { const LAS bf16* ia = (w4 < 2) ? iA : (w4 == 2 ? iB : iK); const LAS bf16* ib = (w4 == 0) ? iB : (w4 == 1 ? iK : iR);
            f32x16 acc = zero16();
#pragma unroll
            for (int ks = 0; ks < 4; ++ks) acc = MFMA32(rd_nat(ia, RMS, r, 16 * ks + 8 * h), rd_nat(ib, RMS, r, 16 * ks + 8 * h), acc);
#pragma unroll
            for (int i = 0; i < 16; ++i) { const int row = crow(i, h); const bool keep = (w4 < 2) ? (r < row) : (row <= r); acc[i] = keep ? acc[i] : 0.f; }
            if (w4 == 0) {
#pragma unroll
                for (int i = 0; i < 16; ++i) Lm[crow(i, h) * LST + r] = acc[i]; }
            else if (w4 == 1) lak = acc;
            else if (w4 == 2) { fnrb[lane] = pack_acc<0>(acc); fnrb[64 + lane] = pack_acc<1>(acc); }
            else {
#pragma unroll
                for (int i = 0; i < 16; ++i) cnrk[i * 64 + lane] = acc[i]; } }
        __syncthreads();
        if (w4 == 0) { float Tr[32];
#pragma unroll
            for (int t = 0; t < 32; ++t) { float acc = (t == r) ? 1.f : 0.f;
#pragma unroll
                for (int s4 = 0; s4 < (t + 3) / 4; ++s4) { const f32x4 l4 = *(const LAS f32x4*)(Lm + t * LST + 4 * s4);
#pragma unroll
                    for (int q = 0; q < 4; ++q) if (4 * s4 + q < t) acc += l4[q] * Tr[4 * s4 + q]; }
                Tr[t] = acc; }
            if (lane < 32) {
#pragma unroll
                for (int t = 0; t < 32; ++t) Tm[t * TRS + r] = (bf16)f2bf(Tr[t]); } }
        __syncthreads();
        if (w4 == 0 || w4 == 2) { const int a = w4 >> 1;
            f32x16 x1 = zero16();
#pragma unroll
            for (int ks = 0; ks < 2; ++ks) x1 = MFMA32(rd_nat(Tm, TRS, r, 16 * ks + 8 * h), rd_nat(iAT, TRS, 32 * a + r, 16 * ks + 8 * h), x1);
            const bf16x8 xf0 = pack_acc<0>(x1), xf1 = pack_acc<1>(x1);
#pragma unroll
            for (int b = 0; b < 2; ++b) { f32x16 p = zero16();
                p = MFMA32(xf0, rd_perm(iBHT, TRS, 32 * b + r, 0, h), p); p = MFMA32(xf1, rd_perm(iBHT, TRS, 32 * b + r, 16, h), p);
                if (a == b) { const float gc = gcv[32 * a + r];
#pragma unroll
                    for (int i = 0; i < 16; ++i) p[i] += (crow(i, h) == r) ? gc : 0.f; }
                bf16x8* dst = PT + ((size_t)(chunk * 2 + a) * 2 + b) * 2 * 64 + lane; dst[0] = pack_acc<0>(p); dst[64] = pack_acc<1>(p); }
            f32x16 ry;
#pragma unroll
            for (int g = 0; g < 4; ++g) { const u32x2 rr = *(const LAS u32x2*)(iR + r * RMS + 32 * a + 8 * g + 4 * h);
                ry[4 * g] = bflo(rr.x); ry[4 * g + 1] = bfhi(rr.x); ry[4 * g + 2] = bflo(rr.y); ry[4 * g + 3] = bfhi(rr.y); }
            ry = MFMA32(xf0, fnrb[lane], ry); ry = MFMA32(xf1, fnrb[64 + lane], ry);
            bf16x8* dr = RYT + (size_t)(chunk * 2 + a) * 2 * 64 + lane; dr[0] = pack_acc<0>(ry); dr[64] = pack_acc<1>(ry);
        } else if (w4 == 1) {
            f32x16 x2 = zero16();
            x2 = MFMA32(rd_perm(Tm, TRS, r, 0, h), pack_acc<0>(lak), x2); x2 = MFMA32(rd_perm(Tm, TRS, r, 16, h), pack_acc<1>(lak), x2);
            const bf16x8 xf0 = pack_acc<0>(x2), xf1 = pack_acc<1>(x2);
#pragma unroll
            for (int b = 0; b < 2; ++b) { f32x16 qm;
#pragma unroll
                for (int g = 0; g < 4; ++g) { const u32x2 kk2 = *(const LAS u32x2*)(iKHT + (32 * b + r) * TRS + 8 * g + 4 * h);
                    qm[4 * g] = bflo(kk2.x); qm[4 * g + 1] = bfhi(kk2.x); qm[4 * g + 2] = bflo(kk2.y); qm[4 * g + 3] = bfhi(kk2.y); }
                qm = MFMA32(xf0, rd_perm(iBHT, TRS, 32 * b + r, 0, h), qm); qm = MFMA32(xf1, rd_perm(iBHT, TRS, 32 * b + r, 16, h), qm);
                fqm[(b * 2 + 0) * 64 + lane] = pack_acc<0>(qm); fqm[(b * 2 + 1) * 64 + lane] = pack_acc<1>(qm); }
            f32x16 gy;
#pragma unroll
            for (int i = 0; i < 16; ++i) gy[i] = cnrk[i * 64 + lane];
            gy = MFMA32(xf0, fnrb[lane], gy); gy = MFMA32(xf1, fnrb[64 + lane], gy);
            const bf16x8 gf0 = pack_acc<0>(gy), gf1 = pack_acc<1>(gy);
#pragma unroll
            for (int vh = 0; vh < 2; ++vh) { f32x16 yv = zero16();
                yv = MFMA32(rd_perm(iVT, TRS, 32 * vh + r, 0, h), gf0, yv); yv = MFMA32(rd_perm(iVT, TRS, 32 * vh + r, 16, h), gf1, yv);
                f32x4* dy = YVT + ((size_t)(chunk * 2 + vh) * 64 + lane) * 4;
#pragma unroll
                for (int g = 0; g < 4; ++g) dy[g] = (f32x4){yv[4 * g], yv[4 * g + 1], yv[4 * g + 2], yv[4 * g + 3]}; }
        }
        __syncthreads();
        if (w4 == 3) {
#pragma unroll
            for (int b = 0; b < 2; ++b)
#pragma unroll
                for (int vh = 0; vh < 2; ++vh) { f32x16 zv = zero16();
                    zv = MFMA32(fqm[(b * 2 + 0) * 64 + lane], rd_perm(iVT, TRS, 32 * vh + r, 0, h), zv); zv = MFMA32(fqm[(b * 2 + 1) * 64 + lane], rd_perm(iVT, TRS, 32 * vh + r, 16, h), zv);
                    f32x4* dz = ZV + (((size_t)(chunk * 2 + b) * 2 + vh) * 64 + lane) * 4;
#pragma unroll
                    for (int g = 0; g < 4; ++g) dz[g] = (f32x4){zv[4 * g], zv[4 * g + 1], zv[4 * g + 2], zv[4 * g + 3]}; }
        }
    }
}
constexpr int CL2_LA = 2 * CL_GROUP, LAS_STRIDE = 264;
static_assert(CL2_LA + 32 * LAS_STRIDE * 2 <= MISC_OFF, "fused summaries LDS map");
__device__ __forceinline__ void phase4a_fused(const Frame& F) {
    const bf16* P = wsp<bf16>(F, WS_P); const bf16* LW = wsp<bf16>(F, WS_LW);
    const float* mu = F.in[6]; const float* w0 = F.in[7]; const float* a0 = F.in[9]; const float* k_k = F.in[12]; const float* k_a = F.in[13]; const float* r_k = F.in[14];
    float* SV = wsp<float>(F, WS_SV); bf16* G = wsp<bf16>(F, WS_G); float* BON = wsp<float>(F, WS_BONUS);
    bf16x8* PT = wsp<bf16x8>(F, WS_PT); f32x4* ZV = wsp<f32x4>(F, WS_ZV); bf16x8* RYT = wsp<bf16x8>(F, WS_RYT); f32x4* YVT = wsp<f32x4>(F, WS_YVT);
    const int grp = F.tid >> 8, gt = F.tid & 255, w4 = F.wave & 3, lane = F.lane, r = lane & 31, h = lane >> 5;
    LAS unsigned char* gl = F.lds + grp * CL_GROUP;
    LAS bf16* iA = (LAS bf16*)(gl + CL_A); LAS bf16* iB = (LAS bf16*)(gl + CL_B); LAS bf16* iK = (LAS bf16*)(gl + CL_K); LAS bf16* iR = (LAS bf16*)(gl + CL_R);
    LAS bf16* iAT = (LAS bf16*)(gl + CL_AT); LAS bf16* iBHT = (LAS bf16*)(gl + CL_BHT); LAS bf16* iKHT = (LAS bf16*)(gl + CL_KHT); LAS bf16* iVT = (LAS bf16*)(gl + CL_VT);
    LAS float* gtot = (LAS float*)(gl + CL_GTOT); LAS float* gcv = (LAS float*)(gl + CL_GC); LAS float* Lm = (LAS float*)(gl + CL_L); LAS bf16* Tm = (LAS bf16*)(gl + CL_T);
    LAS bf16x8* fnrb = (LAS bf16x8*)(gl + CL_FNRB); LAS float* cnrk = (LAS float*)(gl + CL_CNRK); LAS bf16x8* fqm = (LAS bf16x8*)(gl + CL_FQM);
    LAS float* lwo_w = (LAS float*)(gl + CL_L); LAS float* lwo_a = lwo_w + 32 * 64;
    LAS bf16* LA = (LAS bf16*)(F.lds + CL2_LA);
    bf16 cr[9], ck[9], cv[9]; float cst[8]; bool tz;
#define S1_LOAD(tc_, hp_) do { const int _hh = 2 * (hp_) + grp, _cc = _hh * 64 + (gt & 63), _t0 = ((tc_) % NCHK) * CK + 8 * (gt >> 6); \
        const size_t _pr = ((size_t)((tc_) / NCHK) * T + _t0) * IN_COLS + _cc; tz = _t0 > 0; const size_t _pp = tz ? _pr - IN_COLS : _pr; \
        cr[0] = P[_pp]; ck[0] = P[_pp + 512]; cv[0] = P[_pp + 1024]; \
        _Pragma("unroll") for (int _i = 0; _i < 8; ++_i) { cr[_i + 1] = P[_pr + (size_t)_i * IN_COLS]; ck[_i + 1] = P[_pr + (size_t)_i * IN_COLS + 512]; cv[_i + 1] = P[_pr + (size_t)_i * IN_COLS + 1024]; } \
        cst[0] = mu[_cc]; cst[1] = mu[512 + _cc]; cst[2] = mu[1024 + _cc]; cst[3] = w0[_cc]; cst[4] = a0[_cc]; cst[5] = k_k[_cc]; cst[6] = k_a[_cc]; cst[7] = r_k[_cc]; } while (0)
    bf16x8 lwf[8];
#define LW_LOAD(hp_) do { const bf16* _lw = LW + (size_t)((2 * (hp_) + grp) * 64 + 32 * (w4 & 1) + r) * 256 + 8 * h + (w4 < 2 ? 0 : 128); \
        _Pragma("unroll") for (int _q = 0; _q < 8; ++_q) lwf[_q] = *(const bf16x8*)(_lw + 16 * _q); } while (0)
    S1_LOAD(F.vcu, 0);
    LW_LOAD(0);
    for (int tc = F.vcu; tc < M / CK; tc += F.G) {
        const int b = tc / NCHK, c = tc % NCHK, t0 = c * CK, row0 = b * T + t0;
        lds_barrier();
        { const int tk = F.tid >> 4, cb = (F.tid & 15) * 16; float x[8];
#pragma unroll
            for (int q8 = 0; q8 < 2; ++q8) { const int col = cb + 8 * q8; lerp8(P, mu, row0 + tk, t0 + tk, 1536 + col, x);
                if (col < 64) {
#pragma unroll
                    for (int j = 0; j < 8; ++j) x[j] = 2.f * sigmoidf_(2.f * x[j]) - 1.f; }
                else if (col >= 128) {
#pragma unroll
                    for (int j = 0; j < 8; ++j) x[j] = sigmoidf_(x[j]); }
                *(LAS bf16x8*)(LA + tk * LAS_STRIDE + col) = pack8(x); } }
#pragma unroll 1
        for (int hp = 0; hp < 4; ++hp) {
            const int hh = 2 * hp + grp, bh = b * RH + hh, chunk = bh * NCHK + c;
            lds_barrier();
            { const int ct = w4 & 1;
                if (w4 < 2) {
                    f32x16 aw = zero16(), aa = zero16();
#pragma unroll
                    for (int ks = 0; ks < 4; ++ks) { aw = MFMA32(rd_nat(LA, LAS_STRIDE, r, 16 * ks + 8 * h), lwf[ks], aw); aa = MFMA32(rd_nat(LA, LAS_STRIDE, r, 64 + 16 * ks + 8 * h), lwf[4 + ks], aa); }
#pragma unroll
                    for (int i = 0; i < 16; ++i) { lwo_w[crow(i, h) * 64 + 32 * ct + r] = aw[i]; lwo_a[crow(i, h) * 64 + 32 * ct + r] = aa[i]; }
                } else {
                    f32x16 ag = zero16();
#pragma unroll
                    for (int ks = 0; ks < 8; ++ks) ag = MFMA32(rd_nat(LA, LAS_STRIDE, r, 128 + 16 * ks + 8 * h), lwf[ks], ag);
#pragma unroll
                    for (int i = 0; i < 16; ++i) G[(size_t)(row0 + crow(i, h)) * 512 + hh * 64 + 32 * ct + r] = (bf16)f2bf(ag[i]); } }
            LW_LOAD((hp + 1) & 3);
            lds_barrier();
            auto st1 = [&]() { const int k = gt & 63, tq = gt >> 6, cc = hh * 64 + k;
                float wv[8], kkv[8], bv[8], kv[8], rv[8], vv[8], lp[8];
                { const float mur = cst[0], muk = cst[1], muv = cst[2], w0c = cst[3], a0c = cst[4], kkc = cst[5], kac = cst[6], rkc = cst[7];
                    const int tl0 = 8 * tq;
                    if (!tz) { cr[0] = 0; ck[0] = 0; cv[0] = 0; }
                    float lw_[8], la_[8];
#pragma unroll
                    for (int i = 0; i < 8; ++i) { lw_[i] = lwo_w[(tl0 + i) * 64 + k]; la_[i] = lwo_a[(tl0 + i) * 64 + k]; }
                    float kk[8], ssq[8], bo[8], av[8];
#pragma unroll
                    for (int i = 0; i < 8; ++i) { const float c_r = bf2f(cr[i + 1]), c_k = bf2f(ck[i + 1]), c_v = bf2f(cv[i + 1]);
                        rv[i] = c_r + (bf2f(cr[i]) - c_r) * mur; const float kr = c_k + (bf2f(ck[i]) - c_k) * muk; vv[i] = c_v + (bf2f(cv[i]) - c_v) * muv;
                        wv[i] = __expf(-0.60653066f * sigmoidf_(w0c + lw_[i])); av[i] = sigmoidf_(a0c + la_[i]);
                        kk[i] = kr * kkc; ssq[i] = kk[i] * kk[i]; kv[i] = kr * (1.f + (av[i] - 1.f) * kac); bo[i] = rv[i] * kv[i] * rkc; }
#pragma unroll
                    for (int i = 0; i < 8; ++i) { ssq[i] = reduce16(ssq[i]); bo[i] = reduce16(bo[i]); }
#pragma unroll
                    for (int i = 0; i < 8; ++i) { ssq[i] += __shfl_xor(ssq[i], 16); bo[i] += __shfl_xor(bo[i], 16); }
#pragma unroll
                    for (int i = 0; i < 8; ++i) { ssq[i] += __shfl_xor(ssq[i], 32); bo[i] += __shfl_xor(bo[i], 32); }
#pragma unroll
                    for (int i = 0; i < 8; ++i) { kkv[i] = kk[i] * __builtin_amdgcn_rcpf(fmaxf(sqrtf(ssq[i]), 1e-12f)); bv[i] = kkv[i] * av[i];
                        SV[((size_t)bh * T + t0 + tl0 + i) * 64 + k] = vv[i];
                        if (k == 0) BON[(row0 + tl0 + i) * 8 + hh] = bo[i]; } }
                lp[0] = wv[0];
#pragma unroll
                for (int i = 1; i < 8; ++i) lp[i] = lp[i - 1] * wv[i];
                gtot[tq * 64 + k] = lp[7];
                lds_barrier();
                const float g0 = gtot[k], g1 = gtot[64 + k], g2 = gtot[128 + k], g3 = gtot[192 + k];
                const float pre = tq == 0 ? 1.f : (tq == 1 ? g0 : (tq == 2 ? g0 * g1 : g0 * g1 * g2)), gC = (g0 * g1) * (g2 * g3);
                float at[8], bh8[8], kh8[8];
#pragma unroll
                for (int i = 0; i < 8; ++i) { const float g = pre * lp[i], gp = i == 0 ? pre : pre * lp[i - 1], ig = __builtin_amdgcn_rcpf(g);
                    const float bt = bv[i] * ig, kt = kv[i] * ig; at[i] = -kkv[i] * gp; bh8[i] = bt * gC; kh8[i] = kt * gC;
                    const int ro = (8 * tq + i) * RMS + k;
                    iA[ro] = (bf16)f2bf(at[i]); iB[ro] = (bf16)f2bf(bt); iK[ro] = (bf16)f2bf(kt); iR[ro] = (bf16)f2bf(rv[i] * g); }
                *(LAS bf16x8*)(iAT + k * TRS + 8 * tq) = pack8(at); *(LAS bf16x8*)(iBHT + k * TRS + 8 * tq) = pack8(bh8); *(LAS bf16x8*)(iKHT + k * TRS + 8 * tq) = pack8(kh8);
                *(LAS bf16x8*)(iVT + k * TRS + 8 * tq) = pack8(vv);
                if (tq == 0) gcv[k] = gC; };
            st1();
#if MK_DUP & 2
            lds_barrier(); asm volatile("" ::: "memory"); st1();
#endif
            { const int ntc = (hp < 3) ? tc : (tc + F.G < M / CK ? tc + F.G : tc), nhp = (hp < 3) ? hp + 1 : 0; S1_LOAD(ntc, nhp); }
            lds_barrier();
            f32x16 lak = zero16();
            { const LAS bf16* ia = (w4 < 2) ? iA : (w4 == 2 ? iB : iK); const LAS bf16* ib = (w4 == 0) ? iB : (w4 == 1 ? iK : iR);
                f32x16 acc = zero16();
#pragma unroll
                for (int ks = 0; ks < 4; ++ks) acc = MFMA32(rd_nat(ia, RMS, r, 16 * ks + 8 * h), rd_nat(ib, RMS, r, 16 * ks + 8 * h), acc);
#pragma unroll
                for (int i = 0; i < 16; ++i) { const int row = crow(i, h); const bool keep = (w4 < 2) ? (r < row) : (row <= r); acc[i] = keep ? acc[i] : 0.f; }
                if (w4 <= 1) lak = acc;
                else if (w4 == 2) { fnrb[lane] = pack_acc<0>(acc); fnrb[64 + lane] = pack_acc<1>(acc); }
                else {
#pragma unroll
                    for (int i = 0; i < 16; ++i) cnrk[i * 64 + lane] = acc[i]; } }
            lds_barrier();
            auto st3 = [&]() { if (w4 == 0) {
                LAS bf16* imgL = (LAS bf16*)(gl + CL_L);
                f32x16 Lp = lak, Tq = lak;
#pragma unroll
                for (int i = 0; i < 16; ++i) Tq[i] += (crow(i, h) == r) ? 1.f : 0.f;
#pragma unroll
                for (int st = 0; st < 4; ++st) {
#pragma unroll
                    for (int i = 0; i < 16; ++i) { imgL[crow(i, h) * TRS + r] = (bf16)f2bf(Lp[i]); Tm[crow(i, h) * TRS + r] = (bf16)f2bf(Tq[i]); }
                    asm volatile("s_waitcnt lgkmcnt(0)" ::: "memory");
                    const bf16x8 b0 = pack_acc<0>(Lp), b1 = pack_acc<1>(Lp);
                    f32x16 l2 = zero16(); l2 = MFMA32(rd_perm(imgL, TRS, r, 0, h), b0, l2); l2 = MFMA32(rd_perm(imgL, TRS, r, 16, h), b1, l2);
                    Lp = l2;
                    f32x16 mm = l2;
#pragma unroll
                    for (int i = 0; i < 16; ++i) mm[i] += (crow(i, h) == r) ? 1.f : 0.f;
                    const bf16x8 m0 = pack_acc<0>(mm), m1 = pack_acc<1>(mm);
                    f32x16 t2 = zero16(); t2 = MFMA32(rd_perm(Tm, TRS, r, 0, h), m0, t2); t2 = MFMA32(rd_perm(Tm, TRS, r, 16, h), m1, t2);
                    Tq = t2;
                    asm volatile("s_waitcnt lgkmcnt(0)" ::: "memory"); }
#pragma unroll
                for (int i = 0; i < 16; ++i) Tm[crow(i, h) * TRS + r] = (bf16)f2bf(Tq[i]); } };
            st3();
#if MK_DUP & 4
            asm volatile("" ::: "memory"); st3();
#endif
            lds_barrier();
            auto st4 = [&]() { if (w4 == 0 || w4 == 2) { const int a = w4 >> 1;
                f32x16 x1 = zero16();
#pragma unroll
                for (int ks = 0; ks < 2; ++ks) x1 = MFMA32(rd_nat(Tm, TRS, r, 16 * ks + 8 * h), rd_nat(iAT, TRS, 32 * a + r, 16 * ks + 8 * h), x1);
                const bf16x8 xf0 = pack_acc<0>(x1), xf1 = pack_acc<1>(x1);
#pragma unroll
                for (int b = 0; b < 2; ++b) { f32x16 p = zero16();
                    p = MFMA32(xf0, rd_perm(iBHT, TRS, 32 * b + r, 0, h), p); p = MFMA32(xf1, rd_perm(iBHT, TRS, 32 * b + r, 16, h), p);
                    if (a == b) { const float gc = gcv[32 * a + r];
#pragma unroll
                        for (int i = 0; i < 16; ++i) p[i] += (crow(i, h) == r) ? gc : 0.f; }
                    bf16x8* dst = PT + ((size_t)(chunk * 2 + a) * 2 + b) * 2 * 64 + lane; dst[0] = pack_acc<0>(p); dst[64] = pack_acc<1>(p); }
                f32x16 ry;
#pragma unroll
                for (int g = 0; g < 4; ++g) { const u32x2 rr = *(const LAS u32x2*)(iR + r * RMS + 32 * a + 8 * g + 4 * h);
                    ry[4 * g] = bflo(rr.x); ry[4 * g + 1] = bfhi(rr.x); ry[4 * g + 2] = bflo(rr.y); ry[4 * g + 3] = bfhi(rr.y); }
                ry = MFMA32(xf0, fnrb[lane], ry); ry = MFMA32(xf1, fnrb[64 + lane], ry);
                bf16x8* dr = RYT + (size_t)(chunk * 2 + a) * 2 * 64 + lane; dr[0] = pack_acc<0>(ry); dr[64] = pack_acc<1>(ry);
            } else if (w4 == 1) {
                f32x16 x2 = zero16();
                x2 = MFMA32(rd_perm(Tm, TRS, r, 0, h), pack_acc<0>(lak), x2); x2 = MFMA32(rd_perm(Tm, TRS, r, 16, h), pack_acc<1>(lak), x2);
                const bf16x8 xf0 = pack_acc<0>(x2), xf1 = pack_acc<1>(x2);
#pragma unroll
                for (int b = 0; b < 2; ++b) { f32x16 qm;
#pragma unroll
                    for (int g = 0; g < 4; ++g) { const u32x2 kk2 = *(const LAS u32x2*)(iKHT + (32 * b + r) * TRS + 8 * g + 4 * h);
                        qm[4 * g] = bflo(kk2.x); qm[4 * g + 1] = bfhi(kk2.x); qm[4 * g + 2] = bflo(kk2.y); qm[4 * g + 3] = bfhi(kk2.y); }
                    qm = MFMA32(xf0, rd_perm(iBHT, TRS, 32 * b + r, 0, h), qm); qm = MFMA32(xf1, rd_perm(iBHT, TRS, 32 * b + r, 16, h), qm);
                    fqm[(b * 2 + 0) * 64 + lane] = pack_acc<0>(qm); fqm[(b * 2 + 1) * 64 + lane] = pack_acc<1>(qm); }
                f32x16 gy;
#pragma unroll
                for (int i = 0; i < 16; ++i) gy[i] = cnrk[i * 64 + lane];
                gy = MFMA32(xf0, fnrb[lane], gy); gy = MFMA32(xf1, fnrb[64 + lane], gy);
                const bf16x8 gf0 = pack_acc<0>(gy), gf1 = pack_acc<1>(gy);
#pragma unroll
                for (int vh = 0; vh < 2; ++vh) { f32x16 yv = zero16();
                    yv = MFMA32(rd_perm(iVT, TRS, 32 * vh + r, 0, h), gf0, yv); yv = MFMA32(rd_perm(iVT, TRS, 32 * vh + r, 16, h), gf1, yv);
                    f32x4* dy = YVT + ((size_t)(chunk * 2 + vh) * 64 + lane) * 4;
#pragma unroll
                    for (int g = 0; g < 4; ++g) dy[g] = (f32x4){yv[4 * g], yv[4 * g + 1], yv[4 * g + 2], yv[4 * g + 3]}; }
            } };
            st4();
#if MK_DUP & 8
            asm volatile("" ::: "memory"); st4();
#endif
            lds_barrier();
            if (w4 == 3) {
#pragma unroll
                for (int b = 0; b < 2; ++b)
#pragma unroll
                    for (int vh = 0; vh < 2; ++vh) { f32x16 zv = zero16();
                        zv = MFMA32(fqm[(b * 2 + 0) * 64 + lane], rd_perm(iVT, TRS, 32 * vh + r, 0, h), zv); zv = MFMA32(fqm[(b * 2 + 1) * 64 + lane], rd_perm(iVT, TRS, 32 * vh + r, 16, h), zv);
                        f32x4* dz = ZV + (((size_t)(chunk * 2 + b) * 2 + vh) * 64 + lane) * 4;
#pragma unroll
                        for (int g = 0; g < 4; ++g) dz[g] = (f32x4){zv[4 * g], zv[4 * g + 1], zv[4 * g + 2], zv[4 * g + 3]}; }
            }
        }
    }
#undef S1_LOAD
#undef LW_LOAD
}
constexpr int SB_SLOT = 16384, SB_NSLOT = 7, SB_FLAGS = SB_NSLOT * SB_SLOT;
__device__ __forceinline__ void phase4b_states(const Frame& F) {
    volatile LAS unsigned* FULL = (volatile LAS unsigned*)(F.lds + SB_FLAGS);
    volatile LAS unsigned* DONEC = (volatile LAS unsigned*)(F.lds + SB_FLAGS + 64);
    __syncthreads();
    if (F.tid < 32) ((LAS unsigned*)(F.lds + SB_FLAGS))[F.tid] = 0u;
    __syncthreads();
    if (F.vcu < 128) {
        const int bh = F.vcu >> 1, vh = F.vcu & 1, lane = F.lane;
        if (F.wave == 0) {
            bf16x8* Z0 = wsp<bf16x8>(F, WS_Z0);
            f32x16 z0 = zero16(), z1 = zero16();
            int slot = 0;
            for (int c = 0; c < NCHK; ++c) { const int chunk = bh * NCHK + c;
                const bf16x8 f00 = pack_acc<0>(z0), f01 = pack_acc<1>(z0), f10 = pack_acc<0>(z1), f11 = pack_acc<1>(z1);
                bf16x8* dz = Z0 + (size_t)(chunk * 2 + vh) * 4 * 64 + lane; dz[0] = f00; dz[64] = f01; dz[128] = f10; dz[192] = f11;
                { int sp = 0; while (FULL[slot] < (unsigned)(c + 1)) { if (++sp > SC_SPIN_CAP) break; } }
                __builtin_amdgcn_fence(__ATOMIC_ACQUIRE, "workgroup");
                const LAS unsigned char* sb = F.lds + slot * SB_SLOT;
                const LAS bf16x8* p = (const LAS bf16x8*)sb + lane;
                const LAS f32x4* s0 = (const LAS f32x4*)(sb + 8192) + lane * 4; const LAS f32x4* s1 = (const LAS f32x4*)(sb + 12288) + lane * 4;
                f32x16 n0, n1;
#pragma unroll
                for (int g = 0; g < 4; ++g) { const f32x4 u = s0[g], w = s1[g]; n0[4 * g] = u[0]; n0[4 * g + 1] = u[1]; n0[4 * g + 2] = u[2]; n0[4 * g + 3] = u[3]; n1[4 * g] = w[0]; n1[4 * g + 1] = w[1]; n1[4 * g + 2] = w[2]; n1[4 * g + 3] = w[3]; }
                const bf16x8 p000 = p[0 * 64], p001 = p[1 * 64], p010 = p[2 * 64], p011 = p[3 * 64], p100 = p[4 * 64], p101 = p[5 * 64], p110 = p[6 * 64], p111 = p[7 * 64];
                asm volatile("s_waitcnt lgkmcnt(0)" ::: "memory");
                if (lane == 0) DONEC[0] = (unsigned)(c + 1);
                n0 = MFMA32(p000, f00, n0); n0 = MFMA32(p001, f01, n0); n0 = MFMA32(p100, f10, n0); n0 = MFMA32(p101, f11, n0);
                n1 = MFMA32(p010, f00, n1); n1 = MFMA32(p011, f01, n1); n1 = MFMA32(p110, f10, n1); n1 = MFMA32(p111, f11, n1);
                z0 = n0; z1 = n1;
                slot = (slot + 1 == SB_NSLOT) ? 0 : slot + 1; }
        } else {
            const int slot = F.wave - 1;
            const unsigned char* gpt = (const unsigned char*)wsp<bf16x8>(F, WS_PT) + lane * 16;
            const unsigned char* gzv = (const unsigned char*)wsp<f32x4>(F, WS_ZV) + lane * 16;
            LAS unsigned char* dst = F.lds + slot * SB_SLOT;
            for (int c = slot; c < NCHK; c += SB_NSLOT) { const int chunk = bh * NCHK + c;
                if (c >= SB_NSLOT) { const unsigned need = (unsigned)(c - SB_NSLOT + 1); int sp = 0;
                    while (DONEC[0] < need) { __builtin_amdgcn_s_sleep(1); if (++sp > SC_SPIN_CAP) break; }
                    __builtin_amdgcn_fence(__ATOMIC_ACQUIRE, "workgroup"); }
                const unsigned char* sp_ = gpt + (size_t)chunk * 8192;
#pragma unroll
                for (int j = 0; j < 8; ++j) __builtin_amdgcn_global_load_lds((const unsigned*)(sp_ + j * 1024), (LAS unsigned*)(dst + j * 1024), 16, 0, 0);
                const unsigned char* sz0 = gzv + ((size_t)(chunk * 2 + 0) * 2 + vh) * 4096; const unsigned char* sz1 = gzv + ((size_t)(chunk * 2 + 1) * 2 + vh) * 4096;
#pragma unroll
                for (int j = 0; j < 4; ++j) { __builtin_amdgcn_global_load_lds((const unsigned*)(sz0 + j * 1024), (LAS unsigned*)(dst + 8192 + j * 1024), 16, 0, 0);
                    __builtin_amdgcn_global_load_lds((const unsigned*)(sz1 + j * 1024), (LAS unsigned*)(dst + 12288 + j * 1024), 16, 0, 0); }
                asm volatile("s_waitcnt vmcnt(0)" ::: "memory");
                if (lane == 0) FULL[slot] = (unsigned)(c + 1); }
        }
    }
    __syncthreads();
}

__device__ __forceinline__ void phase4c_output(const Frame& F) {
    const bf16x8* Z0 = wsp<bf16x8>(F, WS_Z0); const bf16x8* RYT = wsp<bf16x8>(F, WS_RYT); const f32x4* YVT = wsp<f32x4>(F, WS_YVT);
    const float* SV = wsp<float>(F, WS_SV); const bf16* G = wsp<bf16>(F, WS_G); const float* BON = wsp<float>(F, WS_BONUS); bf16* CAT = wsp<bf16>(F, WS_CAT);
    const float* lg = F.in[15]; const float* lb = F.in[16];
    const int gw = F.vcu * 8 + F.wave, NGW = F.G * 8, lane = F.lane, r = lane & 31, h = lane >> 5;
    for (int chunk = gw; chunk < NBATCH * RH * NCHK; chunk += NGW) {
        const int bh = chunk / NCHK, c = chunk % NCHK, b = bh / RH, hh = bh % RH, t = c * CK + r, row = b * T + t;
        const bf16x8* rf = RYT + (size_t)chunk * 4 * 64 + lane;
        f32x16 y[2];
#pragma unroll
        for (int vh = 0; vh < 2; ++vh) { const f32x4* sy = YVT + ((size_t)(chunk * 2 + vh) * 64 + lane) * 4;
#pragma unroll
            for (int g = 0; g < 4; ++g) { const f32x4 u = sy[g]; y[vh][4 * g] = u[0]; y[vh][4 * g + 1] = u[1]; y[vh][4 * g + 2] = u[2]; y[vh][4 * g + 3] = u[3]; }
            const bf16x8* zf = Z0 + (size_t)(chunk * 2 + vh) * 4 * 64 + lane;
#pragma unroll
            for (int q = 0; q < 4; ++q) y[vh] = MFMA32(zf[q * 64], rf[q * 64], y[vh]); }
        float sm = 0.f;
#pragma unroll
        for (int vh = 0; vh < 2; ++vh)
#pragma unroll
            for (int i = 0; i < 16; ++i) sm += y[vh][i];
        sm += __shfl_xor(sm, 32);
        const float mean = sm * (1.f / 64.f); float qv = 0.f;
#pragma unroll
        for (int vh = 0; vh < 2; ++vh)
#pragma unroll
            for (int i = 0; i < 16; ++i) { y[vh][i] -= mean; qv += y[vh][i] * y[vh][i]; }
        qv += __shfl_xor(qv, 32);
        const float rstd = rsqrtf(qv * (1.f / 64.f) + GN_EPS);
        const float bon = BON[row * 8 + hh];
#pragma unroll
        for (int vh = 0; vh < 2; ++vh)
#pragma unroll
            for (int g = 0; g < 4; ++g) { const int v0 = 32 * vh + 8 * g + 4 * h, c0 = hh * 64 + v0;
                const f32x4 vv = *(const f32x4*)(SV + ((size_t)bh * T + t) * 64 + v0), lg4 = *(const f32x4*)(lg + c0), lb4 = *(const f32x4*)(lb + c0);
                const u32x2 gr = *(const u32x2*)(G + (size_t)row * 512 + c0);
                const float gg[4] = {bflo(gr.x), bfhi(gr.x), bflo(gr.y), bfhi(gr.y)}; float o[4];
#pragma unroll
                for (int q = 0; q < 4; ++q) o[q] = (y[vh][4 * g + q] * rstd * lg4[q] + lb4[q] + bon * vv[q]) * gg[q];
                u32x2 w; w.x = pk2(o[0], o[1]); w.y = pk2(o[2], o[3]);
                *(u32x2*)(CAT + (size_t)row * D + c0) = w; }
    }
}

constexpr int SC_STEPS = 16, SC_NSLOT = 6, SC_SHARED = SC_STEPS * 1280, SC_SLOT = SC_SHARED + SC_STEPS * 64, SC_RING = SC_NSLOT * SC_SLOT;
constexpr int SC_FLAGS = SC_RING, SC_CONV = SC_RING + 256, SC_NCH = T / SC_STEPS;
static_assert(SC_CONV + 3 * 8704 <= LDS_BYTES, "scan LDS map");
__device__ __forceinline__ void phase4_scan(const Frame& F) {
    volatile LAS unsigned* READY = (volatile LAS unsigned*)(F.lds + SC_FLAGS);
    volatile LAS unsigned* DONE = (volatile LAS unsigned*)(F.lds + SC_FLAGS + 64);
    __syncthreads();
    if (F.tid < 64) ((LAS unsigned*)(F.lds + SC_FLAGS))[F.tid] = 0u;
    __syncthreads();
    const int bh = F.vcu >> 2, rg = F.vcu & 3, b = bh / RH, hh = bh % RH;
    if (F.wave < 4) {
        const int rl = F.lane >> 4, ks = F.lane & 15, rowl = F.wave * 4 + rl;
        float* yp = wsp<float>(F, WS_Y) + (size_t)b * T * 512 + hh * 64 + rg * 16 + rowl;
        f32x4 S = (f32x4){0.f, 0.f, 0.f, 0.f};
        int slot = 0;
        for (int c = 0; c < SC_NCH; ++c) {
#if MK_RWKV_MODE == 1
            if ((c & 1) == 0) {
                const int v = rg * 16 + rowl, chunk = bh * NCHK + (c >> 1);
                const bf16* zp = wsp<bf16>(F, WS_Z0) + ((((size_t)chunk * 2 + (v >> 5)) * 2 + (ks >> 3)) * 2 + ((ks >> 2) & 1)) * 512 + ((v & 31) + 32 * (ks & 1)) * 8 + 4 * ((ks >> 1) & 1);
                const u32x2 zz = *(const u32x2*)zp;
                S = (f32x4){bflo(zz.x), bfhi(zz.x), bflo(zz.y), bfhi(zz.y)}; }
#endif
            { int sp = 0; while (READY[slot] < (unsigned)(c + 1)) { if (++sp > SC_SPIN_CAP) break; } }
            __builtin_amdgcn_fence(__ATOMIC_ACQUIRE, "workgroup");
            const LAS unsigned char* sb = F.lds + slot * SC_SLOT;
            const LAS unsigned char* op = sb + ks * 16; const LAS float* vp = (const LAS float*)(sb + SC_SHARED) + rowl;
            f32x4 w4 = *(const LAS f32x4*)(op), kk4 = *(const LAS f32x4*)(op + 256), b4 = *(const LAS f32x4*)(op + 512), k4 = *(const LAS f32x4*)(op + 768), r4 = *(const LAS f32x4*)(op + 1024);
            float v = vp[0];
            float ykeep = 0.f;
#pragma unroll
            for (int s = 0; s < SC_STEPS; ++s) {
                const f32x4 cw = w4, ckk = kk4, cb = b4, ck = k4, cr = r4; const float cv = v;
                if (s + 1 < SC_STEPS) { const LAS unsigned char* o2 = op + (s + 1) * 1280;
                    w4 = *(const LAS f32x4*)(o2); kk4 = *(const LAS f32x4*)(o2 + 256); b4 = *(const LAS f32x4*)(o2 + 512); k4 = *(const LAS f32x4*)(o2 + 768); r4 = *(const LAS f32x4*)(o2 + 1024);
                    v = vp[(s + 1) * 16]; }
                if (s == SC_STEPS - 1) { asm volatile("s_waitcnt lgkmcnt(0)" ::: "memory"); if (F.lane == 0) DONE[F.wave] = (unsigned)(c + 1); }
                float p = (S[0] * ckk[0] + S[1] * ckk[1]) + (S[2] * ckk[2] + S[3] * ckk[3]);
                p = reduce16(p);
                const f32x4 tt = S * cw + ck * cv;
                S = tt - cb * p;
                float q = (S[0] * cr[0] + S[1] * cr[1]) + (S[2] * cr[2] + S[3] * cr[3]);
                q = reduce16(q);
                ykeep = (ks == s) ? q : ykeep;
            }
            yp[(size_t)(c * SC_STEPS + ks) * 512] = ykeep;
            slot = (slot + 1 == SC_NSLOT) ? 0 : slot + 1;
        }
    } else if (F.wave == 4) {
        const unsigned char* gs = (const unsigned char*)(wsp<float>(F, WS_SCN) + (size_t)bh * T * 320) + F.lane * 16;
        const unsigned char* gv = (const unsigned char*)(wsp<float>(F, WS_SV) + (size_t)bh * T * 64 + (F.lane >> 2) * 64 + rg * 16 + (F.lane & 3) * 4);
        int slot = 0;
        for (int c = 0; c < SC_NCH; ++c) {
            if (c >= SC_NSLOT) { const unsigned need = (unsigned)(c - SC_NSLOT + 1); int sp = 0;
                while (DONE[0] < need || DONE[1] < need || DONE[2] < need || DONE[3] < need) { __builtin_amdgcn_s_sleep(1); if (++sp > SC_SPIN_CAP) break; }
                __builtin_amdgcn_fence(__ATOMIC_ACQUIRE, "workgroup"); }
            LAS unsigned char* dst = F.lds + slot * SC_SLOT;
            const unsigned char* src = gs + (size_t)c * SC_SHARED;
#pragma unroll
            for (int j = 0; j < SC_SHARED / 1024; ++j) __builtin_amdgcn_global_load_lds((const unsigned*)(src + j * 1024), (LAS unsigned*)(dst + j * 1024), 16, 0, 0);
            __builtin_amdgcn_global_load_lds((const unsigned*)(gv + (size_t)c * SC_STEPS * 256), (LAS unsigned*)(dst + SC_SHARED), 16, 0, 0);
            if (c >= 2) { asm volatile("s_waitcnt vmcnt(42)" ::: "memory"); const int ps = (slot >= 2) ? slot - 2 : slot + SC_NSLOT - 2; if (F.lane == 0) READY[ps] = (unsigned)(c - 1); }
            slot = (slot + 1 == SC_NSLOT) ? 0 : slot + 1;
        }
        { asm volatile("s_waitcnt vmcnt(21)" ::: "memory"); const int ps = (slot >= 2) ? slot - 2 : slot + SC_NSLOT - 2; if (F.lane == 0) READY[ps] = (unsigned)(SC_NCH - 1); }
        { asm volatile("s_waitcnt vmcnt(0)" ::: "memory"); const int ps = (slot >= 1) ? slot - 1 : SC_NSLOT - 1; if (F.lane == 0) READY[ps] = (unsigned)(SC_NCH); }
    } else {
#if MK_CONV_IN_SCAN
        for (int it = F.vcu * 3 + (F.wave - 5); it < MOE_ITEMS; it += F.G * 3) moe_weight_item(F, it);
#endif
    }
    __syncthreads();
}

constexpr int KLD = 72;
constexpr int VLD = 260;
__device__ __forceinline__ void phase5_attn(const Frame& F) {
    const bf16* P = wsp<bf16>(F, WS_P);
    bf16* CAT = wsp<bf16>(F, WS_CAT);
    const float* qg = F.in[17]; const float* kg = F.in[18]; const float* sinks = F.in[19];
    LAS bf16* Kl = (LAS bf16*)F.lds;
    LAS bf16* Vt = (LAS bf16*)(F.lds + 256 * KLD * 2);
    const int lane = F.lane, r = lane & 31, h = lane >> 5;
    for (int unit = F.vcu; unit < NBATCH * KVH * (T / 128); unit += F.G) {
        const int blk = unit % (T / 128), kvh = (unit / (T / 128)) % KVH, b = unit / (T / 128 * KVH);
        const int kpos0 = blk * 128 - 128;
        __syncthreads();
        for (int ch = F.tid; ch < 2048; ch += 512) { const int key = ch >> 3, dc = ch & 7, kpos = kpos0 + key;
            u32x4 kraw = (u32x4){0u, 0u, 0u, 0u}, vraw = (u32x4){0u, 0u, 0u, 0u};
            if (kpos >= 0) { const size_t ro = (size_t)(b * T + kpos) * IN_COLS; kraw = *(const u32x4*)(P + ro + COL_K + kvh * 64 + dc * 8); vraw = *(const u32x4*)(P + ro + COL_V + kvh * 64 + dc * 8); }
            float kf[8]; kf[0] = bflo(kraw.x); kf[1] = bfhi(kraw.x); kf[2] = bflo(kraw.y); kf[3] = bfhi(kraw.y); kf[4] = bflo(kraw.z); kf[5] = bfhi(kraw.z); kf[6] = bflo(kraw.w); kf[7] = bfhi(kraw.w);
            float ss = 0.f;
#pragma unroll
            for (int j = 0; j < 8; ++j) ss += kf[j] * kf[j];
            ss += __shfl_xor(ss, 1); ss += __shfl_xor(ss, 2); ss += __shfl_xor(ss, 4);
            const float rstd = rsqrtf(ss * (1.f / 64.f) + NORM_EPS);
            const f32x4 g0 = *(const f32x4*)(kg + dc * 8), g1 = *(const f32x4*)(kg + dc * 8 + 4);
            u32x4 ko; ko.x = pk2(kf[0] * rstd * g0[0], kf[1] * rstd * g0[1]); ko.y = pk2(kf[2] * rstd * g0[2], kf[3] * rstd * g0[3]);
            ko.z = pk2(kf[4] * rstd * g1[0], kf[5] * rstd * g1[1]); ko.w = pk2(kf[6] * rstd * g1[2], kf[7] * rstd * g1[3]);
            *(LAS u32x4*)(Kl + key * KLD + dc * 8) = ko;
            const unsigned vv[4] = {vraw.x, vraw.y, vraw.z, vraw.w};
#pragma unroll
            for (int j = 0; j < 4; ++j) { Vt[(dc * 8 + 2 * j) * VLD + key] = (bf16)(vv[j] & 0xffffu); Vt[(dc * 8 + 2 * j + 1) * VLD + key] = (bf16)(vv[j] >> 16); }
        }
        __syncthreads();
        for (int task = F.wave; task < 16; task += 8) {
            const int g = task & 3, qs = task >> 2, head = kvh * 4 + g;
            const int qrow = b * T + blk * 128 + qs * 32 + r;
            float qf[4][8]; float ss = 0.f;
#pragma unroll
            for (int s = 0; s < 4; ++s) { const u32x4 qr = *(const u32x4*)(P + (size_t)qrow * IN_COLS + COL_Q + head * 64 + 16 * s + 8 * h);
                qf[s][0] = bflo(qr.x); qf[s][1] = bfhi(qr.x); qf[s][2] = bflo(qr.y); qf[s][3] = bfhi(qr.y); qf[s][4] = bflo(qr.z); qf[s][5] = bfhi(qr.z); qf[s][6] = bflo(qr.w); qf[s][7] = bfhi(qr.w);
#pragma unroll
                for (int j = 0; j < 8; ++j) ss += qf[s][j] * qf[s][j]; }
            ss += __shfl_xor(ss, 32);
            const float qscale = rsqrtf(ss * (1.f / 64.f) + NORM_EPS) * 0.125f;
            bf16x8 qb[4];
#pragma unroll
            for (int s = 0; s < 4; ++s) { u32x4 w;
                const f32x4 g0 = *(const f32x4*)(qg + 16 * s + 8 * h), g1 = *(const f32x4*)(qg + 16 * s + 8 * h + 4);
                w.x = pk2(qf[s][0] * qscale * g0[0], qf[s][1] * qscale * g0[1]); w.y = pk2(qf[s][2] * qscale * g0[2], qf[s][3] * qscale * g0[3]);
                w.z = pk2(qf[s][4] * qscale * g1[0], qf[s][5] * qscale * g1[1]); w.w = pk2(qf[s][6] * qscale * g1[2], qf[s][7] * qscale * g1[3]);
                qb[s] = __builtin_bit_cast(bf16x8, w); }
            f32x16 st[5];
#pragma unroll
            for (int kt = 0; kt < 5; ++kt) {
#pragma unroll
                for (int i = 0; i < 16; ++i) st[kt][i] = 0.f;
#pragma unroll
                for (int s = 0; s < 4; ++s) { const bf16x8 ka = *(const LAS bf16x8*)(Kl + (32 * (qs + kt) + r) * KLD + 16 * s + 8 * h);
                    st[kt] = __builtin_amdgcn_mfma_f32_32x32x16_bf16(ka, qb[s], st[kt], 0, 0, 0); }
            }
            const int iq = 32 * qs + r;
            const float sink = sinks[head];
            float mx = sink;
#pragma unroll
            for (int kt = 0; kt < 5; ++kt)
#pragma unroll
                for (int i = 0; i < 16; ++i) { const int jw = 32 * (qs + kt) + (i & 3) + 8 * (i >> 2) + 4 * h;
                    const bool ok = (jw >= iq + 1) && (jw <= iq + 128) && (kpos0 + jw >= 0);
                    st[kt][i] = ok ? st[kt][i] : -INFINITY; mx = fmaxf(mx, st[kt][i]); }
            mx = fmaxf(mx, __shfl_xor(mx, 32));
            float lsum = 0.f;
#pragma unroll
            for (int kt = 0; kt < 5; ++kt)
#pragma unroll
                for (int i = 0; i < 16; ++i) { const float p = __expf(st[kt][i] - mx); st[kt][i] = p; lsum += p; }
            lsum += __shfl_xor(lsum, 32);
            const float linv = __builtin_amdgcn_rcpf(lsum + __expf(sink - mx));
            f32x16 o[2];
#pragma unroll
            for (int dt = 0; dt < 2; ++dt)
#pragma unroll
                for (int i = 0; i < 16; ++i) o[dt][i] = 0.f;
#pragma unroll
            for (int kt = 0; kt < 5; ++kt)
#pragma unroll
                for (int sp = 0; sp < 2; ++sp) { u32x4 pw;
                    pw.x = pk2(st[kt][8 * sp + 0] * linv, st[kt][8 * sp + 1] * linv); pw.y = pk2(st[kt][8 * sp + 2] * linv, st[kt][8 * sp + 3] * linv);
                    pw.z = pk2(st[kt][8 * sp + 4] * linv, st[kt][8 * sp + 5] * linv); pw.w = pk2(st[kt][8 * sp + 6] * linv, st[kt][8 * sp + 7] * linv);
                    const bf16x8 pa = __builtin_bit_cast(bf16x8, pw);
                    const int kb = 32 * (qs + kt) + 16 * sp + 4 * h;
#pragma unroll
                    for (int dt = 0; dt < 2; ++dt) { const LAS bf16* vp = Vt + (32 * dt + r) * VLD + kb;
                        const u32x2 lo = *(const LAS u32x2*)vp, hi = *(const LAS u32x2*)(vp + 8);
                        u32x4 vw; vw.x = lo.x; vw.y = lo.y; vw.z = hi.x; vw.w = hi.y;
                        o[dt] = __builtin_amdgcn_mfma_f32_32x32x16_bf16(pa, __builtin_bit_cast(bf16x8, vw), o[dt], 0, 0, 0); } }
#pragma unroll
            for (int dt = 0; dt < 2; ++dt)
#pragma unroll
                for (int i = 0; i < 16; ++i) { const int qr = (i & 3) + 8 * (i >> 2) + 4 * h;
                    CAT[(size_t)(b * T + blk * 128 + qs * 32 + qr) * D + 512 + head * 64 + 32 * dt + r] = (bf16)f2bf(o[dt][i]); }
        }
    }
}

__device__ __forceinline__ void phase6(const Frame& F) {
    const int gw = F.vcu * 8 + F.wave, NGW = F.G * 8;
    const float* Y = wsp<float>(F, WS_Y); const float* SV = wsp<float>(F, WS_SV); const bf16* G = wsp<bf16>(F, WS_G); const float* BON = wsp<float>(F, WS_BONUS);
    bf16* CAT = wsp<bf16>(F, WS_CAT);
    const float* lg = F.in[15]; const float* lb = F.in[16];
    const int hh = F.lane >> 3, n0 = (F.lane & 7) * 8, c0 = F.lane * 8;
    for (int row = gw; row < M; row += NGW) { const int b = row / T, t = row % T;
        const f32x4 y0 = *(const f32x4*)(Y + (size_t)row * 512 + c0), y1 = *(const f32x4*)(Y + (size_t)row * 512 + c0 + 4);
        float yv[8] = {y0[0], y0[1], y0[2], y0[3], y1[0], y1[1], y1[2], y1[3]};
        float s = 0.f;
#pragma unroll
        for (int j = 0; j < 8; ++j) s += yv[j];
        s += __shfl_xor(s, 1); s += __shfl_xor(s, 2); s += __shfl_xor(s, 4);
        const float mean = s * (1.f / 64.f); float q = 0.f;
#pragma unroll
        for (int j = 0; j < 8; ++j) { yv[j] -= mean; q += yv[j] * yv[j]; }
        q += __shfl_xor(q, 1); q += __shfl_xor(q, 2); q += __shfl_xor(q, 4);
        const float rstd = rsqrtf(q * (1.f / 64.f) + GN_EPS);
        const float bon = BON[row * 8 + hh];
        const float* vp = SV + ((size_t)(b * RH + hh) * T + t) * 64 + n0;
        const f32x4 v0 = *(const f32x4*)vp, v1 = *(const f32x4*)(vp + 4);
        const float vv[8] = {v0[0], v0[1], v0[2], v0[3], v1[0], v1[1], v1[2], v1[3]};
        const u32x4 graw = *(const u32x4*)(G + (size_t)row * 512 + c0);
        const float gg[8] = {bflo(graw.x), bfhi(graw.x), bflo(graw.y), bfhi(graw.y), bflo(graw.z), bfhi(graw.z), bflo(graw.w), bfhi(graw.w)};
        float ov[8];
#pragma unroll
        for (int j = 0; j < 8; ++j) ov[j] = (yv[j] * rstd * lg[c0 + j] + lb[c0 + j] + bon * vv[j]) * gg[j];
        u32x4 w; w.x = pk2(ov[0], ov[1]); w.y = pk2(ov[2], ov[3]); w.z = pk2(ov[4], ov[5]); w.w = pk2(ov[6], ov[7]);
        *(u32x4*)(CAT + (size_t)row * D + c0) = w; }
}

__device__ __forceinline__ float reduce32x64(float (&v)[32], int lane) {
#pragma unroll
    for (int i = 0; i < 16; ++i) { const bool hi = lane & 16; const float send = hi ? v[i] : v[i + 16], keep = hi ? v[i + 16] : v[i]; v[i] = keep + __shfl_xor(send, 16); }
#pragma unroll
    for (int i = 0; i < 8; ++i) { const bool hi = lane & 8; const float send = hi ? v[i] : v[i + 8], keep = hi ? v[i + 8] : v[i]; v[i] = keep + __shfl_xor(send, 8); }
#pragma unroll
    for (int i = 0; i < 4; ++i) { const bool hi = lane & 4; const float send = hi ? v[i] : v[i + 4], keep = hi ? v[i + 4] : v[i]; v[i] = keep + __shfl_xor(send, 4); }
#pragma unroll
    for (int i = 0; i < 2; ++i) { const bool hi = lane & 2; const float send = hi ? v[i] : v[i + 2], keep = hi ? v[i + 2] : v[i]; v[i] = keep + __shfl_xor(send, 2); }
    { const bool hi = lane & 1; const float send = hi ? v[0] : v[1], keep = hi ? v[1] : v[0]; v[0] = keep + __shfl_xor(send, 1); }
    return v[0] + __shfl_xor(v[0], 32);
}
__device__ __forceinline__ void phase8(const Frame& F) {
    const float* mod = wsp<float>(F, WS_MOD); const float* x1 = F.out;
    const float* wr_ = F.in[22]; const float* br = F.in[23];
    LAS float* Wt = (LAS float*)F.lds;
    LAS float* lgw = (LAS float*)(F.lds + 131072 + F.wave * 512);
    LAS int* cnt = (LAS int*)(F.lds + 131072 + 4096);
    __syncthreads();
    for (int idx = F.tid; idx < 8192; idx += 512) { const int k = idx >> 3, e4 = idx & 7; const f32x4 w = *(const f32x4*)(wr_ + k * 32 + e4 * 4);
        Wt[(4 * e4 + 0) * 1024 + k] = w[0]; Wt[(4 * e4 + 1) * 1024 + k] = w[1]; Wt[(4 * e4 + 2) * 1024 + k] = w[2]; Wt[(4 * e4 + 3) * 1024 + k] = w[3]; }
    if (F.tid < 32) cnt[F.tid] = 0;
    __syncthreads();
    int* RT_E = wsp<int>(F, WS_RT_E); int* RT_LP = wsp<int>(F, WS_RT_LP); float* RT_G = wsp<float>(F, WS_RT_G);
    const int e = F.lane & 31;
    const float bre = br[e];
    for (int pr = 0; pr < 8; ++pr) { const int row0 = F.vcu * 128 + F.wave * 16 + 2 * pr, b = row0 / T;
        f32x4 h0[4], h1[4];
        norm_row<MK_FP8>(F, x1 + (size_t)row0 * D, F.in[21], mod + b * 6144 + 3072, mod + b * 6144 + 4096, (bf16*)(wsp<unsigned char>(F, WS_H) + (size_t)row0 * D * (MK_FP8 ? 1 : 2)), h0);
        norm_row<MK_FP8>(F, x1 + (size_t)(row0 + 1) * D, F.in[21], mod + b * 6144 + 3072, mod + b * 6144 + 4096, (bf16*)(wsp<unsigned char>(F, WS_H) + (size_t)(row0 + 1) * D * (MK_FP8 ? 1 : 2)), h1);
        float pa0[32], pa1[32];
#pragma unroll
        for (int q = 0; q < 32; ++q) { float s0 = 0.f, s1 = 0.f;
#pragma unroll
            for (int j = 0; j < 4; ++j) { const f32x4 w4 = *(const LAS f32x4*)(Wt + q * 1024 + 4 * F.lane + 256 * j);
                s0 += (h0[j][0] * w4[0] + h0[j][1] * w4[1]) + (h0[j][2] * w4[2] + h0[j][3] * w4[3]);
                s1 += (h1[j][0] * w4[0] + h1[j][1] * w4[1]) + (h1[j][2] * w4[2] + h1[j][3] * w4[3]); }
            pa0[q] = s0; pa1[q] = s1; }
        const float lg0 = reduce32x64(pa0, F.lane) + bre, lg1 = reduce32x64(pa1, F.lane) + bre;
#pragma unroll
        for (int q = 0; q < 2; ++q) { const float logit = q ? lg1 : lg0; const int row = row0 + q; LAS float* lg32 = lgw + q * 64;
            if (F.lane < 32) lg32[e] = logit;
            asm volatile("s_waitcnt lgkmcnt(0)" ::: "memory");
            int rank = 0;
#pragma unroll 8
            for (int o = 0; o < 32; ++o) { const float ov = lg32[o]; rank += (ov > logit || (ov == logit && o < e)) ? 1 : 0; }
            if (F.lane < 32 && rank < 4) lg32[32 + rank] = logit;
            asm volatile("s_waitcnt lgkmcnt(0)" ::: "memory");
            const float t0 = lg32[32], t1 = lg32[33], t2 = lg32[34], t3 = lg32[35];
            const float den = 1.f + __expf(t1 - t0) + __expf(t2 - t0) + __expf(t3 - t0);
            if (F.lane < 32 && rank < 4) { const int lp = atomicAdd((int*)&cnt[e], 1);
                RT_E[row * 4 + rank] = e; RT_LP[row * 4 + rank] = lp; RT_G[row * 4 + rank] = __expf(logit - t0) / den; }
            asm volatile("s_waitcnt lgkmcnt(0)" ::: "memory"); }
    }
    __syncthreads();
    if (F.tid < 32) wsp<int>(F, WS_BLKCNT)[F.vcu * 32 + F.tid] = cnt[F.tid];
}

__device__ __forceinline__ void phase9(const Frame& F) {
    LAS int* base = (LAS int*)F.lds;
    LAS int* tot = base + 32;
    LAS int* pst = base + 64;
    const int* BC = wsp<int>(F, WS_BLKCNT);
    if (F.tid < 32) { int s = 0, mine = 0; for (int bk = 0; bk < F.G; ++bk) { if (bk == F.vcu) mine = s; s += BC[bk * 32 + F.tid]; } base[F.tid] = mine; tot[F.tid] = s; }
    __syncthreads();
    if (F.tid == 0) { int s = 0; for (int e = 0; e < 32; ++e) { pst[e] = s; s += (tot[e] + 255) / 256 * 256; } pst[32] = s; }
    __syncthreads();
    int* SLOT_TOK = wsp<int>(F, WS_SLOTTOK); float* SLOT_GATE = wsp<float>(F, WS_SLOTGATE); int* TOK_SLOT = wsp<int>(F, WS_TOKSLOT);
    const int* RT_E = wsp<int>(F, WS_RT_E); const int* RT_LP = wsp<int>(F, WS_RT_LP); const float* RT_G = wsp<float>(F, WS_RT_G);
    { const int idx = F.vcu * 512 + F.tid;
        const int e = RT_E[idx], slot = pst[e] + base[e] + RT_LP[idx];
        SLOT_TOK[slot] = idx >> 2; SLOT_GATE[slot] = RT_G[idx]; TOK_SLOT[idx] = slot; }
    if (F.vcu < 32) { const int e = F.vcu; for (int s = pst[e] + tot[e] + F.tid; s < pst[e + 1]; s += 512) { SLOT_TOK[s] = 0; SLOT_GATE[s] = 0.f; } }
    if (F.vcu == 0) { unsigned* ctl = wsp<unsigned>(F, WS_CTL);
        if (F.tid == 0) ctl[CW_NTILES] = (unsigned)(pst[32] / 256);
        if (F.tid < 33) ctl[CW_PADSTART + F.tid] = (unsigned)pst[F.tid];
        int* TE = wsp<int>(F, WS_TILEE);
        for (int tl = F.tid; tl < MAX_TILES; tl += 512) { int e = 31; for (int q = 0; q < 32; ++q) if (tl * 256 < pst[q + 1]) { e = q; break; } TE[tl] = e; } }
#if MK_CONV_WHERE == 9
    for (int it = F.vcu * 8 + F.wave; it < MOE_ITEMS; it += F.G * 8) moe_weight_item(F, it);
#endif
}

__device__ __forceinline__ void phase12(const Frame& F) {
    const int gw = F.vcu * 8 + F.wave, NGW = F.G * 8;
    const float* mod = wsp<float>(F, WS_MOD); const bf16* YS = wsp<bf16>(F, WS_YS); const int* TOK_SLOT = wsp<int>(F, WS_TOKSLOT);
    for (int row = gw; row < M; row += NGW) { const int b = row / T;
        int sl[4];
#pragma unroll
        for (int k = 0; k < 4; ++k) sl[k] = TOK_SLOT[row * 4 + k];
#pragma unroll
        for (int j = 0; j < 2; ++j) { const int col = 8 * F.lane + 512 * j;
            float a[8];
#pragma unroll
            for (int q = 0; q < 8; ++q) a[q] = 0.f;
#pragma unroll
            for (int k = 0; k < 4; ++k) { const u32x4 v = *(const u32x4*)(YS + (size_t)sl[k] * D + col);
                a[0] += bflo(v.x); a[1] += bfhi(v.x); a[2] += bflo(v.y); a[3] += bfhi(v.y); a[4] += bflo(v.z); a[5] += bfhi(v.z); a[6] += bflo(v.w); a[7] += bfhi(v.w); }
            const float* gp = mod + b * 6144 + 5120 + col;
            const f32x4 g0 = *(const f32x4*)gp, g1 = *(const f32x4*)(gp + 4);
            float* op = F.out + (size_t)row * D + col;
            f32x4 x0 = *(const f32x4*)op, x1v = *(const f32x4*)(op + 4);
            x0[0] += g0[0] * a[0]; x0[1] += g0[1] * a[1]; x0[2] += g0[2] * a[2]; x0[3] += g0[3] * a[3];
            x1v[0] += g1[0] * a[4]; x1v[1] += g1[1] * a[5]; x1v[2] += g1[2] * a[6]; x1v[3] += g1[3] * a[7];
            *(f32x4*)op = x0; *(f32x4*)(op + 4) = x1v; } }
}

__device__ __forceinline__ void copy_x_to_out(const Frame& F) {
    const size_t n4 = (size_t)M * D / 4; const f32x4* s = (const f32x4*)F.in[0]; f32x4* d = (f32x4*)F.out;
    for (size_t i = (size_t)blockIdx.x * 512 + F.tid; i < n4; i += (size_t)gridDim.x * 512) d[i] = s[i];
}


#define XB_TMO      128
#define XB_XCNT(j)  (256  + 64 * (j))
#define XB_XSUB(j)  (1280 + 64 * (j))
#define XB_XGEN(j)  (2304 + 64 * (j))
#define XB_TOP      3328
#define XB_TOPGEN   3392
#define XCD_BAR_WORDS 3456
#define XB_SPIN_CAP (1u << 18)
__device__ __forceinline__ unsigned xb_ld(unsigned* p)              { return __hip_atomic_load(p, __ATOMIC_RELAXED, __HIP_MEMORY_SCOPE_AGENT); }
__device__ __forceinline__ unsigned xb_add(unsigned* p, unsigned v) { return __hip_atomic_fetch_add(p, v, __ATOMIC_RELAXED, __HIP_MEMORY_SCOPE_AGENT); }
__device__ __forceinline__ unsigned xb_xcc_id() { return (unsigned)__builtin_amdgcn_s_getreg((3 << 11) | 20) & 0xFu; }
#define XB_SPIN(cond, bar) do { unsigned _sp = 0; while (cond) { __builtin_amdgcn_s_sleep(1); \
    if ((++_sp & 255u) == 0u) { if (xb_ld(&(bar)[XB_TMO])) break; if (_sp > XB_SPIN_CAP) { atomicAdd(&(bar)[XB_TMO], 1u); break; } } } } while (0)
struct XcdBarrier { unsigned* bar; unsigned x; volatile LAS unsigned* st; };
__device__ __forceinline__ XcdBarrier xcd_barrier_post(unsigned* bar, volatile LAS unsigned* st) {
    XcdBarrier b; b.bar = bar; b.x = xb_xcc_id(); b.st = st;
    if (threadIdx.x == 0) (void)xb_add(&bar[XB_XCNT(b.x)], 1u);
    return b;
}
__device__ __forceinline__ void xcd_barrier_complete(unsigned* bar, unsigned x, unsigned& nloc, unsigned& nx) {
    const unsigned G = gridDim.x * gridDim.y * gridDim.z;
    unsigned sum, cnt, mine, sp = 0u;
    for (;;) {
        sum = 0u; cnt = 0u; mine = 0u;
#pragma unroll
        for (unsigned j = 0; j < 16; ++j) { const unsigned c = xb_ld(&bar[XB_XCNT(j)]); sum += c; cnt += (c > 0u) ? 1u : 0u; mine = (j == x) ? c : mine; }
        if (sum == G) break;
        __builtin_amdgcn_s_sleep(1);
        if ((++sp & 255u) == 0u) { if (xb_ld(&bar[XB_TMO])) break; if (sp > XB_SPIN_CAP) { atomicAdd(&bar[XB_TMO], 1u); break; } }
    }
    nloc = mine > 0u ? mine : 1u; nx = cnt > 0u ? cnt : 1u;
}
__device__ __forceinline__ void xcd_barrier(const XcdBarrier& b) {
    asm volatile("s_waitcnt vmcnt(0)" ::: "memory");
    __syncthreads();
    if (threadIdx.x == 0) {
        unsigned* bar = b.bar;
        __builtin_amdgcn_s_waitcnt(0);
        unsigned nloc = b.st[0], nx = b.st[1];
        if (nloc == 0u) { xcd_barrier_complete(bar, b.x, nloc, nx); b.st[0] = nloc; b.st[1] = nx; }
        const unsigned old = xb_add(&bar[XB_XSUB(b.x)], 1u);
        const unsigned gen = old / nloc;
        if (old + 1u == (gen + 1u) * nloc) {
            __builtin_amdgcn_fence(__ATOMIC_RELEASE, "agent");
            asm volatile("s_waitcnt vmcnt(0)" ::: "memory");
            const unsigned og = xb_add(&bar[XB_TOP], 1u);
            const unsigned tg = og / nx;
            if (og + 1u == (tg + 1u) * nx) xb_add(&bar[XB_TOPGEN], 1u);
            else XB_SPIN(xb_ld(&bar[XB_TOPGEN]) == tg, bar);
            __builtin_amdgcn_fence(__ATOMIC_ACQUIRE, "agent");
            xb_add(&bar[XB_XGEN(b.x)], 1u);
            asm volatile("s_waitcnt vmcnt(0)" ::: "memory");
        } else {
            XB_SPIN(xb_ld(&bar[XB_XGEN(b.x)]) == gen, bar);
            __builtin_amdgcn_fence(__ATOMIC_ACQUIRE, "agent");
            asm volatile("s_waitcnt vmcnt(0)" ::: "memory");
        }
    }
    __syncthreads();
}

struct Args { const float* in[28]; float* out; unsigned char* ws; int ph_lo, ph_hi; };
constexpr int N_PHASES = 13;

__global__ void __launch_bounds__(512, 2) mk_fwd(Args args) {
    extern __shared__ __attribute__((aligned(16))) unsigned char lds_raw[];
    Frame F;
    F.lds = (LAS unsigned char*)lds_raw;
    F.tid = threadIdx.x; F.lane = F.tid & 63; F.wave = __builtin_amdgcn_readfirstlane(F.tid >> 6);
    F.G = gridDim.x; { const int bx = blockIdx.x; F.vcu = (F.G % 8 == 0) ? (bx % 8) * (F.G / 8) + bx / 8 : bx; }
    F.in = args.in;
    F.out = args.out; F.ws = args.ws;
    cg::grid_group grid = cg::this_grid();
    const int lo = args.ph_lo, hi = args.ph_hi;
    volatile LAS unsigned* MISC = (volatile LAS unsigned*)(F.lds + MISC_OFF);
    if (F.tid < 16) MISC[F.tid] = 0u;
    __syncthreads();
    XcdBarrier bar; bar.bar = wsp<unsigned>(F, WS_CTL) + CW_BAR; bar.x = 0; bar.st = MISC;
    if (hi - lo > 1) bar = xcd_barrier_post(wsp<unsigned>(F, WS_CTL) + CW_BAR, MISC);
#define IN(k) (lo <= (k) && (k) < hi)
#define REP(k) for (int rep_ = 0; rep_ < 1 + ((MK_REPEAT_MASK >> (k)) & 1); ++rep_)
#define SEAM(k) do { if (IN(k) && IN((k) + 1)) { if ((MK_CG_SEAMS >> (k)) & 1) grid.sync(); else xcd_barrier(bar); } } while (0)

    if (IN(0)) REP(0) { phase0(F); } SEAM(0);
    if (IN(1)) REP(1) { phase1(F); } SEAM(1);
    if (IN(2)) REP(2) {
#if MK_CONV_WHERE == 2
        if ((int)blockIdx.x >= 192) { for (int it = ((int)blockIdx.x - 192) * 8 + F.wave; it < MOE_ITEMS; it += 64 * 8) moe_weight_item(F, it); }
        else {
        pg8::Gemm g{wsp<bf16>(F, WS_H), wsp<bf16>(F, WS_WIN), D, IN_COLS, nullptr};
        pg8::StaticOrder S; S.init(M, IN_COLS, 192, (int)blockIdx.x);
        pg8::EpiBf16P E{wsp<bf16>(F, WS_P), IN_COLS};
        pg8::gemm_phase<pg8::EpiBf16P, pg8::StaticOrder, false>(F.lds, g, S, E);
        }
#else
        pg8::Gemm g{wsp<bf16>(F, WS_H), wsp<bf16>(F, WS_WIN), D, IN_COLS, nullptr};
        pg8::StaticOrder S; S.init(M, IN_COLS, F.G, (int)blockIdx.x);
        pg8::EpiBf16P E{wsp<bf16>(F, WS_P), IN_COLS};
        pg8::gemm_phase<pg8::EpiBf16P, pg8::StaticOrder, false>(F.lds, g, S, E);
#endif
    } SEAM(2);
#if MK_RWKV_MODE != 3
    if (IN(3)) REP(3) { phase3(F); } SEAM(3);
#endif
    if (IN(4)) REP(4) {
#if MK_RWKV_MODE >= 1
#if MK_RWKV_MODE == 3
        for (int q_ = 0; q_ < 1 + (MK_REP4 & 1); ++q_) { phase4a_fused(F); xcd_barrier(bar); }
#else
        for (int q_ = 0; q_ < 1 + (MK_REP4 & 1); ++q_) { phase4a_summaries(F); xcd_barrier(bar); }
#endif
        for (int q_ = 0; q_ < 1 + ((MK_REP4 >> 1) & 1); ++q_) { phase4b_states(F); xcd_barrier(bar); }
#endif
#if MK_RWKV_MODE >= 2
        for (int q_ = 0; q_ < 1 + ((MK_REP4 >> 2) & 1); ++q_) phase4c_output(F);
#else
        phase4_scan(F);
#endif
        } SEAM(4);
    if (IN(5)) REP(5) { phase5_attn(F); } SEAM(5);
#if MK_RWKV_MODE < 2
    if (IN(6)) REP(6) { phase6(F); } SEAM(6);
#endif
    if (IN(7)) REP(7) {
#if MK_LAST_PHASE >= 7
        pg8::Gemm g{wsp<bf16>(F, WS_CAT), wsp<bf16>(F, WS_WOUT), D, D, nullptr};
        pg8::StaticOrder S; S.init(M, D, F.G, (int)blockIdx.x);
        pg8::EpiOutProj E{F.in[0], F.out, wsp<float>(F, WS_MOD) + 2048};
        pg8::gemm_phase<pg8::EpiOutProj, pg8::StaticOrder, false>(F.lds, g, S, E);
#else
        copy_x_to_out(F);
#endif
    } SEAM(7);
    if (IN(8)) REP(8) { phase8(F); } SEAM(8);
    if (IN(9)) REP(9) { phase9(F); } SEAM(9);
    if (IN(10)) REP(10) {
        const unsigned* ctl = wsp<unsigned>(F, WS_CTL);
        pg8::Gemm g{wsp<bf16>(F, WS_H), wsp<bf16>(F, WS_W1), MK_FP8 ? D / 2 : D, 2 * DE, wsp<int>(F, WS_SLOTTOK)};
        pg8::MoeOrder S{(int)ctl[CW_NTILES], 8, F.G, F.vcu, wsp<int>(F, WS_TILEE)};
        pg8::EpiMoe1 E{wsp<unsigned char>(F, WS_ACT), F.in[25]};
        pg8::gemm_phase<pg8::EpiMoe1, pg8::MoeOrder, true, MK_FP8 != 0>(F.lds, g, S, E);
    } SEAM(10);
    if (IN(11)) REP(11) {
        const unsigned* ctl = wsp<unsigned>(F, WS_CTL);
        pg8::Gemm g{wsp<bf16>(F, WS_ACT), wsp<bf16>(F, WS_W2), MK_FP8 ? DE / 2 : DE, D, nullptr};
        pg8::MoeOrder S{(int)ctl[CW_NTILES], 4, F.G, F.vcu, wsp<int>(F, WS_TILEE)};
        pg8::EpiMoe2 E{wsp<bf16>(F, WS_YS), F.in[27], wsp<float>(F, WS_SLOTGATE)};
        pg8::gemm_phase<pg8::EpiMoe2, pg8::MoeOrder, false, MK_FP8 != 0>(F.lds, g, S, E);
    } SEAM(11);
    if (IN(12)) { phase12(F); }
#undef IN
#undef SEAM
}

extern "C" void kernel_launch(void* const* d_in, const int* in_sizes, int n_in, void* d_out, int out_size, void* d_ws, size_t ws_size, hipStream_t stream) {
    static int grid = 0;
    if (grid == 0) {
        if (n_in != 28 || out_size != M * D || ws_size < WS_END) { fprintf(stderr, "kernel_launch: unexpected sizes (n_in %d out %d ws %zu, need %zu)\n", n_in, out_size, ws_size, (size_t)WS_END); grid = -1; return; }
        int dev = 0, cus = 0, per_cu = 0;
        (void)hipGetDevice(&dev); (void)hipDeviceGetAttribute(&cus, hipDeviceAttributeMultiprocessorCount, dev);
        (void)hipFuncSetAttribute((const void*)mk_fwd, hipFuncAttributeMaxDynamicSharedMemorySize, LDS_BYTES);
        (void)hipOccupancyMaxActiveBlocksPerMultiprocessor(&per_cu, (const void*)mk_fwd, 512, LDS_BYTES);
        if (per_cu < 1 || cus != 256) { fprintf(stderr, "kernel_launch: occupancy %d, CUs %d: this build needs 256 CUs x 1 block\n", per_cu, cus); grid = -1; return; }
        grid = cus;
    }
    if (grid < 0) return;
    (void)hipMemsetAsync((char*)d_ws + WS_CTL, 0, CTL_BYTES, stream);
    Args a{};
    for (int i = 0; i < 28; ++i) a.in[i] = (const float*)d_in[i];
    a.out = (float*)d_out; a.ws = (unsigned char*)d_ws;
    const int last = MK_LAST_PHASE + 1;
#if MK_ONE_LAUNCH
    a.ph_lo = 0; a.ph_hi = last;
#if MK_COOP
    void* kargs[] = {&a};
    hipError_t e = hipLaunchCooperativeKernel((const void*)mk_fwd, dim3(grid), dim3(512), kargs, LDS_BYTES, stream);
    if (e != hipSuccess) fprintf(stderr, "cooperative launch failed: %s\n", hipGetErrorString(e));
#else
    hipLaunchKernelGGL(mk_fwd, dim3(grid), dim3(512), LDS_BYTES, stream, a);
#endif
#else
    for (int p = 0; p < last; ++p) { a.ph_lo = p; a.ph_hi = p + 1; hipLaunchKernelGGL(mk_fwd, dim3(grid), dim3(512), LDS_BYTES, stream, a); }
#endif
}
```

```cpp
#include <hip/hip_runtime.h>
#include <hip/hip_cooperative_groups.h>
#include <cstdio>
#include <cstdint>
namespace cg = cooperative_groups;

#ifndef MK_ONE_LAUNCH
#define MK_ONE_LAUNCH 1
#endif
#ifndef MK_REPEAT_MASK
#define MK_REPEAT_MASK 0
#endif
#ifndef MK_CONV_WHERE
#define MK_CONV_WHERE 9
#endif
#define MK_CONV_IN_SCAN (MK_CONV_WHERE == 4)
#ifndef MK_RWKV_MODE
#define MK_RWKV_MODE 3
#endif
#ifndef MK_FP8
#define MK_FP8 1
#endif
#ifndef MK_DUP
#define MK_DUP 0
#endif
#ifndef MK_WMASK
#define MK_WMASK 63
#endif
#ifndef MK_REP4
#define MK_REP4 0
#endif
#ifndef MK_CG_SEAMS
#define MK_CG_SEAMS 0
#endif
#ifndef MK_COOP
#define MK_COOP 0
#endif
#ifndef MK_LAST_PHASE
#define MK_LAST_PHASE 12
#endif

constexpr int D = 1024, NBATCH = 8, T = 4096, M = NBATCH * T;
constexpr int HD = 64, RW = 512, RH = 8, AW = 512, QH = 8, KVH = 2, WIN = 128;
constexpr int RWKV_COLS = 1792, IN_COLS = 2560;
constexpr int COL_Q = 1792, COL_K = 1792 + 512, COL_V = 1792 + 512 + 128;
constexpr int NE = 32, TOPK = 4, DE = 1024;
constexpr int MAX_TILES = 544;
constexpr int MAX_SLOTS = MAX_TILES * 256;
constexpr float NORM_EPS = 1e-6f, GN_EPS = 64e-5f;

#define GAS __attribute__((address_space(1)))
#define LAS __attribute__((address_space(3)))
typedef unsigned short bf16;
typedef short bf16x8 __attribute__((ext_vector_type(8)));
typedef float f32x4 __attribute__((ext_vector_type(4)));
typedef float f32x2 __attribute__((ext_vector_type(2)));
typedef float f32x16 __attribute__((ext_vector_type(16)));
typedef unsigned u32x4 __attribute__((ext_vector_type(4)));
typedef unsigned u32x2 __attribute__((ext_vector_type(2)));
typedef int i32x8 __attribute__((ext_vector_type(8)));
typedef int i32x4 __attribute__((ext_vector_type(4)));

constexpr size_t MiB = 1u << 20;
constexpr size_t WS_CTL = 0, CTL_BYTES = 64 * 1024;
constexpr size_t WS_MOD = 1 * MiB;
constexpr size_t WS_BON = 1 * MiB + 256 * 1024;
constexpr size_t WS_RT_E = 2 * MiB;
constexpr size_t WS_RT_LP = 2 * MiB + 512 * 1024;
constexpr size_t WS_RT_G = 3 * MiB;
constexpr size_t WS_TOKSLOT = 3 * MiB + 512 * 1024;
constexpr size_t WS_SLOTTOK = 4 * MiB;
constexpr size_t WS_SLOTGATE = 5 * MiB;
constexpr size_t WS_BLKCNT = 6 * MiB;
constexpr size_t WS_TILEE = 6 * MiB + 64 * 1024;
constexpr size_t WS_BONUS = 7 * MiB;
constexpr size_t WS_LW = 9 * MiB;
constexpr size_t WS_WIN = 10 * MiB;
constexpr size_t WS_WOUT = 16 * MiB;
constexpr size_t WS_W1 = 20 * MiB;
constexpr size_t WS_W2 = 148 * MiB;
constexpr size_t WS_H = 212 * MiB;
constexpr size_t WS_R2 = 276 * MiB;
constexpr size_t WS_P = WS_R2;
constexpr size_t WS_SCN = WS_R2 + 160 * MiB;
constexpr size_t WS_SV = WS_SCN + 320 * MiB;
constexpr size_t WS_G = WS_SV + 64 * MiB;
constexpr size_t WS_Y = WS_G + 32 * MiB;
constexpr size_t WS_CAT = WS_Y + 64 * MiB;
constexpr size_t WS_ACT = WS_R2;
constexpr size_t WS_YS = WS_R2 + 272 * MiB;
constexpr size_t WS_END = 1012 * MiB;
constexpr size_t WS_X1B = WS_H;
constexpr size_t WS_H8 = WS_Y;
constexpr size_t WS_PT = 436 * MiB;
constexpr size_t WS_ZV = 500 * MiB;
constexpr size_t WS_Z0 = 628 * MiB;
constexpr size_t WS_RYT = 692 * MiB;
constexpr size_t WS_YVT = WS_Y;
static_assert(WS_END <= 1024 * MiB, "workspace map");
static_assert(WS_YS + 272 * MiB <= WS_CAT, "YS must not overlay CAT");
constexpr int CW_NTILES = 16;
constexpr int CW_PADSTART = 64;
constexpr int CW_BAR = 4096;
constexpr int MISC_OFF = 160 * 1024 - 64;

constexpr int LDS_BYTES = 160 * 1024;

__device__ __forceinline__ unsigned f2bf(float f) { unsigned u = __builtin_bit_cast(unsigned, f); return (u + 0x7fffu + ((u >> 16) & 1u)) >> 16; }
typedef __bf16 bf16x2_t __attribute__((ext_vector_type(2)));
__device__ __forceinline__ unsigned pk2(float lo, float hi) { const f32x2 v = {lo, hi}; return __builtin_bit_cast(unsigned, __builtin_convertvector(v, bf16x2_t)); }
__device__ __forceinline__ float bf2f(unsigned short b) { return __builtin_bit_cast(float, ((unsigned)b) << 16); }
__device__ __forceinline__ float bflo(unsigned u) { return __builtin_bit_cast(float, u << 16); }
__device__ __forceinline__ float bfhi(unsigned u) { return __builtin_bit_cast(float, u & 0xffff0000u); }
__device__ __forceinline__ float wave_sum(float v) {
#pragma unroll
    for (int o = 1; o < 64; o <<= 1) v += __shfl_xor(v, o);
    return v;
}
__device__ __forceinline__ void lds_barrier() { asm volatile("s_waitcnt lgkmcnt(0)" ::: "memory"); __builtin_amdgcn_s_barrier(); asm volatile("" ::: "memory"); }
__device__ __forceinline__ float sigmoidf_(float x) { return __builtin_amdgcn_rcpf(1.f + __expf(-x)); }

namespace pg8 {
#define PG8_LAS __attribute__((address_space(3)))
constexpr int BM = 256, BK = 64, HALF = 128, HTB = HALF * BK * 2, STAGE_BYTES = 8 * HTB, NXCD = 8, WGM = 8;
__host__ __device__ __forceinline__ int lds_byte(int r, int c) { const int st = (r >> 4) * 2 + (c >> 5), rr = r & 15, cc = c & 31, ob = rr * 64 + cc * 2; return st * 1024 + (ob ^ (((ob >> 9) & 1) << 5)); }
__host__ __device__ __forceinline__ void stage_rc(int b, int& R, int& C) { const int st = b / 1024, sb = b % 1024, swz = sb ^ (((sb >> 9) & 1) << 5); R = (st >> 1) * 16 + swz / 64; C = (st & 1) * 32 + (swz % 64) / 2; }

struct Unit { int pm, pn, e; };
struct Gemm { const bf16* A; const bf16* Bt; int K, N; const int* rowmap; };

struct StaticOrder {
    int nM, nN, nwg, G, c;
    __device__ void init(int M_, int N_, int G_, int c_) { nM = M_ / BM; nN = N_ / BM; nwg = nM * nN; G = G_; c = c_; }
    __device__ bool next(int i, Unit& u) const {
        const long L = (long)i * G + c; if (L >= nwg) return false;
        int wgid = (int)L; { const int q = nwg / NXCD, r = nwg % NXCD, xcd = wgid % NXCD, off = wgid / NXCD; wgid = (xcd < r ? xcd * (q + 1) : r * (q + 1) + (xcd - r) * q) + off; }
        const int nig = WGM * nN, gid = wgid / nig, fm = gid * WGM, gsz = (nM - fm) < WGM ? (nM - fm) : WGM;
        u.pm = fm + ((wgid % nig) % gsz); u.pn = (wgid % nig) / gsz; u.e = 0; return true;
    }
};
struct MoeOrder {
    int nMt, nN, G, c; const int* tile_e;
    __device__ bool next(int i, Unit& u) const {
        const long L = (long)i * G + c; if (L >= (long)nMt * nN) return false;
        u.pm = (int)(L / nN); u.pn = (int)(L % nN); u.e = tile_e[u.pm]; return true;
    }
};

__device__ __forceinline__ unsigned cvt_pk_bf16(float lo, float hi) { unsigned r; asm volatile("v_cvt_pk_bf16_f32 %0, %1, %2" : "=v"(r) : "v"(lo), "v"(hi)); return r; }

struct EpiBf16P {
    bf16* O; int ldc;
    __device__ __forceinline__ void operator()(const f32x4 (&acc)[2][2][4][2], const Unit& u, int wr, int wc, int fr, int fq) const {
        const int row0 = u.pm * BM + wr * 64 + fr, col0 = u.pn * BM + wc * 32 + 8 * fq;
#pragma unroll
        for (int ai = 0; ai < 2; ++ai)
#pragma unroll
            for (int m = 0; m < 4; ++m) { bf16* rowp = O + (size_t)(row0 + ai * HALF + m * 16) * ldc + col0;
#pragma unroll
                for (int bj = 0; bj < 2; ++bj) { const f32x4 v0 = acc[ai][bj][m][0], v1 = acc[ai][bj][m][1];
                    u32x4 w; w.x = cvt_pk_bf16(v0[0], v0[1]); w.y = cvt_pk_bf16(v0[2], v0[3]); w.z = cvt_pk_bf16(v1[0], v1[1]); w.w = cvt_pk_bf16(v1[2], v1[3]);
                    *(u32x4*)(rowp + bj * HALF) = w; } }
    }
};
struct EpiOutProj {
    const float* x; bf16* out; const float* gate;
    __device__ __forceinline__ void operator()(const f32x4 (&acc)[2][2][4][2], const Unit& u, int wr, int wc, int fr, int fq) const {
        const int row0 = u.pm * BM + wr * 64 + fr, col0 = u.pn * BM + wc * 32 + 8 * fq;
        const int b = (u.pm * BM) / T;
        f32x4 gv[2][2];
#pragma unroll
        for (int bj = 0; bj < 2; ++bj)
#pragma unroll
            for (int n = 0; n < 2; ++n) gv[bj][n] = *(const f32x4*)(gate + (size_t)b * 6144 + col0 + bj * HALF + 4 * n);
#pragma unroll
        for (int ai = 0; ai < 2; ++ai)
#pragma unroll
            for (int m = 0; m < 4; ++m) { const size_t ro = (size_t)(row0 + ai * HALF + m * 16) * D + col0;
#pragma unroll
                for (int bj = 0; bj < 2; ++bj) { const f32x4 x0 = __builtin_nontemporal_load((const f32x4*)(x + ro + bj * HALF)), x1 = __builtin_nontemporal_load((const f32x4*)(x + ro + bj * HALF + 4));
                    const f32x4 v0 = x0 + gv[bj][0] * acc[ai][bj][m][0], v1 = x1 + gv[bj][1] * acc[ai][bj][m][1];
                    u32x4 w; w.x = cvt_pk_bf16(v0[0], v0[1]); w.y = cvt_pk_bf16(v0[2], v0[3]); w.z = cvt_pk_bf16(v1[0], v1[1]); w.w = cvt_pk_bf16(v1[2], v1[3]);
                    *(u32x4*)(out + ro + bj * HALF) = w; } }
    }
};
__device__ __forceinline__ unsigned pk4_fp8(float a, float b, float c, float d) { int w = 0; w = __builtin_amdgcn_cvt_pk_fp8_f32(a, b, w, false); w = __builtin_amdgcn_cvt_pk_fp8_f32(c, d, w, true); return (unsigned)w; }
constexpr float W8_SCALE = 32.f, W8_INV = 1.f / 32.f;
struct EpiMoe1 {
    unsigned char* act; const float* b1;
    __device__ __forceinline__ void operator()(const f32x4 (&acc)[2][2][4][2], const Unit& u, int wr, int wc, int fr, int fq) const {
        const int row0 = u.pm * BM + wr * 64 + fr, j0 = u.pn * 128 + wc * 16 + 4 * fq;
        const float* bb = b1 + (size_t)u.e * 2048;
        f32x4 bg[2], bl[2];
#pragma unroll
        for (int bj = 0; bj < 2; ++bj) { bg[bj] = *(const f32x4*)(bb + j0 + bj * 64); bl[bj] = *(const f32x4*)(bb + 1024 + j0 + bj * 64); }
#pragma unroll
        for (int ai = 0; ai < 2; ++ai)
#pragma unroll
            for (int m = 0; m < 4; ++m) { unsigned char* rowp = act + ((size_t)(row0 + ai * HALF + m * 16) * DE + j0) * (MK_FP8 ? 1 : 2);
#pragma unroll
                for (int bj = 0; bj < 2; ++bj) { const f32x4 g4 = acc[ai][bj][m][0] * (MK_FP8 ? W8_INV : 1.f) + bg[bj], l4 = acc[ai][bj][m][1] * (MK_FP8 ? W8_INV : 1.f) + bl[bj]; float a[4];
#pragma unroll
                    for (int q = 0; q < 4; ++q) { const float gl = fminf(g4[q], 7.0f), li = fminf(fmaxf(l4[q], -7.0f), 7.0f);
                        a[q] = gl * __builtin_amdgcn_rcpf(1.f + __expf(-1.702f * gl)) * (li + 1.f); }
#if MK_FP8
                    *(unsigned*)(rowp + bj * 64) = pk4_fp8(a[0], a[1], a[2], a[3]);
#else
                    u32x2 w; w.x = cvt_pk_bf16(a[0], a[1]); w.y = cvt_pk_bf16(a[2], a[3]); *(u32x2*)(rowp + bj * 128) = w;
#endif
                } }
    }
};
struct EpiMoe2 {
    bf16* ys; const float* b2; const float* sgate;
    __device__ __forceinline__ void operator()(const f32x4 (&acc)[2][2][4][2], const Unit& u, int wr, int wc, int fr, int fq) const {
        const int row0 = u.pm * BM + wr * 64 + fr, col0 = u.pn * BM + wc * 32 + 8 * fq;
        const float* bb = b2 + (size_t)u.e * 1024;
        f32x4 bv[2][2];
#pragma unroll
        for (int bj = 0; bj < 2; ++bj)
#pragma unroll
            for (int n = 0; n < 2; ++n) bv[bj][n] = *(const f32x4*)(bb + col0 + bj * HALF + 4 * n);
#pragma unroll
        for (int ai = 0; ai < 2; ++ai)
#pragma unroll
            for (int m = 0; m < 4; ++m) { const int row = row0 + ai * HALF + m * 16; const float gt = sgate[row]; bf16* rowp = ys + (size_t)row * D + col0;
#pragma unroll
                for (int bj = 0; bj < 2; ++bj) { const f32x4 v0 = (acc[ai][bj][m][0] * (MK_FP8 ? W8_INV : 1.f) + bv[bj][0]) * gt, v1 = (acc[ai][bj][m][1] * (MK_FP8 ? W8_INV : 1.f) + bv[bj][1]) * gt;
                    u32x4 w; w.x = cvt_pk_bf16(v0[0], v0[1]); w.y = cvt_pk_bf16(v0[2], v0[3]); w.z = cvt_pk_bf16(v1[0], v1[1]); w.w = cvt_pk_bf16(v1[2], v1[3]);
                    *(u32x4*)(rowp + bj * HALF) = w; } }
    }
};

template <class Epi, class Sched, bool GATHER, bool FP8 = false>
__device__ __forceinline__ void gemm_phase(PG8_LAS unsigned char* lds, const Gemm g, const Sched& S, const Epi& E) {
    const int tid = threadIdx.x, wid = __builtin_amdgcn_readfirstlane(tid >> 6), lane = tid & 63, wr = wid >> 2, wc = wid & 3, fr = lane & 15, fq = lane >> 4;
    const int K = g.K, nt = K / BK;
    int Rr[2], Cc[2]; unsigned voffB[2];
#pragma unroll
    for (int i = 0; i < 2; ++i) { stage_rc(tid * 16 + i * 8192, Rr[i], Cc[i]); voffB[i] = (unsigned)(Rr[i] * K + Cc[i]) * 2u; }
    const size_t kstep = (size_t)(BK * 2);
    const size_t hstep = (size_t)HALF * K * 2;
    const size_t tstep = 2 * hstep;
    const unsigned ldsw = (unsigned)wid * 1024u;
    const int aoff = lds_byte(wr * 64 + fr, fq * 8), boff = lds_byte(wc * 32 + fr, fq * 8);
#define PG8_SA(b, h) (((b) * 2 + (h)) * HTB)
#define PG8_SB(b, h) ((4 + (b) * 2 + (h)) * HTB)
#define PG8_STAGE(bufoff, gbase, voff) do { _Pragma("unroll") for (int _i = 0; _i < 2; ++_i) \
        __builtin_amdgcn_global_load_lds((const unsigned*)((const char*)(gbase) + (voff)[_i]), (PG8_LAS unsigned*)(lds + (bufoff) + ldsw + _i * 8192), 16, 0, 0); } while (0)
#define PG8_LDA(dst, b, h) do { _Pragma("unroll") for (int m = 0; m < 4; ++m) { const PG8_LAS i32x4* _p = (const PG8_LAS i32x4*)(lds + PG8_SA(b, h) + aoff + m * 2048); \
        dst[m] = __builtin_shufflevector(_p[0], _p[64], 0, 1, 2, 3, 4, 5, 6, 7); } } while (0)
#define PG8_LDB(dst, b, h) do { _Pragma("unroll") for (int n = 0; n < 2; ++n) { const PG8_LAS i32x4* _p = (const PG8_LAS i32x4*)(lds + PG8_SB(b, h) + boff + n * 2048); \
        dst[n] = __builtin_shufflevector(_p[0], _p[64], 0, 1, 2, 3, 4, 5, 6, 7); } } while (0)
#define PG8_MMA(ai, bj, At, Bt) do { __builtin_amdgcn_s_setprio(1); _Pragma("unroll") for (int m = 0; m < 4; ++m) _Pragma("unroll") for (int n = 0; n < 2; ++n) { \
        if constexpr (FP8)   \
            asm volatile("v_mfma_scale_f32_16x16x128_f8f6f4 %0, %1, %2, %0, %3, %3 op_sel_hi:[0,0,0]" : "+v"(acc[ai][bj][m][n]) : "v"(Bt[n]), "v"(At[m]), "v"(0x7F7F7F7F)); \
        else { acc[ai][bj][m][n] = __builtin_amdgcn_mfma_f32_16x16x32_bf16(__builtin_bit_cast(bf16x8, __builtin_shufflevector(Bt[n], Bt[n], 0, 1, 2, 3)), __builtin_bit_cast(bf16x8, __builtin_shufflevector(At[m], At[m], 0, 1, 2, 3)), acc[ai][bj][m][n], 0, 0, 0); \
               acc[ai][bj][m][n] = __builtin_amdgcn_mfma_f32_16x16x32_bf16(__builtin_bit_cast(bf16x8, __builtin_shufflevector(Bt[n], Bt[n], 4, 5, 6, 7)), __builtin_bit_cast(bf16x8, __builtin_shufflevector(At[m], At[m], 4, 5, 6, 7)), acc[ai][bj][m][n], 0, 0, 0); } } \
        __builtin_amdgcn_s_setprio(0); \
        if constexpr (FP8) asm volatile("" : "+v"(acc[ai][bj][0][0]), "+v"(acc[ai][bj][0][1]), "+v"(acc[ai][bj][1][0]), "+v"(acc[ai][bj][1][1]), "+v"(acc[ai][bj][2][0]), "+v"(acc[ai][bj][2][1]), "+v"(acc[ai][bj][3][0]), "+v"(acc[ai][bj][3][1]));   \
        } while (0)
#define PG8_WAIT_V(n) asm volatile("s_waitcnt vmcnt(" #n ")" ::: "memory")
#define PG8_WAIT_L(n) asm volatile("s_waitcnt lgkmcnt(" #n ")" ::: "memory")
#define PG8_BAR __builtin_amdgcn_s_barrier()
#define PG8_SCHED __builtin_amdgcn_sched_barrier(0)
#define PG8_AOFFS(dst, u) do { _Pragma("unroll") for (int _h = 0; _h < 2; ++_h) _Pragma("unroll") for (int _i = 0; _i < 2; ++_i) { int _R, _C; stage_rc((int)threadIdx.x * 16 + _i * 8192, _R, _C); \
        if constexpr (GATHER) { const int _tok = g.rowmap[(u).pm * BM + _h * HALF + _R]; dst[_h][_i] = (unsigned)(_tok * K + _C) * 2u; } \
        else dst[_h][_i] = (unsigned)((_h * HALF + _R) * K + _C) * 2u; } } while (0)
#define PG8_ABASE(u) (GATHER ? (const char*)g.A : (const char*)g.A + (size_t)(u).pm * tstep)
#define PG8_BBASE(u) ((const char*)g.Bt + ((size_t)(u).e * g.N + (size_t)(u).pn * BM) * K * 2)
    Unit cur, nxt, nn; int ui = 0;
    if (!S.next(0, cur)) return;
    bool has_next = S.next(1, nxt);
    unsigned curA[2][2], nxtA[2][2];
    PG8_AOFFS(curA, cur);
    if (has_next) PG8_AOFFS(nxtA, nxt); else {
#pragma unroll
        for (int h = 0; h < 2; ++h)
#pragma unroll
            for (int i = 0; i < 2; ++i) nxtA[h][i] = curA[h][i]; }
    f32x4 acc[2][2][4][2];
#pragma unroll
    for (int a = 0; a < 2; ++a)
#pragma unroll
        for (int b = 0; b < 2; ++b)
#pragma unroll
            for (int m = 0; m < 4; ++m)
#pragma unroll
                for (int n = 0; n < 2; ++n) acc[a][b][m][n] = (f32x4){0.f, 0.f, 0.f, 0.f};
    i32x8 At[4], B0[2], B1[2];
    const char* cA = PG8_ABASE(cur); const char* cB = PG8_BBASE(cur);
    PG8_STAGE(PG8_SB(0, 0), cB, voffB); PG8_STAGE(PG8_SB(0, 1), cB + hstep, voffB); PG8_STAGE(PG8_SA(0, 0), cA, curA[0]); PG8_STAGE(PG8_SA(0, 1), cA, curA[1]);
    if (wr == 1) PG8_BAR;
    PG8_WAIT_V(2); PG8_BAR;
    PG8_STAGE(PG8_SB(1, 0), cB + kstep, voffB); PG8_STAGE(PG8_SA(1, 0), cA + kstep, curA[0]); PG8_STAGE(PG8_SB(1, 1), cB + hstep + kstep, voffB);
    PG8_WAIT_V(6); PG8_BAR;
    for (;;) {
        const char* nA = has_next ? PG8_ABASE(nxt) : cA; const char* nB = has_next ? PG8_BBASE(nxt) : cB;
#pragma unroll 1
        for (int t = 0; t < nt; t += 2) {
            const bool last = (t == nt - 2);
            const char* a1 = cA + (size_t)(t + 1) * kstep;
            const char* a2 = last ? nA : cA + (size_t)(t + 2) * kstep; const char* b2 = last ? nB : cB + (size_t)(t + 2) * kstep;
            const char* a3 = a2 + kstep; const char* b3 = b2 + kstep;
            unsigned o2[2][2];
#pragma unroll
            for (int h = 0; h < 2; ++h)
#pragma unroll
                for (int i = 0; i < 2; ++i) o2[h][i] = last ? nxtA[h][i] : curA[h][i];
            PG8_LDB(B0, 0, 0); PG8_LDB(B1, 0, 1); PG8_SCHED; PG8_LDA(At, 0, 0); PG8_STAGE(PG8_SA(1, 1), a1, curA[1]);
            PG8_WAIT_V(8); PG8_WAIT_L(0); PG8_BAR; PG8_MMA(0, 0, At, B0); PG8_MMA(0, 1, At, B1); PG8_BAR; PG8_SCHED;
            PG8_LDA(At, 0, 1); PG8_STAGE(PG8_SB(0, 0), b2, voffB); PG8_STAGE(PG8_SB(0, 1), b2 + hstep, voffB); PG8_STAGE(PG8_SA(0, 0), a2, o2[0]);
            PG8_WAIT_V(8); PG8_WAIT_L(0); PG8_BAR; PG8_MMA(1, 0, At, B0); PG8_MMA(1, 1, At, B1); PG8_BAR; PG8_SCHED;
            PG8_LDB(B0, 1, 0); PG8_LDB(B1, 1, 1); PG8_SCHED; PG8_LDA(At, 1, 0); PG8_STAGE(PG8_SA(0, 1), a2, o2[1]);
            PG8_WAIT_V(8); PG8_WAIT_L(0); PG8_BAR; PG8_MMA(0, 0, At, B0); PG8_MMA(0, 1, At, B1); PG8_BAR; PG8_SCHED;
            PG8_LDA(At, 1, 1); PG8_STAGE(PG8_SB(1, 0), b3, voffB); PG8_STAGE(PG8_SB(1, 1), b3 + hstep, voffB); PG8_STAGE(PG8_SA(1, 0), a3, o2[0]);
            PG8_WAIT_V(8); PG8_WAIT_L(0); PG8_BAR; PG8_MMA(1, 0, At, B0); PG8_MMA(1, 1, At, B1); PG8_BAR; PG8_SCHED;
        }
        if constexpr (FP8) asm volatile("s_nop 15\n\ts_nop 15" ::: "memory");
        if (wr == 0) PG8_BAR;
        const bool has_nn = has_next && S.next(ui + 2, nn);
        unsigned nnA[2][2];
        if (has_nn) PG8_AOFFS(nnA, nn);
        E(acc, cur, wr, wc, fr, fq);
        if (!has_next) break;
#pragma unroll
        for (int a = 0; a < 2; ++a)
#pragma unroll
            for (int b = 0; b < 2; ++b)
#pragma unroll
                for (int m = 0; m < 4; ++m)
#pragma unroll
                    for (int n = 0; n < 2; ++n) acc[a][b][m][n] = (f32x4){0.f, 0.f, 0.f, 0.f};
        cur = nxt; cA = nA; cB = nB; ++ui;
#pragma unroll
        for (int h = 0; h < 2; ++h)
#pragma unroll
            for (int i = 0; i < 2; ++i) { curA[h][i] = nxtA[h][i]; if (has_nn) nxtA[h][i] = nnA[h][i]; }
        nxt = nn; has_next = has_nn;
        if (wr == 1) PG8_BAR;
    }
    PG8_WAIT_V(0);
    PG8_BAR;
#undef PG8_SA
#undef PG8_SB
#undef PG8_STAGE
#undef PG8_LDA
#undef PG8_LDB
#undef PG8_MMA
#undef PG8_WAIT_V
#undef PG8_WAIT_L
#undef PG8_BAR
#undef PG8_SCHED
#undef PG8_AOFFS
#undef PG8_ABASE
#undef PG8_BBASE
}
}

struct Frame {
    LAS unsigned char* lds;
    int tid, lane, wave, vcu, G;
    const float* const* in;
    float* out;
    unsigned char* ws;
};
template <class Tp> __device__ __forceinline__ Tp* wsp(const Frame& F, size_t off) { return (Tp*)(F.ws + off); }

__device__ __forceinline__ int dest_row(int mode, int s) {
    if (mode == 0) return s;
    if (mode == 1) return (s & ~31) | (((s >> 2) & 1) << 4) | (((s >> 3) & 3) << 2) | (s & 3);
    const int half = s >> 10, j = s & 1023;
    return ((j >> 7) << 8) | (((j >> 6) & 1) << 7) | (((j >> 4) & 3) << 5) | (half << 4) | (j & 15);
}
__device__ __forceinline__ void transpose_item(const float* W, int K, int N, bf16* WT, int mode, int item, int lane) {
    const int nblk = N / 64, kb = item / nblk, nb = item % nblk, k0 = 64 * kb, n0 = 64 * nb;
    const float* src = W + (size_t)k0 * N + n0 + lane;
    float v[64];
#pragma unroll
    for (int i = 0; i < 64; ++i) v[i] = src[(size_t)i * N];
    bf16* dst = WT + (size_t)dest_row(mode, n0 + lane) * K + k0;
#pragma unroll
    for (int j = 0; j < 8; ++j) { u32x4 o; o.x = pk2(v[8 * j], v[8 * j + 1]); o.y = pk2(v[8 * j + 2], v[8 * j + 3]); o.z = pk2(v[8 * j + 4], v[8 * j + 5]); o.w = pk2(v[8 * j + 6], v[8 * j + 7]);
        *(u32x4*)(dst + 8 * j) = o; }
}
__device__ __forceinline__ void transpose_item8(const float* W, int K, int N, unsigned char* WT, int mode, int item, int lane) {
    const int nblk = N / 64, kb = item / nblk, nb = item % nblk, k0 = 64 * kb, n0 = 64 * nb;
    const float* src = W + (size_t)k0 * N + n0 + lane;
    float v[64];
#pragma unroll
    for (int i = 0; i < 64; ++i) v[i] = __builtin_nontemporal_load(src + (size_t)i * N) * 32.f;
    unsigned char* dst = WT + (size_t)dest_row(mode, n0 + lane) * K + k0;
#pragma unroll
    for (int j = 0; j < 4; ++j) { u32x4 o; o.x = pg8::pk4_fp8(v[16 * j], v[16 * j + 1], v[16 * j + 2], v[16 * j + 3]); o.y = pg8::pk4_fp8(v[16 * j + 4], v[16 * j + 5], v[16 * j + 6], v[16 * j + 7]);
        o.z = pg8::pk4_fp8(v[16 * j + 8], v[16 * j + 9], v[16 * j + 10], v[16 * j + 11]); o.w = pg8::pk4_fp8(v[16 * j + 12], v[16 * j + 13], v[16 * j + 14], v[16 * j + 15]);
        *(u32x4*)(dst + 16 * j) = o; }
}
constexpr int MOE_I1 = 16 * 32, MOE_I2 = 16 * 16, MOE_ITEMS = NE * (MOE_I1 + MOE_I2);
__device__ __forceinline__ void moe_weight_item(const Frame& F, int it) {
#if !MK_FP8
    if (it < NE * MOE_I1) { const int e = it / MOE_I1; transpose_item(F.in[24] + (size_t)e * 1024 * 2048, 1024, 2048, wsp<bf16>(F, WS_W1) + (size_t)e * 2048 * 1024, 2, it % MOE_I1, F.lane); }
    else { const int r = it - NE * MOE_I1, e = r / MOE_I2; transpose_item(F.in[26] + (size_t)e * 1024 * 1024, 1024, 1024, wsp<bf16>(F, WS_W2) + (size_t)e * 1024 * 1024, 1, r % MOE_I2, F.lane); }
#else
    if (it < NE * MOE_I1) { const int e = it / MOE_I1; transpose_item8(F.in[24] + (size_t)e * 1024 * 2048, 1024, 2048, wsp<unsigned char>(F, WS_W1) + (size_t)e * 2048 * 1024, 2, it % MOE_I1, F.lane); }
    else { const int r = it - NE * MOE_I1, e = r / MOE_I2; transpose_item8(F.in[26] + (size_t)e * 1024 * 1024, 1024, 1024, wsp<unsigned char>(F, WS_W2) + (size_t)e * 1024 * 1024, 1, r % MOE_I2, F.lane); }
#endif
}

__device__ __forceinline__ void phase0(const Frame& F) {
    if (F.vcu < 192) {
        LAS float* sl = (LAS float*)F.lds;
        LAS float* red = (LAS float*)(F.lds + 32768);
        const float* c = F.in[1];
        for (int idx = F.tid; idx < 8192; idx += 512) { const int b = idx & 7, k = idx >> 3; const float cv = c[b * 1024 + k]; sl[idx] = cv / (1.f + __expf(-cv)); }
        __syncthreads();
        const int cl = F.tid & 31, ks = F.tid >> 5, col = F.vcu * 32 + cl;
        const float* wa = F.in[2];
        float acc[8];
#pragma unroll
        for (int b = 0; b < 8; ++b) acc[b] = 0.f;
#pragma unroll 4
        for (int kk = 0; kk < 64; ++kk) { const int k = ks * 64 + kk; const float w = wa[(size_t)k * 6144 + col];
            const f32x4 s0 = *(const LAS f32x4*)(sl + k * 8), s1 = *(const LAS f32x4*)(sl + k * 8 + 4);
            acc[0] += s0[0] * w; acc[1] += s0[1] * w; acc[2] += s0[2] * w; acc[3] += s0[3] * w;
            acc[4] += s1[0] * w; acc[5] += s1[1] * w; acc[6] += s1[2] * w; acc[7] += s1[3] * w; }
#pragma unroll
        for (int b = 0; b < 8; ++b) red[(ks * 32 + cl) * 8 + b] = acc[b];
        __syncthreads();
        if (F.tid < 256) { const int b = F.tid >> 5; float s = F.in[3][col];
            for (int q = 0; q < 16; ++q) s += red[(q * 32 + cl) * 8 + b];
            wsp<float>(F, WS_MOD)[b * 6144 + col] = s; }
    }
    const int gw = F.vcu * 8 + F.wave, NGW = F.G * 8;
    constexpr int I_IN = 16 * 40, I_OUT = 16 * 16;
    constexpr int NITEMS = I_IN + I_OUT;
    for (int it = gw; it < NITEMS; it += NGW) {
        int r = it;
        if (r < I_IN) { transpose_item(F.in[5], 1024, 2560, wsp<bf16>(F, WS_WIN), 1, r, F.lane); continue; } r -= I_IN;
        transpose_item(F.in[20], 1024, 1024, wsp<bf16>(F, WS_WOUT), 1, r, F.lane);
    }
#if MK_CONV_WHERE == 0
    for (int it = gw; it < MOE_ITEMS; it += NGW) moe_weight_item(F, it);
#endif
    { bf16* LW = wsp<bf16>(F, WS_LW);
        for (int idx = F.vcu * 512 + F.tid; idx < 256 * 512; idx += F.G * 512) { const int k = idx >> 9, c = idx & 511;
            const float v = k < 64 ? F.in[8][k * 512 + c] : (k < 128 ? F.in[10][(k - 64) * 512 + c] : F.in[11][(k - 128) * 512 + c]);
            LW[c * 256 + k] = (bf16)f2bf(v); } }
}
template <bool OUT8 = false, bool IN16 = false>
__device__ __forceinline__ void norm_row(const Frame& F, const float* xrow, const float* g, const float* shift, const float* scale, bf16* orow, f32x4 (&h)[4]) {
    const f32x4* xr = (const f32x4*)xrow + F.lane; const u32x2* xr16 = (const u32x2*)xrow + F.lane;
    float ss = 0.f;
#pragma unroll
    for (int j = 0; j < 4; ++j) { if constexpr (IN16) { const u32x2 q = xr16[64 * j]; h[j] = (f32x4){bflo(q.x), bfhi(q.x), bflo(q.y), bfhi(q.y)}; } else h[j] = __builtin_nontemporal_load(xr + 64 * j); ss += (h[j][0] * h[j][0] + h[j][1] * h[j][1]) + (h[j][2] * h[j][2] + h[j][3] * h[j][3]); }
    const float rstd = rsqrtf(wave_sum(ss) * (1.f / D) + NORM_EPS);
    u32x2* o8 = (u32x2*)orow + F.lane;
#pragma unroll
    for (int j = 0; j < 4; ++j) { const int col = 4 * F.lane + 256 * j;
        const f32x4 gv = *(const f32x4*)(g + col), sh = *(const f32x4*)(shift + col), sc = *(const f32x4*)(scale + col);
        h[j] = h[j] * rstd * gv * (sc + 1.f) + sh;
        if constexpr (OUT8) ((unsigned*)orow)[F.lane + 64 * j] = pg8::pk4_fp8(h[j][0], h[j][1], h[j][2], h[j][3]);
        else { u32x2 w; w.x = pk2(h[j][0], h[j][1]); w.y = pk2(h[j][2], h[j][3]); o8[64 * j] = w; } }
}
__device__ __forceinline__ void phase1(const Frame& F) {
    const int gw = F.vcu * 8 + F.wave, NGW = F.G * 8;
    const float* mod = wsp<float>(F, WS_MOD);
    for (int row = gw; row < M; row += NGW) { const int b = row / T; f32x4 h[4];
        norm_row(F, F.in[0] + (size_t)row * D, F.in[4], mod + b * 6144, mod + b * 6144 + 1024, wsp<bf16>(F, WS_H) + (size_t)row * D, h); }
}

template <int CTRL> __device__ __forceinline__ float dpp_mov(float v) { return __builtin_bit_cast(float, __builtin_amdgcn_update_dpp(0, __builtin_bit_cast(int, v), CTRL, 0xf, 0xf, false)); }
__device__ __forceinline__ float reduce16(float v) { v += dpp_mov<0xB1>(v); v += dpp_mov<0x4E>(v); v += dpp_mov<0x141>(v); v += dpp_mov<0x140>(v); return v; }
__device__ __forceinline__ void lerp8(const bf16* P, const float* mu, int tok, int t, int col, float (&x)[8]) {
    const u32x4 c = *(const u32x4*)(P + (size_t)tok * IN_COLS + col);
    u32x4 p = (u32x4){0u, 0u, 0u, 0u};
    if (t > 0) p = *(const u32x4*)(P + (size_t)(tok - 1) * IN_COLS + col);
    const f32x4 m0 = *(const f32x4*)(mu + col), m1 = *(const f32x4*)(mu + col + 4);
    const float cf[8] = {bflo(c.x), bfhi(c.x), bflo(c.y), bfhi(c.y), bflo(c.z), bfhi(c.z), bflo(c.w), bfhi(c.w)};
    const float pf[8] = {bflo(p.x), bfhi(p.x), bflo(p.y), bfhi(p.y), bflo(p.z), bfhi(p.z), bflo(p.w), bfhi(p.w)};
    const float mf[8] = {m0[0], m0[1], m0[2], m0[3], m1[0], m1[1], m1[2], m1[3]};
#pragma unroll
    for (int j = 0; j < 8; ++j) x[j] = cf[j] + (pf[j] - cf[j]) * mf[j];
}
__device__ __forceinline__ f32x4 lerp4(const bf16* P, const float* mu, int tok, int t, int col) {
    const u32x2 c = *(const u32x2*)(P + (size_t)tok * IN_COLS + col);
    u32x2 p = (u32x2){0u, 0u};
    if (t > 0) p = *(const u32x2*)(P + (size_t)(tok - 1) * IN_COLS + col);
    const f32x4 m = *(const f32x4*)(mu + col);
    const f32x4 cf = (f32x4){bflo(c.x), bfhi(c.x), bflo(c.y), bfhi(c.y)}, pf = (f32x4){bflo(p.x), bfhi(p.x), bflo(p.y), bfhi(p.y)};
    return cf + (pf - cf) * m;
}
__device__ __forceinline__ bf16x8 pack8(const float (&x)[8]) { u32x4 w; w.x = pk2(x[0], x[1]); w.y = pk2(x[2], x[3]); w.z = pk2(x[4], x[5]); w.w = pk2(x[6], x[7]); return __builtin_bit_cast(bf16x8, w); }
__device__ __forceinline__ void phase3(const Frame& F) {
    const bf16* P = wsp<bf16>(F, WS_P); const bf16* LW = wsp<bf16>(F, WS_LW);
    const float* mu = F.in[6]; const float* w0 = F.in[7]; const float* a0 = F.in[9];
    const float* k_k = F.in[12]; const float* k_a = F.in[13]; const float* r_k = F.in[14];
    float* SCN = wsp<float>(F, WS_SCN); float* SV = wsp<float>(F, WS_SV); bf16* G = wsp<bf16>(F, WS_G); float* BON = wsp<float>(F, WS_BONUS);
    const int gw = F.vcu * 8 + F.wave, NGW = F.G * 8;
    const int cl = F.lane & 15, q = F.lane >> 4;
    for (int tile = gw; tile < M / 16; tile += NGW) {
        bf16x8 Aw[2], Aa[2], Ag[4];
        { const int tok = tile * 16 + cl, t = tok % T; float x[8];
#pragma unroll
            for (int s = 0; s < 2; ++s) { lerp8(P, mu, tok, t, 1536 + 32 * s + 8 * q, x);
#pragma unroll
                for (int j = 0; j < 8; ++j) x[j] = tanhf(x[j]);
                Aw[s] = pack8(x);
                lerp8(P, mu, tok, t, 1600 + 32 * s + 8 * q, x); Aa[s] = pack8(x); }
#pragma unroll
            for (int s = 0; s < 4; ++s) { lerp8(P, mu, tok, t, 1664 + 32 * s + 8 * q, x);
#pragma unroll
                for (int j = 0; j < 8; ++j) x[j] = sigmoidf_(x[j]);
                Ag[s] = pack8(x); } }
        const int tk0 = tile * 16 + 4 * q, b = tk0 / T, t0 = tk0 % T;
#pragma unroll 1
        for (int hh = 0; hh < RH; ++hh) {
            const int c0 = hh * 64 + cl * 4;
            f32x4 accw[4], acca[4], accg[4];
#pragma unroll
            for (int ct = 0; ct < 4; ++ct) { const bf16* lw = LW + (size_t)(c0 + ct) * 256 + 8 * q;
                f32x4 aw = (f32x4){0.f, 0.f, 0.f, 0.f}, aa = aw, ag = aw;
#pragma unroll
                for (int s = 0; s < 2; ++s) { aw = __builtin_amdgcn_mfma_f32_16x16x32_bf16(Aw[s], *(const bf16x8*)(lw + 32 * s), aw, 0, 0, 0);
                    aa = __builtin_amdgcn_mfma_f32_16x16x32_bf16(Aa[s], *(const bf16x8*)(lw + 64 + 32 * s), aa, 0, 0, 0); }
#pragma unroll
                for (int s = 0; s < 4; ++s) ag = __builtin_amdgcn_mfma_f32_16x16x32_bf16(Ag[s], *(const bf16x8*)(lw + 128 + 32 * s), ag, 0, 0, 0);
                accw[ct] = aw; acca[ct] = aa; accg[ct] = ag; }
            const f32x4 w0v = *(const f32x4*)(w0 + c0), a0v = *(const f32x4*)(a0 + c0), kkv = *(const f32x4*)(k_k + c0), kav = *(const f32x4*)(k_a + c0), rkv = *(const f32x4*)(r_k + c0);
#pragma unroll
            for (int i = 0; i < 4; ++i) { const int tk = tk0 + i, t = t0 + i;
                const f32x4 r4 = lerp4(P, mu, tk, t, c0), kr4 = lerp4(P, mu, tk, t, 512 + c0), v4 = lerp4(P, mu, tk, t, 1024 + c0);
                f32x4 dec, av, gv, kk4, k4;
                float ssq = 0.f, bon = 0.f;
#pragma unroll
                for (int ct = 0; ct < 4; ++ct) {
                    dec[ct] = __expf(-0.60653066f * sigmoidf_(w0v[ct] + accw[ct][i]));
                    av[ct] = sigmoidf_(a0v[ct] + acca[ct][i]);
                    gv[ct] = accg[ct][i];
                    kk4[ct] = kr4[ct] * kkv[ct]; ssq += kk4[ct] * kk4[ct];
                    k4[ct] = kr4[ct] * (1.f + (av[ct] - 1.f) * kav[ct]);
                    bon += r4[ct] * k4[ct] * rkv[ct]; }
                ssq = reduce16(ssq); bon = reduce16(bon);
                const float inv = __builtin_amdgcn_rcpf(fmaxf(sqrtf(ssq), 1e-12f));
                const f32x4 kkn = kk4 * inv, bb = kkn * av;
                const size_t so = ((size_t)(b * RH + hh) * T + t) * 64 + cl * 4;
                float* sc = SCN + ((size_t)(b * RH + hh) * T + t) * 320 + cl * 4;
                *(f32x4*)(sc) = dec; *(f32x4*)(sc + 64) = kkn; *(f32x4*)(sc + 128) = bb; *(f32x4*)(sc + 192) = k4; *(f32x4*)(sc + 256) = r4;
                *(f32x4*)(SV + so) = v4;
                u32x2 gw2; gw2.x = pk2(gv[0], gv[1]); gw2.y = pk2(gv[2], gv[3]);
                *(u32x2*)(G + (size_t)tk * 512 + c0) = gw2;
                if (cl == 0) BON[tk * 8 + hh] = bon; }
        }
    }
}

constexpr int CK = 32, NCHK = T / CK;
#define SC_SPIN_CAP (1 << 24)
#define MFMA32(a, b, c) __builtin_amdgcn_mfma_f32_32x32x16_bf16((a), (b), (c), 0, 0, 0)
__device__ __forceinline__ int crow(int i, int h) { return (i & 3) + 8 * (i >> 2) + 4 * h; }
template <int S_> __device__ __forceinline__ bf16x8 pack_acc(const f32x16& x) { u32x4 w; w.x = pk2(x[8 * S_], x[8 * S_ + 1]); w.y = pk2(x[8 * S_ + 2], x[8 * S_ + 3]); w.z = pk2(x[8 * S_ + 4], x[8 * S_ + 5]); w.w = pk2(x[8 * S_ + 6], x[8 * S_ + 7]); return __builtin_bit_cast(bf16x8, w); }
__device__ __forceinline__ bf16x8 rd_nat(const LAS bf16* img, int stride, int row, int k0) { return *(const LAS bf16x8*)(img + row * stride + k0); }
__device__ __forceinline__ bf16x8 rd_perm(const LAS bf16* img, int stride, int row, int kb, int h) {
    const u32x2 lo = *(const LAS u32x2*)(img + row * stride + kb + 4 * h), hi = *(const LAS u32x2*)(img + row * stride + kb + 8 + 4 * h);
    u32x4 w; w.x = lo.x; w.y = lo.y; w.z = hi.x; w.w = hi.y; return __builtin_bit_cast(bf16x8, w);
}
__device__ __forceinline__ f32x16 zero16() { f32x16 z; for (int i = 0; i < 16; ++i) z[i] = 0.f; return z; }
constexpr int CL_A = 0, CL_B = 4608, CL_K = 9216, CL_R = 13824, CL_AT = 18432, CL_BHT = 23552, CL_KHT = 28672, CL_VT = 33792, CL_GTOT = 38912, CL_GC = 39936,
              CL_L = 40192, CL_T = 44800, CL_FNRB = 47360, CL_CNRK = 49408, CL_FQM = 53504, CL_GROUP = 57600;
constexpr int RMS = 72, TRS = 40, LST = 36;
__device__ __forceinline__ void phase4a_summaries(const Frame& F) {
    const float* SCN = wsp<float>(F, WS_SCN); const float* SV = wsp<float>(F, WS_SV);
    bf16x8* PT = wsp<bf16x8>(F, WS_PT); f32x4* ZV = wsp<f32x4>(F, WS_ZV); bf16x8* RYT = wsp<bf16x8>(F, WS_RYT); f32x4* YVT = wsp<f32x4>(F, WS_YVT);
    const int grp = F.tid >> 8, gt = F.tid & 255, w4 = F.wave & 3, lane = F.lane, r = lane & 31, h = lane >> 5;
    LAS unsigned char* gl = F.lds + grp * CL_GROUP;
    LAS bf16* iA = (LAS bf16*)(gl + CL_A); LAS bf16* iB = (LAS bf16*)(gl + CL_B); LAS bf16* iK = (LAS bf16*)(gl + CL_K); LAS bf16* iR = (LAS bf16*)(gl + CL_R);
    LAS bf16* iAT = (LAS bf16*)(gl + CL_AT); LAS bf16* iBHT = (LAS bf16*)(gl + CL_BHT); LAS bf16* iKHT = (LAS bf16*)(gl + CL_KHT); LAS bf16* iVT = (LAS bf16*)(gl + CL_VT);
    LAS float* gtot = (LAS float*)(gl + CL_GTOT); LAS float* gcv = (LAS float*)(gl + CL_GC); LAS float* Lm = (LAS float*)(gl + CL_L); LAS bf16* Tm = (LAS bf16*)(gl + CL_T);
    LAS bf16x8* fnrb = (LAS bf16x8*)(gl + CL_FNRB); LAS float* cnrk = (LAS float*)(gl + CL_CNRK); LAS bf16x8* fqm = (LAS bf16x8*)(gl + CL_FQM);
    constexpr int NCHUNKS = NBATCH * RH * NCHK;
    for (int it = F.vcu; it < NCHUNKS / 2; it += F.G) {
        const int chunk = it * 2 + grp, bh = chunk / NCHK, c = chunk % NCHK, t0 = c * CK;
        __syncthreads();
        { const int k = gt & 63, tq = gt >> 6;
            float wv[8], kkv[8], bv[8], kv[8], rv[8], vv[8], lp[8];
#pragma unroll
            for (int i = 0; i < 8; ++i) { const size_t row = (size_t)bh * T + t0 + 8 * tq + i; const float* sc = SCN + row * 320 + k;
                wv[i] = sc[0]; kkv[i] = sc[64]; bv[i] = sc[128]; kv[i] = sc[192]; rv[i] = sc[256]; vv[i] = SV[row * 64 + k]; }
            lp[0] = wv[0];
#pragma unroll
            for (int i = 1; i < 8; ++i) lp[i] = lp[i - 1] * wv[i];
            gtot[tq * 64 + k] = lp[7];
            __syncthreads();
            const float g0 = gtot[k], g1 = gtot[64 + k], g2 = gtot[128 + k], g3 = gtot[192 + k];
            const float pre = tq == 0 ? 1.f : (tq == 1 ? g0 : (tq == 2 ? g0 * g1 : g0 * g1 * g2)), gC = (g0 * g1) * (g2 * g3);
            float at[8], bh8[8], kh8[8];
#pragma unroll
            for (int i = 0; i < 8; ++i) { const float g = pre * lp[i], gp = i == 0 ? pre : pre * lp[i - 1], ig = __builtin_amdgcn_rcpf(g);
                const float bt = bv[i] * ig, kt = kv[i] * ig; at[i] = -kkv[i] * gp; bh8[i] = bt * gC; kh8[i] = kt * gC;
                const int ro = (8 * tq + i) * RMS + k;
                iA[ro] = (bf16)f2bf(at[i]); iB[ro] = (bf16)f2bf(bt); iK[ro] = (bf16)f2bf(kt); iR[ro] = (bf16)f2bf(rv[i] * g); }
            *(LAS bf16x8*)(iAT + k * TRS + 8 * tq) = pack8(at); *(LAS bf16x8*)(iBHT + k * TRS + 8 * tq) = pack8(bh8); *(LAS bf16x8*)(iKHT + k * TRS + 8 * tq) = pack8(kh8);
            *(LAS bf16x8*)(iVT + k * TRS + 8 * tq) = pack8(vv);
            if (tq == 0) gcv[k] = gC; }
        __syncthreads();
        f32x16 lak = zero16();
        { const LAS bf16* ia = (w4 < 2) ? iA : (w4 == 2 ? iB : iK); const LAS bf16* ib = (w4 == 0) ? iB : (w4 == 1 ? iK : iR);
            f32x16 acc = zero16();
#pragma unroll
            for (int ks = 0; ks < 4; ++ks) acc = MFMA32(rd_nat(ia, RMS, r, 16 * ks + 8 * h), rd_nat(ib, RMS, r, 16 * ks + 8 * h), acc);
#pragma unroll
            for (int i = 0; i < 16; ++i) { const int row = crow(i, h); const bool keep = (w4 < 2) ? (r < row) : (row <= r); acc[i] = keep ? acc[i] : 0.f; }
            if (w4 == 0) {
#pragma unroll
                for (int i = 0; i < 16; ++i) Lm[crow(i, h) * LST + r] = acc[i]; }
            else if (w4 == 1) lak = acc;
            else if (w4 == 2) { fnrb[lane] = pack_acc<0>(acc); fnrb[64 + lane] = pack_acc<1>(acc); }
            else {
#pragma unroll
                for (int i = 0; i < 16; ++i) cnrk[i * 64 + lane] = acc[i]; } }
        __syncthreads();
        if (w4 == 0) { float Tr[32];
#pragma unroll
            for (int t = 0; t < 32; ++t) { float acc = (t == r) ? 1.f : 0.f;
#pragma unroll
                for (int s4 = 0; s4 < (t + 3) / 4; ++s4) { const f32x4 l4 = *(const LAS f32x4*)(Lm + t * LST + 4 * s4);
#pragma unroll
                    for (int q = 0; q < 4; ++q) if (4 * s4 + q < t) acc += l4[q] * Tr[4 * s4 + q]; }
                Tr[t] = acc; }
            if (lane < 32) {
#pragma unroll
                for (int t = 0; t < 32; ++t) Tm[t * TRS + r] = (bf16)f2bf(Tr[t]); } }
        __syncthreads();
        if (w4 == 0 || w4 == 2) { const int a = w4 >> 1;
            f32x16 x1 = zero16();
#pragma unroll
            for (int ks = 0; ks < 2; ++ks) x1 = MFMA32(rd_nat(Tm, TRS, r, 16 * ks + 8 * h), rd_nat(iAT, TRS, 32 * a + r, 16 * ks + 8 * h), x1);
            const bf16x8 xf0 = pack_acc<0>(x1), xf1 = pack_acc<1>(x1);
#pragma unroll
            for (int b = 0; b < 2; ++b) { f32x16 p = zero16();
                p = MFMA32(xf0, rd_perm(iBHT, TRS, 32 * b + r, 0, h), p); p = MFMA32(xf1, rd_perm(iBHT, TRS, 32 * b + r, 16, h), p);
                if (a == b) { const float gc = gcv[32 * a + r];
#pragma unroll
                    for (int i = 0; i < 16; ++i) p[i] += (crow(i, h) == r) ? gc : 0.f; }
                bf16x8* dst = PT + ((size_t)(chunk * 2 + a) * 2 + b) * 2 * 64 + lane; dst[0] = pack_acc<0>(p); dst[64] = pack_acc<1>(p); }
            f32x16 ry;
#pragma unroll
            for (int g = 0; g < 4; ++g) { const u32x2 rr = *(const LAS u32x2*)(iR + r * RMS + 32 * a + 8 * g + 4 * h);
                ry[4 * g] = bflo(rr.x); ry[4 * g + 1] = bfhi(rr.x); ry[4 * g + 2] = bflo(rr.y); ry[4 * g + 3] = bfhi(rr.y); }
            ry = MFMA32(xf0, fnrb[lane], ry); ry = MFMA32(xf1, fnrb[64 + lane], ry);
            bf16x8* dr = RYT + (size_t)(chunk * 2 + a) * 2 * 64 + lane; dr[0] = pack_acc<0>(ry); dr[64] = pack_acc<1>(ry);
        } else if (w4 == 1) {
            f32x16 x2 = zero16();
            x2 = MFMA32(rd_perm(Tm, TRS, r, 0, h), pack_acc<0>(lak), x2); x2 = MFMA32(rd_perm(Tm, TRS, r, 16, h), pack_acc<1>(lak), x2);
            const bf16x8 xf0 = pack_acc<0>(x2), xf1 = pack_acc<1>(x2);
#pragma unroll
            for (int b = 0; b < 2; ++b) { f32x16 qm;
#pragma unroll
                for (int g = 0; g < 4; ++g) { const u32x2 kk2 = *(const LAS u32x2*)(iKHT + (32 * b + r) * TRS + 8 * g + 4 * h);
                    qm[4 * g] = bflo(kk2.x); qm[4 * g + 1] = bfhi(kk2.x); qm[4 * g + 2] = bflo(kk2.y); qm[4 * g + 3] = bfhi(kk2.y); }
                qm = MFMA32(xf0, rd_perm(iBHT, TRS, 32 * b + r, 0, h), qm); qm = MFMA32(xf1, rd_perm(iBHT, TRS, 32 * b + r, 16, h), qm);
                fqm[(b * 2 + 0) * 64 + lane] = pack_acc<0>(qm); fqm[(b * 2 + 1) * 64 + lane] = pack_acc<1>(qm); }
            f32x16 gy;
#pragma unroll
            for (int i = 0; i < 16; ++i) gy[i] = cnrk[i * 64 + lane];
            gy = MFMA32(xf0, fnrb[lane], gy); gy = MFMA32(xf1, fnrb[64 + lane], gy);
            const bf16x8 gf0 = pack_acc<0>(gy), gf1 = pack_acc<1>(gy);
#pragma unroll
            for (int vh = 0; vh < 2; ++vh) { f32x16 yv = zero16();
                yv = MFMA32(rd_perm(iVT, TRS, 32 * vh + r, 0, h), gf0, yv); yv = MFMA32(rd_perm(iVT, TRS, 32 * vh + r, 16, h), gf1, yv);
                f32x4* dy = YVT + ((size_t)(chunk * 2 + vh) * 64 + lane) * 4;
#pragma unroll
                for (int g = 0; g < 4; ++g) dy[g] = (f32x4){yv[4 * g], yv[4 * g + 1], yv[4 * g + 2], yv[4 * g + 3]}; }
        }
        __syncthreads();
        if (w4 == 3) {
#pragma unroll
            for (int b = 0; b < 2; ++b)
#pragma unroll
                for (int vh = 0; vh < 2; ++vh) { f32x16 zv = zero16();
                    zv = MFMA32(fqm[(b * 2 + 0) * 64 + lane], rd_perm(iVT, TRS, 32 * vh + r, 0, h), zv); zv = MFMA32(fqm[(b * 2 + 1) * 64 + lane], rd_perm(iVT, TRS, 32 * vh + r, 16, h), zv);
                    f32x4* dz = ZV + (((size_t)(chunk * 2 + b) * 2 + vh) * 64 + lane) * 4;
#pragma unroll
                    for (int g = 0; g < 4; ++g) dz[g] = (f32x4){zv[4 * g], zv[4 * g + 1], zv[4 * g + 2], zv[4 * g + 3]}; }
        }
    }
}
constexpr int CL2_LA = 2 * CL_GROUP, LAS_STRIDE = 264;
static_assert(CL2_LA + 32 * LAS_STRIDE * 2 <= MISC_OFF, "fused summaries LDS map");
__device__ __forceinline__ void phase4a_fused(const Frame& F) {
    const bf16* P = wsp<bf16>(F, WS_P); const bf16* LW = wsp<bf16>(F, WS_LW);
    const float* mu = F.in[6]; const float* w0 = F.in[7]; const float* a0 = F.in[9]; const float* k_k = F.in[12]; const float* k_a = F.in[13]; const float* r_k = F.in[14];
    float* SV = wsp<float>(F, WS_SV); bf16* G = wsp<bf16>(F, WS_G); float* BON = wsp<float>(F, WS_BONUS);
    bf16x8* PT = wsp<bf16x8>(F, WS_PT); f32x4* ZV = wsp<f32x4>(F, WS_ZV); bf16x8* RYT = wsp<bf16x8>(F, WS_RYT); f32x4* YVT = wsp<f32x4>(F, WS_YVT);
    const int grp = F.tid >> 8, gt = F.tid & 255, w4 = F.wave & 3, lane = F.lane, r = lane & 31, h = lane >> 5;
    LAS unsigned char* gl = F.lds + grp * CL_GROUP;
    LAS bf16* iA = (LAS bf16*)(gl + CL_A); LAS bf16* iB = (LAS bf16*)(gl + CL_B); LAS bf16* iK = (LAS bf16*)(gl + CL_K); LAS bf16* iR = (LAS bf16*)(gl + CL_R);
    LAS bf16* iAT = (LAS bf16*)(gl + CL_AT); LAS bf16* iBHT = (LAS bf16*)(gl + CL_BHT); LAS bf16* iKHT = (LAS bf16*)(gl + CL_KHT); LAS bf16* iVT = (LAS bf16*)(gl + CL_VT);
    LAS float* gtot = (LAS float*)(gl + CL_GTOT); LAS float* gcv = (LAS float*)(gl + CL_GC); LAS float* Lm = (LAS float*)(gl + CL_L); LAS bf16* Tm = (LAS bf16*)(gl + CL_T);
    LAS bf16x8* fnrb = (LAS bf16x8*)(gl + CL_FNRB); LAS float* cnrk = (LAS float*)(gl + CL_CNRK); LAS bf16x8* fqm = (LAS bf16x8*)(gl + CL_FQM);
    LAS float* lwo_w = (LAS float*)(gl + CL_L); LAS float* lwo_a = lwo_w + 32 * 64;
    LAS bf16* LA = (LAS bf16*)(F.lds + CL2_LA);
    bf16 cr[9], ck[9], cv[9]; float cst[8]; bool tz;
#define S1_LOAD(tc_, hp_) do { const int _hh = 2 * (hp_) + grp, _cc = _hh * 64 + (gt & 63), _t0 = ((tc_) % NCHK) * CK + 8 * (gt >> 6); \
        const size_t _pr = ((size_t)((tc_) / NCHK) * T + _t0) * IN_COLS + _cc; tz = _t0 > 0; const size_t _pp = tz ? _pr - IN_COLS : _pr; \
        cr[0] = P[_pp]; ck[0] = P[_pp + 512]; cv[0] = P[_pp + 1024]; \
        _Pragma("unroll") for (int _i = 0; _i < 8; ++_i) { cr[_i + 1] = P[_pr + (size_t)_i * IN_COLS]; ck[_i + 1] = P[_pr + (size_t)_i * IN_COLS + 512]; cv[_i + 1] = P[_pr + (size_t)_i * IN_COLS + 1024]; } \
        cst[0] = mu[_cc]; cst[1] = mu[512 + _cc]; cst[2] = mu[1024 + _cc]; cst[3] = w0[_cc]; cst[4] = a0[_cc]; cst[5] = k_k[_cc]; cst[6] = k_a[_cc]; cst[7] = r_k[_cc]; } while (0)
    bf16x8 lwf[8];
#define LW_LOAD(hp_) do { const bf16* _lw = LW + (size_t)((2 * (hp_) + grp) * 64 + 32 * (w4 & 1) + r) * 256 + 8 * h + (w4 < 2 ? 0 : 128); \
        _Pragma("unroll") for (int _q = 0; _q < 8; ++_q) lwf[_q] = *(const bf16x8*)(_lw + 16 * _q); } while (0)
    S1_LOAD(F.vcu, 0);
    LW_LOAD(0);
    for (int tc = F.vcu; tc < M / CK; tc += F.G) {
        const int b = tc / NCHK, c = tc % NCHK, t0 = c * CK, row0 = b * T + t0;
        lds_barrier();
        { const int tk = F.tid >> 4, cb = (F.tid & 15) * 16; float x[8];
#pragma unroll
            for (int q8 = 0; q8 < 2; ++q8) { const int col = cb + 8 * q8; lerp8(P, mu, row0 + tk, t0 + tk, 1536 + col, x);
                if (col < 64) {
#pragma unroll
                    for (int j = 0; j < 8; ++j) x[j] = 2.f * sigmoidf_(2.f * x[j]) - 1.f; }
                else if (col >= 128) {
#pragma unroll
                    for (int j = 0; j < 8; ++j) x[j] = sigmoidf_(x[j]); }
                *(LAS bf16x8*)(LA + tk * LAS_STRIDE + col) = pack8(x); } }
#pragma unroll 1
        for (int hp = 0; hp < 4; ++hp) {
            const int hh = 2 * hp + grp, bh = b * RH + hh, chunk = bh * NCHK + c;
            lds_barrier();
            { const int ct = w4 & 1;
                if (w4 < 2) {
                    f32x16 aw = zero16(), aa = zero16();
#pragma unroll
                    for (int ks = 0; ks < 4; ++ks) { aw = MFMA32(rd_nat(LA, LAS_STRIDE, r, 16 * ks + 8 * h), lwf[ks], aw); aa = MFMA32(rd_nat(LA, LAS_STRIDE, r, 64 + 16 * ks + 8 * h), lwf[4 + ks], aa); }
#pragma unroll
                    for (int i = 0; i < 16; ++i) { lwo_w[crow(i, h) * 64 + 32 * ct + r] = aw[i]; lwo_a[crow(i, h) * 64 + 32 * ct + r] = aa[i]; }
                } else {
                    f32x16 ag = zero16();
#pragma unroll
                    for (int ks = 0; ks < 8; ++ks) ag = MFMA32(rd_nat(LA, LAS_STRIDE, r, 128 + 16 * ks + 8 * h), lwf[ks], ag);
#pragma unroll
                    for (int i = 0; i < 16; ++i) G[(size_t)(row0 + crow(i, h)) * 512 + hh * 64 + 32 * ct + r] = (bf16)f2bf(ag[i]); } }
            LW_LOAD((hp + 1) & 3);
            lds_barrier();
            auto st1 = [&]() { const int k = gt & 63, tq = gt >> 6, cc = hh * 64 + k;
                float wv[8], kkv[8], bv[8], kv[8], rv[8], vv[8], lp[8];
                { const float mur = cst[0], muk = cst[1], muv = cst[2], w0c = cst[3], a0c = cst[4], kkc = cst[5], kac = cst[6], rkc = cst[7];
                    const int tl0 = 8 * tq;
                    if (!tz) { cr[0] = 0; ck[0] = 0; cv[0] = 0; }
                    float lw_[8], la_[8];
#pragma unroll
                    for (int i = 0; i < 8; ++i) { lw_[i] = lwo_w[(tl0 + i) * 64 + k]; la_[i] = lwo_a[(tl0 + i) * 64 + k]; }
                    float kk[8], ssq[8], bo[8], av[8];
#pragma unroll
                    for (int i = 0; i < 8; ++i) { const float c_r = bf2f(cr[i + 1]), c_k = bf2f(ck[i + 1]), c_v = bf2f(cv[i + 1]);
                        rv[i] = c_r + (bf2f(cr[i]) - c_r) * mur; const float kr = c_k + (bf2f(ck[i]) - c_k) * muk; vv[i] = c_v + (bf2f(cv[i]) - c_v) * muv;
                        wv[i] = __expf(-0.60653066f * sigmoidf_(w0c + lw_[i])); av[i] = sigmoidf_(a0c + la_[i]);
                        kk[i] = kr * kkc; ssq[i] = kk[i] * kk[i]; kv[i] = kr * (1.f + (av[i] - 1.f) * kac); bo[i] = rv[i] * kv[i] * rkc; }
#pragma unroll
                    for (int i = 0; i < 8; ++i) { ssq[i] = reduce16(ssq[i]); bo[i] = reduce16(bo[i]); }
#pragma unroll
                    for (int i = 0; i < 8; ++i) { ssq[i] += __shfl_xor(ssq[i], 16); bo[i] += __shfl_xor(bo[i], 16); }
#pragma unroll
                    for (int i = 0; i < 8; ++i) { ssq[i] += __shfl_xor(ssq[i], 32); bo[i] += __shfl_xor(bo[i], 32); }
#pragma unroll
                    for (int i = 0; i < 8; ++i) { kkv[i] = kk[i] * __builtin_amdgcn_rcpf(fmaxf(sqrtf(ssq[i]), 1e-12f)); bv[i] = kkv[i] * av[i];
                        SV[((size_t)bh * T + t0 + tl0 + i) * 64 + k] = vv[i];
                        if (k == 0) BON[(row0 + tl0 + i) * 8 + hh] = bo[i]; } }
                lp[0] = wv[0];
#pragma unroll
                for (int i = 1; i < 8; ++i) lp[i] = lp[i - 1] * wv[i];
                gtot[tq * 64 + k] = lp[7];
                lds_barrier();
                const float g0 = gtot[k], g1 = gtot[64 + k], g2 = gtot[128 + k], g3 = gtot[192 + k];
                const float pre = tq == 0 ? 1.f : (tq == 1 ? g0 : (tq == 2 ? g0 * g1 : g0 * g1 * g2)), gC = (g0 * g1) * (g2 * g3);
                float at[8], bh8[8], kh8[8];
#pragma unroll
                for (int i = 0; i < 8; ++i) { const float g = pre * lp[i], gp = i == 0 ? pre : pre * lp[i - 1], ig = __builtin_amdgcn_rcpf(g);
                    const float bt = bv[i] * ig, kt = kv[i] * ig; at[i] = -kkv[i] * gp; bh8[i] = bt * gC; kh8[i] = kt * gC;
                    const int ro = (8 * tq + i) * RMS + k;
                    iA[ro] = (bf16)f2bf(at[i]); iB[ro] = (bf16)f2bf(bt); iK[ro] = (bf16)f2bf(kt); iR[ro] = (bf16)f2bf(rv[i] * g); }
                *(LAS bf16x8*)(iAT + k * TRS + 8 * tq) = pack8(at); *(LAS bf16x8*)(iBHT + k * TRS + 8 * tq) = pack8(bh8); *(LAS bf16x8*)(iKHT + k * TRS + 8 * tq) = pack8(kh8);
                *(LAS bf16x8*)(iVT + k * TRS + 8 * tq) = pack8(vv);
                if (tq == 0) gcv[k] = gC; };
            st1();
#if MK_DUP & 2
            lds_barrier(); asm volatile("" ::: "memory"); st1();
#endif
            { const int ntc = (hp < 3) ? tc : (tc + F.G < M / CK ? tc + F.G : tc), nhp = (hp < 3) ? hp + 1 : 0; S1_LOAD(ntc, nhp); }
            lds_barrier();
            f32x16 lak = zero16();
            { const LAS bf16* ia = (w4 < 2) ? iA : (w4 == 2 ? iB : iK); const LAS bf16* ib = (w4 == 0) ? iB : (w4 == 1 ? iK : iR);
                f32x16 acc = zero16();
#pragma unroll
                for (int ks = 0; ks < 4; ++ks) acc = MFMA32(rd_nat(ia, RMS, r, 16 * ks + 8 * h), rd_nat(ib, RMS, r, 16 * ks + 8 * h), acc);
#pragma unroll
                for (int i = 0; i < 16; ++i) { const int row = crow(i, h); const bool keep = (w4 < 2) ? (r < row) : (row <= r); acc[i] = keep ? acc[i] : 0.f; }
                if (w4 <= 1) lak = acc;
                else if (w4 == 2) { fnrb[lane] = pack_acc<0>(acc); fnrb[64 + lane] = pack_acc<1>(acc); }
                else {
#pragma unroll
                    for (int i = 0; i < 16; ++i) cnrk[i * 64 + lane] = acc[i]; } }
            lds_barrier();
            auto st3 = [&]() { if (w4 == 0) {
                LAS bf16* imgL = (LAS bf16*)(gl + CL_L);
                f32x16 Lp = lak, Tq = lak;
#pragma unroll
                for (int i = 0; i < 16; ++i) Tq[i] += (crow(i, h) == r) ? 1.f : 0.f;
#pragma unroll
                for (int st = 0; st < 4; ++st) {
#pragma unroll
                    for (int i = 0; i < 16; ++i) { imgL[crow(i, h) * TRS + r] = (bf16)f2bf(Lp[i]); Tm[crow(i, h) * TRS + r] = (bf16)f2bf(Tq[i]); }
                    asm volatile("s_waitcnt lgkmcnt(0)" ::: "memory");
                    const bf16x8 b0 = pack_acc<0>(Lp), b1 = pack_acc<1>(Lp);
                    f32x16 l2 = zero16(); l2 = MFMA32(rd_perm(imgL, TRS, r, 0, h), b0, l2); l2 = MFMA32(rd_perm(imgL, TRS, r, 16, h), b1, l2);
                    Lp = l2;
                    f32x16 mm = l2;
#pragma unroll
                    for (int i = 0; i < 16; ++i) mm[i] += (crow(i, h) == r) ? 1.f : 0.f;
                    const bf16x8 m0 = pack_acc<0>(mm), m1 = pack_acc<1>(mm);
                    f32x16 t2 = zero16(); t2 = MFMA32(rd_perm(Tm, TRS, r, 0, h), m0, t2); t2 = MFMA32(rd_perm(Tm, TRS, r, 16, h), m1, t2);
                    Tq = t2;
                    asm volatile("s_waitcnt lgkmcnt(0)" ::: "memory"); }
#pragma unroll
                for (int i = 0; i < 16; ++i) Tm[crow(i, h) * TRS + r] = (bf16)f2bf(Tq[i]); } };
            st3();
#if MK_DUP & 4
            asm volatile("" ::: "memory"); st3();
#endif
            lds_barrier();
            auto st4 = [&]() { if (w4 == 0 || w4 == 2) { const int a = w4 >> 1;
                f32x16 x1 = zero16();
#pragma unroll
                for (int ks = 0; ks < 2; ++ks) x1 = MFMA32(rd_nat(Tm, TRS, r, 16 * ks + 8 * h), rd_nat(iAT, TRS, 32 * a + r, 16 * ks + 8 * h), x1);
                const bf16x8 xf0 = pack_acc<0>(x1), xf1 = pack_acc<1>(x1);
#pragma unroll
                for (int b = 0; b < 2; ++b) { f32x16 p = zero16();
                    p = MFMA32(xf0, rd_perm(iBHT, TRS, 32 * b + r, 0, h), p); p = MFMA32(xf1, rd_perm(iBHT, TRS, 32 * b + r, 16, h), p);
                    if (a == b) { const float gc = gcv[32 * a + r];
#pragma unroll
                        for (int i = 0; i < 16; ++i) p[i] += (crow(i, h) == r) ? gc : 0.f; }
                    bf16x8* dst = PT + ((size_t)(chunk * 2 + a) * 2 + b) * 2 * 64 + lane; dst[0] = pack_acc<0>(p); dst[64] = pack_acc<1>(p); }
                f32x16 ry;
#pragma unroll
                for (int g = 0; g < 4; ++g) { const u32x2 rr = *(const LAS u32x2*)(iR + r * RMS + 32 * a + 8 * g + 4 * h);
                    ry[4 * g] = bflo(rr.x); ry[4 * g + 1] = bfhi(rr.x); ry[4 * g + 2] = bflo(rr.y); ry[4 * g + 3] = bfhi(rr.y); }
                ry = MFMA32(xf0, fnrb[lane], ry); ry = MFMA32(xf1, fnrb[64 + lane], ry);
                bf16x8* dr = RYT + (size_t)(chunk * 2 + a) * 2 * 64 + lane; dr[0] = pack_acc<0>(ry); dr[64] = pack_acc<1>(ry);
            } else if (w4 == 1) {
                f32x16 x2 = zero16();
                x2 = MFMA32(rd_perm(Tm, TRS, r, 0, h), pack_acc<0>(lak), x2); x2 = MFMA32(rd_perm(Tm, TRS, r, 16, h), pack_acc<1>(lak), x2);
                const bf16x8 xf0 = pack_acc<0>(x2), xf1 = pack_acc<1>(x2);
#pragma unroll
                for (int b = 0; b < 2; ++b) { f32x16 qm;
#pragma unroll
                    for (int g = 0; g < 4; ++g) { const u32x2 kk2 = *(const LAS u32x2*)(iKHT + (32 * b + r) * TRS + 8 * g + 4 * h);
                        qm[4 * g] = bflo(kk2.x); qm[4 * g + 1] = bfhi(kk2.x); qm[4 * g + 2] = bflo(kk2.y); qm[4 * g + 3] = bfhi(kk2.y); }
                    qm = MFMA32(xf0, rd_perm(iBHT, TRS, 32 * b + r, 0, h), qm); qm = MFMA32(xf1, rd_perm(iBHT, TRS, 32 * b + r, 16, h), qm);
                    fqm[(b * 2 + 0) * 64 + lane] = pack_acc<0>(qm); fqm[(b * 2 + 1) * 64 + lane] = pack_acc<1>(qm); }
                f32x16 gy;
#pragma unroll
                for (int i = 0; i < 16; ++i) gy[i] = cnrk[i * 64 + lane];
                gy = MFMA32(xf0, fnrb[lane], gy); gy = MFMA32(xf1, fnrb[64 + lane], gy);
                const bf16x8 gf0 = pack_acc<0>(gy), gf1 = pack_acc<1>(gy);
#pragma unroll
                for (int vh = 0; vh < 2; ++vh) { f32x16 yv = zero16();
                    yv = MFMA32(rd_perm(iVT, TRS, 32 * vh + r, 0, h), gf0, yv); yv = MFMA32(rd_perm(iVT, TRS, 32 * vh + r, 16, h), gf1, yv);
                    f32x4* dy = YVT + ((size_t)(chunk * 2 + vh) * 64 + lane) * 4;
#pragma unroll
                    for (int g = 0; g < 4; ++g) dy[g] = (f32x4){yv[4 * g], yv[4 * g + 1], yv[4 * g + 2], yv[4 * g + 3]}; }
            } };
            st4();
#if MK_DUP & 8
            asm volatile("" ::: "memory"); st4();
#endif
            lds_barrier();
            if (w4 == 3) {
#pragma unroll
                for (int b = 0; b < 2; ++b)
#pragma unroll
                    for (int vh = 0; vh < 2; ++vh) { f32x16 zv = zero16();
                        zv = MFMA32(fqm[(b * 2 + 0) * 64 + lane], rd_perm(iVT, TRS, 32 * vh + r, 0, h), zv); zv = MFMA32(fqm[(b * 2 + 1) * 64 + lane], rd_perm(iVT, TRS, 32 * vh + r, 16, h), zv);
                        f32x4* dz = ZV + (((size_t)(chunk * 2 + b) * 2 + vh) * 64 + lane) * 4;
#pragma unroll
                        for (int g = 0; g < 4; ++g) dz[g] = (f32x4){zv[4 * g], zv[4 * g + 1], zv[4 * g + 2], zv[4 * g + 3]}; }
            }
        }
    }
#undef S1_LOAD
#undef LW_LOAD
}
constexpr int WRS = 68, WTS = 36;
constexpr int WL_A = 0, WL_B = 4352, WL_K = 8704, WL_R = 13056, WL_AT = 17408, WL_BHT = 22016, WL_KHT = 26624, WL_VT = 31232, WL_SIZE = 35840, WL_LA = 4 * WL_SIZE;
static_assert(WL_LA + 32 * LAS_STRIDE * 2 <= MISC_OFF, "wave-per-chunk LDS map");
__device__ __forceinline__ bf16x8 rd_nat2(const LAS bf16* img, int stride, int row, int k0) {
    const u32x2 lo = *(const LAS u32x2*)(img + row * stride + k0), hi = *(const LAS u32x2*)(img + row * stride + k0 + 4);
    u32x4 w; w.x = lo.x; w.y = lo.y; w.z = hi.x; w.w = hi.y; return __builtin_bit_cast(bf16x8, w);
}
__device__ __forceinline__ void phase4a_wave(const Frame& F) {
    const bf16* P = wsp<bf16>(F, WS_P); const bf16* LW = wsp<bf16>(F, WS_LW);
    const float* mu = F.in[6]; const float* w0 = F.in[7]; const float* a0 = F.in[9]; const float* k_k = F.in[12]; const float* k_a = F.in[13]; const float* r_k = F.in[14];
    float* SV = wsp<float>(F, WS_SV); bf16* G = wsp<bf16>(F, WS_G); float* BON = wsp<float>(F, WS_BONUS);
    bf16x8* PT = wsp<bf16x8>(F, WS_PT); f32x4* ZV = wsp<f32x4>(F, WS_ZV); bf16x8* RYT = wsp<bf16x8>(F, WS_RYT); f32x4* YVT = wsp<f32x4>(F, WS_YVT);
    const int wv_ = F.wave & 3;
    LAS unsigned char* gl = F.lds + wv_ * WL_SIZE;
    LAS bf16* iA = (LAS bf16*)(gl + WL_A); LAS bf16* iB = (LAS bf16*)(gl + WL_B); LAS bf16* iK = (LAS bf16*)(gl + WL_K); LAS bf16* iR = (LAS bf16*)(gl + WL_R);
    LAS bf16* iAT = (LAS bf16*)(gl + WL_AT); LAS bf16* iBHT = (LAS bf16*)(gl + WL_BHT); LAS bf16* iKHT = (LAS bf16*)(gl + WL_KHT); LAS bf16* iVT = (LAS bf16*)(gl + WL_VT);
    LAS bf16* imgL = iA; LAS bf16* Tm = iB;
    LAS bf16* LA = (LAS bf16*)(F.lds + WL_LA);
    for (int tc = F.vcu; tc < M / CK; tc += F.G) {
        const int b = tc / NCHK, c = tc % NCHK, t0 = c * CK, row0 = b * T + t0;
        lds_barrier();
        { const int tk = F.tid >> 4, cb = (F.tid & 15) * 16; float x[8];
#pragma unroll
            for (int q8 = 0; q8 < 2; ++q8) { const int col = cb + 8 * q8; lerp8(P, mu, row0 + tk, t0 + tk, 1536 + col, x);
                if (col < 64) {
#pragma unroll
                    for (int j = 0; j < 8; ++j) x[j] = 2.f * sigmoidf_(2.f * x[j]) - 1.f; }
                else if (col >= 128) {
#pragma unroll
                    for (int j = 0; j < 8; ++j) x[j] = sigmoidf_(x[j]); }
                *(LAS bf16x8*)(LA + tk * LAS_STRIDE + col) = pack8(x); } }
        lds_barrier();
        if (F.wave < 4) {
#pragma unroll 1
        for (int rnd = 0; rnd < 2; ++rnd) {
            int lane = F.lane; asm volatile("" : "+v"(lane));
            const int r = lane & 31, h = lane >> 5;
            const int hh = wv_ + 4 * rnd, bh = b * RH + hh, chunk = bh * NCHK + c, cc = hh * 64 + lane;
            f32x16 aw[2], aa[2];
#pragma unroll
            for (int ct = 0; ct < 2; ++ct) { const bf16* lw = LW + (size_t)(hh * 64 + 32 * ct + r) * 256 + 8 * h;
                { bf16x8 bf_[8];
#pragma unroll
                    for (int ks = 0; ks < 8; ++ks) bf_[ks] = *(const bf16x8*)(lw + 128 + 16 * ks);
                    f32x16 g_ = zero16();
#pragma unroll
                    for (int ks = 0; ks < 8; ++ks) g_ = MFMA32(rd_nat(LA, LAS_STRIDE, r, 128 + 16 * ks + 8 * h), bf_[ks], g_);
#pragma unroll
                    for (int i = 0; i < 16; ++i) if (MK_WMASK & 1) G[(size_t)(row0 + crow(i, h)) * 512 + hh * 64 + 32 * ct + r] = (bf16)f2bf(g_[i]); }
                { bf16x8 bf_[8];
#pragma unroll
                    for (int ks = 0; ks < 8; ++ks) bf_[ks] = *(const bf16x8*)(lw + 16 * ks);
                    f32x16 w_ = zero16(), a_ = zero16();
#pragma unroll
                    for (int ks = 0; ks < 4; ++ks) { w_ = MFMA32(rd_nat(LA, LAS_STRIDE, r, 16 * ks + 8 * h), bf_[ks], w_); a_ = MFMA32(rd_nat(LA, LAS_STRIDE, r, 64 + 16 * ks + 8 * h), bf_[4 + ks], a_); }
                    aw[ct] = w_; aa[ct] = a_; } }
            f32x16 wo, wr_, ao, ar_;
#pragma unroll
            for (int i = 0; i < 16; ++i) { wo[i] = h ? aw[1][i] : aw[0][i]; ao[i] = h ? aa[1][i] : aa[0][i];
                wr_[i] = __shfl_xor(h ? aw[0][i] : aw[1][i], 32); ar_[i] = __shfl_xor(h ? aa[0][i] : aa[1][i], 32); }
            const float mur = mu[cc], muk = mu[512 + cc], muv = mu[1024 + cc], w0c = w0[cc], a0c = a0[cc], kkc = k_k[cc], kac = k_a[cc], rkc = r_k[cc];
            float gam[32];
#pragma unroll
            for (int t = 0; t < 32; ++t) { const int i = (t & 3) + 4 * (t >> 3); const float wl = (((t >> 2) & 1) == h) ? wo[i] : wr_[i];
                const float dec = __expf(-0.60653066f * sigmoidf_(w0c + wl)); gam[t] = t ? gam[t - 1] * dec : dec; }
            const float gC = gam[31];
            const size_t pbase = (size_t)row0 * IN_COLS + cc;
            bf16 pr_ = 0, pk_ = 0, pv_ = 0;
            if (t0 > 0) { pr_ = P[pbase - IN_COLS]; pk_ = P[pbase - IN_COLS + 512]; pv_ = P[pbase - IN_COLS + 1024]; }
#pragma unroll
            for (int tb = 0; tb < 4; ++tb) {
                asm volatile("" ::: "memory");
                bf16 cr[8], ck[8], cv[8];
#pragma unroll
                for (int i = 0; i < 8; ++i) { const size_t o = pbase + (size_t)(8 * tb + i) * IN_COLS; cr[i] = P[o]; ck[i] = P[o + 512]; cv[i] = P[o + 1024]; }
                float rv[8], vv[8], kk[8], ssq[8], bo[8], av[8], kv[8];
#pragma unroll
                for (int i = 0; i < 8; ++i) { const int t = 8 * tb + i, ii = (t & 3) + 4 * (t >> 3);
                    const float c_r = bf2f(cr[i]), c_k = bf2f(ck[i]), c_v = bf2f(cv[i]);
                    const float p_r = bf2f(i ? cr[i - 1] : pr_), p_k = bf2f(i ? ck[i - 1] : pk_), p_v = bf2f(i ? cv[i - 1] : pv_);
                    rv[i] = c_r + (p_r - c_r) * mur; const float kr = c_k + (p_k - c_k) * muk; vv[i] = c_v + (p_v - c_v) * muv;
                    const float al = (((t >> 2) & 1) == h) ? ao[ii] : ar_[ii];
                    av[i] = sigmoidf_(a0c + al);
                    kk[i] = kr * kkc; ssq[i] = kk[i] * kk[i]; kv[i] = kr * (1.f + (av[i] - 1.f) * kac); bo[i] = rv[i] * kv[i] * rkc; }
                pr_ = cr[7]; pk_ = ck[7]; pv_ = cv[7];
#pragma unroll
                for (int i = 0; i < 8; ++i) { ssq[i] = reduce16(ssq[i]); bo[i] = reduce16(bo[i]); }
#pragma unroll
                for (int i = 0; i < 8; ++i) { ssq[i] += __shfl_xor(ssq[i], 16); bo[i] += __shfl_xor(bo[i], 16); }
#pragma unroll
                for (int i = 0; i < 8; ++i) { ssq[i] += __shfl_xor(ssq[i], 32); bo[i] += __shfl_xor(bo[i], 32); }
                float at[8], bh8[8], kh8[8];
#pragma unroll
                for (int i = 0; i < 8; ++i) { const int t = 8 * tb + i;
                    const float kkn = kk[i] * __builtin_amdgcn_rcpf(fmaxf(sqrtf(ssq[i]), 1e-12f)), bb = kkn * av[i];
                    const float g = gam[t], gp = t ? gam[t - 1] : 1.f, ig = __builtin_amdgcn_rcpf(g);
                    const float bt = bb * ig, kt = kv[i] * ig; at[i] = -kkn * gp; bh8[i] = bt * gC; kh8[i] = kt * gC;
                    const int ro = t * WRS + lane;
                    iA[ro] = (bf16)f2bf(at[i]); iB[ro] = (bf16)f2bf(bt); iK[ro] = (bf16)f2bf(kt); iR[ro] = (bf16)f2bf(rv[i] * g);
                    if (MK_WMASK & 2) { SV[((size_t)bh * T + t0 + t) * 64 + lane] = vv[i];
                    if (lane == 0) BON[(row0 + t) * 8 + hh] = bo[i]; } }
#pragma unroll
                for (int q = 0; q < 2; ++q) { u32x2 w;
                    w.x = pk2(at[4 * q], at[4 * q + 1]); w.y = pk2(at[4 * q + 2], at[4 * q + 3]); *(LAS u32x2*)(iAT + lane * WTS + 8 * tb + 4 * q) = w;
                    w.x = pk2(bh8[4 * q], bh8[4 * q + 1]); w.y = pk2(bh8[4 * q + 2], bh8[4 * q + 3]); *(LAS u32x2*)(iBHT + lane * WTS + 8 * tb + 4 * q) = w;
                    w.x = pk2(kh8[4 * q], kh8[4 * q + 1]); w.y = pk2(kh8[4 * q + 2], kh8[4 * q + 3]); *(LAS u32x2*)(iKHT + lane * WTS + 8 * tb + 4 * q) = w;
                    w.x = pk2(vv[4 * q], vv[4 * q + 1]); w.y = pk2(vv[4 * q + 2], vv[4 * q + 3]); *(LAS u32x2*)(iVT + lane * WTS + 8 * tb + 4 * q) = w; }
            }
            asm volatile("s_waitcnt lgkmcnt(0)" ::: "memory");
            f32x16 lab = zero16(), lak = zero16(), nrb = zero16(), nrk = zero16();
#pragma unroll
            for (int ks = 0; ks < 4; ++ks) { const bf16x8 fa = rd_nat2(iA, WRS, r, 16 * ks + 8 * h), fb = rd_nat2(iB, WRS, r, 16 * ks + 8 * h), fk = rd_nat2(iK, WRS, r, 16 * ks + 8 * h), fr_ = rd_nat2(iR, WRS, r, 16 * ks + 8 * h);
                lab = MFMA32(fa, fb, lab); lak = MFMA32(fa, fk, lak); nrb = MFMA32(fb, fr_, nrb); nrk = MFMA32(fk, fr_, nrk); }
#pragma unroll
            for (int i = 0; i < 16; ++i) { const int row = crow(i, h); lab[i] = (r < row) ? lab[i] : 0.f; lak[i] = (r < row) ? lak[i] : 0.f; nrb[i] = (row <= r) ? nrb[i] : 0.f; nrk[i] = (row <= r) ? nrk[i] : 0.f; }
            const bf16x8 fn0 = pack_acc<0>(nrb), fn1 = pack_acc<1>(nrb);
            asm volatile("s_waitcnt lgkmcnt(0)" ::: "memory");
            { f32x16 Lp = lab, Tq = lab;
#pragma unroll
                for (int i = 0; i < 16; ++i) Tq[i] += (crow(i, h) == r) ? 1.f : 0.f;
#pragma unroll
                for (int st = 0; st < 4; ++st) {
#pragma unroll
                    for (int i = 0; i < 16; ++i) { imgL[crow(i, h) * WTS + r] = (bf16)f2bf(Lp[i]); Tm[crow(i, h) * WTS + r] = (bf16)f2bf(Tq[i]); }
                    asm volatile("s_waitcnt lgkmcnt(0)" ::: "memory");
                    const bf16x8 b0 = pack_acc<0>(Lp), b1 = pack_acc<1>(Lp);
                    f32x16 l2 = zero16(); l2 = MFMA32(rd_perm(imgL, WTS, r, 0, h), b0, l2); l2 = MFMA32(rd_perm(imgL, WTS, r, 16, h), b1, l2);
                    Lp = l2;
                    f32x16 mm = l2;
#pragma unroll
                    for (int i = 0; i < 16; ++i) mm[i] += (crow(i, h) == r) ? 1.f : 0.f;
                    const bf16x8 m0 = pack_acc<0>(mm), m1 = pack_acc<1>(mm);
                    f32x16 t2 = zero16(); t2 = MFMA32(rd_perm(Tm, WTS, r, 0, h), m0, t2); t2 = MFMA32(rd_perm(Tm, WTS, r, 16, h), m1, t2);
                    Tq = t2;
                    asm volatile("s_waitcnt lgkmcnt(0)" ::: "memory"); }
#pragma unroll
                for (int i = 0; i < 16; ++i) Tm[crow(i, h) * WTS + r] = (bf16)f2bf(Tq[i]);
                asm volatile("s_waitcnt lgkmcnt(0)" ::: "memory"); }
            const float gcd2[2] = {__shfl(gC, r), __shfl(gC, 32 + r)};
#pragma unroll
            for (int a = 0; a < 2; ++a) { f32x16 x1 = zero16();
#pragma unroll
                for (int ks = 0; ks < 2; ++ks) x1 = MFMA32(rd_nat2(Tm, WTS, r, 16 * ks + 8 * h), rd_nat2(iAT, WTS, 32 * a + r, 16 * ks + 8 * h), x1);
                const bf16x8 xf0 = pack_acc<0>(x1), xf1 = pack_acc<1>(x1);
#pragma unroll
                for (int b2 = 0; b2 < 2; ++b2) { f32x16 p = zero16();
                    p = MFMA32(xf0, rd_perm(iBHT, WTS, 32 * b2 + r, 0, h), p); p = MFMA32(xf1, rd_perm(iBHT, WTS, 32 * b2 + r, 16, h), p);
                    if (a == b2) { const float gcd = gcd2[a];
#pragma unroll
                        for (int i = 0; i < 16; ++i) p[i] += (crow(i, h) == r) ? gcd : 0.f; }
                    bf16x8* dst = PT + ((size_t)(chunk * 2 + a) * 2 + b2) * 2 * 64 + lane; if (MK_WMASK & 4) { dst[0] = pack_acc<0>(p); dst[64] = pack_acc<1>(p); } }
                f32x16 ry;
#pragma unroll
                for (int g = 0; g < 4; ++g) { const u32x2 rr = *(const LAS u32x2*)(iR + r * WRS + 32 * a + 8 * g + 4 * h);
                    ry[4 * g] = bflo(rr.x); ry[4 * g + 1] = bfhi(rr.x); ry[4 * g + 2] = bflo(rr.y); ry[4 * g + 3] = bfhi(rr.y); }
                ry = MFMA32(xf0, fn0, ry); ry = MFMA32(xf1, fn1, ry);
                bf16x8* dr = RYT + (size_t)(chunk * 2 + a) * 2 * 64 + lane; if (MK_WMASK & 8) { dr[0] = pack_acc<0>(ry); dr[64] = pack_acc<1>(ry); } }
            { f32x16 x2 = zero16();
                x2 = MFMA32(rd_perm(Tm, WTS, r, 0, h), pack_acc<0>(lak), x2); x2 = MFMA32(rd_perm(Tm, WTS, r, 16, h), pack_acc<1>(lak), x2);
                const bf16x8 xf0 = pack_acc<0>(x2), xf1 = pack_acc<1>(x2);
                bf16x8 fq[2][2];
#pragma unroll
                for (int b2 = 0; b2 < 2; ++b2) { f32x16 qm;
#pragma unroll
                    for (int g = 0; g < 4; ++g) { const u32x2 kk2 = *(const LAS u32x2*)(iKHT + (32 * b2 + r) * WTS + 8 * g + 4 * h);
                        qm[4 * g] = bflo(kk2.x); qm[4 * g + 1] = bfhi(kk2.x); qm[4 * g + 2] = bflo(kk2.y); qm[4 * g + 3] = bfhi(kk2.y); }
                    qm = MFMA32(xf0, rd_perm(iBHT, WTS, 32 * b2 + r, 0, h), qm); qm = MFMA32(xf1, rd_perm(iBHT, WTS, 32 * b2 + r, 16, h), qm);
                    fq[b2][0] = pack_acc<0>(qm); fq[b2][1] = pack_acc<1>(qm); }
                f32x16 gy = nrk;
                gy = MFMA32(xf0, fn0, gy); gy = MFMA32(xf1, fn1, gy);
                const bf16x8 gf0 = pack_acc<0>(gy), gf1 = pack_acc<1>(gy);
#pragma unroll
                for (int vh = 0; vh < 2; ++vh) { f32x16 yv = zero16();
                    yv = MFMA32(rd_perm(iVT, WTS, 32 * vh + r, 0, h), gf0, yv); yv = MFMA32(rd_perm(iVT, WTS, 32 * vh + r, 16, h), gf1, yv);
                    f32x4* dy = YVT + ((size_t)(chunk * 2 + vh) * 64 + lane) * 4;
#pragma unroll
                    for (int g = 0; g < 4; ++g) if (MK_WMASK & 16) dy[g] = (f32x4){yv[4 * g], yv[4 * g + 1], yv[4 * g + 2], yv[4 * g + 3]}; }
#pragma unroll
                for (int b2 = 0; b2 < 2; ++b2)
#pragma unroll
                    for (int vh = 0; vh < 2; ++vh) { f32x16 zv = zero16();
                        zv = MFMA32(fq[b2][0], rd_perm(iVT, WTS, 32 * vh + r, 0, h), zv); zv = MFMA32(fq[b2][1], rd_perm(iVT, WTS, 32 * vh + r, 16, h), zv);
                        f32x4* dz = ZV + (((size_t)(chunk * 2 + b2) * 2 + vh) * 64 + lane) * 4;
#pragma unroll
                        for (int g = 0; g < 4; ++g) if (MK_WMASK & 32) dz[g] = (f32x4){zv[4 * g], zv[4 * g + 1], zv[4 * g + 2], zv[4 * g + 3]}; } }
            asm volatile("s_waitcnt lgkmcnt(0)" ::: "memory");
        }
        }
    }
}

constexpr int SB_SLOT = 16384, SB_NSLOT = 7, SB_FLAGS = SB_NSLOT * SB_SLOT;
constexpr int CONV_4B = MK_CONV_WHERE == 9 ? 6144 : 0;
__device__ __forceinline__ void phase4b_states(const Frame& F) {
    volatile LAS unsigned* FULL = (volatile LAS unsigned*)(F.lds + SB_FLAGS);
    volatile LAS unsigned* DONEC = (volatile LAS unsigned*)(F.lds + SB_FLAGS + 64);
    __syncthreads();
    if (F.tid < 32) ((LAS unsigned*)(F.lds + SB_FLAGS))[F.tid] = 0u;
    __syncthreads();
    if (F.vcu < 128) {
        const int bh = F.vcu >> 1, vh = F.vcu & 1, lane = F.lane;
        if (F.wave == 0) {
            bf16x8* Z0 = wsp<bf16x8>(F, WS_Z0);
            f32x16 z0 = zero16(), z1 = zero16();
            int slot = 0;
            for (int c = 0; c < NCHK; ++c) { const int chunk = bh * NCHK + c;
                const bf16x8 f00 = pack_acc<0>(z0), f01 = pack_acc<1>(z0), f10 = pack_acc<0>(z1), f11 = pack_acc<1>(z1);
                bf16x8* dz = Z0 + (size_t)(chunk * 2 + vh) * 4 * 64 + lane; dz[0] = f00; dz[64] = f01; dz[128] = f10; dz[192] = f11;
                { int sp = 0; while (FULL[slot] < (unsigned)(c + 1)) { if (++sp > SC_SPIN_CAP) break; } }
                __builtin_amdgcn_fence(__ATOMIC_ACQUIRE, "workgroup");
                const LAS unsigned char* sb = F.lds + slot * SB_SLOT;
                const LAS bf16x8* p = (const LAS bf16x8*)sb + lane;
                const LAS f32x4* s0 = (const LAS f32x4*)(sb + 8192) + lane * 4; const LAS f32x4* s1 = (const LAS f32x4*)(sb + 12288) + lane * 4;
                f32x16 n0, n1;
#pragma unroll
                for (int g = 0; g < 4; ++g) { const f32x4 u = s0[g], w = s1[g]; n0[4 * g] = u[0]; n0[4 * g + 1] = u[1]; n0[4 * g + 2] = u[2]; n0[4 * g + 3] = u[3]; n1[4 * g] = w[0]; n1[4 * g + 1] = w[1]; n1[4 * g + 2] = w[2]; n1[4 * g + 3] = w[3]; }
                const bf16x8 p000 = p[0 * 64], p001 = p[1 * 64], p010 = p[2 * 64], p011 = p[3 * 64], p100 = p[4 * 64], p101 = p[5 * 64], p110 = p[6 * 64], p111 = p[7 * 64];
                asm volatile("s_waitcnt lgkmcnt(0)" ::: "memory");
                if (lane == 0) DONEC[0] = (unsigned)(c + 1);
                n0 = MFMA32(p000, f00, n0); n0 = MFMA32(p001, f01, n0); n0 = MFMA32(p100, f10, n0); n0 = MFMA32(p101, f11, n0);
                n1 = MFMA32(p010, f00, n1); n1 = MFMA32(p011, f01, n1); n1 = MFMA32(p110, f10, n1); n1 = MFMA32(p111, f11, n1);
                z0 = n0; z1 = n1;
                slot = (slot + 1 == SB_NSLOT) ? 0 : slot + 1; }
        } else {
            const int slot = F.wave - 1;
            const unsigned char* gpt = (const unsigned char*)wsp<bf16x8>(F, WS_PT) + lane * 16;
            const unsigned char* gzv = (const unsigned char*)wsp<f32x4>(F, WS_ZV) + lane * 16;
            LAS unsigned char* dst = F.lds + slot * SB_SLOT;
            for (int c = slot; c < NCHK; c += SB_NSLOT) { const int chunk = bh * NCHK + c;
                if (c >= SB_NSLOT) { const unsigned need = (unsigned)(c - SB_NSLOT + 1); int sp = 0;
                    while (DONEC[0] < need) { __builtin_amdgcn_s_sleep(1); if (++sp > SC_SPIN_CAP) break; }
                    __builtin_amdgcn_fence(__ATOMIC_ACQUIRE, "workgroup"); }
                const unsigned char* sp_ = gpt + (size_t)chunk * 8192;
#pragma unroll
                for (int j = 0; j < 8; ++j) __builtin_amdgcn_global_load_lds((const unsigned*)(sp_ + j * 1024), (LAS unsigned*)(dst + j * 1024), 16, 0, 0);
                const unsigned char* sz0 = gzv + ((size_t)(chunk * 2 + 0) * 2 + vh) * 4096; const unsigned char* sz1 = gzv + ((size_t)(chunk * 2 + 1) * 2 + vh) * 4096;
#pragma unroll
                for (int j = 0; j < 4; ++j) { __builtin_amdgcn_global_load_lds((const unsigned*)(sz0 + j * 1024), (LAS unsigned*)(dst + 8192 + j * 1024), 16, 0, 0);
                    __builtin_amdgcn_global_load_lds((const unsigned*)(sz1 + j * 1024), (LAS unsigned*)(dst + 12288 + j * 1024), 16, 0, 0); }
                asm volatile("s_waitcnt vmcnt(0)" ::: "memory");
                if (lane == 0) FULL[slot] = (unsigned)(c + 1); }
        }
    } else {
        for (int it = (F.vcu - 128) * 8 + F.wave; it < CONV_4B; it += 128 * 8) moe_weight_item(F, it);
    }
    __syncthreads();
}

__device__ __forceinline__ void phase4c_output(const Frame& F) {
    const bf16x8* Z0 = wsp<bf16x8>(F, WS_Z0); const bf16x8* RYT = wsp<bf16x8>(F, WS_RYT); const f32x4* YVT = wsp<f32x4>(F, WS_YVT);
    const float* SV = wsp<float>(F, WS_SV); const bf16* G = wsp<bf16>(F, WS_G); const float* BON = wsp<float>(F, WS_BONUS); bf16* CAT = wsp<bf16>(F, WS_CAT);
    const float* lg = F.in[15]; const float* lb = F.in[16];
    const int gw = F.vcu * 8 + F.wave, NGW = F.G * 8, lane = F.lane, r = lane & 31, h = lane >> 5;
    for (int chunk = gw; chunk < NBATCH * RH * NCHK; chunk += NGW) {
        const int bh = chunk / NCHK, c = chunk % NCHK, b = bh / RH, hh = bh % RH, t = c * CK + r, row = b * T + t;
        const bf16x8* rf = RYT + (size_t)chunk * 4 * 64 + lane;
        f32x16 y[2];
#pragma unroll
        for (int vh = 0; vh < 2; ++vh) { const f32x4* sy = YVT + ((size_t)(chunk * 2 + vh) * 64 + lane) * 4;
#pragma unroll
            for (int g = 0; g < 4; ++g) { const f32x4 u = __builtin_nontemporal_load(sy + g); y[vh][4 * g] = u[0]; y[vh][4 * g + 1] = u[1]; y[vh][4 * g + 2] = u[2]; y[vh][4 * g + 3] = u[3]; }
            const bf16x8* zf = Z0 + (size_t)(chunk * 2 + vh) * 4 * 64 + lane;
#pragma unroll
            for (int q = 0; q < 4; ++q) y[vh] = MFMA32(__builtin_nontemporal_load(zf + q * 64), rf[q * 64], y[vh]); }
        float sm = 0.f;
#pragma unroll
        for (int vh = 0; vh < 2; ++vh)
#pragma unroll
            for (int i = 0; i < 16; ++i) sm += y[vh][i];
        sm += __shfl_xor(sm, 32);
        const float mean = sm * (1.f / 64.f); float qv = 0.f;
#pragma unroll
        for (int vh = 0; vh < 2; ++vh)
#pragma unroll
            for (int i = 0; i < 16; ++i) { y[vh][i] -= mean; qv += y[vh][i] * y[vh][i]; }
        qv += __shfl_xor(qv, 32);
        const float rstd = rsqrtf(qv * (1.f / 64.f) + GN_EPS);
        const float bon = BON[row * 8 + hh];
#pragma unroll
        for (int vh = 0; vh < 2; ++vh)
#pragma unroll
            for (int g = 0; g < 4; ++g) { const int v0 = 32 * vh + 8 * g + 4 * h, c0 = hh * 64 + v0;
                const f32x4 vv = *(const f32x4*)(SV + ((size_t)bh * T + t) * 64 + v0), lg4 = *(const f32x4*)(lg + c0), lb4 = *(const f32x4*)(lb + c0);
                const u32x2 gr = *(const u32x2*)(G + (size_t)row * 512 + c0);
                const float gg[4] = {bflo(gr.x), bfhi(gr.x), bflo(gr.y), bfhi(gr.y)}; float o[4];
#pragma unroll
                for (int q = 0; q < 4; ++q) o[q] = (y[vh][4 * g + q] * rstd * lg4[q] + lb4[q] + bon * vv[q]) * gg[q];
                u32x2 w; w.x = pk2(o[0], o[1]); w.y = pk2(o[2], o[3]);
                *(u32x2*)(CAT + (size_t)row * D + c0) = w; }
    }
}

constexpr int SC_STEPS = 16, SC_NSLOT = 6, SC_SHARED = SC_STEPS * 1280, SC_SLOT = SC_SHARED + SC_STEPS * 64, SC_RING = SC_NSLOT * SC_SLOT;
constexpr int SC_FLAGS = SC_RING, SC_CONV = SC_RING + 256, SC_NCH = T / SC_STEPS;
static_assert(SC_CONV + 3 * 8704 <= LDS_BYTES, "scan LDS map");
__device__ __forceinline__ void phase4_scan(const Frame& F) {
    volatile LAS unsigned* READY = (volatile LAS unsigned*)(F.lds + SC_FLAGS);
    volatile LAS unsigned* DONE = (volatile LAS unsigned*)(F.lds + SC_FLAGS + 64);
    __syncthreads();
    if (F.tid < 64) ((LAS unsigned*)(F.lds + SC_FLAGS))[F.tid] = 0u;
    __syncthreads();
    const int bh = F.vcu >> 2, rg = F.vcu & 3, b = bh / RH, hh = bh % RH;
    if (F.wave < 4) {
        const int rl = F.lane >> 4, ks = F.lane & 15, rowl = F.wave * 4 + rl;
        float* yp = wsp<float>(F, WS_Y) + (size_t)b * T * 512 + hh * 64 + rg * 16 + rowl;
        f32x4 S = (f32x4){0.f, 0.f, 0.f, 0.f};
        int slot = 0;
        for (int c = 0; c < SC_NCH; ++c) {
#if MK_RWKV_MODE == 1
            if ((c & 1) == 0) {
                const int v = rg * 16 + rowl, chunk = bh * NCHK + (c >> 1);
                const bf16* zp = wsp<bf16>(F, WS_Z0) + ((((size_t)chunk * 2 + (v >> 5)) * 2 + (ks >> 3)) * 2 + ((ks >> 2) & 1)) * 512 + ((v & 31) + 32 * (ks & 1)) * 8 + 4 * ((ks >> 1) & 1);
                const u32x2 zz = *(const u32x2*)zp;
                S = (f32x4){bflo(zz.x), bfhi(zz.x), bflo(zz.y), bfhi(zz.y)}; }
#endif
            { int sp = 0; while (READY[slot] < (unsigned)(c + 1)) { if (++sp > SC_SPIN_CAP) break; } }
            __builtin_amdgcn_fence(__ATOMIC_ACQUIRE, "workgroup");
            const LAS unsigned char* sb = F.lds + slot * SC_SLOT;
            const LAS unsigned char* op = sb + ks * 16; const LAS float* vp = (const LAS float*)(sb + SC_SHARED) + rowl;
            f32x4 w4 = *(const LAS f32x4*)(op), kk4 = *(const LAS f32x4*)(op + 256), b4 = *(const LAS f32x4*)(op + 512), k4 = *(const LAS f32x4*)(op + 768), r4 = *(const LAS f32x4*)(op + 1024);
            float v = vp[0];
            float ykeep = 0.f;
#pragma unroll
            for (int s = 0; s < SC_STEPS; ++s) {
                const f32x4 cw = w4, ckk = kk4, cb = b4, ck = k4, cr = r4; const float cv = v;
                if (s + 1 < SC_STEPS) { const LAS unsigned char* o2 = op + (s + 1) * 1280;
                    w4 = *(const LAS f32x4*)(o2); kk4 = *(const LAS f32x4*)(o2 + 256); b4 = *(const LAS f32x4*)(o2 + 512); k4 = *(const LAS f32x4*)(o2 + 768); r4 = *(const LAS f32x4*)(o2 + 1024);
                    v = vp[(s + 1) * 16]; }
                if (s == SC_STEPS - 1) { asm volatile("s_waitcnt lgkmcnt(0)" ::: "memory"); if (F.lane == 0) DONE[F.wave] = (unsigned)(c + 1); }
                float p = (S[0] * ckk[0] + S[1] * ckk[1]) + (S[2] * ckk[2] + S[3] * ckk[3]);
                p = reduce16(p);
                const f32x4 tt = S * cw + ck * cv;
                S = tt - cb * p;
                float q = (S[0] * cr[0] + S[1] * cr[1]) + (S[2] * cr[2] + S[3] * cr[3]);
                q = reduce16(q);
                ykeep = (ks == s) ? q : ykeep;
            }
            yp[(size_t)(c * SC_STEPS + ks) * 512] = ykeep;
            slot = (slot + 1 == SC_NSLOT) ? 0 : slot + 1;
        }
    } else if (F.wave == 4) {
        const unsigned char* gs = (const unsigned char*)(wsp<float>(F, WS_SCN) + (size_t)bh * T * 320) + F.lane * 16;
        const unsigned char* gv = (const unsigned char*)(wsp<float>(F, WS_SV) + (size_t)bh * T * 64 + (F.lane >> 2) * 64 + rg * 16 + (F.lane & 3) * 4);
        int slot = 0;
        for (int c = 0; c < SC_NCH; ++c) {
            if (c >= SC_NSLOT) { const unsigned need = (unsigned)(c - SC_NSLOT + 1); int sp = 0;
                while (DONE[0] < need || DONE[1] < need || DONE[2] < need || DONE[3] < need) { __builtin_amdgcn_s_sleep(1); if (++sp > SC_SPIN_CAP) break; }
                __builtin_amdgcn_fence(__ATOMIC_ACQUIRE, "workgroup"); }
            LAS unsigned char* dst = F.lds + slot * SC_SLOT;
            const unsigned char* src = gs + (size_t)c * SC_SHARED;
#pragma unroll
            for (int j = 0; j < SC_SHARED / 1024; ++j) __builtin_amdgcn_global_load_lds((const unsigned*)(src + j * 1024), (LAS unsigned*)(dst + j * 1024), 16, 0, 0);
            __builtin_amdgcn_global_load_lds((const unsigned*)(gv + (size_t)c * SC_STEPS * 256), (LAS unsigned*)(dst + SC_SHARED), 16, 0, 0);
            if (c >= 2) { asm volatile("s_waitcnt vmcnt(42)" ::: "memory"); const int ps = (slot >= 2) ? slot - 2 : slot + SC_NSLOT - 2; if (F.lane == 0) READY[ps] = (unsigned)(c - 1); }
            slot = (slot + 1 == SC_NSLOT) ? 0 : slot + 1;
        }
        { asm volatile("s_waitcnt vmcnt(21)" ::: "memory"); const int ps = (slot >= 2) ? slot - 2 : slot + SC_NSLOT - 2; if (F.lane == 0) READY[ps] = (unsigned)(SC_NCH - 1); }
        { asm volatile("s_waitcnt vmcnt(0)" ::: "memory"); const int ps = (slot >= 1) ? slot - 1 : SC_NSLOT - 1; if (F.lane == 0) READY[ps] = (unsigned)(SC_NCH); }
    } else {
#if MK_CONV_IN_SCAN
        for (int it = F.vcu * 3 + (F.wave - 5); it < MOE_ITEMS; it += F.G * 3) moe_weight_item(F, it);
#endif
    }
    __syncthreads();
}

constexpr int KLD = 72;
constexpr int VLD = 260;
__device__ __forceinline__ void phase5_attn(const Frame& F) {
    const bf16* P = wsp<bf16>(F, WS_P);
    bf16* CAT = wsp<bf16>(F, WS_CAT);
    const float* qg = F.in[17]; const float* kg = F.in[18]; const float* sinks = F.in[19];
    LAS bf16* Kl = (LAS bf16*)F.lds;
    LAS bf16* Vt = (LAS bf16*)(F.lds + 256 * KLD * 2);
    const int lane = F.lane, r = lane & 31, h = lane >> 5;
    for (int unit = F.vcu; unit < NBATCH * KVH * (T / 128); unit += F.G) {
        const int blk = unit % (T / 128), kvh = (unit / (T / 128)) % KVH, b = unit / (T / 128 * KVH);
        const int kpos0 = blk * 128 - 128;
        __syncthreads();
        for (int ch = F.tid; ch < 2048; ch += 512) { const int key = ch >> 3, dc = ch & 7, kpos = kpos0 + key;
            u32x4 kraw = (u32x4){0u, 0u, 0u, 0u}, vraw = (u32x4){0u, 0u, 0u, 0u};
            if (kpos >= 0) { const size_t ro = (size_t)(b * T + kpos) * IN_COLS; kraw = *(const u32x4*)(P + ro + COL_K + kvh * 64 + dc * 8); vraw = *(const u32x4*)(P + ro + COL_V + kvh * 64 + dc * 8); }
            float kf[8]; kf[0] = bflo(kraw.x); kf[1] = bfhi(kraw.x); kf[2] = bflo(kraw.y); kf[3] = bfhi(kraw.y); kf[4] = bflo(kraw.z); kf[5] = bfhi(kraw.z); kf[6] = bflo(kraw.w); kf[7] = bfhi(kraw.w);
            float ss = 0.f;
#pragma unroll
            for (int j = 0; j < 8; ++j) ss += kf[j] * kf[j];
            ss += __shfl_xor(ss, 1); ss += __shfl_xor(ss, 2); ss += __shfl_xor(ss, 4);
            const float rstd = rsqrtf(ss * (1.f / 64.f) + NORM_EPS);
            const f32x4 g0 = *(const f32x4*)(kg + dc * 8), g1 = *(const f32x4*)(kg + dc * 8 + 4);
            u32x4 ko; ko.x = pk2(kf[0] * rstd * g0[0], kf[1] * rstd * g0[1]); ko.y = pk2(kf[2] * rstd * g0[2], kf[3] * rstd * g0[3]);
            ko.z = pk2(kf[4] * rstd * g1[0], kf[5] * rstd * g1[1]); ko.w = pk2(kf[6] * rstd * g1[2], kf[7] * rstd * g1[3]);
            *(LAS u32x4*)(Kl + key * KLD + dc * 8) = ko;
            const unsigned vv[4] = {vraw.x, vraw.y, vraw.z, vraw.w};
#pragma unroll
            for (int j = 0; j < 4; ++j) { Vt[(dc * 8 + 2 * j) * VLD + key] = (bf16)(vv[j] & 0xffffu); Vt[(dc * 8 + 2 * j + 1) * VLD + key] = (bf16)(vv[j] >> 16); }
        }
        __syncthreads();
        for (int task = F.wave; task < 16; task += 8) {
            const int g = task & 3, qs = task >> 2, head = kvh * 4 + g;
            const int qrow = b * T + blk * 128 + qs * 32 + r;
            float qf[4][8]; float ss = 0.f;
#pragma unroll
            for (int s = 0; s < 4; ++s) { const u32x4 qr = *(const u32x4*)(P + (size_t)qrow * IN_COLS + COL_Q + head * 64 + 16 * s + 8 * h);
                qf[s][0] = bflo(qr.x); qf[s][1] = bfhi(qr.x); qf[s][2] = bflo(qr.y); qf[s][3] = bfhi(qr.y); qf[s][4] = bflo(qr.z); qf[s][5] = bfhi(qr.z); qf[s][6] = bflo(qr.w); qf[s][7] = bfhi(qr.w);
#pragma unroll
                for (int j = 0; j < 8; ++j) ss += qf[s][j] * qf[s][j]; }
            ss += __shfl_xor(ss, 32);
            const float qscale = rsqrtf(ss * (1.f / 64.f) + NORM_EPS) * 0.125f;
            bf16x8 qb[4];
#pragma unroll
            for (int s = 0; s < 4; ++s) { u32x4 w;
                const f32x4 g0 = *(const f32x4*)(qg + 16 * s + 8 * h), g1 = *(const f32x4*)(qg + 16 * s + 8 * h + 4);
                w.x = pk2(qf[s][0] * qscale * g0[0], qf[s][1] * qscale * g0[1]); w.y = pk2(qf[s][2] * qscale * g0[2], qf[s][3] * qscale * g0[3]);
                w.z = pk2(qf[s][4] * qscale * g1[0], qf[s][5] * qscale * g1[1]); w.w = pk2(qf[s][6] * qscale * g1[2], qf[s][7] * qscale * g1[3]);
                qb[s] = __builtin_bit_cast(bf16x8, w); }
            f32x16 st[5];
#pragma unroll
            for (int kt = 0; kt < 5; ++kt) {
#pragma unroll
                for (int i = 0; i < 16; ++i) st[kt][i] = 0.f;
#pragma unroll
                for (int s = 0; s < 4; ++s) { const bf16x8 ka = *(const LAS bf16x8*)(Kl + (32 * (qs + kt) + r) * KLD + 16 * s + 8 * h);
                    st[kt] = __builtin_amdgcn_mfma_f32_32x32x16_bf16(ka, qb[s], st[kt], 0, 0, 0); }
            }
            const int iq = 32 * qs + r;
            const float sink = sinks[head];
            float mx = sink;
#pragma unroll
            for (int kt = 0; kt < 5; ++kt)
#pragma unroll
                for (int i = 0; i < 16; ++i) { const int jw = 32 * (qs + kt) + (i & 3) + 8 * (i >> 2) + 4 * h;
                    const bool ok = (jw >= iq + 1) && (jw <= iq + 128) && (kpos0 + jw >= 0);
                    st[kt][i] = ok ? st[kt][i] : -INFINITY; mx = fmaxf(mx, st[kt][i]); }
            mx = fmaxf(mx, __shfl_xor(mx, 32));
            float lsum = 0.f;
#pragma unroll
            for (int kt = 0; kt < 5; ++kt)
#pragma unroll
                for (int i = 0; i < 16; ++i) { const float p = __expf(st[kt][i] - mx); st[kt][i] = p; lsum += p; }
            lsum += __shfl_xor(lsum, 32);
            const float linv = __builtin_amdgcn_rcpf(lsum + __expf(sink - mx));
            f32x16 o[2];
#pragma unroll
            for (int dt = 0; dt < 2; ++dt)
#pragma unroll
                for (int i = 0; i < 16; ++i) o[dt][i] = 0.f;
#pragma unroll
            for (int kt = 0; kt < 5; ++kt)
#pragma unroll
                for (int sp = 0; sp < 2; ++sp) { u32x4 pw;
                    pw.x = pk2(st[kt][8 * sp + 0] * linv, st[kt][8 * sp + 1] * linv); pw.y = pk2(st[kt][8 * sp + 2] * linv, st[kt][8 * sp + 3] * linv);
                    pw.z = pk2(st[kt][8 * sp + 4] * linv, st[kt][8 * sp + 5] * linv); pw.w = pk2(st[kt][8 * sp + 6] * linv, st[kt][8 * sp + 7] * linv);
                    const bf16x8 pa = __builtin_bit_cast(bf16x8, pw);
                    const int kb = 32 * (qs + kt) + 16 * sp + 4 * h;
#pragma unroll
                    for (int dt = 0; dt < 2; ++dt) { const LAS bf16* vp = Vt + (32 * dt + r) * VLD + kb;
                        const u32x2 lo = *(const LAS u32x2*)vp, hi = *(const LAS u32x2*)(vp + 8);
                        u32x4 vw; vw.x = lo.x; vw.y = lo.y; vw.z = hi.x; vw.w = hi.y;
                        o[dt] = __builtin_amdgcn_mfma_f32_32x32x16_bf16(pa, __builtin_bit_cast(bf16x8, vw), o[dt], 0, 0, 0); } }
#pragma unroll
            for (int dt = 0; dt < 2; ++dt)
#pragma unroll
                for (int i = 0; i < 16; ++i) { const int qr = (i & 3) + 8 * (i >> 2) + 4 * h;
                    CAT[(size_t)(b * T + blk * 128 + qs * 32 + qr) * D + 512 + head * 64 + 32 * dt + r] = (bf16)f2bf(o[dt][i]); }
        }
    }
}

__device__ __forceinline__ void phase6(const Frame& F) {
    const int gw = F.vcu * 8 + F.wave, NGW = F.G * 8;
    const float* Y = wsp<float>(F, WS_Y); const float* SV = wsp<float>(F, WS_SV); const bf16* G = wsp<bf16>(F, WS_G); const float* BON = wsp<float>(F, WS_BONUS);
    bf16* CAT = wsp<bf16>(F, WS_CAT);
    const float* lg = F.in[15]; const float* lb = F.in[16];
    const int hh = F.lane >> 3, n0 = (F.lane & 7) * 8, c0 = F.lane * 8;
    for (int row = gw; row < M; row += NGW) { const int b = row / T, t = row % T;
        const f32x4 y0 = *(const f32x4*)(Y + (size_t)row * 512 + c0), y1 = *(const f32x4*)(Y + (size_t)row * 512 + c0 + 4);
        float yv[8] = {y0[0], y0[1], y0[2], y0[3], y1[0], y1[1], y1[2], y1[3]};
        float s = 0.f;
#pragma unroll
        for (int j = 0; j < 8; ++j) s += yv[j];
        s += __shfl_xor(s, 1); s += __shfl_xor(s, 2); s += __shfl_xor(s, 4);
        const float mean = s * (1.f / 64.f); float q = 0.f;
#pragma unroll
        for (int j = 0; j < 8; ++j) { yv[j] -= mean; q += yv[j] * yv[j]; }
        q += __shfl_xor(q, 1); q += __shfl_xor(q, 2); q += __shfl_xor(q, 4);
        const float rstd = rsqrtf(q * (1.f / 64.f) + GN_EPS);
        const float bon = BON[row * 8 + hh];
        const float* vp = SV + ((size_t)(b * RH + hh) * T + t) * 64 + n0;
        const f32x4 v0 = *(const f32x4*)vp, v1 = *(const f32x4*)(vp + 4);
        const float vv[8] = {v0[0], v0[1], v0[2], v0[3], v1[0], v1[1], v1[2], v1[3]};
        const u32x4 graw = *(const u32x4*)(G + (size_t)row * 512 + c0);
        const float gg[8] = {bflo(graw.x), bfhi(graw.x), bflo(graw.y), bfhi(graw.y), bflo(graw.z), bfhi(graw.z), bflo(graw.w), bfhi(graw.w)};
        float ov[8];
#pragma unroll
        for (int j = 0; j < 8; ++j) ov[j] = (yv[j] * rstd * lg[c0 + j] + lb[c0 + j] + bon * vv[j]) * gg[j];
        u32x4 w; w.x = pk2(ov[0], ov[1]); w.y = pk2(ov[2], ov[3]); w.z = pk2(ov[4], ov[5]); w.w = pk2(ov[6], ov[7]);
        *(u32x4*)(CAT + (size_t)row * D + c0) = w; }
}

__device__ __forceinline__ float reduce32x64(float (&v)[32], int lane) {
#pragma unroll
    for (int i = 0; i < 16; ++i) { const bool hi = lane & 16; const float send = hi ? v[i] : v[i + 16], keep = hi ? v[i + 16] : v[i]; v[i] = keep + __shfl_xor(send, 16); }
#pragma unroll
    for (int i = 0; i < 8; ++i) { const bool hi = lane & 8; const float send = hi ? v[i] : v[i + 8], keep = hi ? v[i + 8] : v[i]; v[i] = keep + __shfl_xor(send, 8); }
#pragma unroll
    for (int i = 0; i < 4; ++i) { const bool hi = lane & 4; const float send = hi ? v[i] : v[i + 4], keep = hi ? v[i + 4] : v[i]; v[i] = keep + __shfl_xor(send, 4); }
#pragma unroll
    for (int i = 0; i < 2; ++i) { const bool hi = lane & 2; const float send = hi ? v[i] : v[i + 2], keep = hi ? v[i + 2] : v[i]; v[i] = keep + __shfl_xor(send, 2); }
    { const bool hi = lane & 1; const float send = hi ? v[0] : v[1], keep = hi ? v[1] : v[0]; v[0] = keep + __shfl_xor(send, 1); }
    return v[0] + __shfl_xor(v[0], 32);
}
__device__ __forceinline__ void phase8(const Frame& F) {
    const float* mod = wsp<float>(F, WS_MOD); const bf16* x1 = wsp<bf16>(F, WS_X1B);
    const float* wr_ = F.in[22]; const float* br = F.in[23];
    LAS float* Wt = (LAS float*)F.lds;
    LAS float* lgw = (LAS float*)(F.lds + 131072 + F.wave * 512);
    LAS int* cnt = (LAS int*)(F.lds + 131072 + 4096);
    __syncthreads();
    for (int idx = F.tid; idx < 8192; idx += 512) { const int k = idx >> 3, e4 = idx & 7; const f32x4 w = *(const f32x4*)(wr_ + k * 32 + e4 * 4);
        Wt[(4 * e4 + 0) * 1024 + k] = w[0]; Wt[(4 * e4 + 1) * 1024 + k] = w[1]; Wt[(4 * e4 + 2) * 1024 + k] = w[2]; Wt[(4 * e4 + 3) * 1024 + k] = w[3]; }
    if (F.tid < 32) cnt[F.tid] = 0;
    __syncthreads();
    int* RT_E = wsp<int>(F, WS_RT_E); int* RT_LP = wsp<int>(F, WS_RT_LP); float* RT_G = wsp<float>(F, WS_RT_G);
    const int e = F.lane & 31;
    const float bre = br[e];
    for (int pr = 0; pr < 8; ++pr) { const int row0 = F.vcu * 128 + F.wave * 16 + 2 * pr, b = row0 / T;
        f32x4 h0[4], h1[4];
        norm_row<MK_FP8, true>(F, (const float*)(x1 + (size_t)row0 * D), F.in[21], mod + b * 6144 + 3072, mod + b * 6144 + 4096, (bf16*)(wsp<unsigned char>(F, WS_H8) + (size_t)row0 * D * (MK_FP8 ? 1 : 2)), h0);
        norm_row<MK_FP8, true>(F, (const float*)(x1 + (size_t)(row0 + 1) * D), F.in[21], mod + b * 6144 + 3072, mod + b * 6144 + 4096, (bf16*)(wsp<unsigned char>(F, WS_H8) + (size_t)(row0 + 1) * D * (MK_FP8 ? 1 : 2)), h1);
        float pa0[32], pa1[32];
#pragma unroll
        for (int q = 0; q < 32; ++q) { float s0 = 0.f, s1 = 0.f;
#pragma unroll
            for (int j = 0; j < 4; ++j) { const f32x4 w4 = *(const LAS f32x4*)(Wt + q * 1024 + 4 * F.lane + 256 * j);
                s0 += (h0[j][0] * w4[0] + h0[j][1] * w4[1]) + (h0[j][2] * w4[2] + h0[j][3] * w4[3]);
                s1 += (h1[j][0] * w4[0] + h1[j][1] * w4[1]) + (h1[j][2] * w4[2] + h1[j][3] * w4[3]); }
            pa0[q] = s0; pa1[q] = s1; }
        const float lg0 = reduce32x64(pa0, F.lane) + bre, lg1 = reduce32x64(pa1, F.lane) + bre;
#pragma unroll
        for (int q = 0; q < 2; ++q) { const float logit = q ? lg1 : lg0; const int row = row0 + q; LAS float* lg32 = lgw + q * 64;
            if (F.lane < 32) lg32[e] = logit;
            asm volatile("s_waitcnt lgkmcnt(0)" ::: "memory");
            int rank = 0;
#pragma unroll 8
            for (int o = 0; o < 32; ++o) { const float ov = lg32[o]; rank += (ov > logit || (ov == logit && o < e)) ? 1 : 0; }
            if (F.lane < 32 && rank < 4) lg32[32 + rank] = logit;
            asm volatile("s_waitcnt lgkmcnt(0)" ::: "memory");
            const float t0 = lg32[32], t1 = lg32[33], t2 = lg32[34], t3 = lg32[35];
            const float den = 1.f + __expf(t1 - t0) + __expf(t2 - t0) + __expf(t3 - t0);
            if (F.lane < 32 && rank < 4) { const int lp = atomicAdd((int*)&cnt[e], 1);
                RT_E[row * 4 + rank] = e; RT_LP[row * 4 + rank] = lp; RT_G[row * 4 + rank] = __expf(logit - t0) / den; }
            asm volatile("s_waitcnt lgkmcnt(0)" ::: "memory"); }
    }
    __syncthreads();
    if (F.tid < 32) wsp<int>(F, WS_BLKCNT)[F.vcu * 32 + F.tid] = cnt[F.tid];
}

__device__ __forceinline__ void phase9(const Frame& F) {
    LAS int* base = (LAS int*)F.lds;
    LAS int* tot = base + 32;
    LAS int* pst = base + 64;
    const int* BC = wsp<int>(F, WS_BLKCNT);
    if (F.tid < 32) { int s = 0, mine = 0; for (int bk = 0; bk < F.G; ++bk) { if (bk == F.vcu) mine = s; s += BC[bk * 32 + F.tid]; } base[F.tid] = mine; tot[F.tid] = s; }
    __syncthreads();
    if (F.tid == 0) { int s = 0; for (int e = 0; e < 32; ++e) { pst[e] = s; s += (tot[e] + 255) / 256 * 256; } pst[32] = s; }
    __syncthreads();
    int* SLOT_TOK = wsp<int>(F, WS_SLOTTOK); float* SLOT_GATE = wsp<float>(F, WS_SLOTGATE); int* TOK_SLOT = wsp<int>(F, WS_TOKSLOT);
    const int* RT_E = wsp<int>(F, WS_RT_E); const int* RT_LP = wsp<int>(F, WS_RT_LP); const float* RT_G = wsp<float>(F, WS_RT_G);
    { const int idx = F.vcu * 512 + F.tid;
        const int e = RT_E[idx], slot = pst[e] + base[e] + RT_LP[idx];
        SLOT_TOK[slot] = idx >> 2; SLOT_GATE[slot] = RT_G[idx]; TOK_SLOT[idx] = slot; }
    if (F.vcu < 32) { const int e = F.vcu; for (int s = pst[e] + tot[e] + F.tid; s < pst[e + 1]; s += 512) { SLOT_TOK[s] = 0; SLOT_GATE[s] = 0.f; } }
    if (F.vcu == 0) { unsigned* ctl = wsp<unsigned>(F, WS_CTL);
        if (F.tid == 0) ctl[CW_NTILES] = (unsigned)(pst[32] / 256);
        if (F.tid < 33) ctl[CW_PADSTART + F.tid] = (unsigned)pst[F.tid];
        int* TE = wsp<int>(F, WS_TILEE);
        for (int tl = F.tid; tl < MAX_TILES; tl += 512) { int e = 31; for (int q = 0; q < 32; ++q) if (tl * 256 < pst[q + 1]) { e = q; break; } TE[tl] = e; } }
#if MK_CONV_WHERE == 9
    for (int it = CONV_4B + F.vcu * 8 + F.wave; it < MOE_ITEMS; it += F.G * 8) moe_weight_item(F, it);
#endif
}

__device__ __forceinline__ void phase12(const Frame& F) {
    const int gw = F.vcu * 8 + F.wave, NGW = F.G * 8;
    const float* mod = wsp<float>(F, WS_MOD); const bf16* YS = wsp<bf16>(F, WS_YS); const int* TOK_SLOT = wsp<int>(F, WS_TOKSLOT);
    for (int row = gw; row < M; row += NGW) { const int b = row / T;
        int sl[4];
#pragma unroll
        for (int k = 0; k < 4; ++k) sl[k] = TOK_SLOT[row * 4 + k];
#pragma unroll
        for (int j = 0; j < 2; ++j) { const int col = 8 * F.lane + 512 * j;
            float a[8];
#pragma unroll
            for (int q = 0; q < 8; ++q) a[q] = 0.f;
#pragma unroll
            for (int k = 0; k < 4; ++k) { const u32x4 v = __builtin_nontemporal_load((const u32x4*)(YS + (size_t)sl[k] * D + col));
                a[0] += bflo(v.x); a[1] += bfhi(v.x); a[2] += bflo(v.y); a[3] += bfhi(v.y); a[4] += bflo(v.z); a[5] += bfhi(v.z); a[6] += bflo(v.w); a[7] += bfhi(v.w); }
            const float* gp = mod + b * 6144 + 5120 + col;
            const f32x4 g0 = *(const f32x4*)gp, g1 = *(const f32x4*)(gp + 4);
            float* op = F.out + (size_t)row * D + col;
            const u32x4 xb = __builtin_nontemporal_load((const u32x4*)(wsp<bf16>(F, WS_X1B) + (size_t)row * D + col));
            f32x4 x0 = (f32x4){bflo(xb.x), bfhi(xb.x), bflo(xb.y), bfhi(xb.y)}, x1v = (f32x4){bflo(xb.z), bfhi(xb.z), bflo(xb.w), bfhi(xb.w)};
            x0[0] += g0[0] * a[0]; x0[1] += g0[1] * a[1]; x0[2] += g0[2] * a[2]; x0[3] += g0[3] * a[3];
            x1v[0] += g1[0] * a[4]; x1v[1] += g1[1] * a[5]; x1v[2] += g1[2] * a[6]; x1v[3] += g1[3] * a[7];
            *(f32x4*)op = x0; *(f32x4*)(op + 4) = x1v; } }
}

__device__ __forceinline__ void copy_x_to_out(const Frame& F) {
    const size_t n4 = (size_t)M * D / 4; const f32x4* s = (const f32x4*)F.in[0]; f32x4* d = (f32x4*)F.out;
    for (size_t i = (size_t)blockIdx.x * 512 + F.tid; i < n4; i += (size_t)gridDim.x * 512) d[i] = s[i];
}


#define XB_TMO      128
#define XB_XCNT(j)  (256  + 64 * (j))
#define XB_XSUB(j)  (1280 + 64 * (j))
#define XB_XGEN(j)  (2304 + 64 * (j))
#define XB_TOP      3328
#define XB_TOPGEN   3392
#define XCD_BAR_WORDS 3456
#define XB_SPIN_CAP (1u << 18)
__device__ __forceinline__ unsigned xb_ld(unsigned* p)              { return __hip_atomic_load(p, __ATOMIC_RELAXED, __HIP_MEMORY_SCOPE_AGENT); }
__device__ __forceinline__ unsigned xb_add(unsigned* p, unsigned v) { return __hip_atomic_fetch_add(p, v, __ATOMIC_RELAXED, __HIP_MEMORY_SCOPE_AGENT); }
__device__ __forceinline__ unsigned xb_xcc_id() { return (unsigned)__builtin_amdgcn_s_getreg((3 << 11) | 20) & 0xFu; }
#define XB_SPIN(cond, bar) do { unsigned _sp = 0; while (cond) { __builtin_amdgcn_s_sleep(1); \
    if ((++_sp & 255u) == 0u) { if (xb_ld(&(bar)[XB_TMO])) break; if (_sp > XB_SPIN_CAP) { atomicAdd(&(bar)[XB_TMO], 1u); break; } } } } while (0)
struct XcdBarrier { unsigned* bar; unsigned x; volatile LAS unsigned* st; };
__device__ __forceinline__ XcdBarrier xcd_barrier_post(unsigned* bar, volatile LAS unsigned* st) {
    XcdBarrier b; b.bar = bar; b.x = xb_xcc_id(); b.st = st;
    if (threadIdx.x == 0) (void)xb_add(&bar[XB_XCNT(b.x)], 1u);
    return b;
}
__device__ __forceinline__ void xcd_barrier_complete(unsigned* bar, unsigned x, unsigned& nloc, unsigned& nx) {
    const unsigned G = gridDim.x * gridDim.y * gridDim.z;
    unsigned sum, cnt, mine, sp = 0u;
    for (;;) {
        sum = 0u; cnt = 0u; mine = 0u;
#pragma unroll
        for (unsigned j = 0; j < 16; ++j) { const unsigned c = xb_ld(&bar[XB_XCNT(j)]); sum += c; cnt += (c > 0u) ? 1u : 0u; mine = (j == x) ? c : mine; }
        if (sum == G) break;
        __builtin_amdgcn_s_sleep(1);
        if ((++sp & 255u) == 0u) { if (xb_ld(&bar[XB_TMO])) break; if (sp > XB_SPIN_CAP) { atomicAdd(&bar[XB_TMO], 1u); break; } }
    }
    nloc = mine > 0u ? mine : 1u; nx = cnt > 0u ? cnt : 1u;
}
__device__ __forceinline__ void xcd_barrier(const XcdBarrier& b) {
    asm volatile("s_waitcnt vmcnt(0)" ::: "memory");
    __syncthreads();
    if (threadIdx.x == 0) {
        unsigned* bar = b.bar;
        __builtin_amdgcn_s_waitcnt(0);
        unsigned nloc = b.st[0], nx = b.st[1];
        if (nloc == 0u) { xcd_barrier_complete(bar, b.x, nloc, nx); b.st[0] = nloc; b.st[1] = nx; }
        const unsigned old = xb_add(&bar[XB_XSUB(b.x)], 1u);
        const unsigned gen = old / nloc;
        if (old + 1u == (gen + 1u) * nloc) {
            __builtin_amdgcn_fence(__ATOMIC_RELEASE, "agent");
            asm volatile("s_waitcnt vmcnt(0)" ::: "memory");
            const unsigned og = xb_add(&bar[XB_TOP], 1u);
            const unsigned tg = og / nx;
            if (og + 1u == (tg + 1u) * nx) xb_add(&bar[XB_TOPGEN], 1u);
            else XB_SPIN(xb_ld(&bar[XB_TOPGEN]) == tg, bar);
            __builtin_amdgcn_fence(__ATOMIC_ACQUIRE, "agent");
            xb_add(&bar[XB_XGEN(b.x)], 1u);
            asm volatile("s_waitcnt vmcnt(0)" ::: "memory");
        } else {
            XB_SPIN(xb_ld(&bar[XB_XGEN(b.x)]) == gen, bar);
            __builtin_amdgcn_fence(__ATOMIC_ACQUIRE, "agent");
            asm volatile("s_waitcnt vmcnt(0)" ::: "memory");
        }
    }
    __syncthreads();
}

struct Args { const float* in[28]; float* out; unsigned char* ws; int ph_lo, ph_hi; };
constexpr int N_PHASES = 13;

__global__ void __launch_bounds__(512, 2) mk_fwd(Args args) {
    extern __shared__ __attribute__((aligned(16))) unsigned char lds_raw[];
    Frame F;
    F.lds = (LAS unsigned char*)lds_raw;
    F.tid = threadIdx.x; F.lane = F.tid & 63; F.wave = __builtin_amdgcn_readfirstlane(F.tid >> 6);
    F.G = gridDim.x; { const int bx = blockIdx.x; F.vcu = (F.G % 8 == 0) ? (bx % 8) * (F.G / 8) + bx / 8 : bx; }
    F.in = args.in;
    F.out = args.out; F.ws = args.ws;
    cg::grid_group grid = cg::this_grid();
    const int lo = args.ph_lo, hi = args.ph_hi;
    volatile LAS unsigned* MISC = (volatile LAS unsigned*)(F.lds + MISC_OFF);
    if (F.tid < 16) MISC[F.tid] = 0u;
    __syncthreads();
    XcdBarrier bar; bar.bar = wsp<unsigned>(F, WS_CTL) + CW_BAR; bar.x = 0; bar.st = MISC;
    if (hi - lo > 1) bar = xcd_barrier_post(wsp<unsigned>(F, WS_CTL) + CW_BAR, MISC);
#define IN(k) (lo <= (k) && (k) < hi)
#define REP(k) for (int rep_ = 0; rep_ < 1 + ((MK_REPEAT_MASK >> (k)) & 1); ++rep_)
#define SEAM(k) do { if (IN(k) && IN((k) + 1)) { if ((MK_CG_SEAMS >> (k)) & 1) grid.sync(); else xcd_barrier(bar); } } while (0)

    if (IN(0)) REP(0) { phase0(F); } SEAM(0);
    if (IN(1)) REP(1) { phase1(F); } SEAM(1);
    if (IN(2)) REP(2) {
#if MK_CONV_WHERE == 2
        if ((int)blockIdx.x >= 192) { for (int it = ((int)blockIdx.x - 192) * 8 + F.wave; it < MOE_ITEMS; it += 64 * 8) moe_weight_item(F, it); }
        else {
        pg8::Gemm g{wsp<bf16>(F, WS_H), wsp<bf16>(F, WS_WIN), D, IN_COLS, nullptr};
        pg8::StaticOrder S; S.init(M, IN_COLS, 192, (int)blockIdx.x);
        pg8::EpiBf16P E{wsp<bf16>(F, WS_P), IN_COLS};
        pg8::gemm_phase<pg8::EpiBf16P, pg8::StaticOrder, false>(F.lds, g, S, E);
        }
#else
        pg8::Gemm g{wsp<bf16>(F, WS_H), wsp<bf16>(F, WS_WIN), D, IN_COLS, nullptr};
        pg8::StaticOrder S; S.init(M, IN_COLS, F.G, (int)blockIdx.x);
        pg8::EpiBf16P E{wsp<bf16>(F, WS_P), IN_COLS};
        pg8::gemm_phase<pg8::EpiBf16P, pg8::StaticOrder, false>(F.lds, g, S, E);
#endif
    } SEAM(2);
#if MK_RWKV_MODE < 3
    if (IN(3)) REP(3) { phase3(F); } SEAM(3);
#endif
    if (IN(4)) REP(4) {
#if MK_RWKV_MODE >= 1
#if MK_RWKV_MODE == 4
#if MK_WMASK != 63
        phase4a_fused(F); xcd_barrier(bar);
#endif
        for (int q_ = 0; q_ < 1 + (MK_REP4 & 1); ++q_) { phase4a_wave(F); xcd_barrier(bar); }
#elif MK_RWKV_MODE == 3
        for (int q_ = 0; q_ < 1 + (MK_REP4 & 1); ++q_) { phase4a_fused(F); xcd_barrier(bar); }
#else
        for (int q_ = 0; q_ < 1 + (MK_REP4 & 1); ++q_) { phase4a_summaries(F); xcd_barrier(bar); }
#endif
        for (int q_ = 0; q_ < 1 + ((MK_REP4 >> 1) & 1); ++q_) { phase4b_states(F); xcd_barrier(bar); }
#endif
#if MK_RWKV_MODE >= 2
        for (int q_ = 0; q_ < 1 + ((MK_REP4 >> 2) & 1); ++q_) phase4c_output(F);
#else
        phase4_scan(F);
#endif
        } SEAM(4);
    if (IN(5)) REP(5) { phase5_attn(F); } SEAM(5);
#if MK_RWKV_MODE < 2
    if (IN(6)) REP(6) { phase6(F); } SEAM(6);
#endif
    if (IN(7)) REP(7) {
#if MK_LAST_PHASE >= 7
        pg8::Gemm g{wsp<bf16>(F, WS_CAT), wsp<bf16>(F, WS_WOUT), D, D, nullptr};
        pg8::StaticOrder S; S.init(M, D, F.G, (int)blockIdx.x);
        pg8::EpiOutProj E{F.in[0], wsp<bf16>(F, WS_X1B), wsp<float>(F, WS_MOD) + 2048};
        pg8::gemm_phase<pg8::EpiOutProj, pg8::StaticOrder, false>(F.lds, g, S, E);
#else
        copy_x_to_out(F);
#endif
    } SEAM(7);
    if (IN(8)) REP(8) { phase8(F); } SEAM(8);
    if (IN(9)) REP(9) { phase9(F); } SEAM(9);
    if (IN(10)) REP(10) {
        const unsigned* ctl = wsp<unsigned>(F, WS_CTL);
        pg8::Gemm g{wsp<bf16>(F, WS_H8), wsp<bf16>(F, WS_W1), MK_FP8 ? D / 2 : D, 2 * DE, wsp<int>(F, WS_SLOTTOK)};
        pg8::MoeOrder S{(int)ctl[CW_NTILES], 8, F.G, F.vcu, wsp<int>(F, WS_TILEE)};
        pg8::EpiMoe1 E{wsp<unsigned char>(F, WS_ACT), F.in[25]};
        pg8::gemm_phase<pg8::EpiMoe1, pg8::MoeOrder, true, MK_FP8 != 0>(F.lds, g, S, E);
    } SEAM(10);
    if (IN(11)) REP(11) {
        const unsigned* ctl = wsp<unsigned>(F, WS_CTL);
        pg8::Gemm g{wsp<bf16>(F, WS_ACT), wsp<bf16>(F, WS_W2), MK_FP8 ? DE / 2 : DE, D, nullptr};
        pg8::MoeOrder S{(int)ctl[CW_NTILES], 4, F.G, F.vcu, wsp<int>(F, WS_TILEE)};
        pg8::EpiMoe2 E{wsp<bf16>(F, WS_YS), F.in[27], wsp<float>(F, WS_SLOTGATE)};
        pg8::gemm_phase<pg8::EpiMoe2, pg8::MoeOrder, false, MK_FP8 != 0>(F.lds, g, S, E);
    } SEAM(11);
    if (IN(12)) { phase12(F); }
#undef IN
#undef SEAM
}

extern "C" void kernel_launch(void* const* d_in, const int* in_sizes, int n_in, void* d_out, int out_size, void* d_ws, size_t ws_size, hipStream_t stream) {
    static int grid = 0;
    if (grid == 0) {
        if (n_in != 28 || out_size != M * D || ws_size < WS_END) { fprintf(stderr, "kernel_launch: unexpected sizes (n_in %d out %d ws %zu, need %zu)\n", n_in, out_size, ws_size, (size_t)WS_END); grid = -1; return; }
        int dev = 0, cus = 0, per_cu = 0;
        (void)hipGetDevice(&dev); (void)hipDeviceGetAttribute(&cus, hipDeviceAttributeMultiprocessorCount, dev);
        (void)hipFuncSetAttribute((const void*)mk_fwd, hipFuncAttributeMaxDynamicSharedMemorySize, LDS_BYTES);
        (void)hipOccupancyMaxActiveBlocksPerMultiprocessor(&per_cu, (const void*)mk_fwd, 512, LDS_BYTES);
        if (per_cu < 1 || cus != 256) { fprintf(stderr, "kernel_launch: occupancy %d, CUs %d: this build needs 256 CUs x 1 block\n", per_cu, cus); grid = -1; return; }
        grid = cus;
    }
    if (grid < 0) return;
    (void)hipMemsetAsync((char*)d_ws + WS_CTL, 0, CTL_BYTES, stream);
    Args a{};
    for (int i = 0; i < 28; ++i) a.in[i] = (const float*)d_in[i];
    a.out = (float*)d_out; a.ws = (unsigned char*)d_ws;
    const int last = MK_LAST_PHASE + 1;
#if MK_ONE_LAUNCH
    a.ph_lo = 0; a.ph_hi = last;
#if MK_COOP
    void* kargs[] = {&a};
    hipError_t e = hipLaunchCooperativeKernel((const void*)mk_fwd, dim3(grid), dim3(512), kargs, LDS_BYTES, stream);
    if (e != hipSuccess) fprintf(stderr, "cooperative launch failed: %s\n", hipGetErrorString(e));
#else
    hipLaunchKernelGGL(mk_fwd, dim3(grid), dim3(512), LDS_BYTES, stream, a);
#endif
#else
    for (int p = 0; p < last; ++p) { a.ph_lo = p; a.ph_hi = p + 1; hipLaunchKernelGGL(mk_fwd, dim3(grid), dim3(512), LDS_BYTES, stream, a); }
#endif
}
```

```cpp
#include <hip/hip_runtime.h>
#include <hip/hip_cooperative_groups.h>
#include <cstdio>
#include <cstdint>
namespace cg = cooperative_groups;

#ifndef MK_ONE_LAUNCH
#define MK_ONE_LAUNCH 1
#endif
#ifndef MK_REPEAT_MASK
#define MK_REPEAT_MASK 0
#endif
#ifndef MK_CONV_WHERE
#define MK_CONV_WHERE 9
#endif
#define MK_CONV_IN_SCAN (MK_CONV_WHERE == 4)
#ifndef MK_RWKV_MODE
#define MK_RWKV_MODE 3
#endif
#ifndef MK_FP8
#define MK_FP8 1
#endif
#ifndef MK_DUP
#define MK_DUP 0
#endif
#ifndef MK_WMASK
#define MK_WMASK 63
#endif
#ifndef MK_REP4
#define MK_REP4 0
#endif
#ifndef MK_CG_SEAMS
#define MK_CG_SEAMS 0
#endif
#ifndef MK_COOP
#define MK_COOP 0
#endif
#ifndef MK_LAST_PHASE
#define MK_LAST_PHASE 12
#endif

constexpr int D = 1024, NBATCH = 8, T = 4096, M = NBATCH * T;
constexpr int HD = 64, RW = 512, RH = 8, AW = 512, QH = 8, KVH = 2, WIN = 128;
constexpr int RWKV_COLS = 1792, IN_COLS = 2560;
constexpr int COL_Q = 1792, COL_K = 1792 + 512, COL_V = 1792 + 512 + 128;
constexpr int NE = 32, TOPK = 4, DE = 1024;
constexpr int MAX_TILES = 544;
constexpr int MAX_SLOTS = MAX_TILES * 256;
constexpr float NORM_EPS = 1e-6f, GN_EPS = 64e-5f;

#define GAS __attribute__((address_space(1)))
#define LAS __attribute__((address_space(3)))
typedef unsigned short bf16;
typedef short bf16x8 __attribute__((ext_vector_type(8)));
typedef float f32x4 __attribute__((ext_vector_type(4)));
typedef float f32x2 __attribute__((ext_vector_type(2)));
typedef float f32x16 __attribute__((ext_vector_type(16)));
typedef unsigned u32x4 __attribute__((ext_vector_type(4)));
typedef unsigned u32x2 __attribute__((ext_vector_type(2)));
typedef int i32x8 __attribute__((ext_vector_type(8)));
typedef int i32x4 __attribute__((ext_vector_type(4)));

constexpr size_t MiB = 1u << 20;
constexpr size_t WS_CTL = 0, CTL_BYTES = 64 * 1024;
constexpr size_t WS_MOD = 1 * MiB;
constexpr size_t WS_BON = 1 * MiB + 256 * 1024;
constexpr size_t WS_RT_E = 2 * MiB;
constexpr size_t WS_RT_LP = 2 * MiB + 512 * 1024;
constexpr size_t WS_RT_G = 3 * MiB;
constexpr size_t WS_TOKSLOT = 3 * MiB + 512 * 1024;
constexpr size_t WS_SLOTTOK = 4 * MiB;
constexpr size_t WS_SLOTGATE = 5 * MiB;
constexpr size_t WS_BLKCNT = 6 * MiB;
constexpr size_t WS_TILEE = 6 * MiB + 64 * 1024;
constexpr size_t WS_BONUS = 7 * MiB;
constexpr size_t WS_LW = 9 * MiB;
constexpr size_t WS_WIN = 10 * MiB;
constexpr size_t WS_WOUT = 16 * MiB;
constexpr size_t WS_W1 = 20 * MiB;
constexpr size_t WS_W2 = 148 * MiB;
constexpr size_t WS_H = 212 * MiB;
constexpr size_t WS_R2 = 276 * MiB;
constexpr size_t WS_P = WS_R2;
constexpr size_t WS_SCN = WS_R2 + 160 * MiB;
constexpr size_t WS_SV = WS_SCN + 320 * MiB;
constexpr size_t WS_G = WS_SV + 64 * MiB;
constexpr size_t WS_Y = WS_G + 32 * MiB;
constexpr size_t WS_CAT = WS_Y + 64 * MiB;
constexpr size_t WS_ACT = WS_R2;
constexpr size_t WS_YS = WS_R2 + 272 * MiB;
constexpr size_t WS_END = 1012 * MiB;
constexpr size_t WS_X1B = WS_H;
constexpr size_t WS_H8 = WS_Y;
constexpr size_t WS_PT = 436 * MiB;
constexpr size_t WS_ZV = 500 * MiB;
constexpr size_t WS_Z0 = 628 * MiB;
constexpr size_t WS_RYT = 692 * MiB;
constexpr size_t WS_YVT = WS_Y;
static_assert(WS_END <= 1024 * MiB, "workspace map");
static_assert(WS_YS + 272 * MiB <= WS_CAT, "YS must not overlay CAT");
constexpr int CW_NTILES = 16;
constexpr int CW_PADSTART = 64;
constexpr int CW_BAR = 4096;
constexpr int MISC_OFF = 160 * 1024 - 64;

constexpr int LDS_BYTES = 160 * 1024;

__device__ __forceinline__ unsigned f2bf(float f) { unsigned u = __builtin_bit_cast(unsigned, f); return (u + 0x7fffu + ((u >> 16) & 1u)) >> 16; }
typedef __bf16 bf16x2_t __attribute__((ext_vector_type(2)));
__device__ __forceinline__ unsigned pk2(float lo, float hi) { const f32x2 v = {lo, hi}; return __builtin_bit_cast(unsigned, __builtin_convertvector(v, bf16x2_t)); }
__device__ __forceinline__ float bf2f(unsigned short b) { return __builtin_bit_cast(float, ((unsigned)b) << 16); }
__device__ __forceinline__ float bflo(unsigned u) { return __builtin_bit_cast(float, u << 16); }
__device__ __forceinline__ float bfhi(unsigned u) { return __builtin_bit_cast(float, u & 0xffff0000u); }
__device__ __forceinline__ float wave_sum(float v) {
#pragma unroll
    for (int o = 1; o < 64; o <<= 1) v += __shfl_xor(v, o);
    return v;
}
__device__ __forceinline__ void lds_barrier() { asm volatile("s_waitcnt lgkmcnt(0)" ::: "memory"); __builtin_amdgcn_s_barrier(); asm volatile("" ::: "memory"); }
__device__ __forceinline__ float sigmoidf_(float x) { return __builtin_amdgcn_rcpf(1.f + __expf(-x)); }

namespace pg8 {
#define PG8_LAS __attribute__((address_space(3)))
constexpr int BM = 256, BK = 64, HALF = 128, HTB = HALF * BK * 2, STAGE_BYTES = 8 * HTB, NXCD = 8, WGM = 8;
__host__ __device__ __forceinline__ int lds_byte(int r, int c) { const int st = (r >> 4) * 2 + (c >> 5), rr = r & 15, cc = c & 31, ob = rr * 64 + cc * 2; return st * 1024 + (ob ^ (((ob >> 9) & 1) << 5)); }
__host__ __device__ __forceinline__ void stage_rc(int b, int& R, int& C) { const int st = b / 1024, sb = b % 1024, swz = sb ^ (((sb >> 9) & 1) << 5); R = (st >> 1) * 16 + swz / 64; C = (st & 1) * 32 + (swz % 64) / 2; }

struct Unit { int pm, pn, e; };
struct Gemm { const bf16* A; const bf16* Bt; int K, N; const int* rowmap; };

struct StaticOrder {
    int nM, nN, nwg, G, c;
    __device__ void init(int M_, int N_, int G_, int c_) { nM = M_ / BM; nN = N_ / BM; nwg = nM * nN; G = G_; c = c_; }
    __device__ bool next(int i, Unit& u) const {
        const long L = (long)i * G + c; if (L >= nwg) return false;
        int wgid = (int)L; { const int q = nwg / NXCD, r = nwg % NXCD, xcd = wgid % NXCD, off = wgid / NXCD; wgid = (xcd < r ? xcd * (q + 1) : r * (q + 1) + (xcd - r) * q) + off; }
        const int nig = WGM * nN, gid = wgid / nig, fm = gid * WGM, gsz = (nM - fm) < WGM ? (nM - fm) : WGM;
        u.pm = fm + ((wgid % nig) % gsz); u.pn = (wgid % nig) / gsz; u.e = 0; return true;
    }
};
struct MoeOrder {
    int nMt, nN, G, c; const int* tile_e;
    __device__ bool next(int i, Unit& u) const {
        const long L = (long)i * G + c; if (L >= (long)nMt * nN) return false;
        u.pm = (int)(L / nN); u.pn = (int)(L % nN); u.e = tile_e[u.pm]; return true;
    }
};

__device__ __forceinline__ unsigned cvt_pk_bf16(float lo, float hi) { unsigned r; asm volatile("v_cvt_pk_bf16_f32 %0, %1, %2" : "=v"(r) : "v"(lo), "v"(hi)); return r; }

struct EpiBf16P {
    bf16* O; int ldc;
    __device__ __forceinline__ void operator()(const f32x4 (&acc)[2][2][4][2], const Unit& u, int wr, int wc, int fr, int fq) const {
        const int row0 = u.pm * BM + wr * 64 + fr, col0 = u.pn * BM + wc * 32 + 8 * fq;
#pragma unroll
        for (int ai = 0; ai < 2; ++ai)
#pragma unroll
            for (int m = 0; m < 4; ++m) { bf16* rowp = O + (size_t)(row0 + ai * HALF + m * 16) * ldc + col0;
#pragma unroll
                for (int bj = 0; bj < 2; ++bj) { const f32x4 v0 = acc[ai][bj][m][0], v1 = acc[ai][bj][m][1];
                    u32x4 w; w.x = cvt_pk_bf16(v0[0], v0[1]); w.y = cvt_pk_bf16(v0[2], v0[3]); w.z = cvt_pk_bf16(v1[0], v1[1]); w.w = cvt_pk_bf16(v1[2], v1[3]);
                    *(u32x4*)(rowp + bj * HALF) = w; } }
    }
};
struct EpiOutProj {
    const float* x; bf16* out; const float* gate;
    __device__ __forceinline__ void operator()(const f32x4 (&acc)[2][2][4][2], const Unit& u, int wr, int wc, int fr, int fq) const {
        const int row0 = u.pm * BM + wr * 64 + fr, col0 = u.pn * BM + wc * 32 + 8 * fq;
        const int b = (u.pm * BM) / T;
        f32x4 gv[2][2];
#pragma unroll
        for (int bj = 0; bj < 2; ++bj)
#pragma unroll
            for (int n = 0; n < 2; ++n) gv[bj][n] = *(const f32x4*)(gate + (size_t)b * 6144 + col0 + bj * HALF + 4 * n);
#pragma unroll
        for (int ai = 0; ai < 2; ++ai)
#pragma unroll
            for (int m = 0; m < 4; ++m) { const size_t ro = (size_t)(row0 + ai * HALF + m * 16) * D + col0;
#pragma unroll
                for (int bj = 0; bj < 2; ++bj) { const f32x4 x0 = __builtin_nontemporal_load((const f32x4*)(x + ro + bj * HALF)), x1 = __builtin_nontemporal_load((const f32x4*)(x + ro + bj * HALF + 4));
                    const f32x4 v0 = x0 + gv[bj][0] * acc[ai][bj][m][0], v1 = x1 + gv[bj][1] * acc[ai][bj][m][1];
                    u32x4 w; w.x = cvt_pk_bf16(v0[0], v0[1]); w.y = cvt_pk_bf16(v0[2], v0[3]); w.z = cvt_pk_bf16(v1[0], v1[1]); w.w = cvt_pk_bf16(v1[2], v1[3]);
                    *(u32x4*)(out + ro + bj * HALF) = w; } }
    }
};
__device__ __forceinline__ unsigned pk4_fp8(float a, float b, float c, float d) { int w = 0; w = __builtin_amdgcn_cvt_pk_fp8_f32(a, b, w, false); w = __builtin_amdgcn_cvt_pk_fp8_f32(c, d, w, true); return (unsigned)w; }
constexpr float W8_SCALE = 32.f, W8_INV = 1.f / 32.f;
struct EpiMoe1 {
    unsigned char* act; const float* b1;
    __device__ __forceinline__ void operator()(const f32x4 (&acc)[2][2][4][2], const Unit& u, int wr, int wc, int fr, int fq) const {
        const int row0 = u.pm * BM + wr * 64 + fr, j0 = u.pn * 128 + wc * 16 + 4 * fq;
        const float* bb = b1 + (size_t)u.e * 2048;
        f32x4 bg[2], bl[2];
#pragma unroll
        for (int bj = 0; bj < 2; ++bj) { bg[bj] = *(const f32x4*)(bb + j0 + bj * 64); bl[bj] = *(const f32x4*)(bb + 1024 + j0 + bj * 64); }
#pragma unroll
        for (int ai = 0; ai < 2; ++ai)
#pragma unroll
            for (int m = 0; m < 4; ++m) { unsigned char* rowp = act + ((size_t)(row0 + ai * HALF + m * 16) * DE + j0) * (MK_FP8 ? 1 : 2);
#pragma unroll
                for (int bj = 0; bj < 2; ++bj) { const f32x4 g4 = acc[ai][bj][m][0] * (MK_FP8 ? W8_INV : 1.f) + bg[bj], l4 = acc[ai][bj][m][1] * (MK_FP8 ? W8_INV : 1.f) + bl[bj]; float a[4];
#pragma unroll
                    for (int q = 0; q < 4; ++q) { const float gl = fminf(g4[q], 7.0f), li = fminf(fmaxf(l4[q], -7.0f), 7.0f);
                        a[q] = gl * __builtin_amdgcn_rcpf(1.f + __expf(-1.702f * gl)) * (li + 1.f); }
#if MK_FP8
                    *(unsigned*)(rowp + bj * 64) = pk4_fp8(a[0], a[1], a[2], a[3]);
#else
                    u32x2 w; w.x = cvt_pk_bf16(a[0], a[1]); w.y = cvt_pk_bf16(a[2], a[3]); *(u32x2*)(rowp + bj * 128) = w;
#endif
                } }
    }
};
struct EpiMoe2 {
    bf16* ys; const float* b2; const float* sgate;
    __device__ __forceinline__ void operator()(const f32x4 (&acc)[2][2][4][2], const Unit& u, int wr, int wc, int fr, int fq) const {
        const int row0 = u.pm * BM + wr * 64 + fr, col0 = u.pn * BM + wc * 32 + 8 * fq;
        const float* bb = b2 + (size_t)u.e * 1024;
        f32x4 bv[2][2];
#pragma unroll
        for (int bj = 0; bj < 2; ++bj)
#pragma unroll
            for (int n = 0; n < 2; ++n) bv[bj][n] = *(const f32x4*)(bb + col0 + bj * HALF + 4 * n);
#pragma unroll
        for (int ai = 0; ai < 2; ++ai)
#pragma unroll
            for (int m = 0; m < 4; ++m) { const int row = row0 + ai * HALF + m * 16; const float gt = sgate[row]; bf16* rowp = ys + (size_t)row * D + col0;
#pragma unroll
                for (int bj = 0; bj < 2; ++bj) { const f32x4 v0 = (acc[ai][bj][m][0] * (MK_FP8 ? W8_INV : 1.f) + bv[bj][0]) * gt, v1 = (acc[ai][bj][m][1] * (MK_FP8 ? W8_INV : 1.f) + bv[bj][1]) * gt;
                    u32x4 w; w.x = cvt_pk_bf16(v0[0], v0[1]); w.y = cvt_pk_bf16(v0[2], v0[3]); w.z = cvt_pk_bf16(v1[0], v1[1]); w.w = cvt_pk_bf16(v1[2], v1[3]);
                    *(u32x4*)(rowp + bj * HALF) = w; } }
    }
};

template <class Epi, class Sched, bool GATHER, bool FP8 = false>
__device__ __forceinline__ void gemm_phase(PG8_LAS unsigned char* lds, const Gemm g, const Sched& S, const Epi& E) {
    const int tid = threadIdx.x, wid = __builtin_amdgcn_readfirstlane(tid >> 6), lane = tid & 63, wr = wid >> 2, wc = wid & 3, fr = lane & 15, fq = lane >> 4;
    const int K = g.K, nt = K / BK;
    int Rr[2], Cc[2]; unsigned voffB[2];
#pragma unroll
    for (int i = 0; i < 2; ++i) { stage_rc(tid * 16 + i * 8192, Rr[i], Cc[i]); voffB[i] = (unsigned)(Rr[i] * K + Cc[i]) * 2u; }
    const size_t kstep = (size_t)(BK * 2);
    const size_t hstep = (size_t)HALF * K * 2;
    const size_t tstep = 2 * hstep;
    const unsigned ldsw = (unsigned)wid * 1024u;
    const int aoff = lds_byte(wr * 64 + fr, fq * 8), boff = lds_byte(wc * 32 + fr, fq * 8);
#define PG8_SA(b, h) (((b) * 2 + (h)) * HTB)
#define PG8_SB(b, h) ((4 + (b) * 2 + (h)) * HTB)
#define PG8_STAGE(bufoff, gbase, voff) do { _Pragma("unroll") for (int _i = 0; _i < 2; ++_i) \
        __builtin_amdgcn_global_load_lds((const unsigned*)((const char*)(gbase) + (voff)[_i]), (PG8_LAS unsigned*)(lds + (bufoff) + ldsw + _i * 8192), 16, 0, 0); } while (0)
#define PG8_LDA(dst, b, h) do { _Pragma("unroll") for (int m = 0; m < 4; ++m) { const PG8_LAS i32x4* _p = (const PG8_LAS i32x4*)(lds + PG8_SA(b, h) + aoff + m * 2048); \
        dst[m] = __builtin_shufflevector(_p[0], _p[64], 0, 1, 2, 3, 4, 5, 6, 7); } } while (0)
#define PG8_LDB(dst, b, h) do { _Pragma("unroll") for (int n = 0; n < 2; ++n) { const PG8_LAS i32x4* _p = (const PG8_LAS i32x4*)(lds + PG8_SB(b, h) + boff + n * 2048); \
        dst[n] = __builtin_shufflevector(_p[0], _p[64], 0, 1, 2, 3, 4, 5, 6, 7); } } while (0)
#define PG8_MMA(ai, bj, At, Bt) do { __builtin_amdgcn_s_setprio(1); _Pragma("unroll") for (int m = 0; m < 4; ++m) _Pragma("unroll") for (int n = 0; n < 2; ++n) { \
        if constexpr (FP8)   \
            asm volatile("v_mfma_scale_f32_16x16x128_f8f6f4 %0, %1, %2, %0, %3, %3 op_sel_hi:[0,0,0]" : "+v"(acc[ai][bj][m][n]) : "v"(Bt[n]), "v"(At[m]), "v"(0x7F7F7F7F)); \
        else { acc[ai][bj][m][n] = __builtin_amdgcn_mfma_f32_16x16x32_bf16(__builtin_bit_cast(bf16x8, __builtin_shufflevector(Bt[n], Bt[n], 0, 1, 2, 3)), __builtin_bit_cast(bf16x8, __builtin_shufflevector(At[m], At[m], 0, 1, 2, 3)), acc[ai][bj][m][n], 0, 0, 0); \
               acc[ai][bj][m][n] = __builtin_amdgcn_mfma_f32_16x16x32_bf16(__builtin_bit_cast(bf16x8, __builtin_shufflevector(Bt[n], Bt[n], 4, 5, 6, 7)), __builtin_bit_cast(bf16x8, __builtin_shufflevector(At[m], At[m], 4, 5, 6, 7)), acc[ai][bj][m][n], 0, 0, 0); } } \
        __builtin_amdgcn_s_setprio(0); \
        if constexpr (FP8) asm volatile("" : "+v"(acc[ai][bj][0][0]), "+v"(acc[ai][bj][0][1]), "+v"(acc[ai][bj][1][0]), "+v"(acc[ai][bj][1][1]), "+v"(acc[ai][bj][2][0]), "+v"(acc[ai][bj][2][1]), "+v"(acc[ai][bj][3][0]), "+v"(acc[ai][bj][3][1]));   \
        } while (0)
#define PG8_WAIT_V(n) asm volatile("s_waitcnt vmcnt(" #n ")" ::: "memory")
#define PG8_WAIT_L(n) asm volatile("s_waitcnt lgkmcnt(" #n ")" ::: "memory")
#define PG8_BAR __builtin_amdgcn_s_barrier()
#define PG8_SCHED __builtin_amdgcn_sched_barrier(0)
#define PG8_AOFFS(dst, u) do { _Pragma("unroll") for (int _h = 0; _h < 2; ++_h) _Pragma("unroll") for (int _i = 0; _i < 2; ++_i) { int _R, _C; stage_rc((int)threadIdx.x * 16 + _i * 8192, _R, _C); \
        if constexpr (GATHER) { const int _tok = g.rowmap[(u).pm * BM + _h * HALF + _R]; dst[_h][_i] = (unsigned)(_tok * K + _C) * 2u; } \
        else dst[_h][_i] = (unsigned)((_h * HALF + _R) * K + _C) * 2u; } } while (0)
#define PG8_ABASE(u) (GATHER ? (const char*)g.A : (const char*)g.A + (size_t)(u).pm * tstep)
#define PG8_BBASE(u) ((const char*)g.Bt + ((size_t)(u).e * g.N + (size_t)(u).pn * BM) * K * 2)
    Unit cur, nxt, nn; int ui = 0;
    if (!S.next(0, cur)) return;
    bool has_next = S.next(1, nxt);
    unsigned curA[2][2], nxtA[2][2];
    PG8_AOFFS(curA, cur);
    if (has_next) PG8_AOFFS(nxtA, nxt); else {
#pragma unroll
        for (int h = 0; h < 2; ++h)
#pragma unroll
            for (int i = 0; i < 2; ++i) nxtA[h][i] = curA[h][i]; }
    f32x4 acc[2][2][4][2];
#pragma unroll
    for (int a = 0; a < 2; ++a)
#pragma unroll
        for (int b = 0; b < 2; ++b)
#pragma unroll
            for (int m = 0; m < 4; ++m)
#pragma unroll
                for (int n = 0; n < 2; ++n) acc[a][b][m][n] = (f32x4){0.f, 0.f, 0.f, 0.f};
    i32x8 At[4], B0[2], B1[2];
    const char* cA = PG8_ABASE(cur); const char* cB = PG8_BBASE(cur);
    PG8_STAGE(PG8_SB(0, 0), cB, voffB); PG8_STAGE(PG8_SB(0, 1), cB + hstep, voffB); PG8_STAGE(PG8_SA(0, 0), cA, curA[0]); PG8_STAGE(PG8_SA(0, 1), cA, curA[1]);
    if (wr == 1) PG8_BAR;
    PG8_WAIT_V(2); PG8_BAR;
    PG8_STAGE(PG8_SB(1, 0), cB + kstep, voffB); PG8_STAGE(PG8_SA(1, 0), cA + kstep, curA[0]); PG8_STAGE(PG8_SB(1, 1), cB + hstep + kstep, voffB);
    PG8_WAIT_V(6); PG8_BAR;
    for (;;) {
        const char* nA = has_next ? PG8_ABASE(nxt) : cA; const char* nB = has_next ? PG8_BBASE(nxt) : cB;
#pragma unroll 1
        for (int t = 0; t < nt; t += 2) {
            const bool last = (t == nt - 2);
            const char* a1 = cA + (size_t)(t + 1) * kstep;
            const char* a2 = last ? nA : cA + (size_t)(t + 2) * kstep; const char* b2 = last ? nB : cB + (size_t)(t + 2) * kstep;
            const char* a3 = a2 + kstep; const char* b3 = b2 + kstep;
            unsigned o2[2][2];
#pragma unroll
            for (int h = 0; h < 2; ++h)
#pragma unroll
                for (int i = 0; i < 2; ++i) o2[h][i] = last ? nxtA[h][i] : curA[h][i];
            PG8_LDB(B0, 0, 0); PG8_LDB(B1, 0, 1); PG8_SCHED; PG8_LDA(At, 0, 0); PG8_STAGE(PG8_SA(1, 1), a1, curA[1]);
            PG8_WAIT_V(8); PG8_WAIT_L(0); PG8_BAR; PG8_MMA(0, 0, At, B0); PG8_MMA(0, 1, At, B1); PG8_BAR; PG8_SCHED;
            PG8_LDA(At, 0, 1); PG8_STAGE(PG8_SB(0, 0), b2, voffB); PG8_STAGE(PG8_SB(0, 1), b2 + hstep, voffB); PG8_STAGE(PG8_SA(0, 0), a2, o2[0]);
            PG8_WAIT_V(8); PG8_WAIT_L(0); PG8_BAR; PG8_MMA(1, 0, At, B0); PG8_MMA(1, 1, At, B1); PG8_BAR; PG8_SCHED;
            PG8_LDB(B0, 1, 0); PG8_LDB(B1, 1, 1); PG8_SCHED; PG8_LDA(At, 1, 0); PG8_STAGE(PG8_SA(0, 1), a2, o2[1]);
            PG8_WAIT_V(8); PG8_WAIT_L(0); PG8_BAR; PG8_MMA(0, 0, At, B0); PG8_MMA(0, 1, At, B1); PG8_BAR; PG8_SCHED;
            PG8_LDA(At, 1, 1); PG8_STAGE(PG8_SB(1, 0), b3, voffB); PG8_STAGE(PG8_SB(1, 1), b3 + hstep, voffB); PG8_STAGE(PG8_SA(1, 0), a3, o2[0]);
            PG8_WAIT_V(8); PG8_WAIT_L(0); PG8_BAR; PG8_MMA(1, 0, At, B0); PG8_MMA(1, 1, At, B1); PG8_BAR; PG8_SCHED;
        }
        if constexpr (FP8) asm volatile("s_nop 15\n\ts_nop 15" ::: "memory");
        if (wr == 0) PG8_BAR;
        const bool has_nn = has_next && S.next(ui + 2, nn);
        unsigned nnA[2][2];
        if (has_nn) PG8_AOFFS(nnA, nn);
        E(acc, cur, wr, wc, fr, fq);
        if (!has_next) break;
#pragma unroll
        for (int a = 0; a < 2; ++a)
#pragma unroll
            for (int b = 0; b < 2; ++b)
#pragma unroll
                for (int m = 0; m < 4; ++m)
#pragma unroll
                    for (int n = 0; n < 2; ++n) acc[a][b][m][n] = (f32x4){0.f, 0.f, 0.f, 0.f};
        cur = nxt; cA = nA; cB = nB; ++ui;
#pragma unroll
        for (int h = 0; h < 2; ++h)
#pragma unroll
            for (int i = 0; i < 2; ++i) { curA[h][i] = nxtA[h][i]; if (has_nn) nxtA[h][i] = nnA[h][i]; }
        nxt = nn; has_next = has_nn;
        if (wr == 1) PG8_BAR;
    }
    PG8_WAIT_V(0);
    PG8_BAR;
#undef PG8_SA
#undef PG8_SB
#undef PG8_STAGE
#undef PG8_LDA
#undef PG8_LDB
#undef PG8_MMA
#undef PG8_WAIT_V
#undef PG8_WAIT_L
#undef PG8_BAR
#undef PG8_SCHED
#undef PG8_AOFFS
#undef PG8_ABASE
#undef PG8_BBASE
}
}

struct Frame {
    LAS unsigned char* lds;
    int tid, lane, wave, vcu, G;
    const float* const* in;
    float* out;
    unsigned char* ws;
};
template <class Tp> __device__ __forceinline__ Tp* wsp(const Frame& F, size_t off) { return (Tp*)(F.ws + off); }

__device__ __forceinline__ int dest_row(int mode, int s) {
    if (mode == 0) return s;
    if (mode == 1) return (s & ~31) | (((s >> 2) & 1) << 4) | (((s >> 3) & 3) << 2) | (s & 3);
    const int half = s >> 10, j = s & 1023;
    return ((j >> 7) << 8) | (((j >> 6) & 1) << 7) | (((j >> 4) & 3) << 5) | (half << 4) | (j & 15);
}
__device__ __forceinline__ void transpose_item(const float* W, int K, int N, bf16* WT, int mode, int item, int lane) {
    const int nblk = N / 64, kb = item / nblk, nb = item % nblk, k0 = 64 * kb, n0 = 64 * nb;
    const float* src = W + (size_t)k0 * N + n0 + lane;
    float v[64];
#pragma unroll
    for (int i = 0; i < 64; ++i) v[i] = src[(size_t)i * N];
    bf16* dst = WT + (size_t)dest_row(mode, n0 + lane) * K + k0;
#pragma unroll
    for (int j = 0; j < 8; ++j) { u32x4 o; o.x = pk2(v[8 * j], v[8 * j + 1]); o.y = pk2(v[8 * j + 2], v[8 * j + 3]); o.z = pk2(v[8 * j + 4], v[8 * j + 5]); o.w = pk2(v[8 * j + 6], v[8 * j + 7]);
        *(u32x4*)(dst + 8 * j) = o; }
}
__device__ __forceinline__ void transpose_item8(const float* W, int K, int N, unsigned char* WT, int mode, int item, int lane) {
    const int nblk = N / 64, kb = item / nblk, nb = item % nblk, k0 = 64 * kb, n0 = 64 * nb;
    const float* src = W + (size_t)k0 * N + n0 + lane;
    float v[64];
#pragma unroll
    for (int i = 0; i < 64; ++i) v[i] = __builtin_nontemporal_load(src + (size_t)i * N) * 32.f;
    unsigned char* dst = WT + (size_t)dest_row(mode, n0 + lane) * K + k0;
#pragma unroll
    for (int j = 0; j < 4; ++j) { u32x4 o; o.x = pg8::pk4_fp8(v[16 * j], v[16 * j + 1], v[16 * j + 2], v[16 * j + 3]); o.y = pg8::pk4_fp8(v[16 * j + 4], v[16 * j + 5], v[16 * j + 6], v[16 * j + 7]);
        o.z = pg8::pk4_fp8(v[16 * j + 8], v[16 * j + 9], v[16 * j + 10], v[16 * j + 11]); o.w = pg8::pk4_fp8(v[16 * j + 12], v[16 * j + 13], v[16 * j + 14], v[16 * j + 15]);
        *(u32x4*)(dst + 16 * j) = o; }
}
constexpr int MOE_I1 = 16 * 32, MOE_I2 = 16 * 16, MOE_ITEMS = NE * (MOE_I1 + MOE_I2);
__device__ __forceinline__ void moe_weight_item(const Frame& F, int it) {
#if !MK_FP8
    if (it < NE * MOE_I1) { const int e = it / MOE_I1; transpose_item(F.in[24] + (size_t)e * 1024 * 2048, 1024, 2048, wsp<bf16>(F, WS_W1) + (size_t)e * 2048 * 1024, 2, it % MOE_I1, F.lane); }
    else { const int r = it - NE * MOE_I1, e = r / MOE_I2; transpose_item(F.in[26] + (size_t)e * 1024 * 1024, 1024, 1024, wsp<bf16>(F, WS_W2) + (size_t)e * 1024 * 1024, 1, r % MOE_I2, F.lane); }
#else
    if (it < NE * MOE_I1) { const int e = it / MOE_I1; transpose_item8(F.in[24] + (size_t)e * 1024 * 2048, 1024, 2048, wsp<unsigned char>(F, WS_W1) + (size_t)e * 2048 * 1024, 2, it % MOE_I1, F.lane); }
    else { const int r = it - NE * MOE_I1, e = r / MOE_I2; transpose_item8(F.in[26] + (size_t)e * 1024 * 1024, 1024, 1024, wsp<unsigned char>(F, WS_W2) + (size_t)e * 1024 * 1024, 1, r % MOE_I2, F.lane); }
#endif
}

__device__ __forceinline__ void phase0(const Frame& F) {
    if (F.vcu < 192) {
        LAS float* sl = (LAS float*)F.lds;
        LAS float* red = (LAS float*)(F.lds + 32768);
        const float* c = F.in[1];
        for (int idx = F.tid; idx < 8192; idx += 512) { const int b = idx & 7, k = idx >> 3; const float cv = c[b * 1024 + k]; sl[idx] = cv / (1.f + __expf(-cv)); }
        __syncthreads();
        const int cl = F.tid & 31, ks = F.tid >> 5, col = F.vcu * 32 + cl;
        const float* wa = F.in[2];
        float acc[8];
#pragma unroll
        for (int b = 0; b < 8; ++b) acc[b] = 0.f;
#pragma unroll 4
        for (int kk = 0; kk < 64; ++kk) { const int k = ks * 64 + kk; const float w = wa[(size_t)k * 6144 + col];
            const f32x4 s0 = *(const LAS f32x4*)(sl + k * 8), s1 = *(const LAS f32x4*)(sl + k * 8 + 4);
            acc[0] += s0[0] * w; acc[1] += s0[1] * w; acc[2] += s0[2] * w; acc[3] += s0[3] * w;
            acc[4] += s1[0] * w; acc[5] += s1[1] * w; acc[6] += s1[2] * w; acc[7] += s1[3] * w; }
#pragma unroll
        for (int b = 0; b < 8; ++b) red[(ks * 32 + cl) * 8 + b] = acc[b];
        __syncthreads();
        if (F.tid < 256) { const int b = F.tid >> 5; float s = F.in[3][col];
            for (int q = 0; q < 16; ++q) s += red[(q * 32 + cl) * 8 + b];
            wsp<float>(F, WS_MOD)[b * 6144 + col] = s; }
    }
    const int gw = F.vcu * 8 + F.wave, NGW = F.G * 8;
    constexpr int I_IN = 16 * 40, I_OUT = 16 * 16;
    constexpr int NITEMS = I_IN + I_OUT;
    for (int it = gw; it < NITEMS; it += NGW) {
        int r = it;
        if (r < I_IN) { transpose_item(F.in[5], 1024, 2560, wsp<bf16>(F, WS_WIN), 1, r, F.lane); continue; } r -= I_IN;
        transpose_item(F.in[20], 1024, 1024, wsp<bf16>(F, WS_WOUT), 1, r, F.lane);
    }
#if MK_CONV_WHERE == 0
    for (int it = gw; it < MOE_ITEMS; it += NGW) moe_weight_item(F, it);
#endif
    { bf16* LW = wsp<bf16>(F, WS_LW);
        for (int idx = F.vcu * 512 + F.tid; idx < 256 * 512; idx += F.G * 512) { const int k = idx >> 9, c = idx & 511;
            const float v = k < 64 ? F.in[8][k * 512 + c] : (k < 128 ? F.in[10][(k - 64) * 512 + c] : F.in[11][(k - 128) * 512 + c]);
            LW[c * 256 + k] = (bf16)f2bf(v); } }
}
template <bool OUT8 = false, bool IN16 = false>
__device__ __forceinline__ void norm_row(const Frame& F, const float* xrow, const float* g, const float* shift, const float* scale, bf16* orow, f32x4 (&h)[4]) {
    const f32x4* xr = (const f32x4*)xrow + F.lane; const u32x2* xr16 = (const u32x2*)xrow + F.lane;
    float ss = 0.f;
#pragma unroll
    for (int j = 0; j < 4; ++j) { if constexpr (IN16) { const u32x2 q = __builtin_nontemporal_load(xr16 + 64 * j); h[j] = (f32x4){bflo(q.x), bfhi(q.x), bflo(q.y), bfhi(q.y)}; } else h[j] = __builtin_nontemporal_load(xr + 64 * j); ss += (h[j][0] * h[j][0] + h[j][1] * h[j][1]) + (h[j][2] * h[j][2] + h[j][3] * h[j][3]); }
    const float rstd = rsqrtf(wave_sum(ss) * (1.f / D) + NORM_EPS);
    u32x2* o8 = (u32x2*)orow + F.lane;
#pragma unroll
    for (int j = 0; j < 4; ++j) { const int col = 4 * F.lane + 256 * j;
        const f32x4 gv = *(const f32x4*)(g + col), sh = *(const f32x4*)(shift + col), sc = *(const f32x4*)(scale + col);
        h[j] = h[j] * rstd * gv * (sc + 1.f) + sh;
        if constexpr (OUT8) ((unsigned*)orow)[F.lane + 64 * j] = pg8::pk4_fp8(h[j][0], h[j][1], h[j][2], h[j][3]);
        else { u32x2 w; w.x = pk2(h[j][0], h[j][1]); w.y = pk2(h[j][2], h[j][3]); o8[64 * j] = w; } }
}
__device__ __forceinline__ void phase1(const Frame& F) {
    const int gw = F.vcu * 8 + F.wave, NGW = F.G * 8;
    const float* mod = wsp<float>(F, WS_MOD);
    for (int row = gw; row < M; row += NGW) { const int b = row / T; f32x4 h[4];
        norm_row(F, F.in[0] + (size_t)row * D, F.in[4], mod + b * 6144, mod + b * 6144 + 1024, wsp<bf16>(F, WS_H) + (size_t)row * D, h); }
}

template <int CTRL> __device__ __forceinline__ float dpp_mov(float v) { return __builtin_bit_cast(float, __builtin_amdgcn_update_dpp(0, __builtin_bit_cast(int, v), CTRL, 0xf, 0xf, false)); }
__device__ __forceinline__ float reduce16(float v) { v += dpp_mov<0xB1>(v); v += dpp_mov<0x4E>(v); v += dpp_mov<0x141>(v); v += dpp_mov<0x140>(v); return v; }
__device__ __forceinline__ void lerp8(const bf16* P, const float* mu, int tok, int t, int col, float (&x)[8]) {
    const u32x4 c = *(const u32x4*)(P + (size_t)tok * IN_COLS + col);
    u32x4 p = (u32x4){0u, 0u, 0u, 0u};
    if (t > 0) p = *(const u32x4*)(P + (size_t)(tok - 1) * IN_COLS + col);
    const f32x4 m0 = *(const f32x4*)(mu + col), m1 = *(const f32x4*)(mu + col + 4);
    const float cf[8] = {bflo(c.x), bfhi(c.x), bflo(c.y), bfhi(c.y), bflo(c.z), bfhi(c.z), bflo(c.w), bfhi(c.w)};
    const float pf[8] = {bflo(p.x), bfhi(p.x), bflo(p.y), bfhi(p.y), bflo(p.z), bfhi(p.z), bflo(p.w), bfhi(p.w)};
    const float mf[8] = {m0[0], m0[1], m0[2], m0[3], m1[0], m1[1], m1[2], m1[3]};
#pragma unroll
    for (int j = 0; j < 8; ++j) x[j] = cf[j] + (pf[j] - cf[j]) * mf[j];
}
__device__ __forceinline__ f32x4 lerp4(const bf16* P, const float* mu, int tok, int t, int col) {
    const u32x2 c = *(const u32x2*)(P + (size_t)tok * IN_COLS + col);
    u32x2 p = (u32x2){0u, 0u};
    if (t > 0) p = *(const u32x2*)(P + (size_t)(tok - 1) * IN_COLS + col);
    const f32x4 m = *(const f32x4*)(mu + col);
    const f32x4 cf = (f32x4){bflo(c.x), bfhi(c.x), bflo(c.y), bfhi(c.y)}, pf = (f32x4){bflo(p.x), bfhi(p.x), bflo(p.y), bfhi(p.y)};
    return cf + (pf - cf) * m;
}
__device__ __forceinline__ bf16x8 pack8(const float (&x)[8]) { u32x4 w; w.x = pk2(x[0], x[1]); w.y = pk2(x[2], x[3]); w.z = pk2(x[4], x[5]); w.w = pk2(x[6], x[7]); return __builtin_bit_cast(bf16x8, w); }
__device__ __forceinline__ void phase3(const Frame& F) {
    const bf16* P = wsp<bf16>(F, WS_P); const bf16* LW = wsp<bf16>(F, WS_LW);
    const float* mu = F.in[6]; const float* w0 = F.in[7]; const float* a0 = F.in[9];
    const float* k_k = F.in[12]; const float* k_a = F.in[13]; const float* r_k = F.in[14];
    float* SCN = wsp<float>(F, WS_SCN); float* SV = wsp<float>(F, WS_SV); bf16* G = wsp<bf16>(F, WS_G); float* BON = wsp<float>(F, WS_BONUS);
    const int gw = F.vcu * 8 + F.wave, NGW = F.G * 8;
    const int cl = F.lane & 15, q = F.lane >> 4;
    for (int tile = gw; tile < M / 16; tile += NGW) {
        bf16x8 Aw[2], Aa[2], Ag[4];
        { const int tok = tile * 16 + cl, t = tok % T; float x[8];
#pragma unroll
            for (int s = 0; s < 2; ++s) { lerp8(P, mu, tok, t, 1536 + 32 * s + 8 * q, x);
#pragma unroll
                for (int j = 0; j < 8; ++j) x[j] = tanhf(x[j]);
                Aw[s] = pack8(x);
                lerp8(P, mu, tok, t, 1600 + 32 * s + 8 * q, x); Aa[s] = pack8(x); }
#pragma unroll
            for (int s = 0; s < 4; ++s) { lerp8(P, mu, tok, t, 1664 + 32 * s + 8 * q, x);
#pragma unroll
                for (int j = 0; j < 8; ++j) x[j] = sigmoidf_(x[j]);
                Ag[s] = pack8(x); } }
        const int tk0 = tile * 16 + 4 * q, b = tk0 / T, t0 = tk0 % T;
#pragma unroll 1
        for (int hh = 0; hh < RH; ++hh) {
            const int c0 = hh * 64 + cl * 4;
            f32x4 accw[4], acca[4], accg[4];
#pragma unroll
            for (int ct = 0; ct < 4; ++ct) { const bf16* lw = LW + (size_t)(c0 + ct) * 256 + 8 * q;
                f32x4 aw = (f32x4){0.f, 0.f, 0.f, 0.f}, aa = aw, ag = aw;
#pragma unroll
                for (int s = 0; s < 2; ++s) { aw = __builtin_amdgcn_mfma_f32_16x16x32_bf16(Aw[s], *(const bf16x8*)(lw + 32 * s), aw, 0, 0, 0);
                    aa = __builtin_amdgcn_mfma_f32_16x16x32_bf16(Aa[s], *(const bf16x8*)(lw + 64 + 32 * s), aa, 0, 0, 0); }
#pragma unroll
                for (int s = 0; s < 4; ++s) ag = __builtin_amdgcn_mfma_f32_16x16x32_bf16(Ag[s], *(const bf16x8*)(lw + 128 + 32 * s), ag, 0, 0, 0);
                accw[ct] = aw; acca[ct] = aa; accg[ct] = ag; }
            const f32x4 w0v = *(const f32x4*)(w0 + c0), a0v = *(const f32x4*)(a0 + c0), kkv = *(const f32x4*)(k_k + c0), kav = *(const f32x4*)(k_a + c0), rkv = *(const f32x4*)(r_k + c0);
#pragma unroll
            for (int i = 0; i < 4; ++i) { const int tk = tk0 + i, t = t0 + i;
                const f32x4 r4 = lerp4(P, mu, tk, t, c0), kr4 = lerp4(P, mu, tk, t, 512 + c0), v4 = lerp4(P, mu, tk, t, 1024 + c0);
                f32x4 dec, av, gv, kk4, k4;
                float ssq = 0.f, bon = 0.f;
#pragma unroll
                for (int ct = 0; ct < 4; ++ct) {
                    dec[ct] = __expf(-0.60653066f * sigmoidf_(w0v[ct] + accw[ct][i]));
                    av[ct] = sigmoidf_(a0v[ct] + acca[ct][i]);
                    gv[ct] = accg[ct][i];
                    kk4[ct] = kr4[ct] * kkv[ct]; ssq += kk4[ct] * kk4[ct];
                    k4[ct] = kr4[ct] * (1.f + (av[ct] - 1.f) * kav[ct]);
                    bon += r4[ct] * k4[ct] * rkv[ct]; }
                ssq = reduce16(ssq); bon = reduce16(bon);
                const float inv = __builtin_amdgcn_rcpf(fmaxf(sqrtf(ssq), 1e-12f));
                const f32x4 kkn = kk4 * inv, bb = kkn * av;
                const size_t so = ((size_t)(b * RH + hh) * T + t) * 64 + cl * 4;
                float* sc = SCN + ((size_t)(b * RH + hh) * T + t) * 320 + cl * 4;
                *(f32x4*)(sc) = dec; *(f32x4*)(sc + 64) = kkn; *(f32x4*)(sc + 128) = bb; *(f32x4*)(sc + 192) = k4; *(f32x4*)(sc + 256) = r4;
                *(f32x4*)(SV + so) = v4;
                u32x2 gw2; gw2.x = pk2(gv[0], gv[1]); gw2.y = pk2(gv[2], gv[3]);
                *(u32x2*)(G + (size_t)tk * 512 + c0) = gw2;
                if (cl == 0) BON[tk * 8 + hh] = bon; }
        }
    }
}

constexpr int CK = 32, NCHK = T / CK;
#define SC_SPIN_CAP (1 << 24)
#define MFMA32(a, b, c) __builtin_amdgcn_mfma_f32_32x32x16_bf16((a), (b), (c), 0, 0, 0)
__device__ __forceinline__ int crow(int i, int h) { return (i & 3) + 8 * (i >> 2) + 4 * h; }
template <int S_> __device__ __forceinline__ bf16x8 pack_acc(const f32x16& x) { u32x4 w; w.x = pk2(x[8 * S_], x[8 * S_ + 1]); w.y = pk2(x[8 * S_ + 2], x[8 * S_ + 3]); w.z = pk2(x[8 * S_ + 4], x[8 * S_ + 5]); w.w = pk2(x[8 * S_ + 6], x[8 * S_ + 7]); return __builtin_bit_cast(bf16x8, w); }
__device__ __forceinline__ bf16x8 rd_nat(const LAS bf16* img, int stride, int row, int k0) { return *(const LAS bf16x8*)(img + row * stride + k0); }
__device__ __forceinline__ bf16x8 rd_perm(const LAS bf16* img, int stride, int row, int kb, int h) {
    const u32x2 lo = *(const LAS u32x2*)(img + row * stride + kb + 4 * h), hi = *(const LAS u32x2*)(img + row * stride + kb + 8 + 4 * h);
    u32x4 w; w.x = lo.x; w.y = lo.y; w.z = hi.x; w.w = hi.y; return __builtin_bit_cast(bf16x8, w);
}
__device__ __forceinline__ f32x16 zero16() { f32x16 z; for (int i = 0; i < 16; ++i) z[i] = 0.f; return z; }
constexpr int CL_A = 0, CL_B = 4608, CL_K = 9216, CL_R = 13824, CL_AT = 18432, CL_BHT = 23552, CL_KHT = 28672, CL_VT = 33792, CL_GTOT = 38912, CL_GC = 39936,
              CL_L = 40192, CL_T = 44800, CL_FNRB = 47360, CL_CNRK = 49408, CL_FQM = 53504, CL_GROUP = 57600;
constexpr int RMS = 72, TRS = 40, LST = 36;
__device__ __forceinline__ void phase4a_summaries(const Frame& F) {
    const float* SCN = wsp<float>(F, WS_SCN); const float* SV = wsp<float>(F, WS_SV);
    bf16x8* PT = wsp<bf16x8>(F, WS_PT); f32x4* ZV = wsp<f32x4>(F, WS_ZV); bf16x8* RYT = wsp<bf16x8>(F, WS_RYT); f32x4* YVT = wsp<f32x4>(F, WS_YVT);
    const int grp = F.tid >> 8, gt = F.tid & 255, w4 = F.wave & 3, lane = F.lane, r = lane & 31, h = lane >> 5;
    LAS unsigned char* gl = F.lds + grp * CL_GROUP;
    LAS bf16* iA = (LAS bf16*)(gl + CL_A); LAS bf16* iB = (LAS bf16*)(gl + CL_B); LAS bf16* iK = (LAS bf16*)(gl + CL_K); LAS bf16* iR = (LAS bf16*)(gl + CL_R);
    LAS bf16* iAT = (LAS bf16*)(gl + CL_AT); LAS bf16* iBHT = (LAS bf16*)(gl + CL_BHT); LAS bf16* iKHT = (LAS bf16*)(gl + CL_KHT); LAS bf16* iVT = (LAS bf16*)(gl + CL_VT);
    LAS float* gtot = (LAS float*)(gl + CL_GTOT); LAS float* gcv = (LAS float*)(gl + CL_GC); LAS float* Lm = (LAS float*)(gl + CL_L); LAS bf16* Tm = (LAS bf16*)(gl + CL_T);
    LAS bf16x8* fnrb = (LAS bf16x8*)(gl + CL_FNRB); LAS float* cnrk = (LAS float*)(gl + CL_CNRK); LAS bf16x8* fqm = (LAS bf16x8*)(gl + CL_FQM);
    constexpr int NCHUNKS = NBATCH * RH * NCHK;
    for (int it = F.vcu; it < NCHUNKS / 2; it += F.G) {
        const int chunk = it * 2 + grp, bh = chunk / NCHK, c = chunk % NCHK, t0 = c * CK;
        __syncthreads();
        { const int k = gt & 63, tq = gt >> 6;
            float wv[8], kkv[8], bv[8], kv[8], rv[8], vv[8], lp[8];
#pragma unroll
            for (int i = 0; i < 8; ++i) { const size_t row = (size_t)bh * T + t0 + 8 * tq + i; const float* sc = SCN + row * 320 + k;
                wv[i] = sc[0]; kkv[i] = sc[64]; bv[i] = sc[128]; kv[i] = sc[192]; rv[i] = sc[256]; vv[i] = SV[row * 64 + k]; }
            lp[0] = wv[0];
#pragma unroll
            for (int i = 1; i < 8; ++i) lp[i] = lp[i - 1] * wv[i];
            gtot[tq * 64 + k] = lp[7];
            __syncthreads();
            const float g0 = gtot[k], g1 = gtot[64 + k], g2 = gtot[128 + k], g3 = gtot[192 + k];
            const float pre = tq == 0 ? 1.f : (tq == 1 ? g0 : (tq == 2 ? g0 * g1 : g0 * g1 * g2)), gC = (g0 * g1) * (g2 * g3);
            float at[8], bh8[8], kh8[8];
#pragma unroll
            for (int i = 0; i < 8; ++i) { const float g = pre * lp[i], gp = i == 0 ? pre : pre * lp[i - 1], ig = __builtin_amdgcn_rcpf(g);
                const float bt = bv[i] * ig, kt = kv[i] * ig; at[i] = -kkv[i] * gp; bh8[i] = bt * gC; kh8[i] = kt * gC;
                const int ro = (8 * tq + i) * RMS + k;
                iA[ro] = (bf16)f2bf(at[i]); iB[ro] = (bf16)f2bf(bt); iK[ro] = (bf16)f2bf(kt); iR[ro] = (bf16)f2bf(rv[i] * g); }
            *(LAS bf16x8*)(iAT + k * TRS + 8 * tq) = pack8(at); *(LAS bf16x8*)(iBHT + k * TRS + 8 * tq) = pack8(bh8); *(LAS bf16x8*)(iKHT + k * TRS + 8 * tq) = pack8(kh8);
            *(LAS bf16x8*)(iVT + k * TRS + 8 * tq) = pack8(vv);
            if (tq == 0) gcv[k] = gC; }
        __syncthreads();
        f32x16 lak = zero16();
        { const LAS bf16* ia = (w4 < 2) ? iA : (w4 == 2 ? iB : iK); const LAS bf16* ib = (w4 == 0) ? iB : (w4 == 1 ? iK : iR);
            f32x16 acc = zero16();
#pragma unroll
            for (int ks = 0; ks < 4; ++ks) acc = MFMA32(rd_nat(ia, RMS, r, 16 * ks + 8 * h), rd_nat(ib, RMS, r, 16 * ks + 8 * h), acc);
#pragma unroll
            for (int i = 0; i < 16; ++i) { const int row = crow(i, h); const bool keep = (w4 < 2) ? (r < row) : (row <= r); acc[i] = keep ? acc[i] : 0.f; }
            if (w4 == 0) {
#pragma unroll
                for (int i = 0; i < 16; ++i) Lm[crow(i, h) * LST + r] = acc[i]; }
            else if (w4 == 1) lak = acc;
            else if (w4 == 2) { fnrb[lane] = pack_acc<0>(acc); fnrb[64 + lane] = pack_acc<1>(acc); }
            else {
#pragma unroll
                for (int i = 0; i < 16; ++i) cnrk[i * 64 + lane] = acc[i]; } }
        __syncthreads();
        if (w4 == 0) { float Tr[32];
#pragma unroll
            for (int t = 0; t < 32; ++t) { float acc = (t == r) ? 1.f : 0.f;
#pragma unroll
                for (int s4 = 0; s4 < (t + 3) / 4; ++s4) { const f32x4 l4 = *(const LAS f32x4*)(Lm + t * LST + 4 * s4);
#pragma unroll
                    for (int q = 0; q < 4; ++q) if (4 * s4 + q < t) acc += l4[q] * Tr[4 * s4 + q]; }
                Tr[t] = acc; }
            if (lane < 32) {
#pragma unroll
                for (int t = 0; t < 32; ++t) Tm[t * TRS + r] = (bf16)f2bf(Tr[t]); } }
        __syncthreads();
        if (w4 == 0 || w4 == 2) { const int a = w4 >> 1;
            f32x16 x1 = zero16();
#pragma unroll
            for (int ks = 0; ks < 2; ++ks) x1 = MFMA32(rd_nat(Tm, TRS, r, 16 * ks + 8 * h), rd_nat(iAT, TRS, 32 * a + r, 16 * ks + 8 * h), x1);
            const bf16x8 xf0 = pack_acc<0>(x1), xf1 = pack_acc<1>(x1);
#pragma unroll
            for (int b = 0; b < 2; ++b) { f32x16 p = zero16();
                p = MFMA32(xf0, rd_perm(iBHT, TRS, 32 * b + r, 0, h), p); p = MFMA32(xf1, rd_perm(iBHT, TRS, 32 * b + r, 16, h), p);
                if (a == b) { const float gc = gcv[32 * a + r];
#pragma unroll
                    for (int i = 0; i < 16; ++i) p[i] += (crow(i, h) == r) ? gc : 0.f; }
                bf16x8* dst = PT + ((size_t)(chunk * 2 + a) * 2 + b) * 2 * 64 + lane; dst[0] = pack_acc<0>(p); dst[64] = pack_acc<1>(p); }
            f32x16 ry;
#pragma unroll
            for (int g = 0; g < 4; ++g) { const u32x2 rr = *(const LAS u32x2*)(iR + r * RMS + 32 * a + 8 * g + 4 * h);
                ry[4 * g] = bflo(rr.x); ry[4 * g + 1] = bfhi(rr.x); ry[4 * g + 2] = bflo(rr.y); ry[4 * g + 3] = bfhi(rr.y); }
            ry = MFMA32(xf0, fnrb[lane], ry); ry = MFMA32(xf1, fnrb[64 + lane], ry);
            bf16x8* dr = RYT + (size_t)(chunk * 2 + a) * 2 * 64 + lane; dr[0] = pack_acc<0>(ry); dr[64] = pack_acc<1>(ry);
        } else if (w4 == 1) {
            f32x16 x2 = zero16();
            x2 = MFMA32(rd_perm(Tm, TRS, r, 0, h), pack_acc<0>(lak), x2); x2 = MFMA32(rd_perm(Tm, TRS, r, 16, h), pack_acc<1>(lak), x2);
            const bf16x8 xf0 = pack_acc<0>(x2), xf1 = pack_acc<1>(x2);
#pragma unroll
            for (int b = 0; b < 2; ++b) { f32x16 qm;
#pragma unroll
                for (int g = 0; g < 4; ++g) { const u32x2 kk2 = *(const LAS u32x2*)(iKHT + (32 * b + r) * TRS + 8 * g + 4 * h);
                    qm[4 * g] = bflo(kk2.x); qm[4 * g + 1] = bfhi(kk2.x); qm[4 * g + 2] = bflo(kk2.y); qm[4 * g + 3] = bfhi(kk2.y); }
                qm = MFMA32(xf0, rd_perm(iBHT, TRS, 32 * b + r, 0, h), qm); qm = MFMA32(xf1, rd_perm(iBHT, TRS, 32 * b + r, 16, h), qm);
                fqm[(b * 2 + 0) * 64 + lane] = pack_acc<0>(qm); fqm[(b * 2 + 1) * 64 + lane] = pack_acc<1>(qm); }
            f32x16 gy;
#pragma unroll
            for (int i = 0; i < 16; ++i) gy[i] = cnrk[i * 64 + lane];
            gy = MFMA32(xf0, fnrb[lane], gy); gy = MFMA32(xf1, fnrb[64 + lane], gy);
            const bf16x8 gf0 = pack_acc<0>(gy), gf1 = pack_acc<1>(gy);
#pragma unroll
            for (int vh = 0; vh < 2; ++vh) { f32x16 yv = zero16();
                yv = MFMA32(rd_perm(iVT, TRS, 32 * vh + r, 0, h), gf0, yv); yv = MFMA32(rd_perm(iVT, TRS, 32 * vh + r, 16, h), gf1, yv);
                bf16x8* dy = (bf16x8*)YVT + ((size_t)(chunk * 2 + vh) * 64 + lane) * 2;
                dy[0] = pack_acc<0>(yv); dy[1] = pack_acc<1>(yv); }
        }
        __syncthreads();
        if (w4 == 3) {
#pragma unroll
            for (int b = 0; b < 2; ++b)
#pragma unroll
                for (int vh = 0; vh < 2; ++vh) { f32x16 zv = zero16();
                    zv = MFMA32(fqm[(b * 2 + 0) * 64 + lane], rd_perm(iVT, TRS, 32 * vh + r, 0, h), zv); zv = MFMA32(fqm[(b * 2 + 1) * 64 + lane], rd_perm(iVT, TRS, 32 * vh + r, 16, h), zv);
                    f32x4* dz = ZV + (((size_t)(chunk * 2 + b) * 2 + vh) * 64 + lane) * 4;
#pragma unroll
                    for (int g = 0; g < 4; ++g) dz[g] = (f32x4){zv[4 * g], zv[4 * g + 1], zv[4 * g + 2], zv[4 * g + 3]}; }
        }
    }
}
constexpr int CL2_LA = 2 * CL_GROUP, LAS_STRIDE = 264;
static_assert(CL2_LA + 32 * LAS_STRIDE * 2 <= MISC_OFF, "fused summaries LDS map");
__device__ __forceinline__ void phase4a_fused(const Frame& F) {
    const bf16* P = wsp<bf16>(F, WS_P); const bf16* LW = wsp<bf16>(F, WS_LW);
    const float* mu = F.in[6]; const float* w0 = F.in[7]; const float* a0 = F.in[9]; const float* k_k = F.in[12]; const float* k_a = F.in[13]; const float* r_k = F.in[14];
    float* SV = wsp<float>(F, WS_SV); bf16* G = wsp<bf16>(F, WS_G); float* BON = wsp<float>(F, WS_BONUS);
    bf16x8* PT = wsp<bf16x8>(F, WS_PT); f32x4* ZV = wsp<f32x4>(F, WS_ZV); bf16x8* RYT = wsp<bf16x8>(F, WS_RYT); f32x4* YVT = wsp<f32x4>(F, WS_YVT);
    const int grp = F.tid >> 8, gt = F.tid & 255, w4 = F.wave & 3, lane = F.lane, r = lane & 31, h = lane >> 5;
    LAS unsigned char* gl = F.lds + grp * CL_GROUP;
    LAS bf16* iA = (LAS bf16*)(gl + CL_A); LAS bf16* iB = (LAS bf16*)(gl + CL_B); LAS bf16* iK = (LAS bf16*)(gl + CL_K); LAS bf16* iR = (LAS bf16*)(gl + CL_R);
    LAS bf16* iAT = (LAS bf16*)(gl + CL_AT); LAS bf16* iBHT = (LAS bf16*)(gl + CL_BHT); LAS bf16* iKHT = (LAS bf16*)(gl + CL_KHT); LAS bf16* iVT = (LAS bf16*)(gl + CL_VT);
    LAS float* gtot = (LAS float*)(gl + CL_GTOT); LAS float* gcv = (LAS float*)(gl + CL_GC); LAS float* Lm = (LAS float*)(gl + CL_L); LAS bf16* Tm = (LAS bf16*)(gl + CL_T);
    LAS bf16x8* fnrb = (LAS bf16x8*)(gl + CL_FNRB); LAS float* cnrk = (LAS float*)(gl + CL_CNRK); LAS bf16x8* fqm = (LAS bf16x8*)(gl + CL_FQM);
    LAS float* lwo_w = (LAS float*)(gl + CL_L); LAS float* lwo_a = lwo_w + 32 * 64;
    LAS bf16* LA = (LAS bf16*)(F.lds + CL2_LA);
    bf16 cr[9], ck[9], cv[9]; float cst[8]; bool tz;
#define S1_LOAD(tc_, hp_) do { const int _hh = 2 * (hp_) + grp, _cc = _hh * 64 + (gt & 63), _t0 = ((tc_) % NCHK) * CK + 8 * (gt >> 6); \
        const size_t _pr = ((size_t)((tc_) / NCHK) * T + _t0) * IN_COLS + _cc; tz = _t0 > 0; const size_t _pp = tz ? _pr - IN_COLS : _pr; \
        cr[0] = __builtin_nontemporal_load(P + _pp); ck[0] = __builtin_nontemporal_load(P + _pp + 512); cv[0] = __builtin_nontemporal_load(P + _pp + 1024); \
        _Pragma("unroll") for (int _i = 0; _i < 8; ++_i) { cr[_i + 1] = __builtin_nontemporal_load(P + _pr + (size_t)_i * IN_COLS); ck[_i + 1] = __builtin_nontemporal_load(P + _pr + (size_t)_i * IN_COLS + 512); cv[_i + 1] = __builtin_nontemporal_load(P + _pr + (size_t)_i * IN_COLS + 1024); } \
        cst[0] = mu[_cc]; cst[1] = mu[512 + _cc]; cst[2] = mu[1024 + _cc]; cst[3] = w0[_cc]; cst[4] = a0[_cc]; cst[5] = k_k[_cc]; cst[6] = k_a[_cc]; cst[7] = r_k[_cc]; } while (0)
    bf16x8 lwf[8];
#define LW_LOAD(hp_) do { const bf16* _lw = LW + (size_t)((2 * (hp_) + grp) * 64 + 32 * (w4 & 1) + r) * 256 + 8 * h + (w4 < 2 ? 0 : 128); \
        _Pragma("unroll") for (int _q = 0; _q < 8; ++_q) lwf[_q] = *(const bf16x8*)(_lw + 16 * _q); } while (0)
    S1_LOAD(F.vcu, 0);
    LW_LOAD(0);
    for (int tc = F.vcu; tc < M / CK; tc += F.G) {
        const int b = tc / NCHK, c = tc % NCHK, t0 = c * CK, row0 = b * T + t0;
        lds_barrier();
        { const int tk = F.tid >> 4, cb = (F.tid & 15) * 16; float x[8];
#pragma unroll
            for (int q8 = 0; q8 < 2; ++q8) { const int col = cb + 8 * q8; lerp8(P, mu, row0 + tk, t0 + tk, 1536 + col, x);
                if (col < 64) {
#pragma unroll
                    for (int j = 0; j < 8; ++j) x[j] = 2.f * sigmoidf_(2.f * x[j]) - 1.f; }
                else if (col >= 128) {
#pragma unroll
                    for (int j = 0; j < 8; ++j) x[j] = sigmoidf_(x[j]); }
                *(LAS bf16x8*)(LA + tk * LAS_STRIDE + col) = pack8(x); } }
#pragma unroll 1
        for (int hp = 0; hp < 4; ++hp) {
            const int hh = 2 * hp + grp, bh = b * RH + hh, chunk = bh * NCHK + c;
            lds_barrier();
            { const int ct = w4 & 1;
                if (w4 < 2) {
                    f32x16 aw = zero16(), aa = zero16();
#pragma unroll
                    for (int ks = 0; ks < 4; ++ks) { aw = MFMA32(rd_nat(LA, LAS_STRIDE, r, 16 * ks + 8 * h), lwf[ks], aw); aa = MFMA32(rd_nat(LA, LAS_STRIDE, r, 64 + 16 * ks + 8 * h), lwf[4 + ks], aa); }
#pragma unroll
                    for (int i = 0; i < 16; ++i) { lwo_w[crow(i, h) * 64 + 32 * ct + r] = aw[i]; lwo_a[crow(i, h) * 64 + 32 * ct + r] = aa[i]; }
                } else {
                    f32x16 ag = zero16();
#pragma unroll
                    for (int ks = 0; ks < 8; ++ks) ag = MFMA32(rd_nat(LA, LAS_STRIDE, r, 128 + 16 * ks + 8 * h), lwf[ks], ag);
#pragma unroll
                    for (int i = 0; i < 16; ++i) G[(size_t)(row0 + crow(i, h)) * 512 + hh * 64 + 32 * ct + r] = (bf16)f2bf(ag[i]); } }
            LW_LOAD((hp + 1) & 3);
            lds_barrier();
            auto st1 = [&]() { const int k = gt & 63, tq = gt >> 6, cc = hh * 64 + k;
                float wv[8], kkv[8], bv[8], kv[8], rv[8], vv[8], lp[8];
                { const float mur = cst[0], muk = cst[1], muv = cst[2], w0c = cst[3], a0c = cst[4], kkc = cst[5], kac = cst[6], rkc = cst[7];
                    const int tl0 = 8 * tq;
                    if (!tz) { cr[0] = 0; ck[0] = 0; cv[0] = 0; }
                    float lw_[8], la_[8];
#pragma unroll
                    for (int i = 0; i < 8; ++i) { lw_[i] = lwo_w[(tl0 + i) * 64 + k]; la_[i] = lwo_a[(tl0 + i) * 64 + k]; }
                    float kk[8], ssq[8], bo[8], av[8];
#pragma unroll
                    for (int i = 0; i < 8; ++i) { const float c_r = bf2f(cr[i + 1]), c_k = bf2f(ck[i + 1]), c_v = bf2f(cv[i + 1]);
                        rv[i] = c_r + (bf2f(cr[i]) - c_r) * mur; const float kr = c_k + (bf2f(ck[i]) - c_k) * muk; vv[i] = c_v + (bf2f(cv[i]) - c_v) * muv;
                        wv[i] = __expf(-0.60653066f * sigmoidf_(w0c + lw_[i])); av[i] = sigmoidf_(a0c + la_[i]);
                        kk[i] = kr * kkc; ssq[i] = kk[i] * kk[i]; kv[i] = kr * (1.f + (av[i] - 1.f) * kac); bo[i] = rv[i] * kv[i] * rkc; }
#pragma unroll
                    for (int i = 0; i < 8; ++i) { ssq[i] = reduce16(ssq[i]); bo[i] = reduce16(bo[i]); }
#pragma unroll
                    for (int i = 0; i < 8; ++i) { ssq[i] += __shfl_xor(ssq[i], 16); bo[i] += __shfl_xor(bo[i], 16); }
#pragma unroll
                    for (int i = 0; i < 8; ++i) { ssq[i] += __shfl_xor(ssq[i], 32); bo[i] += __shfl_xor(bo[i], 32); }
#pragma unroll
                    for (int i = 0; i < 8; ++i) { kkv[i] = kk[i] * __builtin_amdgcn_rcpf(fmaxf(sqrtf(ssq[i]), 1e-12f)); bv[i] = kkv[i] * av[i];
                        ((bf16*)SV)[((size_t)bh * T + t0 + tl0 + i) * 64 + k] = (bf16)f2bf(vv[i]);
                        if (k == 0) BON[(row0 + tl0 + i) * 8 + hh] = bo[i]; } }
                lp[0] = wv[0];
#pragma unroll
                for (int i = 1; i < 8; ++i) lp[i] = lp[i - 1] * wv[i];
                gtot[tq * 64 + k] = lp[7];
                lds_barrier();
                const float g0 = gtot[k], g1 = gtot[64 + k], g2 = gtot[128 + k], g3 = gtot[192 + k];
                const float pre = tq == 0 ? 1.f : (tq == 1 ? g0 : (tq == 2 ? g0 * g1 : g0 * g1 * g2)), gC = (g0 * g1) * (g2 * g3);
                float at[8], bh8[8], kh8[8];
#pragma unroll
                for (int i = 0; i < 8; ++i) { const float g = pre * lp[i], gp = i == 0 ? pre : pre * lp[i - 1], ig = __builtin_amdgcn_rcpf(g);
                    const float bt = bv[i] * ig, kt = kv[i] * ig; at[i] = -kkv[i] * gp; bh8[i] = bt * gC; kh8[i] = kt * gC;
                    const int ro = (8 * tq + i) * RMS + k;
                    iA[ro] = (bf16)f2bf(at[i]); iB[ro] = (bf16)f2bf(bt); iK[ro] = (bf16)f2bf(kt); iR[ro] = (bf16)f2bf(rv[i] * g); }
                *(LAS bf16x8*)(iAT + k * TRS + 8 * tq) = pack8(at); *(LAS bf16x8*)(iBHT + k * TRS + 8 * tq) = pack8(bh8); *(LAS bf16x8*)(iKHT + k * TRS + 8 * tq) = pack8(kh8);
                *(LAS bf16x8*)(iVT + k * TRS + 8 * tq) = pack8(vv);
                if (tq == 0) gcv[k] = gC; };
            st1();
#if MK_DUP & 2
            lds_barrier(); asm volatile("" ::: "memory"); st1();
#endif
            { const int ntc = (hp < 3) ? tc : (tc + F.G < M / CK ? tc + F.G : tc), nhp = (hp < 3) ? hp + 1 : 0; S1_LOAD(ntc, nhp); }
            lds_barrier();
            f32x16 lak = zero16();
            { const LAS bf16* ia = (w4 < 2) ? iA : (w4 == 2 ? iB : iK); const LAS bf16* ib = (w4 == 0) ? iB : (w4 == 1 ? iK : iR);
                f32x16 acc = zero16();
#pragma unroll
                for (int ks = 0; ks < 4; ++ks) acc = MFMA32(rd_nat(ia, RMS, r, 16 * ks + 8 * h), rd_nat(ib, RMS, r, 16 * ks + 8 * h), acc);
#pragma unroll
                for (int i = 0; i < 16; ++i) { const int row = crow(i, h); const bool keep = (w4 < 2) ? (r < row) : (row <= r); acc[i] = keep ? acc[i] : 0.f; }
                if (w4 <= 1) lak = acc;
                else if (w4 == 2) { fnrb[lane] = pack_acc<0>(acc); fnrb[64 + lane] = pack_acc<1>(acc); }
                else {
#pragma unroll
                    for (int i = 0; i < 16; ++i) cnrk[i * 64 + lane] = acc[i]; } }
            lds_barrier();
            auto st3 = [&]() { if (w4 == 0) {
                LAS bf16* imgL = (LAS bf16*)(gl + CL_L);
                f32x16 Lp = lak, Tq = lak;
#pragma unroll
                for (int i = 0; i < 16; ++i) Tq[i] += (crow(i, h) == r) ? 1.f : 0.f;
#pragma unroll
                for (int st = 0; st < 4; ++st) {
#pragma unroll
                    for (int i = 0; i < 16; ++i) { imgL[crow(i, h) * TRS + r] = (bf16)f2bf(Lp[i]); Tm[crow(i, h) * TRS + r] = (bf16)f2bf(Tq[i]); }
                    asm volatile("s_waitcnt lgkmcnt(0)" ::: "memory");
                    const bf16x8 b0 = pack_acc<0>(Lp), b1 = pack_acc<1>(Lp);
                    f32x16 l2 = zero16(); l2 = MFMA32(rd_perm(imgL, TRS, r, 0, h), b0, l2); l2 = MFMA32(rd_perm(imgL, TRS, r, 16, h), b1, l2);
                    Lp = l2;
                    f32x16 mm = l2;
#pragma unroll
                    for (int i = 0; i < 16; ++i) mm[i] += (crow(i, h) == r) ? 1.f : 0.f;
                    const bf16x8 m0 = pack_acc<0>(mm), m1 = pack_acc<1>(mm);
                    f32x16 t2 = zero16(); t2 = MFMA32(rd_perm(Tm, TRS, r, 0, h), m0, t2); t2 = MFMA32(rd_perm(Tm, TRS, r, 16, h), m1, t2);
                    Tq = t2;
                    asm volatile("s_waitcnt lgkmcnt(0)" ::: "memory"); }
#pragma unroll
                for (int i = 0; i < 16; ++i) Tm[crow(i, h) * TRS + r] = (bf16)f2bf(Tq[i]); } };
            st3();
#if MK_DUP & 4
            asm volatile("" ::: "memory"); st3();
#endif
            lds_barrier();
            auto st4 = [&]() { if (w4 == 0 || w4 == 2) { const int a = w4 >> 1;
                f32x16 x1 = zero16();
#pragma unroll
                for (int ks = 0; ks < 2; ++ks) x1 = MFMA32(rd_nat(Tm, TRS, r, 16 * ks + 8 * h), rd_nat(iAT, TRS, 32 * a + r, 16 * ks + 8 * h), x1);
                const bf16x8 xf0 = pack_acc<0>(x1), xf1 = pack_acc<1>(x1);
#pragma unroll
                for (int b = 0; b < 2; ++b) { f32x16 p = zero16();
                    p = MFMA32(xf0, rd_perm(iBHT, TRS, 32 * b + r, 0, h), p); p = MFMA32(xf1, rd_perm(iBHT, TRS, 32 * b + r, 16, h), p);
                    if (a == b) { const float gc = gcv[32 * a + r];
#pragma unroll
                        for (int i = 0; i < 16; ++i) p[i] += (crow(i, h) == r) ? gc : 0.f; }
                    bf16x8* dst = PT + ((size_t)(chunk * 2 + a) * 2 + b) * 2 * 64 + lane; dst[0] = pack_acc<0>(p); dst[64] = pack_acc<1>(p); }
                f32x16 ry;
#pragma unroll
                for (int g = 0; g < 4; ++g) { const u32x2 rr = *(const LAS u32x2*)(iR + r * RMS + 32 * a + 8 * g + 4 * h);
                    ry[4 * g] = bflo(rr.x); ry[4 * g + 1] = bfhi(rr.x); ry[4 * g + 2] = bflo(rr.y); ry[4 * g + 3] = bfhi(rr.y); }
                ry = MFMA32(xf0, fnrb[lane], ry); ry = MFMA32(xf1, fnrb[64 + lane], ry);
                bf16x8* dr = RYT + (size_t)(chunk * 2 + a) * 2 * 64 + lane; dr[0] = pack_acc<0>(ry); dr[64] = pack_acc<1>(ry);
            } else if (w4 == 1) {
                f32x16 x2 = zero16();
                x2 = MFMA32(rd_perm(Tm, TRS, r, 0, h), pack_acc<0>(lak), x2); x2 = MFMA32(rd_perm(Tm, TRS, r, 16, h), pack_acc<1>(lak), x2);
                const bf16x8 xf0 = pack_acc<0>(x2), xf1 = pack_acc<1>(x2);
#pragma unroll
                for (int b = 0; b < 2; ++b) { f32x16 qm;
#pragma unroll
                    for (int g = 0; g < 4; ++g) { const u32x2 kk2 = *(const LAS u32x2*)(iKHT + (32 * b + r) * TRS + 8 * g + 4 * h);
                        qm[4 * g] = bflo(kk2.x); qm[4 * g + 1] = bfhi(kk2.x); qm[4 * g + 2] = bflo(kk2.y); qm[4 * g + 3] = bfhi(kk2.y); }
                    qm = MFMA32(xf0, rd_perm(iBHT, TRS, 32 * b + r, 0, h), qm); qm = MFMA32(xf1, rd_perm(iBHT, TRS, 32 * b + r, 16, h), qm);
                    fqm[(b * 2 + 0) * 64 + lane] = pack_acc<0>(qm); fqm[(b * 2 + 1) * 64 + lane] = pack_acc<1>(qm); }
                f32x16 gy;
#pragma unroll
                for (int i = 0; i < 16; ++i) gy[i] = cnrk[i * 64 + lane];
                gy = MFMA32(xf0, fnrb[lane], gy); gy = MFMA32(xf1, fnrb[64 + lane], gy);
                const bf16x8 gf0 = pack_acc<0>(gy), gf1 = pack_acc<1>(gy);
#pragma unroll
                for (int vh = 0; vh < 2; ++vh) { f32x16 yv = zero16();
                    yv = MFMA32(rd_perm(iVT, TRS, 32 * vh + r, 0, h), gf0, yv); yv = MFMA32(rd_perm(iVT, TRS, 32 * vh + r, 16, h), gf1, yv);
                    bf16x8* dy = (bf16x8*)YVT + ((size_t)(chunk * 2 + vh) * 64 + lane) * 2;
                    dy[0] = pack_acc<0>(yv); dy[1] = pack_acc<1>(yv); }
            } };
            st4();
#if MK_DUP & 8
            asm volatile("" ::: "memory"); st4();
#endif
            lds_barrier();
            if (w4 == 3) {
#pragma unroll
                for (int b = 0; b < 2; ++b)
#pragma unroll
                    for (int vh = 0; vh < 2; ++vh) { f32x16 zv = zero16();
                        zv = MFMA32(fqm[(b * 2 + 0) * 64 + lane], rd_perm(iVT, TRS, 32 * vh + r, 0, h), zv); zv = MFMA32(fqm[(b * 2 + 1) * 64 + lane], rd_perm(iVT, TRS, 32 * vh + r, 16, h), zv);
                        f32x4* dz = ZV + (((size_t)(chunk * 2 + b) * 2 + vh) * 64 + lane) * 4;
#pragma unroll
                        for (int g = 0; g < 4; ++g) dz[g] = (f32x4){zv[4 * g], zv[4 * g + 1], zv[4 * g + 2], zv[4 * g + 3]}; }
            }
        }
    }
#undef S1_LOAD
#undef LW_LOAD
}
constexpr int WRS = 68, WTS = 36;
constexpr int WL_A = 0, WL_B = 4352, WL_K = 8704, WL_R = 13056, WL_AT = 17408, WL_BHT = 22016, WL_KHT = 26624, WL_VT = 31232, WL_SIZE = 35840, WL_LA = 4 * WL_SIZE;
static_assert(WL_LA + 32 * LAS_STRIDE * 2 <= MISC_OFF, "wave-per-chunk LDS map");
__device__ __forceinline__ bf16x8 rd_nat2(const LAS bf16* img, int stride, int row, int k0) {
    const u32x2 lo = *(const LAS u32x2*)(img + row * stride + k0), hi = *(const LAS u32x2*)(img + row * stride + k0 + 4);
    u32x4 w; w.x = lo.x; w.y = lo.y; w.z = hi.x; w.w = hi.y; return __builtin_bit_cast(bf16x8, w);
}
__device__ __forceinline__ void phase4a_wave(const Frame& F) {
    const bf16* P = wsp<bf16>(F, WS_P); const bf16* LW = wsp<bf16>(F, WS_LW);
    const float* mu = F.in[6]; const float* w0 = F.in[7]; const float* a0 = F.in[9]; const float* k_k = F.in[12]; const float* k_a = F.in[13]; const float* r_k = F.in[14];
    float* SV = wsp<float>(F, WS_SV); bf16* G = wsp<bf16>(F, WS_G); float* BON = wsp<float>(F, WS_BONUS);
    bf16x8* PT = wsp<bf16x8>(F, WS_PT); f32x4* ZV = wsp<f32x4>(F, WS_ZV); bf16x8* RYT = wsp<bf16x8>(F, WS_RYT); f32x4* YVT = wsp<f32x4>(F, WS_YVT);
    const int wv_ = F.wave & 3;
    LAS unsigned char* gl = F.lds + wv_ * WL_SIZE;
    LAS bf16* iA = (LAS bf16*)(gl + WL_A); LAS bf16* iB = (LAS bf16*)(gl + WL_B); LAS bf16* iK = (LAS bf16*)(gl + WL_K); LAS bf16* iR = (LAS bf16*)(gl + WL_R);
    LAS bf16* iAT = (LAS bf16*)(gl + WL_AT); LAS bf16* iBHT = (LAS bf16*)(gl + WL_BHT); LAS bf16* iKHT = (LAS bf16*)(gl + WL_KHT); LAS bf16* iVT = (LAS bf16*)(gl + WL_VT);
    LAS bf16* imgL = iA; LAS bf16* Tm = iB;
    LAS bf16* LA = (LAS bf16*)(F.lds + WL_LA);
    for (int tc = F.vcu; tc < M / CK; tc += F.G) {
        const int b = tc / NCHK, c = tc % NCHK, t0 = c * CK, row0 = b * T + t0;
        lds_barrier();
        { const int tk = F.tid >> 4, cb = (F.tid & 15) * 16; float x[8];
#pragma unroll
            for (int q8 = 0; q8 < 2; ++q8) { const int col = cb + 8 * q8; lerp8(P, mu, row0 + tk, t0 + tk, 1536 + col, x);
                if (col < 64) {
#pragma unroll
                    for (int j = 0; j < 8; ++j) x[j] = 2.f * sigmoidf_(2.f * x[j]) - 1.f; }
                else if (col >= 128) {
#pragma unroll
                    for (int j = 0; j < 8; ++j) x[j] = sigmoidf_(x[j]); }
                *(LAS bf16x8*)(LA + tk * LAS_STRIDE + col) = pack8(x); } }
        lds_barrier();
        if (F.wave < 4) {
#pragma unroll 1
        for (int rnd = 0; rnd < 2; ++rnd) {
            int lane = F.lane; asm volatile("" : "+v"(lane));
            const int r = lane & 31, h = lane >> 5;
            const int hh = wv_ + 4 * rnd, bh = b * RH + hh, chunk = bh * NCHK + c, cc = hh * 64 + lane;
            f32x16 aw[2], aa[2];
#pragma unroll
            for (int ct = 0; ct < 2; ++ct) { const bf16* lw = LW + (size_t)(hh * 64 + 32 * ct + r) * 256 + 8 * h;
                { bf16x8 bf_[8];
#pragma unroll
                    for (int ks = 0; ks < 8; ++ks) bf_[ks] = *(const bf16x8*)(lw + 128 + 16 * ks);
                    f32x16 g_ = zero16();
#pragma unroll
                    for (int ks = 0; ks < 8; ++ks) g_ = MFMA32(rd_nat(LA, LAS_STRIDE, r, 128 + 16 * ks + 8 * h), bf_[ks], g_);
#pragma unroll
                    for (int i = 0; i < 16; ++i) if (MK_WMASK & 1) G[(size_t)(row0 + crow(i, h)) * 512 + hh * 64 + 32 * ct + r] = (bf16)f2bf(g_[i]); }
                { bf16x8 bf_[8];
#pragma unroll
                    for (int ks = 0; ks < 8; ++ks) bf_[ks] = *(const bf16x8*)(lw + 16 * ks);
                    f32x16 w_ = zero16(), a_ = zero16();
#pragma unroll
                    for (int ks = 0; ks < 4; ++ks) { w_ = MFMA32(rd_nat(LA, LAS_STRIDE, r, 16 * ks + 8 * h), bf_[ks], w_); a_ = MFMA32(rd_nat(LA, LAS_STRIDE, r, 64 + 16 * ks + 8 * h), bf_[4 + ks], a_); }
                    aw[ct] = w_; aa[ct] = a_; } }
            f32x16 wo, wr_, ao, ar_;
#pragma unroll
            for (int i = 0; i < 16; ++i) { wo[i] = h ? aw[1][i] : aw[0][i]; ao[i] = h ? aa[1][i] : aa[0][i];
                wr_[i] = __shfl_xor(h ? aw[0][i] : aw[1][i], 32); ar_[i] = __shfl_xor(h ? aa[0][i] : aa[1][i], 32); }
            const float mur = mu[cc], muk = mu[512 + cc], muv = mu[1024 + cc], w0c = w0[cc], a0c = a0[cc], kkc = k_k[cc], kac = k_a[cc], rkc = r_k[cc];
            float gam[32];
#pragma unroll
            for (int t = 0; t < 32; ++t) { const int i = (t & 3) + 4 * (t >> 3); const float wl = (((t >> 2) & 1) == h) ? wo[i] : wr_[i];
                const float dec = __expf(-0.60653066f * sigmoidf_(w0c + wl)); gam[t] = t ? gam[t - 1] * dec : dec; }
            const float gC = gam[31];
            const size_t pbase = (size_t)row0 * IN_COLS + cc;
            bf16 pr_ = 0, pk_ = 0, pv_ = 0;
            if (t0 > 0) { pr_ = P[pbase - IN_COLS]; pk_ = P[pbase - IN_COLS + 512]; pv_ = P[pbase - IN_COLS + 1024]; }
#pragma unroll
            for (int tb = 0; tb < 4; ++tb) {
                asm volatile("" ::: "memory");
                bf16 cr[8], ck[8], cv[8];
#pragma unroll
                for (int i = 0; i < 8; ++i) { const size_t o = pbase + (size_t)(8 * tb + i) * IN_COLS; cr[i] = P[o]; ck[i] = P[o + 512]; cv[i] = P[o + 1024]; }
                float rv[8], vv[8], kk[8], ssq[8], bo[8], av[8], kv[8];
#pragma unroll
                for (int i = 0; i < 8; ++i) { const int t = 8 * tb + i, ii = (t & 3) + 4 * (t >> 3);
                    const float c_r = bf2f(cr[i]), c_k = bf2f(ck[i]), c_v = bf2f(cv[i]);
                    const float p_r = bf2f(i ? cr[i - 1] : pr_), p_k = bf2f(i ? ck[i - 1] : pk_), p_v = bf2f(i ? cv[i - 1] : pv_);
                    rv[i] = c_r + (p_r - c_r) * mur; const float kr = c_k + (p_k - c_k) * muk; vv[i] = c_v + (p_v - c_v) * muv;
                    const float al = (((t >> 2) & 1) == h) ? ao[ii] : ar_[ii];
                    av[i] = sigmoidf_(a0c + al);
                    kk[i] = kr * kkc; ssq[i] = kk[i] * kk[i]; kv[i] = kr * (1.f + (av[i] - 1.f) * kac); bo[i] = rv[i] * kv[i] * rkc; }
                pr_ = cr[7]; pk_ = ck[7]; pv_ = cv[7];
#pragma unroll
                for (int i = 0; i < 8; ++i) { ssq[i] = reduce16(ssq[i]); bo[i] = reduce16(bo[i]); }
#pragma unroll
                for (int i = 0; i < 8; ++i) { ssq[i] += __shfl_xor(ssq[i], 16); bo[i] += __shfl_xor(bo[i], 16); }
#pragma unroll
                for (int i = 0; i < 8; ++i) { ssq[i] += __shfl_xor(ssq[i], 32); bo[i] += __shfl_xor(bo[i], 32); }
                float at[8], bh8[8], kh8[8];
#pragma unroll
                for (int i = 0; i < 8; ++i) { const int t = 8 * tb + i;
                    const float kkn = kk[i] * __builtin_amdgcn_rcpf(fmaxf(sqrtf(ssq[i]), 1e-12f)), bb = kkn * av[i];
                    const float g = gam[t], gp = t ? gam[t - 1] : 1.f, ig = __builtin_amdgcn_rcpf(g);
                    const float bt = bb * ig, kt = kv[i] * ig; at[i] = -kkn * gp; bh8[i] = bt * gC; kh8[i] = kt * gC;
                    const int ro = t * WRS + lane;
                    iA[ro] = (bf16)f2bf(at[i]); iB[ro] = (bf16)f2bf(bt); iK[ro] = (bf16)f2bf(kt); iR[ro] = (bf16)f2bf(rv[i] * g);
                    if (MK_WMASK & 2) { ((bf16*)SV)[((size_t)bh * T + t0 + t) * 64 + lane] = (bf16)f2bf(vv[i]);
                    if (lane == 0) BON[(row0 + t) * 8 + hh] = bo[i]; } }
#pragma unroll
                for (int q = 0; q < 2; ++q) { u32x2 w;
                    w.x = pk2(at[4 * q], at[4 * q + 1]); w.y = pk2(at[4 * q + 2], at[4 * q + 3]); *(LAS u32x2*)(iAT + lane * WTS + 8 * tb + 4 * q) = w;
                    w.x = pk2(bh8[4 * q], bh8[4 * q + 1]); w.y = pk2(bh8[4 * q + 2], bh8[4 * q + 3]); *(LAS u32x2*)(iBHT + lane * WTS + 8 * tb + 4 * q) = w;
                    w.x = pk2(kh8[4 * q], kh8[4 * q + 1]); w.y = pk2(kh8[4 * q + 2], kh8[4 * q + 3]); *(LAS u32x2*)(iKHT + lane * WTS + 8 * tb + 4 * q) = w;
                    w.x = pk2(vv[4 * q], vv[4 * q + 1]); w.y = pk2(vv[4 * q + 2], vv[4 * q + 3]); *(LAS u32x2*)(iVT + lane * WTS + 8 * tb + 4 * q) = w; }
            }
            asm volatile("s_waitcnt lgkmcnt(0)" ::: "memory");
            f32x16 lab = zero16(), lak = zero16(), nrb = zero16(), nrk = zero16();
#pragma unroll
            for (int ks = 0; ks < 4; ++ks) { const bf16x8 fa = rd_nat2(iA, WRS, r, 16 * ks + 8 * h), fb = rd_nat2(iB, WRS, r, 16 * ks + 8 * h), fk = rd_nat2(iK, WRS, r, 16 * ks + 8 * h), fr_ = rd_nat2(iR, WRS, r, 16 * ks + 8 * h);
                lab = MFMA32(fa, fb, lab); lak = MFMA32(fa, fk, lak); nrb = MFMA32(fb, fr_, nrb); nrk = MFMA32(fk, fr_, nrk); }
#pragma unroll
            for (int i = 0; i < 16; ++i) { const int row = crow(i, h); lab[i] = (r < row) ? lab[i] : 0.f; lak[i] = (r < row) ? lak[i] : 0.f; nrb[i] = (row <= r) ? nrb[i] : 0.f; nrk[i] = (row <= r) ? nrk[i] : 0.f; }
            const bf16x8 fn0 = pack_acc<0>(nrb), fn1 = pack_acc<1>(nrb);
            asm volatile("s_waitcnt lgkmcnt(0)" ::: "memory");
            { f32x16 Lp = lab, Tq = lab;
#pragma unroll
                for (int i = 0; i < 16; ++i) Tq[i] += (crow(i, h) == r) ? 1.f : 0.f;
#pragma unroll
                for (int st = 0; st < 4; ++st) {
#pragma unroll
                    for (int i = 0; i < 16; ++i) { imgL[crow(i, h) * WTS + r] = (bf16)f2bf(Lp[i]); Tm[crow(i, h) * WTS + r] = (bf16)f2bf(Tq[i]); }
                    asm volatile("s_waitcnt lgkmcnt(0)" ::: "memory");
                    const bf16x8 b0 = pack_acc<0>(Lp), b1 = pack_acc<1>(Lp);
                    f32x16 l2 = zero16(); l2 = MFMA32(rd_perm(imgL, WTS, r, 0, h), b0, l2); l2 = MFMA32(rd_perm(imgL, WTS, r, 16, h), b1, l2);
                    Lp = l2;
                    f32x16 mm = l2;
#pragma unroll
                    for (int i = 0; i < 16; ++i) mm[i] += (crow(i, h) == r) ? 1.f : 0.f;
                    const bf16x8 m0 = pack_acc<0>(mm), m1 = pack_acc<1>(mm);
                    f32x16 t2 = zero16(); t2 = MFMA32(rd_perm(Tm, WTS, r, 0, h), m0, t2); t2 = MFMA32(rd_perm(Tm, WTS, r, 16, h), m1, t2);
                    Tq = t2;
                    asm volatile("s_waitcnt lgkmcnt(0)" ::: "memory"); }
#pragma unroll
                for (int i = 0; i < 16; ++i) Tm[crow(i, h) * WTS + r] = (bf16)f2bf(Tq[i]);
                asm volatile("s_waitcnt lgkmcnt(0)" ::: "memory"); }
            const float gcd2[2] = {__shfl(gC, r), __shfl(gC, 32 + r)};
#pragma unroll
            for (int a = 0; a < 2; ++a) { f32x16 x1 = zero16();
#pragma unroll
                for (int ks = 0; ks < 2; ++ks) x1 = MFMA32(rd_nat2(Tm, WTS, r, 16 * ks + 8 * h), rd_nat2(iAT, WTS, 32 * a + r, 16 * ks + 8 * h), x1);
                const bf16x8 xf0 = pack_acc<0>(x1), xf1 = pack_acc<1>(x1);
#pragma unroll
                for (int b2 = 0; b2 < 2; ++b2) { f32x16 p = zero16();
                    p = MFMA32(xf0, rd_perm(iBHT, WTS, 32 * b2 + r, 0, h), p); p = MFMA32(xf1, rd_perm(iBHT, WTS, 32 * b2 + r, 16, h), p);
                    if (a == b2) { const float gcd = gcd2[a];
#pragma unroll
                        for (int i = 0; i < 16; ++i) p[i] += (crow(i, h) == r) ? gcd : 0.f; }
                    bf16x8* dst = PT + ((size_t)(chunk * 2 + a) * 2 + b2) * 2 * 64 + lane; if (MK_WMASK & 4) { dst[0] = pack_acc<0>(p); dst[64] = pack_acc<1>(p); } }
                f32x16 ry;
#pragma unroll
                for (int g = 0; g < 4; ++g) { const u32x2 rr = *(const LAS u32x2*)(iR + r * WRS + 32 * a + 8 * g + 4 * h);
                    ry[4 * g] = bflo(rr.x); ry[4 * g + 1] = bfhi(rr.x); ry[4 * g + 2] = bflo(rr.y); ry[4 * g + 3] = bfhi(rr.y); }
                ry = MFMA32(xf0, fn0, ry); ry = MFMA32(xf1, fn1, ry);
                bf16x8* dr = RYT + (size_t)(chunk * 2 + a) * 2 * 64 + lane; if (MK_WMASK & 8) { dr[0] = pack_acc<0>(ry); dr[64] = pack_acc<1>(ry); } }
            { f32x16 x2 = zero16();
                x2 = MFMA32(rd_perm(Tm, WTS, r, 0, h), pack_acc<0>(lak), x2); x2 = MFMA32(rd_perm(Tm, WTS, r, 16, h), pack_acc<1>(lak), x2);
                const bf16x8 xf0 = pack_acc<0>(x2), xf1 = pack_acc<1>(x2);
                bf16x8 fq[2][2];
#pragma unroll
                for (int b2 = 0; b2 < 2; ++b2) { f32x16 qm;
#pragma unroll
                    for (int g = 0; g < 4; ++g) { const u32x2 kk2 = *(const LAS u32x2*)(iKHT + (32 * b2 + r) * WTS + 8 * g + 4 * h);
                        qm[4 * g] = bflo(kk2.x); qm[4 * g + 1] = bfhi(kk2.x); qm[4 * g + 2] = bflo(kk2.y); qm[4 * g + 3] = bfhi(kk2.y); }
                    qm = MFMA32(xf0, rd_perm(iBHT, WTS, 32 * b2 + r, 0, h), qm); qm = MFMA32(xf1, rd_perm(iBHT, WTS, 32 * b2 + r, 16, h), qm);
                    fq[b2][0] = pack_acc<0>(qm); fq[b2][1] = pack_acc<1>(qm); }
                f32x16 gy = nrk;
                gy = MFMA32(xf0, fn0, gy); gy = MFMA32(xf1, fn1, gy);
                const bf16x8 gf0 = pack_acc<0>(gy), gf1 = pack_acc<1>(gy);
#pragma unroll
                for (int vh = 0; vh < 2; ++vh) { f32x16 yv = zero16();
                    yv = MFMA32(rd_perm(iVT, WTS, 32 * vh + r, 0, h), gf0, yv); yv = MFMA32(rd_perm(iVT, WTS, 32 * vh + r, 16, h), gf1, yv);
                    bf16x8* dy = (bf16x8*)YVT + ((size_t)(chunk * 2 + vh) * 64 + lane) * 2;
                    if (MK_WMASK & 16) { dy[0] = pack_acc<0>(yv); dy[1] = pack_acc<1>(yv); } }
#pragma unroll
                for (int b2 = 0; b2 < 2; ++b2)
#pragma unroll
                    for (int vh = 0; vh < 2; ++vh) { f32x16 zv = zero16();
                        zv = MFMA32(fq[b2][0], rd_perm(iVT, WTS, 32 * vh + r, 0, h), zv); zv = MFMA32(fq[b2][1], rd_perm(iVT, WTS, 32 * vh + r, 16, h), zv);
                        f32x4* dz = ZV + (((size_t)(chunk * 2 + b2) * 2 + vh) * 64 + lane) * 4;
#pragma unroll
                        for (int g = 0; g < 4; ++g) if (MK_WMASK & 32) dz[g] = (f32x4){zv[4 * g], zv[4 * g + 1], zv[4 * g + 2], zv[4 * g + 3]}; } }
            asm volatile("s_waitcnt lgkmcnt(0)" ::: "memory");
        }
        }
    }
}

constexpr int SB_SLOT = 16384, SB_NSLOT = 7, SB_FLAGS = SB_NSLOT * SB_SLOT;
constexpr int CONV_4B = MK_CONV_WHERE == 9 ? 6144 : 0;
__device__ __forceinline__ void phase4b_states(const Frame& F) {
    volatile LAS unsigned* FULL = (volatile LAS unsigned*)(F.lds + SB_FLAGS);
    volatile LAS unsigned* DONEC = (volatile LAS unsigned*)(F.lds + SB_FLAGS + 64);
    __syncthreads();
    if (F.tid < 32) ((LAS unsigned*)(F.lds + SB_FLAGS))[F.tid] = 0u;
    __syncthreads();
    if (F.vcu < 128) {
        const int bh = F.vcu >> 1, vh = F.vcu & 1, lane = F.lane;
        if (F.wave == 0) {
            bf16x8* Z0 = wsp<bf16x8>(F, WS_Z0);
            f32x16 z0 = zero16(), z1 = zero16();
            int slot = 0;
            for (int c = 0; c < NCHK; ++c) { const int chunk = bh * NCHK + c;
                const bf16x8 f00 = pack_acc<0>(z0), f01 = pack_acc<1>(z0), f10 = pack_acc<0>(z1), f11 = pack_acc<1>(z1);
                bf16x8* dz = Z0 + (size_t)(chunk * 2 + vh) * 4 * 64 + lane; dz[0] = f00; dz[64] = f01; dz[128] = f10; dz[192] = f11;
                { int sp = 0; while (FULL[slot] < (unsigned)(c + 1)) { if (++sp > SC_SPIN_CAP) break; } }
                __builtin_amdgcn_fence(__ATOMIC_ACQUIRE, "workgroup");
                const LAS unsigned char* sb = F.lds + slot * SB_SLOT;
                const LAS bf16x8* p = (const LAS bf16x8*)sb + lane;
                const LAS f32x4* s0 = (const LAS f32x4*)(sb + 8192) + lane * 4; const LAS f32x4* s1 = (const LAS f32x4*)(sb + 12288) + lane * 4;
                f32x16 n0, n1;
#pragma unroll
                for (int g = 0; g < 4; ++g) { const f32x4 u = s0[g], w = s1[g]; n0[4 * g] = u[0]; n0[4 * g + 1] = u[1]; n0[4 * g + 2] = u[2]; n0[4 * g + 3] = u[3]; n1[4 * g] = w[0]; n1[4 * g + 1] = w[1]; n1[4 * g + 2] = w[2]; n1[4 * g + 3] = w[3]; }
                const bf16x8 p000 = p[0 * 64], p001 = p[1 * 64], p010 = p[2 * 64], p011 = p[3 * 64], p100 = p[4 * 64], p101 = p[5 * 64], p110 = p[6 * 64], p111 = p[7 * 64];
                asm volatile("s_waitcnt lgkmcnt(0)" ::: "memory");
                if (lane == 0) DONEC[0] = (unsigned)(c + 1);
                n0 = MFMA32(p000, f00, n0); n0 = MFMA32(p001, f01, n0); n0 = MFMA32(p100, f10, n0); n0 = MFMA32(p101, f11, n0);
                n1 = MFMA32(p010, f00, n1); n1 = MFMA32(p011, f01, n1); n1 = MFMA32(p110, f10, n1); n1 = MFMA32(p111, f11, n1);
                z0 = n0; z1 = n1;
                slot = (slot + 1 == SB_NSLOT) ? 0 : slot + 1; }
        } else {
            const int slot = F.wave - 1;
            const unsigned char* gpt = (const unsigned char*)wsp<bf16x8>(F, WS_PT) + lane * 16;
            const unsigned char* gzv = (const unsigned char*)wsp<f32x4>(F, WS_ZV) + lane * 16;
            LAS unsigned char* dst = F.lds + slot * SB_SLOT;
            for (int c = slot; c < NCHK; c += SB_NSLOT) { const int chunk = bh * NCHK + c;
                if (c >= SB_NSLOT) { const unsigned need = (unsigned)(c - SB_NSLOT + 1); int sp = 0;
                    while (DONEC[0] < need) { __builtin_amdgcn_s_sleep(1); if (++sp > SC_SPIN_CAP) break; }
                    __builtin_amdgcn_fence(__ATOMIC_ACQUIRE, "workgroup"); }
                const unsigned char* sp_ = gpt + (size_t)chunk * 8192;
#pragma unroll
                for (int j = 0; j < 8; ++j) __builtin_amdgcn_global_load_lds((const unsigned*)(sp_ + j * 1024), (LAS unsigned*)(dst + j * 1024), 16, 0, 0);
                const unsigned char* sz0 = gzv + ((size_t)(chunk * 2 + 0) * 2 + vh) * 4096; const unsigned char* sz1 = gzv + ((size_t)(chunk * 2 + 1) * 2 + vh) * 4096;
#pragma unroll
                for (int j = 0; j < 4; ++j) { __builtin_amdgcn_global_load_lds((const unsigned*)(sz0 + j * 1024), (LAS unsigned*)(dst + 8192 + j * 1024), 16, 0, 0);
                    __builtin_amdgcn_global_load_lds((const unsigned*)(sz1 + j * 1024), (LAS unsigned*)(dst + 12288 + j * 1024), 16, 0, 0); }
                asm volatile("s_waitcnt vmcnt(0)" ::: "memory");
                if (lane == 0) FULL[slot] = (unsigned)(c + 1); }
        }
    } else {
        for (int it = (F.vcu - 128) * 8 + F.wave; it < CONV_4B; it += 128 * 8) moe_weight_item(F, it);
    }
    __syncthreads();
}

__device__ __forceinline__ void phase4c_output(const Frame& F) {
    const bf16x8* Z0 = wsp<bf16x8>(F, WS_Z0); const bf16x8* RYT = wsp<bf16x8>(F, WS_RYT); const f32x4* YVT = wsp<f32x4>(F, WS_YVT);
    const float* SV = wsp<float>(F, WS_SV); const bf16* G = wsp<bf16>(F, WS_G); const float* BON = wsp<float>(F, WS_BONUS); bf16* CAT = wsp<bf16>(F, WS_CAT);
    const float* lg = F.in[15]; const float* lb = F.in[16];
    const int gw = F.vcu * 8 + F.wave, NGW = F.G * 8, lane = F.lane, r = lane & 31, h = lane >> 5;
    for (int chunk = gw; chunk < NBATCH * RH * NCHK; chunk += NGW) {
        const int bh = chunk / NCHK, c = chunk % NCHK, b = bh / RH, hh = bh % RH, t = c * CK + r, row = b * T + t;
        bf16x8 rf[4], zf[2][4]; u32x4 yv[2][2]; u32x2 vv[2][4], gr[2][4];
#pragma unroll
        for (int q = 0; q < 4; ++q) rf[q] = __builtin_nontemporal_load(RYT + (size_t)chunk * 4 * 64 + lane + q * 64);
#pragma unroll
        for (int vh = 0; vh < 2; ++vh)
#pragma unroll
            for (int q = 0; q < 4; ++q) { if (q < 2) yv[vh][q] = __builtin_nontemporal_load((const u32x4*)YVT + ((size_t)(chunk * 2 + vh) * 64 + lane) * 2 + q);
                zf[vh][q] = __builtin_nontemporal_load(Z0 + (size_t)(chunk * 2 + vh) * 4 * 64 + lane + q * 64); }
        const float bon = BON[row * 8 + hh];
#pragma unroll
        for (int vh = 0; vh < 2; ++vh)
#pragma unroll
            for (int g = 0; g < 4; ++g) { const int v0 = 32 * vh + 8 * g + 4 * h, c0 = hh * 64 + v0;
                vv[vh][g] = __builtin_nontemporal_load((const u32x2*)((const bf16*)SV + ((size_t)bh * T + t) * 64 + v0));
                gr[vh][g] = __builtin_nontemporal_load((const u32x2*)(G + (size_t)row * 512 + c0)); }
        f32x16 y[2];
#pragma unroll
        for (int vh = 0; vh < 2; ++vh) {
#pragma unroll
            for (int q = 0; q < 2; ++q) { const u32x4 u = yv[vh][q]; y[vh][8 * q] = bflo(u.x); y[vh][8 * q + 1] = bfhi(u.x); y[vh][8 * q + 2] = bflo(u.y); y[vh][8 * q + 3] = bfhi(u.y);
                y[vh][8 * q + 4] = bflo(u.z); y[vh][8 * q + 5] = bfhi(u.z); y[vh][8 * q + 6] = bflo(u.w); y[vh][8 * q + 7] = bfhi(u.w); }
#pragma unroll
            for (int q = 0; q < 4; ++q) y[vh] = MFMA32(zf[vh][q], rf[q], y[vh]); }
        float sm = 0.f;
#pragma unroll
        for (int vh = 0; vh < 2; ++vh)
#pragma unroll
            for (int i = 0; i < 16; ++i) sm += y[vh][i];
        sm += __shfl_xor(sm, 32);
        const float mean = sm * (1.f / 64.f); float qv = 0.f;
#pragma unroll
        for (int vh = 0; vh < 2; ++vh)
#pragma unroll
            for (int i = 0; i < 16; ++i) { y[vh][i] -= mean; qv += y[vh][i] * y[vh][i]; }
        qv += __shfl_xor(qv, 32);
        const float rstd = rsqrtf(qv * (1.f / 64.f) + GN_EPS);
#pragma unroll
        for (int vh = 0; vh < 2; ++vh)
#pragma unroll
            for (int g = 0; g < 4; ++g) { const int v0 = 32 * vh + 8 * g + 4 * h, c0 = hh * 64 + v0;
                const f32x4 lg4 = *(const f32x4*)(lg + c0), lb4 = *(const f32x4*)(lb + c0);
                const float gg[4] = {bflo(gr[vh][g].x), bfhi(gr[vh][g].x), bflo(gr[vh][g].y), bfhi(gr[vh][g].y)}; float o[4];
                const float vf[4] = {bflo(vv[vh][g].x), bfhi(vv[vh][g].x), bflo(vv[vh][g].y), bfhi(vv[vh][g].y)};
#pragma unroll
                for (int q = 0; q < 4; ++q) o[q] = (y[vh][4 * g + q] * rstd * lg4[q] + lb4[q] + bon * vf[q]) * gg[q];
                u32x2 w; w.x = pk2(o[0], o[1]); w.y = pk2(o[2], o[3]);
                *(u32x2*)(CAT + (size_t)row * D + c0) = w; }
    }
}

constexpr int SC_STEPS = 16, SC_NSLOT = 6, SC_SHARED = SC_STEPS * 1280, SC_SLOT = SC_SHARED + SC_STEPS * 64, SC_RING = SC_NSLOT * SC_SLOT;
constexpr int SC_FLAGS = SC_RING, SC_CONV = SC_RING + 256, SC_NCH = T / SC_STEPS;
static_assert(SC_CONV + 3 * 8704 <= LDS_BYTES, "scan LDS map");
__device__ __forceinline__ void phase4_scan(const Frame& F) {
    volatile LAS unsigned* READY = (volatile LAS unsigned*)(F.lds + SC_FLAGS);
    volatile LAS unsigned* DONE = (volatile LAS unsigned*)(F.lds + SC_FLAGS + 64);
    __syncthreads();
    if (F.tid < 64) ((LAS unsigned*)(F.lds + SC_FLAGS))[F.tid] = 0u;
    __syncthreads();
    const int bh = F.vcu >> 2, rg = F.vcu & 3, b = bh / RH, hh = bh % RH;
    if (F.wave < 4) {
        const int rl = F.lane >> 4, ks = F.lane & 15, rowl = F.wave * 4 + rl;
        float* yp = wsp<float>(F, WS_Y) + (size_t)b * T * 512 + hh * 64 + rg * 16 + rowl;
        f32x4 S = (f32x4){0.f, 0.f, 0.f, 0.f};
        int slot = 0;
        for (int c = 0; c < SC_NCH; ++c) {
#if MK_RWKV_MODE == 1
            if ((c & 1) == 0) {
                const int v = rg * 16 + rowl, chunk = bh * NCHK + (c >> 1);
                const bf16* zp = wsp<bf16>(F, WS_Z0) + ((((size_t)chunk * 2 + (v >> 5)) * 2 + (ks >> 3)) * 2 + ((ks >> 2) & 1)) * 512 + ((v & 31) + 32 * (ks & 1)) * 8 + 4 * ((ks >> 1) & 1);
                const u32x2 zz = *(const u32x2*)zp;
                S = (f32x4){bflo(zz.x), bfhi(zz.x), bflo(zz.y), bfhi(zz.y)}; }
#endif
            { int sp = 0; while (READY[slot] < (unsigned)(c + 1)) { if (++sp > SC_SPIN_CAP) break; } }
            __builtin_amdgcn_fence(__ATOMIC_ACQUIRE, "workgroup");
            const LAS unsigned char* sb = F.lds + slot * SC_SLOT;
            const LAS unsigned char* op = sb + ks * 16; const LAS float* vp = (const LAS float*)(sb + SC_SHARED) + rowl;
            f32x4 w4 = *(const LAS f32x4*)(op), kk4 = *(const LAS f32x4*)(op + 256), b4 = *(const LAS f32x4*)(op + 512), k4 = *(const LAS f32x4*)(op + 768), r4 = *(const LAS f32x4*)(op + 1024);
            float v = vp[0];
            float ykeep = 0.f;
#pragma unroll
            for (int s = 0; s < SC_STEPS; ++s) {
                const f32x4 cw = w4, ckk = kk4, cb = b4, ck = k4, cr = r4; const float cv = v;
                if (s + 1 < SC_STEPS) { const LAS unsigned char* o2 = op + (s + 1) * 1280;
                    w4 = *(const LAS f32x4*)(o2); kk4 = *(const LAS f32x4*)(o2 + 256); b4 = *(const LAS f32x4*)(o2 + 512); k4 = *(const LAS f32x4*)(o2 + 768); r4 = *(const LAS f32x4*)(o2 + 1024);
                    v = vp[(s + 1) * 16]; }
                if (s == SC_STEPS - 1) { asm volatile("s_waitcnt lgkmcnt(0)" ::: "memory"); if (F.lane == 0) DONE[F.wave] = (unsigned)(c + 1); }
                float p = (S[0] * ckk[0] + S[1] * ckk[1]) + (S[2] * ckk[2] + S[3] * ckk[3]);
                p = reduce16(p);
                const f32x4 tt = S * cw + ck * cv;
                S = tt - cb * p;
                float q = (S[0] * cr[0] + S[1] * cr[1]) + (S[2] * cr[2] + S[3] * cr[3]);
                q = reduce16(q);
                ykeep = (ks == s) ? q : ykeep;
            }
            yp[(size_t)(c * SC_STEPS + ks) * 512] = ykeep;
            slot = (slot + 1 == SC_NSLOT) ? 0 : slot + 1;
        }
    } else if (F.wave == 4) {
        const unsigned char* gs = (const unsigned char*)(wsp<float>(F, WS_SCN) + (size_t)bh * T * 320) + F.lane * 16;
        const unsigned char* gv = (const unsigned char*)(wsp<float>(F, WS_SV) + (size_t)bh * T * 64 + (F.lane >> 2) * 64 + rg * 16 + (F.lane & 3) * 4);
        int slot = 0;
        for (int c = 0; c < SC_NCH; ++c) {
            if (c >= SC_NSLOT) { const unsigned need = (unsigned)(c - SC_NSLOT + 1); int sp = 0;
                while (DONE[0] < need || DONE[1] < need || DONE[2] < need || DONE[3] < need) { __builtin_amdgcn_s_sleep(1); if (++sp > SC_SPIN_CAP) break; }
                __builtin_amdgcn_fence(__ATOMIC_ACQUIRE, "workgroup"); }
            LAS unsigned char* dst = F.lds + slot * SC_SLOT;
            const unsigned char* src = gs + (size_t)c * SC_SHARED;
#pragma unroll
            for (int j = 0; j < SC_SHARED / 1024; ++j) __builtin_amdgcn_global_load_lds((const unsigned*)(src + j * 1024), (LAS unsigned*)(dst + j * 1024), 16, 0, 0);
            __builtin_amdgcn_global_load_lds((const unsigned*)(gv + (size_t)c * SC_STEPS * 256), (LAS unsigned*)(dst + SC_SHARED), 16, 0, 0);
            if (c >= 2) { asm volatile("s_waitcnt vmcnt(42)" ::: "memory"); const int ps = (slot >= 2) ? slot - 2 : slot + SC_NSLOT - 2; if (F.lane == 0) READY[ps] = (unsigned)(c - 1); }
            slot = (slot + 1 == SC_NSLOT) ? 0 : slot + 1;
        }
        { asm volatile("s_waitcnt vmcnt(21)" ::: "memory"); const int ps = (slot >= 2) ? slot - 2 : slot + SC_NSLOT - 2; if (F.lane == 0) READY[ps] = (unsigned)(SC_NCH - 1); }
        { asm volatile("s_waitcnt vmcnt(0)" ::: "memory"); const int ps = (slot >= 1) ? slot - 1 : SC_NSLOT - 1; if (F.lane == 0) READY[ps] = (unsigned)(SC_NCH); }
    } else {
#if MK_CONV_IN_SCAN
        for (int it = F.vcu * 3 + (F.wave - 5); it < MOE_ITEMS; it += F.G * 3) moe_weight_item(F, it);
#endif
    }
    __syncthreads();
}

constexpr int KLD = 72;
constexpr int VLD = 260;
__device__ __forceinline__ void phase5_attn(const Frame& F) {
    const bf16* P = wsp<bf16>(F, WS_P);
    bf16* CAT = wsp<bf16>(F, WS_CAT);
    const float* qg = F.in[17]; const float* kg = F.in[18]; const float* sinks = F.in[19];
    LAS bf16* Kl = (LAS bf16*)F.lds;
    LAS bf16* Vt = (LAS bf16*)(F.lds + 256 * KLD * 2);
    const int lane = F.lane, r = lane & 31, h = lane >> 5;
    for (int unit = F.vcu; unit < NBATCH * KVH * (T / 128); unit += F.G) {
        const int blk = unit % (T / 128), kvh = (unit / (T / 128)) % KVH, b = unit / (T / 128 * KVH);
        const int kpos0 = blk * 128 - 128;
        __syncthreads();
        for (int ch = F.tid; ch < 2048; ch += 512) { const int key = ch >> 3, dc = ch & 7, kpos = kpos0 + key;
            u32x4 kraw = (u32x4){0u, 0u, 0u, 0u}, vraw = (u32x4){0u, 0u, 0u, 0u};
            if (kpos >= 0) { const size_t ro = (size_t)(b * T + kpos) * IN_COLS; kraw = *(const u32x4*)(P + ro + COL_K + kvh * 64 + dc * 8); vraw = *(const u32x4*)(P + ro + COL_V + kvh * 64 + dc * 8); }
            float kf[8]; kf[0] = bflo(kraw.x); kf[1] = bfhi(kraw.x); kf[2] = bflo(kraw.y); kf[3] = bfhi(kraw.y); kf[4] = bflo(kraw.z); kf[5] = bfhi(kraw.z); kf[6] = bflo(kraw.w); kf[7] = bfhi(kraw.w);
            float ss = 0.f;
#pragma unroll
            for (int j = 0; j < 8; ++j) ss += kf[j] * kf[j];
            ss += __shfl_xor(ss, 1); ss += __shfl_xor(ss, 2); ss += __shfl_xor(ss, 4);
            const float rstd = rsqrtf(ss * (1.f / 64.f) + NORM_EPS);
            const f32x4 g0 = *(const f32x4*)(kg + dc * 8), g1 = *(const f32x4*)(kg + dc * 8 + 4);
            u32x4 ko; ko.x = pk2(kf[0] * rstd * g0[0], kf[1] * rstd * g0[1]); ko.y = pk2(kf[2] * rstd * g0[2], kf[3] * rstd * g0[3]);
            ko.z = pk2(kf[4] * rstd * g1[0], kf[5] * rstd * g1[1]); ko.w = pk2(kf[6] * rstd * g1[2], kf[7] * rstd * g1[3]);
            *(LAS u32x4*)(Kl + key * KLD + dc * 8) = ko;
            const unsigned vv[4] = {vraw.x, vraw.y, vraw.z, vraw.w};
#pragma unroll
            for (int j = 0; j < 4; ++j) { Vt[(dc * 8 + 2 * j) * VLD + key] = (bf16)(vv[j] & 0xffffu); Vt[(dc * 8 + 2 * j + 1) * VLD + key] = (bf16)(vv[j] >> 16); }
        }
        __syncthreads();
        for (int task = F.wave; task < 16; task += 8) {
            const int g = task & 3, qs = task >> 2, head = kvh * 4 + g;
            const int qrow = b * T + blk * 128 + qs * 32 + r;
            float qf[4][8]; float ss = 0.f;
#pragma unroll
            for (int s = 0; s < 4; ++s) { const u32x4 qr = *(const u32x4*)(P + (size_t)qrow * IN_COLS + COL_Q + head * 64 + 16 * s + 8 * h);
                qf[s][0] = bflo(qr.x); qf[s][1] = bfhi(qr.x); qf[s][2] = bflo(qr.y); qf[s][3] = bfhi(qr.y); qf[s][4] = bflo(qr.z); qf[s][5] = bfhi(qr.z); qf[s][6] = bflo(qr.w); qf[s][7] = bfhi(qr.w);
#pragma unroll
                for (int j = 0; j < 8; ++j) ss += qf[s][j] * qf[s][j]; }
            ss += __shfl_xor(ss, 32);
            const float qscale = rsqrtf(ss * (1.f / 64.f) + NORM_EPS) * 0.125f;
            bf16x8 qb[4];
#pragma unroll
            for (int s = 0; s < 4; ++s) { u32x4 w;
                const f32x4 g0 = *(const f32x4*)(qg + 16 * s + 8 * h), g1 = *(const f32x4*)(qg + 16 * s + 8 * h + 4);
                w.x = pk2(qf[s][0] * qscale * g0[0], qf[s][1] * qscale * g0[1]); w.y = pk2(qf[s][2] * qscale * g0[2], qf[s][3] * qscale * g0[3]);
                w.z = pk2(qf[s][4] * qscale * g1[0], qf[s][5] * qscale * g1[1]); w.w = pk2(qf[s][6] * qscale * g1[2], qf[s][7] * qscale * g1[3]);
                qb[s] = __builtin_bit_cast(bf16x8, w); }
            f32x16 st[5];
#pragma unroll
            for (int kt = 0; kt < 5; ++kt) {
#pragma unroll
                for (int i = 0; i < 16; ++i) st[kt][i] = 0.f;
#pragma unroll
                for (int s = 0; s < 4; ++s) { const bf16x8 ka = *(const LAS bf16x8*)(Kl + (32 * (qs + kt) + r) * KLD + 16 * s + 8 * h);
                    st[kt] = __builtin_amdgcn_mfma_f32_32x32x16_bf16(ka, qb[s], st[kt], 0, 0, 0); }
            }
            const int iq = 32 * qs + r;
            const float sink = sinks[head];
            float mx = sink;
#pragma unroll
            for (int kt = 0; kt < 5; ++kt)
#pragma unroll
                for (int i = 0; i < 16; ++i) { const int jw = 32 * (qs + kt) + (i & 3) + 8 * (i >> 2) + 4 * h;
                    const bool ok = (jw >= iq + 1) && (jw <= iq + 128) && (kpos0 + jw >= 0);
                    st[kt][i] = ok ? st[kt][i] : -INFINITY; mx = fmaxf(mx, st[kt][i]); }
            mx = fmaxf(mx, __shfl_xor(mx, 32));
            float lsum = 0.f;
#pragma unroll
            for (int kt = 0; kt < 5; ++kt)
#pragma unroll
                for (int i = 0; i < 16; ++i) { const float p = __expf(st[kt][i] - mx); st[kt][i] = p; lsum += p; }
            lsum += __shfl_xor(lsum, 32);
            const float linv = __builtin_amdgcn_rcpf(lsum + __expf(sink - mx));
            f32x16 o[2];
#pragma unroll
            for (int dt = 0; dt < 2; ++dt)
#pragma unroll
                for (int i = 0; i < 16; ++i) o[dt][i] = 0.f;
#pragma unroll
            for (int kt = 0; kt < 5; ++kt)
#pragma unroll
                for (int sp = 0; sp < 2; ++sp) { u32x4 pw;
                    pw.x = pk2(st[kt][8 * sp + 0] * linv, st[kt][8 * sp + 1] * linv); pw.y = pk2(st[kt][8 * sp + 2] * linv, st[kt][8 * sp + 3] * linv);
                    pw.z = pk2(st[kt][8 * sp + 4] * linv, st[kt][8 * sp + 5] * linv); pw.w = pk2(st[kt][8 * sp + 6] * linv, st[kt][8 * sp + 7] * linv);
                    const bf16x8 pa = __builtin_bit_cast(bf16x8, pw);
                    const int kb = 32 * (qs + kt) + 16 * sp + 4 * h;
#pragma unroll
                    for (int dt = 0; dt < 2; ++dt) { const LAS bf16* vp = Vt + (32 * dt + r) * VLD + kb;
                        const u32x2 lo = *(const LAS u32x2*)vp, hi = *(const LAS u32x2*)(vp + 8);
                        u32x4 vw; vw.x = lo.x; vw.y = lo.y; vw.z = hi.x; vw.w = hi.y;
                        o[dt] = __builtin_amdgcn_mfma_f32_32x32x16_bf16(pa, __builtin_bit_cast(bf16x8, vw), o[dt], 0, 0, 0); } }
#pragma unroll
            for (int dt = 0; dt < 2; ++dt)
#pragma unroll
                for (int i = 0; i < 16; ++i) { const int qr = (i & 3) + 8 * (i >> 2) + 4 * h;
                    CAT[(size_t)(b * T + blk * 128 + qs * 32 + qr) * D + 512 + head * 64 + 32 * dt + r] = (bf16)f2bf(o[dt][i]); }
        }
    }
}

__device__ __forceinline__ void phase6(const Frame& F) {
    const int gw = F.vcu * 8 + F.wave, NGW = F.G * 8;
    const float* Y = wsp<float>(F, WS_Y); const float* SV = wsp<float>(F, WS_SV); const bf16* G = wsp<bf16>(F, WS_G); const float* BON = wsp<float>(F, WS_BONUS);
    bf16* CAT = wsp<bf16>(F, WS_CAT);
    const float* lg = F.in[15]; const float* lb = F.in[16];
    const int hh = F.lane >> 3, n0 = (F.lane & 7) * 8, c0 = F.lane * 8;
    for (int row = gw; row < M; row += NGW) { const int b = row / T, t = row % T;
        const f32x4 y0 = *(const f32x4*)(Y + (size_t)row * 512 + c0), y1 = *(const f32x4*)(Y + (size_t)row * 512 + c0 + 4);
        float yv[8] = {y0[0], y0[1], y0[2], y0[3], y1[0], y1[1], y1[2], y1[3]};
        float s = 0.f;
#pragma unroll
        for (int j = 0; j < 8; ++j) s += yv[j];
        s += __shfl_xor(s, 1); s += __shfl_xor(s, 2); s += __shfl_xor(s, 4);
        const float mean = s * (1.f / 64.f); float q = 0.f;
#pragma unroll
        for (int j = 0; j < 8; ++j) { yv[j] -= mean; q += yv[j] * yv[j]; }
        q += __shfl_xor(q, 1); q += __shfl_xor(q, 2); q += __shfl_xor(q, 4);
        const float rstd = rsqrtf(q * (1.f / 64.f) + GN_EPS);
        const float bon = BON[row * 8 + hh];
        const float* vp = SV + ((size_t)(b * RH + hh) * T + t) * 64 + n0;
        const f32x4 v0 = *(const f32x4*)vp, v1 = *(const f32x4*)(vp + 4);
        const float vv[8] = {v0[0], v0[1], v0[2], v0[3], v1[0], v1[1], v1[2], v1[3]};
        const u32x4 graw = *(const u32x4*)(G + (size_t)row * 512 + c0);
        const float gg[8] = {bflo(graw.x), bfhi(graw.x), bflo(graw.y), bfhi(graw.y), bflo(graw.z), bfhi(graw.z), bflo(graw.w), bfhi(graw.w)};
        float ov[8];
#pragma unroll
        for (int j = 0; j < 8; ++j) ov[j] = (yv[j] * rstd * lg[c0 + j] + lb[c0 + j] + bon * vv[j]) * gg[j];
        u32x4 w; w.x = pk2(ov[0], ov[1]); w.y = pk2(ov[2], ov[3]); w.z = pk2(ov[4], ov[5]); w.w = pk2(ov[6], ov[7]);
        *(u32x4*)(CAT + (size_t)row * D + c0) = w; }
}

__device__ __forceinline__ float reduce32x64(float (&v)[32], int lane) {
#pragma unroll
    for (int i = 0; i < 16; ++i) { const bool hi = lane & 16; const float send = hi ? v[i] : v[i + 16], keep = hi ? v[i + 16] : v[i]; v[i] = keep + __shfl_xor(send, 16); }
#pragma unroll
    for (int i = 0; i < 8; ++i) { const bool hi = lane & 8; const float send = hi ? v[i] : v[i + 8], keep = hi ? v[i + 8] : v[i]; v[i] = keep + __shfl_xor(send, 8); }
#pragma unroll
    for (int i = 0; i < 4; ++i) { const bool hi = lane & 4; const float send = hi ? v[i] : v[i + 4], keep = hi ? v[i + 4] : v[i]; v[i] = keep + __shfl_xor(send, 4); }
#pragma unroll
    for (int i = 0; i < 2; ++i) { const bool hi = lane & 2; const float send = hi ? v[i] : v[i + 2], keep = hi ? v[i + 2] : v[i]; v[i] = keep + __shfl_xor(send, 2); }
    { const bool hi = lane & 1; const float send = hi ? v[0] : v[1], keep = hi ? v[1] : v[0]; v[0] = keep + __shfl_xor(send, 1); }
    return v[0] + __shfl_xor(v[0], 32);
}
__device__ __forceinline__ void phase8(const Frame& F) {
    const float* mod = wsp<float>(F, WS_MOD); const bf16* x1 = wsp<bf16>(F, WS_X1B);
    const float* wr_ = F.in[22]; const float* br = F.in[23];
    LAS float* Wt = (LAS float*)F.lds;
    LAS float* lgw = (LAS float*)(F.lds + 131072 + F.wave * 512);
    LAS int* cnt = (LAS int*)(F.lds + 131072 + 4096);
    __syncthreads();
    for (int idx = F.tid; idx < 8192; idx += 512) { const int k = idx >> 3, e4 = idx & 7; const f32x4 w = *(const f32x4*)(wr_ + k * 32 + e4 * 4);
        Wt[(4 * e4 + 0) * 1024 + k] = w[0]; Wt[(4 * e4 + 1) * 1024 + k] = w[1]; Wt[(4 * e4 + 2) * 1024 + k] = w[2]; Wt[(4 * e4 + 3) * 1024 + k] = w[3]; }
    if (F.tid < 32) cnt[F.tid] = 0;
    __syncthreads();
    int* RT_E = wsp<int>(F, WS_RT_E); int* RT_LP = wsp<int>(F, WS_RT_LP); float* RT_G = wsp<float>(F, WS_RT_G);
    const int e = F.lane & 31;
    const float bre = br[e];
    f32x4 shq[4], scq[4];
    { const int b = (F.vcu * 128) / T;
#pragma unroll
        for (int j = 0; j < 4; ++j) { const int col = 4 * F.lane + 256 * j; shq[j] = *(const f32x4*)(mod + b * 6144 + 3072 + col); scq[j] = (*(const f32x4*)(mod + b * 6144 + 4096 + col) + 1.f) * *(const f32x4*)(F.in[21] + col); } }
    u32x2 xn[2][4];
#pragma unroll
    for (int q = 0; q < 2; ++q)
#pragma unroll
        for (int j = 0; j < 4; ++j) xn[q][j] = ((const u32x2*)(x1 + (size_t)(F.vcu * 128 + F.wave * 16 + q) * D))[F.lane + 64 * j];
    for (int pr = 0; pr < 8; ++pr) { const int row0 = F.vcu * 128 + F.wave * 16 + 2 * pr;
        f32x4 h0[4], h1[4];
        float ss0 = 0.f, ss1 = 0.f;
#pragma unroll
        for (int j = 0; j < 4; ++j) { h0[j] = (f32x4){bflo(xn[0][j].x), bfhi(xn[0][j].x), bflo(xn[0][j].y), bfhi(xn[0][j].y)}; h1[j] = (f32x4){bflo(xn[1][j].x), bfhi(xn[1][j].x), bflo(xn[1][j].y), bfhi(xn[1][j].y)};
            ss0 += (h0[j][0] * h0[j][0] + h0[j][1] * h0[j][1]) + (h0[j][2] * h0[j][2] + h0[j][3] * h0[j][3]); ss1 += (h1[j][0] * h1[j][0] + h1[j][1] * h1[j][1]) + (h1[j][2] * h1[j][2] + h1[j][3] * h1[j][3]); }
        { const int nr = row0 + (pr < 7 ? 2 : 0);
#pragma unroll
            for (int q = 0; q < 2; ++q)
#pragma unroll
                for (int j = 0; j < 4; ++j) xn[q][j] = ((const u32x2*)(x1 + (size_t)(nr + q) * D))[F.lane + 64 * j]; }
#pragma unroll
        for (int o = 1; o < 64; o <<= 1) { ss0 += __shfl_xor(ss0, o); ss1 += __shfl_xor(ss1, o); }
        const float rs0 = rsqrtf(ss0 * (1.f / D) + NORM_EPS), rs1 = rsqrtf(ss1 * (1.f / D) + NORM_EPS);
        unsigned char* o0 = wsp<unsigned char>(F, WS_H8) + (size_t)row0 * D * (MK_FP8 ? 1 : 2); unsigned char* o1 = o0 + (size_t)D * (MK_FP8 ? 1 : 2);
#pragma unroll
        for (int j = 0; j < 4; ++j) { h0[j] = h0[j] * rs0 * scq[j] + shq[j]; h1[j] = h1[j] * rs1 * scq[j] + shq[j];
#if MK_FP8
            ((unsigned*)o0)[F.lane + 64 * j] = pg8::pk4_fp8(h0[j][0], h0[j][1], h0[j][2], h0[j][3]); ((unsigned*)o1)[F.lane + 64 * j] = pg8::pk4_fp8(h1[j][0], h1[j][1], h1[j][2], h1[j][3]);
#else
            { u32x2 w; w.x = pk2(h0[j][0], h0[j][1]); w.y = pk2(h0[j][2], h0[j][3]); ((u32x2*)o0)[F.lane + 64 * j] = w; w.x = pk2(h1[j][0], h1[j][1]); w.y = pk2(h1[j][2], h1[j][3]); ((u32x2*)o1)[F.lane + 64 * j] = w; }
#endif
        }
        float pa0[32], pa1[32];
#pragma unroll
        for (int q = 0; q < 32; ++q) { float s0 = 0.f, s1 = 0.f;
#pragma unroll
            for (int j = 0; j < 4; ++j) { const f32x4 w4 = *(const LAS f32x4*)(Wt + q * 1024 + 4 * F.lane + 256 * j);
                s0 = fmaf(h0[j][0], w4[0], s0); s0 = fmaf(h0[j][1], w4[1], s0); s0 = fmaf(h0[j][2], w4[2], s0); s0 = fmaf(h0[j][3], w4[3], s0);
                s1 = fmaf(h1[j][0], w4[0], s1); s1 = fmaf(h1[j][1], w4[1], s1); s1 = fmaf(h1[j][2], w4[2], s1); s1 = fmaf(h1[j][3], w4[3], s1); }
            pa0[q] = s0; pa1[q] = s1; }
        const float lg0 = reduce32x64(pa0, F.lane) + bre, lg1 = reduce32x64(pa1, F.lane) + bre;
#pragma unroll
        for (int q = 0; q < 2; ++q) { const float logit = q ? lg1 : lg0; const int row = row0 + q; LAS float* lg32 = lgw + q * 64;
            if (F.lane < 32) lg32[e] = logit;
            asm volatile("s_waitcnt lgkmcnt(0)" ::: "memory");
            int rank = 0;
#pragma unroll 8
            for (int o = 0; o < 32; ++o) { const float ov = lg32[o]; rank += (ov > logit || (ov == logit && o < e)) ? 1 : 0; }
            if (F.lane < 32 && rank < 4) lg32[32 + rank] = logit;
            asm volatile("s_waitcnt lgkmcnt(0)" ::: "memory");
            const float t0 = lg32[32], t1 = lg32[33], t2 = lg32[34], t3 = lg32[35];
            const float den = 1.f + __expf(t1 - t0) + __expf(t2 - t0) + __expf(t3 - t0);
            if (F.lane < 32 && rank < 4) { const int lp = atomicAdd((int*)&cnt[e], 1);
                RT_E[row * 4 + rank] = e; RT_LP[row * 4 + rank] = lp; RT_G[row * 4 + rank] = __expf(logit - t0) / den; }
            asm volatile("s_waitcnt lgkmcnt(0)" ::: "memory"); }
    }
    __syncthreads();
    if (F.tid < 32) wsp<int>(F, WS_BLKCNT)[F.vcu * 32 + F.tid] = cnt[F.tid];
}

__device__ __forceinline__ void phase9(const Frame& F) {
    LAS int* base = (LAS int*)F.lds;
    LAS int* tot = base + 32;
    LAS int* pst = base + 64;
    const int* BC = wsp<int>(F, WS_BLKCNT);
    { LAS int* ps = base + 128; LAS int* pm = ps + 512;
        const int e = F.tid & 31, seg = F.tid >> 5; int s = 0, mine = 0;
#pragma unroll
        for (int j = 0; j < 16; ++j) { const int bk = seg * 16 + j, v = BC[bk * 32 + e]; s += v; mine += (bk < F.vcu) ? v : 0; }
        ps[seg * 32 + e] = s; pm[seg * 32 + e] = mine; }
    __syncthreads();
    if (F.tid < 32) { int s = 0, mine = 0;
#pragma unroll
        for (int q = 0; q < 16; ++q) { s += base[128 + q * 32 + F.tid]; mine += base[128 + 512 + q * 32 + F.tid]; }
        base[F.tid] = mine; tot[F.tid] = s; }
    __syncthreads();
    if (F.tid == 0) { int s = 0; for (int e = 0; e < 32; ++e) { pst[e] = s; s += (tot[e] + 255) / 256 * 256; } pst[32] = s; }
    __syncthreads();
    int* SLOT_TOK = wsp<int>(F, WS_SLOTTOK); float* SLOT_GATE = wsp<float>(F, WS_SLOTGATE); int* TOK_SLOT = wsp<int>(F, WS_TOKSLOT);
    const int* RT_E = wsp<int>(F, WS_RT_E); const int* RT_LP = wsp<int>(F, WS_RT_LP); const float* RT_G = wsp<float>(F, WS_RT_G);
    { const int idx = F.vcu * 512 + F.tid;
        const int e = RT_E[idx], slot = pst[e] + base[e] + RT_LP[idx];
        SLOT_TOK[slot] = idx >> 2; SLOT_GATE[slot] = RT_G[idx]; TOK_SLOT[idx] = slot; }
    if (F.vcu < 32) { const int e = F.vcu; for (int s = pst[e] + tot[e] + F.tid; s < pst[e + 1]; s += 512) { SLOT_TOK[s] = 0; SLOT_GATE[s] = 0.f; } }
    if (F.vcu == 0) { unsigned* ctl = wsp<unsigned>(F, WS_CTL);
        if (F.tid == 0) ctl[CW_NTILES] = (unsigned)(pst[32] / 256);
        if (F.tid < 33) ctl[CW_PADSTART + F.tid] = (unsigned)pst[F.tid];
        int* TE = wsp<int>(F, WS_TILEE);
        for (int tl = F.tid; tl < MAX_TILES; tl += 512) { int e = 31; for (int q = 0; q < 32; ++q) if (tl * 256 < pst[q + 1]) { e = q; break; } TE[tl] = e; } }
#if MK_CONV_WHERE == 9
    for (int it = CONV_4B + F.vcu * 8 + F.wave; it < MOE_ITEMS; it += F.G * 8) moe_weight_item(F, it);
#endif
}

__device__ __forceinline__ void phase12(const Frame& F) {
    const int gw = F.vcu * 8 + F.wave, NGW = F.G * 8;
    const float* mod = wsp<float>(F, WS_MOD); const bf16* YS = wsp<bf16>(F, WS_YS); const int* TOK_SLOT = wsp<int>(F, WS_TOKSLOT); const bf16* X1B = wsp<bf16>(F, WS_X1B);
    for (int row = gw; row < M; row += 2 * NGW) {
        int sl[2][4]; u32x4 v[2][2][4], xb[2][2];
#pragma unroll
        for (int rr = 0; rr < 2; ++rr)
#pragma unroll
            for (int k = 0; k < 4; ++k) sl[rr][k] = TOK_SLOT[(row + rr * NGW) * 4 + k];
#pragma unroll
        for (int rr = 0; rr < 2; ++rr)
#pragma unroll
            for (int j = 0; j < 2; ++j) { const int col = 8 * F.lane + 512 * j;
#pragma unroll
                for (int k = 0; k < 4; ++k) v[rr][j][k] = __builtin_nontemporal_load((const u32x4*)(YS + (size_t)sl[rr][k] * D + col));
                xb[rr][j] = __builtin_nontemporal_load((const u32x4*)(X1B + (size_t)(row + rr * NGW) * D + col)); }
#pragma unroll
        for (int rr = 0; rr < 2; ++rr) { const int rw = row + rr * NGW, b = rw / T;
#pragma unroll
            for (int j = 0; j < 2; ++j) { const int col = 8 * F.lane + 512 * j;
                float a[8];
#pragma unroll
                for (int q = 0; q < 8; ++q) a[q] = 0.f;
#pragma unroll
                for (int k = 0; k < 4; ++k) { const u32x4 w = v[rr][j][k];
                    a[0] += bflo(w.x); a[1] += bfhi(w.x); a[2] += bflo(w.y); a[3] += bfhi(w.y); a[4] += bflo(w.z); a[5] += bfhi(w.z); a[6] += bflo(w.w); a[7] += bfhi(w.w); }
                const float* gp = mod + b * 6144 + 5120 + col;
                const f32x4 g0 = *(const f32x4*)gp, g1 = *(const f32x4*)(gp + 4);
                float* op = F.out + (size_t)rw * D + col;
                const u32x4 x = xb[rr][j];
                f32x4 x0 = (f32x4){bflo(x.x), bfhi(x.x), bflo(x.y), bfhi(x.y)}, x1v = (f32x4){bflo(x.z), bfhi(x.z), bflo(x.w), bfhi(x.w)};
                x0[0] += g0[0] * a[0]; x0[1] += g0[1] * a[1]; x0[2] += g0[2] * a[2]; x0[3] += g0[3] * a[3];
                x1v[0] += g1[0] * a[4]; x1v[1] += g1[1] * a[5]; x1v[2] += g1[2] * a[6]; x1v[3] += g1[3] * a[7];
                *(f32x4*)op = x0; *(f32x4*)(op + 4) = x1v; } }
    }
}

__device__ __forceinline__ void copy_x_to_out(const Frame& F) {
    const size_t n4 = (size_t)M * D / 4; const f32x4* s = (const f32x4*)F.in[0]; f32x4* d = (f32x4*)F.out;
    for (size_t i = (size_t)blockIdx.x * 512 + F.tid; i < n4; i += (size_t)gridDim.x * 512) d[i] = s[i];
}


#define XB_TMO      128
#define XB_XCNT(j)  (256  + 64 * (j))
#define XB_XSUB(j)  (1280 + 64 * (j))
#define XB_XGEN(j)  (2304 + 64 * (j))
#define XB_TOP      3328
#define XB_TOPGEN   3392
#define XCD_BAR_WORDS 3456
#define XB_SPIN_CAP (1u << 18)
__device__ __forceinline__ unsigned xb_ld(unsigned* p)              { return __hip_atomic_load(p, __ATOMIC_RELAXED, __HIP_MEMORY_SCOPE_AGENT); }
__device__ __forceinline__ unsigned xb_add(unsigned* p, unsigned v) { return __hip_atomic_fetch_add(p, v, __ATOMIC_RELAXED, __HIP_MEMORY_SCOPE_AGENT); }
__device__ __forceinline__ unsigned xb_xcc_id() { return (unsigned)__builtin_amdgcn_s_getreg((3 << 11) | 20) & 0xFu; }
#define XB_SPIN(cond, bar) do { unsigned _sp = 0; while (cond) { __builtin_amdgcn_s_sleep(1); \
    if ((++_sp & 255u) == 0u) { if (xb_ld(&(bar)[XB_TMO])) break; if (_sp > XB_SPIN_CAP) { atomicAdd(&(bar)[XB_TMO], 1u); break; } } } } while (0)
struct XcdBarrier { unsigned* bar; unsigned x; volatile LAS unsigned* st; };
__device__ __forceinline__ XcdBarrier xcd_barrier_post(unsigned* bar, volatile LAS unsigned* st) {
    XcdBarrier b; b.bar = bar; b.x = xb_xcc_id(); b.st = st;
    if (threadIdx.x == 0) (void)xb_add(&bar[XB_XCNT(b.x)], 1u);
    return b;
}
__device__ __forceinline__ void xcd_barrier_complete(unsigned* bar, unsigned x, unsigned& nloc, unsigned& nx) {
    const unsigned G = gridDim.x * gridDim.y * gridDim.z;
    unsigned sum, cnt, mine, sp = 0u;
    for (;;) {
        sum = 0u; cnt = 0u; mine = 0u;
#pragma unroll
        for (unsigned j = 0; j < 16; ++j) { const unsigned c = xb_ld(&bar[XB_XCNT(j)]); sum += c; cnt += (c > 0u) ? 1u : 0u; mine = (j == x) ? c : mine; }
        if (sum == G) break;
        __builtin_amdgcn_s_sleep(1);
        if ((++sp & 255u) == 0u) { if (xb_ld(&bar[XB_TMO])) break; if (sp > XB_SPIN_CAP) { atomicAdd(&bar[XB_TMO], 1u); break; } }
    }
    nloc = mine > 0u ? mine : 1u; nx = cnt > 0u ? cnt : 1u;
}
__device__ __forceinline__ void xcd_barrier(const XcdBarrier& b) {
    asm volatile("s_waitcnt vmcnt(0)" ::: "memory");
    __syncthreads();
    if (threadIdx.x == 0) {
        unsigned* bar = b.bar;
        __builtin_amdgcn_s_waitcnt(0);
        unsigned nloc = b.st[0], nx = b.st[1];
        if (nloc == 0u) { xcd_barrier_complete(bar, b.x, nloc, nx); b.st[0] = nloc; b.st[1] = nx; }
        const unsigned old = xb_add(&bar[XB_XSUB(b.x)], 1u);
        const unsigned gen = old / nloc;
        if (old + 1u == (gen + 1u) * nloc) {
            __builtin_amdgcn_fence(__ATOMIC_RELEASE, "agent");
            asm volatile("s_waitcnt vmcnt(0)" ::: "memory");
            const unsigned og = xb_add(&bar[XB_TOP], 1u);
            const unsigned tg = og / nx;
            if (og + 1u == (tg + 1u) * nx) xb_add(&bar[XB_TOPGEN], 1u);
            else XB_SPIN(xb_ld(&bar[XB_TOPGEN]) == tg, bar);
            __builtin_amdgcn_fence(__ATOMIC_ACQUIRE, "agent");
            xb_add(&bar[XB_XGEN(b.x)], 1u);
            asm volatile("s_waitcnt vmcnt(0)" ::: "memory");
        } else {
            XB_SPIN(xb_ld(&bar[XB_XGEN(b.x)]) == gen, bar);
            __builtin_amdgcn_fence(__ATOMIC_ACQUIRE, "agent");
            asm volatile("s_waitcnt vmcnt(0)" ::: "memory");
        }
    }
    __syncthreads();
}

struct Args { const float* in[28]; float* out; unsigned char* ws; int ph_lo, ph_hi; };
constexpr int N_PHASES = 13;

__global__ void __launch_bounds__(512, 2) mk_fwd(Args args) {
    extern __shared__ __attribute__((aligned(16))) unsigned char lds_raw[];
    Frame F;
    F.lds = (LAS unsigned char*)lds_raw;
    F.tid = threadIdx.x; F.lane = F.tid & 63; F.wave = __builtin_amdgcn_readfirstlane(F.tid >> 6);
    F.G = gridDim.x; { const int bx = blockIdx.x; F.vcu = (F.G % 8 == 0) ? (bx % 8) * (F.G / 8) + bx / 8 : bx; }
    F.in = args.in;
    F.out = args.out; F.ws = args.ws;
    cg::grid_group grid = cg::this_grid();
    const int lo = args.ph_lo, hi = args.ph_hi;
    volatile LAS unsigned* MISC = (volatile LAS unsigned*)(F.lds + MISC_OFF);
    if (F.tid < 16) MISC[F.tid] = 0u;
    __syncthreads();
    XcdBarrier bar; bar.bar = wsp<unsigned>(F, WS_CTL) + CW_BAR; bar.x = 0; bar.st = MISC;
    if (hi - lo > 1) bar = xcd_barrier_post(wsp<unsigned>(F, WS_CTL) + CW_BAR, MISC);
#define IN(k) (lo <= (k) && (k) < hi)
#define REP(k) for (int rep_ = 0; rep_ < 1 + ((MK_REPEAT_MASK >> (k)) & 1); ++rep_)
#define SEAM(k) do { if (IN(k) && IN((k) + 1)) { if ((MK_CG_SEAMS >> (k)) & 1) grid.sync(); else xcd_barrier(bar); } } while (0)

    if (IN(0)) REP(0) { phase0(F); } SEAM(0);
    if (IN(1)) REP(1) { phase1(F); } SEAM(1);
    if (IN(2)) REP(2) {
#if MK_CONV_WHERE == 2
        if ((int)blockIdx.x >= 192) { for (int it = ((int)blockIdx.x - 192) * 8 + F.wave; it < MOE_ITEMS; it += 64 * 8) moe_weight_item(F, it); }
        else {
        pg8::Gemm g{wsp<bf16>(F, WS_H), wsp<bf16>(F, WS_WIN), D, IN_COLS, nullptr};
        pg8::StaticOrder S; S.init(M, IN_COLS, 192, (int)blockIdx.x);
        pg8::EpiBf16P E{wsp<bf16>(F, WS_P), IN_COLS};
        pg8::gemm_phase<pg8::EpiBf16P, pg8::StaticOrder, false>(F.lds, g, S, E);
        }
#else
        pg8::Gemm g{wsp<bf16>(F, WS_H), wsp<bf16>(F, WS_WIN), D, IN_COLS, nullptr};
        pg8::StaticOrder S; S.init(M, IN_COLS, F.G, (int)blockIdx.x);
        pg8::EpiBf16P E{wsp<bf16>(F, WS_P), IN_COLS};
        pg8::gemm_phase<pg8::EpiBf16P, pg8::StaticOrder, false>(F.lds, g, S, E);
#endif
    } SEAM(2);
#if MK_RWKV_MODE < 3
    if (IN(3)) REP(3) { phase3(F); } SEAM(3);
#endif
    if (IN(4)) REP(4) {
#if MK_RWKV_MODE >= 1
#if MK_RWKV_MODE == 4
#if MK_WMASK != 63
        phase4a_fused(F); xcd_barrier(bar);
#endif
        for (int q_ = 0; q_ < 1 + (MK_REP4 & 1); ++q_) { phase4a_wave(F); xcd_barrier(bar); }
#elif MK_RWKV_MODE == 3
        for (int q_ = 0; q_ < 1 + (MK_REP4 & 1); ++q_) { phase4a_fused(F); xcd_barrier(bar); }
#else
        for (int q_ = 0; q_ < 1 + (MK_REP4 & 1); ++q_) { phase4a_summaries(F); xcd_barrier(bar); }
#endif
        for (int q_ = 0; q_ < 1 + ((MK_REP4 >> 1) & 1); ++q_) { phase4b_states(F); xcd_barrier(bar); }
#endif
#if MK_RWKV_MODE >= 2
        for (int q_ = 0; q_ < 1 + ((MK_REP4 >> 2) & 1); ++q_) phase4c_output(F);
#else
        phase4_scan(F);
#endif
        } SEAM(4);
    if (IN(5)) REP(5) { phase5_attn(F); } SEAM(5);
#if MK_RWKV_MODE < 2
    if (IN(6)) REP(6) { phase6(F); } SEAM(6);
#endif
    if (IN(7)) REP(7) {
#if MK_LAST_PHASE >= 7
        pg8::Gemm g{wsp<bf16>(F, WS_CAT), wsp<bf16>(F, WS_WOUT), D, D, nullptr};
        pg8::StaticOrder S; S.init(M, D, F.G, (int)blockIdx.x);
        pg8::EpiOutProj E{F.in[0], wsp<bf16>(F, WS_X1B), wsp<float>(F, WS_MOD) + 2048};
        pg8::gemm_phase<pg8::EpiOutProj, pg8::StaticOrder, false>(F.lds, g, S, E);
#else
        copy_x_to_out(F);
#endif
    } SEAM(7);
    if (IN(8)) REP(8) { phase8(F); } SEAM(8);
    if (IN(9)) REP(9) { phase9(F); } SEAM(9);
    if (IN(10)) REP(10) {
        const unsigned* ctl = wsp<unsigned>(F, WS_CTL);
        pg8::Gemm g{wsp<bf16>(F, WS_H8), wsp<bf16>(F, WS_W1), MK_FP8 ? D / 2 : D, 2 * DE, wsp<int>(F, WS_SLOTTOK)};
        pg8::MoeOrder S{(int)ctl[CW_NTILES], 8, F.G, F.vcu, wsp<int>(F, WS_TILEE)};
        pg8::EpiMoe1 E{wsp<unsigned char>(F, WS_ACT), F.in[25]};
        pg8::gemm_phase<pg8::EpiMoe1, pg8::MoeOrder, true, MK_FP8 != 0>(F.lds, g, S, E);
    } SEAM(10);
    if (IN(11)) REP(11) {
        const unsigned* ctl = wsp<unsigned>(F, WS_CTL);
        pg8::Gemm g{wsp<bf16>(F, WS_ACT), wsp<bf16>(F, WS_W2), MK_FP8 ? DE / 2 : DE, D, nullptr};
        pg8::MoeOrder S{(int)ctl[CW_NTILES], 4, F.G, F.vcu, wsp<int>(F, WS_TILEE)};
        pg8::EpiMoe2 E{wsp<bf16>(F, WS_YS), F.in[27], wsp<float>(F, WS_SLOTGATE)};
        pg8::gemm_phase<pg8::EpiMoe2, pg8::MoeOrder, false, MK_FP8 != 0>(F.lds, g, S, E);
    } SEAM(11);
    if (IN(12)) { phase12(F); }
#undef IN
#undef SEAM
}

extern "C" void kernel_launch(void* const* d_in, const int* in_sizes, int n_in, void* d_out, int out_size, void* d_ws, size_t ws_size, hipStream_t stream) {
    static int grid = 0;
    if (grid == 0) {
        if (n_in != 28 || out_size != M * D || ws_size < WS_END) { fprintf(stderr, "kernel_launch: unexpected sizes (n_in %d out %d ws %zu, need %zu)\n", n_in, out_size, ws_size, (size_t)WS_END); grid = -1; return; }
        int dev = 0, cus = 0, per_cu = 0;
        (void)hipGetDevice(&dev); (void)hipDeviceGetAttribute(&cus, hipDeviceAttributeMultiprocessorCount, dev);
        (void)hipFuncSetAttribute((const void*)mk_fwd, hipFuncAttributeMaxDynamicSharedMemorySize, LDS_BYTES);
        (void)hipOccupancyMaxActiveBlocksPerMultiprocessor(&per_cu, (const void*)mk_fwd, 512, LDS_BYTES);
        if (per_cu < 1 || cus != 256) { fprintf(stderr, "kernel_launch: occupancy %d, CUs %d: this build needs 256 CUs x 1 block\n", per_cu, cus); grid = -1; return; }
        grid = cus;
    }
    if (grid < 0) return;
    (void)hipMemsetAsync((char*)d_ws + WS_CTL, 0, CTL_BYTES, stream);
    Args a{};
    for (int i = 0; i < 28; ++i) a.in[i] = (const float*)d_in[i];
    a.out = (float*)d_out; a.ws = (unsigned char*)d_ws;
    const int last = MK_LAST_PHASE + 1;
#if MK_ONE_LAUNCH
    a.ph_lo = 0; a.ph_hi = last;
#if MK_COOP
    void* kargs[] = {&a};
    hipError_t e = hipLaunchCooperativeKernel((const void*)mk_fwd, dim3(grid), dim3(512), kargs, LDS_BYTES, stream);
    if (e != hipSuccess) fprintf(stderr, "cooperative launch failed: %s\n", hipGetErrorString(e));
#else
    hipLaunchKernelGGL(mk_fwd, dim3(grid), dim3(512), LDS_BYTES, stream, a);
#endif
#else
    for (int p = 0; p < last; ++p) { a.ph_lo = p; a.ph_hi = p + 1; hipLaunchKernelGGL(mk_fwd, dim3(grid), dim3(512), LDS_BYTES, stream, a); }
#endif
}
```

```cpp
#include <hip/hip_runtime.h>
#include <hip/hip_cooperative_groups.h>
#include <cstdio>
#include <cstdint>
namespace cg = cooperative_groups;

#ifndef MK_ONE_LAUNCH
#define MK_ONE_LAUNCH 1
#endif
#ifndef MK_REPEAT_MASK
#define MK_REPEAT_MASK 0
#endif
#ifndef MK_CONV_WHERE
#define MK_CONV_WHERE 8
#endif
#define MK_CONV_IN_SCAN (MK_CONV_WHERE == 4)
#ifndef MK_RWKV_MODE
#define MK_RWKV_MODE 3
#endif
#ifndef MK_FP8
#define MK_FP8 1
#endif
#ifndef MK_DUP
#define MK_DUP 0
#endif
#ifndef MK_WMASK
#define MK_WMASK 63
#endif
#ifndef MK_REP4
#define MK_REP4 0
#endif
#ifndef MK_CG_SEAMS
#define MK_CG_SEAMS 0
#endif
#ifndef MK_COOP
#define MK_COOP 0
#endif
#ifndef MK_LAST_PHASE
#define MK_LAST_PHASE 12
#endif

constexpr int D = 1024, NBATCH = 8, T = 4096, M = NBATCH * T;
constexpr int HD = 64, RW = 512, RH = 8, AW = 512, QH = 8, KVH = 2, WIN = 128;
constexpr int RWKV_COLS = 1792, IN_COLS = 2560;
constexpr int COL_Q = 1792, COL_K = 1792 + 512, COL_V = 1792 + 512 + 128;
constexpr int NE = 32, TOPK = 4, DE = 1024;
constexpr int MAX_TILES = 544;
constexpr int MAX_SLOTS = MAX_TILES * 256;
constexpr float NORM_EPS = 1e-6f, GN_EPS = 64e-5f;

#define GAS __attribute__((address_space(1)))
#define LAS __attribute__((address_space(3)))
typedef unsigned short bf16;
typedef short bf16x8 __attribute__((ext_vector_type(8)));
typedef float f32x4 __attribute__((ext_vector_type(4)));
typedef float f32x2 __attribute__((ext_vector_type(2)));
typedef float f32x16 __attribute__((ext_vector_type(16)));
typedef unsigned u32x4 __attribute__((ext_vector_type(4)));
typedef unsigned u32x2 __attribute__((ext_vector_type(2)));
typedef int i32x8 __attribute__((ext_vector_type(8)));
typedef int i32x4 __attribute__((ext_vector_type(4)));

constexpr size_t MiB = 1u << 20;
constexpr size_t WS_CTL = 0, CTL_BYTES = 64 * 1024;
constexpr size_t WS_MOD = 1 * MiB;
constexpr size_t WS_BON = 1 * MiB + 256 * 1024;
constexpr size_t WS_RT_E = 2 * MiB;
constexpr size_t WS_RT_LP = 2 * MiB + 512 * 1024;
constexpr size_t WS_RT_G = 3 * MiB;
constexpr size_t WS_TOKSLOT = 3 * MiB + 512 * 1024;
constexpr size_t WS_SLOTTOK = 4 * MiB;
constexpr size_t WS_SLOTGATE = 5 * MiB;
constexpr size_t WS_BLKCNT = 6 * MiB;
constexpr size_t WS_TILEE = 6 * MiB + 64 * 1024;
constexpr size_t WS_BONUS = 7 * MiB;
constexpr size_t WS_LW = 9 * MiB;
constexpr size_t WS_WIN = 10 * MiB;
constexpr size_t WS_WOUT = 16 * MiB;
constexpr size_t WS_W1 = 20 * MiB;
constexpr size_t WS_W2 = 148 * MiB;
constexpr size_t WS_H = 212 * MiB;
constexpr size_t WS_R2 = 276 * MiB;
constexpr size_t WS_P = WS_R2;
constexpr size_t WS_SCN = WS_R2 + 160 * MiB;
constexpr size_t WS_SV = WS_SCN + 320 * MiB;
constexpr size_t WS_G = WS_SV + 64 * MiB;
constexpr size_t WS_Y = WS_G + 32 * MiB;
constexpr size_t WS_CAT = WS_Y + 64 * MiB;
constexpr size_t WS_ACT = WS_R2;
constexpr size_t WS_YS = WS_R2 + 272 * MiB;
constexpr size_t WS_END = 1012 * MiB;
constexpr size_t WS_X1B = WS_H;
constexpr size_t WS_H8 = WS_Y;
constexpr size_t WS_PT = 436 * MiB;
constexpr size_t WS_ZV = 500 * MiB;
constexpr size_t WS_Z0 = 628 * MiB;
constexpr size_t WS_RYT = 692 * MiB;
constexpr size_t WS_YVT = WS_Y;
static_assert(WS_END <= 1024 * MiB, "workspace map");
static_assert(WS_YS + 272 * MiB <= WS_CAT, "YS must not overlay CAT");
constexpr int CW_NTILES = 16;
constexpr int CW_PADSTART = 64;
constexpr int CW_BAR = 4096;
constexpr int MISC_OFF = 160 * 1024 - 64;

constexpr int LDS_BYTES = 160 * 1024;

__device__ __forceinline__ unsigned f2bf(float f) { unsigned u = __builtin_bit_cast(unsigned, f); return (u + 0x7fffu + ((u >> 16) & 1u)) >> 16; }
typedef __bf16 bf16x2_t __attribute__((ext_vector_type(2)));
__device__ __forceinline__ unsigned pk2(float lo, float hi) { const f32x2 v = {lo, hi}; return __builtin_bit_cast(unsigned, __builtin_convertvector(v, bf16x2_t)); }
__device__ __forceinline__ float bf2f(unsigned short b) { return __builtin_bit_cast(float, ((unsigned)b) << 16); }
__device__ __forceinline__ float bflo(unsigned u) { return __builtin_bit_cast(float, u << 16); }
__device__ __forceinline__ float bfhi(unsigned u) { return __builtin_bit_cast(float, u & 0xffff0000u); }
__device__ __forceinline__ float wave_sum(float v) {
#pragma unroll
    for (int o = 1; o < 64; o <<= 1) v += __shfl_xor(v, o);
    return v;
}
__device__ __forceinline__ void lds_barrier() { asm volatile("s_waitcnt lgkmcnt(0)" ::: "memory"); __builtin_amdgcn_s_barrier(); asm volatile("" ::: "memory"); }
__device__ __forceinline__ float sigmoidf_(float x) { return __builtin_amdgcn_rcpf(1.f + __expf(-x)); }

namespace pg8 {
#define PG8_LAS __attribute__((address_space(3)))
constexpr int BM = 256, BK = 64, HALF = 128, HTB = HALF * BK * 2, STAGE_BYTES = 8 * HTB, NXCD = 8, WGM = 8;
__host__ __device__ __forceinline__ int lds_byte(int r, int c) { const int st = (r >> 4) * 2 + (c >> 5), rr = r & 15, cc = c & 31, ob = rr * 64 + cc * 2; return st * 1024 + (ob ^ (((ob >> 9) & 1) << 5)); }
__host__ __device__ __forceinline__ void stage_rc(int b, int& R, int& C) { const int st = b / 1024, sb = b % 1024, swz = sb ^ (((sb >> 9) & 1) << 5); R = (st >> 1) * 16 + swz / 64; C = (st & 1) * 32 + (swz % 64) / 2; }

struct Unit { int pm, pn, e; };
struct Gemm { const bf16* A; const bf16* Bt; int K, N; const int* rowmap; };

struct StaticOrder {
    int nM, nN, nwg, G, c;
    __device__ void init(int M_, int N_, int G_, int c_) { nM = M_ / BM; nN = N_ / BM; nwg = nM * nN; G = G_; c = c_; }
    __device__ bool next(int i, Unit& u) const {
        const long L = (long)i * G + c; if (L >= nwg) return false;
        int wgid = (int)L; { const int q = nwg / NXCD, r = nwg % NXCD, xcd = wgid % NXCD, off = wgid / NXCD; wgid = (xcd < r ? xcd * (q + 1) : r * (q + 1) + (xcd - r) * q) + off; }
        const int nig = WGM * nN, gid = wgid / nig, fm = gid * WGM, gsz = (nM - fm) < WGM ? (nM - fm) : WGM;
        u.pm = fm + ((wgid % nig) % gsz); u.pn = (wgid % nig) / gsz; u.e = 0; return true;
    }
};
struct MoeOrder {
    int nMt, nN, G, c; const int* tile_e;
    __device__ bool next(int i, Unit& u) const {
        const long L = (long)i * G + c; if (L >= (long)nMt * nN) return false;
        u.pm = (int)(L / nN); u.pn = (int)(L % nN); u.e = tile_e[u.pm]; return true;
    }
};

__device__ __forceinline__ unsigned cvt_pk_bf16(float lo, float hi) { unsigned r; asm volatile("v_cvt_pk_bf16_f32 %0, %1, %2" : "=v"(r) : "v"(lo), "v"(hi)); return r; }

struct EpiBf16P {
    bf16* O; int ldc;
    __device__ __forceinline__ void operator()(const f32x4 (&acc)[2][2][4][2], const Unit& u, int wr, int wc, int fr, int fq) const {
        const int row0 = u.pm * BM + wr * 64 + fr, col0 = u.pn * BM + wc * 32 + 8 * fq;
#pragma unroll
        for (int ai = 0; ai < 2; ++ai)
#pragma unroll
            for (int m = 0; m < 4; ++m) { bf16* rowp = O + (size_t)(row0 + ai * HALF + m * 16) * ldc + col0;
#pragma unroll
                for (int bj = 0; bj < 2; ++bj) { const f32x4 v0 = acc[ai][bj][m][0], v1 = acc[ai][bj][m][1];
                    u32x4 w; w.x = cvt_pk_bf16(v0[0], v0[1]); w.y = cvt_pk_bf16(v0[2], v0[3]); w.z = cvt_pk_bf16(v1[0], v1[1]); w.w = cvt_pk_bf16(v1[2], v1[3]);
                    *(u32x4*)(rowp + bj * HALF) = w; } }
    }
};
struct EpiOutProj {
    const float* x; bf16* out; const float* gate;
    __device__ __forceinline__ void operator()(const f32x4 (&acc)[2][2][4][2], const Unit& u, int wr, int wc, int fr, int fq) const {
        const int row0 = u.pm * BM + wr * 64 + fr, col0 = u.pn * BM + wc * 32 + 8 * fq;
        const int b = (u.pm * BM) / T;
        f32x4 gv[2][2];
#pragma unroll
        for (int bj = 0; bj < 2; ++bj)
#pragma unroll
            for (int n = 0; n < 2; ++n) gv[bj][n] = *(const f32x4*)(gate + (size_t)b * 6144 + col0 + bj * HALF + 4 * n);
#pragma unroll
        for (int ai = 0; ai < 2; ++ai)
#pragma unroll
            for (int m = 0; m < 4; ++m) { const size_t ro = (size_t)(row0 + ai * HALF + m * 16) * D + col0;
#pragma unroll
                for (int bj = 0; bj < 2; ++bj) { const f32x4 x0 = __builtin_nontemporal_load((const f32x4*)(x + ro + bj * HALF)), x1 = __builtin_nontemporal_load((const f32x4*)(x + ro + bj * HALF + 4));
                    const f32x4 v0 = x0 + gv[bj][0] * acc[ai][bj][m][0], v1 = x1 + gv[bj][1] * acc[ai][bj][m][1];
                    u32x4 w; w.x = cvt_pk_bf16(v0[0], v0[1]); w.y = cvt_pk_bf16(v0[2], v0[3]); w.z = cvt_pk_bf16(v1[0], v1[1]); w.w = cvt_pk_bf16(v1[2], v1[3]);
                    *(u32x4*)(out + ro + bj * HALF) = w; } }
    }
};
__device__ __forceinline__ unsigned pk4_fp8(float a, float b, float c, float d) { int w = 0; w = __builtin_amdgcn_cvt_pk_fp8_f32(a, b, w, false); w = __builtin_amdgcn_cvt_pk_fp8_f32(c, d, w, true); return (unsigned)w; }
constexpr float W8_SCALE = 32.f, W8_INV = 1.f / 32.f;
struct EpiMoe1 {
    unsigned char* act; const float* b1;
    __device__ __forceinline__ void operator()(const f32x4 (&acc)[2][2][4][2], const Unit& u, int wr, int wc, int fr, int fq) const {
        const int row0 = u.pm * BM + wr * 64 + fr, j0 = u.pn * 128 + wc * 16 + 4 * fq;
        const float* bb = b1 + (size_t)u.e * 2048;
        f32x4 bg[2], bl[2];
#pragma unroll
        for (int bj = 0; bj < 2; ++bj) { bg[bj] = *(const f32x4*)(bb + j0 + bj * 64); bl[bj] = *(const f32x4*)(bb + 1024 + j0 + bj * 64); }
#pragma unroll
        for (int ai = 0; ai < 2; ++ai)
#pragma unroll
            for (int m = 0; m < 4; ++m) { unsigned char* rowp = act + ((size_t)(row0 + ai * HALF + m * 16) * DE + j0) * (MK_FP8 ? 1 : 2);
#pragma unroll
                for (int bj = 0; bj < 2; ++bj) { const f32x4 g4 = acc[ai][bj][m][0] * (MK_FP8 ? W8_INV : 1.f) + bg[bj], l4 = acc[ai][bj][m][1] * (MK_FP8 ? W8_INV : 1.f) + bl[bj]; float a[4];
#pragma unroll
                    for (int q = 0; q < 4; ++q) { const float gl = fminf(g4[q], 7.0f), li = fminf(fmaxf(l4[q], -7.0f), 7.0f);
                        a[q] = gl * __builtin_amdgcn_rcpf(1.f + __expf(-1.702f * gl)) * (li + 1.f); }
#if MK_FP8
                    *(unsigned*)(rowp + bj * 64) = pk4_fp8(a[0], a[1], a[2], a[3]);
#else
                    u32x2 w; w.x = cvt_pk_bf16(a[0], a[1]); w.y = cvt_pk_bf16(a[2], a[3]); *(u32x2*)(rowp + bj * 128) = w;
#endif
                } }
    }
};
struct EpiMoe2 {
    bf16* ys; const float* b2; const float* sgate;
    __device__ __forceinline__ void operator()(const f32x4 (&acc)[2][2][4][2], const Unit& u, int wr, int wc, int fr, int fq) const {
        const int row0 = u.pm * BM + wr * 64 + fr, col0 = u.pn * BM + wc * 32 + 8 * fq;
        const float* bb = b2 + (size_t)u.e * 1024;
        f32x4 bv[2][2];
#pragma unroll
        for (int bj = 0; bj < 2; ++bj)
#pragma unroll
            for (int n = 0; n < 2; ++n) bv[bj][n] = *(const f32x4*)(bb + col0 + bj * HALF + 4 * n);
#pragma unroll
        for (int ai = 0; ai < 2; ++ai)
#pragma unroll
            for (int m = 0; m < 4; ++m) { const int row = row0 + ai * HALF + m * 16; const float gt = sgate[row]; bf16* rowp = ys + (size_t)row * D + col0;
#pragma unroll
                for (int bj = 0; bj < 2; ++bj) { const f32x4 v0 = (acc[ai][bj][m][0] * (MK_FP8 ? W8_INV : 1.f) + bv[bj][0]) * gt, v1 = (acc[ai][bj][m][1] * (MK_FP8 ? W8_INV : 1.f) + bv[bj][1]) * gt;
                    u32x4 w; w.x = cvt_pk_bf16(v0[0], v0[1]); w.y = cvt_pk_bf16(v0[2], v0[3]); w.z = cvt_pk_bf16(v1[0], v1[1]); w.w = cvt_pk_bf16(v1[2], v1[3]);
                    *(u32x4*)(rowp + bj * HALF) = w; } }
    }
};

template <class Epi, class Sched, bool GATHER, bool FP8 = false>
__device__ __forceinline__ void gemm_phase(PG8_LAS unsigned char* lds, const Gemm g, const Sched& S, const Epi& E) {
    const int tid = threadIdx.x, wid = __builtin_amdgcn_readfirstlane(tid >> 6), lane = tid & 63, wr = wid >> 2, wc = wid & 3, fr = lane & 15, fq = lane >> 4;
    const int K = g.K, nt = K / BK;
    int Rr[2], Cc[2]; unsigned voffB[2];
#pragma unroll
    for (int i = 0; i < 2; ++i) { stage_rc(tid * 16 + i * 8192, Rr[i], Cc[i]); voffB[i] = (unsigned)(Rr[i] * K + Cc[i]) * 2u; }
    const size_t kstep = (size_t)(BK * 2);
    const size_t hstep = (size_t)HALF * K * 2;
    const size_t tstep = 2 * hstep;
    const unsigned ldsw = (unsigned)wid * 1024u;
    const int aoff = lds_byte(wr * 64 + fr, fq * 8), boff = lds_byte(wc * 32 + fr, fq * 8);
#define PG8_SA(b, h) (((b) * 2 + (h)) * HTB)
#define PG8_SB(b, h) ((4 + (b) * 2 + (h)) * HTB)
#define PG8_STAGE(bufoff, gbase, voff) do { _Pragma("unroll") for (int _i = 0; _i < 2; ++_i) \
        __builtin_amdgcn_global_load_lds((const unsigned*)((const char*)(gbase) + (voff)[_i]), (PG8_LAS unsigned*)(lds + (bufoff) + ldsw + _i * 8192), 16, 0, 0); } while (0)
#define PG8_LDA(dst, b, h) do { _Pragma("unroll") for (int m = 0; m < 4; ++m) { const PG8_LAS i32x4* _p = (const PG8_LAS i32x4*)(lds + PG8_SA(b, h) + aoff + m * 2048); \
        dst[m] = __builtin_shufflevector(_p[0], _p[64], 0, 1, 2, 3, 4, 5, 6, 7); } } while (0)
#define PG8_LDB(dst, b, h) do { _Pragma("unroll") for (int n = 0; n < 2; ++n) { const PG8_LAS i32x4* _p = (const PG8_LAS i32x4*)(lds + PG8_SB(b, h) + boff + n * 2048); \
        dst[n] = __builtin_shufflevector(_p[0], _p[64], 0, 1, 2, 3, 4, 5, 6, 7); } } while (0)
#define PG8_MMA(ai, bj, At, Bt) do { __builtin_amdgcn_s_setprio(1); _Pragma("unroll") for (int m = 0; m < 4; ++m) _Pragma("unroll") for (int n = 0; n < 2; ++n) { \
        if constexpr (FP8)   \
            asm volatile("v_mfma_scale_f32_16x16x128_f8f6f4 %0, %1, %2, %0, %3, %3 op_sel_hi:[0,0,0]" : "+v"(acc[ai][bj][m][n]) : "v"(Bt[n]), "v"(At[m]), "v"(0x7F7F7F7F)); \
        else { acc[ai][bj][m][n] = __builtin_amdgcn_mfma_f32_16x16x32_bf16(__builtin_bit_cast(bf16x8, __builtin_shufflevector(Bt[n], Bt[n], 0, 1, 2, 3)), __builtin_bit_cast(bf16x8, __builtin_shufflevector(At[m], At[m], 0, 1, 2, 3)), acc[ai][bj][m][n], 0, 0, 0); \
               acc[ai][bj][m][n] = __builtin_amdgcn_mfma_f32_16x16x32_bf16(__builtin_bit_cast(bf16x8, __builtin_shufflevector(Bt[n], Bt[n], 4, 5, 6, 7)), __builtin_bit_cast(bf16x8, __builtin_shufflevector(At[m], At[m], 4, 5, 6, 7)), acc[ai][bj][m][n], 0, 0, 0); } } \
        __builtin_amdgcn_s_setprio(0); \
        if constexpr (FP8) asm volatile("" : "+v"(acc[ai][bj][0][0]), "+v"(acc[ai][bj][0][1]), "+v"(acc[ai][bj][1][0]), "+v"(acc[ai][bj][1][1]), "+v"(acc[ai][bj][2][0]), "+v"(acc[ai][bj][2][1]), "+v"(acc[ai][bj][3][0]), "+v"(acc[ai][bj][3][1]));   \
        } while (0)
#define PG8_WAIT_V(n) asm volatile("s_waitcnt vmcnt(" #n ")" ::: "memory")
#define PG8_WAIT_L(n) asm volatile("s_waitcnt lgkmcnt(" #n ")" ::: "memory")
#define PG8_BAR __builtin_amdgcn_s_barrier()
#define PG8_SCHED __builtin_amdgcn_sched_barrier(0)
#define PG8_AOFFS(dst, u) do { _Pragma("unroll") for (int _h = 0; _h < 2; ++_h) _Pragma("unroll") for (int _i = 0; _i < 2; ++_i) { int _R, _C; stage_rc((int)threadIdx.x * 16 + _i * 8192, _R, _C); \
        if constexpr (GATHER) { const int _tok = g.rowmap[(u).pm * BM + _h * HALF + _R]; dst[_h][_i] = (unsigned)(_tok * K + _C) * 2u; } \
        else dst[_h][_i] = (unsigned)((_h * HALF + _R) * K + _C) * 2u; } } while (0)
#define PG8_ABASE(u) (GATHER ? (const char*)g.A : (const char*)g.A + (size_t)(u).pm * tstep)
#define PG8_BBASE(u) ((const char*)g.Bt + ((size_t)(u).e * g.N + (size_t)(u).pn * BM) * K * 2)
    Unit cur, nxt, nn; int ui = 0;
    if (!S.next(0, cur)) return;
    bool has_next = S.next(1, nxt);
    unsigned curA[2][2], nxtA[2][2];
    PG8_AOFFS(curA, cur);
    if (has_next) PG8_AOFFS(nxtA, nxt); else {
#pragma unroll
        for (int h = 0; h < 2; ++h)
#pragma unroll
            for (int i = 0; i < 2; ++i) nxtA[h][i] = curA[h][i]; }
    f32x4 acc[2][2][4][2];
#pragma unroll
    for (int a = 0; a < 2; ++a)
#pragma unroll
        for (int b = 0; b < 2; ++b)
#pragma unroll
            for (int m = 0; m < 4; ++m)
#pragma unroll
                for (int n = 0; n < 2; ++n) acc[a][b][m][n] = (f32x4){0.f, 0.f, 0.f, 0.f};
    i32x8 At[4], B0[2], B1[2];
    const char* cA = PG8_ABASE(cur); const char* cB = PG8_BBASE(cur);
    PG8_STAGE(PG8_SB(0, 0), cB, voffB); PG8_STAGE(PG8_SB(0, 1), cB + hstep, voffB); PG8_STAGE(PG8_SA(0, 0), cA, curA[0]); PG8_STAGE(PG8_SA(0, 1), cA, curA[1]);
    if (wr == 1) PG8_BAR;
    PG8_WAIT_V(2); PG8_BAR;
    PG8_STAGE(PG8_SB(1, 0), cB + kstep, voffB); PG8_STAGE(PG8_SA(1, 0), cA + kstep, curA[0]); PG8_STAGE(PG8_SB(1, 1), cB + hstep + kstep, voffB);
    PG8_WAIT_V(6); PG8_BAR;
    for (;;) {
        const char* nA = has_next ? PG8_ABASE(nxt) : cA; const char* nB = has_next ? PG8_BBASE(nxt) : cB;
#pragma unroll 1
        for (int t = 0; t < nt; t += 2) {
            const bool last = (t == nt - 2);
            const char* a1 = cA + (size_t)(t + 1) * kstep;
            const char* a2 = last ? nA : cA + (size_t)(t + 2) * kstep; const char* b2 = last ? nB : cB + (size_t)(t + 2) * kstep;
            const char* a3 = a2 + kstep; const char* b3 = b2 + kstep;
            unsigned o2[2][2];
#pragma unroll
            for (int h = 0; h < 2; ++h)
#pragma unroll
                for (int i = 0; i < 2; ++i) o2[h][i] = last ? nxtA[h][i] : curA[h][i];
            PG8_LDB(B0, 0, 0); PG8_LDB(B1, 0, 1); PG8_SCHED; PG8_LDA(At, 0, 0); PG8_STAGE(PG8_SA(1, 1), a1, curA[1]);
            PG8_WAIT_V(8); PG8_WAIT_L(0); PG8_BAR; PG8_MMA(0, 0, At, B0); PG8_MMA(0, 1, At, B1); PG8_BAR; PG8_SCHED;
            PG8_LDA(At, 0, 1); PG8_STAGE(PG8_SB(0, 0), b2, voffB); PG8_STAGE(PG8_SB(0, 1), b2 + hstep, voffB); PG8_STAGE(PG8_SA(0, 0), a2, o2[0]);
            PG8_WAIT_V(8); PG8_WAIT_L(0); PG8_BAR; PG8_MMA(1, 0, At, B0); PG8_MMA(1, 1, At, B1); PG8_BAR; PG8_SCHED;
            PG8_LDB(B0, 1, 0); PG8_LDB(B1, 1, 1); PG8_SCHED; PG8_LDA(At, 1, 0); PG8_STAGE(PG8_SA(0, 1), a2, o2[1]);
            PG8_WAIT_V(8); PG8_WAIT_L(0); PG8_BAR; PG8_MMA(0, 0, At, B0); PG8_MMA(0, 1, At, B1); PG8_BAR; PG8_SCHED;
            PG8_LDA(At, 1, 1); PG8_STAGE(PG8_SB(1, 0), b3, voffB); PG8_STAGE(PG8_SB(1, 1), b3 + hstep, voffB); PG8_STAGE(PG8_SA(1, 0), a3, o2[0]);
            PG8_WAIT_V(8); PG8_WAIT_L(0); PG8_BAR; PG8_MMA(1, 0, At, B0); PG8_MMA(1, 1, At, B1); PG8_BAR; PG8_SCHED;
        }
        if constexpr (FP8) asm volatile("s_nop 15\n\ts_nop 15" ::: "memory");
        if (wr == 0) PG8_BAR;
        const bool has_nn = has_next && S.next(ui + 2, nn);
        unsigned nnA[2][2];
        if (has_nn) PG8_AOFFS(nnA, nn);
        E(acc, cur, wr, wc, fr, fq);
        if (!has_next) break;
#pragma unroll
        for (int a = 0; a < 2; ++a)
#pragma unroll
            for (int b = 0; b < 2; ++b)
#pragma unroll
                for (int m = 0; m < 4; ++m)
#pragma unroll
                    for (int n = 0; n < 2; ++n) acc[a][b][m][n] = (f32x4){0.f, 0.f, 0.f, 0.f};
        cur = nxt; cA = nA; cB = nB; ++ui;
#pragma unroll
        for (int h = 0; h < 2; ++h)
#pragma unroll
            for (int i = 0; i < 2; ++i) { curA[h][i] = nxtA[h][i]; if (has_nn) nxtA[h][i] = nnA[h][i]; }
        nxt = nn; has_next = has_nn;
        if (wr == 1) PG8_BAR;
    }
    PG8_WAIT_V(0);
    PG8_BAR;
#undef PG8_SA
#undef PG8_SB
#undef PG8_STAGE
#undef PG8_LDA
#undef PG8_LDB
#undef PG8_MMA
#undef PG8_WAIT_V
#undef PG8_WAIT_L
#undef PG8_BAR
#undef PG8_SCHED
#undef PG8_AOFFS
#undef PG8_ABASE
#undef PG8_BBASE
}
}

struct Frame {
    LAS unsigned char* lds;
    int tid, lane, wave, vcu, G;
    const float* const* in;
    float* out;
    unsigned char* ws;
};
template <class Tp> __device__ __forceinline__ Tp* wsp(const Frame& F, size_t off) { return (Tp*)(F.ws + off); }

__device__ __forceinline__ int dest_row(int mode, int s) {
    if (mode == 0) return s;
    if (mode == 1) return (s & ~31) | (((s >> 2) & 1) << 4) | (((s >> 3) & 3) << 2) | (s & 3);
    const int half = s >> 10, j = s & 1023;
    return ((j >> 7) << 8) | (((j >> 6) & 1) << 7) | (((j >> 4) & 3) << 5) | (half << 4) | (j & 15);
}
__device__ __forceinline__ void transpose_item(const float* W, int K, int N, bf16* WT, int mode, int item, int lane) {
    const int nblk = N / 64, kb = item / nblk, nb = item % nblk, k0 = 64 * kb, n0 = 64 * nb;
    const float* src = W + (size_t)k0 * N + n0 + lane;
    float v[64];
#pragma unroll
    for (int i = 0; i < 64; ++i) v[i] = src[(size_t)i * N];
    bf16* dst = WT + (size_t)dest_row(mode, n0 + lane) * K + k0;
#pragma unroll
    for (int j = 0; j < 8; ++j) { u32x4 o; o.x = pk2(v[8 * j], v[8 * j + 1]); o.y = pk2(v[8 * j + 2], v[8 * j + 3]); o.z = pk2(v[8 * j + 4], v[8 * j + 5]); o.w = pk2(v[8 * j + 6], v[8 * j + 7]);
        *(u32x4*)(dst + 8 * j) = o; }
}
__device__ __forceinline__ void transpose_item8(const float* W, int K, int N, unsigned char* WT, int mode, int item, int lane) {
    const int nblk = N / 64, kb = item / nblk, nb = item % nblk, k0 = 64 * kb, n0 = 64 * nb;
    const float* src = W + (size_t)k0 * N + n0 + lane;
    float v[64];
#pragma unroll
    for (int i = 0; i < 64; ++i) v[i] = __builtin_nontemporal_load(src + (size_t)i * N) * 32.f;
    unsigned char* dst = WT + (size_t)dest_row(mode, n0 + lane) * K + k0;
#pragma unroll
    for (int j = 0; j < 4; ++j) { u32x4 o; o.x = pg8::pk4_fp8(v[16 * j], v[16 * j + 1], v[16 * j + 2], v[16 * j + 3]); o.y = pg8::pk4_fp8(v[16 * j + 4], v[16 * j + 5], v[16 * j + 6], v[16 * j + 7]);
        o.z = pg8::pk4_fp8(v[16 * j + 8], v[16 * j + 9], v[16 * j + 10], v[16 * j + 11]); o.w = pg8::pk4_fp8(v[16 * j + 12], v[16 * j + 13], v[16 * j + 14], v[16 * j + 15]);
        *(u32x4*)(dst + 16 * j) = o; }
}
constexpr int MOE_I1 = 16 * 32, MOE_I2 = 16 * 16, MOE_ITEMS = NE * (MOE_I1 + MOE_I2);
__device__ __forceinline__ void moe_weight_item(const Frame& F, int it) {
#if !MK_FP8
    if (it < NE * MOE_I1) { const int e = it / MOE_I1; transpose_item(F.in[24] + (size_t)e * 1024 * 2048, 1024, 2048, wsp<bf16>(F, WS_W1) + (size_t)e * 2048 * 1024, 2, it % MOE_I1, F.lane); }
    else { const int r = it - NE * MOE_I1, e = r / MOE_I2; transpose_item(F.in[26] + (size_t)e * 1024 * 1024, 1024, 1024, wsp<bf16>(F, WS_W2) + (size_t)e * 1024 * 1024, 1, r % MOE_I2, F.lane); }
#else
    if (it < NE * MOE_I1) { const int e = it / MOE_I1; transpose_item8(F.in[24] + (size_t)e * 1024 * 2048, 1024, 2048, wsp<unsigned char>(F, WS_W1) + (size_t)e * 2048 * 1024, 2, it % MOE_I1, F.lane); }
    else { const int r = it - NE * MOE_I1, e = r / MOE_I2; transpose_item8(F.in[26] + (size_t)e * 1024 * 1024, 1024, 1024, wsp<unsigned char>(F, WS_W2) + (size_t)e * 1024 * 1024, 1, r % MOE_I2, F.lane); }
#endif
}

__device__ __forceinline__ void phase0(const Frame& F) {
    if (F.vcu < 192) {
        LAS float* sl = (LAS float*)F.lds;
        LAS float* red = (LAS float*)(F.lds + 32768);
        const float* c = F.in[1];
        for (int idx = F.tid; idx < 8192; idx += 512) { const int b = idx & 7, k = idx >> 3; const float cv = c[b * 1024 + k]; sl[idx] = cv / (1.f + __expf(-cv)); }
        __syncthreads();
        const int cl = F.tid & 31, ks = F.tid >> 5, col = F.vcu * 32 + cl;
        const float* wa = F.in[2];
        float acc[8];
#pragma unroll
        for (int b = 0; b < 8; ++b) acc[b] = 0.f;
#pragma unroll 4
        for (int kk = 0; kk < 64; ++kk) { const int k = ks * 64 + kk; const float w = wa[(size_t)k * 6144 + col];
            const f32x4 s0 = *(const LAS f32x4*)(sl + k * 8), s1 = *(const LAS f32x4*)(sl + k * 8 + 4);
            acc[0] += s0[0] * w; acc[1] += s0[1] * w; acc[2] += s0[2] * w; acc[3] += s0[3] * w;
            acc[4] += s1[0] * w; acc[5] += s1[1] * w; acc[6] += s1[2] * w; acc[7] += s1[3] * w; }
#pragma unroll
        for (int b = 0; b < 8; ++b) red[(ks * 32 + cl) * 8 + b] = acc[b];
        __syncthreads();
        if (F.tid < 256) { const int b = F.tid >> 5; float s = F.in[3][col];
            for (int q = 0; q < 16; ++q) s += red[(q * 32 + cl) * 8 + b];
            wsp<float>(F, WS_MOD)[b * 6144 + col] = s; }
    }
    const int gw = F.vcu * 8 + F.wave, NGW = F.G * 8;
    constexpr int I_IN = 16 * 40, I_OUT = 16 * 16;
    constexpr int NITEMS = I_IN + I_OUT;
    for (int it = gw; it < NITEMS; it += NGW) {
        int r = it;
        if (r < I_IN) { transpose_item(F.in[5], 1024, 2560, wsp<bf16>(F, WS_WIN), 1, r, F.lane); continue; } r -= I_IN;
        transpose_item(F.in[20], 1024, 1024, wsp<bf16>(F, WS_WOUT), 1, r, F.lane);
    }
#if MK_CONV_WHERE == 0
    for (int it = gw; it < MOE_ITEMS; it += NGW) moe_weight_item(F, it);
#endif
    { bf16* LW = wsp<bf16>(F, WS_LW);
        for (int idx = F.vcu * 512 + F.tid; idx < 256 * 512; idx += F.G * 512) { const int k = idx >> 9, c = idx & 511;
            const float v = k < 64 ? F.in[8][k * 512 + c] : (k < 128 ? F.in[10][(k - 64) * 512 + c] : F.in[11][(k - 128) * 512 + c]);
            LW[c * 256 + k] = (bf16)f2bf(v); } }
}
template <bool OUT8 = false, bool IN16 = false>
__device__ __forceinline__ void norm_row(const Frame& F, const float* xrow, const float* g, const float* shift, const float* scale, bf16* orow, f32x4 (&h)[4]) {
    const f32x4* xr = (const f32x4*)xrow + F.lane; const u32x2* xr16 = (const u32x2*)xrow + F.lane;
    float ss = 0.f;
#pragma unroll
    for (int j = 0; j < 4; ++j) { if constexpr (IN16) { const u32x2 q = __builtin_nontemporal_load(xr16 + 64 * j); h[j] = (f32x4){bflo(q.x), bfhi(q.x), bflo(q.y), bfhi(q.y)}; } else h[j] = __builtin_nontemporal_load(xr + 64 * j); ss += (h[j][0] * h[j][0] + h[j][1] * h[j][1]) + (h[j][2] * h[j][2] + h[j][3] * h[j][3]); }
    const float rstd = rsqrtf(wave_sum(ss) * (1.f / D) + NORM_EPS);
    u32x2* o8 = (u32x2*)orow + F.lane;
#pragma unroll
    for (int j = 0; j < 4; ++j) { const int col = 4 * F.lane + 256 * j;
        const f32x4 gv = *(const f32x4*)(g + col), sh = *(const f32x4*)(shift + col), sc = *(const f32x4*)(scale + col);
        h[j] = h[j] * rstd * gv * (sc + 1.f) + sh;
        if constexpr (OUT8) ((unsigned*)orow)[F.lane + 64 * j] = pg8::pk4_fp8(h[j][0], h[j][1], h[j][2], h[j][3]);
        else { u32x2 w; w.x = pk2(h[j][0], h[j][1]); w.y = pk2(h[j][2], h[j][3]); o8[64 * j] = w; } }
}
__device__ __forceinline__ void phase1(const Frame& F) {
    const int gw = F.vcu * 8 + F.wave, NGW = F.G * 8;
    const float* mod = wsp<float>(F, WS_MOD);
    for (int row = gw; row < M; row += NGW) { const int b = row / T; f32x4 h[4];
        norm_row(F, F.in[0] + (size_t)row * D, F.in[4], mod + b * 6144, mod + b * 6144 + 1024, wsp<bf16>(F, WS_H) + (size_t)row * D, h); }
}

template <int CTRL> __device__ __forceinline__ float dpp_mov(float v) { return __builtin_bit_cast(float, __builtin_amdgcn_update_dpp(0, __builtin_bit_cast(int, v), CTRL, 0xf, 0xf, false)); }
__device__ __forceinline__ float reduce16(float v) { v += dpp_mov<0xB1>(v); v += dpp_mov<0x4E>(v); v += dpp_mov<0x141>(v); v += dpp_mov<0x140>(v); return v; }
__device__ __forceinline__ void lerp8(const bf16* P, const float* mu, int tok, int t, int col, float (&x)[8]) {
    const u32x4 c = *(const u32x4*)(P + (size_t)tok * IN_COLS + col);
    u32x4 p = (u32x4){0u, 0u, 0u, 0u};
    if (t > 0) p = *(const u32x4*)(P + (size_t)(tok - 1) * IN_COLS + col);
    const f32x4 m0 = *(const f32x4*)(mu + col), m1 = *(const f32x4*)(mu + col + 4);
    const float cf[8] = {bflo(c.x), bfhi(c.x), bflo(c.y), bfhi(c.y), bflo(c.z), bfhi(c.z), bflo(c.w), bfhi(c.w)};
    const float pf[8] = {bflo(p.x), bfhi(p.x), bflo(p.y), bfhi(p.y), bflo(p.z), bfhi(p.z), bflo(p.w), bfhi(p.w)};
    const float mf[8] = {m0[0], m0[1], m0[2], m0[3], m1[0], m1[1], m1[2], m1[3]};
#pragma unroll
    for (int j = 0; j < 8; ++j) x[j] = cf[j] + (pf[j] - cf[j]) * mf[j];
}
__device__ __forceinline__ f32x4 lerp4(const bf16* P, const float* mu, int tok, int t, int col) {
    const u32x2 c = *(const u32x2*)(P + (size_t)tok * IN_COLS + col);
    u32x2 p = (u32x2){0u, 0u};
    if (t > 0) p = *(const u32x2*)(P + (size_t)(tok - 1) * IN_COLS + col);
    const f32x4 m = *(const f32x4*)(mu + col);
    const f32x4 cf = (f32x4){bflo(c.x), bfhi(c.x), bflo(c.y), bfhi(c.y)}, pf = (f32x4){bflo(p.x), bfhi(p.x), bflo(p.y), bfhi(p.y)};
    return cf + (pf - cf) * m;
}
__device__ __forceinline__ bf16x8 pack8(const float (&x)[8]) { u32x4 w; w.x = pk2(x[0], x[1]); w.y = pk2(x[2], x[3]); w.z = pk2(x[4], x[5]); w.w = pk2(x[6], x[7]); return __builtin_bit_cast(bf16x8, w); }
__device__ __forceinline__ void phase3(const Frame& F) {
    const bf16* P = wsp<bf16>(F, WS_P); const bf16* LW = wsp<bf16>(F, WS_LW);
    const float* mu = F.in[6]; const float* w0 = F.in[7]; const float* a0 = F.in[9];
    const float* k_k = F.in[12]; const float* k_a = F.in[13]; const float* r_k = F.in[14];
    float* SCN = wsp<float>(F, WS_SCN); float* SV = wsp<float>(F, WS_SV); bf16* G = wsp<bf16>(F, WS_G); float* BON = wsp<float>(F, WS_BONUS);
    const int gw = F.vcu * 8 + F.wave, NGW = F.G * 8;
    const int cl = F.lane & 15, q = F.lane >> 4;
    for (int tile = gw; tile < M / 16; tile += NGW) {
        bf16x8 Aw[2], Aa[2], Ag[4];
        { const int tok = tile * 16 + cl, t = tok % T; float x[8];
#pragma unroll
            for (int s = 0; s < 2; ++s) { lerp8(P, mu, tok, t, 1536 + 32 * s + 8 * q, x);
#pragma unroll
                for (int j = 0; j < 8; ++j) x[j] = tanhf(x[j]);
                Aw[s] = pack8(x);
                lerp8(P, mu, tok, t, 1600 + 32 * s + 8 * q, x); Aa[s] = pack8(x); }
#pragma unroll
            for (int s = 0; s < 4; ++s) { lerp8(P, mu, tok, t, 1664 + 32 * s + 8 * q, x);
#pragma unroll
                for (int j = 0; j < 8; ++j) x[j] = sigmoidf_(x[j]);
                Ag[s] = pack8(x); } }
        const int tk0 = tile * 16 + 4 * q, b = tk0 / T, t0 = tk0 % T;
#pragma unroll 1
        for (int hh = 0; hh < RH; ++hh) {
            const int c0 = hh * 64 + cl * 4;
            f32x4 accw[4], acca[4], accg[4];
#pragma unroll
            for (int ct = 0; ct < 4; ++ct) { const bf16* lw = LW + (size_t)(c0 + ct) * 256 + 8 * q;
                f32x4 aw = (f32x4){0.f, 0.f, 0.f, 0.f}, aa = aw, ag = aw;
#pragma unroll
                for (int s = 0; s < 2; ++s) { aw = __builtin_amdgcn_mfma_f32_16x16x32_bf16(Aw[s], *(const bf16x8*)(lw + 32 * s), aw, 0, 0, 0);
                    aa = __builtin_amdgcn_mfma_f32_16x16x32_bf16(Aa[s], *(const bf16x8*)(lw + 64 + 32 * s), aa, 0, 0, 0); }
#pragma unroll
                for (int s = 0; s < 4; ++s) ag = __builtin_amdgcn_mfma_f32_16x16x32_bf16(Ag[s], *(const bf16x8*)(lw + 128 + 32 * s), ag, 0, 0, 0);
                accw[ct] = aw; acca[ct] = aa; accg[ct] = ag; }
            const f32x4 w0v = *(const f32x4*)(w0 + c0), a0v = *(const f32x4*)(a0 + c0), kkv = *(const f32x4*)(k_k + c0), kav = *(const f32x4*)(k_a + c0), rkv = *(const f32x4*)(r_k + c0);
#pragma unroll
            for (int i = 0; i < 4; ++i) { const int tk = tk0 + i, t = t0 + i;
                const f32x4 r4 = lerp4(P, mu, tk, t, c0), kr4 = lerp4(P, mu, tk, t, 512 + c0), v4 = lerp4(P, mu, tk, t, 1024 + c0);
                f32x4 dec, av, gv, kk4, k4;
                float ssq = 0.f, bon = 0.f;
#pragma unroll
                for (int ct = 0; ct < 4; ++ct) {
                    dec[ct] = __expf(-0.60653066f * sigmoidf_(w0v[ct] + accw[ct][i]));
                    av[ct] = sigmoidf_(a0v[ct] + acca[ct][i]);
                    gv[ct] = accg[ct][i];
                    kk4[ct] = kr4[ct] * kkv[ct]; ssq += kk4[ct] * kk4[ct];
                    k4[ct] = kr4[ct] * (1.f + (av[ct] - 1.f) * kav[ct]);
                    bon += r4[ct] * k4[ct] * rkv[ct]; }
                ssq = reduce16(ssq); bon = reduce16(bon);
                const float inv = __builtin_amdgcn_rcpf(fmaxf(sqrtf(ssq), 1e-12f));
                const f32x4 kkn = kk4 * inv, bb = kkn * av;
                const size_t so = ((size_t)(b * RH + hh) * T + t) * 64 + cl * 4;
                float* sc = SCN + ((size_t)(b * RH + hh) * T + t) * 320 + cl * 4;
                *(f32x4*)(sc) = dec; *(f32x4*)(sc + 64) = kkn; *(f32x4*)(sc + 128) = bb; *(f32x4*)(sc + 192) = k4; *(f32x4*)(sc + 256) = r4;
                *(f32x4*)(SV + so) = v4;
                u32x2 gw2; gw2.x = pk2(gv[0], gv[1]); gw2.y = pk2(gv[2], gv[3]);
                *(u32x2*)(G + (size_t)tk * 512 + c0) = gw2;
                if (cl == 0) BON[tk * 8 + hh] = bon; }
        }
    }
}

constexpr int CK = 32, NCHK = T / CK;
#define SC_SPIN_CAP (1 << 24)
#define MFMA32(a, b, c) __builtin_amdgcn_mfma_f32_32x32x16_bf16((a), (b), (c), 0, 0, 0)
__device__ __forceinline__ int crow(int i, int h) { return (i & 3) + 8 * (i >> 2) + 4 * h; }
template <int S_> __device__ __forceinline__ bf16x8 pack_acc(const f32x16& x) { u32x4 w; w.x = pk2(x[8 * S_], x[8 * S_ + 1]); w.y = pk2(x[8 * S_ + 2], x[8 * S_ + 3]); w.z = pk2(x[8 * S_ + 4], x[8 * S_ + 5]); w.w = pk2(x[8 * S_ + 6], x[8 * S_ + 7]); return __builtin_bit_cast(bf16x8, w); }
__device__ __forceinline__ bf16x8 rd_nat(const LAS bf16* img, int stride, int row, int k0) { return *(const LAS bf16x8*)(img + row * stride + k0); }
__device__ __forceinline__ bf16x8 rd_perm(const LAS bf16* img, int stride, int row, int kb, int h) {
    const u32x2 lo = *(const LAS u32x2*)(img + row * stride + kb + 4 * h), hi = *(const LAS u32x2*)(img + row * stride + kb + 8 + 4 * h);
    u32x4 w; w.x = lo.x; w.y = lo.y; w.z = hi.x; w.w = hi.y; return __builtin_bit_cast(bf16x8, w);
}
__device__ __forceinline__ f32x16 zero16() { f32x16 z; for (int i = 0; i < 16; ++i) z[i] = 0.f; return z; }
constexpr int CL_A = 0, CL_B = 4608, CL_K = 9216, CL_R = 13824, CL_AT = 18432, CL_BHT = 23552, CL_KHT = 28672, CL_VT = 33792, CL_GTOT = 38912, CL_GC = 39936,
              CL_L = 40192, CL_T = 44800, CL_FNRB = 47360, CL_CNRK = 49408, CL_FQM = 53504, CL_GROUP = 57600;
constexpr int RMS = 72, TRS = 40, LST = 36;
__device__ __forceinline__ void phase4a_summaries(const Frame& F) {
    const float* SCN = wsp<float>(F, WS_SCN); const float* SV = wsp<float>(F, WS_SV);
    bf16x8* PT = wsp<bf16x8>(F, WS_PT); f32x4* ZV = wsp<f32x4>(F, WS_ZV); bf16x8* RYT = wsp<bf16x8>(F, WS_RYT); f32x4* YVT = wsp<f32x4>(F, WS_YVT);
    const int grp = F.tid >> 8, gt = F.tid & 255, w4 = F.wave & 3, lane = F.lane, r = lane & 31, h = lane >> 5;
    LAS unsigned char* gl = F.lds + grp * CL_GROUP;
    LAS bf16* iA = (LAS bf16*)(gl + CL_A); LAS bf16* iB = (LAS bf16*)(gl + CL_B); LAS bf16* iK = (LAS bf16*)(gl + CL_K); LAS bf16* iR = (LAS bf16*)(gl + CL_R);
    LAS bf16* iAT = (LAS bf16*)(gl + CL_AT); LAS bf16* iBHT = (LAS bf16*)(gl + CL_BHT); LAS bf16* iKHT = (LAS bf16*)(gl + CL_KHT); LAS bf16* iVT = (LAS bf16*)(gl + CL_VT);
    LAS float* gtot = (LAS float*)(gl + CL_GTOT); LAS float* gcv = (LAS float*)(gl + CL_GC); LAS float* Lm = (LAS float*)(gl + CL_L); LAS bf16* Tm = (LAS bf16*)(gl + CL_T);
    LAS bf16x8* fnrb = (LAS bf16x8*)(gl + CL_FNRB); LAS float* cnrk = (LAS float*)(gl + CL_CNRK); LAS bf16x8* fqm = (LAS bf16x8*)(gl + CL_FQM);
    constexpr int NCHUNKS = NBATCH * RH * NCHK;
    for (int it = F.vcu; it < NCHUNKS / 2; it += F.G) {
        const int chunk = it * 2 + grp, bh = chunk / NCHK, c = chunk % NCHK, t0 = c * CK;
        __syncthreads();
        { const int k = gt & 63, tq = gt >> 6;
            float wv[8], kkv[8], bv[8], kv[8], rv[8], vv[8], lp[8];
#pragma unroll
            for (int i = 0; i < 8; ++i) { const size_t row = (size_t)bh * T + t0 + 8 * tq + i; const float* sc = SCN + row * 320 + k;
                wv[i] = sc[0]; kkv[i] = sc[64]; bv[i] = sc[128]; kv[i] = sc[192]; rv[i] = sc[256]; vv[i] = SV[row * 64 + k]; }
            lp[0] = wv[0];
#pragma unroll
            for (int i = 1; i < 8; ++i) lp[i] = lp[i - 1] * wv[i];
            gtot[tq * 64 + k] = lp[7];
            __syncthreads();
            const float g0 = gtot[k], g1 = gtot[64 + k], g2 = gtot[128 + k], g3 = gtot[192 + k];
            const float pre = tq == 0 ? 1.f : (tq == 1 ? g0 : (tq == 2 ? g0 * g1 : g0 * g1 * g2)), gC = (g0 * g1) * (g2 * g3);
            float at[8], bh8[8], kh8[8];
#pragma unroll
            for (int i = 0; i < 8; ++i) { const float g = pre * lp[i], gp = i == 0 ? pre : pre * lp[i - 1], ig = __builtin_amdgcn_rcpf(g);
                const float bt = bv[i] * ig, kt = kv[i] * ig; at[i] = -kkv[i] * gp; bh8[i] = bt * gC; kh8[i] = kt * gC;
                const int ro = (8 * tq + i) * RMS + k;
                iA[ro] = (bf16)f2bf(at[i]); iB[ro] = (bf16)f2bf(bt); iK[ro] = (bf16)f2bf(kt); iR[ro] = (bf16)f2bf(rv[i] * g); }
            *(LAS bf16x8*)(iAT + k * TRS + 8 * tq) = pack8(at); *(LAS bf16x8*)(iBHT + k * TRS + 8 * tq) = pack8(bh8); *(LAS bf16x8*)(iKHT + k * TRS + 8 * tq) = pack8(kh8);
            *(LAS bf16x8*)(iVT + k * TRS + 8 * tq) = pack8(vv);
            if (tq == 0) gcv[k] = gC; }
        __syncthreads();
        f32x16 lak = zero16();
        { const LAS bf16* ia = (w4 < 2) ? iA : (w4 == 2 ? iB : iK); const LAS bf16* ib = (w4 == 0) ? iB : (w4 == 1 ? iK : iR);
            f32x16 acc = zero16();
#pragma unroll
            for (int ks = 0; ks < 4; ++ks) acc = MFMA32(rd_nat(ia, RMS, r, 16 * ks + 8 * h), rd_nat(ib, RMS, r, 16 * ks + 8 * h), acc);
#pragma unroll
            for (int i = 0; i < 16; ++i) { const int row = crow(i, h); const bool keep = (w4 < 2) ? (r < row) : (row <= r); acc[i] = keep ? acc[i] : 0.f; }
            if (w4 == 0) {
#pragma unroll
                for (int i = 0; i < 16; ++i) Lm[crow(i, h) * LST + r] = acc[i]; }
            else if (w4 == 1) lak = acc;
            else if (w4 == 2) { fnrb[lane] = pack_acc<0>(acc); fnrb[64 + lane] = pack_acc<1>(acc); }
            else {
#pragma unroll
                for (int i = 0; i < 16; ++i) cnrk[i * 64 + lane] = acc[i]; } }
        __syncthreads();
        if (w4 == 0) { float Tr[32];
#pragma unroll
            for (int t = 0; t < 32; ++t) { float acc = (t == r) ? 1.f : 0.f;
#pragma unroll
                for (int s4 = 0; s4 < (t + 3) / 4; ++s4) { const f32x4 l4 = *(const LAS f32x4*)(Lm + t * LST + 4 * s4);
#pragma unroll
                    for (int q = 0; q < 4; ++q) if (4 * s4 + q < t) acc += l4[q] * Tr[4 * s4 + q]; }
                Tr[t] = acc; }
            if (lane < 32) {
#pragma unroll
                for (int t = 0; t < 32; ++t) Tm[t * TRS + r] = (bf16)f2bf(Tr[t]); } }
        __syncthreads();
        if (w4 == 0 || w4 == 2) { const int a = w4 >> 1;
            f32x16 x1 = zero16();
#pragma unroll
            for (int ks = 0; ks < 2; ++ks) x1 = MFMA32(rd_nat(Tm, TRS, r, 16 * ks + 8 * h), rd_nat(iAT, TRS, 32 * a + r, 16 * ks + 8 * h), x1);
            const bf16x8 xf0 = pack_acc<0>(x1), xf1 = pack_acc<1>(x1);
#pragma unroll
            for (int b = 0; b < 2; ++b) { f32x16 p = zero16();
                p = MFMA32(xf0, rd_perm(iBHT, TRS, 32 * b + r, 0, h), p); p = MFMA32(xf1, rd_perm(iBHT, TRS, 32 * b + r, 16, h), p);
                if (a == b) { const float gc = gcv[32 * a + r];
#pragma unroll
                    for (int i = 0; i < 16; ++i) p[i] += (crow(i, h) == r) ? gc : 0.f; }
                bf16x8* dst = PT + ((size_t)(chunk * 2 + a) * 2 + b) * 2 * 64 + lane; dst[0] = pack_acc<0>(p); dst[64] = pack_acc<1>(p); }
            f32x16 ry;
#pragma unroll
            for (int g = 0; g < 4; ++g) { const u32x2 rr = *(const LAS u32x2*)(iR + r * RMS + 32 * a + 8 * g + 4 * h);
                ry[4 * g] = bflo(rr.x); ry[4 * g + 1] = bfhi(rr.x); ry[4 * g + 2] = bflo(rr.y); ry[4 * g + 3] = bfhi(rr.y); }
            ry = MFMA32(xf0, fnrb[lane], ry); ry = MFMA32(xf1, fnrb[64 + lane], ry);
            bf16x8* dr = RYT + (size_t)(chunk * 2 + a) * 2 * 64 + lane; dr[0] = pack_acc<0>(ry); dr[64] = pack_acc<1>(ry);
        } else if (w4 == 1) {
            f32x16 x2 = zero16();
            x2 = MFMA32(rd_perm(Tm, TRS, r, 0, h), pack_acc<0>(lak), x2); x2 = MFMA32(rd_perm(Tm, TRS, r, 16, h), pack_acc<1>(lak), x2);
            const bf16x8 xf0 = pack_acc<0>(x2), xf1 = pack_acc<1>(x2);
#pragma unroll
            for (int b = 0; b < 2; ++b) { f32x16 qm;
#pragma unroll
                for (int g = 0; g < 4; ++g) { const u32x2 kk2 = *(const LAS u32x2*)(iKHT + (32 * b + r) * TRS + 8 * g + 4 * h);
                    qm[4 * g] = bflo(kk2.x); qm[4 * g + 1] = bfhi(kk2.x); qm[4 * g + 2] = bflo(kk2.y); qm[4 * g + 3] = bfhi(kk2.y); }
                qm = MFMA32(xf0, rd_perm(iBHT, TRS, 32 * b + r, 0, h), qm); qm = MFMA32(xf1, rd_perm(iBHT, TRS, 32 * b + r, 16, h), qm);
                fqm[(b * 2 + 0) * 64 + lane] = pack_acc<0>(qm); fqm[(b * 2 + 1) * 64 + lane] = pack_acc<1>(qm); }
            f32x16 gy;
#pragma unroll
            for (int i = 0; i < 16; ++i) gy[i] = cnrk[i * 64 + lane];
            gy = MFMA32(xf0, fnrb[lane], gy); gy = MFMA32(xf1, fnrb[64 + lane], gy);
            const bf16x8 gf0 = pack_acc<0>(gy), gf1 = pack_acc<1>(gy);
#pragma unroll
            for (int vh = 0; vh < 2; ++vh) { f32x16 yv = zero16();
                yv = MFMA32(rd_perm(iVT, TRS, 32 * vh + r, 0, h), gf0, yv); yv = MFMA32(rd_perm(iVT, TRS, 32 * vh + r, 16, h), gf1, yv);
                bf16x8* dy = (bf16x8*)YVT + ((size_t)(chunk * 2 + vh) * 64 + lane) * 2;
                dy[0] = pack_acc<0>(yv); dy[1] = pack_acc<1>(yv); }
        }
        __syncthreads();
        if (w4 == 3) {
#pragma unroll
            for (int b = 0; b < 2; ++b)
#pragma unroll
                for (int vh = 0; vh < 2; ++vh) { f32x16 zv = zero16();
                    zv = MFMA32(fqm[(b * 2 + 0) * 64 + lane], rd_perm(iVT, TRS, 32 * vh + r, 0, h), zv); zv = MFMA32(fqm[(b * 2 + 1) * 64 + lane], rd_perm(iVT, TRS, 32 * vh + r, 16, h), zv);
                    bf16x8* dz = (bf16x8*)ZV + (((size_t)(chunk * 2 + b) * 2 + vh) * 64 + lane) * 2;
                    dz[0] = pack_acc<0>(zv); dz[1] = pack_acc<1>(zv); }
        }
    }
}
constexpr int CL2_LA = 2 * CL_GROUP, LAS_STRIDE = 264;
static_assert(CL2_LA + 32 * LAS_STRIDE * 2 <= MISC_OFF, "fused summaries LDS map");
__device__ __forceinline__ void phase4a_fused(const Frame& F) {
    const bf16* P = wsp<bf16>(F, WS_P); const bf16* LW = wsp<bf16>(F, WS_LW);
    const float* mu = F.in[6]; const float* w0 = F.in[7]; const float* a0 = F.in[9]; const float* k_k = F.in[12]; const float* k_a = F.in[13]; const float* r_k = F.in[14];
    float* SV = wsp<float>(F, WS_SV); bf16* G = wsp<bf16>(F, WS_G); float* BON = wsp<float>(F, WS_BONUS);
    bf16x8* PT = wsp<bf16x8>(F, WS_PT); f32x4* ZV = wsp<f32x4>(F, WS_ZV); bf16x8* RYT = wsp<bf16x8>(F, WS_RYT); f32x4* YVT = wsp<f32x4>(F, WS_YVT);
    const int grp = F.tid >> 8, gt = F.tid & 255, w4 = F.wave & 3, lane = F.lane, r = lane & 31, h = lane >> 5;
    LAS unsigned char* gl = F.lds + grp * CL_GROUP;
    LAS bf16* iA = (LAS bf16*)(gl + CL_A); LAS bf16* iB = (LAS bf16*)(gl + CL_B); LAS bf16* iK = (LAS bf16*)(gl + CL_K); LAS bf16* iR = (LAS bf16*)(gl + CL_R);
    LAS bf16* iAT = (LAS bf16*)(gl + CL_AT); LAS bf16* iBHT = (LAS bf16*)(gl + CL_BHT); LAS bf16* iKHT = (LAS bf16*)(gl + CL_KHT); LAS bf16* iVT = (LAS bf16*)(gl + CL_VT);
    LAS float* gtot = (LAS float*)(gl + CL_GTOT); LAS float* gcv = (LAS float*)(gl + CL_GC); LAS float* Lm = (LAS float*)(gl + CL_L); LAS bf16* Tm = (LAS bf16*)(gl + CL_T);
    LAS bf16x8* fnrb = (LAS bf16x8*)(gl + CL_FNRB); LAS float* cnrk = (LAS float*)(gl + CL_CNRK); LAS bf16x8* fqm = (LAS bf16x8*)(gl + CL_FQM);
    LAS float* lwo_w = (LAS float*)(gl + CL_L); LAS float* lwo_a = lwo_w + 32 * 64;
    LAS bf16* LA = (LAS bf16*)(F.lds + CL2_LA);
    bf16 cr[9], ck[9], cv[9]; float cst[8]; bool tz;
#define S1_LOAD(tc_, hp_) do { const int _hh = 2 * (hp_) + grp, _cc = _hh * 64 + (gt & 63), _t0 = ((tc_) % NCHK) * CK + 8 * (gt >> 6); \
        const size_t _pr = ((size_t)((tc_) / NCHK) * T + _t0) * IN_COLS + _cc; tz = _t0 > 0; const size_t _pp = tz ? _pr - IN_COLS : _pr; \
        cr[0] = __builtin_nontemporal_load(P + _pp); ck[0] = __builtin_nontemporal_load(P + _pp + 512); cv[0] = __builtin_nontemporal_load(P + _pp + 1024); \
        _Pragma("unroll") for (int _i = 0; _i < 8; ++_i) { cr[_i + 1] = __builtin_nontemporal_load(P + _pr + (size_t)_i * IN_COLS); ck[_i + 1] = __builtin_nontemporal_load(P + _pr + (size_t)_i * IN_COLS + 512); cv[_i + 1] = __builtin_nontemporal_load(P + _pr + (size_t)_i * IN_COLS + 1024); } \
        cst[0] = mu[_cc]; cst[1] = mu[512 + _cc]; cst[2] = mu[1024 + _cc]; cst[3] = w0[_cc]; cst[4] = a0[_cc]; cst[5] = k_k[_cc]; cst[6] = k_a[_cc]; cst[7] = r_k[_cc]; } while (0)
    bf16x8 lwf[8];
#define LW_LOAD(hp_) do { const bf16* _lw = LW + (size_t)((2 * (hp_) + grp) * 64 + 32 * (w4 & 1) + r) * 256 + 8 * h + (w4 < 2 ? 0 : 128); \
        _Pragma("unroll") for (int _q = 0; _q < 8; ++_q) lwf[_q] = *(const bf16x8*)(_lw + 16 * _q); } while (0)
    S1_LOAD(F.vcu, 0);
    LW_LOAD(0);
    u32x4 sa_c[2], sa_p[2]; float sa_mu[2][8];
#pragma unroll
    for (int q8 = 0; q8 < 2; ++q8)
#pragma unroll
        for (int j = 0; j < 8; ++j) sa_mu[q8][j] = mu[1536 + (F.tid & 15) * 16 + 8 * q8 + j];
#define SA_LOAD(tc_) do { const int _tk = F.tid >> 4, _t = ((tc_) % NCHK) * CK + _tk; const size_t _row = (size_t)((tc_) / NCHK) * T + _t; \
        _Pragma("unroll") for (int _q = 0; _q < 2; ++_q) { const size_t _o = _row * IN_COLS + 1536 + (F.tid & 15) * 16 + 8 * _q; \
            sa_c[_q] = __builtin_nontemporal_load((const u32x4*)(P + _o)); sa_p[_q] = __builtin_nontemporal_load((const u32x4*)(P + (_t > 0 ? _o - IN_COLS : _o))); } } while (0)
    SA_LOAD(F.vcu);
    for (int tc = F.vcu; tc < M / CK; tc += F.G) {
        const int b = tc / NCHK, c = tc % NCHK, t0 = c * CK, row0 = b * T + t0;
        lds_barrier();
        { const int tk = F.tid >> 4, cb = (F.tid & 15) * 16; float x[8];
#pragma unroll
            for (int q8 = 0; q8 < 2; ++q8) { const int col = cb + 8 * q8;
                { const u32x4 c_ = sa_c[q8], p_ = (t0 + tk > 0) ? sa_p[q8] : (u32x4){0u, 0u, 0u, 0u};
                    const float cf[8] = {bflo(c_.x), bfhi(c_.x), bflo(c_.y), bfhi(c_.y), bflo(c_.z), bfhi(c_.z), bflo(c_.w), bfhi(c_.w)};
                    const float pf[8] = {bflo(p_.x), bfhi(p_.x), bflo(p_.y), bfhi(p_.y), bflo(p_.z), bfhi(p_.z), bflo(p_.w), bfhi(p_.w)};
#pragma unroll
                    for (int j = 0; j < 8; ++j) x[j] = cf[j] + (pf[j] - cf[j]) * sa_mu[q8][j]; }
                if (col < 64) {
#pragma unroll
                    for (int j = 0; j < 8; ++j) x[j] = 2.f * sigmoidf_(2.f * x[j]) - 1.f; }
                else if (col >= 128) {
#pragma unroll
                    for (int j = 0; j < 8; ++j) x[j] = sigmoidf_(x[j]); }
                *(LAS bf16x8*)(LA + tk * LAS_STRIDE + col) = pack8(x); }
            const int ntc = (tc + F.G < M / CK) ? tc + F.G : tc; SA_LOAD(ntc); }
#pragma unroll 1
        for (int hp = 0; hp < 4; ++hp) {
            const int hh = 2 * hp + grp, bh = b * RH + hh, chunk = bh * NCHK + c;
            lds_barrier();
            { const int ct = w4 & 1;
                if (w4 < 2) {
                    f32x16 aw = zero16(), aa = zero16();
#pragma unroll
                    for (int ks = 0; ks < 4; ++ks) { aw = MFMA32(rd_nat(LA, LAS_STRIDE, r, 16 * ks + 8 * h), lwf[ks], aw); aa = MFMA32(rd_nat(LA, LAS_STRIDE, r, 64 + 16 * ks + 8 * h), lwf[4 + ks], aa); }
#pragma unroll
                    for (int i = 0; i < 16; ++i) { lwo_w[crow(i, h) * 64 + 32 * ct + r] = aw[i]; lwo_a[crow(i, h) * 64 + 32 * ct + r] = aa[i]; }
                } else {
                    f32x16 ag = zero16();
#pragma unroll
                    for (int ks = 0; ks < 8; ++ks) ag = MFMA32(rd_nat(LA, LAS_STRIDE, r, 128 + 16 * ks + 8 * h), lwf[ks], ag);
#pragma unroll
                    for (int i = 0; i < 16; ++i) G[(size_t)(row0 + crow(i, h)) * 512 + hh * 64 + 32 * ct + r] = (bf16)f2bf(ag[i]); } }
            LW_LOAD((hp + 1) & 3);
            lds_barrier();
            auto st1 = [&]() { const int k = gt & 63, tq = gt >> 6, cc = hh * 64 + k;
                float wv[8], kkv[8], bv[8], kv[8], rv[8], vv[8], lp[8];
                { const float mur = cst[0], muk = cst[1], muv = cst[2], w0c = cst[3], a0c = cst[4], kkc = cst[5], kac = cst[6], rkc = cst[7];
                    const int tl0 = 8 * tq;
                    if (!tz) { cr[0] = 0; ck[0] = 0; cv[0] = 0; }
                    float lw_[8], la_[8];
#pragma unroll
                    for (int i = 0; i < 8; ++i) { lw_[i] = lwo_w[(tl0 + i) * 64 + k]; la_[i] = lwo_a[(tl0 + i) * 64 + k]; }
                    float kk[8], ssq[8], bo[8], av[8];
#pragma unroll
                    for (int i = 0; i < 8; ++i) { const float c_r = bf2f(cr[i + 1]), c_k = bf2f(ck[i + 1]), c_v = bf2f(cv[i + 1]);
                        rv[i] = c_r + (bf2f(cr[i]) - c_r) * mur; const float kr = c_k + (bf2f(ck[i]) - c_k) * muk; vv[i] = c_v + (bf2f(cv[i]) - c_v) * muv;
                        wv[i] = __expf(-0.60653066f * sigmoidf_(w0c + lw_[i])); av[i] = sigmoidf_(a0c + la_[i]);
                        kk[i] = kr * kkc; ssq[i] = kk[i] * kk[i]; kv[i] = kr * (1.f + (av[i] - 1.f) * kac); bo[i] = rv[i] * kv[i] * rkc; }
#pragma unroll
                    for (int i = 0; i < 8; ++i) { ssq[i] = reduce16(ssq[i]); bo[i] = reduce16(bo[i]); }
#pragma unroll
                    for (int i = 0; i < 8; ++i) { ssq[i] += __shfl_xor(ssq[i], 16); bo[i] += __shfl_xor(bo[i], 16); }
#pragma unroll
                    for (int i = 0; i < 8; ++i) { ssq[i] += __shfl_xor(ssq[i], 32); bo[i] += __shfl_xor(bo[i], 32); }
#pragma unroll
                    for (int i = 0; i < 8; ++i) { kkv[i] = kk[i] * __builtin_amdgcn_rcpf(fmaxf(sqrtf(ssq[i]), 1e-12f)); bv[i] = kkv[i] * av[i];
                        ((bf16*)SV)[((size_t)bh * T + t0 + tl0 + i) * 64 + k] = (bf16)f2bf(vv[i]);
                        if (k == 0) BON[(row0 + tl0 + i) * 8 + hh] = bo[i]; } }
                lp[0] = wv[0];
#pragma unroll
                for (int i = 1; i < 8; ++i) lp[i] = lp[i - 1] * wv[i];
                gtot[tq * 64 + k] = lp[7];
                lds_barrier();
                const float g0 = gtot[k], g1 = gtot[64 + k], g2 = gtot[128 + k], g3 = gtot[192 + k];
                const float pre = tq == 0 ? 1.f : (tq == 1 ? g0 : (tq == 2 ? g0 * g1 : g0 * g1 * g2)), gC = (g0 * g1) * (g2 * g3);
                float at[8], bh8[8], kh8[8];
#pragma unroll
                for (int i = 0; i < 8; ++i) { const float g = pre * lp[i], gp = i == 0 ? pre : pre * lp[i - 1], ig = __builtin_amdgcn_rcpf(g);
                    const float bt = bv[i] * ig, kt = kv[i] * ig; at[i] = -kkv[i] * gp; bh8[i] = bt * gC; kh8[i] = kt * gC;
                    const int ro = (8 * tq + i) * RMS + k;
                    iA[ro] = (bf16)f2bf(at[i]); iB[ro] = (bf16)f2bf(bt); iK[ro] = (bf16)f2bf(kt); iR[ro] = (bf16)f2bf(rv[i] * g); }
                *(LAS bf16x8*)(iAT + k * TRS + 8 * tq) = pack8(at); *(LAS bf16x8*)(iBHT + k * TRS + 8 * tq) = pack8(bh8); *(LAS bf16x8*)(iKHT + k * TRS + 8 * tq) = pack8(kh8);
                *(LAS bf16x8*)(iVT + k * TRS + 8 * tq) = pack8(vv);
                if (tq == 0) gcv[k] = gC; };
            st1();
#if MK_DUP & 2
            lds_barrier(); asm volatile("" ::: "memory"); st1();
#endif
            { const int ntc = (hp < 3) ? tc : (tc + F.G < M / CK ? tc + F.G : tc), nhp = (hp < 3) ? hp + 1 : 0; S1_LOAD(ntc, nhp); }
            lds_barrier();
            f32x16 lak = zero16();
            { const LAS bf16* ia = (w4 < 2) ? iA : (w4 == 2 ? iB : iK); const LAS bf16* ib = (w4 == 0) ? iB : (w4 == 1 ? iK : iR);
                f32x16 acc = zero16();
#pragma unroll
                for (int ks = 0; ks < 4; ++ks) acc = MFMA32(rd_nat(ia, RMS, r, 16 * ks + 8 * h), rd_nat(ib, RMS, r, 16 * ks + 8 * h), acc);
#pragma unroll
                for (int i = 0; i < 16; ++i) { const int row = crow(i, h); const bool keep = (w4 < 2) ? (r < row) : (row <= r); acc[i] = keep ? acc[i] : 0.f; }
                if (w4 <= 1) lak = acc;
                else if (w4 == 2) { fnrb[lane] = pack_acc<0>(acc); fnrb[64 + lane] = pack_acc<1>(acc); }
                else {
#pragma unroll
                    for (int i = 0; i < 16; ++i) cnrk[i * 64 + lane] = acc[i]; } }
            lds_barrier();
            auto st3 = [&]() { if (w4 == 0) {
                LAS bf16* imgL = (LAS bf16*)(gl + CL_L);
                f32x16 Lp = lak, Tq = lak;
#pragma unroll
                for (int i = 0; i < 16; ++i) Tq[i] += (crow(i, h) == r) ? 1.f : 0.f;
#pragma unroll
                for (int st = 0; st < 4; ++st) {
#pragma unroll
                    for (int i = 0; i < 16; ++i) { imgL[crow(i, h) * TRS + r] = (bf16)f2bf(Lp[i]); Tm[crow(i, h) * TRS + r] = (bf16)f2bf(Tq[i]); }
                    asm volatile("s_waitcnt lgkmcnt(0)" ::: "memory");
                    const bf16x8 b0 = pack_acc<0>(Lp), b1 = pack_acc<1>(Lp);
                    f32x16 l2 = zero16(); l2 = MFMA32(rd_perm(imgL, TRS, r, 0, h), b0, l2); l2 = MFMA32(rd_perm(imgL, TRS, r, 16, h), b1, l2);
                    Lp = l2;
                    f32x16 mm = l2;
#pragma unroll
                    for (int i = 0; i < 16; ++i) mm[i] += (crow(i, h) == r) ? 1.f : 0.f;
                    const bf16x8 m0 = pack_acc<0>(mm), m1 = pack_acc<1>(mm);
                    f32x16 t2 = zero16(); t2 = MFMA32(rd_perm(Tm, TRS, r, 0, h), m0, t2); t2 = MFMA32(rd_perm(Tm, TRS, r, 16, h), m1, t2);
                    Tq = t2;
                    asm volatile("s_waitcnt lgkmcnt(0)" ::: "memory"); }
#pragma unroll
                for (int i = 0; i < 16; ++i) Tm[crow(i, h) * TRS + r] = (bf16)f2bf(Tq[i]); } };
            st3();
#if MK_DUP & 4
            asm volatile("" ::: "memory"); st3();
#endif
            lds_barrier();
            auto st4 = [&]() { if (w4 == 0 || w4 == 2) { const int a = w4 >> 1;
                f32x16 x1 = zero16();
#pragma unroll
                for (int ks = 0; ks < 2; ++ks) x1 = MFMA32(rd_nat(Tm, TRS, r, 16 * ks + 8 * h), rd_nat(iAT, TRS, 32 * a + r, 16 * ks + 8 * h), x1);
                const bf16x8 xf0 = pack_acc<0>(x1), xf1 = pack_acc<1>(x1);
#pragma unroll
                for (int b = 0; b < 2; ++b) { f32x16 p = zero16();
                    p = MFMA32(xf0, rd_perm(iBHT, TRS, 32 * b + r, 0, h), p); p = MFMA32(xf1, rd_perm(iBHT, TRS, 32 * b + r, 16, h), p);
                    if (a == b) { const float gc = gcv[32 * a + r];
#pragma unroll
                        for (int i = 0; i < 16; ++i) p[i] += (crow(i, h) == r) ? gc : 0.f; }
                    bf16x8* dst = PT + ((size_t)(chunk * 2 + a) * 2 + b) * 2 * 64 + lane; dst[0] = pack_acc<0>(p); dst[64] = pack_acc<1>(p); }
                f32x16 ry;
#pragma unroll
                for (int g = 0; g < 4; ++g) { const u32x2 rr = *(const LAS u32x2*)(iR + r * RMS + 32 * a + 8 * g + 4 * h);
                    ry[4 * g] = bflo(rr.x); ry[4 * g + 1] = bfhi(rr.x); ry[4 * g + 2] = bflo(rr.y); ry[4 * g + 3] = bfhi(rr.y); }
                ry = MFMA32(xf0, fnrb[lane], ry); ry = MFMA32(xf1, fnrb[64 + lane], ry);
                bf16x8* dr = RYT + (size_t)(chunk * 2 + a) * 2 * 64 + lane; dr[0] = pack_acc<0>(ry); dr[64] = pack_acc<1>(ry);
            } else if (w4 == 1) {
                f32x16 x2 = zero16();
                x2 = MFMA32(rd_perm(Tm, TRS, r, 0, h), pack_acc<0>(lak), x2); x2 = MFMA32(rd_perm(Tm, TRS, r, 16, h), pack_acc<1>(lak), x2);
                const bf16x8 xf0 = pack_acc<0>(x2), xf1 = pack_acc<1>(x2);
#pragma unroll
                for (int b = 0; b < 2; ++b) { f32x16 qm;
#pragma unroll
                    for (int g = 0; g < 4; ++g) { const u32x2 kk2 = *(const LAS u32x2*)(iKHT + (32 * b + r) * TRS + 8 * g + 4 * h);
                        qm[4 * g] = bflo(kk2.x); qm[4 * g + 1] = bfhi(kk2.x); qm[4 * g + 2] = bflo(kk2.y); qm[4 * g + 3] = bfhi(kk2.y); }
                    qm = MFMA32(xf0, rd_perm(iBHT, TRS, 32 * b + r, 0, h), qm); qm = MFMA32(xf1, rd_perm(iBHT, TRS, 32 * b + r, 16, h), qm);
                    fqm[(b * 2 + 0) * 64 + lane] = pack_acc<0>(qm); fqm[(b * 2 + 1) * 64 + lane] = pack_acc<1>(qm); }
                f32x16 gy;
#pragma unroll
                for (int i = 0; i < 16; ++i) gy[i] = cnrk[i * 64 + lane];
                gy = MFMA32(xf0, fnrb[lane], gy); gy = MFMA32(xf1, fnrb[64 + lane], gy);
                const bf16x8 gf0 = pack_acc<0>(gy), gf1 = pack_acc<1>(gy);
#pragma unroll
                for (int vh = 0; vh < 2; ++vh) { f32x16 yv = zero16();
                    yv = MFMA32(rd_perm(iVT, TRS, 32 * vh + r, 0, h), gf0, yv); yv = MFMA32(rd_perm(iVT, TRS, 32 * vh + r, 16, h), gf1, yv);
                    bf16x8* dy = (bf16x8*)YVT + ((size_t)(chunk * 2 + vh) * 64 + lane) * 2;
                    dy[0] = pack_acc<0>(yv); dy[1] = pack_acc<1>(yv); }
            } };
            st4();
#if MK_DUP & 8
            asm volatile("" ::: "memory"); st4();
#endif
            lds_barrier();
            if (w4 == 3) {
#pragma unroll
                for (int b = 0; b < 2; ++b)
#pragma unroll
                    for (int vh = 0; vh < 2; ++vh) { f32x16 zv = zero16();
                        zv = MFMA32(fqm[(b * 2 + 0) * 64 + lane], rd_perm(iVT, TRS, 32 * vh + r, 0, h), zv); zv = MFMA32(fqm[(b * 2 + 1) * 64 + lane], rd_perm(iVT, TRS, 32 * vh + r, 16, h), zv);
                        bf16x8* dz = (bf16x8*)ZV + (((size_t)(chunk * 2 + b) * 2 + vh) * 64 + lane) * 2;
                        dz[0] = pack_acc<0>(zv); dz[1] = pack_acc<1>(zv); }
            }
        }
    }
#undef S1_LOAD
#undef LW_LOAD
#undef SA_LOAD
}
constexpr int WRS = 68, WTS = 36;
constexpr int WL_A = 0, WL_B = 4352, WL_K = 8704, WL_R = 13056, WL_AT = 17408, WL_BHT = 22016, WL_KHT = 26624, WL_VT = 31232, WL_SIZE = 35840, WL_LA = 4 * WL_SIZE;
static_assert(WL_LA + 32 * LAS_STRIDE * 2 <= MISC_OFF, "wave-per-chunk LDS map");
__device__ __forceinline__ bf16x8 rd_nat2(const LAS bf16* img, int stride, int row, int k0) {
    const u32x2 lo = *(const LAS u32x2*)(img + row * stride + k0), hi = *(const LAS u32x2*)(img + row * stride + k0 + 4);
    u32x4 w; w.x = lo.x; w.y = lo.y; w.z = hi.x; w.w = hi.y; return __builtin_bit_cast(bf16x8, w);
}
__device__ __forceinline__ void phase4a_wave(const Frame& F) {
    const bf16* P = wsp<bf16>(F, WS_P); const bf16* LW = wsp<bf16>(F, WS_LW);
    const float* mu = F.in[6]; const float* w0 = F.in[7]; const float* a0 = F.in[9]; const float* k_k = F.in[12]; const float* k_a = F.in[13]; const float* r_k = F.in[14];
    float* SV = wsp<float>(F, WS_SV); bf16* G = wsp<bf16>(F, WS_G); float* BON = wsp<float>(F, WS_BONUS);
    bf16x8* PT = wsp<bf16x8>(F, WS_PT); f32x4* ZV = wsp<f32x4>(F, WS_ZV); bf16x8* RYT = wsp<bf16x8>(F, WS_RYT); f32x4* YVT = wsp<f32x4>(F, WS_YVT);
    const int wv_ = F.wave & 3;
    LAS unsigned char* gl = F.lds + wv_ * WL_SIZE;
    LAS bf16* iA = (LAS bf16*)(gl + WL_A); LAS bf16* iB = (LAS bf16*)(gl + WL_B); LAS bf16* iK = (LAS bf16*)(gl + WL_K); LAS bf16* iR = (LAS bf16*)(gl + WL_R);
    LAS bf16* iAT = (LAS bf16*)(gl + WL_AT); LAS bf16* iBHT = (LAS bf16*)(gl + WL_BHT); LAS bf16* iKHT = (LAS bf16*)(gl + WL_KHT); LAS bf16* iVT = (LAS bf16*)(gl + WL_VT);
    LAS bf16* imgL = iA; LAS bf16* Tm = iB;
    LAS bf16* LA = (LAS bf16*)(F.lds + WL_LA);
    for (int tc = F.vcu; tc < M / CK; tc += F.G) {
        const int b = tc / NCHK, c = tc % NCHK, t0 = c * CK, row0 = b * T + t0;
        lds_barrier();
        { const int tk = F.tid >> 4, cb = (F.tid & 15) * 16; float x[8];
#pragma unroll
            for (int q8 = 0; q8 < 2; ++q8) { const int col = cb + 8 * q8; lerp8(P, mu, row0 + tk, t0 + tk, 1536 + col, x);
                if (col < 64) {
#pragma unroll
                    for (int j = 0; j < 8; ++j) x[j] = 2.f * sigmoidf_(2.f * x[j]) - 1.f; }
                else if (col >= 128) {
#pragma unroll
                    for (int j = 0; j < 8; ++j) x[j] = sigmoidf_(x[j]); }
                *(LAS bf16x8*)(LA + tk * LAS_STRIDE + col) = pack8(x); } }
        lds_barrier();
        if (F.wave < 4) {
#pragma unroll 1
        for (int rnd = 0; rnd < 2; ++rnd) {
            int lane = F.lane; asm volatile("" : "+v"(lane));
            const int r = lane & 31, h = lane >> 5;
            const int hh = wv_ + 4 * rnd, bh = b * RH + hh, chunk = bh * NCHK + c, cc = hh * 64 + lane;
            f32x16 aw[2], aa[2];
#pragma unroll
            for (int ct = 0; ct < 2; ++ct) { const bf16* lw = LW + (size_t)(hh * 64 + 32 * ct + r) * 256 + 8 * h;
                { bf16x8 bf_[8];
#pragma unroll
                    for (int ks = 0; ks < 8; ++ks) bf_[ks] = *(const bf16x8*)(lw + 128 + 16 * ks);
                    f32x16 g_ = zero16();
#pragma unroll
                    for (int ks = 0; ks < 8; ++ks) g_ = MFMA32(rd_nat(LA, LAS_STRIDE, r, 128 + 16 * ks + 8 * h), bf_[ks], g_);
#pragma unroll
                    for (int i = 0; i < 16; ++i) if (MK_WMASK & 1) G[(size_t)(row0 + crow(i, h)) * 512 + hh * 64 + 32 * ct + r] = (bf16)f2bf(g_[i]); }
                { bf16x8 bf_[8];
#pragma unroll
                    for (int ks = 0; ks < 8; ++ks) bf_[ks] = *(const bf16x8*)(lw + 16 * ks);
                    f32x16 w_ = zero16(), a_ = zero16();
#pragma unroll
                    for (int ks = 0; ks < 4; ++ks) { w_ = MFMA32(rd_nat(LA, LAS_STRIDE, r, 16 * ks + 8 * h), bf_[ks], w_); a_ = MFMA32(rd_nat(LA, LAS_STRIDE, r, 64 + 16 * ks + 8 * h), bf_[4 + ks], a_); }
                    aw[ct] = w_; aa[ct] = a_; } }
            f32x16 wo, wr_, ao, ar_;
#pragma unroll
            for (int i = 0; i < 16; ++i) { wo[i] = h ? aw[1][i] : aw[0][i]; ao[i] = h ? aa[1][i] : aa[0][i];
                wr_[i] = __shfl_xor(h ? aw[0][i] : aw[1][i], 32); ar_[i] = __shfl_xor(h ? aa[0][i] : aa[1][i], 32); }
            const float mur = mu[cc], muk = mu[512 + cc], muv = mu[1024 + cc], w0c = w0[cc], a0c = a0[cc], kkc = k_k[cc], kac = k_a[cc], rkc = r_k[cc];
            float gam[32];
#pragma unroll
            for (int t = 0; t < 32; ++t) { const int i = (t & 3) + 4 * (t >> 3); const float wl = (((t >> 2) & 1) == h) ? wo[i] : wr_[i];
                const float dec = __expf(-0.60653066f * sigmoidf_(w0c + wl)); gam[t] = t ? gam[t - 1] * dec : dec; }
            const float gC = gam[31];
            const size_t pbase = (size_t)row0 * IN_COLS + cc;
            bf16 pr_ = 0, pk_ = 0, pv_ = 0;
            if (t0 > 0) { pr_ = P[pbase - IN_COLS]; pk_ = P[pbase - IN_COLS + 512]; pv_ = P[pbase - IN_COLS + 1024]; }
#pragma unroll
            for (int tb = 0; tb < 4; ++tb) {
                asm volatile("" ::: "memory");
                bf16 cr[8], ck[8], cv[8];
#pragma unroll
                for (int i = 0; i < 8; ++i) { const size_t o = pbase + (size_t)(8 * tb + i) * IN_COLS; cr[i] = P[o]; ck[i] = P[o + 512]; cv[i] = P[o + 1024]; }
                float rv[8], vv[8], kk[8], ssq[8], bo[8], av[8], kv[8];
#pragma unroll
                for (int i = 0; i < 8; ++i) { const int t = 8 * tb + i, ii = (t & 3) + 4 * (t >> 3);
                    const float c_r = bf2f(cr[i]), c_k = bf2f(ck[i]), c_v = bf2f(cv[i]);
                    const float p_r = bf2f(i ? cr[i - 1] : pr_), p_k = bf2f(i ? ck[i - 1] : pk_), p_v = bf2f(i ? cv[i - 1] : pv_);
                    rv[i] = c_r + (p_r - c_r) * mur; const float kr = c_k + (p_k - c_k) * muk; vv[i] = c_v + (p_v - c_v) * muv;
                    const float al = (((t >> 2) & 1) == h) ? ao[ii] : ar_[ii];
                    av[i] = sigmoidf_(a0c + al);
                    kk[i] = kr * kkc; ssq[i] = kk[i] * kk[i]; kv[i] = kr * (1.f + (av[i] - 1.f) * kac); bo[i] = rv[i] * kv[i] * rkc; }
                pr_ = cr[7]; pk_ = ck[7]; pv_ = cv[7];
#pragma unroll
                for (int i = 0; i < 8; ++i) { ssq[i] = reduce16(ssq[i]); bo[i] = reduce16(bo[i]); }
#pragma unroll
                for (int i = 0; i < 8; ++i) { ssq[i] += __shfl_xor(ssq[i], 16); bo[i] += __shfl_xor(bo[i], 16); }
#pragma unroll
                for (int i = 0; i < 8; ++i) { ssq[i] += __shfl_xor(ssq[i], 32); bo[i] += __shfl_xor(bo[i], 32); }
                float at[8], bh8[8], kh8[8];
#pragma unroll
                for (int i = 0; i < 8; ++i) { const int t = 8 * tb + i;
                    const float kkn = kk[i] * __builtin_amdgcn_rcpf(fmaxf(sqrtf(ssq[i]), 1e-12f)), bb = kkn * av[i];
                    const float g = gam[t], gp = t ? gam[t - 1] : 1.f, ig = __builtin_amdgcn_rcpf(g);
                    const float bt = bb * ig, kt = kv[i] * ig; at[i] = -kkn * gp; bh8[i] = bt * gC; kh8[i] = kt * gC;
                    const int ro = t * WRS + lane;
                    iA[ro] = (bf16)f2bf(at[i]); iB[ro] = (bf16)f2bf(bt); iK[ro] = (bf16)f2bf(kt); iR[ro] = (bf16)f2bf(rv[i] * g);
                    if (MK_WMASK & 2) { ((bf16*)SV)[((size_t)bh * T + t0 + t) * 64 + lane] = (bf16)f2bf(vv[i]);
                    if (lane == 0) BON[(row0 + t) * 8 + hh] = bo[i]; } }
#pragma unroll
                for (int q = 0; q < 2; ++q) { u32x2 w;
                    w.x = pk2(at[4 * q], at[4 * q + 1]); w.y = pk2(at[4 * q + 2], at[4 * q + 3]); *(LAS u32x2*)(iAT + lane * WTS + 8 * tb + 4 * q) = w;
                    w.x = pk2(bh8[4 * q], bh8[4 * q + 1]); w.y = pk2(bh8[4 * q + 2], bh8[4 * q + 3]); *(LAS u32x2*)(iBHT + lane * WTS + 8 * tb + 4 * q) = w;
                    w.x = pk2(kh8[4 * q], kh8[4 * q + 1]); w.y = pk2(kh8[4 * q + 2], kh8[4 * q + 3]); *(LAS u32x2*)(iKHT + lane * WTS + 8 * tb + 4 * q) = w;
                    w.x = pk2(vv[4 * q], vv[4 * q + 1]); w.y = pk2(vv[4 * q + 2], vv[4 * q + 3]); *(LAS u32x2*)(iVT + lane * WTS + 8 * tb + 4 * q) = w; }
            }
            asm volatile("s_waitcnt lgkmcnt(0)" ::: "memory");
            f32x16 lab = zero16(), lak = zero16(), nrb = zero16(), nrk = zero16();
#pragma unroll
            for (int ks = 0; ks < 4; ++ks) { const bf16x8 fa = rd_nat2(iA, WRS, r, 16 * ks + 8 * h), fb = rd_nat2(iB, WRS, r, 16 * ks + 8 * h), fk = rd_nat2(iK, WRS, r, 16 * ks + 8 * h), fr_ = rd_nat2(iR, WRS, r, 16 * ks + 8 * h);
                lab = MFMA32(fa, fb, lab); lak = MFMA32(fa, fk, lak); nrb = MFMA32(fb, fr_, nrb); nrk = MFMA32(fk, fr_, nrk); }
#pragma unroll
            for (int i = 0; i < 16; ++i) { const int row = crow(i, h); lab[i] = (r < row) ? lab[i] : 0.f; lak[i] = (r < row) ? lak[i] : 0.f; nrb[i] = (row <= r) ? nrb[i] : 0.f; nrk[i] = (row <= r) ? nrk[i] : 0.f; }
            const bf16x8 fn0 = pack_acc<0>(nrb), fn1 = pack_acc<1>(nrb);
            asm volatile("s_waitcnt lgkmcnt(0)" ::: "memory");
            { f32x16 Lp = lab, Tq = lab;
#pragma unroll
                for (int i = 0; i < 16; ++i) Tq[i] += (crow(i, h) == r) ? 1.f : 0.f;
#pragma unroll
                for (int st = 0; st < 4; ++st) {
#pragma unroll
                    for (int i = 0; i < 16; ++i) { imgL[crow(i, h) * WTS + r] = (bf16)f2bf(Lp[i]); Tm[crow(i, h) * WTS + r] = (bf16)f2bf(Tq[i]); }
                    asm volatile("s_waitcnt lgkmcnt(0)" ::: "memory");
                    const bf16x8 b0 = pack_acc<0>(Lp), b1 = pack_acc<1>(Lp);
                    f32x16 l2 = zero16(); l2 = MFMA32(rd_perm(imgL, WTS, r, 0, h), b0, l2); l2 = MFMA32(rd_perm(imgL, WTS, r, 16, h), b1, l2);
                    Lp = l2;
                    f32x16 mm = l2;
#pragma unroll
                    for (int i = 0; i < 16; ++i) mm[i] += (crow(i, h) == r) ? 1.f : 0.f;
                    const bf16x8 m0 = pack_acc<0>(mm), m1 = pack_acc<1>(mm);
                    f32x16 t2 = zero16(); t2 = MFMA32(rd_perm(Tm, WTS, r, 0, h), m0, t2); t2 = MFMA32(rd_perm(Tm, WTS, r, 16, h), m1, t2);
                    Tq = t2;
                    asm volatile("s_waitcnt lgkmcnt(0)" ::: "memory"); }
#pragma unroll
                for (int i = 0; i < 16; ++i) Tm[crow(i, h) * WTS + r] = (bf16)f2bf(Tq[i]);
                asm volatile("s_waitcnt lgkmcnt(0)" ::: "memory"); }
            const float gcd2[2] = {__shfl(gC, r), __shfl(gC, 32 + r)};
#pragma unroll
            for (int a = 0; a < 2; ++a) { f32x16 x1 = zero16();
#pragma unroll
                for (int ks = 0; ks < 2; ++ks) x1 = MFMA32(rd_nat2(Tm, WTS, r, 16 * ks + 8 * h), rd_nat2(iAT, WTS, 32 * a + r, 16 * ks + 8 * h), x1);
                const bf16x8 xf0 = pack_acc<0>(x1), xf1 = pack_acc<1>(x1);
#pragma unroll
                for (int b2 = 0; b2 < 2; ++b2) { f32x16 p = zero16();
                    p = MFMA32(xf0, rd_perm(iBHT, WTS, 32 * b2 + r, 0, h), p); p = MFMA32(xf1, rd_perm(iBHT, WTS, 32 * b2 + r, 16, h), p);
                    if (a == b2) { const float gcd = gcd2[a];
#pragma unroll
                        for (int i = 0; i < 16; ++i) p[i] += (crow(i, h) == r) ? gcd : 0.f; }
                    bf16x8* dst = PT + ((size_t)(chunk * 2 + a) * 2 + b2) * 2 * 64 + lane; if (MK_WMASK & 4) { dst[0] = pack_acc<0>(p); dst[64] = pack_acc<1>(p); } }
                f32x16 ry;
#pragma unroll
                for (int g = 0; g < 4; ++g) { const u32x2 rr = *(const LAS u32x2*)(iR + r * WRS + 32 * a + 8 * g + 4 * h);
                    ry[4 * g] = bflo(rr.x); ry[4 * g + 1] = bfhi(rr.x); ry[4 * g + 2] = bflo(rr.y); ry[4 * g + 3] = bfhi(rr.y); }
                ry = MFMA32(xf0, fn0, ry); ry = MFMA32(xf1, fn1, ry);
                bf16x8* dr = RYT + (size_t)(chunk * 2 + a) * 2 * 64 + lane; if (MK_WMASK & 8) { dr[0] = pack_acc<0>(ry); dr[64] = pack_acc<1>(ry); } }
            { f32x16 x2 = zero16();
                x2 = MFMA32(rd_perm(Tm, WTS, r, 0, h), pack_acc<0>(lak), x2); x2 = MFMA32(rd_perm(Tm, WTS, r, 16, h), pack_acc<1>(lak), x2);
                const bf16x8 xf0 = pack_acc<0>(x2), xf1 = pack_acc<1>(x2);
                bf16x8 fq[2][2];
#pragma unroll
                for (int b2 = 0; b2 < 2; ++b2) { f32x16 qm;
#pragma unroll
                    for (int g = 0; g < 4; ++g) { const u32x2 kk2 = *(const LAS u32x2*)(iKHT + (32 * b2 + r) * WTS + 8 * g + 4 * h);
                        qm[4 * g] = bflo(kk2.x); qm[4 * g + 1] = bfhi(kk2.x); qm[4 * g + 2] = bflo(kk2.y); qm[4 * g + 3] = bfhi(kk2.y); }
                    qm = MFMA32(xf0, rd_perm(iBHT, WTS, 32 * b2 + r, 0, h), qm); qm = MFMA32(xf1, rd_perm(iBHT, WTS, 32 * b2 + r, 16, h), qm);
                    fq[b2][0] = pack_acc<0>(qm); fq[b2][1] = pack_acc<1>(qm); }
                f32x16 gy = nrk;
                gy = MFMA32(xf0, fn0, gy); gy = MFMA32(xf1, fn1, gy);
                const bf16x8 gf0 = pack_acc<0>(gy), gf1 = pack_acc<1>(gy);
#pragma unroll
                for (int vh = 0; vh < 2; ++vh) { f32x16 yv = zero16();
                    yv = MFMA32(rd_perm(iVT, WTS, 32 * vh + r, 0, h), gf0, yv); yv = MFMA32(rd_perm(iVT, WTS, 32 * vh + r, 16, h), gf1, yv);
                    bf16x8* dy = (bf16x8*)YVT + ((size_t)(chunk * 2 + vh) * 64 + lane) * 2;
                    if (MK_WMASK & 16) { dy[0] = pack_acc<0>(yv); dy[1] = pack_acc<1>(yv); } }
#pragma unroll
                for (int b2 = 0; b2 < 2; ++b2)
#pragma unroll
                    for (int vh = 0; vh < 2; ++vh) { f32x16 zv = zero16();
                        zv = MFMA32(fq[b2][0], rd_perm(iVT, WTS, 32 * vh + r, 0, h), zv); zv = MFMA32(fq[b2][1], rd_perm(iVT, WTS, 32 * vh + r, 16, h), zv);
                        bf16x8* dz = (bf16x8*)ZV + (((size_t)(chunk * 2 + b2) * 2 + vh) * 64 + lane) * 2;
                        if (MK_WMASK & 32) { dz[0] = pack_acc<0>(zv); dz[1] = pack_acc<1>(zv); } } }
            asm volatile("s_waitcnt lgkmcnt(0)" ::: "memory");
        }
        }
    }
}

constexpr int SB_SLOT = 16384, SB_NSLOT = 7, SB_FLAGS = SB_NSLOT * SB_SLOT;
constexpr int CONV_4B = (MK_CONV_WHERE == 9 || MK_CONV_WHERE == 8) ? 6144 : 0;
__device__ __forceinline__ void phase4b_states(const Frame& F) {
    volatile LAS unsigned* FULL = (volatile LAS unsigned*)(F.lds + SB_FLAGS);
    volatile LAS unsigned* DONEC = (volatile LAS unsigned*)(F.lds + SB_FLAGS + 64);
    __syncthreads();
    if (F.tid < 32) ((LAS unsigned*)(F.lds + SB_FLAGS))[F.tid] = 0u;
    __syncthreads();
    if (F.vcu < 128) {
        const int bh = F.vcu >> 1, vh = F.vcu & 1, lane = F.lane;
        if (F.wave == 0) {
            bf16x8* Z0 = wsp<bf16x8>(F, WS_Z0);
            f32x16 z0 = zero16(), z1 = zero16();
            bf16x8 pf[8]; u32x4 zq[2][2];
#define SB_FETCH(c_, slot_) do { { int sp = 0; while (FULL[slot_] < (unsigned)((c_) + 1)) { if (++sp > SC_SPIN_CAP) break; } } \
                __builtin_amdgcn_fence(__ATOMIC_ACQUIRE, "workgroup"); \
                const LAS unsigned char* sb = F.lds + (slot_) * SB_SLOT; const LAS bf16x8* p = (const LAS bf16x8*)sb + lane; \
                _Pragma("unroll") for (int q = 0; q < 8; ++q) pf[q] = p[q * 64]; \
                zq[0][0] = ((const LAS u32x4*)(sb + 8192) + lane * 2)[0]; zq[0][1] = ((const LAS u32x4*)(sb + 8192) + lane * 2)[1]; \
                zq[1][0] = ((const LAS u32x4*)(sb + 10240) + lane * 2)[0]; zq[1][1] = ((const LAS u32x4*)(sb + 10240) + lane * 2)[1]; \
                asm volatile("s_waitcnt lgkmcnt(0)" ::: "memory"); \
                if (lane == 0) DONEC[0] = (unsigned)((c_) + 1); } while (0)
            SB_FETCH(0, 0);
            int slot = 0;
            for (int c = 0; c < NCHK; ++c) { const int chunk = bh * NCHK + c;
                const bf16x8 f00 = pack_acc<0>(z0), f01 = pack_acc<1>(z0), f10 = pack_acc<0>(z1), f11 = pack_acc<1>(z1);
                bf16x8* dz = Z0 + (size_t)(chunk * 2 + vh) * 4 * 64 + lane; dz[0] = f00; dz[64] = f01; dz[128] = f10; dz[192] = f11;
                f32x16 n0, n1;
#pragma unroll
                for (int q = 0; q < 2; ++q) { const u32x4 u = zq[0][q], w = zq[1][q];
                    n0[8 * q] = bflo(u.x); n0[8 * q + 1] = bfhi(u.x); n0[8 * q + 2] = bflo(u.y); n0[8 * q + 3] = bfhi(u.y); n0[8 * q + 4] = bflo(u.z); n0[8 * q + 5] = bfhi(u.z); n0[8 * q + 6] = bflo(u.w); n0[8 * q + 7] = bfhi(u.w);
                    n1[8 * q] = bflo(w.x); n1[8 * q + 1] = bfhi(w.x); n1[8 * q + 2] = bflo(w.y); n1[8 * q + 3] = bfhi(w.y); n1[8 * q + 4] = bflo(w.z); n1[8 * q + 5] = bfhi(w.z); n1[8 * q + 6] = bflo(w.w); n1[8 * q + 7] = bfhi(w.w); }
                n0 = MFMA32(pf[0], f00, n0); n1 = MFMA32(pf[2], f00, n1); n0 = MFMA32(pf[1], f01, n0); n1 = MFMA32(pf[3], f01, n1);
                n0 = MFMA32(pf[4], f10, n0); n1 = MFMA32(pf[6], f10, n1); n0 = MFMA32(pf[5], f11, n0); n1 = MFMA32(pf[7], f11, n1);
                slot = (slot + 1 == SB_NSLOT) ? 0 : slot + 1;
                if (c + 1 < NCHK) SB_FETCH(c + 1, slot);
                z0 = n0; z1 = n1; }
#undef SB_FETCH
        } else {
            const int slot = F.wave - 1;
            const unsigned char* gpt = (const unsigned char*)wsp<bf16x8>(F, WS_PT) + lane * 16;
            const unsigned char* gzv = (const unsigned char*)wsp<f32x4>(F, WS_ZV) + lane * 16;
            LAS unsigned char* dst = F.lds + slot * SB_SLOT;
            for (int c = slot; c < NCHK; c += SB_NSLOT) { const int chunk = bh * NCHK + c;
                if (c >= SB_NSLOT) { const unsigned need = (unsigned)(c - SB_NSLOT + 1); int sp = 0;
                    while (DONEC[0] < need) { __builtin_amdgcn_s_sleep(1); if (++sp > SC_SPIN_CAP) break; }
                    __builtin_amdgcn_fence(__ATOMIC_ACQUIRE, "workgroup"); }
                const unsigned char* sp_ = gpt + (size_t)chunk * 8192;
#pragma unroll
                for (int j = 0; j < 8; ++j) __builtin_amdgcn_global_load_lds((const unsigned*)(sp_ + j * 1024), (LAS unsigned*)(dst + j * 1024), 16, 0, 0);
                const unsigned char* sz0 = gzv + ((size_t)(chunk * 2 + 0) * 2 + vh) * 2048; const unsigned char* sz1 = gzv + ((size_t)(chunk * 2 + 1) * 2 + vh) * 2048;
#pragma unroll
                for (int j = 0; j < 2; ++j) { __builtin_amdgcn_global_load_lds((const unsigned*)(sz0 + j * 1024), (LAS unsigned*)(dst + 8192 + j * 1024), 16, 0, 0);
                    __builtin_amdgcn_global_load_lds((const unsigned*)(sz1 + j * 1024), (LAS unsigned*)(dst + 10240 + j * 1024), 16, 0, 0); }
                asm volatile("s_waitcnt vmcnt(0)" ::: "memory");
                if (lane == 0) FULL[slot] = (unsigned)(c + 1); }
        }
    } else {
        for (int it = (F.vcu - 128) * 8 + F.wave; it < CONV_4B; it += 128 * 8) moe_weight_item(F, it);
    }
    __syncthreads();
}

__device__ __forceinline__ void phase4c_output(const Frame& F) {
    const bf16x8* Z0 = wsp<bf16x8>(F, WS_Z0); const bf16x8* RYT = wsp<bf16x8>(F, WS_RYT); const f32x4* YVT = wsp<f32x4>(F, WS_YVT);
    const float* SV = wsp<float>(F, WS_SV); const bf16* G = wsp<bf16>(F, WS_G); const float* BON = wsp<float>(F, WS_BONUS); bf16* CAT = wsp<bf16>(F, WS_CAT);
    const float* lg = F.in[15]; const float* lb = F.in[16];
    const int gw = F.vcu * 8 + F.wave, NGW = F.G * 8, lane = F.lane, r = lane & 31, h = lane >> 5;
    for (int chunk = gw; chunk < NBATCH * RH * NCHK; chunk += NGW) {
        const int bh = chunk / NCHK, c = chunk % NCHK, b = bh / RH, hh = bh % RH, t = c * CK + r, row = b * T + t;
        bf16x8 rf[4], zf[2][4]; u32x4 yv[2][2]; u32x2 vv[2][4], gr[2][4];
#pragma unroll
        for (int q = 0; q < 4; ++q) rf[q] = __builtin_nontemporal_load(RYT + (size_t)chunk * 4 * 64 + lane + q * 64);
#pragma unroll
        for (int vh = 0; vh < 2; ++vh)
#pragma unroll
            for (int q = 0; q < 4; ++q) { if (q < 2) yv[vh][q] = __builtin_nontemporal_load((const u32x4*)YVT + ((size_t)(chunk * 2 + vh) * 64 + lane) * 2 + q);
                zf[vh][q] = __builtin_nontemporal_load(Z0 + (size_t)(chunk * 2 + vh) * 4 * 64 + lane + q * 64); }
        const float bon = BON[row * 8 + hh];
#pragma unroll
        for (int vh = 0; vh < 2; ++vh)
#pragma unroll
            for (int g = 0; g < 4; ++g) { const int v0 = 32 * vh + 8 * g + 4 * h, c0 = hh * 64 + v0;
                vv[vh][g] = __builtin_nontemporal_load((const u32x2*)((const bf16*)SV + ((size_t)bh * T + t) * 64 + v0));
                gr[vh][g] = __builtin_nontemporal_load((const u32x2*)(G + (size_t)row * 512 + c0)); }
        f32x16 y[2];
#pragma unroll
        for (int vh = 0; vh < 2; ++vh) {
#pragma unroll
            for (int q = 0; q < 2; ++q) { const u32x4 u = yv[vh][q]; y[vh][8 * q] = bflo(u.x); y[vh][8 * q + 1] = bfhi(u.x); y[vh][8 * q + 2] = bflo(u.y); y[vh][8 * q + 3] = bfhi(u.y);
                y[vh][8 * q + 4] = bflo(u.z); y[vh][8 * q + 5] = bfhi(u.z); y[vh][8 * q + 6] = bflo(u.w); y[vh][8 * q + 7] = bfhi(u.w); }
#pragma unroll
            for (int q = 0; q < 4; ++q) y[vh] = MFMA32(zf[vh][q], rf[q], y[vh]); }
        float sm = 0.f;
#pragma unroll
        for (int vh = 0; vh < 2; ++vh)
#pragma unroll
            for (int i = 0; i < 16; ++i) sm += y[vh][i];
        sm += __shfl_xor(sm, 32);
        const float mean = sm * (1.f / 64.f); float qv = 0.f;
#pragma unroll
        for (int vh = 0; vh < 2; ++vh)
#pragma unroll
            for (int i = 0; i < 16; ++i) { y[vh][i] -= mean; qv += y[vh][i] * y[vh][i]; }
        qv += __shfl_xor(qv, 32);
        const float rstd = rsqrtf(qv * (1.f / 64.f) + GN_EPS);
#pragma unroll
        for (int vh = 0; vh < 2; ++vh)
#pragma unroll
            for (int g = 0; g < 4; ++g) { const int v0 = 32 * vh + 8 * g + 4 * h, c0 = hh * 64 + v0;
                const f32x4 lg4 = *(const f32x4*)(lg + c0), lb4 = *(const f32x4*)(lb + c0);
                const float gg[4] = {bflo(gr[vh][g].x), bfhi(gr[vh][g].x), bflo(gr[vh][g].y), bfhi(gr[vh][g].y)}; float o[4];
                const float vf[4] = {bflo(vv[vh][g].x), bfhi(vv[vh][g].x), bflo(vv[vh][g].y), bfhi(vv[vh][g].y)};
#pragma unroll
                for (int q = 0; q < 4; ++q) o[q] = (y[vh][4 * g + q] * rstd * lg4[q] + lb4[q] + bon * vf[q]) * gg[q];
                u32x2 w; w.x = pk2(o[0], o[1]); w.y = pk2(o[2], o[3]);
                *(u32x2*)(CAT + (size_t)row * D + c0) = w; }
    }
}

constexpr int SC_STEPS = 16, SC_NSLOT = 6, SC_SHARED = SC_STEPS * 1280, SC_SLOT = SC_SHARED + SC_STEPS * 64, SC_RING = SC_NSLOT * SC_SLOT;
constexpr int SC_FLAGS = SC_RING, SC_CONV = SC_RING + 256, SC_NCH = T / SC_STEPS;
static_assert(SC_CONV + 3 * 8704 <= LDS_BYTES, "scan LDS map");
__device__ __forceinline__ void phase4_scan(const Frame& F) {
    volatile LAS unsigned* READY = (volatile LAS unsigned*)(F.lds + SC_FLAGS);
    volatile LAS unsigned* DONE = (volatile LAS unsigned*)(F.lds + SC_FLAGS + 64);
    __syncthreads();
    if (F.tid < 64) ((LAS unsigned*)(F.lds + SC_FLAGS))[F.tid] = 0u;
    __syncthreads();
    const int bh = F.vcu >> 2, rg = F.vcu & 3, b = bh / RH, hh = bh % RH;
    if (F.wave < 4) {
        const int rl = F.lane >> 4, ks = F.lane & 15, rowl = F.wave * 4 + rl;
        float* yp = wsp<float>(F, WS_Y) + (size_t)b * T * 512 + hh * 64 + rg * 16 + rowl;
        f32x4 S = (f32x4){0.f, 0.f, 0.f, 0.f};
        int slot = 0;
        for (int c = 0; c < SC_NCH; ++c) {
#if MK_RWKV_MODE == 1
            if ((c & 1) == 0) {
                const int v = rg * 16 + rowl, chunk = bh * NCHK + (c >> 1);
                const bf16* zp = wsp<bf16>(F, WS_Z0) + ((((size_t)chunk * 2 + (v >> 5)) * 2 + (ks >> 3)) * 2 + ((ks >> 2) & 1)) * 512 + ((v & 31) + 32 * (ks & 1)) * 8 + 4 * ((ks >> 1) & 1);
                const u32x2 zz = *(const u32x2*)zp;
                S = (f32x4){bflo(zz.x), bfhi(zz.x), bflo(zz.y), bfhi(zz.y)}; }
#endif
            { int sp = 0; while (READY[slot] < (unsigned)(c + 1)) { if (++sp > SC_SPIN_CAP) break; } }
            __builtin_amdgcn_fence(__ATOMIC_ACQUIRE, "workgroup");
            const LAS unsigned char* sb = F.lds + slot * SC_SLOT;
            const LAS unsigned char* op = sb + ks * 16; const LAS float* vp = (const LAS float*)(sb + SC_SHARED) + rowl;
            f32x4 w4 = *(const LAS f32x4*)(op), kk4 = *(const LAS f32x4*)(op + 256), b4 = *(const LAS f32x4*)(op + 512), k4 = *(const LAS f32x4*)(op + 768), r4 = *(const LAS f32x4*)(op + 1024);
            float v = vp[0];
            float ykeep = 0.f;
#pragma unroll
            for (int s = 0; s < SC_STEPS; ++s) {
                const f32x4 cw = w4, ckk = kk4, cb = b4, ck = k4, cr = r4; const float cv = v;
                if (s + 1 < SC_STEPS) { const LAS unsigned char* o2 = op + (s + 1) * 1280;
                    w4 = *(const LAS f32x4*)(o2); kk4 = *(const LAS f32x4*)(o2 + 256); b4 = *(const LAS f32x4*)(o2 + 512); k4 = *(const LAS f32x4*)(o2 + 768); r4 = *(const LAS f32x4*)(o2 + 1024);
                    v = vp[(s + 1) * 16]; }
                if (s == SC_STEPS - 1) { asm volatile("s_waitcnt lgkmcnt(0)" ::: "memory"); if (F.lane == 0) DONE[F.wave] = (unsigned)(c + 1); }
                float p = (S[0] * ckk[0] + S[1] * ckk[1]) + (S[2] * ckk[2] + S[3] * ckk[3]);
                p = reduce16(p);
                const f32x4 tt = S * cw + ck * cv;
                S = tt - cb * p;
                float q = (S[0] * cr[0] + S[1] * cr[1]) + (S[2] * cr[2] + S[3] * cr[3]);
                q = reduce16(q);
                ykeep = (ks == s) ? q : ykeep;
            }
            yp[(size_t)(c * SC_STEPS + ks) * 512] = ykeep;
            slot = (slot + 1 == SC_NSLOT) ? 0 : slot + 1;
        }
    } else if (F.wave == 4) {
        const unsigned char* gs = (const unsigned char*)(wsp<float>(F, WS_SCN) + (size_t)bh * T * 320) + F.lane * 16;
        const unsigned char* gv = (const unsigned char*)(wsp<float>(F, WS_SV) + (size_t)bh * T * 64 + (F.lane >> 2) * 64 + rg * 16 + (F.lane & 3) * 4);
        int slot = 0;
        for (int c = 0; c < SC_NCH; ++c) {
            if (c >= SC_NSLOT) { const unsigned need = (unsigned)(c - SC_NSLOT + 1); int sp = 0;
                while (DONE[0] < need || DONE[1] < need || DONE[2] < need || DONE[3] < need) { __builtin_amdgcn_s_sleep(1); if (++sp > SC_SPIN_CAP) break; }
                __builtin_amdgcn_fence(__ATOMIC_ACQUIRE, "workgroup"); }
            LAS unsigned char* dst = F.lds + slot * SC_SLOT;
            const unsigned char* src = gs + (size_t)c * SC_SHARED;
#pragma unroll
            for (int j = 0; j < SC_SHARED / 1024; ++j) __builtin_amdgcn_global_load_lds((const unsigned*)(src + j * 1024), (LAS unsigned*)(dst + j * 1024), 16, 0, 0);
            __builtin_amdgcn_global_load_lds((const unsigned*)(gv + (size_t)c * SC_STEPS * 256), (LAS unsigned*)(dst + SC_SHARED), 16, 0, 0);
            if (c >= 2) { asm volatile("s_waitcnt vmcnt(42)" ::: "memory"); const int ps = (slot >= 2) ? slot - 2 : slot + SC_NSLOT - 2; if (F.lane == 0) READY[ps] = (unsigned)(c - 1); }
            slot = (slot + 1 == SC_NSLOT) ? 0 : slot + 1;
        }
        { asm volatile("s_waitcnt vmcnt(21)" ::: "memory"); const int ps = (slot >= 2) ? slot - 2 : slot + SC_NSLOT - 2; if (F.lane == 0) READY[ps] = (unsigned)(SC_NCH - 1); }
        { asm volatile("s_waitcnt vmcnt(0)" ::: "memory"); const int ps = (slot >= 1) ? slot - 1 : SC_NSLOT - 1; if (F.lane == 0) READY[ps] = (unsigned)(SC_NCH); }
    } else {
#if MK_CONV_IN_SCAN
        for (int it = F.vcu * 3 + (F.wave - 5); it < MOE_ITEMS; it += F.G * 3) moe_weight_item(F, it);
#endif
    }
    __syncthreads();
}

constexpr int KLD = 72;
constexpr int VLD = 260;
__device__ __forceinline__ void phase5_attn(const Frame& F) {
    const bf16* P = wsp<bf16>(F, WS_P);
    bf16* CAT = wsp<bf16>(F, WS_CAT);
    const float* qg = F.in[17]; const float* kg = F.in[18]; const float* sinks = F.in[19];
    LAS bf16* Kl = (LAS bf16*)F.lds;
    LAS bf16* Vt = (LAS bf16*)(F.lds + 256 * KLD * 2);
    const int lane = F.lane, r = lane & 31, h = lane >> 5;
    for (int unit = F.vcu; unit < NBATCH * KVH * (T / 128); unit += F.G) {
        const int blk = unit % (T / 128), kvh = (unit / (T / 128)) % KVH, b = unit / (T / 128 * KVH);
        const int kpos0 = blk * 128 - 128;
        __syncthreads();
        u32x4 kr4[4], vr4[4];
#pragma unroll
        for (int it = 0; it < 4; ++it) { const int ch = F.tid + 512 * it, key = ch >> 3, dc = ch & 7, kpos = kpos0 + key;
            const size_t ro = (size_t)(b * T + (kpos >= 0 ? kpos : 0)) * IN_COLS;
            kr4[it] = *(const u32x4*)(P + ro + COL_K + kvh * 64 + dc * 8); vr4[it] = *(const u32x4*)(P + ro + COL_V + kvh * 64 + dc * 8); }
#pragma unroll
        for (int it = 0; it < 4; ++it) { const int ch = F.tid + 512 * it, key = ch >> 3, dc = ch & 7, kpos = kpos0 + key;
            u32x4 kraw = kr4[it], vraw = vr4[it];
            if (kpos < 0) { kraw = (u32x4){0u, 0u, 0u, 0u}; vraw = (u32x4){0u, 0u, 0u, 0u}; }
            float kf[8]; kf[0] = bflo(kraw.x); kf[1] = bfhi(kraw.x); kf[2] = bflo(kraw.y); kf[3] = bfhi(kraw.y); kf[4] = bflo(kraw.z); kf[5] = bfhi(kraw.z); kf[6] = bflo(kraw.w); kf[7] = bfhi(kraw.w);
            float ss = 0.f;
#pragma unroll
            for (int j = 0; j < 8; ++j) ss += kf[j] * kf[j];
            ss += __shfl_xor(ss, 1); ss += __shfl_xor(ss, 2); ss += __shfl_xor(ss, 4);
            const float rstd = rsqrtf(ss * (1.f / 64.f) + NORM_EPS);
            const f32x4 g0 = *(const f32x4*)(kg + dc * 8), g1 = *(const f32x4*)(kg + dc * 8 + 4);
            u32x4 ko; ko.x = pk2(kf[0] * rstd * g0[0], kf[1] * rstd * g0[1]); ko.y = pk2(kf[2] * rstd * g0[2], kf[3] * rstd * g0[3]);
            ko.z = pk2(kf[4] * rstd * g1[0], kf[5] * rstd * g1[1]); ko.w = pk2(kf[6] * rstd * g1[2], kf[7] * rstd * g1[3]);
            *(LAS u32x4*)(Kl + key * KLD + dc * 8) = ko;
            const unsigned vv[4] = {vraw.x, vraw.y, vraw.z, vraw.w};
#pragma unroll
            for (int j = 0; j < 4; ++j) { Vt[(dc * 8 + 2 * j) * VLD + key] = (bf16)(vv[j] & 0xffffu); Vt[(dc * 8 + 2 * j + 1) * VLD + key] = (bf16)(vv[j] >> 16); }
        }
        __syncthreads();
        for (int task = F.wave; task < 16; task += 8) {
            const int g = task & 3, qs = task >> 2, head = kvh * 4 + g;
            const int qrow = b * T + blk * 128 + qs * 32 + r;
            float qf[4][8]; float ss = 0.f;
#pragma unroll
            for (int s = 0; s < 4; ++s) { const u32x4 qr = *(const u32x4*)(P + (size_t)qrow * IN_COLS + COL_Q + head * 64 + 16 * s + 8 * h);
                qf[s][0] = bflo(qr.x); qf[s][1] = bfhi(qr.x); qf[s][2] = bflo(qr.y); qf[s][3] = bfhi(qr.y); qf[s][4] = bflo(qr.z); qf[s][5] = bfhi(qr.z); qf[s][6] = bflo(qr.w); qf[s][7] = bfhi(qr.w);
#pragma unroll
                for (int j = 0; j < 8; ++j) ss += qf[s][j] * qf[s][j]; }
            ss += __shfl_xor(ss, 32);
            const float qscale = rsqrtf(ss * (1.f / 64.f) + NORM_EPS) * 0.125f;
            bf16x8 qb[4];
#pragma unroll
            for (int s = 0; s < 4; ++s) { u32x4 w;
                const f32x4 g0 = *(const f32x4*)(qg + 16 * s + 8 * h), g1 = *(const f32x4*)(qg + 16 * s + 8 * h + 4);
                w.x = pk2(qf[s][0] * qscale * g0[0], qf[s][1] * qscale * g0[1]); w.y = pk2(qf[s][2] * qscale * g0[2], qf[s][3] * qscale * g0[3]);
                w.z = pk2(qf[s][4] * qscale * g1[0], qf[s][5] * qscale * g1[1]); w.w = pk2(qf[s][6] * qscale * g1[2], qf[s][7] * qscale * g1[3]);
                qb[s] = __builtin_bit_cast(bf16x8, w); }
            f32x16 st[5];
#pragma unroll
            for (int kt = 0; kt < 5; ++kt) {
#pragma unroll
                for (int i = 0; i < 16; ++i) st[kt][i] = 0.f;
#pragma unroll
                for (int s = 0; s < 4; ++s) { const bf16x8 ka = *(const LAS bf16x8*)(Kl + (32 * (qs + kt) + r) * KLD + 16 * s + 8 * h);
                    st[kt] = __builtin_amdgcn_mfma_f32_32x32x16_bf16(ka, qb[s], st[kt], 0, 0, 0); }
            }
            const int iq = 32 * qs + r;
            const float sink = sinks[head];
            float mx = sink;
#pragma unroll
            for (int kt = 0; kt < 5; ++kt)
#pragma unroll
                for (int i = 0; i < 16; ++i) { const int jw = 32 * (qs + kt) + (i & 3) + 8 * (i >> 2) + 4 * h;
                    const bool ok = (jw >= iq + 1) && (jw <= iq + 128) && (kpos0 + jw >= 0);
                    st[kt][i] = ok ? st[kt][i] : -INFINITY; mx = fmaxf(mx, st[kt][i]); }
            mx = fmaxf(mx, __shfl_xor(mx, 32));
            float lsum = 0.f;
#pragma unroll
            for (int kt = 0; kt < 5; ++kt)
#pragma unroll
                for (int i = 0; i < 16; ++i) { const float p = __expf(st[kt][i] - mx); st[kt][i] = p; lsum += p; }
            lsum += __shfl_xor(lsum, 32);
            const float linv = __builtin_amdgcn_rcpf(lsum + __expf(sink - mx));
            f32x16 o[2];
#pragma unroll
            for (int dt = 0; dt < 2; ++dt)
#pragma unroll
                for (int i = 0; i < 16; ++i) o[dt][i] = 0.f;
#pragma unroll
            for (int kt = 0; kt < 5; ++kt)
#pragma unroll
                for (int sp = 0; sp < 2; ++sp) { u32x4 pw;
                    pw.x = pk2(st[kt][8 * sp + 0] * linv, st[kt][8 * sp + 1] * linv); pw.y = pk2(st[kt][8 * sp + 2] * linv, st[kt][8 * sp + 3] * linv);
                    pw.z = pk2(st[kt][8 * sp + 4] * linv, st[kt][8 * sp + 5] * linv); pw.w = pk2(st[kt][8 * sp + 6] * linv, st[kt][8 * sp + 7] * linv);
                    const bf16x8 pa = __builtin_bit_cast(bf16x8, pw);
                    const int kb = 32 * (qs + kt) + 16 * sp + 4 * h;
#pragma unroll
                    for (int dt = 0; dt < 2; ++dt) { const LAS bf16* vp = Vt + (32 * dt + r) * VLD + kb;
                        const u32x2 lo = *(const LAS u32x2*)vp, hi = *(const LAS u32x2*)(vp + 8);
                        u32x4 vw; vw.x = lo.x; vw.y = lo.y; vw.z = hi.x; vw.w = hi.y;
                        o[dt] = __builtin_amdgcn_mfma_f32_32x32x16_bf16(pa, __builtin_bit_cast(bf16x8, vw), o[dt], 0, 0, 0); } }
            { LAS bf16* ot = (LAS bf16*)(F.lds + 256 * KLD * 2 + 64 * VLD * 2) + F.wave * (32 * 72);
#pragma unroll
                for (int dt = 0; dt < 2; ++dt)
#pragma unroll
                    for (int i = 0; i < 16; ++i) { const int qr = (i & 3) + 8 * (i >> 2) + 4 * h; ot[qr * 72 + 32 * dt + r] = (bf16)f2bf(o[dt][i]); }
                asm volatile("s_waitcnt lgkmcnt(0)" ::: "memory");
#pragma unroll
                for (int j = 0; j < 4; ++j) { const int id = lane + 64 * j, qr = id >> 3, pc = id & 7;
                    const u32x4 w = *(const LAS u32x4*)(ot + qr * 72 + pc * 8);
                    *(u32x4*)(CAT + (size_t)(b * T + blk * 128 + qs * 32 + qr) * D + 512 + head * 64 + pc * 8) = w; }
                asm volatile("s_waitcnt lgkmcnt(0)" ::: "memory"); }
        }
    }
}

__device__ __forceinline__ void phase6(const Frame& F) {
    const int gw = F.vcu * 8 + F.wave, NGW = F.G * 8;
    const float* Y = wsp<float>(F, WS_Y); const float* SV = wsp<float>(F, WS_SV); const bf16* G = wsp<bf16>(F, WS_G); const float* BON = wsp<float>(F, WS_BONUS);
    bf16* CAT = wsp<bf16>(F, WS_CAT);
    const float* lg = F.in[15]; const float* lb = F.in[16];
    const int hh = F.lane >> 3, n0 = (F.lane & 7) * 8, c0 = F.lane * 8;
    for (int row = gw; row < M; row += NGW) { const int b = row / T, t = row % T;
        const f32x4 y0 = *(const f32x4*)(Y + (size_t)row * 512 + c0), y1 = *(const f32x4*)(Y + (size_t)row * 512 + c0 + 4);
        float yv[8] = {y0[0], y0[1], y0[2], y0[3], y1[0], y1[1], y1[2], y1[3]};
        float s = 0.f;
#pragma unroll
        for (int j = 0; j < 8; ++j) s += yv[j];
        s += __shfl_xor(s, 1); s += __shfl_xor(s, 2); s += __shfl_xor(s, 4);
        const float mean = s * (1.f / 64.f); float q = 0.f;
#pragma unroll
        for (int j = 0; j < 8; ++j) { yv[j] -= mean; q += yv[j] * yv[j]; }
        q += __shfl_xor(q, 1); q += __shfl_xor(q, 2); q += __shfl_xor(q, 4);
        const float rstd = rsqrtf(q * (1.f / 64.f) + GN_EPS);
        const float bon = BON[row * 8 + hh];
        const float* vp = SV + ((size_t)(b * RH + hh) * T + t) * 64 + n0;
        const f32x4 v0 = *(const f32x4*)vp, v1 = *(const f32x4*)(vp + 4);
        const float vv[8] = {v0[0], v0[1], v0[2], v0[3], v1[0], v1[1], v1[2], v1[3]};
        const u32x4 graw = *(const u32x4*)(G + (size_t)row * 512 + c0);
        const float gg[8] = {bflo(graw.x), bfhi(graw.x), bflo(graw.y), bfhi(graw.y), bflo(graw.z), bfhi(graw.z), bflo(graw.w), bfhi(graw.w)};
        float ov[8];
#pragma unroll
        for (int j = 0; j < 8; ++j) ov[j] = (yv[j] * rstd * lg[c0 + j] + lb[c0 + j] + bon * vv[j]) * gg[j];
        u32x4 w; w.x = pk2(ov[0], ov[1]); w.y = pk2(ov[2], ov[3]); w.z = pk2(ov[4], ov[5]); w.w = pk2(ov[6], ov[7]);
        *(u32x4*)(CAT + (size_t)row * D + c0) = w; }
}

__device__ __forceinline__ float reduce32x64(float (&v)[32], int lane) {
#pragma unroll
    for (int i = 0; i < 16; ++i) { const bool hi = lane & 16; const float send = hi ? v[i] : v[i + 16], keep = hi ? v[i + 16] : v[i]; v[i] = keep + __shfl_xor(send, 16); }
#pragma unroll
    for (int i = 0; i < 8; ++i) { const bool hi = lane & 8; const float send = hi ? v[i] : v[i + 8], keep = hi ? v[i + 8] : v[i]; v[i] = keep + __shfl_xor(send, 8); }
#pragma unroll
    for (int i = 0; i < 4; ++i) { const bool hi = lane & 4; const float send = hi ? v[i] : v[i + 4], keep = hi ? v[i + 4] : v[i]; v[i] = keep + __shfl_xor(send, 4); }
#pragma unroll
    for (int i = 0; i < 2; ++i) { const bool hi = lane & 2; const float send = hi ? v[i] : v[i + 2], keep = hi ? v[i + 2] : v[i]; v[i] = keep + __shfl_xor(send, 2); }
    { const bool hi = lane & 1; const float send = hi ? v[0] : v[1], keep = hi ? v[1] : v[0]; v[0] = keep + __shfl_xor(send, 1); }
    return v[0] + __shfl_xor(v[0], 32);
}
__device__ __forceinline__ void phase8(const Frame& F) {
    const float* mod = wsp<float>(F, WS_MOD); const bf16* x1 = wsp<bf16>(F, WS_X1B);
    const float* wr_ = F.in[22]; const float* br = F.in[23];
    LAS float* Wt = (LAS float*)F.lds;
    LAS float* lgw = (LAS float*)(F.lds + 131072 + F.wave * 512);
    LAS int* cnt = (LAS int*)(F.lds + 131072 + 4096);
    __syncthreads();
    for (int idx = F.tid; idx < 8192; idx += 512) { const int k = idx >> 3, e4 = idx & 7; const f32x4 w = *(const f32x4*)(wr_ + k * 32 + e4 * 4);
        Wt[(4 * e4 + 0) * 1024 + k] = w[0]; Wt[(4 * e4 + 1) * 1024 + k] = w[1]; Wt[(4 * e4 + 2) * 1024 + k] = w[2]; Wt[(4 * e4 + 3) * 1024 + k] = w[3]; }
    if (F.tid < 32) cnt[F.tid] = 0;
    __syncthreads();
    int* RT_E = wsp<int>(F, WS_RT_E); int* RT_LP = wsp<int>(F, WS_RT_LP); float* RT_G = wsp<float>(F, WS_RT_G);
    const int e = F.lane & 31;
    const float bre = br[e];
    f32x4 shq[4], scq[4];
    { const int b = (F.vcu * 128) / T;
#pragma unroll
        for (int j = 0; j < 4; ++j) { const int col = 4 * F.lane + 256 * j; shq[j] = *(const f32x4*)(mod + b * 6144 + 3072 + col); scq[j] = (*(const f32x4*)(mod + b * 6144 + 4096 + col) + 1.f) * *(const f32x4*)(F.in[21] + col); } }
#if MK_CONV_WHERE == 8
    const int p_lo = F.wave < 4 ? 11 * F.wave : 44 + 10 * (F.wave - 4), p_n = F.wave < 4 ? 11 : 10;
    if (F.wave >= 6) { for (int it = CONV_4B + F.vcu * 2 + (F.wave - 6); it < MOE_ITEMS; it += F.G * 2) moe_weight_item(F, it); }
    else {
#else
    const int p_lo = 8 * F.wave, p_n = 8;
    {
#endif
    u32x2 xn[2][4];
#pragma unroll
    for (int q = 0; q < 2; ++q)
#pragma unroll
        for (int j = 0; j < 4; ++j) xn[q][j] = ((const u32x2*)(x1 + (size_t)(F.vcu * 128 + 2 * p_lo + q) * D))[F.lane + 64 * j];
    for (int pr = 0; pr < p_n; ++pr) { const int row0 = F.vcu * 128 + 2 * (p_lo + pr);
        f32x4 h0[4], h1[4];
        float ss0 = 0.f, ss1 = 0.f;
#pragma unroll
        for (int j = 0; j < 4; ++j) { h0[j] = (f32x4){bflo(xn[0][j].x), bfhi(xn[0][j].x), bflo(xn[0][j].y), bfhi(xn[0][j].y)}; h1[j] = (f32x4){bflo(xn[1][j].x), bfhi(xn[1][j].x), bflo(xn[1][j].y), bfhi(xn[1][j].y)};
            ss0 += (h0[j][0] * h0[j][0] + h0[j][1] * h0[j][1]) + (h0[j][2] * h0[j][2] + h0[j][3] * h0[j][3]); ss1 += (h1[j][0] * h1[j][0] + h1[j][1] * h1[j][1]) + (h1[j][2] * h1[j][2] + h1[j][3] * h1[j][3]); }
        { const int nr = row0 + (pr + 1 < p_n ? 2 : 0);
#pragma unroll
            for (int q = 0; q < 2; ++q)
#pragma unroll
                for (int j = 0; j < 4; ++j) xn[q][j] = ((const u32x2*)(x1 + (size_t)(nr + q) * D))[F.lane + 64 * j]; }
#pragma unroll
        for (int o = 1; o < 64; o <<= 1) { ss0 += __shfl_xor(ss0, o); ss1 += __shfl_xor(ss1, o); }
        const float rs0 = rsqrtf(ss0 * (1.f / D) + NORM_EPS), rs1 = rsqrtf(ss1 * (1.f / D) + NORM_EPS);
        unsigned char* o0 = wsp<unsigned char>(F, WS_H8) + (size_t)row0 * D * (MK_FP8 ? 1 : 2); unsigned char* o1 = o0 + (size_t)D * (MK_FP8 ? 1 : 2);
#pragma unroll
        for (int j = 0; j < 4; ++j) { h0[j] = h0[j] * rs0 * scq[j] + shq[j]; h1[j] = h1[j] * rs1 * scq[j] + shq[j];
#if MK_FP8
            ((unsigned*)o0)[F.lane + 64 * j] = pg8::pk4_fp8(h0[j][0], h0[j][1], h0[j][2], h0[j][3]); ((unsigned*)o1)[F.lane + 64 * j] = pg8::pk4_fp8(h1[j][0], h1[j][1], h1[j][2], h1[j][3]);
#else
            { u32x2 w; w.x = pk2(h0[j][0], h0[j][1]); w.y = pk2(h0[j][2], h0[j][3]); ((u32x2*)o0)[F.lane + 64 * j] = w; w.x = pk2(h1[j][0], h1[j][1]); w.y = pk2(h1[j][2], h1[j][3]); ((u32x2*)o1)[F.lane + 64 * j] = w; }
#endif
        }
        float pa0[32], pa1[32];
#pragma unroll
        for (int q = 0; q < 32; ++q) { float s0 = 0.f, s1 = 0.f;
#pragma unroll
            for (int j = 0; j < 4; ++j) { const f32x4 w4 = *(const LAS f32x4*)(Wt + q * 1024 + 4 * F.lane + 256 * j);
                s0 = fmaf(h0[j][0], w4[0], s0); s0 = fmaf(h0[j][1], w4[1], s0); s0 = fmaf(h0[j][2], w4[2], s0); s0 = fmaf(h0[j][3], w4[3], s0);
                s1 = fmaf(h1[j][0], w4[0], s1); s1 = fmaf(h1[j][1], w4[1], s1); s1 = fmaf(h1[j][2], w4[2], s1); s1 = fmaf(h1[j][3], w4[3], s1); }
            pa0[q] = s0; pa1[q] = s1; }
        const float lg0 = reduce32x64(pa0, F.lane) + bre, lg1 = reduce32x64(pa1, F.lane) + bre;
#pragma unroll
        for (int q = 0; q < 2; ++q) { const float logit = q ? lg1 : lg0; const int row = row0 + q; LAS float* lg32 = lgw + q * 64;
            if (F.lane < 32) lg32[e] = logit;
            asm volatile("s_waitcnt lgkmcnt(0)" ::: "memory");
            int rank = 0;
#pragma unroll 8
            for (int o = 0; o < 32; ++o) { const float ov = lg32[o]; rank += (ov > logit || (ov == logit && o < e)) ? 1 : 0; }
            if (F.lane < 32 && rank < 4) lg32[32 + rank] = logit;
            asm volatile("s_waitcnt lgkmcnt(0)" ::: "memory");
            const float t0 = lg32[32], t1 = lg32[33], t2 = lg32[34], t3 = lg32[35];
            const float den = 1.f + __expf(t1 - t0) + __expf(t2 - t0) + __expf(t3 - t0);
            if (F.lane < 32 && rank < 4) { const int lp = atomicAdd((int*)&cnt[e], 1);
                RT_E[row * 4 + rank] = e; RT_LP[row * 4 + rank] = lp; RT_G[row * 4 + rank] = __expf(logit - t0) / den; }
            asm volatile("s_waitcnt lgkmcnt(0)" ::: "memory"); }
    }
    }
    __syncthreads();
    if (F.tid < 32) wsp<int>(F, WS_BLKCNT)[F.vcu * 32 + F.tid] = cnt[F.tid];
}

__device__ __forceinline__ void phase9(const Frame& F) {
    LAS int* base = (LAS int*)F.lds;
    LAS int* tot = base + 32;
    LAS int* pst = base + 64;
    const int* BC = wsp<int>(F, WS_BLKCNT);
    { LAS int* ps = base + 128; LAS int* pm = ps + 512;
        const int e = F.tid & 31, seg = F.tid >> 5; int s = 0, mine = 0;
#pragma unroll
        for (int j = 0; j < 16; ++j) { const int bk = seg * 16 + j, v = BC[bk * 32 + e]; s += v; mine += (bk < F.vcu) ? v : 0; }
        ps[seg * 32 + e] = s; pm[seg * 32 + e] = mine; }
    __syncthreads();
    if (F.tid < 32) { int s = 0, mine = 0;
#pragma unroll
        for (int q = 0; q < 16; ++q) { s += base[128 + q * 32 + F.tid]; mine += base[128 + 512 + q * 32 + F.tid]; }
        base[F.tid] = mine; tot[F.tid] = s; }
    __syncthreads();
    if (F.tid == 0) { int s = 0; for (int e = 0; e < 32; ++e) { pst[e] = s; s += (tot[e] + 255) / 256 * 256; } pst[32] = s; }
    __syncthreads();
    int* SLOT_TOK = wsp<int>(F, WS_SLOTTOK); float* SLOT_GATE = wsp<float>(F, WS_SLOTGATE); int* TOK_SLOT = wsp<int>(F, WS_TOKSLOT);
    const int* RT_E = wsp<int>(F, WS_RT_E); const int* RT_LP = wsp<int>(F, WS_RT_LP); const float* RT_G = wsp<float>(F, WS_RT_G);
    { const int idx = F.vcu * 512 + F.tid;
        const int e = RT_E[idx], slot = pst[e] + base[e] + RT_LP[idx];
        SLOT_TOK[slot] = idx >> 2; SLOT_GATE[slot] = RT_G[idx]; TOK_SLOT[idx] = slot; }
    if (F.vcu < 32) { const int e = F.vcu; for (int s = pst[e] + tot[e] + F.tid; s < pst[e + 1]; s += 512) { SLOT_TOK[s] = 0; SLOT_GATE[s] = 0.f; } }
    if (F.vcu == 0) { unsigned* ctl = wsp<unsigned>(F, WS_CTL);
        if (F.tid == 0) ctl[CW_NTILES] = (unsigned)(pst[32] / 256);
        if (F.tid < 33) ctl[CW_PADSTART + F.tid] = (unsigned)pst[F.tid];
        int* TE = wsp<int>(F, WS_TILEE);
        for (int tl = F.tid; tl < MAX_TILES; tl += 512) { int e = 31; for (int q = 0; q < 32; ++q) if (tl * 256 < pst[q + 1]) { e = q; break; } TE[tl] = e; } }
#if MK_CONV_WHERE == 9
    for (int it = CONV_4B + F.vcu * 8 + F.wave; it < MOE_ITEMS; it += F.G * 8) moe_weight_item(F, it);
#endif
}

__device__ __forceinline__ void phase12(const Frame& F) {
    const int gw = F.vcu * 8 + F.wave, NGW = F.G * 8;
    const float* mod = wsp<float>(F, WS_MOD); const bf16* YS = wsp<bf16>(F, WS_YS); const int* TOK_SLOT = wsp<int>(F, WS_TOKSLOT); const bf16* X1B = wsp<bf16>(F, WS_X1B);
    for (int row = gw; row < M; row += 2 * NGW) {
        int sl[2][4]; u32x4 v[2][2][4], xb[2][2];
#pragma unroll
        for (int rr = 0; rr < 2; ++rr)
#pragma unroll
            for (int k = 0; k < 4; ++k) sl[rr][k] = TOK_SLOT[(row + rr * NGW) * 4 + k];
#pragma unroll
        for (int rr = 0; rr < 2; ++rr)
#pragma unroll
            for (int j = 0; j < 2; ++j) { const int col = 8 * F.lane + 512 * j;
#pragma unroll
                for (int k = 0; k < 4; ++k) v[rr][j][k] = __builtin_nontemporal_load((const u32x4*)(YS + (size_t)sl[rr][k] * D + col));
                xb[rr][j] = __builtin_nontemporal_load((const u32x4*)(X1B + (size_t)(row + rr * NGW) * D + col)); }
#pragma unroll
        for (int rr = 0; rr < 2; ++rr) { const int rw = row + rr * NGW, b = rw / T;
#pragma unroll
            for (int j = 0; j < 2; ++j) { const int col = 8 * F.lane + 512 * j;
                float a[8];
#pragma unroll
                for (int q = 0; q < 8; ++q) a[q] = 0.f;
#pragma unroll
                for (int k = 0; k < 4; ++k) { const u32x4 w = v[rr][j][k];
                    a[0] += bflo(w.x); a[1] += bfhi(w.x); a[2] += bflo(w.y); a[3] += bfhi(w.y); a[4] += bflo(w.z); a[5] += bfhi(w.z); a[6] += bflo(w.w); a[7] += bfhi(w.w); }
                const float* gp = mod + b * 6144 + 5120 + col;
                const f32x4 g0 = *(const f32x4*)gp, g1 = *(const f32x4*)(gp + 4);
                float* op = F.out + (size_t)rw * D + col;
                const u32x4 x = xb[rr][j];
                f32x4 x0 = (f32x4){bflo(x.x), bfhi(x.x), bflo(x.y), bfhi(x.y)}, x1v = (f32x4){bflo(x.z), bfhi(x.z), bflo(x.w), bfhi(x.w)};
                x0[0] += g0[0] * a[0]; x0[1] += g0[1] * a[1]; x0[2] += g0[2] * a[2]; x0[3] += g0[3] * a[3];
                x1v[0] += g1[0] * a[4]; x1v[1] += g1[1] * a[5]; x1v[2] += g1[2] * a[6]; x1v[3] += g1[3] * a[7];
                *(f32x4*)op = x0; *(f32x4*)(op + 4) = x1v; } }
    }
}

__device__ __forceinline__ void copy_x_to_out(const Frame& F) {
    const size_t n4 = (size_t)M * D / 4; const f32x4* s = (const f32x4*)F.in[0]; f32x4* d = (f32x4*)F.out;
    for (size_t i = (size_t)blockIdx.x * 512 + F.tid; i < n4; i += (size_t)gridDim.x * 512) d[i] = s[i];
}


#define XB_TMO      128
#define XB_XCNT(j)  (256  + 64 * (j))
#define XB_XSUB(j)  (1280 + 64 * (j))
#define XB_XGEN(j)  (2304 + 64 * (j))
#define XB_TOP      3328
#define XB_TOPGEN   3392
#define XCD_BAR_WORDS 3456
#define XB_SPIN_CAP (1u << 18)
__device__ __forceinline__ unsigned xb_ld(unsigned* p)              { return __hip_atomic_load(p, __ATOMIC_RELAXED, __HIP_MEMORY_SCOPE_AGENT); }
__device__ __forceinline__ unsigned xb_add(unsigned* p, unsigned v) { return __hip_atomic_fetch_add(p, v, __ATOMIC_RELAXED, __HIP_MEMORY_SCOPE_AGENT); }
__device__ __forceinline__ unsigned xb_xcc_id() { return (unsigned)__builtin_amdgcn_s_getreg((3 << 11) | 20) & 0xFu; }
#define XB_SPIN(cond, bar) do { unsigned _sp = 0; while (cond) { __builtin_amdgcn_s_sleep(1); \
    if ((++_sp & 255u) == 0u) { if (xb_ld(&(bar)[XB_TMO])) break; if (_sp > XB_SPIN_CAP) { atomicAdd(&(bar)[XB_TMO], 1u); break; } } } } while (0)
struct XcdBarrier { unsigned* bar; unsigned x; volatile LAS unsigned* st; };
__device__ __forceinline__ XcdBarrier xcd_barrier_post(unsigned* bar, volatile LAS unsigned* st) {
    XcdBarrier b; b.bar = bar; b.x = xb_xcc_id(); b.st = st;
    if (threadIdx.x == 0) (void)xb_add(&bar[XB_XCNT(b.x)], 1u);
    return b;
}
__device__ __forceinline__ void xcd_barrier_complete(unsigned* bar, unsigned x, unsigned& nloc, unsigned& nx) {
    const unsigned G = gridDim.x * gridDim.y * gridDim.z;
    unsigned sum, cnt, mine, sp = 0u;
    for (;;) {
        sum = 0u; cnt = 0u; mine = 0u;
#pragma unroll
        for (unsigned j = 0; j < 16; ++j) { const unsigned c = xb_ld(&bar[XB_XCNT(j)]); sum += c; cnt += (c > 0u) ? 1u : 0u; mine = (j == x) ? c : mine; }
        if (sum == G) break;
        __builtin_amdgcn_s_sleep(1);
        if ((++sp & 255u) == 0u) { if (xb_ld(&bar[XB_TMO])) break; if (sp > XB_SPIN_CAP) { atomicAdd(&bar[XB_TMO], 1u); break; } }
    }
    nloc = mine > 0u ? mine : 1u; nx = cnt > 0u ? cnt : 1u;
}
__device__ __forceinline__ void xcd_barrier(const XcdBarrier& b) {
    asm volatile("s_waitcnt vmcnt(0)" ::: "memory");
    __syncthreads();
    if (threadIdx.x == 0) {
        unsigned* bar = b.bar;
        __builtin_amdgcn_s_waitcnt(0);
        unsigned nloc = b.st[0], nx = b.st[1];
        if (nloc == 0u) { xcd_barrier_complete(bar, b.x, nloc, nx); b.st[0] = nloc; b.st[1] = nx; }
        const unsigned old = xb_add(&bar[XB_XSUB(b.x)], 1u);
        const unsigned gen = old / nloc;
        if (old + 1u == (gen + 1u) * nloc) {
            __builtin_amdgcn_fence(__ATOMIC_RELEASE, "agent");
            asm volatile("s_waitcnt vmcnt(0)" ::: "memory");
            const unsigned og = xb_add(&bar[XB_TOP], 1u);
            const unsigned tg = og / nx;
            if (og + 1u == (tg + 1u) * nx) xb_add(&bar[XB_TOPGEN], 1u);
            else XB_SPIN(xb_ld(&bar[XB_TOPGEN]) == tg, bar);
            __builtin_amdgcn_fence(__ATOMIC_ACQUIRE, "agent");
            xb_add(&bar[XB_XGEN(b.x)], 1u);
            asm volatile("s_waitcnt vmcnt(0)" ::: "memory");
        } else {
            XB_SPIN(xb_ld(&bar[XB_XGEN(b.x)]) == gen, bar);
            __builtin_amdgcn_fence(__ATOMIC_ACQUIRE, "agent");
            asm volatile("s_waitcnt vmcnt(0)" ::: "memory");
        }
    }
    __syncthreads();
}

struct Args { const float* in[28]; float* out; unsigned char* ws; int ph_lo, ph_hi; };
constexpr int N_PHASES = 13;

__global__ void __launch_bounds__(512, 2) mk_fwd(Args args) {
    extern __shared__ __attribute__((aligned(16))) unsigned char lds_raw[];
    Frame F;
    F.lds = (LAS unsigned char*)lds_raw;
    F.tid = threadIdx.x; F.lane = F.tid & 63; F.wave = __builtin_amdgcn_readfirstlane(F.tid >> 6);
    F.G = gridDim.x; { const int bx = blockIdx.x; F.vcu = (F.G % 8 == 0) ? (bx % 8) * (F.G / 8) + bx / 8 : bx; }
    F.in = args.in;
    F.out = args.out; F.ws = args.ws;
    cg::grid_group grid = cg::this_grid();
    const int lo = args.ph_lo, hi = args.ph_hi;
    volatile LAS unsigned* MISC = (volatile LAS unsigned*)(F.lds + MISC_OFF);
    if (F.tid < 16) MISC[F.tid] = 0u;
    __syncthreads();
    XcdBarrier bar; bar.bar = wsp<unsigned>(F, WS_CTL) + CW_BAR; bar.x = 0; bar.st = MISC;
    if (hi - lo > 1) bar = xcd_barrier_post(wsp<unsigned>(F, WS_CTL) + CW_BAR, MISC);
#define IN(k) (lo <= (k) && (k) < hi)
#define REP(k) for (int rep_ = 0; rep_ < 1 + ((MK_REPEAT_MASK >> (k)) & 1); ++rep_)
#define SEAM(k) do { if (IN(k) && IN((k) + 1)) { if ((MK_CG_SEAMS >> (k)) & 1) grid.sync(); else xcd_barrier(bar); } } while (0)

    if (IN(0)) REP(0) { phase0(F); } SEAM(0);
    if (IN(1)) REP(1) { phase1(F); } SEAM(1);
    if (IN(2)) REP(2) {
#if MK_CONV_WHERE == 2
        if ((int)blockIdx.x >= 192) { for (int it = ((int)blockIdx.x - 192) * 8 + F.wave; it < MOE_ITEMS; it += 64 * 8) moe_weight_item(F, it); }
        else {
        pg8::Gemm g{wsp<bf16>(F, WS_H), wsp<bf16>(F, WS_WIN), D, IN_COLS, nullptr};
        pg8::StaticOrder S; S.init(M, IN_COLS, 192, (int)blockIdx.x);
        pg8::EpiBf16P E{wsp<bf16>(F, WS_P), IN_COLS};
        pg8::gemm_phase<pg8::EpiBf16P, pg8::StaticOrder, false>(F.lds, g, S, E);
        }
#else
        pg8::Gemm g{wsp<bf16>(F, WS_H), wsp<bf16>(F, WS_WIN), D, IN_COLS, nullptr};
        pg8::StaticOrder S; S.init(M, IN_COLS, F.G, (int)blockIdx.x);
        pg8::EpiBf16P E{wsp<bf16>(F, WS_P), IN_COLS};
        pg8::gemm_phase<pg8::EpiBf16P, pg8::StaticOrder, false>(F.lds, g, S, E);
#endif
    } SEAM(2);
#if MK_RWKV_MODE < 3
    if (IN(3)) REP(3) { phase3(F); } SEAM(3);
#endif
    if (IN(4)) REP(4) {
#if MK_RWKV_MODE >= 1
#if MK_RWKV_MODE == 4
#if MK_WMASK != 63
        phase4a_fused(F); xcd_barrier(bar);
#endif
        for (int q_ = 0; q_ < 1 + (MK_REP4 & 1); ++q_) { phase4a_wave(F); xcd_barrier(bar); }
#elif MK_RWKV_MODE == 3
        for (int q_ = 0; q_ < 1 + (MK_REP4 & 1); ++q_) { phase4a_fused(F); xcd_barrier(bar); }
#else
        for (int q_ = 0; q_ < 1 + (MK_REP4 & 1); ++q_) { phase4a_summaries(F); xcd_barrier(bar); }
#endif
        for (int q_ = 0; q_ < 1 + ((MK_REP4 >> 1) & 1); ++q_) { phase4b_states(F); xcd_barrier(bar); }
#endif
#if MK_RWKV_MODE >= 2
        for (int q_ = 0; q_ < 1 + ((MK_REP4 >> 2) & 1); ++q_) phase4c_output(F);
#else
        phase4_scan(F);
#endif
        } SEAM(4);
    if (IN(5)) REP(5) { phase5_attn(F); } SEAM(5);
#if MK_RWKV_MODE < 2
    if (IN(6)) REP(6) { phase6(F); } SEAM(6);
#endif
    if (IN(7)) REP(7) {
#if MK_LAST_PHASE >= 7
        pg8::Gemm g{wsp<bf16>(F, WS_CAT), wsp<bf16>(F, WS_WOUT), D, D, nullptr};
        pg8::StaticOrder S; S.init(M, D, F.G, (int)blockIdx.x);
        pg8::EpiOutProj E{F.in[0], wsp<bf16>(F, WS_X1B), wsp<float>(F, WS_MOD) + 2048};
        pg8::gemm_phase<pg8::EpiOutProj, pg8::StaticOrder, false>(F.lds, g, S, E);
#else
        copy_x_to_out(F);
#endif
    } SEAM(7);
    if (IN(8)) REP(8) { phase8(F); } SEAM(8);
    if (IN(9)) REP(9) { phase9(F); } SEAM(9);
    if (IN(10)) REP(10) {
        const unsigned* ctl = wsp<unsigned>(F, WS_CTL);
        pg8::Gemm g{wsp<bf16>(F, WS_H8), wsp<bf16>(F, WS_W1), MK_FP8 ? D / 2 : D, 2 * DE, wsp<int>(F, WS_SLOTTOK)};
        pg8::MoeOrder S{(int)ctl[CW_NTILES], 8, F.G, F.vcu, wsp<int>(F, WS_TILEE)};
        pg8::EpiMoe1 E{wsp<unsigned char>(F, WS_ACT), F.in[25]};
        pg8::gemm_phase<pg8::EpiMoe1, pg8::MoeOrder, true, MK_FP8 != 0>(F.lds, g, S, E);
    } SEAM(10);
    if (IN(11)) REP(11) {
        const unsigned* ctl = wsp<unsigned>(F, WS_CTL);
        pg8::Gemm g{wsp<bf16>(F, WS_ACT), wsp<bf16>(F, WS_W2), MK_FP8 ? DE / 2 : DE, D, nullptr};
        pg8::MoeOrder S{(int)ctl[CW_NTILES], 4, F.G, F.vcu, wsp<int>(F, WS_TILEE)};
        pg8::EpiMoe2 E{wsp<bf16>(F, WS_YS), F.in[27], wsp<float>(F, WS_SLOTGATE)};
        pg8::gemm_phase<pg8::EpiMoe2, pg8::MoeOrder, false, MK_FP8 != 0>(F.lds, g, S, E);
    } SEAM(11);
    if (IN(12)) { phase12(F); }
#undef IN
#undef SEAM
}

extern "C" void kernel_launch(void* const* d_in, const int* in_sizes, int n_in, void* d_out, int out_size, void* d_ws, size_t ws_size, hipStream_t stream) {
    static int grid = 0;
    if (grid == 0) {
        if (n_in != 28 || out_size != M * D || ws_size < WS_END) { fprintf(stderr, "kernel_launch: unexpected sizes (n_in %d out %d ws %zu, need %zu)\n", n_in, out_size, ws_size, (size_t)WS_END); grid = -1; return; }
        int dev = 0, cus = 0, per_cu = 0;
        (void)hipGetDevice(&dev); (void)hipDeviceGetAttribute(&cus, hipDeviceAttributeMultiprocessorCount, dev);
        (void)hipFuncSetAttribute((const void*)mk_fwd, hipFuncAttributeMaxDynamicSharedMemorySize, LDS_BYTES);
        (void)hipOccupancyMaxActiveBlocksPerMultiprocessor(&per_cu, (const void*)mk_fwd, 512, LDS_BYTES);
        if (per_cu < 1 || cus != 256) { fprintf(stderr, "kernel_launch: occupancy %d, CUs %d: this build needs 256 CUs x 1 block\n", per_cu, cus); grid = -1; return; }
        grid = cus;
    }
    if (grid < 0) return;
    (void)hipMemsetAsync((char*)d_ws + WS_CTL, 0, CTL_BYTES, stream);
    Args a{};
    for (int i = 0; i < 28; ++i) a.in[i] = (const float*)d_in[i];
    a.out = (float*)d_out; a.ws = (unsigned char*)d_ws;
    const int last = MK_LAST_PHASE + 1;
#if MK_ONE_LAUNCH
    a.ph_lo = 0; a.ph_hi = last;
#if MK_COOP
    void* kargs[] = {&a};
    hipError_t e = hipLaunchCooperativeKernel((const void*)mk_fwd, dim3(grid), dim3(512), kargs, LDS_BYTES, stream);
    if (e != hipSuccess) fprintf(stderr, "cooperative launch failed: %s\n", hipGetErrorString(e));
#else
    hipLaunchKernelGGL(mk_fwd, dim3(grid), dim3(512), LDS_BYTES, stream, a);
#endif
#else
    for (int p = 0; p < last; ++p) { a.ph_lo = p; a.ph_hi = p + 1; hipLaunchKernelGGL(mk_fwd, dim3(grid), dim3(512), LDS_BYTES, stream, a); }
#endif
}
```

```cpp
#include <hip/hip_runtime.h>
#include <hip/hip_cooperative_groups.h>
#include <cstdio>
#include <cstdint>
namespace cg = cooperative_groups;

#ifndef MK_ONE_LAUNCH
#define MK_ONE_LAUNCH 1
#endif
#ifndef MK_REPEAT_MASK
#define MK_REPEAT_MASK 0
#endif
#ifndef MK_CONV_WHERE
#define MK_CONV_WHERE 8
#endif
#define MK_CONV_IN_SCAN (MK_CONV_WHERE == 4)
#ifndef MK_RWKV_MODE
#define MK_RWKV_MODE 3
#endif
#ifndef MK_FP8
#define MK_FP8 1
#endif
#ifndef MK_DUP
#define MK_DUP 0
#endif
#ifndef MK_WMASK
#define MK_WMASK 63
#endif
#ifndef MK_ATTN_IN_4B
#define MK_ATTN_IN_4B 1
#endif
#ifndef MK_REP4
#define MK_REP4 0
#endif
#ifndef MK_CG_SEAMS
#define MK_CG_SEAMS 0
#endif
#ifndef MK_COOP
#define MK_COOP 0
#endif
#ifndef MK_LAST_PHASE
#define MK_LAST_PHASE 12
#endif

constexpr int D = 1024, NBATCH = 8, T = 4096, M = NBATCH * T;
constexpr int HD = 64, RW = 512, RH = 8, AW = 512, QH = 8, KVH = 2, WIN = 128;
constexpr int RWKV_COLS = 1792, IN_COLS = 2560;
constexpr int COL_Q = 1792, COL_K = 1792 + 512, COL_V = 1792 + 512 + 128;
constexpr int NE = 32, TOPK = 4, DE = 1024;
constexpr int MAX_TILES = 544;
constexpr int MAX_SLOTS = MAX_TILES * 256;
constexpr float NORM_EPS = 1e-6f, GN_EPS = 64e-5f;

#define GAS __attribute__((address_space(1)))
#define LAS __attribute__((address_space(3)))
typedef unsigned short bf16;
typedef short bf16x8 __attribute__((ext_vector_type(8)));
typedef float f32x4 __attribute__((ext_vector_type(4)));
typedef float f32x2 __attribute__((ext_vector_type(2)));
typedef float f32x16 __attribute__((ext_vector_type(16)));
typedef unsigned u32x4 __attribute__((ext_vector_type(4)));
typedef unsigned u32x2 __attribute__((ext_vector_type(2)));
typedef int i32x8 __attribute__((ext_vector_type(8)));
typedef int i32x4 __attribute__((ext_vector_type(4)));

constexpr size_t MiB = 1u << 20;
constexpr size_t WS_CTL = 0, CTL_BYTES = 64 * 1024;
constexpr size_t WS_MOD = 1 * MiB;
constexpr size_t WS_BON = 1 * MiB + 256 * 1024;
constexpr size_t WS_RT_E = 2 * MiB;
constexpr size_t WS_RT_LP = 2 * MiB + 512 * 1024;
constexpr size_t WS_RT_G = 3 * MiB;
constexpr size_t WS_TOKSLOT = 3 * MiB + 512 * 1024;
constexpr size_t WS_SLOTTOK = 4 * MiB;
constexpr size_t WS_SLOTGATE = 5 * MiB;
constexpr size_t WS_BLKCNT = 6 * MiB;
constexpr size_t WS_TILEE = 6 * MiB + 64 * 1024;
constexpr size_t WS_BONUS = 7 * MiB;
constexpr size_t WS_LW = 9 * MiB;
constexpr size_t WS_WIN = 10 * MiB;
constexpr size_t WS_WOUT = 16 * MiB;
constexpr size_t WS_W1 = 20 * MiB;
constexpr size_t WS_W2 = 148 * MiB;
constexpr size_t WS_H = 212 * MiB;
constexpr size_t WS_R2 = 276 * MiB;
constexpr size_t WS_P = WS_R2;
constexpr size_t WS_SCN = WS_R2 + 160 * MiB;
constexpr size_t WS_SV = WS_SCN + 320 * MiB;
constexpr size_t WS_G = WS_SV + 64 * MiB;
constexpr size_t WS_Y = WS_G + 32 * MiB;
constexpr size_t WS_CAT = WS_Y + 64 * MiB;
constexpr size_t WS_ACT = WS_R2;
constexpr size_t WS_YS = WS_R2 + 272 * MiB;
constexpr size_t WS_END = 1012 * MiB;
constexpr size_t WS_X1B = WS_H;
constexpr size_t WS_H8 = WS_Y;
constexpr size_t WS_PT = 436 * MiB;
constexpr size_t WS_ZV = 500 * MiB;
constexpr size_t WS_Z0 = 628 * MiB;
constexpr size_t WS_RYT = 692 * MiB;
constexpr size_t WS_YVT = WS_Y;
static_assert(WS_END <= 1024 * MiB, "workspace map");
static_assert(WS_YS + 272 * MiB <= WS_CAT, "YS must not overlay CAT");
constexpr int CW_NTILES = 16;
constexpr int CW_PADSTART = 64;
constexpr int CW_BAR = 4096;
constexpr int MISC_OFF = 160 * 1024 - 64;

constexpr int LDS_BYTES = 160 * 1024;

__device__ __forceinline__ unsigned f2bf(float f) { unsigned u = __builtin_bit_cast(unsigned, f); return (u + 0x7fffu + ((u >> 16) & 1u)) >> 16; }
typedef __bf16 bf16x2_t __attribute__((ext_vector_type(2)));
__device__ __forceinline__ unsigned pk2(float lo, float hi) { const f32x2 v = {lo, hi}; return __builtin_bit_cast(unsigned, __builtin_convertvector(v, bf16x2_t)); }
__device__ __forceinline__ float bf2f(unsigned short b) { return __builtin_bit_cast(float, ((unsigned)b) << 16); }
__device__ __forceinline__ float bflo(unsigned u) { return __builtin_bit_cast(float, u << 16); }
__device__ __forceinline__ float bfhi(unsigned u) { return __builtin_bit_cast(float, u & 0xffff0000u); }
__device__ __forceinline__ float wave_sum(float v) {
#pragma unroll
    for (int o = 1; o < 64; o <<= 1) v += __shfl_xor(v, o);
    return v;
}
__device__ __forceinline__ void lds_barrier() { asm volatile("s_waitcnt lgkmcnt(0)" ::: "memory"); __builtin_amdgcn_s_barrier(); asm volatile("" ::: "memory"); }
__device__ __forceinline__ float sigmoidf_(float x) { return __builtin_amdgcn_rcpf(1.f + __expf(-x)); }

namespace pg8 {
#define PG8_LAS __attribute__((address_space(3)))
constexpr int BM = 256, BK = 64, HALF = 128, HTB = HALF * BK * 2, STAGE_BYTES = 8 * HTB, NXCD = 8, WGM = 8;
__host__ __device__ __forceinline__ int lds_byte(int r, int c) { const int st = (r >> 4) * 2 + (c >> 5), rr = r & 15, cc = c & 31, ob = rr * 64 + cc * 2; return st * 1024 + (ob ^ (((ob >> 9) & 1) << 5)); }
__host__ __device__ __forceinline__ void stage_rc(int b, int& R, int& C) { const int st = b / 1024, sb = b % 1024, swz = sb ^ (((sb >> 9) & 1) << 5); R = (st >> 1) * 16 + swz / 64; C = (st & 1) * 32 + (swz % 64) / 2; }

struct Unit { int pm, pn, e; };
struct Gemm { const bf16* A; const bf16* Bt; int K, N; const int* rowmap; };

struct StaticOrder {
    int nM, nN, nwg, G, c;
    __device__ void init(int M_, int N_, int G_, int c_) { nM = M_ / BM; nN = N_ / BM; nwg = nM * nN; G = G_; c = c_; }
    __device__ bool next(int i, Unit& u) const {
        const long L = (long)i * G + c; if (L >= nwg) return false;
        int wgid = (int)L; { const int q = nwg / NXCD, r = nwg % NXCD, xcd = wgid % NXCD, off = wgid / NXCD; wgid = (xcd < r ? xcd * (q + 1) : r * (q + 1) + (xcd - r) * q) + off; }
        const int nig = WGM * nN, gid = wgid / nig, fm = gid * WGM, gsz = (nM - fm) < WGM ? (nM - fm) : WGM;
        u.pm = fm + ((wgid % nig) % gsz); u.pn = (wgid % nig) / gsz; u.e = 0; return true;
    }
};
struct MoeOrder {
    int nMt, nN, G, c; const int* tile_e;
    __device__ bool next(int i, Unit& u) const {
        const long L = (long)i * G + c; if (L >= (long)nMt * nN) return false;
        u.pm = (int)(L / nN); u.pn = (int)(L % nN); u.e = tile_e[u.pm]; return true;
    }
};

__device__ __forceinline__ unsigned cvt_pk_bf16(float lo, float hi) { unsigned r; asm volatile("v_cvt_pk_bf16_f32 %0, %1, %2" : "=v"(r) : "v"(lo), "v"(hi)); return r; }

struct EpiBf16P {
    bf16* O; int ldc;
    __device__ __forceinline__ void operator()(const f32x4 (&acc)[2][2][4][2], const Unit& u, int wr, int wc, int fr, int fq) const {
        const int row0 = u.pm * BM + wr * 64 + fr, col0 = u.pn * BM + wc * 32 + 8 * fq;
#pragma unroll
        for (int ai = 0; ai < 2; ++ai)
#pragma unroll
            for (int m = 0; m < 4; ++m) { bf16* rowp = O + (size_t)(row0 + ai * HALF + m * 16) * ldc + col0;
#pragma unroll
                for (int bj = 0; bj < 2; ++bj) { const f32x4 v0 = acc[ai][bj][m][0], v1 = acc[ai][bj][m][1];
                    u32x4 w; w.x = cvt_pk_bf16(v0[0], v0[1]); w.y = cvt_pk_bf16(v0[2], v0[3]); w.z = cvt_pk_bf16(v1[0], v1[1]); w.w = cvt_pk_bf16(v1[2], v1[3]);
                    *(u32x4*)(rowp + bj * HALF) = w; } }
    }
};
struct EpiOutProj {
    const float* x; bf16* out; const float* gate;
    __device__ __forceinline__ void operator()(const f32x4 (&acc)[2][2][4][2], const Unit& u, int wr, int wc, int fr, int fq) const {
        const int row0 = u.pm * BM + wr * 64 + fr, col0 = u.pn * BM + wc * 32 + 8 * fq;
        const int b = (u.pm * BM) / T;
        f32x4 gv[2][2];
#pragma unroll
        for (int bj = 0; bj < 2; ++bj)
#pragma unroll
            for (int n = 0; n < 2; ++n) gv[bj][n] = *(const f32x4*)(gate + (size_t)b * 6144 + col0 + bj * HALF + 4 * n);
#pragma unroll
        for (int ai = 0; ai < 2; ++ai)
#pragma unroll
            for (int m = 0; m < 4; ++m) { const size_t ro = (size_t)(row0 + ai * HALF + m * 16) * D + col0;
#pragma unroll
                for (int bj = 0; bj < 2; ++bj) { const f32x4 x0 = __builtin_nontemporal_load((const f32x4*)(x + ro + bj * HALF)), x1 = __builtin_nontemporal_load((const f32x4*)(x + ro + bj * HALF + 4));
                    const f32x4 v0 = x0 + gv[bj][0] * acc[ai][bj][m][0], v1 = x1 + gv[bj][1] * acc[ai][bj][m][1];
                    u32x4 w; w.x = cvt_pk_bf16(v0[0], v0[1]); w.y = cvt_pk_bf16(v0[2], v0[3]); w.z = cvt_pk_bf16(v1[0], v1[1]); w.w = cvt_pk_bf16(v1[2], v1[3]);
                    *(u32x4*)(out + ro + bj * HALF) = w; } }
    }
};
__device__ __forceinline__ unsigned pk4_fp8(float a, float b, float c, float d) { int w = 0; w = __builtin_amdgcn_cvt_pk_fp8_f32(a, b, w, false); w = __builtin_amdgcn_cvt_pk_fp8_f32(c, d, w, true); return (unsigned)w; }
constexpr float W8_SCALE = 32.f, W8_INV = 1.f / 32.f;
struct EpiMoe1 {
    unsigned char* act; const float* b1;
    __device__ __forceinline__ void operator()(const f32x4 (&acc)[2][2][4][2], const Unit& u, int wr, int wc, int fr, int fq) const {
        const int row0 = u.pm * BM + wr * 64 + fr, j0 = u.pn * 128 + wc * 16 + 4 * fq;
        const float* bb = b1 + (size_t)u.e * 2048;
        f32x4 bg[2], bl[2];
#pragma unroll
        for (int bj = 0; bj < 2; ++bj) { bg[bj] = *(const f32x4*)(bb + j0 + bj * 64); bl[bj] = *(const f32x4*)(bb + 1024 + j0 + bj * 64); }
#pragma unroll
        for (int ai = 0; ai < 2; ++ai)
#pragma unroll
            for (int m = 0; m < 4; ++m) { unsigned char* rowp = act + ((size_t)(row0 + ai * HALF + m * 16) * DE + j0) * (MK_FP8 ? 1 : 2);
#pragma unroll
                for (int bj = 0; bj < 2; ++bj) { const f32x4 g4 = acc[ai][bj][m][0] * (MK_FP8 ? W8_INV : 1.f) + bg[bj], l4 = acc[ai][bj][m][1] * (MK_FP8 ? W8_INV : 1.f) + bl[bj]; float a[4];
#pragma unroll
                    for (int q = 0; q < 4; ++q) { const float gl = fminf(g4[q], 7.0f), li = fminf(fmaxf(l4[q], -7.0f), 7.0f);
                        a[q] = gl * __builtin_amdgcn_rcpf(1.f + __expf(-1.702f * gl)) * (li + 1.f); }
#if MK_FP8
                    *(unsigned*)(rowp + bj * 64) = pk4_fp8(a[0], a[1], a[2], a[3]);
#else
                    u32x2 w; w.x = cvt_pk_bf16(a[0], a[1]); w.y = cvt_pk_bf16(a[2], a[3]); *(u32x2*)(rowp + bj * 128) = w;
#endif
                } }
    }
};
struct EpiMoe2 {
    bf16* ys; const float* b2; const float* sgate;
    __device__ __forceinline__ void operator()(const f32x4 (&acc)[2][2][4][2], const Unit& u, int wr, int wc, int fr, int fq) const {
        const int row0 = u.pm * BM + wr * 64 + fr, col0 = u.pn * BM + wc * 32 + 8 * fq;
        const float* bb = b2 + (size_t)u.e * 1024;
        f32x4 bv[2][2];
#pragma unroll
        for (int bj = 0; bj < 2; ++bj)
#pragma unroll
            for (int n = 0; n < 2; ++n) bv[bj][n] = *(const f32x4*)(bb + col0 + bj * HALF + 4 * n);
#pragma unroll
        for (int ai = 0; ai < 2; ++ai)
#pragma unroll
            for (int m = 0; m < 4; ++m) { const int row = row0 + ai * HALF + m * 16; const float gt = sgate[row]; bf16* rowp = ys + (size_t)row * D + col0;
#pragma unroll
                for (int bj = 0; bj < 2; ++bj) { const f32x4 v0 = (acc[ai][bj][m][0] * (MK_FP8 ? W8_INV : 1.f) + bv[bj][0]) * gt, v1 = (acc[ai][bj][m][1] * (MK_FP8 ? W8_INV : 1.f) + bv[bj][1]) * gt;
                    u32x4 w; w.x = cvt_pk_bf16(v0[0], v0[1]); w.y = cvt_pk_bf16(v0[2], v0[3]); w.z = cvt_pk_bf16(v1[0], v1[1]); w.w = cvt_pk_bf16(v1[2], v1[3]);
                    *(u32x4*)(rowp + bj * HALF) = w; } }
    }
};

template <class Epi, class Sched, bool GATHER, bool FP8 = false>
__device__ __forceinline__ void gemm_phase(PG8_LAS unsigned char* lds, const Gemm g, const Sched& S, const Epi& E) {
    const int tid = threadIdx.x, wid = __builtin_amdgcn_readfirstlane(tid >> 6), lane = tid & 63, wr = wid >> 2, wc = wid & 3, fr = lane & 15, fq = lane >> 4;
    const int K = g.K, nt = K / BK;
    int Rr[2], Cc[2]; unsigned voffB[2];
#pragma unroll
    for (int i = 0; i < 2; ++i) { stage_rc(tid * 16 + i * 8192, Rr[i], Cc[i]); voffB[i] = (unsigned)(Rr[i] * K + Cc[i]) * 2u; }
    const size_t kstep = (size_t)(BK * 2);
    const size_t hstep = (size_t)HALF * K * 2;
    const size_t tstep = 2 * hstep;
    const unsigned ldsw = (unsigned)wid * 1024u;
    const int aoff = lds_byte(wr * 64 + fr, fq * 8), boff = lds_byte(wc * 32 + fr, fq * 8);
#define PG8_SA(b, h) (((b) * 2 + (h)) * HTB)
#define PG8_SB(b, h) ((4 + (b) * 2 + (h)) * HTB)
#define PG8_STAGE(bufoff, gbase, voff) do { _Pragma("unroll") for (int _i = 0; _i < 2; ++_i) \
        __builtin_amdgcn_global_load_lds((const unsigned*)((const char*)(gbase) + (voff)[_i]), (PG8_LAS unsigned*)(lds + (bufoff) + ldsw + _i * 8192), 16, 0, 0); } while (0)
#define PG8_LDA(dst, b, h) do { _Pragma("unroll") for (int m = 0; m < 4; ++m) { const PG8_LAS i32x4* _p = (const PG8_LAS i32x4*)(lds + PG8_SA(b, h) + aoff + m * 2048); \
        dst[m] = __builtin_shufflevector(_p[0], _p[64], 0, 1, 2, 3, 4, 5, 6, 7); } } while (0)
#define PG8_LDB(dst, b, h) do { _Pragma("unroll") for (int n = 0; n < 2; ++n) { const PG8_LAS i32x4* _p = (const PG8_LAS i32x4*)(lds + PG8_SB(b, h) + boff + n * 2048); \
        dst[n] = __builtin_shufflevector(_p[0], _p[64], 0, 1, 2, 3, 4, 5, 6, 7); } } while (0)
#define PG8_MMA(ai, bj, At, Bt) do { __builtin_amdgcn_s_setprio(1); _Pragma("unroll") for (int m = 0; m < 4; ++m) _Pragma("unroll") for (int n = 0; n < 2; ++n) { \
        if constexpr (FP8)   \
            asm volatile("v_mfma_scale_f32_16x16x128_f8f6f4 %0, %1, %2, %0, %3, %3 op_sel_hi:[0,0,0]" : "+v"(acc[ai][bj][m][n]) : "v"(Bt[n]), "v"(At[m]), "v"(0x7F7F7F7F)); \
        else { acc[ai][bj][m][n] = __builtin_amdgcn_mfma_f32_16x16x32_bf16(__builtin_bit_cast(bf16x8, __builtin_shufflevector(Bt[n], Bt[n], 0, 1, 2, 3)), __builtin_bit_cast(bf16x8, __builtin_shufflevector(At[m], At[m], 0, 1, 2, 3)), acc[ai][bj][m][n], 0, 0, 0); \
               acc[ai][bj][m][n] = __builtin_amdgcn_mfma_f32_16x16x32_bf16(__builtin_bit_cast(bf16x8, __builtin_shufflevector(Bt[n], Bt[n], 4, 5, 6, 7)), __builtin_bit_cast(bf16x8, __builtin_shufflevector(At[m], At[m], 4, 5, 6, 7)), acc[ai][bj][m][n], 0, 0, 0); } } \
        __builtin_amdgcn_s_setprio(0); \
        if constexpr (FP8) asm volatile("" : "+v"(acc[ai][bj][0][0]), "+v"(acc[ai][bj][0][1]), "+v"(acc[ai][bj][1][0]), "+v"(acc[ai][bj][1][1]), "+v"(acc[ai][bj][2][0]), "+v"(acc[ai][bj][2][1]), "+v"(acc[ai][bj][3][0]), "+v"(acc[ai][bj][3][1]));   \
        } while (0)
#define PG8_WAIT_V(n) asm volatile("s_waitcnt vmcnt(" #n ")" ::: "memory")
#define PG8_WAIT_L(n) asm volatile("s_waitcnt lgkmcnt(" #n ")" ::: "memory")
#define PG8_BAR __builtin_amdgcn_s_barrier()
#define PG8_SCHED __builtin_amdgcn_sched_barrier(0)
#define PG8_AOFFS(dst, u) do { _Pragma("unroll") for (int _h = 0; _h < 2; ++_h) _Pragma("unroll") for (int _i = 0; _i < 2; ++_i) { int _R, _C; stage_rc((int)threadIdx.x * 16 + _i * 8192, _R, _C); \
        if constexpr (GATHER) { const int _tok = g.rowmap[(u).pm * BM + _h * HALF + _R]; dst[_h][_i] = (unsigned)(_tok * K + _C) * 2u; } \
        else dst[_h][_i] = (unsigned)((_h * HALF + _R) * K + _C) * 2u; } } while (0)
#define PG8_ABASE(u) (GATHER ? (const char*)g.A : (const char*)g.A + (size_t)(u).pm * tstep)
#define PG8_BBASE(u) ((const char*)g.Bt + ((size_t)(u).e * g.N + (size_t)(u).pn * BM) * K * 2)
    Unit cur, nxt, nn; int ui = 0;
    if (!S.next(0, cur)) return;
    bool has_next = S.next(1, nxt);
    unsigned curA[2][2], nxtA[2][2];
    PG8_AOFFS(curA, cur);
    if (has_next) PG8_AOFFS(nxtA, nxt); else {
#pragma unroll
        for (int h = 0; h < 2; ++h)
#pragma unroll
            for (int i = 0; i < 2; ++i) nxtA[h][i] = curA[h][i]; }
    f32x4 acc[2][2][4][2];
#pragma unroll
    for (int a = 0; a < 2; ++a)
#pragma unroll
        for (int b = 0; b < 2; ++b)
#pragma unroll
            for (int m = 0; m < 4; ++m)
#pragma unroll
                for (int n = 0; n < 2; ++n) acc[a][b][m][n] = (f32x4){0.f, 0.f, 0.f, 0.f};
    i32x8 At[4], B0[2], B1[2];
    const char* cA = PG8_ABASE(cur); const char* cB = PG8_BBASE(cur);
    PG8_STAGE(PG8_SB(0, 0), cB, voffB); PG8_STAGE(PG8_SB(0, 1), cB + hstep, voffB); PG8_STAGE(PG8_SA(0, 0), cA, curA[0]); PG8_STAGE(PG8_SA(0, 1), cA, curA[1]);
    if (wr == 1) PG8_BAR;
    PG8_WAIT_V(2); PG8_BAR;
    PG8_STAGE(PG8_SB(1, 0), cB + kstep, voffB); PG8_STAGE(PG8_SA(1, 0), cA + kstep, curA[0]); PG8_STAGE(PG8_SB(1, 1), cB + hstep + kstep, voffB);
    PG8_WAIT_V(6); PG8_BAR;
    for (;;) {
        const char* nA = has_next ? PG8_ABASE(nxt) : cA; const char* nB = has_next ? PG8_BBASE(nxt) : cB;
#pragma unroll 1
        for (int t = 0; t < nt; t += 2) {
            const bool last = (t == nt - 2);
            const char* a1 = cA + (size_t)(t + 1) * kstep;
            const char* a2 = last ? nA : cA + (size_t)(t + 2) * kstep; const char* b2 = last ? nB : cB + (size_t)(t + 2) * kstep;
            const char* a3 = a2 + kstep; const char* b3 = b2 + kstep;
            unsigned o2[2][2];
#pragma unroll
            for (int h = 0; h < 2; ++h)
#pragma unroll
                for (int i = 0; i < 2; ++i) o2[h][i] = last ? nxtA[h][i] : curA[h][i];
            PG8_LDB(B0, 0, 0); PG8_LDB(B1, 0, 1); PG8_SCHED; PG8_LDA(At, 0, 0); PG8_STAGE(PG8_SA(1, 1), a1, curA[1]);
            PG8_WAIT_V(8); PG8_WAIT_L(0); PG8_BAR; PG8_MMA(0, 0, At, B0); PG8_MMA(0, 1, At, B1); PG8_BAR; PG8_SCHED;
            PG8_LDA(At, 0, 1); PG8_STAGE(PG8_SB(0, 0), b2, voffB); PG8_STAGE(PG8_SB(0, 1), b2 + hstep, voffB); PG8_STAGE(PG8_SA(0, 0), a2, o2[0]);
            PG8_WAIT_V(8); PG8_WAIT_L(0); PG8_BAR; PG8_MMA(1, 0, At, B0); PG8_MMA(1, 1, At, B1); PG8_BAR; PG8_SCHED;
            PG8_LDB(B0, 1, 0); PG8_LDB(B1, 1, 1); PG8_SCHED; PG8_LDA(At, 1, 0); PG8_STAGE(PG8_SA(0, 1), a2, o2[1]);
            PG8_WAIT_V(8); PG8_WAIT_L(0); PG8_BAR; PG8_MMA(0, 0, At, B0); PG8_MMA(0, 1, At, B1); PG8_BAR; PG8_SCHED;
            PG8_LDA(At, 1, 1); PG8_STAGE(PG8_SB(1, 0), b3, voffB); PG8_STAGE(PG8_SB(1, 1), b3 + hstep, voffB); PG8_STAGE(PG8_SA(1, 0), a3, o2[0]);
            PG8_WAIT_V(8); PG8_WAIT_L(0); PG8_BAR; PG8_MMA(1, 0, At, B0); PG8_MMA(1, 1, At, B1); PG8_BAR; PG8_SCHED;
        }
        if constexpr (FP8) asm volatile("s_nop 15\n\ts_nop 15" ::: "memory");
        if (wr == 0) PG8_BAR;
        const bool has_nn = has_next && S.next(ui + 2, nn);
        unsigned nnA[2][2];
        if (has_nn) PG8_AOFFS(nnA, nn);
        E(acc, cur, wr, wc, fr, fq);
        if (!has_next) break;
#pragma unroll
        for (int a = 0; a < 2; ++a)
#pragma unroll
            for (int b = 0; b < 2; ++b)
#pragma unroll
                for (int m = 0; m < 4; ++m)
#pragma unroll
                    for (int n = 0; n < 2; ++n) acc[a][b][m][n] = (f32x4){0.f, 0.f, 0.f, 0.f};
        cur = nxt; cA = nA; cB = nB; ++ui;
#pragma unroll
        for (int h = 0; h < 2; ++h)
#pragma unroll
            for (int i = 0; i < 2; ++i) { curA[h][i] = nxtA[h][i]; if (has_nn) nxtA[h][i] = nnA[h][i]; }
        nxt = nn; has_next = has_nn;
        if (wr == 1) PG8_BAR;
    }
    PG8_WAIT_V(0);
    PG8_BAR;
#undef PG8_SA
#undef PG8_SB
#undef PG8_STAGE
#undef PG8_LDA
#undef PG8_LDB
#undef PG8_MMA
#undef PG8_WAIT_V
#undef PG8_WAIT_L
#undef PG8_BAR
#undef PG8_SCHED
#undef PG8_AOFFS
#undef PG8_ABASE
#undef PG8_BBASE
}
}

struct Frame {
    LAS unsigned char* lds;
    int tid, lane, wave, vcu, G;
    const float* const* in;
    float* out;
    unsigned char* ws;
};
template <class Tp> __device__ __forceinline__ Tp* wsp(const Frame& F, size_t off) { return (Tp*)(F.ws + off); }

__device__ __forceinline__ int dest_row(int mode, int s) {
    if (mode == 0) return s;
    if (mode == 1) return (s & ~31) | (((s >> 2) & 1) << 4) | (((s >> 3) & 3) << 2) | (s & 3);
    const int half = s >> 10, j = s & 1023;
    return ((j >> 7) << 8) | (((j >> 6) & 1) << 7) | (((j >> 4) & 3) << 5) | (half << 4) | (j & 15);
}
__device__ __forceinline__ void transpose_item(const float* W, int K, int N, bf16* WT, int mode, int item, int lane) {
    const int nblk = N / 64, kb = item / nblk, nb = item % nblk, k0 = 64 * kb, n0 = 64 * nb;
    const float* src = W + (size_t)k0 * N + n0 + lane;
    float v[64];
#pragma unroll
    for (int i = 0; i < 64; ++i) v[i] = src[(size_t)i * N];
    bf16* dst = WT + (size_t)dest_row(mode, n0 + lane) * K + k0;
#pragma unroll
    for (int j = 0; j < 8; ++j) { u32x4 o; o.x = pk2(v[8 * j], v[8 * j + 1]); o.y = pk2(v[8 * j + 2], v[8 * j + 3]); o.z = pk2(v[8 * j + 4], v[8 * j + 5]); o.w = pk2(v[8 * j + 6], v[8 * j + 7]);
        *(u32x4*)(dst + 8 * j) = o; }
}
__device__ __forceinline__ void transpose_item8(const float* W, int K, int N, unsigned char* WT, int mode, int item, int lane) {
    const int nblk = N / 64, kb = item / nblk, nb = item % nblk, k0 = 64 * kb, n0 = 64 * nb;
    const float* src = W + (size_t)k0 * N + n0 + lane;
    float v[64];
#pragma unroll
    for (int i = 0; i < 64; ++i) v[i] = __builtin_nontemporal_load(src + (size_t)i * N) * 32.f;
    unsigned char* dst = WT + (size_t)dest_row(mode, n0 + lane) * K + k0;
#pragma unroll
    for (int j = 0; j < 4; ++j) { u32x4 o; o.x = pg8::pk4_fp8(v[16 * j], v[16 * j + 1], v[16 * j + 2], v[16 * j + 3]); o.y = pg8::pk4_fp8(v[16 * j + 4], v[16 * j + 5], v[16 * j + 6], v[16 * j + 7]);
        o.z = pg8::pk4_fp8(v[16 * j + 8], v[16 * j + 9], v[16 * j + 10], v[16 * j + 11]); o.w = pg8::pk4_fp8(v[16 * j + 12], v[16 * j + 13], v[16 * j + 14], v[16 * j + 15]);
        *(u32x4*)(dst + 16 * j) = o; }
}
constexpr int MOE_I1 = 16 * 32, MOE_I2 = 16 * 16, MOE_ITEMS = NE * (MOE_I1 + MOE_I2);
__device__ __forceinline__ void moe_weight_item(const Frame& F, int it) {
#if !MK_FP8
    if (it < NE * MOE_I1) { const int e = it / MOE_I1; transpose_item(F.in[24] + (size_t)e * 1024 * 2048, 1024, 2048, wsp<bf16>(F, WS_W1) + (size_t)e * 2048 * 1024, 2, it % MOE_I1, F.lane); }
    else { const int r = it - NE * MOE_I1, e = r / MOE_I2; transpose_item(F.in[26] + (size_t)e * 1024 * 1024, 1024, 1024, wsp<bf16>(F, WS_W2) + (size_t)e * 1024 * 1024, 1, r % MOE_I2, F.lane); }
#else
    if (it < NE * MOE_I1) { const int e = it / MOE_I1; transpose_item8(F.in[24] + (size_t)e * 1024 * 2048, 1024, 2048, wsp<unsigned char>(F, WS_W1) + (size_t)e * 2048 * 1024, 2, it % MOE_I1, F.lane); }
    else { const int r = it - NE * MOE_I1, e = r / MOE_I2; transpose_item8(F.in[26] + (size_t)e * 1024 * 1024, 1024, 1024, wsp<unsigned char>(F, WS_W2) + (size_t)e * 1024 * 1024, 1, r % MOE_I2, F.lane); }
#endif
}

__device__ __forceinline__ void phase0(const Frame& F) {
    if (F.vcu < 192) {
        LAS float* sl = (LAS float*)F.lds;
        LAS float* red = (LAS float*)(F.lds + 32768);
        const float* c = F.in[1];
        for (int idx = F.tid; idx < 8192; idx += 512) { const int b = idx & 7, k = idx >> 3; const float cv = c[b * 1024 + k]; sl[idx] = cv / (1.f + __expf(-cv)); }
        __syncthreads();
        const int cl = F.tid & 31, ks = F.tid >> 5, col = F.vcu * 32 + cl;
        const float* wa = F.in[2];
        float acc[8];
#pragma unroll
        for (int b = 0; b < 8; ++b) acc[b] = 0.f;
#pragma unroll 4
        for (int kk = 0; kk < 64; ++kk) { const int k = ks * 64 + kk; const float w = wa[(size_t)k * 6144 + col];
            const f32x4 s0 = *(const LAS f32x4*)(sl + k * 8), s1 = *(const LAS f32x4*)(sl + k * 8 + 4);
            acc[0] += s0[0] * w; acc[1] += s0[1] * w; acc[2] += s0[2] * w; acc[3] += s0[3] * w;
            acc[4] += s1[0] * w; acc[5] += s1[1] * w; acc[6] += s1[2] * w; acc[7] += s1[3] * w; }
#pragma unroll
        for (int b = 0; b < 8; ++b) red[(ks * 32 + cl) * 8 + b] = acc[b];
        __syncthreads();
        if (F.tid < 256) { const int b = F.tid >> 5; float s = F.in[3][col];
            for (int q = 0; q < 16; ++q) s += red[(q * 32 + cl) * 8 + b];
            wsp<float>(F, WS_MOD)[b * 6144 + col] = s; }
    }
    const int gw = F.vcu * 8 + F.wave, NGW = F.G * 8;
    constexpr int I_IN = 16 * 40, I_OUT = 16 * 16;
    constexpr int NITEMS = I_IN + I_OUT;
    for (int it = gw; it < NITEMS; it += NGW) {
        int r = it;
        if (r < I_IN) { transpose_item(F.in[5], 1024, 2560, wsp<bf16>(F, WS_WIN), 1, r, F.lane); continue; } r -= I_IN;
        transpose_item(F.in[20], 1024, 1024, wsp<bf16>(F, WS_WOUT), 1, r, F.lane);
    }
#if MK_CONV_WHERE == 0
    for (int it = gw; it < MOE_ITEMS; it += NGW) moe_weight_item(F, it);
#endif
    { bf16* LW = wsp<bf16>(F, WS_LW);
        for (int idx = F.vcu * 512 + F.tid; idx < 256 * 512; idx += F.G * 512) { const int k = idx >> 9, c = idx & 511;
            const float v = k < 64 ? F.in[8][k * 512 + c] : (k < 128 ? F.in[10][(k - 64) * 512 + c] : F.in[11][(k - 128) * 512 + c]);
            LW[c * 256 + k] = (bf16)f2bf(v); } }
}
template <bool OUT8 = false, bool IN16 = false>
__device__ __forceinline__ void norm_row(const Frame& F, const float* xrow, const float* g, const float* shift, const float* scale, bf16* orow, f32x4 (&h)[4]) {
    const f32x4* xr = (const f32x4*)xrow + F.lane; const u32x2* xr16 = (const u32x2*)xrow + F.lane;
    float ss = 0.f;
#pragma unroll
    for (int j = 0; j < 4; ++j) { if constexpr (IN16) { const u32x2 q = __builtin_nontemporal_load(xr16 + 64 * j); h[j] = (f32x4){bflo(q.x), bfhi(q.x), bflo(q.y), bfhi(q.y)}; } else h[j] = __builtin_nontemporal_load(xr + 64 * j); ss += (h[j][0] * h[j][0] + h[j][1] * h[j][1]) + (h[j][2] * h[j][2] + h[j][3] * h[j][3]); }
    const float rstd = rsqrtf(wave_sum(ss) * (1.f / D) + NORM_EPS);
    u32x2* o8 = (u32x2*)orow + F.lane;
#pragma unroll
    for (int j = 0; j < 4; ++j) { const int col = 4 * F.lane + 256 * j;
        const f32x4 gv = *(const f32x4*)(g + col), sh = *(const f32x4*)(shift + col), sc = *(const f32x4*)(scale + col);
        h[j] = h[j] * rstd * gv * (sc + 1.f) + sh;
        if constexpr (OUT8) ((unsigned*)orow)[F.lane + 64 * j] = pg8::pk4_fp8(h[j][0], h[j][1], h[j][2], h[j][3]);
        else { u32x2 w; w.x = pk2(h[j][0], h[j][1]); w.y = pk2(h[j][2], h[j][3]); o8[64 * j] = w; } }
}
__device__ __forceinline__ void phase1(const Frame& F) {
    const int gw = F.vcu * 8 + F.wave, NGW = F.G * 8;
    const float* mod = wsp<float>(F, WS_MOD);
    for (int row = gw; row < M; row += NGW) { const int b = row / T; f32x4 h[4];
        norm_row(F, F.in[0] + (size_t)row * D, F.in[4], mod + b * 6144, mod + b * 6144 + 1024, wsp<bf16>(F, WS_H) + (size_t)row * D, h); }
}

template <int CTRL> __device__ __forceinline__ float dpp_mov(float v) { return __builtin_bit_cast(float, __builtin_amdgcn_update_dpp(0, __builtin_bit_cast(int, v), CTRL, 0xf, 0xf, false)); }
__device__ __forceinline__ float reduce16(float v) { v += dpp_mov<0xB1>(v); v += dpp_mov<0x4E>(v); v += dpp_mov<0x141>(v); v += dpp_mov<0x140>(v); return v; }
__device__ __forceinline__ void lerp8(const bf16* P, const float* mu, int tok, int t, int col, float (&x)[8]) {
    const u32x4 c = *(const u32x4*)(P + (size_t)tok * IN_COLS + col);
    u32x4 p = (u32x4){0u, 0u, 0u, 0u};
    if (t > 0) p = *(const u32x4*)(P + (size_t)(tok - 1) * IN_COLS + col);
    const f32x4 m0 = *(const f32x4*)(mu + col), m1 = *(const f32x4*)(mu + col + 4);
    const float cf[8] = {bflo(c.x), bfhi(c.x), bflo(c.y), bfhi(c.y), bflo(c.z), bfhi(c.z), bflo(c.w), bfhi(c.w)};
    const float pf[8] = {bflo(p.x), bfhi(p.x), bflo(p.y), bfhi(p.y), bflo(p.z), bfhi(p.z), bflo(p.w), bfhi(p.w)};
    const float mf[8] = {m0[0], m0[1], m0[2], m0[3], m1[0], m1[1], m1[2], m1[3]};
#pragma unroll
    for (int j = 0; j < 8; ++j) x[j] = cf[j] + (pf[j] - cf[j]) * mf[j];
}
__device__ __forceinline__ f32x4 lerp4(const bf16* P, const float* mu, int tok, int t, int col) {
    const u32x2 c = *(const u32x2*)(P + (size_t)tok * IN_COLS + col);
    u32x2 p = (u32x2){0u, 0u};
    if (t > 0) p = *(const u32x2*)(P + (size_t)(tok - 1) * IN_COLS + col);
    const f32x4 m = *(const f32x4*)(mu + col);
    const f32x4 cf = (f32x4){bflo(c.x), bfhi(c.x), bflo(c.y), bfhi(c.y)}, pf = (f32x4){bflo(p.x), bfhi(p.x), bflo(p.y), bfhi(p.y)};
    return cf + (pf - cf) * m;
}
__device__ __forceinline__ bf16x8 pack8(const float (&x)[8]) { u32x4 w; w.x = pk2(x[0], x[1]); w.y = pk2(x[2], x[3]); w.z = pk2(x[4], x[5]); w.w = pk2(x[6], x[7]); return __builtin_bit_cast(bf16x8, w); }
__device__ __forceinline__ void phase3(const Frame& F) {
    const bf16* P = wsp<bf16>(F, WS_P); const bf16* LW = wsp<bf16>(F, WS_LW);
    const float* mu = F.in[6]; const float* w0 = F.in[7]; const float* a0 = F.in[9];
    const float* k_k = F.in[12]; const float* k_a = F.in[13]; const float* r_k = F.in[14];
    float* SCN = wsp<float>(F, WS_SCN); float* SV = wsp<float>(F, WS_SV); bf16* G = wsp<bf16>(F, WS_G); float* BON = wsp<float>(F, WS_BONUS);
    const int gw = F.vcu * 8 + F.wave, NGW = F.G * 8;
    const int cl = F.lane & 15, q = F.lane >> 4;
    for (int tile = gw; tile < M / 16; tile += NGW) {
        bf16x8 Aw[2], Aa[2], Ag[4];
        { const int tok = tile * 16 + cl, t = tok % T; float x[8];
#pragma unroll
            for (int s = 0; s < 2; ++s) { lerp8(P, mu, tok, t, 1536 + 32 * s + 8 * q, x);
#pragma unroll
                for (int j = 0; j < 8; ++j) x[j] = tanhf(x[j]);
                Aw[s] = pack8(x);
                lerp8(P, mu, tok, t, 1600 + 32 * s + 8 * q, x); Aa[s] = pack8(x); }
#pragma unroll
            for (int s = 0; s < 4; ++s) { lerp8(P, mu, tok, t, 1664 + 32 * s + 8 * q, x);
#pragma unroll
                for (int j = 0; j < 8; ++j) x[j] = sigmoidf_(x[j]);
                Ag[s] = pack8(x); } }
        const int tk0 = tile * 16 + 4 * q, b = tk0 / T, t0 = tk0 % T;
#pragma unroll 1
        for (int hh = 0; hh < RH; ++hh) {
            const int c0 = hh * 64 + cl * 4;
            f32x4 accw[4], acca[4], accg[4];
#pragma unroll
            for (int ct = 0; ct < 4; ++ct) { const bf16* lw = LW + (size_t)(c0 + ct) * 256 + 8 * q;
                f32x4 aw = (f32x4){0.f, 0.f, 0.f, 0.f}, aa = aw, ag = aw;
#pragma unroll
                for (int s = 0; s < 2; ++s) { aw = __builtin_amdgcn_mfma_f32_16x16x32_bf16(Aw[s], *(const bf16x8*)(lw + 32 * s), aw, 0, 0, 0);
                    aa = __builtin_amdgcn_mfma_f32_16x16x32_bf16(Aa[s], *(const bf16x8*)(lw + 64 + 32 * s), aa, 0, 0, 0); }
#pragma unroll
                for (int s = 0; s < 4; ++s) ag = __builtin_amdgcn_mfma_f32_16x16x32_bf16(Ag[s], *(const bf16x8*)(lw + 128 + 32 * s), ag, 0, 0, 0);
                accw[ct] = aw; acca[ct] = aa; accg[ct] = ag; }
            const f32x4 w0v = *(const f32x4*)(w0 + c0), a0v = *(const f32x4*)(a0 + c0), kkv = *(const f32x4*)(k_k + c0), kav = *(const f32x4*)(k_a + c0), rkv = *(const f32x4*)(r_k + c0);
#pragma unroll
            for (int i = 0; i < 4; ++i) { const int tk = tk0 + i, t = t0 + i;
                const f32x4 r4 = lerp4(P, mu, tk, t, c0), kr4 = lerp4(P, mu, tk, t, 512 + c0), v4 = lerp4(P, mu, tk, t, 1024 + c0);
                f32x4 dec, av, gv, kk4, k4;
                float ssq = 0.f, bon = 0.f;
#pragma unroll
                for (int ct = 0; ct < 4; ++ct) {
                    dec[ct] = __expf(-0.60653066f * sigmoidf_(w0v[ct] + accw[ct][i]));
                    av[ct] = sigmoidf_(a0v[ct] + acca[ct][i]);
                    gv[ct] = accg[ct][i];
                    kk4[ct] = kr4[ct] * kkv[ct]; ssq += kk4[ct] * kk4[ct];
                    k4[ct] = kr4[ct] * (1.f + (av[ct] - 1.f) * kav[ct]);
                    bon += r4[ct] * k4[ct] * rkv[ct]; }
                ssq = reduce16(ssq); bon = reduce16(bon);
                const float inv = __builtin_amdgcn_rcpf(fmaxf(sqrtf(ssq), 1e-12f));
                const f32x4 kkn = kk4 * inv, bb = kkn * av;
                const size_t so = ((size_t)(b * RH + hh) * T + t) * 64 + cl * 4;
                float* sc = SCN + ((size_t)(b * RH + hh) * T + t) * 320 + cl * 4;
                *(f32x4*)(sc) = dec; *(f32x4*)(sc + 64) = kkn; *(f32x4*)(sc + 128) = bb; *(f32x4*)(sc + 192) = k4; *(f32x4*)(sc + 256) = r4;
                *(f32x4*)(SV + so) = v4;
                u32x2 gw2; gw2.x = pk2(gv[0], gv[1]); gw2.y = pk2(gv[2], gv[3]);
                *(u32x2*)(G + (size_t)tk * 512 + c0) = gw2;
                if (cl == 0) BON[tk * 8 + hh] = bon; }
        }
    }
}

constexpr int CK = 32, NCHK = T / CK;
#define SC_SPIN_CAP (1 << 24)
#define MFMA32(a, b, c) __builtin_amdgcn_mfma_f32_32x32x16_bf16((a), (b), (c), 0, 0, 0)
__device__ __forceinline__ int crow(int i, int h) { return (i & 3) + 8 * (i >> 2) + 4 * h; }
template <int S_> __device__ __forceinline__ bf16x8 pack_acc(const f32x16& x) { u32x4 w; w.x = pk2(x[8 * S_], x[8 * S_ + 1]); w.y = pk2(x[8 * S_ + 2], x[8 * S_ + 3]); w.z = pk2(x[8 * S_ + 4], x[8 * S_ + 5]); w.w = pk2(x[8 * S_ + 6], x[8 * S_ + 7]); return __builtin_bit_cast(bf16x8, w); }
__device__ __forceinline__ bf16x8 rd_nat(const LAS bf16* img, int stride, int row, int k0) { return *(const LAS bf16x8*)(img + row * stride + k0); }
__device__ __forceinline__ bf16x8 rd_perm(const LAS bf16* img, int stride, int row, int kb, int h) {
    const u32x2 lo = *(const LAS u32x2*)(img + row * stride + kb + 4 * h), hi = *(const LAS u32x2*)(img + row * stride + kb + 8 + 4 * h);
    u32x4 w; w.x = lo.x; w.y = lo.y; w.z = hi.x; w.w = hi.y; return __builtin_bit_cast(bf16x8, w);
}
__device__ __forceinline__ f32x16 zero16() { f32x16 z; for (int i = 0; i < 16; ++i) z[i] = 0.f; return z; }
constexpr int CL_A = 0, CL_B = 4608, CL_K = 9216, CL_R = 13824, CL_AT = 18432, CL_BHT = 23552, CL_KHT = 28672, CL_VT = 33792, CL_GTOT = 38912, CL_GC = 39936,
              CL_L = 40192, CL_T = 44800, CL_FNRB = 47360, CL_CNRK = 49408, CL_FQM = 53504, CL_GROUP = 57600;
constexpr int RMS = 72, TRS = 40, LST = 36;
__device__ __forceinline__ void phase4a_summaries(const Frame& F) {
    const float* SCN = wsp<float>(F, WS_SCN); const float* SV = wsp<float>(F, WS_SV);
    bf16x8* PT = wsp<bf16x8>(F, WS_PT); f32x4* ZV = wsp<f32x4>(F, WS_ZV); bf16x8* RYT = wsp<bf16x8>(F, WS_RYT); f32x4* YVT = wsp<f32x4>(F, WS_YVT);
    const int grp = F.tid >> 8, gt = F.tid & 255, w4 = F.wave & 3, lane = F.lane, r = lane & 31, h = lane >> 5;
    LAS unsigned char* gl = F.lds + grp * CL_GROUP;
    LAS bf16* iA = (LAS bf16*)(gl + CL_A); LAS bf16* iB = (LAS bf16*)(gl + CL_B); LAS bf16* iK = (LAS bf16*)(gl + CL_K); LAS bf16* iR = (LAS bf16*)(gl + CL_R);
    LAS bf16* iAT = (LAS bf16*)(gl + CL_AT); LAS bf16* iBHT = (LAS bf16*)(gl + CL_BHT); LAS bf16* iKHT = (LAS bf16*)(gl + CL_KHT); LAS bf16* iVT = (LAS bf16*)(gl + CL_VT);
    LAS float* gtot = (LAS float*)(gl + CL_GTOT); LAS float* gcv = (LAS float*)(gl + CL_GC); LAS float* Lm = (LAS float*)(gl + CL_L); LAS bf16* Tm = (LAS bf16*)(gl + CL_T);
    LAS bf16x8* fnrb = (LAS bf16x8*)(gl + CL_FNRB); LAS float* cnrk = (LAS float*)(gl + CL_CNRK); LAS bf16x8* fqm = (LAS bf16x8*)(gl + CL_FQM);
    constexpr int NCHUNKS = NBATCH * RH * NCHK;
    for (int it = F.vcu; it < NCHUNKS / 2; it += F.G) {
        const int chunk = it * 2 + grp, bh = chunk / NCHK, c = chunk % NCHK, t0 = c * CK;
        __syncthreads();
        { const int k = gt & 63, tq = gt >> 6;
            float wv[8], kkv[8], bv[8], kv[8], rv[8], vv[8], lp[8];
#pragma unroll
            for (int i = 0; i < 8; ++i) { const size_t row = (size_t)bh * T + t0 + 8 * tq + i; const float* sc = SCN + row * 320 + k;
                wv[i] = sc[0]; kkv[i] = sc[64]; bv[i] = sc[128]; kv[i] = sc[192]; rv[i] = sc[256]; vv[i] = SV[row * 64 + k]; }
            lp[0] = wv[0];
#pragma unroll
            for (int i = 1; i < 8; ++i) lp[i] = lp[i - 1] * wv[i];
            gtot[tq * 64 + k] = lp[7];
            __syncthreads();
            const float g0 = gtot[k], g1 = gtot[64 + k], g2 = gtot[128 + k], g3 = gtot[192 + k];
            const float pre = tq == 0 ? 1.f : (tq == 1 ? g0 : (tq == 2 ? g0 * g1 : g0 * g1 * g2)), gC = (g0 * g1) * (g2 * g3);
            float at[8], bh8[8], kh8[8];
#pragma unroll
            for (int i = 0; i < 8; ++i) { const float g = pre * lp[i], gp = i == 0 ? pre : pre * lp[i - 1], ig = __builtin_amdgcn_rcpf(g);
                const float bt = bv[i] * ig, kt = kv[i] * ig; at[i] = -kkv[i] * gp; bh8[i] = bt * gC; kh8[i] = kt * gC;
                const int ro = (8 * tq + i) * RMS + k;
                iA[ro] = (bf16)f2bf(at[i]); iB[ro] = (bf16)f2bf(bt); iK[ro] = (bf16)f2bf(kt); iR[ro] = (bf16)f2bf(rv[i] * g); }
            *(LAS bf16x8*)(iAT + k * TRS + 8 * tq) = pack8(at); *(LAS bf16x8*)(iBHT + k * TRS + 8 * tq) = pack8(bh8); *(LAS bf16x8*)(iKHT + k * TRS + 8 * tq) = pack8(kh8);
            *(LAS bf16x8*)(iVT + k * TRS + 8 * tq) = pack8(vv);
            if (tq == 0) gcv[k] = gC; }
        __syncthreads();
        f32x16 lak = zero16();
        { const LAS bf16* ia = (w4 < 2) ? iA : (w4 == 2 ? iB : iK); const LAS bf16* ib = (w4 == 0) ? iB : (w4 == 1 ? iK : iR);
            f32x16 acc = zero16();
#pragma unroll
            for (int ks = 0; ks < 4; ++ks) acc = MFMA32(rd_nat(ia, RMS, r, 16 * ks + 8 * h), rd_nat(ib, RMS, r, 16 * ks + 8 * h), acc);
#pragma unroll
            for (int i = 0; i < 16; ++i) { const int row = crow(i, h); const bool keep = (w4 < 2) ? (r < row) : (row <= r); acc[i] = keep ? acc[i] : 0.f; }
            if (w4 == 0) {
#pragma unroll
                for (int i = 0; i < 16; ++i) Lm[crow(i, h) * LST + r] = acc[i]; }
            else if (w4 == 1) lak = acc;
            else if (w4 == 2) { fnrb[lane] = pack_acc<0>(acc); fnrb[64 + lane] = pack_acc<1>(acc); }
            else {
#pragma unroll
                for (int i = 0; i < 16; ++i) cnrk[i * 64 + lane] = acc[i]; } }
        __syncthreads();
        if (w4 == 0) { float Tr[32];
#pragma unroll
            for (int t = 0; t < 32; ++t) { float acc = (t == r) ? 1.f : 0.f;
#pragma unroll
                for (int s4 = 0; s4 < (t + 3) / 4; ++s4) { const f32x4 l4 = *(const LAS f32x4*)(Lm + t * LST + 4 * s4);
#pragma unroll
                    for (int q = 0; q < 4; ++q) if (4 * s4 + q < t) acc += l4[q] * Tr[4 * s4 + q]; }
                Tr[t] = acc; }
            if (lane < 32) {
#pragma unroll
                for (int t = 0; t < 32; ++t) Tm[t * TRS + r] = (bf16)f2bf(Tr[t]); } }
        __syncthreads();
        if (w4 == 0 || w4 == 2) { const int a = w4 >> 1;
            f32x16 x1 = zero16();
#pragma unroll
            for (int ks = 0; ks < 2; ++ks) x1 = MFMA32(rd_nat(Tm, TRS, r, 16 * ks + 8 * h), rd_nat(iAT, TRS, 32 * a + r, 16 * ks + 8 * h), x1);
            const bf16x8 xf0 = pack_acc<0>(x1), xf1 = pack_acc<1>(x1);
#pragma unroll
            for (int b = 0; b < 2; ++b) { f32x16 p = zero16();
                p = MFMA32(xf0, rd_perm(iBHT, TRS, 32 * b + r, 0, h), p); p = MFMA32(xf1, rd_perm(iBHT, TRS, 32 * b + r, 16, h), p);
                if (a == b) { const float gc = gcv[32 * a + r];
#pragma unroll
                    for (int i = 0; i < 16; ++i) p[i] += (crow(i, h) == r) ? gc : 0.f; }
                bf16x8* dst = PT + ((size_t)(chunk * 2 + a) * 2 + b) * 2 * 64 + lane; dst[0] = pack_acc<0>(p); dst[64] = pack_acc<1>(p); }
            f32x16 ry;
#pragma unroll
            for (int g = 0; g < 4; ++g) { const u32x2 rr = *(const LAS u32x2*)(iR + r * RMS + 32 * a + 8 * g + 4 * h);
                ry[4 * g] = bflo(rr.x); ry[4 * g + 1] = bfhi(rr.x); ry[4 * g + 2] = bflo(rr.y); ry[4 * g + 3] = bfhi(rr.y); }
            ry = MFMA32(xf0, fnrb[lane], ry); ry = MFMA32(xf1, fnrb[64 + lane], ry);
            bf16x8* dr = RYT + (size_t)(chunk * 2 + a) * 2 * 64 + lane; dr[0] = pack_acc<0>(ry); dr[64] = pack_acc<1>(ry);
        } else if (w4 == 1) {
            f32x16 x2 = zero16();
            x2 = MFMA32(rd_perm(Tm, TRS, r, 0, h), pack_acc<0>(lak), x2); x2 = MFMA32(rd_perm(Tm, TRS, r, 16, h), pack_acc<1>(lak), x2);
            const bf16x8 xf0 = pack_acc<0>(x2), xf1 = pack_acc<1>(x2);
#pragma unroll
            for (int b = 0; b < 2; ++b) { f32x16 qm;
#pragma unroll
                for (int g = 0; g < 4; ++g) { const u32x2 kk2 = *(const LAS u32x2*)(iKHT + (32 * b + r) * TRS + 8 * g + 4 * h);
                    qm[4 * g] = bflo(kk2.x); qm[4 * g + 1] = bfhi(kk2.x); qm[4 * g + 2] = bflo(kk2.y); qm[4 * g + 3] = bfhi(kk2.y); }
                qm = MFMA32(xf0, rd_perm(iBHT, TRS, 32 * b + r, 0, h), qm); qm = MFMA32(xf1, rd_perm(iBHT, TRS, 32 * b + r, 16, h), qm);
                fqm[(b * 2 + 0) * 64 + lane] = pack_acc<0>(qm); fqm[(b * 2 + 1) * 64 + lane] = pack_acc<1>(qm); }
            f32x16 gy;
#pragma unroll
            for (int i = 0; i < 16; ++i) gy[i] = cnrk[i * 64 + lane];
            gy = MFMA32(xf0, fnrb[lane], gy); gy = MFMA32(xf1, fnrb[64 + lane], gy);
            const bf16x8 gf0 = pack_acc<0>(gy), gf1 = pack_acc<1>(gy);
#pragma unroll
            for (int vh = 0; vh < 2; ++vh) { f32x16 yv = zero16();
                yv = MFMA32(rd_perm(iVT, TRS, 32 * vh + r, 0, h), gf0, yv); yv = MFMA32(rd_perm(iVT, TRS, 32 * vh + r, 16, h), gf1, yv);
                bf16x8* dy = (bf16x8*)YVT + ((size_t)(chunk * 2 + vh) * 64 + lane) * 2;
                dy[0] = pack_acc<0>(yv); dy[1] = pack_acc<1>(yv); }
        }
        __syncthreads();
        if (w4 == 3) {
#pragma unroll
            for (int b = 0; b < 2; ++b)
#pragma unroll
                for (int vh = 0; vh < 2; ++vh) { f32x16 zv = zero16();
                    zv = MFMA32(fqm[(b * 2 + 0) * 64 + lane], rd_perm(iVT, TRS, 32 * vh + r, 0, h), zv); zv = MFMA32(fqm[(b * 2 + 1) * 64 + lane], rd_perm(iVT, TRS, 32 * vh + r, 16, h), zv);
                    bf16x8* dz = (bf16x8*)ZV + (((size_t)(chunk * 2 + b) * 2 + vh) * 64 + lane) * 2;
                    dz[0] = pack_acc<0>(zv); dz[1] = pack_acc<1>(zv); }
        }
    }
}
constexpr int CL2_LA = 2 * CL_GROUP, LAS_STRIDE = 264;
static_assert(CL2_LA + 32 * LAS_STRIDE * 2 <= MISC_OFF, "fused summaries LDS map");
__device__ __forceinline__ void phase4a_fused(const Frame& F) {
    const bf16* P = wsp<bf16>(F, WS_P); const bf16* LW = wsp<bf16>(F, WS_LW);
    const float* mu = F.in[6]; const float* w0 = F.in[7]; const float* a0 = F.in[9]; const float* k_k = F.in[12]; const float* k_a = F.in[13]; const float* r_k = F.in[14];
    float* SV = wsp<float>(F, WS_SV); bf16* G = wsp<bf16>(F, WS_G); float* BON = wsp<float>(F, WS_BONUS);
    bf16x8* PT = wsp<bf16x8>(F, WS_PT); f32x4* ZV = wsp<f32x4>(F, WS_ZV); bf16x8* RYT = wsp<bf16x8>(F, WS_RYT); f32x4* YVT = wsp<f32x4>(F, WS_YVT);
    const int grp = F.tid >> 8, gt = F.tid & 255, w4 = F.wave & 3, lane = F.lane, r = lane & 31, h = lane >> 5;
    LAS unsigned char* gl = F.lds + grp * CL_GROUP;
    LAS bf16* iA = (LAS bf16*)(gl + CL_A); LAS bf16* iB = (LAS bf16*)(gl + CL_B); LAS bf16* iK = (LAS bf16*)(gl + CL_K); LAS bf16* iR = (LAS bf16*)(gl + CL_R);
    LAS bf16* iAT = (LAS bf16*)(gl + CL_AT); LAS bf16* iBHT = (LAS bf16*)(gl + CL_BHT); LAS bf16* iKHT = (LAS bf16*)(gl + CL_KHT); LAS bf16* iVT = (LAS bf16*)(gl + CL_VT);
    LAS float* gtot = (LAS float*)(gl + CL_GTOT); LAS float* gcv = (LAS float*)(gl + CL_GC); LAS float* Lm = (LAS float*)(gl + CL_L); LAS bf16* Tm = (LAS bf16*)(gl + CL_T);
    LAS bf16x8* fnrb = (LAS bf16x8*)(gl + CL_FNRB); LAS float* cnrk = (LAS float*)(gl + CL_CNRK); LAS bf16x8* fqm = (LAS bf16x8*)(gl + CL_FQM);
    LAS float* lwo_w = (LAS float*)(gl + CL_L); LAS float* lwo_a = lwo_w + 32 * 64;
    LAS bf16* LA = (LAS bf16*)(F.lds + CL2_LA);
    bf16 cr[9], ck[9], cv[9]; float cst[8]; bool tz;
#define S1_LOAD(tc_, hp_) do { const int _hh = 2 * (hp_) + grp, _cc = _hh * 64 + (gt & 63), _t0 = ((tc_) % NCHK) * CK + 8 * (gt >> 6); \
        const size_t _pr = ((size_t)((tc_) / NCHK) * T + _t0) * IN_COLS + _cc; tz = _t0 > 0; const size_t _pp = tz ? _pr - IN_COLS : _pr; \
        cr[0] = __builtin_nontemporal_load(P + _pp); ck[0] = __builtin_nontemporal_load(P + _pp + 512); cv[0] = __builtin_nontemporal_load(P + _pp + 1024); \
        _Pragma("unroll") for (int _i = 0; _i < 8; ++_i) { cr[_i + 1] = __builtin_nontemporal_load(P + _pr + (size_t)_i * IN_COLS); ck[_i + 1] = __builtin_nontemporal_load(P + _pr + (size_t)_i * IN_COLS + 512); cv[_i + 1] = __builtin_nontemporal_load(P + _pr + (size_t)_i * IN_COLS + 1024); } \
        cst[0] = mu[_cc]; cst[1] = mu[512 + _cc]; cst[2] = mu[1024 + _cc]; cst[3] = w0[_cc]; cst[4] = a0[_cc]; cst[5] = k_k[_cc]; cst[6] = k_a[_cc]; cst[7] = r_k[_cc]; } while (0)
    bf16x8 lwf[8];
#define LW_LOAD(hp_) do { const bf16* _lw = LW + (size_t)((2 * (hp_) + grp) * 64 + 32 * (w4 & 1) + r) * 256 + 8 * h + (w4 < 2 ? 0 : 128); \
        _Pragma("unroll") for (int _q = 0; _q < 8; ++_q) lwf[_q] = *(const bf16x8*)(_lw + 16 * _q); } while (0)
    S1_LOAD(F.vcu, 0);
    LW_LOAD(0);
    u32x4 sa_c[2], sa_p[2]; float sa_mu[2][8];
#pragma unroll
    for (int q8 = 0; q8 < 2; ++q8)
#pragma unroll
        for (int j = 0; j < 8; ++j) sa_mu[q8][j] = mu[1536 + (F.tid & 15) * 16 + 8 * q8 + j];
#define SA_LOAD(tc_) do { const int _tk = F.tid >> 4, _t = ((tc_) % NCHK) * CK + _tk; const size_t _row = (size_t)((tc_) / NCHK) * T + _t; \
        _Pragma("unroll") for (int _q = 0; _q < 2; ++_q) { const size_t _o = _row * IN_COLS + 1536 + (F.tid & 15) * 16 + 8 * _q; \
            sa_c[_q] = __builtin_nontemporal_load((const u32x4*)(P + _o)); sa_p[_q] = __builtin_nontemporal_load((const u32x4*)(P + (_t > 0 ? _o - IN_COLS : _o))); } } while (0)
    SA_LOAD(F.vcu);
    for (int tc = F.vcu; tc < M / CK; tc += F.G) {
        const int b = tc / NCHK, c = tc % NCHK, t0 = c * CK, row0 = b * T + t0;
        lds_barrier();
        { const int tk = F.tid >> 4, cb = (F.tid & 15) * 16; float x[8];
#pragma unroll
            for (int q8 = 0; q8 < 2; ++q8) { const int col = cb + 8 * q8;
                { const u32x4 c_ = sa_c[q8], p_ = (t0 + tk > 0) ? sa_p[q8] : (u32x4){0u, 0u, 0u, 0u};
                    const float cf[8] = {bflo(c_.x), bfhi(c_.x), bflo(c_.y), bfhi(c_.y), bflo(c_.z), bfhi(c_.z), bflo(c_.w), bfhi(c_.w)};
                    const float pf[8] = {bflo(p_.x), bfhi(p_.x), bflo(p_.y), bfhi(p_.y), bflo(p_.z), bfhi(p_.z), bflo(p_.w), bfhi(p_.w)};
#pragma unroll
                    for (int j = 0; j < 8; ++j) x[j] = cf[j] + (pf[j] - cf[j]) * sa_mu[q8][j]; }
                if (col < 64) {
#pragma unroll
                    for (int j = 0; j < 8; ++j) x[j] = 2.f * sigmoidf_(2.f * x[j]) - 1.f; }
                else if (col >= 128) {
#pragma unroll
                    for (int j = 0; j < 8; ++j) x[j] = sigmoidf_(x[j]); }
                *(LAS bf16x8*)(LA + tk * LAS_STRIDE + col) = pack8(x); }
            const int ntc = (tc + F.G < M / CK) ? tc + F.G : tc; SA_LOAD(ntc); }
#pragma unroll 1
        for (int hp = 0; hp < 4; ++hp) {
            const int hh = 2 * hp + grp, bh = b * RH + hh, chunk = bh * NCHK + c;
            lds_barrier();
            { const int ct = w4 & 1;
                if (w4 < 2) {
                    f32x16 aw = zero16(), aa = zero16();
#pragma unroll
                    for (int ks = 0; ks < 4; ++ks) { aw = MFMA32(rd_nat(LA, LAS_STRIDE, r, 16 * ks + 8 * h), lwf[ks], aw); aa = MFMA32(rd_nat(LA, LAS_STRIDE, r, 64 + 16 * ks + 8 * h), lwf[4 + ks], aa); }
#pragma unroll
                    for (int i = 0; i < 16; ++i) { lwo_w[crow(i, h) * 64 + 32 * ct + r] = aw[i]; lwo_a[crow(i, h) * 64 + 32 * ct + r] = aa[i]; }
                } else {
                    f32x16 ag = zero16();
#pragma unroll
                    for (int ks = 0; ks < 8; ++ks) ag = MFMA32(rd_nat(LA, LAS_STRIDE, r, 128 + 16 * ks + 8 * h), lwf[ks], ag);
#pragma unroll
                    for (int i = 0; i < 16; ++i) G[(size_t)(row0 + crow(i, h)) * 512 + hh * 64 + 32 * ct + r] = (bf16)f2bf(ag[i]); } }
            LW_LOAD((hp + 1) & 3);
            lds_barrier();
            auto st1 = [&]() { const int k = gt & 63, tq = gt >> 6, cc = hh * 64 + k;
                float wv[8], kkv[8], bv[8], kv[8], rv[8], vv[8], lp[8];
                { const float mur = cst[0], muk = cst[1], muv = cst[2], w0c = cst[3], a0c = cst[4], kkc = cst[5], kac = cst[6], rkc = cst[7];
                    const int tl0 = 8 * tq;
                    if (!tz) { cr[0] = 0; ck[0] = 0; cv[0] = 0; }
                    float lw_[8], la_[8];
#pragma unroll
                    for (int i = 0; i < 8; ++i) { lw_[i] = lwo_w[(tl0 + i) * 64 + k]; la_[i] = lwo_a[(tl0 + i) * 64 + k]; }
                    float kk[8], ssq[8], bo[8], av[8];
#pragma unroll
                    for (int i = 0; i < 8; ++i) { const float c_r = bf2f(cr[i + 1]), c_k = bf2f(ck[i + 1]), c_v = bf2f(cv[i + 1]);
                        rv[i] = c_r + (bf2f(cr[i]) - c_r) * mur; const float kr = c_k + (bf2f(ck[i]) - c_k) * muk; vv[i] = c_v + (bf2f(cv[i]) - c_v) * muv;
                        wv[i] = __expf(-0.60653066f * sigmoidf_(w0c + lw_[i])); av[i] = sigmoidf_(a0c + la_[i]);
                        kk[i] = kr * kkc; ssq[i] = kk[i] * kk[i]; kv[i] = kr * (1.f + (av[i] - 1.f) * kac); bo[i] = rv[i] * kv[i] * rkc; }
#pragma unroll
                    for (int i = 0; i < 8; ++i) { ssq[i] = reduce16(ssq[i]); bo[i] = reduce16(bo[i]); }
#pragma unroll
                    for (int i = 0; i < 8; ++i) { ssq[i] += __shfl_xor(ssq[i], 16); bo[i] += __shfl_xor(bo[i], 16); }
#pragma unroll
                    for (int i = 0; i < 8; ++i) { ssq[i] += __shfl_xor(ssq[i], 32); bo[i] += __shfl_xor(bo[i], 32); }
#pragma unroll
                    for (int i = 0; i < 8; ++i) { kkv[i] = kk[i] * __builtin_amdgcn_rcpf(fmaxf(sqrtf(ssq[i]), 1e-12f)); bv[i] = kkv[i] * av[i];
                        ((bf16*)SV)[((size_t)bh * T + t0 + tl0 + i) * 64 + k] = (bf16)f2bf(vv[i]);
                        if (k == 0) BON[(row0 + tl0 + i) * 8 + hh] = bo[i]; } }
                lp[0] = wv[0];
#pragma unroll
                for (int i = 1; i < 8; ++i) lp[i] = lp[i - 1] * wv[i];
                gtot[tq * 64 + k] = lp[7];
                lds_barrier();
                const float g0 = gtot[k], g1 = gtot[64 + k], g2 = gtot[128 + k], g3 = gtot[192 + k];
                const float pre = tq == 0 ? 1.f : (tq == 1 ? g0 : (tq == 2 ? g0 * g1 : g0 * g1 * g2)), gC = (g0 * g1) * (g2 * g3);
                float at[8], bh8[8], kh8[8];
#pragma unroll
                for (int i = 0; i < 8; ++i) { const float g = pre * lp[i], gp = i == 0 ? pre : pre * lp[i - 1], ig = __builtin_amdgcn_rcpf(g);
                    const float bt = bv[i] * ig, kt = kv[i] * ig; at[i] = -kkv[i] * gp; bh8[i] = bt * gC; kh8[i] = kt * gC;
                    const int ro = (8 * tq + i) * RMS + k;
                    iA[ro] = (bf16)f2bf(at[i]); iB[ro] = (bf16)f2bf(bt); iK[ro] = (bf16)f2bf(kt); iR[ro] = (bf16)f2bf(rv[i] * g); }
                *(LAS bf16x8*)(iAT + k * TRS + 8 * tq) = pack8(at); *(LAS bf16x8*)(iBHT + k * TRS + 8 * tq) = pack8(bh8); *(LAS bf16x8*)(iKHT + k * TRS + 8 * tq) = pack8(kh8);
                *(LAS bf16x8*)(iVT + k * TRS + 8 * tq) = pack8(vv);
                if (tq == 0) gcv[k] = gC; };
            st1();
#if MK_DUP & 2
            lds_barrier(); asm volatile("" ::: "memory"); st1();
#endif
            { const int ntc = (hp < 3) ? tc : (tc + F.G < M / CK ? tc + F.G : tc), nhp = (hp < 3) ? hp + 1 : 0; S1_LOAD(ntc, nhp); }
            lds_barrier();
            f32x16 lak = zero16();
            { const LAS bf16* ia = (w4 < 2) ? iA : (w4 == 2 ? iB : iK); const LAS bf16* ib = (w4 == 0) ? iB : (w4 == 1 ? iK : iR);
                f32x16 acc = zero16();
#pragma unroll
                for (int ks = 0; ks < 4; ++ks) acc = MFMA32(rd_nat(ia, RMS, r, 16 * ks + 8 * h), rd_nat(ib, RMS, r, 16 * ks + 8 * h), acc);
#pragma unroll
                for (int i = 0; i < 16; ++i) { const int row = crow(i, h); const bool keep = (w4 < 2) ? (r < row) : (row <= r); acc[i] = keep ? acc[i] : 0.f; }
                if (w4 <= 1) lak = acc;
                else if (w4 == 2) { fnrb[lane] = pack_acc<0>(acc); fnrb[64 + lane] = pack_acc<1>(acc); }
                else {
#pragma unroll
                    for (int i = 0; i < 16; ++i) cnrk[i * 64 + lane] = acc[i]; } }
            lds_barrier();
            auto st3 = [&]() { if (w4 == 0) {
                LAS bf16* imgL = (LAS bf16*)(gl + CL_L);
                f32x16 Lp = lak, Tq = lak;
#pragma unroll
                for (int i = 0; i < 16; ++i) Tq[i] += (crow(i, h) == r) ? 1.f : 0.f;
#pragma unroll
                for (int st = 0; st < 4; ++st) {
#pragma unroll
                    for (int i = 0; i < 16; ++i) { imgL[crow(i, h) * TRS + r] = (bf16)f2bf(Lp[i]); Tm[crow(i, h) * TRS + r] = (bf16)f2bf(Tq[i]); }
                    asm volatile("s_waitcnt lgkmcnt(0)" ::: "memory");
                    const bf16x8 b0 = pack_acc<0>(Lp), b1 = pack_acc<1>(Lp);
                    f32x16 l2 = zero16(); l2 = MFMA32(rd_perm(imgL, TRS, r, 0, h), b0, l2); l2 = MFMA32(rd_perm(imgL, TRS, r, 16, h), b1, l2);
                    Lp = l2;
                    f32x16 mm = l2;
#pragma unroll
                    for (int i = 0; i < 16; ++i) mm[i] += (crow(i, h) == r) ? 1.f : 0.f;
                    const bf16x8 m0 = pack_acc<0>(mm), m1 = pack_acc<1>(mm);
                    f32x16 t2 = zero16(); t2 = MFMA32(rd_perm(Tm, TRS, r, 0, h), m0, t2); t2 = MFMA32(rd_perm(Tm, TRS, r, 16, h), m1, t2);
                    Tq = t2;
                    asm volatile("s_waitcnt lgkmcnt(0)" ::: "memory"); }
#pragma unroll
                for (int i = 0; i < 16; ++i) Tm[crow(i, h) * TRS + r] = (bf16)f2bf(Tq[i]); } };
            st3();
#if MK_DUP & 4
            asm volatile("" ::: "memory"); st3();
#endif
            lds_barrier();
            auto st4 = [&]() { if (w4 == 0 || w4 == 2) { const int a = w4 >> 1;
                f32x16 x1 = zero16();
#pragma unroll
                for (int ks = 0; ks < 2; ++ks) x1 = MFMA32(rd_nat(Tm, TRS, r, 16 * ks + 8 * h), rd_nat(iAT, TRS, 32 * a + r, 16 * ks + 8 * h), x1);
                const bf16x8 xf0 = pack_acc<0>(x1), xf1 = pack_acc<1>(x1);
#pragma unroll
                for (int b = 0; b < 2; ++b) { f32x16 p = zero16();
                    p = MFMA32(xf0, rd_perm(iBHT, TRS, 32 * b + r, 0, h), p); p = MFMA32(xf1, rd_perm(iBHT, TRS, 32 * b + r, 16, h), p);
                    if (a == b) { const float gc = gcv[32 * a + r];
#pragma unroll
                        for (int i = 0; i < 16; ++i) p[i] += (crow(i, h) == r) ? gc : 0.f; }
                    bf16x8* dst = PT + ((size_t)(chunk * 2 + a) * 2 + b) * 2 * 64 + lane; dst[0] = pack_acc<0>(p); dst[64] = pack_acc<1>(p); }
                f32x16 ry;
#pragma unroll
                for (int g = 0; g < 4; ++g) { const u32x2 rr = *(const LAS u32x2*)(iR + r * RMS + 32 * a + 8 * g + 4 * h);
                    ry[4 * g] = bflo(rr.x); ry[4 * g + 1] = bfhi(rr.x); ry[4 * g + 2] = bflo(rr.y); ry[4 * g + 3] = bfhi(rr.y); }
                ry = MFMA32(xf0, fnrb[lane], ry); ry = MFMA32(xf1, fnrb[64 + lane], ry);
                bf16x8* dr = RYT + (size_t)(chunk * 2 + a) * 2 * 64 + lane; dr[0] = pack_acc<0>(ry); dr[64] = pack_acc<1>(ry);
            } else if (w4 == 1) {
                f32x16 x2 = zero16();
                x2 = MFMA32(rd_perm(Tm, TRS, r, 0, h), pack_acc<0>(lak), x2); x2 = MFMA32(rd_perm(Tm, TRS, r, 16, h), pack_acc<1>(lak), x2);
                const bf16x8 xf0 = pack_acc<0>(x2), xf1 = pack_acc<1>(x2);
#pragma unroll
                for (int b = 0; b < 2; ++b) { f32x16 qm;
#pragma unroll
                    for (int g = 0; g < 4; ++g) { const u32x2 kk2 = *(const LAS u32x2*)(iKHT + (32 * b + r) * TRS + 8 * g + 4 * h);
                        qm[4 * g] = bflo(kk2.x); qm[4 * g + 1] = bfhi(kk2.x); qm[4 * g + 2] = bflo(kk2.y); qm[4 * g + 3] = bfhi(kk2.y); }
                    qm = MFMA32(xf0, rd_perm(iBHT, TRS, 32 * b + r, 0, h), qm); qm = MFMA32(xf1, rd_perm(iBHT, TRS, 32 * b + r, 16, h), qm);
                    fqm[(b * 2 + 0) * 64 + lane] = pack_acc<0>(qm); fqm[(b * 2 + 1) * 64 + lane] = pack_acc<1>(qm); }
                f32x16 gy;
#pragma unroll
                for (int i = 0; i < 16; ++i) gy[i] = cnrk[i * 64 + lane];
                gy = MFMA32(xf0, fnrb[lane], gy); gy = MFMA32(xf1, fnrb[64 + lane], gy);
                const bf16x8 gf0 = pack_acc<0>(gy), gf1 = pack_acc<1>(gy);
#pragma unroll
                for (int vh = 0; vh < 2; ++vh) { f32x16 yv = zero16();
                    yv = MFMA32(rd_perm(iVT, TRS, 32 * vh + r, 0, h), gf0, yv); yv = MFMA32(rd_perm(iVT, TRS, 32 * vh + r, 16, h), gf1, yv);
                    bf16x8* dy = (bf16x8*)YVT + ((size_t)(chunk * 2 + vh) * 64 + lane) * 2;
                    dy[0] = pack_acc<0>(yv); dy[1] = pack_acc<1>(yv); }
            } };
            st4();
#if MK_DUP & 8
            asm volatile("" ::: "memory"); st4();
#endif
            lds_barrier();
            if (w4 == 3) {
#pragma unroll
                for (int b = 0; b < 2; ++b)
#pragma unroll
                    for (int vh = 0; vh < 2; ++vh) { f32x16 zv = zero16();
                        zv = MFMA32(fqm[(b * 2 + 0) * 64 + lane], rd_perm(iVT, TRS, 32 * vh + r, 0, h), zv); zv = MFMA32(fqm[(b * 2 + 1) * 64 + lane], rd_perm(iVT, TRS, 32 * vh + r, 16, h), zv);
                        bf16x8* dz = (bf16x8*)ZV + (((size_t)(chunk * 2 + b) * 2 + vh) * 64 + lane) * 2;
                        dz[0] = pack_acc<0>(zv); dz[1] = pack_acc<1>(zv); }
            }
        }
    }
#undef S1_LOAD
#undef LW_LOAD
#undef SA_LOAD
}
constexpr int WRS = 68, WTS = 36;
constexpr int WL_A = 0, WL_B = 4352, WL_K = 8704, WL_R = 13056, WL_AT = 17408, WL_BHT = 22016, WL_KHT = 26624, WL_VT = 31232, WL_SIZE = 35840, WL_LA = 4 * WL_SIZE;
static_assert(WL_LA + 32 * LAS_STRIDE * 2 <= MISC_OFF, "wave-per-chunk LDS map");
__device__ __forceinline__ bf16x8 rd_nat2(const LAS bf16* img, int stride, int row, int k0) {
    const u32x2 lo = *(const LAS u32x2*)(img + row * stride + k0), hi = *(const LAS u32x2*)(img + row * stride + k0 + 4);
    u32x4 w; w.x = lo.x; w.y = lo.y; w.z = hi.x; w.w = hi.y; return __builtin_bit_cast(bf16x8, w);
}
__device__ __forceinline__ void phase4a_wave(const Frame& F) {
    const bf16* P = wsp<bf16>(F, WS_P); const bf16* LW = wsp<bf16>(F, WS_LW);
    const float* mu = F.in[6]; const float* w0 = F.in[7]; const float* a0 = F.in[9]; const float* k_k = F.in[12]; const float* k_a = F.in[13]; const float* r_k = F.in[14];
    float* SV = wsp<float>(F, WS_SV); bf16* G = wsp<bf16>(F, WS_G); float* BON = wsp<float>(F, WS_BONUS);
    bf16x8* PT = wsp<bf16x8>(F, WS_PT); f32x4* ZV = wsp<f32x4>(F, WS_ZV); bf16x8* RYT = wsp<bf16x8>(F, WS_RYT); f32x4* YVT = wsp<f32x4>(F, WS_YVT);
    const int wv_ = F.wave & 3;
    LAS unsigned char* gl = F.lds + wv_ * WL_SIZE;
    LAS bf16* iA = (LAS bf16*)(gl + WL_A); LAS bf16* iB = (LAS bf16*)(gl + WL_B); LAS bf16* iK = (LAS bf16*)(gl + WL_K); LAS bf16* iR = (LAS bf16*)(gl + WL_R);
    LAS bf16* iAT = (LAS bf16*)(gl + WL_AT); LAS bf16* iBHT = (LAS bf16*)(gl + WL_BHT); LAS bf16* iKHT = (LAS bf16*)(gl + WL_KHT); LAS bf16* iVT = (LAS bf16*)(gl + WL_VT);
    LAS bf16* imgL = iA; LAS bf16* Tm = iB;
    LAS bf16* LA = (LAS bf16*)(F.lds + WL_LA);
    for (int tc = F.vcu; tc < M / CK; tc += F.G) {
        const int b = tc / NCHK, c = tc % NCHK, t0 = c * CK, row0 = b * T + t0;
        lds_barrier();
        { const int tk = F.tid >> 4, cb = (F.tid & 15) * 16; float x[8];
#pragma unroll
            for (int q8 = 0; q8 < 2; ++q8) { const int col = cb + 8 * q8; lerp8(P, mu, row0 + tk, t0 + tk, 1536 + col, x);
                if (col < 64) {
#pragma unroll
                    for (int j = 0; j < 8; ++j) x[j] = 2.f * sigmoidf_(2.f * x[j]) - 1.f; }
                else if (col >= 128) {
#pragma unroll
                    for (int j = 0; j < 8; ++j) x[j] = sigmoidf_(x[j]); }
                *(LAS bf16x8*)(LA + tk * LAS_STRIDE + col) = pack8(x); } }
        lds_barrier();
        if (F.wave < 4) {
#pragma unroll 1
        for (int rnd = 0; rnd < 2; ++rnd) {
            int lane = F.lane; asm volatile("" : "+v"(lane));
            const int r = lane & 31, h = lane >> 5;
            const int hh = wv_ + 4 * rnd, bh = b * RH + hh, chunk = bh * NCHK + c, cc = hh * 64 + lane;
            f32x16 aw[2], aa[2];
#pragma unroll
            for (int ct = 0; ct < 2; ++ct) { const bf16* lw = LW + (size_t)(hh * 64 + 32 * ct + r) * 256 + 8 * h;
                { bf16x8 bf_[8];
#pragma unroll
                    for (int ks = 0; ks < 8; ++ks) bf_[ks] = *(const bf16x8*)(lw + 128 + 16 * ks);
                    f32x16 g_ = zero16();
#pragma unroll
                    for (int ks = 0; ks < 8; ++ks) g_ = MFMA32(rd_nat(LA, LAS_STRIDE, r, 128 + 16 * ks + 8 * h), bf_[ks], g_);
#pragma unroll
                    for (int i = 0; i < 16; ++i) if (MK_WMASK & 1) G[(size_t)(row0 + crow(i, h)) * 512 + hh * 64 + 32 * ct + r] = (bf16)f2bf(g_[i]); }
                { bf16x8 bf_[8];
#pragma unroll
                    for (int ks = 0; ks < 8; ++ks) bf_[ks] = *(const bf16x8*)(lw + 16 * ks);
                    f32x16 w_ = zero16(), a_ = zero16();
#pragma unroll
                    for (int ks = 0; ks < 4; ++ks) { w_ = MFMA32(rd_nat(LA, LAS_STRIDE, r, 16 * ks + 8 * h), bf_[ks], w_); a_ = MFMA32(rd_nat(LA, LAS_STRIDE, r, 64 + 16 * ks + 8 * h), bf_[4 + ks], a_); }
                    aw[ct] = w_; aa[ct] = a_; } }
            f32x16 wo, wr_, ao, ar_;
#pragma unroll
            for (int i = 0; i < 16; ++i) { wo[i] = h ? aw[1][i] : aw[0][i]; ao[i] = h ? aa[1][i] : aa[0][i];
                wr_[i] = __shfl_xor(h ? aw[0][i] : aw[1][i], 32); ar_[i] = __shfl_xor(h ? aa[0][i] : aa[1][i], 32); }
            const float mur = mu[cc], muk = mu[512 + cc], muv = mu[1024 + cc], w0c = w0[cc], a0c = a0[cc], kkc = k_k[cc], kac = k_a[cc], rkc = r_k[cc];
            float gam[32];
#pragma unroll
            for (int t = 0; t < 32; ++t) { const int i = (t & 3) + 4 * (t >> 3); const float wl = (((t >> 2) & 1) == h) ? wo[i] : wr_[i];
                const float dec = __expf(-0.60653066f * sigmoidf_(w0c + wl)); gam[t] = t ? gam[t - 1] * dec : dec; }
            const float gC = gam[31];
            const size_t pbase = (size_t)row0 * IN_COLS + cc;
            bf16 pr_ = 0, pk_ = 0, pv_ = 0;
            if (t0 > 0) { pr_ = P[pbase - IN_COLS]; pk_ = P[pbase - IN_COLS + 512]; pv_ = P[pbase - IN_COLS + 1024]; }
#pragma unroll
            for (int tb = 0; tb < 4; ++tb) {
                asm volatile("" ::: "memory");
                bf16 cr[8], ck[8], cv[8];
#pragma unroll
                for (int i = 0; i < 8; ++i) { const size_t o = pbase + (size_t)(8 * tb + i) * IN_COLS; cr[i] = P[o]; ck[i] = P[o + 512]; cv[i] = P[o + 1024]; }
                float rv[8], vv[8], kk[8], ssq[8], bo[8], av[8], kv[8];
#pragma unroll
                for (int i = 0; i < 8; ++i) { const int t = 8 * tb + i, ii = (t & 3) + 4 * (t >> 3);
                    const float c_r = bf2f(cr[i]), c_k = bf2f(ck[i]), c_v = bf2f(cv[i]);
                    const float p_r = bf2f(i ? cr[i - 1] : pr_), p_k = bf2f(i ? ck[i - 1] : pk_), p_v = bf2f(i ? cv[i - 1] : pv_);
                    rv[i] = c_r + (p_r - c_r) * mur; const float kr = c_k + (p_k - c_k) * muk; vv[i] = c_v + (p_v - c_v) * muv;
                    const float al = (((t >> 2) & 1) == h) ? ao[ii] : ar_[ii];
                    av[i] = sigmoidf_(a0c + al);
                    kk[i] = kr * kkc; ssq[i] = kk[i] * kk[i]; kv[i] = kr * (1.f + (av[i] - 1.f) * kac); bo[i] = rv[i] * kv[i] * rkc; }
                pr_ = cr[7]; pk_ = ck[7]; pv_ = cv[7];
#pragma unroll
                for (int i = 0; i < 8; ++i) { ssq[i] = reduce16(ssq[i]); bo[i] = reduce16(bo[i]); }
#pragma unroll
                for (int i = 0; i < 8; ++i) { ssq[i] += __shfl_xor(ssq[i], 16); bo[i] += __shfl_xor(bo[i], 16); }
#pragma unroll
                for (int i = 0; i < 8; ++i) { ssq[i] += __shfl_xor(ssq[i], 32); bo[i] += __shfl_xor(bo[i], 32); }
                float at[8], bh8[8], kh8[8];
#pragma unroll
                for (int i = 0; i < 8; ++i) { const int t = 8 * tb + i;
                    const float kkn = kk[i] * __builtin_amdgcn_rcpf(fmaxf(sqrtf(ssq[i]), 1e-12f)), bb = kkn * av[i];
                    const float g = gam[t], gp = t ? gam[t - 1] : 1.f, ig = __builtin_amdgcn_rcpf(g);
                    const float bt = bb * ig, kt = kv[i] * ig; at[i] = -kkn * gp; bh8[i] = bt * gC; kh8[i] = kt * gC;
                    const int ro = t * WRS + lane;
                    iA[ro] = (bf16)f2bf(at[i]); iB[ro] = (bf16)f2bf(bt); iK[ro] = (bf16)f2bf(kt); iR[ro] = (bf16)f2bf(rv[i] * g);
                    if (MK_WMASK & 2) { ((bf16*)SV)[((size_t)bh * T + t0 + t) * 64 + lane] = (bf16)f2bf(vv[i]);
                    if (lane == 0) BON[(row0 + t) * 8 + hh] = bo[i]; } }
#pragma unroll
                for (int q = 0; q < 2; ++q) { u32x2 w;
                    w.x = pk2(at[4 * q], at[4 * q + 1]); w.y = pk2(at[4 * q + 2], at[4 * q + 3]); *(LAS u32x2*)(iAT + lane * WTS + 8 * tb + 4 * q) = w;
                    w.x = pk2(bh8[4 * q], bh8[4 * q + 1]); w.y = pk2(bh8[4 * q + 2], bh8[4 * q + 3]); *(LAS u32x2*)(iBHT + lane * WTS + 8 * tb + 4 * q) = w;
                    w.x = pk2(kh8[4 * q], kh8[4 * q + 1]); w.y = pk2(kh8[4 * q + 2], kh8[4 * q + 3]); *(LAS u32x2*)(iKHT + lane * WTS + 8 * tb + 4 * q) = w;
                    w.x = pk2(vv[4 * q], vv[4 * q + 1]); w.y = pk2(vv[4 * q + 2], vv[4 * q + 3]); *(LAS u32x2*)(iVT + lane * WTS + 8 * tb + 4 * q) = w; }
            }
            asm volatile("s_waitcnt lgkmcnt(0)" ::: "memory");
            f32x16 lab = zero16(), lak = zero16(), nrb = zero16(), nrk = zero16();
#pragma unroll
            for (int ks = 0; ks < 4; ++ks) { const bf16x8 fa = rd_nat2(iA, WRS, r, 16 * ks + 8 * h), fb = rd_nat2(iB, WRS, r, 16 * ks + 8 * h), fk = rd_nat2(iK, WRS, r, 16 * ks + 8 * h), fr_ = rd_nat2(iR, WRS, r, 16 * ks + 8 * h);
                lab = MFMA32(fa, fb, lab); lak = MFMA32(fa, fk, lak); nrb = MFMA32(fb, fr_, nrb); nrk = MFMA32(fk, fr_, nrk); }
#pragma unroll
            for (int i = 0; i < 16; ++i) { const int row = crow(i, h); lab[i] = (r < row) ? lab[i] : 0.f; lak[i] = (r < row) ? lak[i] : 0.f; nrb[i] = (row <= r) ? nrb[i] : 0.f; nrk[i] = (row <= r) ? nrk[i] : 0.f; }
            const bf16x8 fn0 = pack_acc<0>(nrb), fn1 = pack_acc<1>(nrb);
            asm volatile("s_waitcnt lgkmcnt(0)" ::: "memory");
            { f32x16 Lp = lab, Tq = lab;
#pragma unroll
                for (int i = 0; i < 16; ++i) Tq[i] += (crow(i, h) == r) ? 1.f : 0.f;
#pragma unroll
                for (int st = 0; st < 4; ++st) {
#pragma unroll
                    for (int i = 0; i < 16; ++i) { imgL[crow(i, h) * WTS + r] = (bf16)f2bf(Lp[i]); Tm[crow(i, h) * WTS + r] = (bf16)f2bf(Tq[i]); }
                    asm volatile("s_waitcnt lgkmcnt(0)" ::: "memory");
                    const bf16x8 b0 = pack_acc<0>(Lp), b1 = pack_acc<1>(Lp);
                    f32x16 l2 = zero16(); l2 = MFMA32(rd_perm(imgL, WTS, r, 0, h), b0, l2); l2 = MFMA32(rd_perm(imgL, WTS, r, 16, h), b1, l2);
                    Lp = l2;
                    f32x16 mm = l2;
#pragma unroll
                    for (int i = 0; i < 16; ++i) mm[i] += (crow(i, h) == r) ? 1.f : 0.f;
                    const bf16x8 m0 = pack_acc<0>(mm), m1 = pack_acc<1>(mm);
                    f32x16 t2 = zero16(); t2 = MFMA32(rd_perm(Tm, WTS, r, 0, h), m0, t2); t2 = MFMA32(rd_perm(Tm, WTS, r, 16, h), m1, t2);
                    Tq = t2;
                    asm volatile("s_waitcnt lgkmcnt(0)" ::: "memory"); }
#pragma unroll
                for (int i = 0; i < 16; ++i) Tm[crow(i, h) * WTS + r] = (bf16)f2bf(Tq[i]);
                asm volatile("s_waitcnt lgkmcnt(0)" ::: "memory"); }
            const float gcd2[2] = {__shfl(gC, r), __shfl(gC, 32 + r)};
#pragma unroll
            for (int a = 0; a < 2; ++a) { f32x16 x1 = zero16();
#pragma unroll
                for (int ks = 0; ks < 2; ++ks) x1 = MFMA32(rd_nat2(Tm, WTS, r, 16 * ks + 8 * h), rd_nat2(iAT, WTS, 32 * a + r, 16 * ks + 8 * h), x1);
                const bf16x8 xf0 = pack_acc<0>(x1), xf1 = pack_acc<1>(x1);
#pragma unroll
                for (int b2 = 0; b2 < 2; ++b2) { f32x16 p = zero16();
                    p = MFMA32(xf0, rd_perm(iBHT, WTS, 32 * b2 + r, 0, h), p); p = MFMA32(xf1, rd_perm(iBHT, WTS, 32 * b2 + r, 16, h), p);
                    if (a == b2) { const float gcd = gcd2[a];
#pragma unroll
                        for (int i = 0; i < 16; ++i) p[i] += (crow(i, h) == r) ? gcd : 0.f; }
                    bf16x8* dst = PT + ((size_t)(chunk * 2 + a) * 2 + b2) * 2 * 64 + lane; if (MK_WMASK & 4) { dst[0] = pack_acc<0>(p); dst[64] = pack_acc<1>(p); } }
                f32x16 ry;
#pragma unroll
                for (int g = 0; g < 4; ++g) { const u32x2 rr = *(const LAS u32x2*)(iR + r * WRS + 32 * a + 8 * g + 4 * h);
                    ry[4 * g] = bflo(rr.x); ry[4 * g + 1] = bfhi(rr.x); ry[4 * g + 2] = bflo(rr.y); ry[4 * g + 3] = bfhi(rr.y); }
                ry = MFMA32(xf0, fn0, ry); ry = MFMA32(xf1, fn1, ry);
                bf16x8* dr = RYT + (size_t)(chunk * 2 + a) * 2 * 64 + lane; if (MK_WMASK & 8) { dr[0] = pack_acc<0>(ry); dr[64] = pack_acc<1>(ry); } }
            { f32x16 x2 = zero16();
                x2 = MFMA32(rd_perm(Tm, WTS, r, 0, h), pack_acc<0>(lak), x2); x2 = MFMA32(rd_perm(Tm, WTS, r, 16, h), pack_acc<1>(lak), x2);
                const bf16x8 xf0 = pack_acc<0>(x2), xf1 = pack_acc<1>(x2);
                bf16x8 fq[2][2];
#pragma unroll
                for (int b2 = 0; b2 < 2; ++b2) { f32x16 qm;
#pragma unroll
                    for (int g = 0; g < 4; ++g) { const u32x2 kk2 = *(const LAS u32x2*)(iKHT + (32 * b2 + r) * WTS + 8 * g + 4 * h);
                        qm[4 * g] = bflo(kk2.x); qm[4 * g + 1] = bfhi(kk2.x); qm[4 * g + 2] = bflo(kk2.y); qm[4 * g + 3] = bfhi(kk2.y); }
                    qm = MFMA32(xf0, rd_perm(iBHT, WTS, 32 * b2 + r, 0, h), qm); qm = MFMA32(xf1, rd_perm(iBHT, WTS, 32 * b2 + r, 16, h), qm);
                    fq[b2][0] = pack_acc<0>(qm); fq[b2][1] = pack_acc<1>(qm); }
                f32x16 gy = nrk;
                gy = MFMA32(xf0, fn0, gy); gy = MFMA32(xf1, fn1, gy);
                const bf16x8 gf0 = pack_acc<0>(gy), gf1 = pack_acc<1>(gy);
#pragma unroll
                for (int vh = 0; vh < 2; ++vh) { f32x16 yv = zero16();
                    yv = MFMA32(rd_perm(iVT, WTS, 32 * vh + r, 0, h), gf0, yv); yv = MFMA32(rd_perm(iVT, WTS, 32 * vh + r, 16, h), gf1, yv);
                    bf16x8* dy = (bf16x8*)YVT + ((size_t)(chunk * 2 + vh) * 64 + lane) * 2;
                    if (MK_WMASK & 16) { dy[0] = pack_acc<0>(yv); dy[1] = pack_acc<1>(yv); } }
#pragma unroll
                for (int b2 = 0; b2 < 2; ++b2)
#pragma unroll
                    for (int vh = 0; vh < 2; ++vh) { f32x16 zv = zero16();
                        zv = MFMA32(fq[b2][0], rd_perm(iVT, WTS, 32 * vh + r, 0, h), zv); zv = MFMA32(fq[b2][1], rd_perm(iVT, WTS, 32 * vh + r, 16, h), zv);
                        bf16x8* dz = (bf16x8*)ZV + (((size_t)(chunk * 2 + b2) * 2 + vh) * 64 + lane) * 2;
                        if (MK_WMASK & 32) { dz[0] = pack_acc<0>(zv); dz[1] = pack_acc<1>(zv); } } }
            asm volatile("s_waitcnt lgkmcnt(0)" ::: "memory");
        }
        }
    }
}

__device__ __forceinline__ void phase5_attn_part(const Frame& F, int first, int stride);
constexpr int SB_SLOT = 16384, SB_NSLOT = 7, SB_FLAGS = SB_NSLOT * SB_SLOT;
constexpr int CONV_4B = ((MK_CONV_WHERE == 9 || MK_CONV_WHERE == 8) && !MK_ATTN_IN_4B) ? 6144 : 0;
__device__ __forceinline__ void phase4b_states(const Frame& F) {
    volatile LAS unsigned* FULL = (volatile LAS unsigned*)(F.lds + SB_FLAGS);
    volatile LAS unsigned* DONEC = (volatile LAS unsigned*)(F.lds + SB_FLAGS + 64);
    __syncthreads();
    if (F.tid < 32) ((LAS unsigned*)(F.lds + SB_FLAGS))[F.tid] = 0u;
    __syncthreads();
    if (F.vcu < 128) {
        const int bh = F.vcu >> 1, vh = F.vcu & 1, lane = F.lane;
        if (F.wave == 0) {
            bf16x8* Z0 = wsp<bf16x8>(F, WS_Z0);
            f32x16 z0 = zero16(), z1 = zero16();
            bf16x8 pf[8]; u32x4 zq[2][2];
#define SB_FETCH(c_, slot_) do { { int sp = 0; while (FULL[slot_] < (unsigned)((c_) + 1)) { if (++sp > SC_SPIN_CAP) break; } } \
                __builtin_amdgcn_fence(__ATOMIC_ACQUIRE, "workgroup"); \
                const LAS unsigned char* sb = F.lds + (slot_) * SB_SLOT; const LAS bf16x8* p = (const LAS bf16x8*)sb + lane; \
                _Pragma("unroll") for (int q = 0; q < 8; ++q) pf[q] = p[q * 64]; \
                zq[0][0] = ((const LAS u32x4*)(sb + 8192) + lane * 2)[0]; zq[0][1] = ((const LAS u32x4*)(sb + 8192) + lane * 2)[1]; \
                zq[1][0] = ((const LAS u32x4*)(sb + 10240) + lane * 2)[0]; zq[1][1] = ((const LAS u32x4*)(sb + 10240) + lane * 2)[1]; \
                asm volatile("s_waitcnt lgkmcnt(0)" ::: "memory"); \
                if (lane == 0) DONEC[0] = (unsigned)((c_) + 1); } while (0)
            SB_FETCH(0, 0);
            int slot = 0;
            for (int c = 0; c < NCHK; ++c) { const int chunk = bh * NCHK + c;
                const bf16x8 f00 = pack_acc<0>(z0), f01 = pack_acc<1>(z0), f10 = pack_acc<0>(z1), f11 = pack_acc<1>(z1);
                bf16x8* dz = Z0 + (size_t)(chunk * 2 + vh) * 4 * 64 + lane; dz[0] = f00; dz[64] = f01; dz[128] = f10; dz[192] = f11;
                f32x16 n0, n1;
#pragma unroll
                for (int q = 0; q < 2; ++q) { const u32x4 u = zq[0][q], w = zq[1][q];
                    n0[8 * q] = bflo(u.x); n0[8 * q + 1] = bfhi(u.x); n0[8 * q + 2] = bflo(u.y); n0[8 * q + 3] = bfhi(u.y); n0[8 * q + 4] = bflo(u.z); n0[8 * q + 5] = bfhi(u.z); n0[8 * q + 6] = bflo(u.w); n0[8 * q + 7] = bfhi(u.w);
                    n1[8 * q] = bflo(w.x); n1[8 * q + 1] = bfhi(w.x); n1[8 * q + 2] = bflo(w.y); n1[8 * q + 3] = bfhi(w.y); n1[8 * q + 4] = bflo(w.z); n1[8 * q + 5] = bfhi(w.z); n1[8 * q + 6] = bflo(w.w); n1[8 * q + 7] = bfhi(w.w); }
                n0 = MFMA32(pf[0], f00, n0); n1 = MFMA32(pf[2], f00, n1); n0 = MFMA32(pf[1], f01, n0); n1 = MFMA32(pf[3], f01, n1);
                n0 = MFMA32(pf[4], f10, n0); n1 = MFMA32(pf[6], f10, n1); n0 = MFMA32(pf[5], f11, n0); n1 = MFMA32(pf[7], f11, n1);
                slot = (slot + 1 == SB_NSLOT) ? 0 : slot + 1;
                if (c + 1 < NCHK) SB_FETCH(c + 1, slot);
                z0 = n0; z1 = n1; }
#undef SB_FETCH
        } else {
            const int slot = F.wave - 1;
            const unsigned char* gpt = (const unsigned char*)wsp<bf16x8>(F, WS_PT) + lane * 16;
            const unsigned char* gzv = (const unsigned char*)wsp<f32x4>(F, WS_ZV) + lane * 16;
            LAS unsigned char* dst = F.lds + slot * SB_SLOT;
            for (int c = slot; c < NCHK; c += SB_NSLOT) { const int chunk = bh * NCHK + c;
                if (c >= SB_NSLOT) { const unsigned need = (unsigned)(c - SB_NSLOT + 1); int sp = 0;
                    while (DONEC[0] < need) { __builtin_amdgcn_s_sleep(1); if (++sp > SC_SPIN_CAP) break; }
                    __builtin_amdgcn_fence(__ATOMIC_ACQUIRE, "workgroup"); }
                const unsigned char* sp_ = gpt + (size_t)chunk * 8192;
#pragma unroll
                for (int j = 0; j < 8; ++j) __builtin_amdgcn_global_load_lds((const unsigned*)(sp_ + j * 1024), (LAS unsigned*)(dst + j * 1024), 16, 0, 0);
                const unsigned char* sz0 = gzv + ((size_t)(chunk * 2 + 0) * 2 + vh) * 2048; const unsigned char* sz1 = gzv + ((size_t)(chunk * 2 + 1) * 2 + vh) * 2048;
#pragma unroll
                for (int j = 0; j < 2; ++j) { __builtin_amdgcn_global_load_lds((const unsigned*)(sz0 + j * 1024), (LAS unsigned*)(dst + 8192 + j * 1024), 16, 0, 0);
                    __builtin_amdgcn_global_load_lds((const unsigned*)(sz1 + j * 1024), (LAS unsigned*)(dst + 10240 + j * 1024), 16, 0, 0); }
                asm volatile("s_waitcnt vmcnt(0)" ::: "memory");
                if (lane == 0) FULL[slot] = (unsigned)(c + 1); }
        }
    } else {
#if MK_ATTN_IN_4B
        phase5_attn_part(F, F.vcu - 128, 128);
#else
        for (int it = (F.vcu - 128) * 8 + F.wave; it < CONV_4B; it += 128 * 8) moe_weight_item(F, it);
#endif
    }
    __syncthreads();
}

__device__ __forceinline__ void phase4c_output(const Frame& F) {
    const bf16x8* Z0 = wsp<bf16x8>(F, WS_Z0); const bf16x8* RYT = wsp<bf16x8>(F, WS_RYT); const f32x4* YVT = wsp<f32x4>(F, WS_YVT);
    const float* SV = wsp<float>(F, WS_SV); const bf16* G = wsp<bf16>(F, WS_G); const float* BON = wsp<float>(F, WS_BONUS); bf16* CAT = wsp<bf16>(F, WS_CAT);
    const float* lg = F.in[15]; const float* lb = F.in[16];
    const int gw = F.vcu * 8 + F.wave, NGW = F.G * 8, lane = F.lane, r = lane & 31, h = lane >> 5;
    for (int chunk = gw; chunk < NBATCH * RH * NCHK; chunk += NGW) {
        const int bh = chunk / NCHK, c = chunk % NCHK, b = bh / RH, hh = bh % RH, t = c * CK + r, row = b * T + t;
        bf16x8 rf[4], zf[2][4]; u32x4 yv[2][2]; u32x2 vv[2][4], gr[2][4];
#pragma unroll
        for (int q = 0; q < 4; ++q) rf[q] = __builtin_nontemporal_load(RYT + (size_t)chunk * 4 * 64 + lane + q * 64);
#pragma unroll
        for (int vh = 0; vh < 2; ++vh)
#pragma unroll
            for (int q = 0; q < 4; ++q) { if (q < 2) yv[vh][q] = __builtin_nontemporal_load((const u32x4*)YVT + ((size_t)(chunk * 2 + vh) * 64 + lane) * 2 + q);
                zf[vh][q] = __builtin_nontemporal_load(Z0 + (size_t)(chunk * 2 + vh) * 4 * 64 + lane + q * 64); }
        const float bon = BON[row * 8 + hh];
#pragma unroll
        for (int vh = 0; vh < 2; ++vh)
#pragma unroll
            for (int g = 0; g < 4; ++g) { const int v0 = 32 * vh + 8 * g + 4 * h, c0 = hh * 64 + v0;
                vv[vh][g] = __builtin_nontemporal_load((const u32x2*)((const bf16*)SV + ((size_t)bh * T + t) * 64 + v0));
                gr[vh][g] = __builtin_nontemporal_load((const u32x2*)(G + (size_t)row * 512 + c0)); }
        f32x16 y[2];
#pragma unroll
        for (int vh = 0; vh < 2; ++vh) {
#pragma unroll
            for (int q = 0; q < 2; ++q) { const u32x4 u = yv[vh][q]; y[vh][8 * q] = bflo(u.x); y[vh][8 * q + 1] = bfhi(u.x); y[vh][8 * q + 2] = bflo(u.y); y[vh][8 * q + 3] = bfhi(u.y);
                y[vh][8 * q + 4] = bflo(u.z); y[vh][8 * q + 5] = bfhi(u.z); y[vh][8 * q + 6] = bflo(u.w); y[vh][8 * q + 7] = bfhi(u.w); }
#pragma unroll
            for (int q = 0; q < 4; ++q) y[vh] = MFMA32(zf[vh][q], rf[q], y[vh]); }
        float sm = 0.f;
#pragma unroll
        for (int vh = 0; vh < 2; ++vh)
#pragma unroll
            for (int i = 0; i < 16; ++i) sm += y[vh][i];
        sm += __shfl_xor(sm, 32);
        const float mean = sm * (1.f / 64.f); float qv = 0.f;
#pragma unroll
        for (int vh = 0; vh < 2; ++vh)
#pragma unroll
            for (int i = 0; i < 16; ++i) { y[vh][i] -= mean; qv += y[vh][i] * y[vh][i]; }
        qv += __shfl_xor(qv, 32);
        const float rstd = rsqrtf(qv * (1.f / 64.f) + GN_EPS);
#pragma unroll
        for (int vh = 0; vh < 2; ++vh)
#pragma unroll
            for (int g = 0; g < 4; ++g) { const int v0 = 32 * vh + 8 * g + 4 * h, c0 = hh * 64 + v0;
                const f32x4 lg4 = *(const f32x4*)(lg + c0), lb4 = *(const f32x4*)(lb + c0);
                const float gg[4] = {bflo(gr[vh][g].x), bfhi(gr[vh][g].x), bflo(gr[vh][g].y), bfhi(gr[vh][g].y)}; float o[4];
                const float vf[4] = {bflo(vv[vh][g].x), bfhi(vv[vh][g].x), bflo(vv[vh][g].y), bfhi(vv[vh][g].y)};
#pragma unroll
                for (int q = 0; q < 4; ++q) o[q] = (y[vh][4 * g + q] * rstd * lg4[q] + lb4[q] + bon * vf[q]) * gg[q];
                u32x2 w; w.x = pk2(o[0], o[1]); w.y = pk2(o[2], o[3]);
                *(u32x2*)(CAT + (size_t)row * D + c0) = w; }
    }
}

constexpr int SC_STEPS = 16, SC_NSLOT = 6, SC_SHARED = SC_STEPS * 1280, SC_SLOT = SC_SHARED + SC_STEPS * 64, SC_RING = SC_NSLOT * SC_SLOT;
constexpr int SC_FLAGS = SC_RING, SC_CONV = SC_RING + 256, SC_NCH = T / SC_STEPS;
static_assert(SC_CONV + 3 * 8704 <= LDS_BYTES, "scan LDS map");
__device__ __forceinline__ void phase4_scan(const Frame& F) {
    volatile LAS unsigned* READY = (volatile LAS unsigned*)(F.lds + SC_FLAGS);
    volatile LAS unsigned* DONE = (volatile LAS unsigned*)(F.lds + SC_FLAGS + 64);
    __syncthreads();
    if (F.tid < 64) ((LAS unsigned*)(F.lds + SC_FLAGS))[F.tid] = 0u;
    __syncthreads();
    const int bh = F.vcu >> 2, rg = F.vcu & 3, b = bh / RH, hh = bh % RH;
    if (F.wave < 4) {
        const int rl = F.lane >> 4, ks = F.lane & 15, rowl = F.wave * 4 + rl;
        float* yp = wsp<float>(F, WS_Y) + (size_t)b * T * 512 + hh * 64 + rg * 16 + rowl;
        f32x4 S = (f32x4){0.f, 0.f, 0.f, 0.f};
        int slot = 0;
        for (int c = 0; c < SC_NCH; ++c) {
#if MK_RWKV_MODE == 1
            if ((c & 1) == 0) {
                const int v = rg * 16 + rowl, chunk = bh * NCHK + (c >> 1);
                const bf16* zp = wsp<bf16>(F, WS_Z0) + ((((size_t)chunk * 2 + (v >> 5)) * 2 + (ks >> 3)) * 2 + ((ks >> 2) & 1)) * 512 + ((v & 31) + 32 * (ks & 1)) * 8 + 4 * ((ks >> 1) & 1);
                const u32x2 zz = *(const u32x2*)zp;
                S = (f32x4){bflo(zz.x), bfhi(zz.x), bflo(zz.y), bfhi(zz.y)}; }
#endif
            { int sp = 0; while (READY[slot] < (unsigned)(c + 1)) { if (++sp > SC_SPIN_CAP) break; } }
            __builtin_amdgcn_fence(__ATOMIC_ACQUIRE, "workgroup");
            const LAS unsigned char* sb = F.lds + slot * SC_SLOT;
            const LAS unsigned char* op = sb + ks * 16; const LAS float* vp = (const LAS float*)(sb + SC_SHARED) + rowl;
            f32x4 w4 = *(const LAS f32x4*)(op), kk4 = *(const LAS f32x4*)(op + 256), b4 = *(const LAS f32x4*)(op + 512), k4 = *(const LAS f32x4*)(op + 768), r4 = *(const LAS f32x4*)(op + 1024);
            float v = vp[0];
            float ykeep = 0.f;
#pragma unroll
            for (int s = 0; s < SC_STEPS; ++s) {
                const f32x4 cw = w4, ckk = kk4, cb = b4, ck = k4, cr = r4; const float cv = v;
                if (s + 1 < SC_STEPS) { const LAS unsigned char* o2 = op + (s + 1) * 1280;
                    w4 = *(const LAS f32x4*)(o2); kk4 = *(const LAS f32x4*)(o2 + 256); b4 = *(const LAS f32x4*)(o2 + 512); k4 = *(const LAS f32x4*)(o2 + 768); r4 = *(const LAS f32x4*)(o2 + 1024);
                    v = vp[(s + 1) * 16]; }
                if (s == SC_STEPS - 1) { asm volatile("s_waitcnt lgkmcnt(0)" ::: "memory"); if (F.lane == 0) DONE[F.wave] = (unsigned)(c + 1); }
                float p = (S[0] * ckk[0] + S[1] * ckk[1]) + (S[2] * ckk[2] + S[3] * ckk[3]);
                p = reduce16(p);
                const f32x4 tt = S * cw + ck * cv;
                S = tt - cb * p;
                float q = (S[0] * cr[0] + S[1] * cr[1]) + (S[2] * cr[2] + S[3] * cr[3]);
                q = reduce16(q);
                ykeep = (ks == s) ? q : ykeep;
            }
            yp[(size_t)(c * SC_STEPS + ks) * 512] = ykeep;
            slot = (slot + 1 == SC_NSLOT) ? 0 : slot + 1;
        }
    } else if (F.wave == 4) {
        const unsigned char* gs = (const unsigned char*)(wsp<float>(F, WS_SCN) + (size_t)bh * T * 320) + F.lane * 16;
        const unsigned char* gv = (const unsigned char*)(wsp<float>(F, WS_SV) + (size_t)bh * T * 64 + (F.lane >> 2) * 64 + rg * 16 + (F.lane & 3) * 4);
        int slot = 0;
        for (int c = 0; c < SC_NCH; ++c) {
            if (c >= SC_NSLOT) { const unsigned need = (unsigned)(c - SC_NSLOT + 1); int sp = 0;
                while (DONE[0] < need || DONE[1] < need || DONE[2] < need || DONE[3] < need) { __builtin_amdgcn_s_sleep(1); if (++sp > SC_SPIN_CAP) break; }
                __builtin_amdgcn_fence(__ATOMIC_ACQUIRE, "workgroup"); }
            LAS unsigned char* dst = F.lds + slot * SC_SLOT;
            const unsigned char* src = gs + (size_t)c * SC_SHARED;
#pragma unroll
            for (int j = 0; j < SC_SHARED / 1024; ++j) __builtin_amdgcn_global_load_lds((const unsigned*)(src + j * 1024), (LAS unsigned*)(dst + j * 1024), 16, 0, 0);
            __builtin_amdgcn_global_load_lds((const unsigned*)(gv + (size_t)c * SC_STEPS * 256), (LAS unsigned*)(dst + SC_SHARED), 16, 0, 0);
            if (c >= 2) { asm volatile("s_waitcnt vmcnt(42)" ::: "memory"); const int ps = (slot >= 2) ? slot - 2 : slot + SC_NSLOT - 2; if (F.lane == 0) READY[ps] = (unsigned)(c - 1); }
            slot = (slot + 1 == SC_NSLOT) ? 0 : slot + 1;
        }
        { asm volatile("s_waitcnt vmcnt(21)" ::: "memory"); const int ps = (slot >= 2) ? slot - 2 : slot + SC_NSLOT - 2; if (F.lane == 0) READY[ps] = (unsigned)(SC_NCH - 1); }
        { asm volatile("s_waitcnt vmcnt(0)" ::: "memory"); const int ps = (slot >= 1) ? slot - 1 : SC_NSLOT - 1; if (F.lane == 0) READY[ps] = (unsigned)(SC_NCH); }
    } else {
#if MK_CONV_IN_SCAN
        for (int it = F.vcu * 3 + (F.wave - 5); it < MOE_ITEMS; it += F.G * 3) moe_weight_item(F, it);
#endif
    }
    __syncthreads();
}

constexpr int KLD = 72;
constexpr int VLD = 260;
__device__ __forceinline__ void phase5_attn_part(const Frame& F, int first, int stride) {
    const bf16* P = wsp<bf16>(F, WS_P);
    bf16* CAT = wsp<bf16>(F, WS_CAT);
    const float* qg = F.in[17]; const float* kg = F.in[18]; const float* sinks = F.in[19];
    LAS bf16* Kl = (LAS bf16*)F.lds;
    LAS bf16* Vt = (LAS bf16*)(F.lds + 256 * KLD * 2);
    const int lane = F.lane, r = lane & 31, h = lane >> 5;
    for (int unit = first; unit < NBATCH * KVH * (T / 128); unit += stride) {
        const int blk = unit % (T / 128), kvh = (unit / (T / 128)) % KVH, b = unit / (T / 128 * KVH);
        const int kpos0 = blk * 128 - 128;
        __syncthreads();
        u32x4 kr4[4], vr4[4];
#pragma unroll
        for (int it = 0; it < 4; ++it) { const int ch = F.tid + 512 * it, key = ch >> 3, dc = ch & 7, kpos = kpos0 + key;
            const size_t ro = (size_t)(b * T + (kpos >= 0 ? kpos : 0)) * IN_COLS;
            kr4[it] = *(const u32x4*)(P + ro + COL_K + kvh * 64 + dc * 8); vr4[it] = *(const u32x4*)(P + ro + COL_V + kvh * 64 + dc * 8); }
#pragma unroll
        for (int it = 0; it < 4; ++it) { const int ch = F.tid + 512 * it, key = ch >> 3, dc = ch & 7, kpos = kpos0 + key;
            u32x4 kraw = kr4[it], vraw = vr4[it];
            if (kpos < 0) { kraw = (u32x4){0u, 0u, 0u, 0u}; vraw = (u32x4){0u, 0u, 0u, 0u}; }
            float kf[8]; kf[0] = bflo(kraw.x); kf[1] = bfhi(kraw.x); kf[2] = bflo(kraw.y); kf[3] = bfhi(kraw.y); kf[4] = bflo(kraw.z); kf[5] = bfhi(kraw.z); kf[6] = bflo(kraw.w); kf[7] = bfhi(kraw.w);
            float ss = 0.f;
#pragma unroll
            for (int j = 0; j < 8; ++j) ss += kf[j] * kf[j];
            ss += __shfl_xor(ss, 1); ss += __shfl_xor(ss, 2); ss += __shfl_xor(ss, 4);
            const float rstd = rsqrtf(ss * (1.f / 64.f) + NORM_EPS);
            const f32x4 g0 = *(const f32x4*)(kg + dc * 8), g1 = *(const f32x4*)(kg + dc * 8 + 4);
            u32x4 ko; ko.x = pk2(kf[0] * rstd * g0[0], kf[1] * rstd * g0[1]); ko.y = pk2(kf[2] * rstd * g0[2], kf[3] * rstd * g0[3]);
            ko.z = pk2(kf[4] * rstd * g1[0], kf[5] * rstd * g1[1]); ko.w = pk2(kf[6] * rstd * g1[2], kf[7] * rstd * g1[3]);
            *(LAS u32x4*)(Kl + key * KLD + dc * 8) = ko;
            const unsigned vv[4] = {vraw.x, vraw.y, vraw.z, vraw.w};
#pragma unroll
            for (int j = 0; j < 4; ++j) { Vt[(dc * 8 + 2 * j) * VLD + key] = (bf16)(vv[j] & 0xffffu); Vt[(dc * 8 + 2 * j + 1) * VLD + key] = (bf16)(vv[j] >> 16); }
        }
        __syncthreads();
        for (int task = F.wave; task < 16; task += 8) {
            const int g = task & 3, qs = task >> 2, head = kvh * 4 + g;
            const int qrow = b * T + blk * 128 + qs * 32 + r;
            float qf[4][8]; float ss = 0.f;
#pragma unroll
            for (int s = 0; s < 4; ++s) { const u32x4 qr = *(const u32x4*)(P + (size_t)qrow * IN_COLS + COL_Q + head * 64 + 16 * s + 8 * h);
                qf[s][0] = bflo(qr.x); qf[s][1] = bfhi(qr.x); qf[s][2] = bflo(qr.y); qf[s][3] = bfhi(qr.y); qf[s][4] = bflo(qr.z); qf[s][5] = bfhi(qr.z); qf[s][6] = bflo(qr.w); qf[s][7] = bfhi(qr.w);
#pragma unroll
                for (int j = 0; j < 8; ++j) ss += qf[s][j] * qf[s][j]; }
            ss += __shfl_xor(ss, 32);
            const float qscale = rsqrtf(ss * (1.f / 64.f) + NORM_EPS) * 0.125f;
            bf16x8 qb[4];
#pragma unroll
            for (int s = 0; s < 4; ++s) { u32x4 w;
                const f32x4 g0 = *(const f32x4*)(qg + 16 * s + 8 * h), g1 = *(const f32x4*)(qg + 16 * s + 8 * h + 4);
                w.x = pk2(qf[s][0] * qscale * g0[0], qf[s][1] * qscale * g0[1]); w.y = pk2(qf[s][2] * qscale * g0[2], qf[s][3] * qscale * g0[3]);
                w.z = pk2(qf[s][4] * qscale * g1[0], qf[s][5] * qscale * g1[1]); w.w = pk2(qf[s][6] * qscale * g1[2], qf[s][7] * qscale * g1[3]);
                qb[s] = __builtin_bit_cast(bf16x8, w); }
            f32x16 st[5];
#pragma unroll
            for (int kt = 0; kt < 5; ++kt) {
#pragma unroll
                for (int i = 0; i < 16; ++i) st[kt][i] = 0.f;
#pragma unroll
                for (int s = 0; s < 4; ++s) { const bf16x8 ka = *(const LAS bf16x8*)(Kl + (32 * (qs + kt) + r) * KLD + 16 * s + 8 * h);
                    st[kt] = __builtin_amdgcn_mfma_f32_32x32x16_bf16(ka, qb[s], st[kt], 0, 0, 0); }
            }
            const int iq = 32 * qs + r;
            const float sink = sinks[head];
            float mx = sink;
#pragma unroll
            for (int kt = 0; kt < 5; ++kt)
#pragma unroll
                for (int i = 0; i < 16; ++i) { const int jw = 32 * (qs + kt) + (i & 3) + 8 * (i >> 2) + 4 * h;
                    const bool ok = (jw >= iq + 1) && (jw <= iq + 128) && (kpos0 + jw >= 0);
                    st[kt][i] = ok ? st[kt][i] : -INFINITY; mx = fmaxf(mx, st[kt][i]); }
            mx = fmaxf(mx, __shfl_xor(mx, 32));
            float lsum = 0.f;
#pragma unroll
            for (int kt = 0; kt < 5; ++kt)
#pragma unroll
                for (int i = 0; i < 16; ++i) { const float p = __expf(st[kt][i] - mx); st[kt][i] = p; lsum += p; }
            lsum += __shfl_xor(lsum, 32);
            const float linv = __builtin_amdgcn_rcpf(lsum + __expf(sink - mx));
            f32x16 o[2];
#pragma unroll
            for (int dt = 0; dt < 2; ++dt)
#pragma unroll
                for (int i = 0; i < 16; ++i) o[dt][i] = 0.f;
#pragma unroll
            for (int kt = 0; kt < 5; ++kt)
#pragma unroll
                for (int sp = 0; sp < 2; ++sp) { u32x4 pw;
                    pw.x = pk2(st[kt][8 * sp + 0] * linv, st[kt][8 * sp + 1] * linv); pw.y = pk2(st[kt][8 * sp + 2] * linv, st[kt][8 * sp + 3] * linv);
                    pw.z = pk2(st[kt][8 * sp + 4] * linv, st[kt][8 * sp + 5] * linv); pw.w = pk2(st[kt][8 * sp + 6] * linv, st[kt][8 * sp + 7] * linv);
                    const bf16x8 pa = __builtin_bit_cast(bf16x8, pw);
                    const int kb = 32 * (qs + kt) + 16 * sp + 4 * h;
#pragma unroll
                    for (int dt = 0; dt < 2; ++dt) { const LAS bf16* vp = Vt + (32 * dt + r) * VLD + kb;
                        const u32x2 lo = *(const LAS u32x2*)vp, hi = *(const LAS u32x2*)(vp + 8);
                        u32x4 vw; vw.x = lo.x; vw.y = lo.y; vw.z = hi.x; vw.w = hi.y;
                        o[dt] = __builtin_amdgcn_mfma_f32_32x32x16_bf16(pa, __builtin_bit_cast(bf16x8, vw), o[dt], 0, 0, 0); } }
            { LAS bf16* ot = (LAS bf16*)(F.lds + 256 * KLD * 2 + 64 * VLD * 2) + F.wave * (32 * 72);
#pragma unroll
                for (int dt = 0; dt < 2; ++dt)
#pragma unroll
                    for (int i = 0; i < 16; ++i) { const int qr = (i & 3) + 8 * (i >> 2) + 4 * h; ot[qr * 72 + 32 * dt + r] = (bf16)f2bf(o[dt][i]); }
                asm volatile("s_waitcnt lgkmcnt(0)" ::: "memory");
#pragma unroll
                for (int j = 0; j < 4; ++j) { const int id = lane + 64 * j, qr = id >> 3, pc = id & 7;
                    const u32x4 w = *(const LAS u32x4*)(ot + qr * 72 + pc * 8);
                    *(u32x4*)(CAT + (size_t)(b * T + blk * 128 + qs * 32 + qr) * D + 512 + head * 64 + pc * 8) = w; }
                asm volatile("s_waitcnt lgkmcnt(0)" ::: "memory"); }
        }
    }
}

__device__ __forceinline__ void phase5_attn(const Frame& F) { phase5_attn_part(F, F.vcu, F.G); }
__device__ __forceinline__ void phase6(const Frame& F) {
    const int gw = F.vcu * 8 + F.wave, NGW = F.G * 8;
    const float* Y = wsp<float>(F, WS_Y); const float* SV = wsp<float>(F, WS_SV); const bf16* G = wsp<bf16>(F, WS_G); const float* BON = wsp<float>(F, WS_BONUS);
    bf16* CAT = wsp<bf16>(F, WS_CAT);
    const float* lg = F.in[15]; const float* lb = F.in[16];
    const int hh = F.lane >> 3, n0 = (F.lane & 7) * 8, c0 = F.lane * 8;
    for (int row = gw; row < M; row += NGW) { const int b = row / T, t = row % T;
        const f32x4 y0 = *(const f32x4*)(Y + (size_t)row * 512 + c0), y1 = *(const f32x4*)(Y + (size_t)row * 512 + c0 + 4);
        float yv[8] = {y0[0], y0[1], y0[2], y0[3], y1[0], y1[1], y1[2], y1[3]};
        float s = 0.f;
#pragma unroll
        for (int j = 0; j < 8; ++j) s += yv[j];
        s += __shfl_xor(s, 1); s += __shfl_xor(s, 2); s += __shfl_xor(s, 4);
        const float mean = s * (1.f / 64.f); float q = 0.f;
#pragma unroll
        for (int j = 0; j < 8; ++j) { yv[j] -= mean; q += yv[j] * yv[j]; }
        q += __shfl_xor(q, 1); q += __shfl_xor(q, 2); q += __shfl_xor(q, 4);
        const float rstd = rsqrtf(q * (1.f / 64.f) + GN_EPS);
        const float bon = BON[row * 8 + hh];
        const float* vp = SV + ((size_t)(b * RH + hh) * T + t) * 64 + n0;
        const f32x4 v0 = *(const f32x4*)vp, v1 = *(const f32x4*)(vp + 4);
        const float vv[8] = {v0[0], v0[1], v0[2], v0[3], v1[0], v1[1], v1[2], v1[3]};
        const u32x4 graw = *(const u32x4*)(G + (size_t)row * 512 + c0);
        const float gg[8] = {bflo(graw.x), bfhi(graw.x), bflo(graw.y), bfhi(graw.y), bflo(graw.z), bfhi(graw.z), bflo(graw.w), bfhi(graw.w)};
        float ov[8];
#pragma unroll
        for (int j = 0; j < 8; ++j) ov[j] = (yv[j] * rstd * lg[c0 + j] + lb[c0 + j] + bon * vv[j]) * gg[j];
        u32x4 w; w.x = pk2(ov[0], ov[1]); w.y = pk2(ov[2], ov[3]); w.z = pk2(ov[4], ov[5]); w.w = pk2(ov[6], ov[7]);
        *(u32x4*)(CAT + (size_t)row * D + c0) = w; }
}

__device__ __forceinline__ float reduce32x64(float (&v)[32], int lane) {
#pragma unroll
    for (int i = 0; i < 16; ++i) { const bool hi = lane & 16; const float send = hi ? v[i] : v[i + 16], keep = hi ? v[i + 16] : v[i]; v[i] = keep + __shfl_xor(send, 16); }
#pragma unroll
    for (int i = 0; i < 8; ++i) { const bool hi = lane & 8; const float send = hi ? v[i] : v[i + 8], keep = hi ? v[i + 8] : v[i]; v[i] = keep + __shfl_xor(send, 8); }
#pragma unroll
    for (int i = 0; i < 4; ++i) { const bool hi = lane & 4; const float send = hi ? v[i] : v[i + 4], keep = hi ? v[i + 4] : v[i]; v[i] = keep + __shfl_xor(send, 4); }
#pragma unroll
    for (int i = 0; i < 2; ++i) { const bool hi = lane & 2; const float send = hi ? v[i] : v[i + 2], keep = hi ? v[i + 2] : v[i]; v[i] = keep + __shfl_xor(send, 2); }
    { const bool hi = lane & 1; const float send = hi ? v[0] : v[1], keep = hi ? v[1] : v[0]; v[0] = keep + __shfl_xor(send, 1); }
    return v[0] + __shfl_xor(v[0], 32);
}
__device__ __forceinline__ void phase8(const Frame& F) {
    const float* mod = wsp<float>(F, WS_MOD); const bf16* x1 = wsp<bf16>(F, WS_X1B);
    const float* wr_ = F.in[22]; const float* br = F.in[23];
    LAS float* Wt = (LAS float*)F.lds;
    LAS float* lgw = (LAS float*)(F.lds + 131072 + F.wave * 512);
    LAS int* cnt = (LAS int*)(F.lds + 131072 + 4096);
    __syncthreads();
    for (int idx = F.tid; idx < 8192; idx += 512) { const int k = idx >> 3, e4 = idx & 7; const f32x4 w = *(const f32x4*)(wr_ + k * 32 + e4 * 4);
        Wt[(4 * e4 + 0) * 1024 + k] = w[0]; Wt[(4 * e4 + 1) * 1024 + k] = w[1]; Wt[(4 * e4 + 2) * 1024 + k] = w[2]; Wt[(4 * e4 + 3) * 1024 + k] = w[3]; }
    if (F.tid < 32) cnt[F.tid] = 0;
    __syncthreads();
    int* RT_E = wsp<int>(F, WS_RT_E); int* RT_LP = wsp<int>(F, WS_RT_LP); float* RT_G = wsp<float>(F, WS_RT_G);
    const int e = F.lane & 31;
    const float bre = br[e];
    f32x4 shq[4], scq[4];
    { const int b = (F.vcu * 128) / T;
#pragma unroll
        for (int j = 0; j < 4; ++j) { const int col = 4 * F.lane + 256 * j; shq[j] = *(const f32x4*)(mod + b * 6144 + 3072 + col); scq[j] = (*(const f32x4*)(mod + b * 6144 + 4096 + col) + 1.f) * *(const f32x4*)(F.in[21] + col); } }
#if MK_CONV_WHERE == 8
    const int p_lo = F.wave < 4 ? 11 * F.wave : 44 + 10 * (F.wave - 4), p_n = F.wave < 4 ? 11 : 10;
    if (F.wave >= 6) { for (int it = CONV_4B + F.vcu * 2 + (F.wave - 6); it < MOE_ITEMS; it += F.G * 2) moe_weight_item(F, it); }
    else {
#else
    const int p_lo = 8 * F.wave, p_n = 8;
    {
#endif
    u32x2 xn[2][4];
#pragma unroll
    for (int q = 0; q < 2; ++q)
#pragma unroll
        for (int j = 0; j < 4; ++j) xn[q][j] = ((const u32x2*)(x1 + (size_t)(F.vcu * 128 + 2 * p_lo + q) * D))[F.lane + 64 * j];
    for (int pr = 0; pr < p_n; ++pr) { const int row0 = F.vcu * 128 + 2 * (p_lo + pr);
        f32x4 h0[4], h1[4];
        float ss0 = 0.f, ss1 = 0.f;
#pragma unroll
        for (int j = 0; j < 4; ++j) { h0[j] = (f32x4){bflo(xn[0][j].x), bfhi(xn[0][j].x), bflo(xn[0][j].y), bfhi(xn[0][j].y)}; h1[j] = (f32x4){bflo(xn[1][j].x), bfhi(xn[1][j].x), bflo(xn[1][j].y), bfhi(xn[1][j].y)};
            ss0 += (h0[j][0] * h0[j][0] + h0[j][1] * h0[j][1]) + (h0[j][2] * h0[j][2] + h0[j][3] * h0[j][3]); ss1 += (h1[j][0] * h1[j][0] + h1[j][1] * h1[j][1]) + (h1[j][2] * h1[j][2] + h1[j][3] * h1[j][3]); }
        { const int nr = row0 + (pr + 1 < p_n ? 2 : 0);
#pragma unroll
            for (int q = 0; q < 2; ++q)
#pragma unroll
                for (int j = 0; j < 4; ++j) xn[q][j] = ((const u32x2*)(x1 + (size_t)(nr + q) * D))[F.lane + 64 * j]; }
#pragma unroll
        for (int o = 1; o < 64; o <<= 1) { ss0 += __shfl_xor(ss0, o); ss1 += __shfl_xor(ss1, o); }
        const float rs0 = rsqrtf(ss0 * (1.f / D) + NORM_EPS), rs1 = rsqrtf(ss1 * (1.f / D) + NORM_EPS);
        unsigned char* o0 = wsp<unsigned char>(F, WS_H8) + (size_t)row0 * D * (MK_FP8 ? 1 : 2); unsigned char* o1 = o0 + (size_t)D * (MK_FP8 ? 1 : 2);
#pragma unroll
        for (int j = 0; j < 4; ++j) { h0[j] = h0[j] * rs0 * scq[j] + shq[j]; h1[j] = h1[j] * rs1 * scq[j] + shq[j];
#if MK_FP8
            ((unsigned*)o0)[F.lane + 64 * j] = pg8::pk4_fp8(h0[j][0], h0[j][1], h0[j][2], h0[j][3]); ((unsigned*)o1)[F.lane + 64 * j] = pg8::pk4_fp8(h1[j][0], h1[j][1], h1[j][2], h1[j][3]);
#else
            { u32x2 w; w.x = pk2(h0[j][0], h0[j][1]); w.y = pk2(h0[j][2], h0[j][3]); ((u32x2*)o0)[F.lane + 64 * j] = w; w.x = pk2(h1[j][0], h1[j][1]); w.y = pk2(h1[j][2], h1[j][3]); ((u32x2*)o1)[F.lane + 64 * j] = w; }
#endif
        }
        float pa0[32], pa1[32];
#pragma unroll
        for (int q = 0; q < 32; ++q) { float s0 = 0.f, s1 = 0.f;
#pragma unroll
            for (int j = 0; j < 4; ++j) { const f32x4 w4 = *(const LAS f32x4*)(Wt + q * 1024 + 4 * F.lane + 256 * j);
                s0 = fmaf(h0[j][0], w4[0], s0); s0 = fmaf(h0[j][1], w4[1], s0); s0 = fmaf(h0[j][2], w4[2], s0); s0 = fmaf(h0[j][3], w4[3], s0);
                s1 = fmaf(h1[j][0], w4[0], s1); s1 = fmaf(h1[j][1], w4[1], s1); s1 = fmaf(h1[j][2], w4[2], s1); s1 = fmaf(h1[j][3], w4[3], s1); }
            pa0[q] = s0; pa1[q] = s1; }
        const float lg0 = reduce32x64(pa0, F.lane) + bre, lg1 = reduce32x64(pa1, F.lane) + bre;
#pragma unroll
        for (int q = 0; q < 2; ++q) { const float logit = q ? lg1 : lg0; const int row = row0 + q; LAS float* lg32 = lgw + q * 64;
            if (F.lane < 32) lg32[e] = logit;
            asm volatile("s_waitcnt lgkmcnt(0)" ::: "memory");
            int rank = 0;
#pragma unroll 8
            for (int o = 0; o < 32; ++o) { const float ov = lg32[o]; rank += (ov > logit || (ov == logit && o < e)) ? 1 : 0; }
            if (F.lane < 32 && rank < 4) lg32[32 + rank] = logit;
            asm volatile("s_waitcnt lgkmcnt(0)" ::: "memory");
            const float t0 = lg32[32], t1 = lg32[33], t2 = lg32[34], t3 = lg32[35];
            const float den = 1.f + __expf(t1 - t0) + __expf(t2 - t0) + __expf(t3 - t0);
            if (F.lane < 32 && rank < 4) { const int lp = atomicAdd((int*)&cnt[e], 1);
                RT_E[row * 4 + rank] = e; RT_LP[row * 4 + rank] = lp; RT_G[row * 4 + rank] = __expf(logit - t0) / den; }
            asm volatile("s_waitcnt lgkmcnt(0)" ::: "memory"); }
    }
    }
    __syncthreads();
    if (F.tid < 32) wsp<int>(F, WS_BLKCNT)[F.vcu * 32 + F.tid] = cnt[F.tid];
}

__device__ __forceinline__ void phase9(const Frame& F) {
    LAS int* base = (LAS int*)F.lds;
    LAS int* tot = base + 32;
    LAS int* pst = base + 64;
    const int* BC = wsp<int>(F, WS_BLKCNT);
    { LAS int* ps = base + 128; LAS int* pm = ps + 512;
        const int e = F.tid & 31, seg = F.tid >> 5; int s = 0, mine = 0;
#pragma unroll
        for (int j = 0; j < 16; ++j) { const int bk = seg * 16 + j, v = BC[bk * 32 + e]; s += v; mine += (bk < F.vcu) ? v : 0; }
        ps[seg * 32 + e] = s; pm[seg * 32 + e] = mine; }
    __syncthreads();
    if (F.tid < 32) { int s = 0, mine = 0;
#pragma unroll
        for (int q = 0; q < 16; ++q) { s += base[128 + q * 32 + F.tid]; mine += base[128 + 512 + q * 32 + F.tid]; }
        base[F.tid] = mine; tot[F.tid] = s; }
    __syncthreads();
    if (F.tid == 0) { int s = 0; for (int e = 0; e < 32; ++e) { pst[e] = s; s += (tot[e] + 255) / 256 * 256; } pst[32] = s; }
    __syncthreads();
    int* SLOT_TOK = wsp<int>(F, WS_SLOTTOK); float* SLOT_GATE = wsp<float>(F, WS_SLOTGATE); int* TOK_SLOT = wsp<int>(F, WS_TOKSLOT);
    const int* RT_E = wsp<int>(F, WS_RT_E); const int* RT_LP = wsp<int>(F, WS_RT_LP); const float* RT_G = wsp<float>(F, WS_RT_G);
    { const int idx = F.vcu * 512 + F.tid;
        const int e = RT_E[idx], slot = pst[e] + base[e] + RT_LP[idx];
        SLOT_TOK[slot] = idx >> 2; SLOT_GATE[slot] = RT_G[idx]; TOK_SLOT[idx] = slot; }
    if (F.vcu < 32) { const int e = F.vcu; for (int s = pst[e] + tot[e] + F.tid; s < pst[e + 1]; s += 512) { SLOT_TOK[s] = 0; SLOT_GATE[s] = 0.f; } }
    if (F.vcu == 0) { unsigned* ctl = wsp<unsigned>(F, WS_CTL);
        if (F.tid == 0) ctl[CW_NTILES] = (unsigned)(pst[32] / 256);
        if (F.tid < 33) ctl[CW_PADSTART + F.tid] = (unsigned)pst[F.tid];
        int* TE = wsp<int>(F, WS_TILEE);
        for (int tl = F.tid; tl < MAX_TILES; tl += 512) { int e = 31; for (int q = 0; q < 32; ++q) if (tl * 256 < pst[q + 1]) { e = q; break; } TE[tl] = e; } }
#if MK_CONV_WHERE == 9
    for (int it = CONV_4B + F.vcu * 8 + F.wave; it < MOE_ITEMS; it += F.G * 8) moe_weight_item(F, it);
#endif
}

__device__ __forceinline__ void phase12(const Frame& F) {
    const int gw = F.vcu * 8 + F.wave, NGW = F.G * 8;
    const float* mod = wsp<float>(F, WS_MOD); const bf16* YS = wsp<bf16>(F, WS_YS); const int* TOK_SLOT = wsp<int>(F, WS_TOKSLOT); const bf16* X1B = wsp<bf16>(F, WS_X1B);
    for (int row = gw; row < M; row += 2 * NGW) {
        int sl[2][4]; u32x4 v[2][2][4], xb[2][2];
#pragma unroll
        for (int rr = 0; rr < 2; ++rr)
#pragma unroll
            for (int k = 0; k < 4; ++k) sl[rr][k] = TOK_SLOT[(row + rr * NGW) * 4 + k];
#pragma unroll
        for (int rr = 0; rr < 2; ++rr)
#pragma unroll
            for (int j = 0; j < 2; ++j) { const int col = 8 * F.lane + 512 * j;
#pragma unroll
                for (int k = 0; k < 4; ++k) v[rr][j][k] = __builtin_nontemporal_load((const u32x4*)(YS + (size_t)sl[rr][k] * D + col));
                xb[rr][j] = __builtin_nontemporal_load((const u32x4*)(X1B + (size_t)(row + rr * NGW) * D + col)); }
#pragma unroll
        for (int rr = 0; rr < 2; ++rr) { const int rw = row + rr * NGW, b = rw / T;
#pragma unroll
            for (int j = 0; j < 2; ++j) { const int col = 8 * F.lane + 512 * j;
                float a[8];
#pragma unroll
                for (int q = 0; q < 8; ++q) a[q] = 0.f;
#pragma unroll
                for (int k = 0; k < 4; ++k) { const u32x4 w = v[rr][j][k];
                    a[0] += bflo(w.x); a[1] += bfhi(w.x); a[2] += bflo(w.y); a[3] += bfhi(w.y); a[4] += bflo(w.z); a[5] += bfhi(w.z); a[6] += bflo(w.w); a[7] += bfhi(w.w); }
                const float* gp = mod + b * 6144 + 5120 + col;
                const f32x4 g0 = *(const f32x4*)gp, g1 = *(const f32x4*)(gp + 4);
                float* op = F.out + (size_t)rw * D + col;
                const u32x4 x = xb[rr][j];
                f32x4 x0 = (f32x4){bflo(x.x), bfhi(x.x), bflo(x.y), bfhi(x.y)}, x1v = (f32x4){bflo(x.z), bfhi(x.z), bflo(x.w), bfhi(x.w)};
                x0[0] += g0[0] * a[0]; x0[1] += g0[1] * a[1]; x0[2] += g0[2] * a[2]; x0[3] += g0[3] * a[3];
                x1v[0] += g1[0] * a[4]; x1v[1] += g1[1] * a[5]; x1v[2] += g1[2] * a[6]; x1v[3] += g1[3] * a[7];
                *(f32x4*)op = x0; *(f32x4*)(op + 4) = x1v; } }
    }
}

__device__ __forceinline__ void copy_x_to_out(const Frame& F) {
    const size_t n4 = (size_t)M * D / 4; const f32x4* s = (const f32x4*)F.in[0]; f32x4* d = (f32x4*)F.out;
    for (size_t i = (size_t)blockIdx.x * 512 + F.tid; i < n4; i += (size_t)gridDim.x * 512) d[i] = s[i];
}


#define XB_TMO      128
#define XB_XCNT(j)  (256  + 64 * (j))
#define XB_XSUB(j)  (1280 + 64 * (j))
#define XB_XGEN(j)  (2304 + 64 * (j))
#define XB_TOP      3328
#define XB_TOPGEN   3392
#define XCD_BAR_WORDS 3456
#define XB_SPIN_CAP (1u << 18)
__device__ __forceinline__ unsigned xb_ld(unsigned* p)              { return __hip_atomic_load(p, __ATOMIC_RELAXED, __HIP_MEMORY_SCOPE_AGENT); }
__device__ __forceinline__ unsigned xb_add(unsigned* p, unsigned v) { return __hip_atomic_fetch_add(p, v, __ATOMIC_RELAXED, __HIP_MEMORY_SCOPE_AGENT); }
__device__ __forceinline__ unsigned xb_xcc_id() { return (unsigned)__builtin_amdgcn_s_getreg((3 << 11) | 20) & 0xFu; }
#define XB_SPIN(cond, bar) do { unsigned _sp = 0; while (cond) { __builtin_amdgcn_s_sleep(1); \
    if ((++_sp & 255u) == 0u) { if (xb_ld(&(bar)[XB_TMO])) break; if (_sp > XB_SPIN_CAP) { atomicAdd(&(bar)[XB_TMO], 1u); break; } } } } while (0)
struct XcdBarrier { unsigned* bar; unsigned x; volatile LAS unsigned* st; };
__device__ __forceinline__ XcdBarrier xcd_barrier_post(unsigned* bar, volatile LAS unsigned* st) {
    XcdBarrier b; b.bar = bar; b.x = xb_xcc_id(); b.st = st;
    if (threadIdx.x == 0) (void)xb_add(&bar[XB_XCNT(b.x)], 1u);
    return b;
}
__device__ __forceinline__ void xcd_barrier_complete(unsigned* bar, unsigned x, unsigned& nloc, unsigned& nx) {
    const unsigned G = gridDim.x * gridDim.y * gridDim.z;
    unsigned sum, cnt, mine, sp = 0u;
    for (;;) {
        sum = 0u; cnt = 0u; mine = 0u;
#pragma unroll
        for (unsigned j = 0; j < 16; ++j) { const unsigned c = xb_ld(&bar[XB_XCNT(j)]); sum += c; cnt += (c > 0u) ? 1u : 0u; mine = (j == x) ? c : mine; }
        if (sum == G) break;
        __builtin_amdgcn_s_sleep(1);
        if ((++sp & 255u) == 0u) { if (xb_ld(&bar[XB_TMO])) break; if (sp > XB_SPIN_CAP) { atomicAdd(&bar[XB_TMO], 1u); break; } }
    }
    nloc = mine > 0u ? mine : 1u; nx = cnt > 0u ? cnt : 1u;
}
__device__ __forceinline__ void xcd_barrier(const XcdBarrier& b) {
    asm volatile("s_waitcnt vmcnt(0)" ::: "memory");
    __syncthreads();
    if (threadIdx.x == 0) {
        unsigned* bar = b.bar;
        __builtin_amdgcn_s_waitcnt(0);
        unsigned nloc = b.st[0], nx = b.st[1];
        if (nloc == 0u) { xcd_barrier_complete(bar, b.x, nloc, nx); b.st[0] = nloc; b.st[1] = nx; }
        const unsigned old = xb_add(&bar[XB_XSUB(b.x)], 1u);
        const unsigned gen = old / nloc;
        if (old + 1u == (gen + 1u) * nloc) {
            __builtin_amdgcn_fence(__ATOMIC_RELEASE, "agent");
            asm volatile("s_waitcnt vmcnt(0)" ::: "memory");
            const unsigned og = xb_add(&bar[XB_TOP], 1u);
            const unsigned tg = og / nx;
            if (og + 1u == (tg + 1u) * nx) xb_add(&bar[XB_TOPGEN], 1u);
            else XB_SPIN(xb_ld(&bar[XB_TOPGEN]) == tg, bar);
            __builtin_amdgcn_fence(__ATOMIC_ACQUIRE, "agent");
            xb_add(&bar[XB_XGEN(b.x)], 1u);
            asm volatile("s_waitcnt vmcnt(0)" ::: "memory");
        } else {
            XB_SPIN(xb_ld(&bar[XB_XGEN(b.x)]) == gen, bar);
            __builtin_amdgcn_fence(__ATOMIC_ACQUIRE, "agent");
            asm volatile("s_waitcnt vmcnt(0)" ::: "memory");
        }
    }
    __syncthreads();
}

struct Args { const float* in[28]; float* out; unsigned char* ws; int ph_lo, ph_hi; };
constexpr int N_PHASES = 13;

__global__ void __launch_bounds__(512, 2) mk_fwd(Args args) {
    extern __shared__ __attribute__((aligned(16))) unsigned char lds_raw[];
    Frame F;
    F.lds = (LAS unsigned char*)lds_raw;
    F.tid = threadIdx.x; F.lane = F.tid & 63; F.wave = __builtin_amdgcn_readfirstlane(F.tid >> 6);
    F.G = gridDim.x; { const int bx = blockIdx.x; F.vcu = (F.G % 8 == 0) ? (bx % 8) * (F.G / 8) + bx / 8 : bx; }
    F.in = args.in;
    F.out = args.out; F.ws = args.ws;
    cg::grid_group grid = cg::this_grid();
    const int lo = args.ph_lo, hi = args.ph_hi;
    volatile LAS unsigned* MISC = (volatile LAS unsigned*)(F.lds + MISC_OFF);
    if (F.tid < 16) MISC[F.tid] = 0u;
    __syncthreads();
    XcdBarrier bar; bar.bar = wsp<unsigned>(F, WS_CTL) + CW_BAR; bar.x = 0; bar.st = MISC;
    if (hi - lo > 1) bar = xcd_barrier_post(wsp<unsigned>(F, WS_CTL) + CW_BAR, MISC);
#define IN(k) (lo <= (k) && (k) < hi)
#define REP(k) for (int rep_ = 0; rep_ < 1 + ((MK_REPEAT_MASK >> (k)) & 1); ++rep_)
#define SEAM(k) do { if (IN(k) && IN((k) + 1)) { if ((MK_CG_SEAMS >> (k)) & 1) grid.sync(); else xcd_barrier(bar); } } while (0)

    if (IN(0)) REP(0) { phase0(F); } SEAM(0);
    if (IN(1)) REP(1) { phase1(F); } SEAM(1);
    if (IN(2)) REP(2) {
#if MK_CONV_WHERE == 2
        if ((int)blockIdx.x >= 192) { for (int it = ((int)blockIdx.x - 192) * 8 + F.wave; it < MOE_ITEMS; it += 64 * 8) moe_weight_item(F, it); }
        else {
        pg8::Gemm g{wsp<bf16>(F, WS_H), wsp<bf16>(F, WS_WIN), D, IN_COLS, nullptr};
        pg8::StaticOrder S; S.init(M, IN_COLS, 192, (int)blockIdx.x);
        pg8::EpiBf16P E{wsp<bf16>(F, WS_P), IN_COLS};
        pg8::gemm_phase<pg8::EpiBf16P, pg8::StaticOrder, false>(F.lds, g, S, E);
        }
#else
        pg8::Gemm g{wsp<bf16>(F, WS_H), wsp<bf16>(F, WS_WIN), D, IN_COLS, nullptr};
        pg8::StaticOrder S; S.init(M, IN_COLS, F.G, (int)blockIdx.x);
        pg8::EpiBf16P E{wsp<bf16>(F, WS_P), IN_COLS};
        pg8::gemm_phase<pg8::EpiBf16P, pg8::StaticOrder, false>(F.lds, g, S, E);
#endif
    } SEAM(2);
#if MK_RWKV_MODE < 3
    if (IN(3)) REP(3) { phase3(F); } SEAM(3);
#endif
    if (IN(4)) REP(4) {
#if MK_RWKV_MODE >= 1
#if MK_RWKV_MODE == 4
#if MK_WMASK != 63
        phase4a_fused(F); xcd_barrier(bar);
#endif
        for (int q_ = 0; q_ < 1 + (MK_REP4 & 1); ++q_) { phase4a_wave(F); xcd_barrier(bar); }
#elif MK_RWKV_MODE == 3
        for (int q_ = 0; q_ < 1 + (MK_REP4 & 1); ++q_) { phase4a_fused(F); xcd_barrier(bar); }
#else
        for (int q_ = 0; q_ < 1 + (MK_REP4 & 1); ++q_) { phase4a_summaries(F); xcd_barrier(bar); }
#endif
        for (int q_ = 0; q_ < 1 + ((MK_REP4 >> 1) & 1); ++q_) { phase4b_states(F); xcd_barrier(bar); }
#endif
#if MK_RWKV_MODE >= 2
        for (int q_ = 0; q_ < 1 + ((MK_REP4 >> 2) & 1); ++q_) phase4c_output(F);
#else
        phase4_scan(F);
#endif
        } SEAM(4);
#if !MK_ATTN_IN_4B
    if (IN(5)) REP(5) { phase5_attn(F); } SEAM(5);
#endif
#if MK_RWKV_MODE < 2
    if (IN(6)) REP(6) { phase6(F); } SEAM(6);
#endif
    if (IN(7)) REP(7) {
#if MK_LAST_PHASE >= 7
        pg8::Gemm g{wsp<bf16>(F, WS_CAT), wsp<bf16>(F, WS_WOUT), D, D, nullptr};
        pg8::StaticOrder S; S.init(M, D, F.G, (int)blockIdx.x);
        pg8::EpiOutProj E{F.in[0], wsp<bf16>(F, WS_X1B), wsp<float>(F, WS_MOD) + 2048};
        pg8::gemm_phase<pg8::EpiOutProj, pg8::StaticOrder, false>(F.lds, g, S, E);
#else
        copy_x_to_out(F);
#endif
    } SEAM(7);
    if (IN(8)) REP(8) { phase8(F); } SEAM(8);
    if (IN(9)) REP(9) { phase9(F); } SEAM(9);
    if (IN(10)) REP(10) {
        const unsigned* ctl = wsp<unsigned>(F, WS_CTL);
        pg8::Gemm g{wsp<bf16>(F, WS_H8), wsp<bf16>(F, WS_W1), MK_FP8 ? D / 2 : D, 2 * DE, wsp<int>(F, WS_SLOTTOK)};
        pg8::MoeOrder S{(int)ctl[CW_NTILES], 8, F.G, F.vcu, wsp<int>(F, WS_TILEE)};
        pg8::EpiMoe1 E{wsp<unsigned char>(F, WS_ACT), F.in[25]};
        pg8::gemm_phase<pg8::EpiMoe1, pg8::MoeOrder, true, MK_FP8 != 0>(F.lds, g, S, E);
    } SEAM(10);
    if (IN(11)) REP(11) {
        const unsigned* ctl = wsp<unsigned>(F, WS_CTL);
        pg8::Gemm g{wsp<bf16>(F, WS_ACT), wsp<bf16>(F, WS_W2), MK_FP8 ? DE / 2 : DE, D, nullptr};
        pg8::MoeOrder S{(int)ctl[CW_NTILES], 4, F.G, F.vcu, wsp<int>(F, WS_TILEE)};
        pg8::EpiMoe2 E{wsp<bf16>(F, WS_YS), F.in[27], wsp<float>(F, WS_SLOTGATE)};
        pg8::gemm_phase<pg8::EpiMoe2, pg8::MoeOrder, false, MK_FP8 != 0>(F.lds, g, S, E);
    } SEAM(11);
    if (IN(12)) { phase12(F); }
#undef IN
#undef SEAM
}

extern "C" void kernel_launch(void* const* d_in, const int* in_sizes, int n_in, void* d_out, int out_size, void* d_ws, size_t ws_size, hipStream_t stream) {
    static int grid = 0;
    if (grid == 0) {
        if (n_in != 28 || out_size != M * D || ws_size < WS_END) { fprintf(stderr, "kernel_launch: unexpected sizes (n_in %d out %d ws %zu, need %zu)\n", n_in, out_size, ws_size, (size_t)WS_END); grid = -1; return; }
        int dev = 0, cus = 0, per_cu = 0;
        (void)hipGetDevice(&dev); (void)hipDeviceGetAttribute(&cus, hipDeviceAttributeMultiprocessorCount, dev);
        (void)hipFuncSetAttribute((const void*)mk_fwd, hipFuncAttributeMaxDynamicSharedMemorySize, LDS_BYTES);
        (void)hipOccupancyMaxActiveBlocksPerMultiprocessor(&per_cu, (const void*)mk_fwd, 512, LDS_BYTES);
        if (per_cu < 1 || cus != 256) { fprintf(stderr, "kernel_launch: occupancy %d, CUs %d: this build needs 256 CUs x 1 block\n", per_cu, cus); grid = -1; return; }
        grid = cus;
    }
    if (grid < 0) return;
    (void)hipMemsetAsync((char*)d_ws + WS_CTL, 0, CTL_BYTES, stream);
    Args a{};
    for (int i = 0; i < 28; ++i) a.in[i] = (const float*)d_in[i];
    a.out = (float*)d_out; a.ws = (unsigned char*)d_ws;
    const int last = MK_LAST_PHASE + 1;
#if MK_ONE_LAUNCH
    a.ph_lo = 0; a.ph_hi = last;
#if MK_COOP
    void* kargs[] = {&a};
    hipError_t e = hipLaunchCooperativeKernel((const void*)mk_fwd, dim3(grid), dim3(512), kargs, LDS_BYTES, stream);
    if (e != hipSuccess) fprintf(stderr, "cooperative launch failed: %s\n", hipGetErrorString(e));
#else
    hipLaunchKernelGGL(mk_fwd, dim3(grid), dim3(512), LDS_BYTES, stream, a);
#endif
#else
    for (int p = 0; p < last; ++p) { a.ph_lo = p; a.ph_hi = p + 1; hipLaunchKernelGGL(mk_fwd, dim3(grid), dim3(512), LDS_BYTES, stream, a); }
#endif
}
```

```cpp
#include <hip/hip_runtime.h>
#include <hip/hip_cooperative_groups.h>
#include <cstdio>
#include <cstdint>
namespace cg = cooperative_groups;

#ifndef MK_ONE_LAUNCH
#define MK_ONE_LAUNCH 1
#endif
#ifndef MK_REPEAT_MASK
#define MK_REPEAT_MASK 0
#endif
#ifndef MK_CONV_WHERE
#define MK_CONV_WHERE 8
#endif
#define MK_CONV_IN_SCAN (MK_CONV_WHERE == 4)
#ifndef MK_RWKV_MODE
#define MK_RWKV_MODE 3
#endif
#ifndef MK_FP8
#define MK_FP8 1
#endif
#ifndef MK_DUP
#define MK_DUP 0
#endif
#ifndef MK_WMASK
#define MK_WMASK 63
#endif
#ifndef MK_ATTN_IN_4B
#define MK_ATTN_IN_4B 1
#endif
#ifndef MK_REP4
#define MK_REP4 0
#endif
#ifndef MK_CG_SEAMS
#define MK_CG_SEAMS 0
#endif
#ifndef MK_COOP
#define MK_COOP 0
#endif
#ifndef MK_LAST_PHASE
#define MK_LAST_PHASE 12
#endif

constexpr int D = 1024, NBATCH = 8, T = 4096, M = NBATCH * T;
constexpr int HD = 64, RW = 512, RH = 8, AW = 512, QH = 8, KVH = 2, WIN = 128;
constexpr int RWKV_COLS = 1792, IN_COLS = 2560;
constexpr int COL_Q = 1792, COL_K = 1792 + 512, COL_V = 1792 + 512 + 128;
constexpr int NE = 32, TOPK = 4, DE = 1024;
constexpr int MAX_TILES = 544;
constexpr int MAX_SLOTS = MAX_TILES * 256;
constexpr float NORM_EPS = 1e-6f, GN_EPS = 64e-5f;

#define GAS __attribute__((address_space(1)))
#define LAS __attribute__((address_space(3)))
typedef unsigned short bf16;
typedef short bf16x8 __attribute__((ext_vector_type(8)));
typedef float f32x4 __attribute__((ext_vector_type(4)));
typedef float f32x2 __attribute__((ext_vector_type(2)));
typedef float f32x16 __attribute__((ext_vector_type(16)));
typedef unsigned u32x4 __attribute__((ext_vector_type(4)));
typedef unsigned u32x2 __attribute__((ext_vector_type(2)));
typedef int i32x8 __attribute__((ext_vector_type(8)));
typedef int i32x4 __attribute__((ext_vector_type(4)));

constexpr size_t MiB = 1u << 20;
constexpr size_t WS_CTL = 0, CTL_BYTES = 64 * 1024;
constexpr size_t WS_MOD = 1 * MiB;
constexpr size_t WS_BON = 1 * MiB + 256 * 1024;
constexpr size_t WS_RT_E = 2 * MiB;
constexpr size_t WS_RT_LP = 2 * MiB + 512 * 1024;
constexpr size_t WS_RT_G = 3 * MiB;
constexpr size_t WS_TOKSLOT = 3 * MiB + 512 * 1024;
constexpr size_t WS_SLOTTOK = 4 * MiB;
constexpr size_t WS_SLOTGATE = 5 * MiB;
constexpr size_t WS_BLKCNT = 6 * MiB;
constexpr size_t WS_TILEE = 6 * MiB + 64 * 1024;
constexpr size_t WS_BONUS = 7 * MiB;
constexpr size_t WS_LW = 9 * MiB;
constexpr size_t WS_WIN = 10 * MiB;
constexpr size_t WS_WOUT = 16 * MiB;
constexpr size_t WS_W1 = 20 * MiB;
constexpr size_t WS_W2 = 148 * MiB;
constexpr size_t WS_H = 212 * MiB;
constexpr size_t WS_R2 = 276 * MiB;
constexpr size_t WS_P = WS_R2;
constexpr size_t WS_SCN = WS_R2 + 160 * MiB;
constexpr size_t WS_SV = WS_SCN + 320 * MiB;
constexpr size_t WS_G = WS_SV + 64 * MiB;
constexpr size_t WS_Y = WS_G + 32 * MiB;
constexpr size_t WS_CAT = WS_Y + 64 * MiB;
constexpr size_t WS_ACT = WS_R2;
constexpr size_t WS_YS = WS_R2 + 272 * MiB;
constexpr size_t WS_END = 1012 * MiB;
constexpr size_t WS_X1B = WS_H;
constexpr size_t WS_H8 = WS_Y;
constexpr size_t WS_PT = 436 * MiB;
constexpr size_t WS_ZV = 500 * MiB;
constexpr size_t WS_Z0 = 628 * MiB;
constexpr size_t WS_RYT = 692 * MiB;
constexpr size_t WS_YVT = WS_Y;
static_assert(WS_END <= 1024 * MiB, "workspace map");
static_assert(WS_YS + 272 * MiB <= WS_CAT, "YS must not overlay CAT");
constexpr int CW_NTILES = 16;
constexpr int CW_PADSTART = 64;
constexpr int CW_BAR = 4096;
constexpr int MISC_OFF = 160 * 1024 - 64;

constexpr int LDS_BYTES = 160 * 1024;

__device__ __forceinline__ unsigned f2bf(float f) { unsigned u = __builtin_bit_cast(unsigned, f); return (u + 0x7fffu + ((u >> 16) & 1u)) >> 16; }
typedef __bf16 bf16x2_t __attribute__((ext_vector_type(2)));
__device__ __forceinline__ unsigned pk2(float lo, float hi) { const f32x2 v = {lo, hi}; return __builtin_bit_cast(unsigned, __builtin_convertvector(v, bf16x2_t)); }
__device__ __forceinline__ float bf2f(unsigned short b) { return __builtin_bit_cast(float, ((unsigned)b) << 16); }
__device__ __forceinline__ float bflo(unsigned u) { return __builtin_bit_cast(float, u << 16); }
__device__ __forceinline__ float bfhi(unsigned u) { return __builtin_bit_cast(float, u & 0xffff0000u); }
__device__ __forceinline__ float wave_sum(float v) {
#pragma unroll
    for (int o = 1; o < 64; o <<= 1) v += __shfl_xor(v, o);
    return v;
}
__device__ __forceinline__ void lds_barrier() { asm volatile("s_waitcnt lgkmcnt(0)" ::: "memory"); __builtin_amdgcn_s_barrier(); asm volatile("" ::: "memory"); }
__device__ __forceinline__ float sigmoidf_(float x) { return __builtin_amdgcn_rcpf(1.f + __expf(-x)); }

namespace pg8 {
#define PG8_LAS __attribute__((address_space(3)))
constexpr int BM = 256, BK = 64, HALF = 128, HTB = HALF * BK * 2, STAGE_BYTES = 8 * HTB, NXCD = 8, WGM = 8;
__host__ __device__ __forceinline__ int lds_byte(int r, int c) { const int st = (r >> 4) * 2 + (c >> 5), rr = r & 15, cc = c & 31, ob = rr * 64 + cc * 2; return st * 1024 + (ob ^ (((ob >> 9) & 1) << 5)); }
__host__ __device__ __forceinline__ void stage_rc(int b, int& R, int& C) { const int st = b / 1024, sb = b % 1024, swz = sb ^ (((sb >> 9) & 1) << 5); R = (st >> 1) * 16 + swz / 64; C = (st & 1) * 32 + (swz % 64) / 2; }

struct Unit { int pm, pn, e; };
struct Gemm { const bf16* A; const bf16* Bt; int K, N; const int* rowmap; };

struct StaticOrder {
    int nM, nN, nwg, G, c;
    __device__ void init(int M_, int N_, int G_, int c_) { nM = M_ / BM; nN = N_ / BM; nwg = nM * nN; G = G_; c = c_; }
    __device__ bool next(int i, Unit& u) const {
        const long L = (long)i * G + c; if (L >= nwg) return false;
        int wgid = (int)L; { const int q = nwg / NXCD, r = nwg % NXCD, xcd = wgid % NXCD, off = wgid / NXCD; wgid = (xcd < r ? xcd * (q + 1) : r * (q + 1) + (xcd - r) * q) + off; }
        const int nig = WGM * nN, gid = wgid / nig, fm = gid * WGM, gsz = (nM - fm) < WGM ? (nM - fm) : WGM;
        u.pm = fm + ((wgid % nig) % gsz); u.pn = (wgid % nig) / gsz; u.e = 0; return true;
    }
};
struct MoeOrder {
    int nMt, nN, G, c; const int* tile_e;
    __device__ bool next(int i, Unit& u) const {
        const long L = (long)i * G + c; if (L >= (long)nMt * nN) return false;
        u.pm = (int)(L / nN); u.pn = (int)(L % nN); u.e = tile_e[u.pm]; return true;
    }
};

__device__ __forceinline__ unsigned cvt_pk_bf16(float lo, float hi) { unsigned r; asm volatile("v_cvt_pk_bf16_f32 %0, %1, %2" : "=v"(r) : "v"(lo), "v"(hi)); return r; }

struct EpiBf16P {
    bf16* O; int ldc;
    __device__ __forceinline__ void operator()(const f32x4 (&acc)[2][2][4][2], const Unit& u, int wr, int wc, int fr, int fq) const {
        const int row0 = u.pm * BM + wr * 64 + fr, col0 = u.pn * BM + wc * 32 + 8 * fq;
#pragma unroll
        for (int ai = 0; ai < 2; ++ai)
#pragma unroll
            for (int m = 0; m < 4; ++m) { bf16* rowp = O + (size_t)(row0 + ai * HALF + m * 16) * ldc + col0;
#pragma unroll
                for (int bj = 0; bj < 2; ++bj) { const f32x4 v0 = acc[ai][bj][m][0], v1 = acc[ai][bj][m][1];
                    u32x4 w; w.x = cvt_pk_bf16(v0[0], v0[1]); w.y = cvt_pk_bf16(v0[2], v0[3]); w.z = cvt_pk_bf16(v1[0], v1[1]); w.w = cvt_pk_bf16(v1[2], v1[3]);
                    *(u32x4*)(rowp + bj * HALF) = w; } }
    }
};
struct EpiOutProj {
    const float* x; bf16* out; const float* gate;
    __device__ __forceinline__ void operator()(const f32x4 (&acc)[2][2][4][2], const Unit& u, int wr, int wc, int fr, int fq) const {
        const int row0 = u.pm * BM + wr * 64 + fr, col0 = u.pn * BM + wc * 32 + 8 * fq;
        const int b = (u.pm * BM) / T;
        f32x4 gv[2][2];
#pragma unroll
        for (int bj = 0; bj < 2; ++bj)
#pragma unroll
            for (int n = 0; n < 2; ++n) gv[bj][n] = *(const f32x4*)(gate + (size_t)b * 6144 + col0 + bj * HALF + 4 * n);
#pragma unroll
        for (int ai = 0; ai < 2; ++ai)
#pragma unroll
            for (int m = 0; m < 4; ++m) { const size_t ro = (size_t)(row0 + ai * HALF + m * 16) * D + col0;
#pragma unroll
                for (int bj = 0; bj < 2; ++bj) { const f32x4 x0 = __builtin_nontemporal_load((const f32x4*)(x + ro + bj * HALF)), x1 = __builtin_nontemporal_load((const f32x4*)(x + ro + bj * HALF + 4));
                    const f32x4 v0 = x0 + gv[bj][0] * acc[ai][bj][m][0], v1 = x1 + gv[bj][1] * acc[ai][bj][m][1];
                    u32x4 w; w.x = cvt_pk_bf16(v0[0], v0[1]); w.y = cvt_pk_bf16(v0[2], v0[3]); w.z = cvt_pk_bf16(v1[0], v1[1]); w.w = cvt_pk_bf16(v1[2], v1[3]);
                    *(u32x4*)(out + ro + bj * HALF) = w; } }
    }
};
__device__ __forceinline__ unsigned pk4_fp8(float a, float b, float c, float d) { int w = 0; w = __builtin_amdgcn_cvt_pk_fp8_f32(a, b, w, false); w = __builtin_amdgcn_cvt_pk_fp8_f32(c, d, w, true); return (unsigned)w; }
constexpr float W8_SCALE = 32.f, W8_INV = 1.f / 32.f;
struct EpiMoe1 {
    unsigned char* act; const float* b1;
    __device__ __forceinline__ void operator()(const f32x4 (&acc)[2][2][4][2], const Unit& u, int wr, int wc, int fr, int fq) const {
        const int row0 = u.pm * BM + wr * 64 + fr, j0 = u.pn * 128 + wc * 16 + 4 * fq;
        const float* bb = b1 + (size_t)u.e * 2048;
        f32x4 bg[2], bl[2];
#pragma unroll
        for (int bj = 0; bj < 2; ++bj) { bg[bj] = *(const f32x4*)(bb + j0 + bj * 64); bl[bj] = *(const f32x4*)(bb + 1024 + j0 + bj * 64); }
#pragma unroll
        for (int ai = 0; ai < 2; ++ai)
#pragma unroll
            for (int m = 0; m < 4; ++m) { unsigned char* rowp = act + ((size_t)(row0 + ai * HALF + m * 16) * DE + j0) * (MK_FP8 ? 1 : 2);
#pragma unroll
                for (int bj = 0; bj < 2; ++bj) { const f32x4 g4 = acc[ai][bj][m][0] * (MK_FP8 ? W8_INV : 1.f) + bg[bj], l4 = acc[ai][bj][m][1] * (MK_FP8 ? W8_INV : 1.f) + bl[bj]; float a[4];
#pragma unroll
                    for (int q = 0; q < 4; ++q) { const float gl = fminf(g4[q], 7.0f), li = fminf(fmaxf(l4[q], -7.0f), 7.0f);
                        a[q] = gl * __builtin_amdgcn_rcpf(1.f + __expf(-1.702f * gl)) * (li + 1.f); }
#if MK_FP8
                    *(unsigned*)(rowp + bj * 64) = pk4_fp8(a[0], a[1], a[2], a[3]);
#else
                    u32x2 w; w.x = cvt_pk_bf16(a[0], a[1]); w.y = cvt_pk_bf16(a[2], a[3]); *(u32x2*)(rowp + bj * 128) = w;
#endif
                } }
    }
};
struct EpiMoe2 {
    bf16* ys; const float* b2; const float* sgate;
    __device__ __forceinline__ void operator()(const f32x4 (&acc)[2][2][4][2], const Unit& u, int wr, int wc, int fr, int fq) const {
        const int row0 = u.pm * BM + wr * 64 + fr, col0 = u.pn * BM + wc * 32 + 8 * fq;
        const float* bb = b2 + (size_t)u.e * 1024;
        f32x4 bv[2][2];
#pragma unroll
        for (int bj = 0; bj < 2; ++bj)
#pragma unroll
            for (int n = 0; n < 2; ++n) bv[bj][n] = *(const f32x4*)(bb + col0 + bj * HALF + 4 * n);
#pragma unroll
        for (int ai = 0; ai < 2; ++ai)
#pragma unroll
            for (int m = 0; m < 4; ++m) { const int row = row0 + ai * HALF + m * 16; const float gt = sgate[row]; bf16* rowp = ys + (size_t)row * D + col0;
#pragma unroll
                for (int bj = 0; bj < 2; ++bj) { const f32x4 v0 = (acc[ai][bj][m][0] * (MK_FP8 ? W8_INV : 1.f) + bv[bj][0]) * gt, v1 = (acc[ai][bj][m][1] * (MK_FP8 ? W8_INV : 1.f) + bv[bj][1]) * gt;
                    u32x4 w; w.x = cvt_pk_bf16(v0[0], v0[1]); w.y = cvt_pk_bf16(v0[2], v0[3]); w.z = cvt_pk_bf16(v1[0], v1[1]); w.w = cvt_pk_bf16(v1[2], v1[3]);
                    *(u32x4*)(rowp + bj * HALF) = w; } }
    }
};

template <class Epi, class Sched, bool GATHER, bool FP8 = false>
__device__ __forceinline__ void gemm_phase(PG8_LAS unsigned char* lds, const Gemm g, const Sched& S, const Epi& E) {
    const int tid = threadIdx.x, wid = __builtin_amdgcn_readfirstlane(tid >> 6), lane = tid & 63, wr = wid >> 2, wc = wid & 3, fr = lane & 15, fq = lane >> 4;
    const int K = g.K, nt = K / BK;
    int Rr[2], Cc[2]; unsigned voffB[2];
#pragma unroll
    for (int i = 0; i < 2; ++i) { stage_rc(tid * 16 + i * 8192, Rr[i], Cc[i]); voffB[i] = (unsigned)(Rr[i] * K + Cc[i]) * 2u; }
    const size_t kstep = (size_t)(BK * 2);
    const size_t hstep = (size_t)HALF * K * 2;
    const size_t tstep = 2 * hstep;
    const unsigned ldsw = (unsigned)wid * 1024u;
    const int aoff = lds_byte(wr * 64 + fr, fq * 8), boff = lds_byte(wc * 32 + fr, fq * 8);
#define PG8_SA(b, h) (((b) * 2 + (h)) * HTB)
#define PG8_SB(b, h) ((4 + (b) * 2 + (h)) * HTB)
#define PG8_STAGE(bufoff, gbase, voff) do { _Pragma("unroll") for (int _i = 0; _i < 2; ++_i) \
        __builtin_amdgcn_global_load_lds((const unsigned*)((const char*)(gbase) + (voff)[_i]), (PG8_LAS unsigned*)(lds + (bufoff) + ldsw + _i * 8192), 16, 0, 0); } while (0)
#define PG8_LDA(dst, b, h) do { _Pragma("unroll") for (int m = 0; m < 4; ++m) { const PG8_LAS i32x4* _p = (const PG8_LAS i32x4*)(lds + PG8_SA(b, h) + aoff + m * 2048); \
        dst[m] = __builtin_shufflevector(_p[0], _p[64], 0, 1, 2, 3, 4, 5, 6, 7); } } while (0)
#define PG8_LDB(dst, b, h) do { _Pragma("unroll") for (int n = 0; n < 2; ++n) { const PG8_LAS i32x4* _p = (const PG8_LAS i32x4*)(lds + PG8_SB(b, h) + boff + n * 2048); \
        dst[n] = __builtin_shufflevector(_p[0], _p[64], 0, 1, 2, 3, 4, 5, 6, 7); } } while (0)
#define PG8_MMA(ai, bj, At, Bt) do { __builtin_amdgcn_s_setprio(1); _Pragma("unroll") for (int m = 0; m < 4; ++m) _Pragma("unroll") for (int n = 0; n < 2; ++n) { \
        if constexpr (FP8)   \
            asm volatile("v_mfma_scale_f32_16x16x128_f8f6f4 %0, %1, %2, %0, %3, %3 op_sel_hi:[0,0,0]" : "+v"(acc[ai][bj][m][n]) : "v"(Bt[n]), "v"(At[m]), "v"(0x7F7F7F7F)); \
        else { acc[ai][bj][m][n] = __builtin_amdgcn_mfma_f32_16x16x32_bf16(__builtin_bit_cast(bf16x8, __builtin_shufflevector(Bt[n], Bt[n], 0, 1, 2, 3)), __builtin_bit_cast(bf16x8, __builtin_shufflevector(At[m], At[m], 0, 1, 2, 3)), acc[ai][bj][m][n], 0, 0, 0); \
               acc[ai][bj][m][n] = __builtin_amdgcn_mfma_f32_16x16x32_bf16(__builtin_bit_cast(bf16x8, __builtin_shufflevector(Bt[n], Bt[n], 4, 5, 6, 7)), __builtin_bit_cast(bf16x8, __builtin_shufflevector(At[m], At[m], 4, 5, 6, 7)), acc[ai][bj][m][n], 0, 0, 0); } } \
        __builtin_amdgcn_s_setprio(0); \
        if constexpr (FP8) asm volatile("" : "+v"(acc[ai][bj][0][0]), "+v"(acc[ai][bj][0][1]), "+v"(acc[ai][bj][1][0]), "+v"(acc[ai][bj][1][1]), "+v"(acc[ai][bj][2][0]), "+v"(acc[ai][bj][2][1]), "+v"(acc[ai][bj][3][0]), "+v"(acc[ai][bj][3][1]));   \
        } while (0)
#define PG8_WAIT_V(n) asm volatile("s_waitcnt vmcnt(" #n ")" ::: "memory")
#define PG8_WAIT_L(n) asm volatile("s_waitcnt lgkmcnt(" #n ")" ::: "memory")
#define PG8_BAR __builtin_amdgcn_s_barrier()
#define PG8_SCHED __builtin_amdgcn_sched_barrier(0)
#define PG8_AOFFS(dst, u) do { _Pragma("unroll") for (int _h = 0; _h < 2; ++_h) _Pragma("unroll") for (int _i = 0; _i < 2; ++_i) { int _R, _C; stage_rc((int)threadIdx.x * 16 + _i * 8192, _R, _C); \
        if constexpr (GATHER) { const int _tok = g.rowmap[(u).pm * BM + _h * HALF + _R]; dst[_h][_i] = (unsigned)(_tok * K + _C) * 2u; } \
        else dst[_h][_i] = (unsigned)((_h * HALF + _R) * K + _C) * 2u; } } while (0)
#define PG8_ABASE(u) (GATHER ? (const char*)g.A : (const char*)g.A + (size_t)(u).pm * tstep)
#define PG8_BBASE(u) ((const char*)g.Bt + ((size_t)(u).e * g.N + (size_t)(u).pn * BM) * K * 2)
    Unit cur, nxt, nn; int ui = 0;
    if (!S.next(0, cur)) return;
    bool has_next = S.next(1, nxt);
    unsigned curA[2][2], nxtA[2][2];
    PG8_AOFFS(curA, cur);
    if (has_next) PG8_AOFFS(nxtA, nxt); else {
#pragma unroll
        for (int h = 0; h < 2; ++h)
#pragma unroll
            for (int i = 0; i < 2; ++i) nxtA[h][i] = curA[h][i]; }
    f32x4 acc[2][2][4][2];
#pragma unroll
    for (int a = 0; a < 2; ++a)
#pragma unroll
        for (int b = 0; b < 2; ++b)
#pragma unroll
            for (int m = 0; m < 4; ++m)
#pragma unroll
                for (int n = 0; n < 2; ++n) acc[a][b][m][n] = (f32x4){0.f, 0.f, 0.f, 0.f};
    i32x8 At[4], B0[2], B1[2];
    const char* cA = PG8_ABASE(cur); const char* cB = PG8_BBASE(cur);
    PG8_STAGE(PG8_SB(0, 0), cB, voffB); PG8_STAGE(PG8_SB(0, 1), cB + hstep, voffB); PG8_STAGE(PG8_SA(0, 0), cA, curA[0]); PG8_STAGE(PG8_SA(0, 1), cA, curA[1]);
    if (wr == 1) PG8_BAR;
    PG8_WAIT_V(2); PG8_BAR;
    PG8_STAGE(PG8_SB(1, 0), cB + kstep, voffB); PG8_STAGE(PG8_SA(1, 0), cA + kstep, curA[0]); PG8_STAGE(PG8_SB(1, 1), cB + hstep + kstep, voffB);
    PG8_WAIT_V(6); PG8_BAR;
    for (;;) {
        const char* nA = has_next ? PG8_ABASE(nxt) : cA; const char* nB = has_next ? PG8_BBASE(nxt) : cB;
#pragma unroll 1
        for (int t = 0; t < nt; t += 2) {
            const bool last = (t == nt - 2);
            const char* a1 = cA + (size_t)(t + 1) * kstep;
            const char* a2 = last ? nA : cA + (size_t)(t + 2) * kstep; const char* b2 = last ? nB : cB + (size_t)(t + 2) * kstep;
            const char* a3 = a2 + kstep; const char* b3 = b2 + kstep;
            unsigned o2[2][2];
#pragma unroll
            for (int h = 0; h < 2; ++h)
#pragma unroll
                for (int i = 0; i < 2; ++i) o2[h][i] = last ? nxtA[h][i] : curA[h][i];
            PG8_LDB(B0, 0, 0); PG8_LDB(B1, 0, 1); PG8_SCHED; PG8_LDA(At, 0, 0); PG8_STAGE(PG8_SA(1, 1), a1, curA[1]);
            PG8_WAIT_V(8); PG8_WAIT_L(0); PG8_BAR; PG8_MMA(0, 0, At, B0); PG8_MMA(0, 1, At, B1); PG8_BAR; PG8_SCHED;
            PG8_LDA(At, 0, 1); PG8_STAGE(PG8_SB(0, 0), b2, voffB); PG8_STAGE(PG8_SB(0, 1), b2 + hstep, voffB); PG8_STAGE(PG8_SA(0, 0), a2, o2[0]);
            PG8_WAIT_V(8); PG8_WAIT_L(0); PG8_BAR; PG8_MMA(1, 0, At, B0); PG8_MMA(1, 1, At, B1); PG8_BAR; PG8_SCHED;
            PG8_LDB(B0, 1, 0); PG8_LDB(B1, 1, 1); PG8_SCHED; PG8_LDA(At, 1, 0); PG8_STAGE(PG8_SA(0, 1), a2, o2[1]);
            PG8_WAIT_V(8); PG8_WAIT_L(0); PG8_BAR; PG8_MMA(0, 0, At, B0); PG8_MMA(0, 1, At, B1); PG8_BAR; PG8_SCHED;
            PG8_LDA(At, 1, 1); PG8_STAGE(PG8_SB(1, 0), b3, voffB); PG8_STAGE(PG8_SB(1, 1), b3 + hstep, voffB); PG8_STAGE(PG8_SA(1, 0), a3, o2[0]);
            PG8_WAIT_V(8); PG8_WAIT_L(0); PG8_BAR; PG8_MMA(1, 0, At, B0); PG8_MMA(1, 1, At, B1); PG8_BAR; PG8_SCHED;
        }
        if constexpr (FP8) asm volatile("s_nop 15\n\ts_nop 15" ::: "memory");
        if (wr == 0) PG8_BAR;
        const bool has_nn = has_next && S.next(ui + 2, nn);
        unsigned nnA[2][2];
        if (has_nn) PG8_AOFFS(nnA, nn);
        E(acc, cur, wr, wc, fr, fq);
        if (!has_next) break;
#pragma unroll
        for (int a = 0; a < 2; ++a)
#pragma unroll
            for (int b = 0; b < 2; ++b)
#pragma unroll
                for (int m = 0; m < 4; ++m)
#pragma unroll
                    for (int n = 0; n < 2; ++n) acc[a][b][m][n] = (f32x4){0.f, 0.f, 0.f, 0.f};
        cur = nxt; cA = nA; cB = nB; ++ui;
#pragma unroll
        for (int h = 0; h < 2; ++h)
#pragma unroll
            for (int i = 0; i < 2; ++i) { curA[h][i] = nxtA[h][i]; if (has_nn) nxtA[h][i] = nnA[h][i]; }
        nxt = nn; has_next = has_nn;
        if (wr == 1) PG8_BAR;
    }
    PG8_WAIT_V(0);
    PG8_BAR;
#undef PG8_SA
#undef PG8_SB
#undef PG8_STAGE
#undef PG8_LDA
#undef PG8_LDB
#undef PG8_MMA
#undef PG8_WAIT_V
#undef PG8_WAIT_L
#undef PG8_BAR
#undef PG8_SCHED
#undef PG8_AOFFS
#undef PG8_ABASE
#undef PG8_BBASE
}
}

struct Frame {
    LAS unsigned char* lds;
    int tid, lane, wave, vcu, G;
    const float* const* in;
    float* out;
    unsigned char* ws;
};
template <class Tp> __device__ __forceinline__ Tp* wsp(const Frame& F, size_t off) { return (Tp*)(F.ws + off); }

__device__ __forceinline__ int dest_row(int mode, int s) {
    if (mode == 0) return s;
    if (mode == 1) return (s & ~31) | (((s >> 2) & 1) << 4) | (((s >> 3) & 3) << 2) | (s & 3);
    const int half = s >> 10, j = s & 1023;
    return ((j >> 7) << 8) | (((j >> 6) & 1) << 7) | (((j >> 4) & 3) << 5) | (half << 4) | (j & 15);
}
__device__ __forceinline__ void transpose_item(const float* W, int K, int N, bf16* WT, int mode, int item, int lane) {
    const int nblk = N / 64, kb = item / nblk, nb = item % nblk, k0 = 64 * kb, n0 = 64 * nb;
    const float* src = W + (size_t)k0 * N + n0 + lane;
    float v[64];
#pragma unroll
    for (int i = 0; i < 64; ++i) v[i] = src[(size_t)i * N];
    bf16* dst = WT + (size_t)dest_row(mode, n0 + lane) * K + k0;
#pragma unroll
    for (int j = 0; j < 8; ++j) { u32x4 o; o.x = pk2(v[8 * j], v[8 * j + 1]); o.y = pk2(v[8 * j + 2], v[8 * j + 3]); o.z = pk2(v[8 * j + 4], v[8 * j + 5]); o.w = pk2(v[8 * j + 6], v[8 * j + 7]);
        *(u32x4*)(dst + 8 * j) = o; }
}
__device__ __forceinline__ void transpose_item8(const float* W, int K, int N, unsigned char* WT, int mode, int item, int lane) {
    const int nblk = N / 64, kb = item / nblk, nb = item % nblk, k0 = 64 * kb, n0 = 64 * nb;
    const float* src = W + (size_t)k0 * N + n0 + lane;
    float v[64];
#pragma unroll
    for (int i = 0; i < 64; ++i) v[i] = __builtin_nontemporal_load(src + (size_t)i * N) * 32.f;
    unsigned char* dst = WT + (size_t)dest_row(mode, n0 + lane) * K + k0;
#pragma unroll
    for (int j = 0; j < 4; ++j) { u32x4 o; o.x = pg8::pk4_fp8(v[16 * j], v[16 * j + 1], v[16 * j + 2], v[16 * j + 3]); o.y = pg8::pk4_fp8(v[16 * j + 4], v[16 * j + 5], v[16 * j + 6], v[16 * j + 7]);
        o.z = pg8::pk4_fp8(v[16 * j + 8], v[16 * j + 9], v[16 * j + 10], v[16 * j + 11]); o.w = pg8::pk4_fp8(v[16 * j + 12], v[16 * j + 13], v[16 * j + 14], v[16 * j + 15]);
        *(u32x4*)(dst + 16 * j) = o; }
}
constexpr int MOE_I1 = 16 * 32, MOE_I2 = 16 * 16, MOE_ITEMS = NE * (MOE_I1 + MOE_I2);
__device__ __forceinline__ void moe_weight_item(const Frame& F, int it) {
#if !MK_FP8
    if (it < NE * MOE_I1) { const int e = it / MOE_I1; transpose_item(F.in[24] + (size_t)e * 1024 * 2048, 1024, 2048, wsp<bf16>(F, WS_W1) + (size_t)e * 2048 * 1024, 2, it % MOE_I1, F.lane); }
    else { const int r = it - NE * MOE_I1, e = r / MOE_I2; transpose_item(F.in[26] + (size_t)e * 1024 * 1024, 1024, 1024, wsp<bf16>(F, WS_W2) + (size_t)e * 1024 * 1024, 1, r % MOE_I2, F.lane); }
#else
    if (it < NE * MOE_I1) { const int e = it / MOE_I1; transpose_item8(F.in[24] + (size_t)e * 1024 * 2048, 1024, 2048, wsp<unsigned char>(F, WS_W1) + (size_t)e * 2048 * 1024, 2, it % MOE_I1, F.lane); }
    else { const int r = it - NE * MOE_I1, e = r / MOE_I2; transpose_item8(F.in[26] + (size_t)e * 1024 * 1024, 1024, 1024, wsp<unsigned char>(F, WS_W2) + (size_t)e * 1024 * 1024, 1, r % MOE_I2, F.lane); }
#endif
}

__device__ __forceinline__ void phase0(const Frame& F) {
    if (F.vcu < 192) {
        LAS float* sl = (LAS float*)F.lds;
        LAS float* red = (LAS float*)(F.lds + 32768);
        const float* c = F.in[1];
        for (int idx = F.tid; idx < 8192; idx += 512) { const int b = idx & 7, k = idx >> 3; const float cv = c[b * 1024 + k]; sl[idx] = cv / (1.f + __expf(-cv)); }
        __syncthreads();
        const int cl = F.tid & 31, ks = F.tid >> 5, col = F.vcu * 32 + cl;
        const float* wa = F.in[2];
        float acc[8];
#pragma unroll
        for (int b = 0; b < 8; ++b) acc[b] = 0.f;
#pragma unroll 4
        for (int kk = 0; kk < 64; ++kk) { const int k = ks * 64 + kk; const float w = wa[(size_t)k * 6144 + col];
            const f32x4 s0 = *(const LAS f32x4*)(sl + k * 8), s1 = *(const LAS f32x4*)(sl + k * 8 + 4);
            acc[0] += s0[0] * w; acc[1] += s0[1] * w; acc[2] += s0[2] * w; acc[3] += s0[3] * w;
            acc[4] += s1[0] * w; acc[5] += s1[1] * w; acc[6] += s1[2] * w; acc[7] += s1[3] * w; }
#pragma unroll
        for (int b = 0; b < 8; ++b) red[(ks * 32 + cl) * 8 + b] = acc[b];
        __syncthreads();
        if (F.tid < 256) { const int b = F.tid >> 5; float s = F.in[3][col];
            for (int q = 0; q < 16; ++q) s += red[(q * 32 + cl) * 8 + b];
            wsp<float>(F, WS_MOD)[b * 6144 + col] = s; }
    }
    const int gw = F.vcu * 8 + F.wave, NGW = F.G * 8;
    constexpr int I_IN = 16 * 40, I_OUT = 16 * 16;
    constexpr int NITEMS = I_IN + I_OUT;
    for (int it = gw; it < NITEMS; it += NGW) {
        int r = it;
        if (r < I_IN) { transpose_item(F.in[5], 1024, 2560, wsp<bf16>(F, WS_WIN), 1, r, F.lane); continue; } r -= I_IN;
        transpose_item(F.in[20], 1024, 1024, wsp<bf16>(F, WS_WOUT), 1, r, F.lane);
    }
#if MK_CONV_WHERE == 0
    for (int it = gw; it < MOE_ITEMS; it += NGW) moe_weight_item(F, it);
#endif
    { bf16* LW = wsp<bf16>(F, WS_LW);
        for (int idx = F.vcu * 512 + F.tid; idx < 256 * 512; idx += F.G * 512) { const int k = idx >> 9, c = idx & 511;
            const float v = k < 64 ? F.in[8][k * 512 + c] : (k < 128 ? F.in[10][(k - 64) * 512 + c] : F.in[11][(k - 128) * 512 + c]);
            LW[c * 256 + k] = (bf16)f2bf(v); } }
}
template <bool OUT8 = false, bool IN16 = false>
__device__ __forceinline__ void norm_row(const Frame& F, const float* xrow, const float* g, const float* shift, const float* scale, bf16* orow, f32x4 (&h)[4]) {
    const f32x4* xr = (const f32x4*)xrow + F.lane; const u32x2* xr16 = (const u32x2*)xrow + F.lane;
    float ss = 0.f;
#pragma unroll
    for (int j = 0; j < 4; ++j) { if constexpr (IN16) { const u32x2 q = __builtin_nontemporal_load(xr16 + 64 * j); h[j] = (f32x4){bflo(q.x), bfhi(q.x), bflo(q.y), bfhi(q.y)}; } else h[j] = __builtin_nontemporal_load(xr + 64 * j); ss += (h[j][0] * h[j][0] + h[j][1] * h[j][1]) + (h[j][2] * h[j][2] + h[j][3] * h[j][3]); }
    const float rstd = rsqrtf(wave_sum(ss) * (1.f / D) + NORM_EPS);
    u32x2* o8 = (u32x2*)orow + F.lane;
#pragma unroll
    for (int j = 0; j < 4; ++j) { const int col = 4 * F.lane + 256 * j;
        const f32x4 gv = *(const f32x4*)(g + col), sh = *(const f32x4*)(shift + col), sc = *(const f32x4*)(scale + col);
        h[j] = h[j] * rstd * gv * (sc + 1.f) + sh;
        if constexpr (OUT8) ((unsigned*)orow)[F.lane + 64 * j] = pg8::pk4_fp8(h[j][0], h[j][1], h[j][2], h[j][3]);
        else { u32x2 w; w.x = pk2(h[j][0], h[j][1]); w.y = pk2(h[j][2], h[j][3]); o8[64 * j] = w; } }
}
__device__ __forceinline__ void phase1(const Frame& F) {
    const int gw = F.vcu * 8 + F.wave, NGW = F.G * 8;
    const float* mod = wsp<float>(F, WS_MOD);
    for (int row = gw; row < M; row += NGW) { const int b = row / T; f32x4 h[4];
        norm_row(F, F.in[0] + (size_t)row * D, F.in[4], mod + b * 6144, mod + b * 6144 + 1024, wsp<bf16>(F, WS_H) + (size_t)row * D, h); }
}

template <int CTRL> __device__ __forceinline__ float dpp_mov(float v) { return __builtin_bit_cast(float, __builtin_amdgcn_update_dpp(0, __builtin_bit_cast(int, v), CTRL, 0xf, 0xf, false)); }
__device__ __forceinline__ float reduce16(float v) { v += dpp_mov<0xB1>(v); v += dpp_mov<0x4E>(v); v += dpp_mov<0x141>(v); v += dpp_mov<0x140>(v); return v; }
__device__ __forceinline__ void lerp8(const bf16* P, const float* mu, int tok, int t, int col, float (&x)[8]) {
    const u32x4 c = *(const u32x4*)(P + (size_t)tok * IN_COLS + col);
    u32x4 p = (u32x4){0u, 0u, 0u, 0u};
    if (t > 0) p = *(const u32x4*)(P + (size_t)(tok - 1) * IN_COLS + col);
    const f32x4 m0 = *(const f32x4*)(mu + col), m1 = *(const f32x4*)(mu + col + 4);
    const float cf[8] = {bflo(c.x), bfhi(c.x), bflo(c.y), bfhi(c.y), bflo(c.z), bfhi(c.z), bflo(c.w), bfhi(c.w)};
    const float pf[8] = {bflo(p.x), bfhi(p.x), bflo(p.y), bfhi(p.y), bflo(p.z), bfhi(p.z), bflo(p.w), bfhi(p.w)};
    const float mf[8] = {m0[0], m0[1], m0[2], m0[3], m1[0], m1[1], m1[2], m1[3]};
#pragma unroll
    for (int j = 0; j < 8; ++j) x[j] = cf[j] + (pf[j] - cf[j]) * mf[j];
}
__device__ __forceinline__ f32x4 lerp4(const bf16* P, const float* mu, int tok, int t, int col) {
    const u32x2 c = *(const u32x2*)(P + (size_t)tok * IN_COLS + col);
    u32x2 p = (u32x2){0u, 0u};
    if (t > 0) p = *(const u32x2*)(P + (size_t)(tok - 1) * IN_COLS + col);
    const f32x4 m = *(const f32x4*)(mu + col);
    const f32x4 cf = (f32x4){bflo(c.x), bfhi(c.x), bflo(c.y), bfhi(c.y)}, pf = (f32x4){bflo(p.x), bfhi(p.x), bflo(p.y), bfhi(p.y)};
    return cf + (pf - cf) * m;
}
__device__ __forceinline__ bf16x8 pack8(const float (&x)[8]) { u32x4 w; w.x = pk2(x[0], x[1]); w.y = pk2(x[2], x[3]); w.z = pk2(x[4], x[5]); w.w = pk2(x[6], x[7]); return __builtin_bit_cast(bf16x8, w); }
__device__ __forceinline__ void phase3(const Frame& F) {
    const bf16* P = wsp<bf16>(F, WS_P); const bf16* LW = wsp<bf16>(F, WS_LW);
    const float* mu = F.in[6]; const float* w0 = F.in[7]; const float* a0 = F.in[9];
    const float* k_k = F.in[12]; const float* k_a = F.in[13]; const float* r_k = F.in[14];
    float* SCN = wsp<float>(F, WS_SCN); float* SV = wsp<float>(F, WS_SV); bf16* G = wsp<bf16>(F, WS_G); float* BON = wsp<float>(F, WS_BONUS);
    const int gw = F.vcu * 8 + F.wave, NGW = F.G * 8;
    const int cl = F.lane & 15, q = F.lane >> 4;
    for (int tile = gw; tile < M / 16; tile += NGW) {
        bf16x8 Aw[2], Aa[2], Ag[4];
        { const int tok = tile * 16 + cl, t = tok % T; float x[8];
#pragma unroll
            for (int s = 0; s < 2; ++s) { lerp8(P, mu, tok, t, 1536 + 32 * s + 8 * q, x);
#pragma unroll
                for (int j = 0; j < 8; ++j) x[j] = tanhf(x[j]);
                Aw[s] = pack8(x);
                lerp8(P, mu, tok, t, 1600 + 32 * s + 8 * q, x); Aa[s] = pack8(x); }
#pragma unroll
            for (int s = 0; s < 4; ++s) { lerp8(P, mu, tok, t, 1664 + 32 * s + 8 * q, x);
#pragma unroll
                for (int j = 0; j < 8; ++j) x[j] = sigmoidf_(x[j]);
                Ag[s] = pack8(x); } }
        const int tk0 = tile * 16 + 4 * q, b = tk0 / T, t0 = tk0 % T;
#pragma unroll 1
        for (int hh = 0; hh < RH; ++hh) {
            const int c0 = hh * 64 + cl * 4;
            f32x4 accw[4], acca[4], accg[4];
#pragma unroll
            for (int ct = 0; ct < 4; ++ct) { const bf16* lw = LW + (size_t)(c0 + ct) * 256 + 8 * q;
                f32x4 aw = (f32x4){0.f, 0.f, 0.f, 0.f}, aa = aw, ag = aw;
#pragma unroll
                for (int s = 0; s < 2; ++s) { aw = __builtin_amdgcn_mfma_f32_16x16x32_bf16(Aw[s], *(const bf16x8*)(lw + 32 * s), aw, 0, 0, 0);
                    aa = __builtin_amdgcn_mfma_f32_16x16x32_bf16(Aa[s], *(const bf16x8*)(lw + 64 + 32 * s), aa, 0, 0, 0); }
#pragma unroll
                for (int s = 0; s < 4; ++s) ag = __builtin_amdgcn_mfma_f32_16x16x32_bf16(Ag[s], *(const bf16x8*)(lw + 128 + 32 * s), ag, 0, 0, 0);
                accw[ct] = aw; acca[ct] = aa; accg[ct] = ag; }
            const f32x4 w0v = *(const f32x4*)(w0 + c0), a0v = *(const f32x4*)(a0 + c0), kkv = *(const f32x4*)(k_k + c0), kav = *(const f32x4*)(k_a + c0), rkv = *(const f32x4*)(r_k + c0);
#pragma unroll
            for (int i = 0; i < 4; ++i) { const int tk = tk0 + i, t = t0 + i;
                const f32x4 r4 = lerp4(P, mu, tk, t, c0), kr4 = lerp4(P, mu, tk, t, 512 + c0), v4 = lerp4(P, mu, tk, t, 1024 + c0);
                f32x4 dec, av, gv, kk4, k4;
                float ssq = 0.f, bon = 0.f;
#pragma unroll
                for (int ct = 0; ct < 4; ++ct) {
                    dec[ct] = __expf(-0.60653066f * sigmoidf_(w0v[ct] + accw[ct][i]));
                    av[ct] = sigmoidf_(a0v[ct] + acca[ct][i]);
                    gv[ct] = accg[ct][i];
                    kk4[ct] = kr4[ct] * kkv[ct]; ssq += kk4[ct] * kk4[ct];
                    k4[ct] = kr4[ct] * (1.f + (av[ct] - 1.f) * kav[ct]);
                    bon += r4[ct] * k4[ct] * rkv[ct]; }
                ssq = reduce16(ssq); bon = reduce16(bon);
                const float inv = __builtin_amdgcn_rcpf(fmaxf(sqrtf(ssq), 1e-12f));
                const f32x4 kkn = kk4 * inv, bb = kkn * av;
                const size_t so = ((size_t)(b * RH + hh) * T + t) * 64 + cl * 4;
                float* sc = SCN + ((size_t)(b * RH + hh) * T + t) * 320 + cl * 4;
                *(f32x4*)(sc) = dec; *(f32x4*)(sc + 64) = kkn; *(f32x4*)(sc + 128) = bb; *(f32x4*)(sc + 192) = k4; *(f32x4*)(sc + 256) = r4;
                *(f32x4*)(SV + so) = v4;
                u32x2 gw2; gw2.x = pk2(gv[0], gv[1]); gw2.y = pk2(gv[2], gv[3]);
                *(u32x2*)(G + (size_t)tk * 512 + c0) = gw2;
                if (cl == 0) BON[tk * 8 + hh] = bon; }
        }
    }
}

constexpr int CK = 32, NCHK = T / CK;
#define SC_SPIN_CAP (1 << 24)
#define MFMA32(a, b, c) __builtin_amdgcn_mfma_f32_32x32x16_bf16((a), (b), (c), 0, 0, 0)
__device__ __forceinline__ int crow(int i, int h) { return (i & 3) + 8 * (i >> 2) + 4 * h; }
template <int S_> __device__ __forceinline__ bf16x8 pack_acc(const f32x16& x) { u32x4 w; w.x = pk2(x[8 * S_], x[8 * S_ + 1]); w.y = pk2(x[8 * S_ + 2], x[8 * S_ + 3]); w.z = pk2(x[8 * S_ + 4], x[8 * S_ + 5]); w.w = pk2(x[8 * S_ + 6], x[8 * S_ + 7]); return __builtin_bit_cast(bf16x8, w); }
__device__ __forceinline__ bf16x8 rd_nat(const LAS bf16* img, int stride, int row, int k0) { return *(const LAS bf16x8*)(img + row * stride + k0); }
__device__ __forceinline__ bf16x8 rd_perm(const LAS bf16* img, int stride, int row, int kb, int h) {
    const u32x2 lo = *(const LAS u32x2*)(img + row * stride + kb + 4 * h), hi = *(const LAS u32x2*)(img + row * stride + kb + 8 + 4 * h);
    u32x4 w; w.x = lo.x; w.y = lo.y; w.z = hi.x; w.w = hi.y; return __builtin_bit_cast(bf16x8, w);
}
__device__ __forceinline__ f32x16 zero16() { f32x16 z; for (int i = 0; i < 16; ++i) z[i] = 0.f; return z; }
constexpr int CL_A = 0, CL_B = 4608, CL_K = 9216, CL_R = 13824, CL_AT = 18432, CL_BHT = 23552, CL_KHT = 28672, CL_VT = 33792, CL_GTOT = 38912, CL_GC = 39936,
              CL_L = 40192, CL_T = 44800, CL_FNRB = 47360, CL_CNRK = 49408, CL_FQM = 53504, CL_GROUP = 57600;
constexpr int RMS = 72, TRS = 40, LST = 36;
__device__ __forceinline__ void phase4a_summaries(const Frame& F) {
    const float* SCN = wsp<float>(F, WS_SCN); const float* SV = wsp<float>(F, WS_SV);
    bf16x8* PT = wsp<bf16x8>(F, WS_PT); f32x4* ZV = wsp<f32x4>(F, WS_ZV); bf16x8* RYT = wsp<bf16x8>(F, WS_RYT); f32x4* YVT = wsp<f32x4>(F, WS_YVT);
    const int grp = F.tid >> 8, gt = F.tid & 255, w4 = F.wave & 3, lane = F.lane, r = lane & 31, h = lane >> 5;
    LAS unsigned char* gl = F.lds + grp * CL_GROUP;
    LAS bf16* iA = (LAS bf16*)(gl + CL_A); LAS bf16* iB = (LAS bf16*)(gl + CL_B); LAS bf16* iK = (LAS bf16*)(gl + CL_K); LAS bf16* iR = (LAS bf16*)(gl + CL_R);
    LAS bf16* iAT = (LAS bf16*)(gl + CL_AT); LAS bf16* iBHT = (LAS bf16*)(gl + CL_BHT); LAS bf16* iKHT = (LAS bf16*)(gl + CL_KHT); LAS bf16* iVT = (LAS bf16*)(gl + CL_VT);
    LAS float* gtot = (LAS float*)(gl + CL_GTOT); LAS float* gcv = (LAS float*)(gl + CL_GC); LAS float* Lm = (LAS float*)(gl + CL_L); LAS bf16* Tm = (LAS bf16*)(gl + CL_T);
    LAS bf16x8* fnrb = (LAS bf16x8*)(gl + CL_FNRB); LAS float* cnrk = (LAS float*)(gl + CL_CNRK); LAS bf16x8* fqm = (LAS bf16x8*)(gl + CL_FQM);
    constexpr int NCHUNKS = NBATCH * RH * NCHK;
    for (int it = F.vcu; it < NCHUNKS / 2; it += F.G) {
        const int chunk = it * 2 + grp, bh = chunk / NCHK, c = chunk % NCHK, t0 = c * CK;
        __syncthreads();
        { const int k = gt & 63, tq = gt >> 6;
            float wv[8], kkv[8], bv[8], kv[8], rv[8], vv[8], lp[8];
#pragma unroll
            for (int i = 0; i < 8; ++i) { const size_t row = (size_t)bh * T + t0 + 8 * tq + i; const float* sc = SCN + row * 320 + k;
                wv[i] = sc[0]; kkv[i] = sc[64]; bv[i] = sc[128]; kv[i] = sc[192]; rv[i] = sc[256]; vv[i] = SV[row * 64 + k]; }
            lp[0] = wv[0];
#pragma unroll
            for (int i = 1; i < 8; ++i) lp[i] = lp[i - 1] * wv[i];
            gtot[tq * 64 + k] = lp[7];
            __syncthreads();
            const float g0 = gtot[k], g1 = gtot[64 + k], g2 = gtot[128 + k], g3 = gtot[192 + k];
            const float pre = tq == 0 ? 1.f : (tq == 1 ? g0 : (tq == 2 ? g0 * g1 : g0 * g1 * g2)), gC = (g0 * g1) * (g2 * g3);
            float at[8], bh8[8], kh8[8];
#pragma unroll
            for (int i = 0; i < 8; ++i) { const float g = pre * lp[i], gp = i == 0 ? pre : pre * lp[i - 1], ig = __builtin_amdgcn_rcpf(g);
                const float bt = bv[i] * ig, kt = kv[i] * ig; at[i] = -kkv[i] * gp; bh8[i] = bt * gC; kh8[i] = kt * gC;
                const int ro = (8 * tq + i) * RMS + k;
                iA[ro] = (bf16)f2bf(at[i]); iB[ro] = (bf16)f2bf(bt); iK[ro] = (bf16)f2bf(kt); iR[ro] = (bf16)f2bf(rv[i] * g); }
            *(LAS bf16x8*)(iAT + k * TRS + 8 * tq) = pack8(at); *(LAS bf16x8*)(iBHT + k * TRS + 8 * tq) = pack8(bh8); *(LAS bf16x8*)(iKHT + k * TRS + 8 * tq) = pack8(kh8);
            *(LAS bf16x8*)(iVT + k * TRS + 8 * tq) = pack8(vv);
            if (tq == 0) gcv[k] = gC; }
        __syncthreads();
        f32x16 lak = zero16();
        { const LAS bf16* ia = (w4 < 2) ? iA : (w4 == 2 ? iB : iK); const LAS bf16* ib = (w4 == 0) ? iB : (w4 == 1 ? iK : iR);
            f32x16 acc = zero16();
#pragma unroll
            for (int ks = 0; ks < 4; ++ks) acc = MFMA32(rd_nat(ia, RMS, r, 16 * ks + 8 * h), rd_nat(ib, RMS, r, 16 * ks + 8 * h), acc);
#pragma unroll
            for (int i = 0; i < 16; ++i) { const int row = crow(i, h); const bool keep = (w4 < 2) ? (r < row) : (row <= r); acc[i] = keep ? acc[i] : 0.f; }
            if (w4 == 0) {
#pragma unroll
                for (int i = 0; i < 16; ++i) Lm[crow(i, h) * LST + r] = acc[i]; }
            else if (w4 == 1) lak = acc;
            else if (w4 == 2) { fnrb[lane] = pack_acc<0>(acc); fnrb[64 + lane] = pack_acc<1>(acc); }
            else {
#pragma unroll
                for (int i = 0; i < 16; ++i) cnrk[i * 64 + lane] = acc[i]; } }
        __syncthreads();
        if (w4 == 0) { float Tr[32];
#pragma unroll
            for (int t = 0; t < 32; ++t) { float acc = (t == r) ? 1.f : 0.f;
#pragma unroll
                for (int s4 = 0; s4 < (t + 3) / 4; ++s4) { const f32x4 l4 = *(const LAS f32x4*)(Lm + t * LST + 4 * s4);
#pragma unroll
                    for (int q = 0; q < 4; ++q) if (4 * s4 + q < t) acc += l4[q] * Tr[4 * s4 + q]; }
                Tr[t] = acc; }
            if (lane < 32) {
#pragma unroll
                for (int t = 0; t < 32; ++t) Tm[t * TRS + r] = (bf16)f2bf(Tr[t]); } }
        __syncthreads();
        if (w4 == 0 || w4 == 2) { const int a = w4 >> 1;
            f32x16 x1 = zero16();
#pragma unroll
            for (int ks = 0; ks < 2; ++ks) x1 = MFMA32(rd_nat(Tm, TRS, r, 16 * ks + 8 * h), rd_nat(iAT, TRS, 32 * a + r, 16 * ks + 8 * h), x1);
            const bf16x8 xf0 = pack_acc<0>(x1), xf1 = pack_acc<1>(x1);
#pragma unroll
            for (int b = 0; b < 2; ++b) { f32x16 p = zero16();
                p = MFMA32(xf0, rd_perm(iBHT, TRS, 32 * b + r, 0, h), p); p = MFMA32(xf1, rd_perm(iBHT, TRS, 32 * b + r, 16, h), p);
                if (a == b) { const float gc = gcv[32 * a + r];
#pragma unroll
                    for (int i = 0; i < 16; ++i) p[i] += (crow(i, h) == r) ? gc : 0.f; }
                bf16x8* dst = PT + ((size_t)(chunk * 2 + a) * 2 + b) * 2 * 64 + lane; dst[0] = pack_acc<0>(p); dst[64] = pack_acc<1>(p); }
            f32x16 ry;
#pragma unroll
            for (int g = 0; g < 4; ++g) { const u32x2 rr = *(const LAS u32x2*)(iR + r * RMS + 32 * a + 8 * g + 4 * h);
                ry[4 * g] = bflo(rr.x); ry[4 * g + 1] = bfhi(rr.x); ry[4 * g + 2] = bflo(rr.y); ry[4 * g + 3] = bfhi(rr.y); }
            ry = MFMA32(xf0, fnrb[lane], ry); ry = MFMA32(xf1, fnrb[64 + lane], ry);
            bf16x8* dr = RYT + (size_t)(chunk * 2 + a) * 2 * 64 + lane; dr[0] = pack_acc<0>(ry); dr[64] = pack_acc<1>(ry);
        } else if (w4 == 1) {
            f32x16 x2 = zero16();
            x2 = MFMA32(rd_perm(Tm, TRS, r, 0, h), pack_acc<0>(lak), x2); x2 = MFMA32(rd_perm(Tm, TRS, r, 16, h), pack_acc<1>(lak), x2);
            const bf16x8 xf0 = pack_acc<0>(x2), xf1 = pack_acc<1>(x2);
#pragma unroll
            for (int b = 0; b < 2; ++b) { f32x16 qm;
#pragma unroll
                for (int g = 0; g < 4; ++g) { const u32x2 kk2 = *(const LAS u32x2*)(iKHT + (32 * b + r) * TRS + 8 * g + 4 * h);
                    qm[4 * g] = bflo(kk2.x); qm[4 * g + 1] = bfhi(kk2.x); qm[4 * g + 2] = bflo(kk2.y); qm[4 * g + 3] = bfhi(kk2.y); }
                qm = MFMA32(xf0, rd_perm(iBHT, TRS, 32 * b + r, 0, h), qm); qm = MFMA32(xf1, rd_perm(iBHT, TRS, 32 * b + r, 16, h), qm);
                fqm[(b * 2 + 0) * 64 + lane] = pack_acc<0>(qm); fqm[(b * 2 + 1) * 64 + lane] = pack_acc<1>(qm); }
            f32x16 gy;
#pragma unroll
            for (int i = 0; i < 16; ++i) gy[i] = cnrk[i * 64 + lane];
            gy = MFMA32(xf0, fnrb[lane], gy); gy = MFMA32(xf1, fnrb[64 + lane], gy);
            const bf16x8 gf0 = pack_acc<0>(gy), gf1 = pack_acc<1>(gy);
#pragma unroll
            for (int vh = 0; vh < 2; ++vh) { f32x16 yv = zero16();
                yv = MFMA32(rd_perm(iVT, TRS, 32 * vh + r, 0, h), gf0, yv); yv = MFMA32(rd_perm(iVT, TRS, 32 * vh + r, 16, h), gf1, yv);
                bf16x8* dy = (bf16x8*)YVT + ((size_t)(chunk * 2 + vh) * 64 + lane) * 2;
                dy[0] = pack_acc<0>(yv); dy[1] = pack_acc<1>(yv); }
        }
        __syncthreads();
        if (w4 == 3) {
#pragma unroll
            for (int b = 0; b < 2; ++b)
#pragma unroll
                for (int vh = 0; vh < 2; ++vh) { f32x16 zv = zero16();
                    zv = MFMA32(fqm[(b * 2 + 0) * 64 + lane], rd_perm(iVT, TRS, 32 * vh + r, 0, h), zv); zv = MFMA32(fqm[(b * 2 + 1) * 64 + lane], rd_perm(iVT, TRS, 32 * vh + r, 16, h), zv);
                    bf16x8* dz = (bf16x8*)ZV + (((size_t)(chunk * 2 + b) * 2 + vh) * 64 + lane) * 2;
                    dz[0] = pack_acc<0>(zv); dz[1] = pack_acc<1>(zv); }
        }
    }
}
constexpr int CL2_LA = 2 * CL_GROUP, LAS_STRIDE = 264;
static_assert(CL2_LA + 32 * LAS_STRIDE * 2 <= MISC_OFF, "fused summaries LDS map");
__device__ __forceinline__ void phase4a_fused(const Frame& F) {
    const bf16* P = wsp<bf16>(F, WS_P); const bf16* LW = wsp<bf16>(F, WS_LW);
    const float* mu = F.in[6]; const float* w0 = F.in[7]; const float* a0 = F.in[9]; const float* k_k = F.in[12]; const float* k_a = F.in[13]; const float* r_k = F.in[14];
    float* SV = wsp<float>(F, WS_SV); bf16* G = wsp<bf16>(F, WS_G); float* BON = wsp<float>(F, WS_BONUS);
    bf16x8* PT = wsp<bf16x8>(F, WS_PT); f32x4* ZV = wsp<f32x4>(F, WS_ZV); bf16x8* RYT = wsp<bf16x8>(F, WS_RYT); f32x4* YVT = wsp<f32x4>(F, WS_YVT);
    const int grp = F.tid >> 8, gt = F.tid & 255, w4 = F.wave & 3, lane = F.lane, r = lane & 31, h = lane >> 5;
    LAS unsigned char* gl = F.lds + grp * CL_GROUP;
    LAS bf16* iA = (LAS bf16*)(gl + CL_A); LAS bf16* iB = (LAS bf16*)(gl + CL_B); LAS bf16* iK = (LAS bf16*)(gl + CL_K); LAS bf16* iR = (LAS bf16*)(gl + CL_R);
    LAS bf16* iAT = (LAS bf16*)(gl + CL_AT); LAS bf16* iBHT = (LAS bf16*)(gl + CL_BHT); LAS bf16* iKHT = (LAS bf16*)(gl + CL_KHT); LAS bf16* iVT = (LAS bf16*)(gl + CL_VT);
    LAS float* gtot = (LAS float*)(gl + CL_GTOT); LAS float* gcv = (LAS float*)(gl + CL_GC); LAS float* Lm = (LAS float*)(gl + CL_L); LAS bf16* Tm = (LAS bf16*)(gl + CL_T);
    LAS bf16x8* fnrb = (LAS bf16x8*)(gl + CL_FNRB); LAS float* cnrk = (LAS float*)(gl + CL_CNRK); LAS bf16x8* fqm = (LAS bf16x8*)(gl + CL_FQM);
    LAS float* lwo_w = (LAS float*)(gl + CL_L); LAS float* lwo_a = lwo_w + 32 * 64;
    LAS bf16* LA = (LAS bf16*)(F.lds + CL2_LA);
    bf16 cr[9], ck[9], cv[9]; float cst[8]; bool tz;
#define S1_LOAD(tc_, hp_) do { const int _hh = 2 * (hp_) + grp, _cc = _hh * 64 + (gt & 63), _t0 = ((tc_) % NCHK) * CK + 8 * (gt >> 6); \
        const size_t _pr = ((size_t)((tc_) / NCHK) * T + _t0) * IN_COLS + _cc; tz = _t0 > 0; const size_t _pp = tz ? _pr - IN_COLS : _pr; \
        cr[0] = __builtin_nontemporal_load(P + _pp); ck[0] = __builtin_nontemporal_load(P + _pp + 512); cv[0] = __builtin_nontemporal_load(P + _pp + 1024); \
        _Pragma("unroll") for (int _i = 0; _i < 8; ++_i) { cr[_i + 1] = __builtin_nontemporal_load(P + _pr + (size_t)_i * IN_COLS); ck[_i + 1] = __builtin_nontemporal_load(P + _pr + (size_t)_i * IN_COLS + 512); cv[_i + 1] = __builtin_nontemporal_load(P + _pr + (size_t)_i * IN_COLS + 1024); } \
        cst[0] = mu[_cc]; cst[1] = mu[512 + _cc]; cst[2] = mu[1024 + _cc]; cst[3] = w0[_cc]; cst[4] = a0[_cc]; cst[5] = k_k[_cc]; cst[6] = k_a[_cc]; cst[7] = r_k[_cc]; } while (0)
    bf16x8 lwf[8];
#define LW_LOAD(hp_) do { const bf16* _lw = LW + (size_t)((2 * (hp_) + grp) * 64 + 32 * (w4 & 1) + r) * 256 + 8 * h + (w4 < 2 ? 0 : 128); \
        _Pragma("unroll") for (int _q = 0; _q < 8; ++_q) lwf[_q] = *(const bf16x8*)(_lw + 16 * _q); } while (0)
    S1_LOAD(F.vcu, 0);
    LW_LOAD(0);
    u32x4 sa_c[2], sa_p[2]; float sa_mu[2][8];
#pragma unroll
    for (int q8 = 0; q8 < 2; ++q8)
#pragma unroll
        for (int j = 0; j < 8; ++j) sa_mu[q8][j] = mu[1536 + (F.tid & 15) * 16 + 8 * q8 + j];
#define SA_LOAD(tc_) do { const int _tk = F.tid >> 4, _t = ((tc_) % NCHK) * CK + _tk; const size_t _row = (size_t)((tc_) / NCHK) * T + _t; \
        _Pragma("unroll") for (int _q = 0; _q < 2; ++_q) { const size_t _o = _row * IN_COLS + 1536 + (F.tid & 15) * 16 + 8 * _q; \
            sa_c[_q] = __builtin_nontemporal_load((const u32x4*)(P + _o)); sa_p[_q] = __builtin_nontemporal_load((const u32x4*)(P + (_t > 0 ? _o - IN_COLS : _o))); } } while (0)
    SA_LOAD(F.vcu);
    for (int tc = F.vcu; tc < M / CK; tc += F.G) {
        const int b = tc / NCHK, c = tc % NCHK, t0 = c * CK, row0 = b * T + t0;
        lds_barrier();
        { const int tk = F.tid >> 4, cb = (F.tid & 15) * 16; float x[8];
#pragma unroll
            for (int q8 = 0; q8 < 2; ++q8) { const int col = cb + 8 * q8;
                { const u32x4 c_ = sa_c[q8], p_ = (t0 + tk > 0) ? sa_p[q8] : (u32x4){0u, 0u, 0u, 0u};
                    const float cf[8] = {bflo(c_.x), bfhi(c_.x), bflo(c_.y), bfhi(c_.y), bflo(c_.z), bfhi(c_.z), bflo(c_.w), bfhi(c_.w)};
                    const float pf[8] = {bflo(p_.x), bfhi(p_.x), bflo(p_.y), bfhi(p_.y), bflo(p_.z), bfhi(p_.z), bflo(p_.w), bfhi(p_.w)};
#pragma unroll
                    for (int j = 0; j < 8; ++j) x[j] = cf[j] + (pf[j] - cf[j]) * sa_mu[q8][j]; }
                if (col < 64) {
#pragma unroll
                    for (int j = 0; j < 8; ++j) x[j] = 2.f * sigmoidf_(2.f * x[j]) - 1.f; }
                else if (col >= 128) {
#pragma unroll
                    for (int j = 0; j < 8; ++j) x[j] = sigmoidf_(x[j]); }
                *(LAS bf16x8*)(LA + tk * LAS_STRIDE + col) = pack8(x); }
            const int ntc = (tc + F.G < M / CK) ? tc + F.G : tc; SA_LOAD(ntc); }
#pragma unroll 1
        for (int hp = 0; hp < 4; ++hp) {
            const int hh = 2 * hp + grp, bh = b * RH + hh, chunk = bh * NCHK + c;
            lds_barrier();
            { const int ct = w4 & 1;
                if (w4 < 2) {
                    f32x16 aw = zero16(), aa = zero16();
#pragma unroll
                    for (int ks = 0; ks < 4; ++ks) { aw = MFMA32(rd_nat(LA, LAS_STRIDE, r, 16 * ks + 8 * h), lwf[ks], aw); aa = MFMA32(rd_nat(LA, LAS_STRIDE, r, 64 + 16 * ks + 8 * h), lwf[4 + ks], aa); }
#pragma unroll
                    for (int i = 0; i < 16; ++i) { lwo_w[crow(i, h) * 64 + 32 * ct + r] = aw[i]; lwo_a[crow(i, h) * 64 + 32 * ct + r] = aa[i]; }
                } else {
                    f32x16 ag = zero16();
#pragma unroll
                    for (int ks = 0; ks < 8; ++ks) ag = MFMA32(rd_nat(LA, LAS_STRIDE, r, 128 + 16 * ks + 8 * h), lwf[ks], ag);
#pragma unroll
                    for (int i = 0; i < 16; ++i) G[(size_t)(row0 + crow(i, h)) * 512 + hh * 64 + 32 * ct + r] = (bf16)f2bf(ag[i]); } }
            LW_LOAD((hp + 1) & 3);
            lds_barrier();
            auto st1 = [&]() { const int k = gt & 63, tq = gt >> 6, cc = hh * 64 + k;
                float wv[8], kkv[8], bv[8], kv[8], rv[8], vv[8], lp[8];
                { const float mur = cst[0], muk = cst[1], muv = cst[2], w0c = cst[3], a0c = cst[4], kkc = cst[5], kac = cst[6], rkc = cst[7];
                    const int tl0 = 8 * tq;
                    if (!tz) { cr[0] = 0; ck[0] = 0; cv[0] = 0; }
                    float lw_[8], la_[8];
#pragma unroll
                    for (int i = 0; i < 8; ++i) { lw_[i] = lwo_w[(tl0 + i) * 64 + k]; la_[i] = lwo_a[(tl0 + i) * 64 + k]; }
                    float kk[8], ssq[8], bo[8], av[8];
#pragma unroll
                    for (int i = 0; i < 8; ++i) { const float c_r = bf2f(cr[i + 1]), c_k = bf2f(ck[i + 1]), c_v = bf2f(cv[i + 1]);
                        rv[i] = c_r + (bf2f(cr[i]) - c_r) * mur; const float kr = c_k + (bf2f(ck[i]) - c_k) * muk; vv[i] = c_v + (bf2f(cv[i]) - c_v) * muv;
                        wv[i] = __expf(-0.60653066f * sigmoidf_(w0c + lw_[i])); av[i] = sigmoidf_(a0c + la_[i]);
                        kk[i] = kr * kkc; ssq[i] = kk[i] * kk[i]; kv[i] = kr * (1.f + (av[i] - 1.f) * kac); bo[i] = rv[i] * kv[i] * rkc; }
#pragma unroll
                    for (int i = 0; i < 8; ++i) { ssq[i] = reduce16(ssq[i]); bo[i] = reduce16(bo[i]); }
#pragma unroll
                    for (int i = 0; i < 8; ++i) { ssq[i] += __shfl_xor(ssq[i], 16); bo[i] += __shfl_xor(bo[i], 16); }
#pragma unroll
                    for (int i = 0; i < 8; ++i) { ssq[i] += __shfl_xor(ssq[i], 32); bo[i] += __shfl_xor(bo[i], 32); }
#pragma unroll
                    for (int i = 0; i < 8; ++i) { kkv[i] = kk[i] * __builtin_amdgcn_rcpf(fmaxf(sqrtf(ssq[i]), 1e-12f)); bv[i] = kkv[i] * av[i];
                        ((bf16*)SV)[((size_t)bh * T + t0 + tl0 + i) * 64 + k] = (bf16)f2bf(vv[i]);
                        if (k == 0) BON[(row0 + tl0 + i) * 8 + hh] = bo[i]; } }
                lp[0] = wv[0];
#pragma unroll
                for (int i = 1; i < 8; ++i) lp[i] = lp[i - 1] * wv[i];
                gtot[tq * 64 + k] = lp[7];
                lds_barrier();
                const float g0 = gtot[k], g1 = gtot[64 + k], g2 = gtot[128 + k], g3 = gtot[192 + k];
                const float pre = tq == 0 ? 1.f : (tq == 1 ? g0 : (tq == 2 ? g0 * g1 : g0 * g1 * g2)), gC = (g0 * g1) * (g2 * g3);
                float at[8], bh8[8], kh8[8];
#pragma unroll
                for (int i = 0; i < 8; ++i) { const float g = pre * lp[i], gp = i == 0 ? pre : pre * lp[i - 1], ig = __builtin_amdgcn_rcpf(g);
                    const float bt = bv[i] * ig, kt = kv[i] * ig; at[i] = -kkv[i] * gp; bh8[i] = bt * gC; kh8[i] = kt * gC;
                    const int ro = (8 * tq + i) * RMS + k;
                    iA[ro] = (bf16)f2bf(at[i]); iB[ro] = (bf16)f2bf(bt); iK[ro] = (bf16)f2bf(kt); iR[ro] = (bf16)f2bf(rv[i] * g); }
                *(LAS bf16x8*)(iAT + k * TRS + 8 * tq) = pack8(at); *(LAS bf16x8*)(iBHT + k * TRS + 8 * tq) = pack8(bh8); *(LAS bf16x8*)(iKHT + k * TRS + 8 * tq) = pack8(kh8);
                *(LAS bf16x8*)(iVT + k * TRS + 8 * tq) = pack8(vv);
                if (tq == 0) gcv[k] = gC; };
            st1();
#if MK_DUP & 2
            lds_barrier(); asm volatile("" ::: "memory"); st1();
#endif
            { const int ntc = (hp < 3) ? tc : (tc + F.G < M / CK ? tc + F.G : tc), nhp = (hp < 3) ? hp + 1 : 0; S1_LOAD(ntc, nhp); }
            lds_barrier();
            f32x16 lak = zero16();
            { const LAS bf16* ia = (w4 < 2) ? iA : (w4 == 2 ? iB : iK); const LAS bf16* ib = (w4 == 0) ? iB : (w4 == 1 ? iK : iR);
                f32x16 acc = zero16();
#pragma unroll
                for (int ks = 0; ks < 4; ++ks) acc = MFMA32(rd_nat(ia, RMS, r, 16 * ks + 8 * h), rd_nat(ib, RMS, r, 16 * ks + 8 * h), acc);
#pragma unroll
                for (int i = 0; i < 16; ++i) { const int row = crow(i, h); const bool keep = (w4 < 2) ? (r < row) : (row <= r); acc[i] = keep ? acc[i] : 0.f; }
                if (w4 <= 1) lak = acc;
                else if (w4 == 2) { fnrb[lane] = pack_acc<0>(acc); fnrb[64 + lane] = pack_acc<1>(acc); }
                else {
#pragma unroll
                    for (int i = 0; i < 16; ++i) cnrk[i * 64 + lane] = acc[i]; } }
            lds_barrier();
            auto st3 = [&]() { if (w4 == 0) {
                LAS bf16* imgL = (LAS bf16*)(gl + CL_L);
                f32x16 Lp = lak, Tq = lak;
#pragma unroll
                for (int i = 0; i < 16; ++i) Tq[i] += (crow(i, h) == r) ? 1.f : 0.f;
#pragma unroll
                for (int st = 0; st < 4; ++st) {
#pragma unroll
                    for (int i = 0; i < 16; ++i) { imgL[crow(i, h) * TRS + r] = (bf16)f2bf(Lp[i]); Tm[crow(i, h) * TRS + r] = (bf16)f2bf(Tq[i]); }
                    asm volatile("s_waitcnt lgkmcnt(0)" ::: "memory");
                    const bf16x8 b0 = pack_acc<0>(Lp), b1 = pack_acc<1>(Lp);
                    f32x16 l2 = zero16(); l2 = MFMA32(rd_perm(imgL, TRS, r, 0, h), b0, l2); l2 = MFMA32(rd_perm(imgL, TRS, r, 16, h), b1, l2);
                    Lp = l2;
                    f32x16 mm = l2;
#pragma unroll
                    for (int i = 0; i < 16; ++i) mm[i] += (crow(i, h) == r) ? 1.f : 0.f;
                    const bf16x8 m0 = pack_acc<0>(mm), m1 = pack_acc<1>(mm);
                    f32x16 t2 = zero16(); t2 = MFMA32(rd_perm(Tm, TRS, r, 0, h), m0, t2); t2 = MFMA32(rd_perm(Tm, TRS, r, 16, h), m1, t2);
                    Tq = t2;
                    asm volatile("s_waitcnt lgkmcnt(0)" ::: "memory"); }
#pragma unroll
                for (int i = 0; i < 16; ++i) Tm[crow(i, h) * TRS + r] = (bf16)f2bf(Tq[i]); } };
            st3();
#if MK_DUP & 4
            asm volatile("" ::: "memory"); st3();
#endif
            lds_barrier();
            auto st4 = [&]() { if (w4 == 0 || w4 == 2) { const int a = w4 >> 1;
                f32x16 x1 = zero16();
#pragma unroll
                for (int ks = 0; ks < 2; ++ks) x1 = MFMA32(rd_nat(Tm, TRS, r, 16 * ks + 8 * h), rd_nat(iAT, TRS, 32 * a + r, 16 * ks + 8 * h), x1);
                const bf16x8 xf0 = pack_acc<0>(x1), xf1 = pack_acc<1>(x1);
#pragma unroll
                for (int b = 0; b < 2; ++b) { f32x16 p = zero16();
                    p = MFMA32(xf0, rd_perm(iBHT, TRS, 32 * b + r, 0, h), p); p = MFMA32(xf1, rd_perm(iBHT, TRS, 32 * b + r, 16, h), p);
                    if (a == b) { const float gc = gcv[32 * a + r];
#pragma unroll
                        for (int i = 0; i < 16; ++i) p[i] += (crow(i, h) == r) ? gc : 0.f; }
                    bf16x8* dst = PT + ((size_t)(chunk * 2 + a) * 2 + b) * 2 * 64 + lane; dst[0] = pack_acc<0>(p); dst[64] = pack_acc<1>(p); }
                f32x16 ry;
#pragma unroll
                for (int g = 0; g < 4; ++g) { const u32x2 rr = *(const LAS u32x2*)(iR + r * RMS + 32 * a + 8 * g + 4 * h);
                    ry[4 * g] = bflo(rr.x); ry[4 * g + 1] = bfhi(rr.x); ry[4 * g + 2] = bflo(rr.y); ry[4 * g + 3] = bfhi(rr.y); }
                ry = MFMA32(xf0, fnrb[lane], ry); ry = MFMA32(xf1, fnrb[64 + lane], ry);
                bf16x8* dr = RYT + (size_t)(chunk * 2 + a) * 2 * 64 + lane; dr[0] = pack_acc<0>(ry); dr[64] = pack_acc<1>(ry);
            } else if (w4 == 1) {
                f32x16 x2 = zero16();
                x2 = MFMA32(rd_perm(Tm, TRS, r, 0, h), pack_acc<0>(lak), x2); x2 = MFMA32(rd_perm(Tm, TRS, r, 16, h), pack_acc<1>(lak), x2);
                const bf16x8 xf0 = pack_acc<0>(x2), xf1 = pack_acc<1>(x2);
#pragma unroll
                for (int b = 0; b < 2; ++b) { f32x16 qm;
#pragma unroll
                    for (int g = 0; g < 4; ++g) { const u32x2 kk2 = *(const LAS u32x2*)(iKHT + (32 * b + r) * TRS + 8 * g + 4 * h);
                        qm[4 * g] = bflo(kk2.x); qm[4 * g + 1] = bfhi(kk2.x); qm[4 * g + 2] = bflo(kk2.y); qm[4 * g + 3] = bfhi(kk2.y); }
                    qm = MFMA32(xf0, rd_perm(iBHT, TRS, 32 * b + r, 0, h), qm); qm = MFMA32(xf1, rd_perm(iBHT, TRS, 32 * b + r, 16, h), qm);
                    fqm[(b * 2 + 0) * 64 + lane] = pack_acc<0>(qm); fqm[(b * 2 + 1) * 64 + lane] = pack_acc<1>(qm); }
                f32x16 gy;
#pragma unroll
                for (int i = 0; i < 16; ++i) gy[i] = cnrk[i * 64 + lane];
                gy = MFMA32(xf0, fnrb[lane], gy); gy = MFMA32(xf1, fnrb[64 + lane], gy);
                const bf16x8 gf0 = pack_acc<0>(gy), gf1 = pack_acc<1>(gy);
#pragma unroll
                for (int vh = 0; vh < 2; ++vh) { f32x16 yv = zero16();
                    yv = MFMA32(rd_perm(iVT, TRS, 32 * vh + r, 0, h), gf0, yv); yv = MFMA32(rd_perm(iVT, TRS, 32 * vh + r, 16, h), gf1, yv);
                    bf16x8* dy = (bf16x8*)YVT + ((size_t)(chunk * 2 + vh) * 64 + lane) * 2;
                    dy[0] = pack_acc<0>(yv); dy[1] = pack_acc<1>(yv); }
            } };
            st4();
#if MK_DUP & 8
            asm volatile("" ::: "memory"); st4();
#endif
            lds_barrier();
            if (w4 == 3) {
#pragma unroll
                for (int b = 0; b < 2; ++b)
#pragma unroll
                    for (int vh = 0; vh < 2; ++vh) { f32x16 zv = zero16();
                        zv = MFMA32(fqm[(b * 2 + 0) * 64 + lane], rd_perm(iVT, TRS, 32 * vh + r, 0, h), zv); zv = MFMA32(fqm[(b * 2 + 1) * 64 + lane], rd_perm(iVT, TRS, 32 * vh + r, 16, h), zv);
                        bf16x8* dz = (bf16x8*)ZV + (((size_t)(chunk * 2 + b) * 2 + vh) * 64 + lane) * 2;
                        dz[0] = pack_acc<0>(zv); dz[1] = pack_acc<1>(zv); }
            }
        }
    }
#undef S1_LOAD
#undef LW_LOAD
#undef SA_LOAD
}
constexpr int WRS = 68, WTS = 36;
constexpr int WL_A = 0, WL_B = 4352, WL_K = 8704, WL_R = 13056, WL_AT = 17408, WL_BHT = 22016, WL_KHT = 26624, WL_VT = 31232, WL_SIZE = 35840, WL_LA = 4 * WL_SIZE;
static_assert(WL_LA + 32 * LAS_STRIDE * 2 <= MISC_OFF, "wave-per-chunk LDS map");
__device__ __forceinline__ bf16x8 rd_nat2(const LAS bf16* img, int stride, int row, int k0) {
    const u32x2 lo = *(const LAS u32x2*)(img + row * stride + k0), hi = *(const LAS u32x2*)(img + row * stride + k0 + 4);
    u32x4 w; w.x = lo.x; w.y = lo.y; w.z = hi.x; w.w = hi.y; return __builtin_bit_cast(bf16x8, w);
}
__device__ __forceinline__ void phase4a_wave(const Frame& F) {
    const bf16* P = wsp<bf16>(F, WS_P); const bf16* LW = wsp<bf16>(F, WS_LW);
    const float* mu = F.in[6]; const float* w0 = F.in[7]; const float* a0 = F.in[9]; const float* k_k = F.in[12]; const float* k_a = F.in[13]; const float* r_k = F.in[14];
    float* SV = wsp<float>(F, WS_SV); bf16* G = wsp<bf16>(F, WS_G); float* BON = wsp<float>(F, WS_BONUS);
    bf16x8* PT = wsp<bf16x8>(F, WS_PT); f32x4* ZV = wsp<f32x4>(F, WS_ZV); bf16x8* RYT = wsp<bf16x8>(F, WS_RYT); f32x4* YVT = wsp<f32x4>(F, WS_YVT);
    const int wv_ = F.wave & 3;
    LAS unsigned char* gl = F.lds + wv_ * WL_SIZE;
    LAS bf16* iA = (LAS bf16*)(gl + WL_A); LAS bf16* iB = (LAS bf16*)(gl + WL_B); LAS bf16* iK = (LAS bf16*)(gl + WL_K); LAS bf16* iR = (LAS bf16*)(gl + WL_R);
    LAS bf16* iAT = (LAS bf16*)(gl + WL_AT); LAS bf16* iBHT = (LAS bf16*)(gl + WL_BHT); LAS bf16* iKHT = (LAS bf16*)(gl + WL_KHT); LAS bf16* iVT = (LAS bf16*)(gl + WL_VT);
    LAS bf16* imgL = iA; LAS bf16* Tm = iB;
    LAS bf16* LA = (LAS bf16*)(F.lds + WL_LA);
    for (int tc = F.vcu; tc < M / CK; tc += F.G) {
        const int b = tc / NCHK, c = tc % NCHK, t0 = c * CK, row0 = b * T + t0;
        lds_barrier();
        { const int tk = F.tid >> 4, cb = (F.tid & 15) * 16; float x[8];
#pragma unroll
            for (int q8 = 0; q8 < 2; ++q8) { const int col = cb + 8 * q8; lerp8(P, mu, row0 + tk, t0 + tk, 1536 + col, x);
                if (col < 64) {
#pragma unroll
                    for (int j = 0; j < 8; ++j) x[j] = 2.f * sigmoidf_(2.f * x[j]) - 1.f; }
                else if (col >= 128) {
#pragma unroll
                    for (int j = 0; j < 8; ++j) x[j] = sigmoidf_(x[j]); }
                *(LAS bf16x8*)(LA + tk * LAS_STRIDE + col) = pack8(x); } }
        lds_barrier();
        if (F.wave < 4) {
#pragma unroll 1
        for (int rnd = 0; rnd < 2; ++rnd) {
            int lane = F.lane; asm volatile("" : "+v"(lane));
            const int r = lane & 31, h = lane >> 5;
            const int hh = wv_ + 4 * rnd, bh = b * RH + hh, chunk = bh * NCHK + c, cc = hh * 64 + lane;
            f32x16 aw[2], aa[2];
#pragma unroll
            for (int ct = 0; ct < 2; ++ct) { const bf16* lw = LW + (size_t)(hh * 64 + 32 * ct + r) * 256 + 8 * h;
                { bf16x8 bf_[8];
#pragma unroll
                    for (int ks = 0; ks < 8; ++ks) bf_[ks] = *(const bf16x8*)(lw + 128 + 16 * ks);
                    f32x16 g_ = zero16();
#pragma unroll
                    for (int ks = 0; ks < 8; ++ks) g_ = MFMA32(rd_nat(LA, LAS_STRIDE, r, 128 + 16 * ks + 8 * h), bf_[ks], g_);
#pragma unroll
                    for (int i = 0; i < 16; ++i) if (MK_WMASK & 1) G[(size_t)(row0 + crow(i, h)) * 512 + hh * 64 + 32 * ct + r] = (bf16)f2bf(g_[i]); }
                { bf16x8 bf_[8];
#pragma unroll
                    for (int ks = 0; ks < 8; ++ks) bf_[ks] = *(const bf16x8*)(lw + 16 * ks);
                    f32x16 w_ = zero16(), a_ = zero16();
#pragma unroll
                    for (int ks = 0; ks < 4; ++ks) { w_ = MFMA32(rd_nat(LA, LAS_STRIDE, r, 16 * ks + 8 * h), bf_[ks], w_); a_ = MFMA32(rd_nat(LA, LAS_STRIDE, r, 64 + 16 * ks + 8 * h), bf_[4 + ks], a_); }
                    aw[ct] = w_; aa[ct] = a_; } }
            f32x16 wo, wr_, ao, ar_;
#pragma unroll
            for (int i = 0; i < 16; ++i) { wo[i] = h ? aw[1][i] : aw[0][i]; ao[i] = h ? aa[1][i] : aa[0][i];
                wr_[i] = __shfl_xor(h ? aw[0][i] : aw[1][i], 32); ar_[i] = __shfl_xor(h ? aa[0][i] : aa[1][i], 32); }
            const float mur = mu[cc], muk = mu[512 + cc], muv = mu[1024 + cc], w0c = w0[cc], a0c = a0[cc], kkc = k_k[cc], kac = k_a[cc], rkc = r_k[cc];
            float gam[32];
#pragma unroll
            for (int t = 0; t < 32; ++t) { const int i = (t & 3) + 4 * (t >> 3); const float wl = (((t >> 2) & 1) == h) ? wo[i] : wr_[i];
                const float dec = __expf(-0.60653066f * sigmoidf_(w0c + wl)); gam[t] = t ? gam[t - 1] * dec : dec; }
            const float gC = gam[31];
            const size_t pbase = (size_t)row0 * IN_COLS + cc;
            bf16 pr_ = 0, pk_ = 0, pv_ = 0;
            if (t0 > 0) { pr_ = P[pbase - IN_COLS]; pk_ = P[pbase - IN_COLS + 512]; pv_ = P[pbase - IN_COLS + 1024]; }
#pragma unroll
            for (int tb = 0; tb < 4; ++tb) {
                asm volatile("" ::: "memory");
                bf16 cr[8], ck[8], cv[8];
#pragma unroll
                for (int i = 0; i < 8; ++i) { const size_t o = pbase + (size_t)(8 * tb + i) * IN_COLS; cr[i] = P[o]; ck[i] = P[o + 512]; cv[i] = P[o + 1024]; }
                float rv[8], vv[8], kk[8], ssq[8], bo[8], av[8], kv[8];
#pragma unroll
                for (int i = 0; i < 8; ++i) { const int t = 8 * tb + i, ii = (t & 3) + 4 * (t >> 3);
                    const float c_r = bf2f(cr[i]), c_k = bf2f(ck[i]), c_v = bf2f(cv[i]);
                    const float p_r = bf2f(i ? cr[i - 1] : pr_), p_k = bf2f(i ? ck[i - 1] : pk_), p_v = bf2f(i ? cv[i - 1] : pv_);
                    rv[i] = c_r + (p_r - c_r) * mur; const float kr = c_k + (p_k - c_k) * muk; vv[i] = c_v + (p_v - c_v) * muv;
                    const float al = (((t >> 2) & 1) == h) ? ao[ii] : ar_[ii];
                    av[i] = sigmoidf_(a0c + al);
                    kk[i] = kr * kkc; ssq[i] = kk[i] * kk[i]; kv[i] = kr * (1.f + (av[i] - 1.f) * kac); bo[i] = rv[i] * kv[i] * rkc; }
                pr_ = cr[7]; pk_ = ck[7]; pv_ = cv[7];
#pragma unroll
                for (int i = 0; i < 8; ++i) { ssq[i] = reduce16(ssq[i]); bo[i] = reduce16(bo[i]); }
#pragma unroll
                for (int i = 0; i < 8; ++i) { ssq[i] += __shfl_xor(ssq[i], 16); bo[i] += __shfl_xor(bo[i], 16); }
#pragma unroll
                for (int i = 0; i < 8; ++i) { ssq[i] += __shfl_xor(ssq[i], 32); bo[i] += __shfl_xor(bo[i], 32); }
                float at[8], bh8[8], kh8[8];
#pragma unroll
                for (int i = 0; i < 8; ++i) { const int t = 8 * tb + i;
                    const float kkn = kk[i] * __builtin_amdgcn_rcpf(fmaxf(sqrtf(ssq[i]), 1e-12f)), bb = kkn * av[i];
                    const float g = gam[t], gp = t ? gam[t - 1] : 1.f, ig = __builtin_amdgcn_rcpf(g);
                    const float bt = bb * ig, kt = kv[i] * ig; at[i] = -kkn * gp; bh8[i] = bt * gC; kh8[i] = kt * gC;
                    const int ro = t * WRS + lane;
                    iA[ro] = (bf16)f2bf(at[i]); iB[ro] = (bf16)f2bf(bt); iK[ro] = (bf16)f2bf(kt); iR[ro] = (bf16)f2bf(rv[i] * g);
                    if (MK_WMASK & 2) { ((bf16*)SV)[((size_t)bh * T + t0 + t) * 64 + lane] = (bf16)f2bf(vv[i]);
                    if (lane == 0) BON[(row0 + t) * 8 + hh] = bo[i]; } }
#pragma unroll
                for (int q = 0; q < 2; ++q) { u32x2 w;
                    w.x = pk2(at[4 * q], at[4 * q + 1]); w.y = pk2(at[4 * q + 2], at[4 * q + 3]); *(LAS u32x2*)(iAT + lane * WTS + 8 * tb + 4 * q) = w;
                    w.x = pk2(bh8[4 * q], bh8[4 * q + 1]); w.y = pk2(bh8[4 * q + 2], bh8[4 * q + 3]); *(LAS u32x2*)(iBHT + lane * WTS + 8 * tb + 4 * q) = w;
                    w.x = pk2(kh8[4 * q], kh8[4 * q + 1]); w.y = pk2(kh8[4 * q + 2], kh8[4 * q + 3]); *(LAS u32x2*)(iKHT + lane * WTS + 8 * tb + 4 * q) = w;
                    w.x = pk2(vv[4 * q], vv[4 * q + 1]); w.y = pk2(vv[4 * q + 2], vv[4 * q + 3]); *(LAS u32x2*)(iVT + lane * WTS + 8 * tb + 4 * q) = w; }
            }
            asm volatile("s_waitcnt lgkmcnt(0)" ::: "memory");
            f32x16 lab = zero16(), lak = zero16(), nrb = zero16(), nrk = zero16();
#pragma unroll
            for (int ks = 0; ks < 4; ++ks) { const bf16x8 fa = rd_nat2(iA, WRS, r, 16 * ks + 8 * h), fb = rd_nat2(iB, WRS, r, 16 * ks + 8 * h), fk = rd_nat2(iK, WRS, r, 16 * ks + 8 * h), fr_ = rd_nat2(iR, WRS, r, 16 * ks + 8 * h);
                lab = MFMA32(fa, fb, lab); lak = MFMA32(fa, fk, lak); nrb = MFMA32(fb, fr_, nrb); nrk = MFMA32(fk, fr_, nrk); }
#pragma unroll
            for (int i = 0; i < 16; ++i) { const int row = crow(i, h); lab[i] = (r < row) ? lab[i] : 0.f; lak[i] = (r < row) ? lak[i] : 0.f; nrb[i] = (row <= r) ? nrb[i] : 0.f; nrk[i] = (row <= r) ? nrk[i] : 0.f; }
            const bf16x8 fn0 = pack_acc<0>(nrb), fn1 = pack_acc<1>(nrb);
            asm volatile("s_waitcnt lgkmcnt(0)" ::: "memory");
            { f32x16 Lp = lab, Tq = lab;
#pragma unroll
                for (int i = 0; i < 16; ++i) Tq[i] += (crow(i, h) == r) ? 1.f : 0.f;
#pragma unroll
                for (int st = 0; st < 4; ++st) {
#pragma unroll
                    for (int i = 0; i < 16; ++i) { imgL[crow(i, h) * WTS + r] = (bf16)f2bf(Lp[i]); Tm[crow(i, h) * WTS + r] = (bf16)f2bf(Tq[i]); }
                    asm volatile("s_waitcnt lgkmcnt(0)" ::: "memory");
                    const bf16x8 b0 = pack_acc<0>(Lp), b1 = pack_acc<1>(Lp);
                    f32x16 l2 = zero16(); l2 = MFMA32(rd_perm(imgL, WTS, r, 0, h), b0, l2); l2 = MFMA32(rd_perm(imgL, WTS, r, 16, h), b1, l2);
                    Lp = l2;
                    f32x16 mm = l2;
#pragma unroll
                    for (int i = 0; i < 16; ++i) mm[i] += (crow(i, h) == r) ? 1.f : 0.f;
                    const bf16x8 m0 = pack_acc<0>(mm), m1 = pack_acc<1>(mm);
                    f32x16 t2 = zero16(); t2 = MFMA32(rd_perm(Tm, WTS, r, 0, h), m0, t2); t2 = MFMA32(rd_perm(Tm, WTS, r, 16, h), m1, t2);
                    Tq = t2;
                    asm volatile("s_waitcnt lgkmcnt(0)" ::: "memory"); }
#pragma unroll
                for (int i = 0; i < 16; ++i) Tm[crow(i, h) * WTS + r] = (bf16)f2bf(Tq[i]);
                asm volatile("s_waitcnt lgkmcnt(0)" ::: "memory"); }
            const float gcd2[2] = {__shfl(gC, r), __shfl(gC, 32 + r)};
#pragma unroll
            for (int a = 0; a < 2; ++a) { f32x16 x1 = zero16();
#pragma unroll
                for (int ks = 0; ks < 2; ++ks) x1 = MFMA32(rd_nat2(Tm, WTS, r, 16 * ks + 8 * h), rd_nat2(iAT, WTS, 32 * a + r, 16 * ks + 8 * h), x1);
                const bf16x8 xf0 = pack_acc<0>(x1), xf1 = pack_acc<1>(x1);
#pragma unroll
                for (int b2 = 0; b2 < 2; ++b2) { f32x16 p = zero16();
                    p = MFMA32(xf0, rd_perm(iBHT, WTS, 32 * b2 + r, 0, h), p); p = MFMA32(xf1, rd_perm(iBHT, WTS, 32 * b2 + r, 16, h), p);
                    if (a == b2) { const float gcd = gcd2[a];
#pragma unroll
                        for (int i = 0; i < 16; ++i) p[i] += (crow(i, h) == r) ? gcd : 0.f; }
                    bf16x8* dst = PT + ((size_t)(chunk * 2 + a) * 2 + b2) * 2 * 64 + lane; if (MK_WMASK & 4) { dst[0] = pack_acc<0>(p); dst[64] = pack_acc<1>(p); } }
                f32x16 ry;
#pragma unroll
                for (int g = 0; g < 4; ++g) { const u32x2 rr = *(const LAS u32x2*)(iR + r * WRS + 32 * a + 8 * g + 4 * h);
                    ry[4 * g] = bflo(rr.x); ry[4 * g + 1] = bfhi(rr.x); ry[4 * g + 2] = bflo(rr.y); ry[4 * g + 3] = bfhi(rr.y); }
                ry = MFMA32(xf0, fn0, ry); ry = MFMA32(xf1, fn1, ry);
                bf16x8* dr = RYT + (size_t)(chunk * 2 + a) * 2 * 64 + lane; if (MK_WMASK & 8) { dr[0] = pack_acc<0>(ry); dr[64] = pack_acc<1>(ry); } }
            { f32x16 x2 = zero16();
                x2 = MFMA32(rd_perm(Tm, WTS, r, 0, h), pack_acc<0>(lak), x2); x2 = MFMA32(rd_perm(Tm, WTS, r, 16, h), pack_acc<1>(lak), x2);
                const bf16x8 xf0 = pack_acc<0>(x2), xf1 = pack_acc<1>(x2);
                bf16x8 fq[2][2];
#pragma unroll
                for (int b2 = 0; b2 < 2; ++b2) { f32x16 qm;
#pragma unroll
                    for (int g = 0; g < 4; ++g) { const u32x2 kk2 = *(const LAS u32x2*)(iKHT + (32 * b2 + r) * WTS + 8 * g + 4 * h);
                        qm[4 * g] = bflo(kk2.x); qm[4 * g + 1] = bfhi(kk2.x); qm[4 * g + 2] = bflo(kk2.y); qm[4 * g + 3] = bfhi(kk2.y); }
                    qm = MFMA32(xf0, rd_perm(iBHT, WTS, 32 * b2 + r, 0, h), qm); qm = MFMA32(xf1, rd_perm(iBHT, WTS, 32 * b2 + r, 16, h), qm);
                    fq[b2][0] = pack_acc<0>(qm); fq[b2][1] = pack_acc<1>(qm); }
                f32x16 gy = nrk;
                gy = MFMA32(xf0, fn0, gy); gy = MFMA32(xf1, fn1, gy);
                const bf16x8 gf0 = pack_acc<0>(gy), gf1 = pack_acc<1>(gy);
#pragma unroll
                for (int vh = 0; vh < 2; ++vh) { f32x16 yv = zero16();
                    yv = MFMA32(rd_perm(iVT, WTS, 32 * vh + r, 0, h), gf0, yv); yv = MFMA32(rd_perm(iVT, WTS, 32 * vh + r, 16, h), gf1, yv);
                    bf16x8* dy = (bf16x8*)YVT + ((size_t)(chunk * 2 + vh) * 64 + lane) * 2;
                    if (MK_WMASK & 16) { dy[0] = pack_acc<0>(yv); dy[1] = pack_acc<1>(yv); } }
#pragma unroll
                for (int b2 = 0; b2 < 2; ++b2)
#pragma unroll
                    for (int vh = 0; vh < 2; ++vh) { f32x16 zv = zero16();
                        zv = MFMA32(fq[b2][0], rd_perm(iVT, WTS, 32 * vh + r, 0, h), zv); zv = MFMA32(fq[b2][1], rd_perm(iVT, WTS, 32 * vh + r, 16, h), zv);
                        bf16x8* dz = (bf16x8*)ZV + (((size_t)(chunk * 2 + b2) * 2 + vh) * 64 + lane) * 2;
                        if (MK_WMASK & 32) { dz[0] = pack_acc<0>(zv); dz[1] = pack_acc<1>(zv); } } }
            asm volatile("s_waitcnt lgkmcnt(0)" ::: "memory");
        }
        }
    }
}

__device__ __forceinline__ void phase5_attn_part(const Frame& F, int first, int stride);
constexpr int SB_SLOT = 16384, SB_NSLOT = 7, SB_FLAGS = SB_NSLOT * SB_SLOT;
constexpr int CONV_4B = ((MK_CONV_WHERE == 9 || MK_CONV_WHERE == 8) && !MK_ATTN_IN_4B) ? 6144 : 0;
__device__ __forceinline__ void phase4b_states(const Frame& F) {
    volatile LAS unsigned* FULL = (volatile LAS unsigned*)(F.lds + SB_FLAGS);
    volatile LAS unsigned* DONEC = (volatile LAS unsigned*)(F.lds + SB_FLAGS + 64);
    __syncthreads();
    if (F.tid < 32) ((LAS unsigned*)(F.lds + SB_FLAGS))[F.tid] = 0u;
    __syncthreads();
    if (F.vcu < 128) {
        const int bh = F.vcu >> 1, vh = F.vcu & 1, lane = F.lane;
        if (F.wave == 0) {
            bf16x8* Z0 = wsp<bf16x8>(F, WS_Z0);
            f32x16 z0 = zero16(), z1 = zero16();
            bf16x8 pf[8]; u32x4 zq[2][2];
#define SB_FETCH(c_, slot_) do { { int sp = 0; while (FULL[slot_] < (unsigned)((c_) + 1)) { if (++sp > SC_SPIN_CAP) break; } } \
                __builtin_amdgcn_fence(__ATOMIC_ACQUIRE, "workgroup"); \
                const LAS unsigned char* sb = F.lds + (slot_) * SB_SLOT; const LAS bf16x8* p = (const LAS bf16x8*)sb + lane; \
                _Pragma("unroll") for (int q = 0; q < 8; ++q) pf[q] = p[q * 64]; \
                zq[0][0] = ((const LAS u32x4*)(sb + 8192) + lane * 2)[0]; zq[0][1] = ((const LAS u32x4*)(sb + 8192) + lane * 2)[1]; \
                zq[1][0] = ((const LAS u32x4*)(sb + 10240) + lane * 2)[0]; zq[1][1] = ((const LAS u32x4*)(sb + 10240) + lane * 2)[1]; \
                asm volatile("s_waitcnt lgkmcnt(0)" ::: "memory"); \
                if (lane == 0) DONEC[0] = (unsigned)((c_) + 1); } while (0)
            SB_FETCH(0, 0);
            int slot = 0;
            for (int c = 0; c < NCHK; ++c) { const int chunk = bh * NCHK + c;
                const bf16x8 f00 = pack_acc<0>(z0), f01 = pack_acc<1>(z0), f10 = pack_acc<0>(z1), f11 = pack_acc<1>(z1);
                bf16x8* dz = Z0 + (size_t)(chunk * 2 + vh) * 4 * 64 + lane; dz[0] = f00; dz[64] = f01; dz[128] = f10; dz[192] = f11;
                f32x16 n0, n1;
#pragma unroll
                for (int q = 0; q < 2; ++q) { const u32x4 u = zq[0][q], w = zq[1][q];
                    n0[8 * q] = bflo(u.x); n0[8 * q + 1] = bfhi(u.x); n0[8 * q + 2] = bflo(u.y); n0[8 * q + 3] = bfhi(u.y); n0[8 * q + 4] = bflo(u.z); n0[8 * q + 5] = bfhi(u.z); n0[8 * q + 6] = bflo(u.w); n0[8 * q + 7] = bfhi(u.w);
                    n1[8 * q] = bflo(w.x); n1[8 * q + 1] = bfhi(w.x); n1[8 * q + 2] = bflo(w.y); n1[8 * q + 3] = bfhi(w.y); n1[8 * q + 4] = bflo(w.z); n1[8 * q + 5] = bfhi(w.z); n1[8 * q + 6] = bflo(w.w); n1[8 * q + 7] = bfhi(w.w); }
                n0 = MFMA32(pf[0], f00, n0); n1 = MFMA32(pf[2], f00, n1); n0 = MFMA32(pf[1], f01, n0); n1 = MFMA32(pf[3], f01, n1);
                n0 = MFMA32(pf[4], f10, n0); n1 = MFMA32(pf[6], f10, n1); n0 = MFMA32(pf[5], f11, n0); n1 = MFMA32(pf[7], f11, n1);
                slot = (slot + 1 == SB_NSLOT) ? 0 : slot + 1;
                if (c + 1 < NCHK) SB_FETCH(c + 1, slot);
                z0 = n0; z1 = n1; }
#undef SB_FETCH
        } else {
            const int slot = F.wave - 1;
            const unsigned char* gpt = (const unsigned char*)wsp<bf16x8>(F, WS_PT) + lane * 16;
            const unsigned char* gzv = (const unsigned char*)wsp<f32x4>(F, WS_ZV) + lane * 16;
            LAS unsigned char* dst = F.lds + slot * SB_SLOT;
            for (int c = slot; c < NCHK; c += SB_NSLOT) { const int chunk = bh * NCHK + c;
                if (c >= SB_NSLOT) { const unsigned need = (unsigned)(c - SB_NSLOT + 1); int sp = 0;
                    while (DONEC[0] < need) { __builtin_amdgcn_s_sleep(1); if (++sp > SC_SPIN_CAP) break; }
                    __builtin_amdgcn_fence(__ATOMIC_ACQUIRE, "workgroup"); }
                const unsigned char* sp_ = gpt + (size_t)chunk * 8192;
#pragma unroll
                for (int j = 0; j < 8; ++j) __builtin_amdgcn_global_load_lds((const unsigned*)(sp_ + j * 1024), (LAS unsigned*)(dst + j * 1024), 16, 0, 0);
                const unsigned char* sz0 = gzv + ((size_t)(chunk * 2 + 0) * 2 + vh) * 2048; const unsigned char* sz1 = gzv + ((size_t)(chunk * 2 + 1) * 2 + vh) * 2048;
#pragma unroll
                for (int j = 0; j < 2; ++j) { __builtin_amdgcn_global_load_lds((const unsigned*)(sz0 + j * 1024), (LAS unsigned*)(dst + 8192 + j * 1024), 16, 0, 0);
                    __builtin_amdgcn_global_load_lds((const unsigned*)(sz1 + j * 1024), (LAS unsigned*)(dst + 10240 + j * 1024), 16, 0, 0); }
                asm volatile("s_waitcnt vmcnt(0)" ::: "memory");
                if (lane == 0) FULL[slot] = (unsigned)(c + 1); }
        }
    } else {
#if MK_ATTN_IN_4B
        phase5_attn_part(F, F.vcu - 128, 128);
#else
        for (int it = (F.vcu - 128) * 8 + F.wave; it < CONV_4B; it += 128 * 8) moe_weight_item(F, it);
#endif
    }
    __syncthreads();
}

__device__ __forceinline__ void phase4c_output(const Frame& F) {
    const bf16x8* Z0 = wsp<bf16x8>(F, WS_Z0); const bf16x8* RYT = wsp<bf16x8>(F, WS_RYT); const f32x4* YVT = wsp<f32x4>(F, WS_YVT);
    const float* SV = wsp<float>(F, WS_SV); const bf16* G = wsp<bf16>(F, WS_G); const float* BON = wsp<float>(F, WS_BONUS); bf16* CAT = wsp<bf16>(F, WS_CAT);
    const float* lg = F.in[15]; const float* lb = F.in[16];
    const int gw = F.vcu * 8 + F.wave, NGW = F.G * 8, lane = F.lane, r = lane & 31, h = lane >> 5;
    for (int tc = F.vcu; tc < M / CK; tc += F.G) {
        const int b = tc / NCHK, c = tc % NCHK, hh = F.wave, bh = b * RH + hh, chunk = bh * NCHK + c, t = c * CK + r, row = b * T + t;
        bf16x8 rf[4], zf[2][4]; u32x4 yv[2][2]; u32x2 vv[2][4], gr[2][4];
#pragma unroll
        for (int q = 0; q < 4; ++q) rf[q] = __builtin_nontemporal_load(RYT + (size_t)chunk * 4 * 64 + lane + q * 64);
#pragma unroll
        for (int vh = 0; vh < 2; ++vh)
#pragma unroll
            for (int q = 0; q < 4; ++q) { if (q < 2) yv[vh][q] = __builtin_nontemporal_load((const u32x4*)YVT + ((size_t)(chunk * 2 + vh) * 64 + lane) * 2 + q);
                zf[vh][q] = __builtin_nontemporal_load(Z0 + (size_t)(chunk * 2 + vh) * 4 * 64 + lane + q * 64); }
        const float bon = BON[row * 8 + hh];
#pragma unroll
        for (int vh = 0; vh < 2; ++vh)
#pragma unroll
            for (int g = 0; g < 4; ++g) { const int v0 = 32 * vh + 8 * g + 4 * h, c0 = hh * 64 + v0;
                vv[vh][g] = __builtin_nontemporal_load((const u32x2*)((const bf16*)SV + ((size_t)bh * T + t) * 64 + v0));
                gr[vh][g] = __builtin_nontemporal_load((const u32x2*)(G + (size_t)row * 512 + c0)); }
        f32x16 y[2];
#pragma unroll
        for (int vh = 0; vh < 2; ++vh) {
#pragma unroll
            for (int q = 0; q < 2; ++q) { const u32x4 u = yv[vh][q]; y[vh][8 * q] = bflo(u.x); y[vh][8 * q + 1] = bfhi(u.x); y[vh][8 * q + 2] = bflo(u.y); y[vh][8 * q + 3] = bfhi(u.y);
                y[vh][8 * q + 4] = bflo(u.z); y[vh][8 * q + 5] = bfhi(u.z); y[vh][8 * q + 6] = bflo(u.w); y[vh][8 * q + 7] = bfhi(u.w); }
#pragma unroll
            for (int q = 0; q < 4; ++q) y[vh] = MFMA32(zf[vh][q], rf[q], y[vh]); }
        float sm = 0.f;
#pragma unroll
        for (int vh = 0; vh < 2; ++vh)
#pragma unroll
            for (int i = 0; i < 16; ++i) sm += y[vh][i];
        sm += __shfl_xor(sm, 32);
        const float mean = sm * (1.f / 64.f); float qv = 0.f;
#pragma unroll
        for (int vh = 0; vh < 2; ++vh)
#pragma unroll
            for (int i = 0; i < 16; ++i) { y[vh][i] -= mean; qv += y[vh][i] * y[vh][i]; }
        qv += __shfl_xor(qv, 32);
        const float rstd = rsqrtf(qv * (1.f / 64.f) + GN_EPS);
#pragma unroll
        for (int vh = 0; vh < 2; ++vh)
#pragma unroll
            for (int g = 0; g < 4; ++g) { const int v0 = 32 * vh + 8 * g + 4 * h, c0 = hh * 64 + v0;
                const f32x4 lg4 = *(const f32x4*)(lg + c0), lb4 = *(const f32x4*)(lb + c0);
                const float gg[4] = {bflo(gr[vh][g].x), bfhi(gr[vh][g].x), bflo(gr[vh][g].y), bfhi(gr[vh][g].y)}; float o[4];
                const float vf[4] = {bflo(vv[vh][g].x), bfhi(vv[vh][g].x), bflo(vv[vh][g].y), bfhi(vv[vh][g].y)};
#pragma unroll
                for (int q = 0; q < 4; ++q) o[q] = (y[vh][4 * g + q] * rstd * lg4[q] + lb4[q] + bon * vf[q]) * gg[q];
                u32x2 w; w.x = pk2(o[0], o[1]); w.y = pk2(o[2], o[3]);
                *(u32x2*)(CAT + (size_t)row * D + c0) = w; }
    }
}

constexpr int SC_STEPS = 16, SC_NSLOT = 6, SC_SHARED = SC_STEPS * 1280, SC_SLOT = SC_SHARED + SC_STEPS * 64, SC_RING = SC_NSLOT * SC_SLOT;
constexpr int SC_FLAGS = SC_RING, SC_CONV = SC_RING + 256, SC_NCH = T / SC_STEPS;
static_assert(SC_CONV + 3 * 8704 <= LDS_BYTES, "scan LDS map");
__device__ __forceinline__ void phase4_scan(const Frame& F) {
    volatile LAS unsigned* READY = (volatile LAS unsigned*)(F.lds + SC_FLAGS);
    volatile LAS unsigned* DONE = (volatile LAS unsigned*)(F.lds + SC_FLAGS + 64);
    __syncthreads();
    if (F.tid < 64) ((LAS unsigned*)(F.lds + SC_FLAGS))[F.tid] = 0u;
    __syncthreads();
    const int bh = F.vcu >> 2, rg = F.vcu & 3, b = bh / RH, hh = bh % RH;
    if (F.wave < 4) {
        const int rl = F.lane >> 4, ks = F.lane & 15, rowl = F.wave * 4 + rl;
        float* yp = wsp<float>(F, WS_Y) + (size_t)b * T * 512 + hh * 64 + rg * 16 + rowl;
        f32x4 S = (f32x4){0.f, 0.f, 0.f, 0.f};
        int slot = 0;
        for (int c = 0; c < SC_NCH; ++c) {
#if MK_RWKV_MODE == 1
            if ((c & 1) == 0) {
                const int v = rg * 16 + rowl, chunk = bh * NCHK + (c >> 1);
                const bf16* zp = wsp<bf16>(F, WS_Z0) + ((((size_t)chunk * 2 + (v >> 5)) * 2 + (ks >> 3)) * 2 + ((ks >> 2) & 1)) * 512 + ((v & 31) + 32 * (ks & 1)) * 8 + 4 * ((ks >> 1) & 1);
                const u32x2 zz = *(const u32x2*)zp;
                S = (f32x4){bflo(zz.x), bfhi(zz.x), bflo(zz.y), bfhi(zz.y)}; }
#endif
            { int sp = 0; while (READY[slot] < (unsigned)(c + 1)) { if (++sp > SC_SPIN_CAP) break; } }
            __builtin_amdgcn_fence(__ATOMIC_ACQUIRE, "workgroup");
            const LAS unsigned char* sb = F.lds + slot * SC_SLOT;
            const LAS unsigned char* op = sb + ks * 16; const LAS float* vp = (const LAS float*)(sb + SC_SHARED) + rowl;
            f32x4 w4 = *(const LAS f32x4*)(op), kk4 = *(const LAS f32x4*)(op + 256), b4 = *(const LAS f32x4*)(op + 512), k4 = *(const LAS f32x4*)(op + 768), r4 = *(const LAS f32x4*)(op + 1024);
            float v = vp[0];
            float ykeep = 0.f;
#pragma unroll
            for (int s = 0; s < SC_STEPS; ++s) {
                const f32x4 cw = w4, ckk = kk4, cb = b4, ck = k4, cr = r4; const float cv = v;
                if (s + 1 < SC_STEPS) { const LAS unsigned char* o2 = op + (s + 1) * 1280;
                    w4 = *(const LAS f32x4*)(o2); kk4 = *(const LAS f32x4*)(o2 + 256); b4 = *(const LAS f32x4*)(o2 + 512); k4 = *(const LAS f32x4*)(o2 + 768); r4 = *(const LAS f32x4*)(o2 + 1024);
                    v = vp[(s + 1) * 16]; }
                if (s == SC_STEPS - 1) { asm volatile("s_waitcnt lgkmcnt(0)" ::: "memory"); if (F.lane == 0) DONE[F.wave] = (unsigned)(c + 1); }
                float p = (S[0] * ckk[0] + S[1] * ckk[1]) + (S[2] * ckk[2] + S[3] * ckk[3]);
                p = reduce16(p);
                const f32x4 tt = S * cw + ck * cv;
                S = tt - cb * p;
                float q = (S[0] * cr[0] + S[1] * cr[1]) + (S[2] * cr[2] + S[3] * cr[3]);
                q = reduce16(q);
                ykeep = (ks == s) ? q : ykeep;
            }
            yp[(size_t)(c * SC_STEPS + ks) * 512] = ykeep;
            slot = (slot + 1 == SC_NSLOT) ? 0 : slot + 1;
        }
    } else if (F.wave == 4) {
        const unsigned char* gs = (const unsigned char*)(wsp<float>(F, WS_SCN) + (size_t)bh * T * 320) + F.lane * 16;
        const unsigned char* gv = (const unsigned char*)(wsp<float>(F, WS_SV) + (size_t)bh * T * 64 + (F.lane >> 2) * 64 + rg * 16 + (F.lane & 3) * 4);
        int slot = 0;
        for (int c = 0; c < SC_NCH; ++c) {
            if (c >= SC_NSLOT) { const unsigned need = (unsigned)(c - SC_NSLOT + 1); int sp = 0;
                while (DONE[0] < need || DONE[1] < need || DONE[2] < need || DONE[3] < need) { __builtin_amdgcn_s_sleep(1); if (++sp > SC_SPIN_CAP) break; }
                __builtin_amdgcn_fence(__ATOMIC_ACQUIRE, "workgroup"); }
            LAS unsigned char* dst = F.lds + slot * SC_SLOT;
            const unsigned char* src = gs + (size_t)c * SC_SHARED;
#pragma unroll
            for (int j = 0; j < SC_SHARED / 1024; ++j) __builtin_amdgcn_global_load_lds((const unsigned*)(src + j * 1024), (LAS unsigned*)(dst + j * 1024), 16, 0, 0);
            __builtin_amdgcn_global_load_lds((const unsigned*)(gv + (size_t)c * SC_STEPS * 256), (LAS unsigned*)(dst + SC_SHARED), 16, 0, 0);
            if (c >= 2) { asm volatile("s_waitcnt vmcnt(42)" ::: "memory"); const int ps = (slot >= 2) ? slot - 2 : slot + SC_NSLOT - 2; if (F.lane == 0) READY[ps] = (unsigned)(c - 1); }
            slot = (slot + 1 == SC_NSLOT) ? 0 : slot + 1;
        }
        { asm volatile("s_waitcnt vmcnt(21)" ::: "memory"); const int ps = (slot >= 2) ? slot - 2 : slot + SC_NSLOT - 2; if (F.lane == 0) READY[ps] = (unsigned)(SC_NCH - 1); }
        { asm volatile("s_waitcnt vmcnt(0)" ::: "memory"); const int ps = (slot >= 1) ? slot - 1 : SC_NSLOT - 1; if (F.lane == 0) READY[ps] = (unsigned)(SC_NCH); }
    } else {
#if MK_CONV_IN_SCAN
        for (int it = F.vcu * 3 + (F.wave - 5); it < MOE_ITEMS; it += F.G * 3) moe_weight_item(F, it);
#endif
    }
    __syncthreads();
}

constexpr int KLD = 72;
constexpr int VLD = 260;
__device__ __forceinline__ void phase5_attn_part(const Frame& F, int first, int stride) {
    const bf16* P = wsp<bf16>(F, WS_P);
    bf16* CAT = wsp<bf16>(F, WS_CAT);
    const float* qg = F.in[17]; const float* kg = F.in[18]; const float* sinks = F.in[19];
    LAS bf16* Kl = (LAS bf16*)F.lds;
    LAS bf16* Vt = (LAS bf16*)(F.lds + 256 * KLD * 2);
    const int lane = F.lane, r = lane & 31, h = lane >> 5;
    for (int unit = first; unit < NBATCH * KVH * (T / 128); unit += stride) {
        const int blk = unit % (T / 128), kvh = (unit / (T / 128)) % KVH, b = unit / (T / 128 * KVH);
        const int kpos0 = blk * 128 - 128;
        __syncthreads();
        u32x4 kr4[4], vr4[4];
#pragma unroll
        for (int it = 0; it < 4; ++it) { const int ch = F.tid + 512 * it, key = ch >> 3, dc = ch & 7, kpos = kpos0 + key;
            const size_t ro = (size_t)(b * T + (kpos >= 0 ? kpos : 0)) * IN_COLS;
            kr4[it] = *(const u32x4*)(P + ro + COL_K + kvh * 64 + dc * 8); vr4[it] = *(const u32x4*)(P + ro + COL_V + kvh * 64 + dc * 8); }
#pragma unroll
        for (int it = 0; it < 4; ++it) { const int ch = F.tid + 512 * it, key = ch >> 3, dc = ch & 7, kpos = kpos0 + key;
            u32x4 kraw = kr4[it], vraw = vr4[it];
            if (kpos < 0) { kraw = (u32x4){0u, 0u, 0u, 0u}; vraw = (u32x4){0u, 0u, 0u, 0u}; }
            float kf[8]; kf[0] = bflo(kraw.x); kf[1] = bfhi(kraw.x); kf[2] = bflo(kraw.y); kf[3] = bfhi(kraw.y); kf[4] = bflo(kraw.z); kf[5] = bfhi(kraw.z); kf[6] = bflo(kraw.w); kf[7] = bfhi(kraw.w);
            float ss = 0.f;
#pragma unroll
            for (int j = 0; j < 8; ++j) ss += kf[j] * kf[j];
            ss += __shfl_xor(ss, 1); ss += __shfl_xor(ss, 2); ss += __shfl_xor(ss, 4);
            const float rstd = rsqrtf(ss * (1.f / 64.f) + NORM_EPS);
            const f32x4 g0 = *(const f32x4*)(kg + dc * 8), g1 = *(const f32x4*)(kg + dc * 8 + 4);
            u32x4 ko; ko.x = pk2(kf[0] * rstd * g0[0], kf[1] * rstd * g0[1]); ko.y = pk2(kf[2] * rstd * g0[2], kf[3] * rstd * g0[3]);
            ko.z = pk2(kf[4] * rstd * g1[0], kf[5] * rstd * g1[1]); ko.w = pk2(kf[6] * rstd * g1[2], kf[7] * rstd * g1[3]);
            *(LAS u32x4*)(Kl + key * KLD + dc * 8) = ko;
            const unsigned vv[4] = {vraw.x, vraw.y, vraw.z, vraw.w};
#pragma unroll
            for (int j = 0; j < 4; ++j) { Vt[(dc * 8 + 2 * j) * VLD + key] = (bf16)(vv[j] & 0xffffu); Vt[(dc * 8 + 2 * j + 1) * VLD + key] = (bf16)(vv[j] >> 16); }
        }
        __syncthreads();
        for (int task = F.wave; task < 16; task += 8) {
            const int g = task & 3, qs = task >> 2, head = kvh * 4 + g;
            const int qrow = b * T + blk * 128 + qs * 32 + r;
            float qf[4][8]; float ss = 0.f;
#pragma unroll
            for (int s = 0; s < 4; ++s) { const u32x4 qr = *(const u32x4*)(P + (size_t)qrow * IN_COLS + COL_Q + head * 64 + 16 * s + 8 * h);
                qf[s][0] = bflo(qr.x); qf[s][1] = bfhi(qr.x); qf[s][2] = bflo(qr.y); qf[s][3] = bfhi(qr.y); qf[s][4] = bflo(qr.z); qf[s][5] = bfhi(qr.z); qf[s][6] = bflo(qr.w); qf[s][7] = bfhi(qr.w);
#pragma unroll
                for (int j = 0; j < 8; ++j) ss += qf[s][j] * qf[s][j]; }
            ss += __shfl_xor(ss, 32);
            const float qscale = rsqrtf(ss * (1.f / 64.f) + NORM_EPS) * 0.125f;
            bf16x8 qb[4];
#pragma unroll
            for (int s = 0; s < 4; ++s) { u32x4 w;
                const f32x4 g0 = *(const f32x4*)(qg + 16 * s + 8 * h), g1 = *(const f32x4*)(qg + 16 * s + 8 * h + 4);
                w.x = pk2(qf[s][0] * qscale * g0[0], qf[s][1] * qscale * g0[1]); w.y = pk2(qf[s][2] * qscale * g0[2], qf[s][3] * qscale * g0[3]);
                w.z = pk2(qf[s][4] * qscale * g1[0], qf[s][5] * qscale * g1[1]); w.w = pk2(qf[s][6] * qscale * g1[2], qf[s][7] * qscale * g1[3]);
                qb[s] = __builtin_bit_cast(bf16x8, w); }
            f32x16 st[5];
#pragma unroll
            for (int kt = 0; kt < 5; ++kt) {
#pragma unroll
                for (int i = 0; i < 16; ++i) st[kt][i] = 0.f;
#pragma unroll
                for (int s = 0; s < 4; ++s) { const bf16x8 ka = *(const LAS bf16x8*)(Kl + (32 * (qs + kt) + r) * KLD + 16 * s + 8 * h);
                    st[kt] = __builtin_amdgcn_mfma_f32_32x32x16_bf16(ka, qb[s], st[kt], 0, 0, 0); }
            }
            const int iq = 32 * qs + r;
            const float sink = sinks[head];
            float mx = sink;
#pragma unroll
            for (int kt = 0; kt < 5; ++kt)
#pragma unroll
                for (int i = 0; i < 16; ++i) { const int jw = 32 * (qs + kt) + (i & 3) + 8 * (i >> 2) + 4 * h;
                    const bool ok = (jw >= iq + 1) && (jw <= iq + 128) && (kpos0 + jw >= 0);
                    st[kt][i] = ok ? st[kt][i] : -INFINITY; mx = fmaxf(mx, st[kt][i]); }
            mx = fmaxf(mx, __shfl_xor(mx, 32));
            float lsum = 0.f;
#pragma unroll
            for (int kt = 0; kt < 5; ++kt)
#pragma unroll
                for (int i = 0; i < 16; ++i) { const float p = __expf(st[kt][i] - mx); st[kt][i] = p; lsum += p; }
            lsum += __shfl_xor(lsum, 32);
            const float linv = __builtin_amdgcn_rcpf(lsum + __expf(sink - mx));
            f32x16 o[2];
#pragma unroll
            for (int dt = 0; dt < 2; ++dt)
#pragma unroll
                for (int i = 0; i < 16; ++i) o[dt][i] = 0.f;
#pragma unroll
            for (int kt = 0; kt < 5; ++kt)
#pragma unroll
                for (int sp = 0; sp < 2; ++sp) { u32x4 pw;
                    pw.x = pk2(st[kt][8 * sp + 0] * linv, st[kt][8 * sp + 1] * linv); pw.y = pk2(st[kt][8 * sp + 2] * linv, st[kt][8 * sp + 3] * linv);
                    pw.z = pk2(st[kt][8 * sp + 4] * linv, st[kt][8 * sp + 5] * linv); pw.w = pk2(st[kt][8 * sp + 6] * linv, st[kt][8 * sp + 7] * linv);
                    const bf16x8 pa = __builtin_bit_cast(bf16x8, pw);
                    const int kb = 32 * (qs + kt) + 16 * sp + 4 * h;
#pragma unroll
                    for (int dt = 0; dt < 2; ++dt) { const LAS bf16* vp = Vt + (32 * dt + r) * VLD + kb;
                        const u32x2 lo = *(const LAS u32x2*)vp, hi = *(const LAS u32x2*)(vp + 8);
                        u32x4 vw; vw.x = lo.x; vw.y = lo.y; vw.z = hi.x; vw.w = hi.y;
                        o[dt] = __builtin_amdgcn_mfma_f32_32x32x16_bf16(pa, __builtin_bit_cast(bf16x8, vw), o[dt], 0, 0, 0); } }
            { LAS bf16* ot = (LAS bf16*)(F.lds + 256 * KLD * 2 + 64 * VLD * 2) + F.wave * (32 * 72);
#pragma unroll
                for (int dt = 0; dt < 2; ++dt)
#pragma unroll
                    for (int i = 0; i < 16; ++i) { const int qr = (i & 3) + 8 * (i >> 2) + 4 * h; ot[qr * 72 + 32 * dt + r] = (bf16)f2bf(o[dt][i]); }
                asm volatile("s_waitcnt lgkmcnt(0)" ::: "memory");
#pragma unroll
                for (int j = 0; j < 4; ++j) { const int id = lane + 64 * j, qr = id >> 3, pc = id & 7;
                    const u32x4 w = *(const LAS u32x4*)(ot + qr * 72 + pc * 8);
                    *(u32x4*)(CAT + (size_t)(b * T + blk * 128 + qs * 32 + qr) * D + 512 + head * 64 + pc * 8) = w; }
                asm volatile("s_waitcnt lgkmcnt(0)" ::: "memory"); }
        }
    }
}

__device__ __forceinline__ void phase5_attn(const Frame& F) { phase5_attn_part(F, F.vcu, F.G); }
__device__ __forceinline__ void phase6(const Frame& F) {
    const int gw = F.vcu * 8 + F.wave, NGW = F.G * 8;
    const float* Y = wsp<float>(F, WS_Y); const float* SV = wsp<float>(F, WS_SV); const bf16* G = wsp<bf16>(F, WS_G); const float* BON = wsp<float>(F, WS_BONUS);
    bf16* CAT = wsp<bf16>(F, WS_CAT);
    const float* lg = F.in[15]; const float* lb = F.in[16];
    const int hh = F.lane >> 3, n0 = (F.lane & 7) * 8, c0 = F.lane * 8;
    for (int row = gw; row < M; row += NGW) { const int b = row / T, t = row % T;
        const f32x4 y0 = *(const f32x4*)(Y + (size_t)row * 512 + c0), y1 = *(const f32x4*)(Y + (size_t)row * 512 + c0 + 4);
        float yv[8] = {y0[0], y0[1], y0[2], y0[3], y1[0], y1[1], y1[2], y1[3]};
        float s = 0.f;
#pragma unroll
        for (int j = 0; j < 8; ++j) s += yv[j];
        s += __shfl_xor(s, 1); s += __shfl_xor(s, 2); s += __shfl_xor(s, 4);
        const float mean = s * (1.f / 64.f); float q = 0.f;
#pragma unroll
        for (int j = 0; j < 8; ++j) { yv[j] -= mean; q += yv[j] * yv[j]; }
        q += __shfl_xor(q, 1); q += __shfl_xor(q, 2); q += __shfl_xor(q, 4);
        const float rstd = rsqrtf(q * (1.f / 64.f) + GN_EPS);
        const float bon = BON[row * 8 + hh];
        const float* vp = SV + ((size_t)(b * RH + hh) * T + t) * 64 + n0;
        const f32x4 v0 = *(const f32x4*)vp, v1 = *(const f32x4*)(vp + 4);
        const float vv[8] = {v0[0], v0[1], v0[2], v0[3], v1[0], v1[1], v1[2], v1[3]};
        const u32x4 graw = *(const u32x4*)(G + (size_t)row * 512 + c0);
        const float gg[8] = {bflo(graw.x), bfhi(graw.x), bflo(graw.y), bfhi(graw.y), bflo(graw.z), bfhi(graw.z), bflo(graw.w), bfhi(graw.w)};
        float ov[8];
#pragma unroll
        for (int j = 0; j < 8; ++j) ov[j] = (yv[j] * rstd * lg[c0 + j] + lb[c0 + j] + bon * vv[j]) * gg[j];
        u32x4 w; w.x = pk2(ov[0], ov[1]); w.y = pk2(ov[2], ov[3]); w.z = pk2(ov[4], ov[5]); w.w = pk2(ov[6], ov[7]);
        *(u32x4*)(CAT + (size_t)row * D + c0) = w; }
}

__device__ __forceinline__ float reduce32x64(float (&v)[32], int lane) {
#pragma unroll
    for (int i = 0; i < 16; ++i) { const bool hi = lane & 16; const float send = hi ? v[i] : v[i + 16], keep = hi ? v[i + 16] : v[i]; v[i] = keep + __shfl_xor(send, 16); }
#pragma unroll
    for (int i = 0; i < 8; ++i) { const bool hi = lane & 8; const float send = hi ? v[i] : v[i + 8], keep = hi ? v[i + 8] : v[i]; v[i] = keep + __shfl_xor(send, 8); }
#pragma unroll
    for (int i = 0; i < 4; ++i) { const bool hi = lane & 4; const float send = hi ? v[i] : v[i + 4], keep = hi ? v[i + 4] : v[i]; v[i] = keep + __shfl_xor(send, 4); }
#pragma unroll
    for (int i = 0; i < 2; ++i) { const bool hi = lane & 2; const float send = hi ? v[i] : v[i + 2], keep = hi ? v[i + 2] : v[i]; v[i] = keep + __shfl_xor(send, 2); }
    { const bool hi = lane & 1; const float send = hi ? v[0] : v[1], keep = hi ? v[1] : v[0]; v[0] = keep + __shfl_xor(send, 1); }
    return v[0] + __shfl_xor(v[0], 32);
}
__device__ __forceinline__ void phase8(const Frame& F) {
    const float* mod = wsp<float>(F, WS_MOD); const bf16* x1 = wsp<bf16>(F, WS_X1B);
    const float* wr_ = F.in[22]; const float* br = F.in[23];
    LAS float* Wt = (LAS float*)F.lds;
    LAS float* lgw = (LAS float*)(F.lds + 131072 + F.wave * 512);
    LAS int* cnt = (LAS int*)(F.lds + 131072 + 4096);
    __syncthreads();
    for (int idx = F.tid; idx < 8192; idx += 512) { const int k = idx >> 3, e4 = idx & 7; const f32x4 w = *(const f32x4*)(wr_ + k * 32 + e4 * 4);
        Wt[(4 * e4 + 0) * 1024 + k] = w[0]; Wt[(4 * e4 + 1) * 1024 + k] = w[1]; Wt[(4 * e4 + 2) * 1024 + k] = w[2]; Wt[(4 * e4 + 3) * 1024 + k] = w[3]; }
    if (F.tid < 32) cnt[F.tid] = 0;
    __syncthreads();
    int* RT_E = wsp<int>(F, WS_RT_E); int* RT_LP = wsp<int>(F, WS_RT_LP); float* RT_G = wsp<float>(F, WS_RT_G);
    const int e = F.lane & 31;
    const float bre = br[e];
    f32x4 shq[4], scq[4];
    { const int b = (F.vcu * 128) / T;
#pragma unroll
        for (int j = 0; j < 4; ++j) { const int col = 4 * F.lane + 256 * j; shq[j] = *(const f32x4*)(mod + b * 6144 + 3072 + col); scq[j] = (*(const f32x4*)(mod + b * 6144 + 4096 + col) + 1.f) * *(const f32x4*)(F.in[21] + col); } }
#if MK_CONV_WHERE == 8
    const int p_lo = F.wave < 4 ? 11 * F.wave : 44 + 10 * (F.wave - 4), p_n = F.wave < 4 ? 11 : 10;
    if (F.wave >= 6) { for (int it = CONV_4B + F.vcu * 2 + (F.wave - 6); it < MOE_ITEMS; it += F.G * 2) moe_weight_item(F, it); }
    else {
#else
    const int p_lo = 8 * F.wave, p_n = 8;
    {
#endif
    u32x2 xn[2][4];
#pragma unroll
    for (int q = 0; q < 2; ++q)
#pragma unroll
        for (int j = 0; j < 4; ++j) xn[q][j] = ((const u32x2*)(x1 + (size_t)(F.vcu * 128 + 2 * p_lo + q) * D))[F.lane + 64 * j];
    for (int pr = 0; pr < p_n; ++pr) { const int row0 = F.vcu * 128 + 2 * (p_lo + pr);
        f32x4 h0[4], h1[4];
        float ss0 = 0.f, ss1 = 0.f;
#pragma unroll
        for (int j = 0; j < 4; ++j) { h0[j] = (f32x4){bflo(xn[0][j].x), bfhi(xn[0][j].x), bflo(xn[0][j].y), bfhi(xn[0][j].y)}; h1[j] = (f32x4){bflo(xn[1][j].x), bfhi(xn[1][j].x), bflo(xn[1][j].y), bfhi(xn[1][j].y)};
            ss0 += (h0[j][0] * h0[j][0] + h0[j][1] * h0[j][1]) + (h0[j][2] * h0[j][2] + h0[j][3] * h0[j][3]); ss1 += (h1[j][0] * h1[j][0] + h1[j][1] * h1[j][1]) + (h1[j][2] * h1[j][2] + h1[j][3] * h1[j][3]); }
        { const int nr = row0 + (pr + 1 < p_n ? 2 : 0);
#pragma unroll
            for (int q = 0; q < 2; ++q)
#pragma unroll
                for (int j = 0; j < 4; ++j) xn[q][j] = ((const u32x2*)(x1 + (size_t)(nr + q) * D))[F.lane + 64 * j]; }
#pragma unroll
        for (int o = 1; o < 64; o <<= 1) { ss0 += __shfl_xor(ss0, o); ss1 += __shfl_xor(ss1, o); }
        const float rs0 = rsqrtf(ss0 * (1.f / D) + NORM_EPS), rs1 = rsqrtf(ss1 * (1.f / D) + NORM_EPS);
        unsigned char* o0 = wsp<unsigned char>(F, WS_H8) + (size_t)row0 * D * (MK_FP8 ? 1 : 2); unsigned char* o1 = o0 + (size_t)D * (MK_FP8 ? 1 : 2);
#pragma unroll
        for (int j = 0; j < 4; ++j) { h0[j] = h0[j] * rs0 * scq[j] + shq[j]; h1[j] = h1[j] * rs1 * scq[j] + shq[j];
#if MK_FP8
            ((unsigned*)o0)[F.lane + 64 * j] = pg8::pk4_fp8(h0[j][0], h0[j][1], h0[j][2], h0[j][3]); ((unsigned*)o1)[F.lane + 64 * j] = pg8::pk4_fp8(h1[j][0], h1[j][1], h1[j][2], h1[j][3]);
#else
            { u32x2 w; w.x = pk2(h0[j][0], h0[j][1]); w.y = pk2(h0[j][2], h0[j][3]); ((u32x2*)o0)[F.lane + 64 * j] = w; w.x = pk2(h1[j][0], h1[j][1]); w.y = pk2(h1[j][2], h1[j][3]); ((u32x2*)o1)[F.lane + 64 * j] = w; }
#endif
        }
        float pa0[32], pa1[32];
#pragma unroll
        for (int q = 0; q < 32; ++q) { float s0 = 0.f, s1 = 0.f;
#pragma unroll
            for (int j = 0; j < 4; ++j) { const f32x4 w4 = *(const LAS f32x4*)(Wt + q * 1024 + 4 * F.lane + 256 * j);
                s0 = fmaf(h0[j][0], w4[0], s0); s0 = fmaf(h0[j][1], w4[1], s0); s0 = fmaf(h0[j][2], w4[2], s0); s0 = fmaf(h0[j][3], w4[3], s0);
                s1 = fmaf(h1[j][0], w4[0], s1); s1 = fmaf(h1[j][1], w4[1], s1); s1 = fmaf(h1[j][2], w4[2], s1); s1 = fmaf(h1[j][3], w4[3], s1); }
            pa0[q] = s0; pa1[q] = s1; }
        const float lg0 = reduce32x64(pa0, F.lane) + bre, lg1 = reduce32x64(pa1, F.lane) + bre;
#pragma unroll
        for (int q = 0; q < 2; ++q) { const float logit = q ? lg1 : lg0; const int row = row0 + q; LAS float* lg32 = lgw + q * 64;
            if (F.lane < 32) lg32[e] = logit;
            asm volatile("s_waitcnt lgkmcnt(0)" ::: "memory");
            int rank = 0;
#pragma unroll 8
            for (int o = 0; o < 32; ++o) { const float ov = lg32[o]; rank += (ov > logit || (ov == logit && o < e)) ? 1 : 0; }
            if (F.lane < 32 && rank < 4) lg32[32 + rank] = logit;
            asm volatile("s_waitcnt lgkmcnt(0)" ::: "memory");
            const float t0 = lg32[32], t1 = lg32[33], t2 = lg32[34], t3 = lg32[35];
            const float den = 1.f + __expf(t1 - t0) + __expf(t2 - t0) + __expf(t3 - t0);
            if (F.lane < 32 && rank < 4) { const int lp = atomicAdd((int*)&cnt[e], 1);
                RT_E[row * 4 + rank] = e; RT_LP[row * 4 + rank] = lp; RT_G[row * 4 + rank] = __expf(logit - t0) / den; }
            asm volatile("s_waitcnt lgkmcnt(0)" ::: "memory"); }
    }
    }
    __syncthreads();
    if (F.tid < 32) wsp<int>(F, WS_BLKCNT)[F.vcu * 32 + F.tid] = cnt[F.tid];
}

__device__ __forceinline__ void phase9(const Frame& F) {
    LAS int* base = (LAS int*)F.lds;
    LAS int* tot = base + 32;
    LAS int* pst = base + 64;
    const int* BC = wsp<int>(F, WS_BLKCNT);
    { LAS int* ps = base + 128; LAS int* pm = ps + 512;
        const int e = F.tid & 31, seg = F.tid >> 5; int s = 0, mine = 0;
#pragma unroll
        for (int j = 0; j < 16; ++j) { const int bk = seg * 16 + j, v = BC[bk * 32 + e]; s += v; mine += (bk < F.vcu) ? v : 0; }
        ps[seg * 32 + e] = s; pm[seg * 32 + e] = mine; }
    __syncthreads();
    if (F.tid < 32) { int s = 0, mine = 0;
#pragma unroll
        for (int q = 0; q < 16; ++q) { s += base[128 + q * 32 + F.tid]; mine += base[128 + 512 + q * 32 + F.tid]; }
        base[F.tid] = mine; tot[F.tid] = s; }
    __syncthreads();
    if (F.tid == 0) { int s = 0; for (int e = 0; e < 32; ++e) { pst[e] = s; s += (tot[e] + 255) / 256 * 256; } pst[32] = s; }
    __syncthreads();
    int* SLOT_TOK = wsp<int>(F, WS_SLOTTOK); float* SLOT_GATE = wsp<float>(F, WS_SLOTGATE); int* TOK_SLOT = wsp<int>(F, WS_TOKSLOT);
    const int* RT_E = wsp<int>(F, WS_RT_E); const int* RT_LP = wsp<int>(F, WS_RT_LP); const float* RT_G = wsp<float>(F, WS_RT_G);
    { const int idx = F.vcu * 512 + F.tid;
        const int e = RT_E[idx], slot = pst[e] + base[e] + RT_LP[idx];
        SLOT_TOK[slot] = idx >> 2; SLOT_GATE[slot] = RT_G[idx]; TOK_SLOT[idx] = slot; }
    if (F.vcu < 32) { const int e = F.vcu; for (int s = pst[e] + tot[e] + F.tid; s < pst[e + 1]; s += 512) { SLOT_TOK[s] = 0; SLOT_GATE[s] = 0.f; } }
    if (F.vcu == 0) { unsigned* ctl = wsp<unsigned>(F, WS_CTL);
        if (F.tid == 0) ctl[CW_NTILES] = (unsigned)(pst[32] / 256);
        if (F.tid < 33) ctl[CW_PADSTART + F.tid] = (unsigned)pst[F.tid];
        int* TE = wsp<int>(F, WS_TILEE);
        for (int tl = F.tid; tl < MAX_TILES; tl += 512) { int e = 31; for (int q = 0; q < 32; ++q) if (tl * 256 < pst[q + 1]) { e = q; break; } TE[tl] = e; } }
#if MK_CONV_WHERE == 9
    for (int it = CONV_4B + F.vcu * 8 + F.wave; it < MOE_ITEMS; it += F.G * 8) moe_weight_item(F, it);
#endif
}

__device__ __forceinline__ void phase12(const Frame& F) {
    const int gw = F.vcu * 8 + F.wave, NGW = F.G * 8;
    const float* mod = wsp<float>(F, WS_MOD); const bf16* YS = wsp<bf16>(F, WS_YS); const int* TOK_SLOT = wsp<int>(F, WS_TOKSLOT); const bf16* X1B = wsp<bf16>(F, WS_X1B);
    for (int row = gw; row < M; row += 2 * NGW) {
        int sl[2][4]; u32x4 v[2][2][4], xb[2][2];
#pragma unroll
        for (int rr = 0; rr < 2; ++rr)
#pragma unroll
            for (int k = 0; k < 4; ++k) sl[rr][k] = TOK_SLOT[(row + rr * NGW) * 4 + k];
#pragma unroll
        for (int rr = 0; rr < 2; ++rr)
#pragma unroll
            for (int j = 0; j < 2; ++j) { const int col = 8 * F.lane + 512 * j;
#pragma unroll
                for (int k = 0; k < 4; ++k) v[rr][j][k] = __builtin_nontemporal_load((const u32x4*)(YS + (size_t)sl[rr][k] * D + col));
                xb[rr][j] = __builtin_nontemporal_load((const u32x4*)(X1B + (size_t)(row + rr * NGW) * D + col)); }
#pragma unroll
        for (int rr = 0; rr < 2; ++rr) { const int rw = row + rr * NGW, b = rw / T;
#pragma unroll
            for (int j = 0; j < 2; ++j) { const int col = 8 * F.lane + 512 * j;
                float a[8];
#pragma unroll
                for (int q = 0; q < 8; ++q) a[q] = 0.f;
#pragma unroll
                for (int k = 0; k < 4; ++k) { const u32x4 w = v[rr][j][k];
                    a[0] += bflo(w.x); a[1] += bfhi(w.x); a[2] += bflo(w.y); a[3] += bfhi(w.y); a[4] += bflo(w.z); a[5] += bfhi(w.z); a[6] += bflo(w.w); a[7] += bfhi(w.w); }
                const float* gp = mod + b * 6144 + 5120 + col;
                const f32x4 g0 = *(const f32x4*)gp, g1 = *(const f32x4*)(gp + 4);
                float* op = F.out + (size_t)rw * D + col;
                const u32x4 x = xb[rr][j];
                f32x4 x0 = (f32x4){bflo(x.x), bfhi(x.x), bflo(x.y), bfhi(x.y)}, x1v = (f32x4){bflo(x.z), bfhi(x.z), bflo(x.w), bfhi(x.w)};
                x0[0] += g0[0] * a[0]; x0[1] += g0[1] * a[1]; x0[2] += g0[2] * a[2]; x0[3] += g0[3] * a[3];
                x1v[0] += g1[0] * a[4]; x1v[1] += g1[1] * a[5]; x1v[2] += g1[2] * a[6]; x1v[3] += g1[3] * a[7];
                *(f32x4*)op = x0; *(f32x4*)(op + 4) = x1v; } }
    }
}

__device__ __forceinline__ void copy_x_to_out(const Frame& F) {
    const size_t n4 = (size_t)M * D / 4; const f32x4* s = (const f32x4*)F.in[0]; f32x4* d = (f32x4*)F.out;
    for (size_t i = (size_t)blockIdx.x * 512 + F.tid; i < n4; i += (size_t)gridDim.x * 512) d[i] = s[i];
}


#define XB_TMO      128
#define XB_XCNT(j)  (256  + 64 * (j))
#define XB_XSUB(j)  (1280 + 64 * (j))
#define XB_XGEN(j)  (2304 + 64 * (j))
#define XB_TOP      3328
#define XB_TOPGEN   3392
#define XCD_BAR_WORDS 3456
#define XB_SPIN_CAP (1u << 18)
__device__ __forceinline__ unsigned xb_ld(unsigned* p)              { return __hip_atomic_load(p, __ATOMIC_RELAXED, __HIP_MEMORY_SCOPE_AGENT); }
__device__ __forceinline__ unsigned xb_add(unsigned* p, unsigned v) { return __hip_atomic_fetch_add(p, v, __ATOMIC_RELAXED, __HIP_MEMORY_SCOPE_AGENT); }
__device__ __forceinline__ unsigned xb_xcc_id() { return (unsigned)__builtin_amdgcn_s_getreg((3 << 11) | 20) & 0xFu; }
#define XB_SPIN(cond, bar) do { unsigned _sp = 0; while (cond) { __builtin_amdgcn_s_sleep(1); \
    if ((++_sp & 255u) == 0u) { if (xb_ld(&(bar)[XB_TMO])) break; if (_sp > XB_SPIN_CAP) { atomicAdd(&(bar)[XB_TMO], 1u); break; } } } } while (0)
struct XcdBarrier { unsigned* bar; unsigned x; volatile LAS unsigned* st; };
__device__ __forceinline__ XcdBarrier xcd_barrier_post(unsigned* bar, volatile LAS unsigned* st) {
    XcdBarrier b; b.bar = bar; b.x = xb_xcc_id(); b.st = st;
    if (threadIdx.x == 0) (void)xb_add(&bar[XB_XCNT(b.x)], 1u);
    return b;
}
__device__ __forceinline__ void xcd_barrier_complete(unsigned* bar, unsigned x, unsigned& nloc, unsigned& nx) {
    const unsigned G = gridDim.x * gridDim.y * gridDim.z;
    unsigned sum, cnt, mine, sp = 0u;
    for (;;) {
        sum = 0u; cnt = 0u; mine = 0u;
#pragma unroll
        for (unsigned j = 0; j < 16; ++j) { const unsigned c = xb_ld(&bar[XB_XCNT(j)]); sum += c; cnt += (c > 0u) ? 1u : 0u; mine = (j == x) ? c : mine; }
        if (sum == G) break;
        __builtin_amdgcn_s_sleep(1);
        if ((++sp & 255u) == 0u) { if (xb_ld(&bar[XB_TMO])) break; if (sp > XB_SPIN_CAP) { atomicAdd(&bar[XB_TMO], 1u); break; } }
    }
    nloc = mine > 0u ? mine : 1u; nx = cnt > 0u ? cnt : 1u;
}
__device__ __forceinline__ void xcd_barrier(const XcdBarrier& b) {
    asm volatile("s_waitcnt vmcnt(0)" ::: "memory");
    __syncthreads();
    if (threadIdx.x == 0) {
        unsigned* bar = b.bar;
        __builtin_amdgcn_s_waitcnt(0);
        unsigned nloc = b.st[0], nx = b.st[1];
        if (nloc == 0u) { xcd_barrier_complete(bar, b.x, nloc, nx); b.st[0] = nloc; b.st[1] = nx; }
        const unsigned old = xb_add(&bar[XB_XSUB(b.x)], 1u);
        const unsigned gen = old / nloc;
        if (old + 1u == (gen + 1u) * nloc) {
            __builtin_amdgcn_fence(__ATOMIC_RELEASE, "agent");
            asm volatile("s_waitcnt vmcnt(0)" ::: "memory");
            const unsigned og = xb_add(&bar[XB_TOP], 1u);
            const unsigned tg = og / nx;
            if (og + 1u == (tg + 1u) * nx) xb_add(&bar[XB_TOPGEN], 1u);
            else XB_SPIN(xb_ld(&bar[XB_TOPGEN]) == tg, bar);
            __builtin_amdgcn_fence(__ATOMIC_ACQUIRE, "agent");
            xb_add(&bar[XB_XGEN(b.x)], 1u);
            asm volatile("s_waitcnt vmcnt(0)" ::: "memory");
        } else {
            XB_SPIN(xb_ld(&bar[XB_XGEN(b.x)]) == gen, bar);
            __builtin_amdgcn_fence(__ATOMIC_ACQUIRE, "agent");
            asm volatile("s_waitcnt vmcnt(0)" ::: "memory");
        }
    }
    __syncthreads();
}

struct Args { const float* in[28]; float* out; unsigned char* ws; int ph_lo, ph_hi; };
constexpr int N_PHASES = 13;

__global__ void __launch_bounds__(512, 2) mk_fwd(Args args) {
    extern __shared__ __attribute__((aligned(16))) unsigned char lds_raw[];
    Frame F;
    F.lds = (LAS unsigned char*)lds_raw;
    F.tid = threadIdx.x; F.lane = F.tid & 63; F.wave = __builtin_amdgcn_readfirstlane(F.tid >> 6);
    F.G = gridDim.x; { const int bx = blockIdx.x; F.vcu = (F.G % 8 == 0) ? (bx % 8) * (F.G / 8) + bx / 8 : bx; }
    F.in = args.in;
    F.out = args.out; F.ws = args.ws;
    cg::grid_group grid = cg::this_grid();
    const int lo = args.ph_lo, hi = args.ph_hi;
    volatile LAS unsigned* MISC = (volatile LAS unsigned*)(F.lds + MISC_OFF);
    if (F.tid < 16) MISC[F.tid] = 0u;
    __syncthreads();
    XcdBarrier bar; bar.bar = wsp<unsigned>(F, WS_CTL) + CW_BAR; bar.x = 0; bar.st = MISC;
    if (hi - lo > 1) bar = xcd_barrier_post(wsp<unsigned>(F, WS_CTL) + CW_BAR, MISC);
#define IN(k) (lo <= (k) && (k) < hi)
#define REP(k) for (int rep_ = 0; rep_ < 1 + ((MK_REPEAT_MASK >> (k)) & 1); ++rep_)
#define SEAM(k) do { if (IN(k) && IN((k) + 1)) { if ((MK_CG_SEAMS >> (k)) & 1) grid.sync(); else xcd_barrier(bar); } } while (0)

    if (IN(0)) REP(0) { phase0(F); } SEAM(0);
    if (IN(1)) REP(1) { phase1(F); } SEAM(1);
    if (IN(2)) REP(2) {
#if MK_CONV_WHERE == 2
        if ((int)blockIdx.x >= 192) { for (int it = ((int)blockIdx.x - 192) * 8 + F.wave; it < MOE_ITEMS; it += 64 * 8) moe_weight_item(F, it); }
        else {
        pg8::Gemm g{wsp<bf16>(F, WS_H), wsp<bf16>(F, WS_WIN), D, IN_COLS, nullptr};
        pg8::StaticOrder S; S.init(M, IN_COLS, 192, (int)blockIdx.x);
        pg8::EpiBf16P E{wsp<bf16>(F, WS_P), IN_COLS};
        pg8::gemm_phase<pg8::EpiBf16P, pg8::StaticOrder, false>(F.lds, g, S, E);
        }
#else
        pg8::Gemm g{wsp<bf16>(F, WS_H), wsp<bf16>(F, WS_WIN), D, IN_COLS, nullptr};
        pg8::StaticOrder S; S.init(M, IN_COLS, F.G, (int)blockIdx.x);
        pg8::EpiBf16P E{wsp<bf16>(F, WS_P), IN_COLS};
        pg8::gemm_phase<pg8::EpiBf16P, pg8::StaticOrder, false>(F.lds, g, S, E);
#endif
    } SEAM(2);
#if MK_RWKV_MODE < 3
    if (IN(3)) REP(3) { phase3(F); } SEAM(3);
#endif
    if (IN(4)) REP(4) {
#if MK_RWKV_MODE >= 1
#if MK_RWKV_MODE == 4
#if MK_WMASK != 63
        phase4a_fused(F); xcd_barrier(bar);
#endif
        for (int q_ = 0; q_ < 1 + (MK_REP4 & 1); ++q_) { phase4a_wave(F); xcd_barrier(bar); }
#elif MK_RWKV_MODE == 3
        for (int q_ = 0; q_ < 1 + (MK_REP4 & 1); ++q_) { phase4a_fused(F); xcd_barrier(bar); }
#else
        for (int q_ = 0; q_ < 1 + (MK_REP4 & 1); ++q_) { phase4a_summaries(F); xcd_barrier(bar); }
#endif
        for (int q_ = 0; q_ < 1 + ((MK_REP4 >> 1) & 1); ++q_) { phase4b_states(F); xcd_barrier(bar); }
#endif
#if MK_RWKV_MODE >= 2
        for (int q_ = 0; q_ < 1 + ((MK_REP4 >> 2) & 1); ++q_) phase4c_output(F);
#else
        phase4_scan(F);
#endif
        } SEAM(4);
#if !MK_ATTN_IN_4B
    if (IN(5)) REP(5) { phase5_attn(F); } SEAM(5);
#endif
#if MK_RWKV_MODE < 2
    if (IN(6)) REP(6) { phase6(F); } SEAM(6);
#endif
    if (IN(7)) REP(7) {
#if MK_LAST_PHASE >= 7
        pg8::Gemm g{wsp<bf16>(F, WS_CAT), wsp<bf16>(F, WS_WOUT), D, D, nullptr};
        pg8::StaticOrder S; S.init(M, D, F.G, (int)blockIdx.x);
        pg8::EpiOutProj E{F.in[0], wsp<bf16>(F, WS_X1B), wsp<float>(F, WS_MOD) + 2048};
        pg8::gemm_phase<pg8::EpiOutProj, pg8::StaticOrder, false>(F.lds, g, S, E);
#else
        copy_x_to_out(F);
#endif
    } SEAM(7);
    if (IN(8)) REP(8) { phase8(F); } SEAM(8);
    if (IN(9)) REP(9) { phase9(F); } SEAM(9);
    if (IN(10)) REP(10) {
        const unsigned* ctl = wsp<unsigned>(F, WS_CTL);
        pg8::Gemm g{wsp<bf16>(F, WS_H8), wsp<bf16>(F, WS_W1), MK_FP8 ? D / 2 : D, 2 * DE, wsp<int>(F, WS_SLOTTOK)};
        pg8::MoeOrder S{(int)ctl[CW_NTILES], 8, F.G, F.vcu, wsp<int>(F, WS_TILEE)};
        pg8::EpiMoe1 E{wsp<unsigned char>(F, WS_ACT), F.in[25]};
        pg8::gemm_phase<pg8::EpiMoe1, pg8::MoeOrder, true, MK_FP8 != 0>(F.lds, g, S, E);
    } SEAM(10);
    if (IN(11)) REP(11) {
        const unsigned* ctl = wsp<unsigned>(F, WS_CTL);
        pg8::Gemm g{wsp<bf16>(F, WS_ACT), wsp<bf16>(F, WS_W2), MK_FP8 ? DE / 2 : DE, D, nullptr};
        pg8::MoeOrder S{(int)ctl[CW_NTILES], 4, F.G, F.vcu, wsp<int>(F, WS_TILEE)};
        pg8::EpiMoe2 E{wsp<bf16>(F, WS_YS), F.in[27], wsp<float>(F, WS_SLOTGATE)};
        pg8::gemm_phase<pg8::EpiMoe2, pg8::MoeOrder, false, MK_FP8 != 0>(F.lds, g, S, E);
    } SEAM(11);
    if (IN(12)) { phase12(F); }
#undef IN
#undef SEAM
}

extern "C" void kernel_launch(void* const* d_in, const int* in_sizes, int n_in, void* d_out, int out_size, void* d_ws, size_t ws_size, hipStream_t stream) {
    static int grid = 0;
    if (grid == 0) {
        if (n_in != 28 || out_size != M * D || ws_size < WS_END) { fprintf(stderr, "kernel_launch: unexpected sizes (n_in %d out %d ws %zu, need %zu)\n", n_in, out_size, ws_size, (size_t)WS_END); grid = -1; return; }
        int dev = 0, cus = 0, per_cu = 0;
        (void)hipGetDevice(&dev); (void)hipDeviceGetAttribute(&cus, hipDeviceAttributeMultiprocessorCount, dev);
        (void)hipFuncSetAttribute((const void*)mk_fwd, hipFuncAttributeMaxDynamicSharedMemorySize, LDS_BYTES);
        (void)hipOccupancyMaxActiveBlocksPerMultiprocessor(&per_cu, (const void*)mk_fwd, 512, LDS_BYTES);
        if (per_cu < 1 || cus != 256) { fprintf(stderr, "kernel_launch: occupancy %d, CUs %d: this build needs 256 CUs x 1 block\n", per_cu, cus); grid = -1; return; }
        grid = cus;
    }
    if (grid < 0) return;
    (void)hipMemsetAsync((char*)d_ws + WS_CTL, 0, CTL_BYTES, stream);
    Args a{};
    for (int i = 0; i < 28; ++i) a.in[i] = (const float*)d_in[i];
    a.out = (float*)d_out; a.ws = (unsigned char*)d_ws;
    const int last = MK_LAST_PHASE + 1;
#if MK_ONE_LAUNCH
    a.ph_lo = 0; a.ph_hi = last;
#if MK_COOP
    void* kargs[] = {&a};
    hipError_t e = hipLaunchCooperativeKernel((const void*)mk_fwd, dim3(grid), dim3(512), kargs, LDS_BYTES, stream);
    if (e != hipSuccess) fprintf(stderr, "cooperative launch failed: %s\n", hipGetErrorString(e));
#else
    hipLaunchKernelGGL(mk_fwd, dim3(grid), dim3(512), LDS_BYTES, stream, a);
#endif
#else
    for (int p = 0; p < last; ++p) { a.ph_lo = p; a.ph_hi = p + 1; hipLaunchKernelGGL(mk_fwd, dim3(grid), dim3(512), LDS_BYTES, stream, a); }
#endif
}
```

```cpp
#include <hip/hip_runtime.h>
#include <hip/hip_cooperative_groups.h>
#include <cstdio>
#include <cstdint>
namespace cg = cooperative_groups;

#ifndef MK_ONE_LAUNCH
#define MK_ONE_LAUNCH 1
#endif
#ifndef MK_REPEAT_MASK
#define MK_REPEAT_MASK 0
#endif
#ifndef MK_CONV_WHERE
#define MK_CONV_WHERE 8
#endif
#define MK_CONV_IN_SCAN (MK_CONV_WHERE == 4)
#ifndef MK_RWKV_MODE
#define MK_RWKV_MODE 3
#endif
#ifndef MK_FP8
#define MK_FP8 1
#endif
#ifndef MK_DUP
#define MK_DUP 0
#endif
#ifndef MK_WMASK
#define MK_WMASK 63
#endif
#ifndef MK_ATTN_IN_4B
#define MK_ATTN_IN_4B 1
#endif
#ifndef MK_REP4
#define MK_REP4 0
#endif
#ifndef MK_CG_SEAMS
#define MK_CG_SEAMS 0
#endif
#ifndef MK_COOP
#define MK_COOP 0
#endif
#ifndef MK_LAST_PHASE
#define MK_LAST_PHASE 12
#endif

constexpr int D = 1024, NBATCH = 8, T = 4096, M = NBATCH * T;
constexpr int HD = 64, RW = 512, RH = 8, AW = 512, QH = 8, KVH = 2, WIN = 128;
constexpr int RWKV_COLS = 1792, IN_COLS = 2560;
constexpr int COL_Q = 1792, COL_K = 1792 + 512, COL_V = 1792 + 512 + 128;
constexpr size_t PL_SZ = (size_t)M * 64, P_LORA = 36 * PL_SZ;
constexpr int NE = 32, TOPK = 4, DE = 1024;
constexpr int MAX_TILES = 544;
constexpr int MAX_SLOTS = MAX_TILES * 256;
constexpr float NORM_EPS = 1e-6f, GN_EPS = 64e-5f;

#define GAS __attribute__((address_space(1)))
#define LAS __attribute__((address_space(3)))
typedef unsigned short bf16;
typedef short bf16x8 __attribute__((ext_vector_type(8)));
typedef float f32x4 __attribute__((ext_vector_type(4)));
typedef float f32x2 __attribute__((ext_vector_type(2)));
typedef float f32x16 __attribute__((ext_vector_type(16)));
typedef unsigned u32x4 __attribute__((ext_vector_type(4)));
typedef unsigned u32x2 __attribute__((ext_vector_type(2)));
typedef int i32x8 __attribute__((ext_vector_type(8)));
typedef int i32x4 __attribute__((ext_vector_type(4)));

constexpr size_t MiB = 1u << 20;
constexpr size_t WS_CTL = 0, CTL_BYTES = 64 * 1024;
constexpr size_t WS_MOD = 1 * MiB;
constexpr size_t WS_BON = 1 * MiB + 256 * 1024;
constexpr size_t WS_RT_E = 2 * MiB;
constexpr size_t WS_RT_LP = 2 * MiB + 512 * 1024;
constexpr size_t WS_RT_G = 3 * MiB;
constexpr size_t WS_TOKSLOT = 3 * MiB + 512 * 1024;
constexpr size_t WS_SLOTTOK = 4 * MiB;
constexpr size_t WS_SLOTGATE = 5 * MiB;
constexpr size_t WS_BLKCNT = 6 * MiB;
constexpr size_t WS_TILEE = 6 * MiB + 64 * 1024;
constexpr size_t WS_BONUS = 7 * MiB;
constexpr size_t WS_LW = 9 * MiB;
constexpr size_t WS_WIN = 10 * MiB;
constexpr size_t WS_WOUT = 16 * MiB;
constexpr size_t WS_W1 = 20 * MiB;
constexpr size_t WS_W2 = 148 * MiB;
constexpr size_t WS_H = 212 * MiB;
constexpr size_t WS_R2 = 276 * MiB;
constexpr size_t WS_P = WS_R2;
constexpr size_t WS_SCN = WS_R2 + 160 * MiB;
constexpr size_t WS_SV = WS_SCN + 320 * MiB;
constexpr size_t WS_G = WS_SV + 64 * MiB;
constexpr size_t WS_Y = WS_G + 32 * MiB;
constexpr size_t WS_CAT = WS_Y + 64 * MiB;
constexpr size_t WS_ACT = WS_R2;
constexpr size_t WS_YS = WS_R2 + 272 * MiB;
constexpr size_t WS_END = 1012 * MiB;
constexpr size_t WS_X1B = WS_H;
constexpr size_t WS_H8 = WS_Y;
constexpr size_t WS_PT = 436 * MiB;
constexpr size_t WS_ZV = 500 * MiB;
constexpr size_t WS_Z0 = 628 * MiB;
constexpr size_t WS_RYT = 692 * MiB;
constexpr size_t WS_YVT = WS_Y;
static_assert(WS_END <= 1024 * MiB, "workspace map");
static_assert(WS_YS + 272 * MiB <= WS_CAT, "YS must not overlay CAT");
constexpr int CW_NTILES = 16;
constexpr int CW_PADSTART = 64;
constexpr int CW_BAR = 4096;
constexpr int MISC_OFF = 160 * 1024 - 64;

constexpr int LDS_BYTES = 160 * 1024;

__device__ __forceinline__ unsigned f2bf(float f) { unsigned u = __builtin_bit_cast(unsigned, f); return (u + 0x7fffu + ((u >> 16) & 1u)) >> 16; }
typedef __bf16 bf16x2_t __attribute__((ext_vector_type(2)));
__device__ __forceinline__ unsigned pk2(float lo, float hi) { const f32x2 v = {lo, hi}; return __builtin_bit_cast(unsigned, __builtin_convertvector(v, bf16x2_t)); }
__device__ __forceinline__ float bf2f(unsigned short b) { return __builtin_bit_cast(float, ((unsigned)b) << 16); }
__device__ __forceinline__ float bflo(unsigned u) { return __builtin_bit_cast(float, u << 16); }
__device__ __forceinline__ float bfhi(unsigned u) { return __builtin_bit_cast(float, u & 0xffff0000u); }
__device__ __forceinline__ float wave_sum(float v) {
#pragma unroll
    for (int o = 1; o < 64; o <<= 1) v += __shfl_xor(v, o);
    return v;
}
__device__ __forceinline__ void lds_barrier() { asm volatile("s_waitcnt lgkmcnt(0)" ::: "memory"); __builtin_amdgcn_s_barrier(); asm volatile("" ::: "memory"); }
__device__ __forceinline__ float sigmoidf_(float x) { return __builtin_amdgcn_rcpf(1.f + __expf(-x)); }

namespace pg8 {
#define PG8_LAS __attribute__((address_space(3)))
constexpr int BM = 256, BK = 64, HALF = 128, HTB = HALF * BK * 2, STAGE_BYTES = 8 * HTB, NXCD = 8, WGM = 8;
__host__ __device__ __forceinline__ int lds_byte(int r, int c) { const int st = (r >> 4) * 2 + (c >> 5), rr = r & 15, cc = c & 31, ob = rr * 64 + cc * 2; return st * 1024 + (ob ^ (((ob >> 9) & 1) << 5)); }
__host__ __device__ __forceinline__ void stage_rc(int b, int& R, int& C) { const int st = b / 1024, sb = b % 1024, swz = sb ^ (((sb >> 9) & 1) << 5); R = (st >> 1) * 16 + swz / 64; C = (st & 1) * 32 + (swz % 64) / 2; }

struct Unit { int pm, pn, e; };
struct Gemm { const bf16* A; const bf16* Bt; int K, N; const int* rowmap; };

struct StaticOrder {
    int nM, nN, nwg, G, c;
    __device__ void init(int M_, int N_, int G_, int c_) { nM = M_ / BM; nN = N_ / BM; nwg = nM * nN; G = G_; c = c_; }
    __device__ bool next(int i, Unit& u) const {
        const long L = (long)i * G + c; if (L >= nwg) return false;
        int wgid = (int)L; { const int q = nwg / NXCD, r = nwg % NXCD, xcd = wgid % NXCD, off = wgid / NXCD; wgid = (xcd < r ? xcd * (q + 1) : r * (q + 1) + (xcd - r) * q) + off; }
        const int nig = WGM * nN, gid = wgid / nig, fm = gid * WGM, gsz = (nM - fm) < WGM ? (nM - fm) : WGM;
        u.pm = fm + ((wgid % nig) % gsz); u.pn = (wgid % nig) / gsz; u.e = 0; return true;
    }
};
struct MoeOrder {
    int nMt, nN, G, c; const int* tile_e;
    __device__ bool next(int i, Unit& u) const {
        const long L = (long)i * G + c; if (L >= (long)nMt * nN) return false;
        u.pm = (int)(L / nN); u.pn = (int)(L % nN); u.e = tile_e[u.pm]; return true;
    }
};

__device__ __forceinline__ unsigned cvt_pk_bf16(float lo, float hi) { unsigned r; asm volatile("v_cvt_pk_bf16_f32 %0, %1, %2" : "=v"(r) : "v"(lo), "v"(hi)); return r; }

struct EpiBf16P {
    bf16* O; int ldc;
    __device__ __forceinline__ void operator()(const f32x4 (&acc)[2][2][4][2], const Unit& u, int wr, int wc, int fr, int fq) const {
        const int row0 = u.pm * BM + wr * 64 + fr, col0 = u.pn * BM + wc * 32 + 8 * fq;
        const bool lora = u.pn == 6; const int ld = lora ? 256 : 64; size_t off[2];
#pragma unroll
        for (int bj = 0; bj < 2; ++bj) { const int c = col0 + bj * HALF;
            off[bj] = lora ? P_LORA + (size_t)(c - 1536) : (size_t)((c < 1536 ? c : c - 256) >> 6) * PL_SZ + (size_t)(c & 63); }
#pragma unroll
        for (int ai = 0; ai < 2; ++ai)
#pragma unroll
            for (int m = 0; m < 4; ++m) { const size_t ro = (size_t)(row0 + ai * HALF + m * 16) * ld;
#pragma unroll
                for (int bj = 0; bj < 2; ++bj) { const f32x4 v0 = acc[ai][bj][m][0], v1 = acc[ai][bj][m][1];
                    u32x4 w; w.x = cvt_pk_bf16(v0[0], v0[1]); w.y = cvt_pk_bf16(v0[2], v0[3]); w.z = cvt_pk_bf16(v1[0], v1[1]); w.w = cvt_pk_bf16(v1[2], v1[3]);
                    *(u32x4*)(O + ro + off[bj]) = w; } }
    }
};
struct EpiOutProj {
    const float* x; bf16* out; const float* gate;
    __device__ __forceinline__ void operator()(const f32x4 (&acc)[2][2][4][2], const Unit& u, int wr, int wc, int fr, int fq) const {
        const int row0 = u.pm * BM + wr * 64 + fr, col0 = u.pn * BM + wc * 32 + 8 * fq;
        const int b = (u.pm * BM) / T;
        f32x4 gv[2][2];
#pragma unroll
        for (int bj = 0; bj < 2; ++bj)
#pragma unroll
            for (int n = 0; n < 2; ++n) gv[bj][n] = *(const f32x4*)(gate + (size_t)b * 6144 + col0 + bj * HALF + 4 * n);
#pragma unroll
        for (int ai = 0; ai < 2; ++ai)
#pragma unroll
            for (int m = 0; m < 4; ++m) { const size_t ro = (size_t)(row0 + ai * HALF + m * 16) * D + col0;
#pragma unroll
                for (int bj = 0; bj < 2; ++bj) { const f32x4 x0 = __builtin_nontemporal_load((const f32x4*)(x + ro + bj * HALF)), x1 = __builtin_nontemporal_load((const f32x4*)(x + ro + bj * HALF + 4));
                    const f32x4 v0 = x0 + gv[bj][0] * acc[ai][bj][m][0], v1 = x1 + gv[bj][1] * acc[ai][bj][m][1];
                    u32x4 w; w.x = cvt_pk_bf16(v0[0], v0[1]); w.y = cvt_pk_bf16(v0[2], v0[3]); w.z = cvt_pk_bf16(v1[0], v1[1]); w.w = cvt_pk_bf16(v1[2], v1[3]);
                    *(u32x4*)(out + ro + bj * HALF) = w; } }
    }
};
__device__ __forceinline__ unsigned pk4_fp8(float a, float b, float c, float d) { int w = 0; w = __builtin_amdgcn_cvt_pk_fp8_f32(a, b, w, false); w = __builtin_amdgcn_cvt_pk_fp8_f32(c, d, w, true); return (unsigned)w; }
constexpr float W8_SCALE = 32.f, W8_INV = 1.f / 32.f;
struct EpiMoe1 {
    unsigned char* act; const float* b1;
    __device__ __forceinline__ void operator()(const f32x4 (&acc)[2][2][4][2], const Unit& u, int wr, int wc, int fr, int fq) const {
        const int row0 = u.pm * BM + wr * 64 + fr, j0 = u.pn * 128 + wc * 16 + 4 * fq;
        const float* bb = b1 + (size_t)u.e * 2048;
        f32x4 bg[2], bl[2];
#pragma unroll
        for (int bj = 0; bj < 2; ++bj) { bg[bj] = *(const f32x4*)(bb + j0 + bj * 64); bl[bj] = *(const f32x4*)(bb + 1024 + j0 + bj * 64); }
#pragma unroll
        for (int ai = 0; ai < 2; ++ai)
#pragma unroll
            for (int m = 0; m < 4; ++m) { unsigned char* rowp = act + ((size_t)(row0 + ai * HALF + m * 16) * DE + j0) * (MK_FP8 ? 1 : 2);
#pragma unroll
                for (int bj = 0; bj < 2; ++bj) { const f32x4 g4 = acc[ai][bj][m][0] * (MK_FP8 ? W8_INV : 1.f) + bg[bj], l4 = acc[ai][bj][m][1] * (MK_FP8 ? W8_INV : 1.f) + bl[bj]; float a[4];
#pragma unroll
                    for (int q = 0; q < 4; ++q) { const float gl = fminf(g4[q], 7.0f), li = fminf(fmaxf(l4[q], -7.0f), 7.0f);
                        a[q] = gl * __builtin_amdgcn_rcpf(1.f + __expf(-1.702f * gl)) * (li + 1.f); }
#if MK_FP8
                    *(unsigned*)(rowp + bj * 64) = pk4_fp8(a[0], a[1], a[2], a[3]);
#else
                    u32x2 w; w.x = cvt_pk_bf16(a[0], a[1]); w.y = cvt_pk_bf16(a[2], a[3]); *(u32x2*)(rowp + bj * 128) = w;
#endif
                } }
    }
};
struct EpiMoe2 {
    bf16* ys; const float* b2; const float* sgate;
    __device__ __forceinline__ void operator()(const f32x4 (&acc)[2][2][4][2], const Unit& u, int wr, int wc, int fr, int fq) const {
        const int row0 = u.pm * BM + wr * 64 + fr, col0 = u.pn * BM + wc * 32 + 8 * fq;
        const float* bb = b2 + (size_t)u.e * 1024;
        f32x4 bv[2][2];
#pragma unroll
        for (int bj = 0; bj < 2; ++bj)
#pragma unroll
            for (int n = 0; n < 2; ++n) bv[bj][n] = *(const f32x4*)(bb + col0 + bj * HALF + 4 * n);
#pragma unroll
        for (int ai = 0; ai < 2; ++ai)
#pragma unroll
            for (int m = 0; m < 4; ++m) { const int row = row0 + ai * HALF + m * 16; const float gt = sgate[row]; bf16* rowp = ys + (size_t)row * D + col0;
#pragma unroll
                for (int bj = 0; bj < 2; ++bj) { const f32x4 v0 = (acc[ai][bj][m][0] * (MK_FP8 ? W8_INV : 1.f) + bv[bj][0]) * gt, v1 = (acc[ai][bj][m][1] * (MK_FP8 ? W8_INV : 1.f) + bv[bj][1]) * gt;
                    u32x4 w; w.x = cvt_pk_bf16(v0[0], v0[1]); w.y = cvt_pk_bf16(v0[2], v0[3]); w.z = cvt_pk_bf16(v1[0], v1[1]); w.w = cvt_pk_bf16(v1[2], v1[3]);
                    *(u32x4*)(rowp + bj * HALF) = w; } }
    }
};

template <class Epi, class Sched, bool GATHER, bool FP8 = false>
__device__ __forceinline__ void gemm_phase(PG8_LAS unsigned char* lds, const Gemm g, const Sched& S, const Epi& E) {
    const int tid = threadIdx.x, wid = __builtin_amdgcn_readfirstlane(tid >> 6), lane = tid & 63, wr = wid >> 2, wc = wid & 3, fr = lane & 15, fq = lane >> 4;
    const int K = g.K, nt = K / BK;
    int Rr[2], Cc[2]; unsigned voffB[2];
#pragma unroll
    for (int i = 0; i < 2; ++i) { stage_rc(tid * 16 + i * 8192, Rr[i], Cc[i]); voffB[i] = (unsigned)(Rr[i] * K + Cc[i]) * 2u; }
    const size_t kstep = (size_t)(BK * 2);
    const size_t hstep = (size_t)HALF * K * 2;
    const size_t tstep = 2 * hstep;
    const unsigned ldsw = (unsigned)wid * 1024u;
    const int aoff = lds_byte(wr * 64 + fr, fq * 8), boff = lds_byte(wc * 32 + fr, fq * 8);
#define PG8_SA(b, h) (((b) * 2 + (h)) * HTB)
#define PG8_SB(b, h) ((4 + (b) * 2 + (h)) * HTB)
#define PG8_STAGE(bufoff, gbase, voff) do { _Pragma("unroll") for (int _i = 0; _i < 2; ++_i) \
        __builtin_amdgcn_global_load_lds((const unsigned*)((const char*)(gbase) + (voff)[_i]), (PG8_LAS unsigned*)(lds + (bufoff) + ldsw + _i * 8192), 16, 0, 0); } while (0)
#define PG8_LDA(dst, b, h) do { _Pragma("unroll") for (int m = 0; m < 4; ++m) { const PG8_LAS i32x4* _p = (const PG8_LAS i32x4*)(lds + PG8_SA(b, h) + aoff + m * 2048); \
        dst[m] = __builtin_shufflevector(_p[0], _p[64], 0, 1, 2, 3, 4, 5, 6, 7); } } while (0)
#define PG8_LDB(dst, b, h) do { _Pragma("unroll") for (int n = 0; n < 2; ++n) { const PG8_LAS i32x4* _p = (const PG8_LAS i32x4*)(lds + PG8_SB(b, h) + boff + n * 2048); \
        dst[n] = __builtin_shufflevector(_p[0], _p[64], 0, 1, 2, 3, 4, 5, 6, 7); } } while (0)
#define PG8_MMA(ai, bj, At, Bt) do { __builtin_amdgcn_s_setprio(1); _Pragma("unroll") for (int m = 0; m < 4; ++m) _Pragma("unroll") for (int n = 0; n < 2; ++n) { \
        if constexpr (FP8)   \
            asm volatile("v_mfma_scale_f32_16x16x128_f8f6f4 %0, %1, %2, %0, %3, %3 op_sel_hi:[0,0,0]" : "+v"(acc[ai][bj][m][n]) : "v"(Bt[n]), "v"(At[m]), "v"(0x7F7F7F7F)); \
        else { acc[ai][bj][m][n] = __builtin_amdgcn_mfma_f32_16x16x32_bf16(__builtin_bit_cast(bf16x8, __builtin_shufflevector(Bt[n], Bt[n], 0, 1, 2, 3)), __builtin_bit_cast(bf16x8, __builtin_shufflevector(At[m], At[m], 0, 1, 2, 3)), acc[ai][bj][m][n], 0, 0, 0); \
               acc[ai][bj][m][n] = __builtin_amdgcn_mfma_f32_16x16x32_bf16(__builtin_bit_cast(bf16x8, __builtin_shufflevector(Bt[n], Bt[n], 4, 5, 6, 7)), __builtin_bit_cast(bf16x8, __builtin_shufflevector(At[m], At[m], 4, 5, 6, 7)), acc[ai][bj][m][n], 0, 0, 0); } } \
        __builtin_amdgcn_s_setprio(0); \
        if constexpr (FP8) asm volatile("" : "+v"(acc[ai][bj][0][0]), "+v"(acc[ai][bj][0][1]), "+v"(acc[ai][bj][1][0]), "+v"(acc[ai][bj][1][1]), "+v"(acc[ai][bj][2][0]), "+v"(acc[ai][bj][2][1]), "+v"(acc[ai][bj][3][0]), "+v"(acc[ai][bj][3][1]));   \
        } while (0)
#define PG8_WAIT_V(n) asm volatile("s_waitcnt vmcnt(" #n ")" ::: "memory")
#define PG8_WAIT_L(n) asm volatile("s_waitcnt lgkmcnt(" #n ")" ::: "memory")
#define PG8_BAR __builtin_amdgcn_s_barrier()
#define PG8_SCHED __builtin_amdgcn_sched_barrier(0)
#define PG8_AOFFS(dst, u) do { _Pragma("unroll") for (int _h = 0; _h < 2; ++_h) _Pragma("unroll") for (int _i = 0; _i < 2; ++_i) { int _R, _C; stage_rc((int)threadIdx.x * 16 + _i * 8192, _R, _C); \
        if constexpr (GATHER) { const int _tok = g.rowmap[(u).pm * BM + _h * HALF + _R]; dst[_h][_i] = (unsigned)(_tok * K + _C) * 2u; } \
        else dst[_h][_i] = (unsigned)((_h * HALF + _R) * K + _C) * 2u; } } while (0)
#define PG8_ABASE(u) (GATHER ? (const char*)g.A : (const char*)g.A + (size_t)(u).pm * tstep)
#define PG8_BBASE(u) ((const char*)g.Bt + ((size_t)(u).e * g.N + (size_t)(u).pn * BM) * K * 2)
    Unit cur, nxt, nn; int ui = 0;
    if (!S.next(0, cur)) return;
    bool has_next = S.next(1, nxt);
    unsigned curA[2][2], nxtA[2][2];
    PG8_AOFFS(curA, cur);
    if (has_next) PG8_AOFFS(nxtA, nxt); else {
#pragma unroll
        for (int h = 0; h < 2; ++h)
#pragma unroll
            for (int i = 0; i < 2; ++i) nxtA[h][i] = curA[h][i]; }
    f32x4 acc[2][2][4][2];
#pragma unroll
    for (int a = 0; a < 2; ++a)
#pragma unroll
        for (int b = 0; b < 2; ++b)
#pragma unroll
            for (int m = 0; m < 4; ++m)
#pragma unroll
                for (int n = 0; n < 2; ++n) acc[a][b][m][n] = (f32x4){0.f, 0.f, 0.f, 0.f};
    i32x8 At[4], B0[2], B1[2];
    const char* cA = PG8_ABASE(cur); const char* cB = PG8_BBASE(cur);
    PG8_STAGE(PG8_SB(0, 0), cB, voffB); PG8_STAGE(PG8_SB(0, 1), cB + hstep, voffB); PG8_STAGE(PG8_SA(0, 0), cA, curA[0]); PG8_STAGE(PG8_SA(0, 1), cA, curA[1]);
    if (wr == 1) PG8_BAR;
    PG8_WAIT_V(2); PG8_BAR;
    PG8_STAGE(PG8_SB(1, 0), cB + kstep, voffB); PG8_STAGE(PG8_SA(1, 0), cA + kstep, curA[0]); PG8_STAGE(PG8_SB(1, 1), cB + hstep + kstep, voffB);
    PG8_WAIT_V(6); PG8_BAR;
    for (;;) {
        const char* nA = has_next ? PG8_ABASE(nxt) : cA; const char* nB = has_next ? PG8_BBASE(nxt) : cB;
#pragma unroll 1
        for (int t = 0; t < nt; t += 2) {
            const bool last = (t == nt - 2);
            const char* a1 = cA + (size_t)(t + 1) * kstep;
            const char* a2 = last ? nA : cA + (size_t)(t + 2) * kstep; const char* b2 = last ? nB : cB + (size_t)(t + 2) * kstep;
            const char* a3 = a2 + kstep; const char* b3 = b2 + kstep;
            unsigned o2[2][2];
#pragma unroll
            for (int h = 0; h < 2; ++h)
#pragma unroll
                for (int i = 0; i < 2; ++i) o2[h][i] = last ? nxtA[h][i] : curA[h][i];
            PG8_LDB(B0, 0, 0); PG8_LDB(B1, 0, 1); PG8_SCHED; PG8_LDA(At, 0, 0); PG8_STAGE(PG8_SA(1, 1), a1, curA[1]);
            PG8_WAIT_V(8); PG8_WAIT_L(0); PG8_BAR; PG8_MMA(0, 0, At, B0); PG8_MMA(0, 1, At, B1); PG8_BAR; PG8_SCHED;
            PG8_LDA(At, 0, 1); PG8_STAGE(PG8_SB(0, 0), b2, voffB); PG8_STAGE(PG8_SB(0, 1), b2 + hstep, voffB); PG8_STAGE(PG8_SA(0, 0), a2, o2[0]);
            PG8_WAIT_V(8); PG8_WAIT_L(0); PG8_BAR; PG8_MMA(1, 0, At, B0); PG8_MMA(1, 1, At, B1); PG8_BAR; PG8_SCHED;
            PG8_LDB(B0, 1, 0); PG8_LDB(B1, 1, 1); PG8_SCHED; PG8_LDA(At, 1, 0); PG8_STAGE(PG8_SA(0, 1), a2, o2[1]);
            PG8_WAIT_V(8); PG8_WAIT_L(0); PG8_BAR; PG8_MMA(0, 0, At, B0); PG8_MMA(0, 1, At, B1); PG8_BAR; PG8_SCHED;
            PG8_LDA(At, 1, 1); PG8_STAGE(PG8_SB(1, 0), b3, voffB); PG8_STAGE(PG8_SB(1, 1), b3 + hstep, voffB); PG8_STAGE(PG8_SA(1, 0), a3, o2[0]);
            PG8_WAIT_V(8); PG8_WAIT_L(0); PG8_BAR; PG8_MMA(1, 0, At, B0); PG8_MMA(1, 1, At, B1); PG8_BAR; PG8_SCHED;
        }
        if constexpr (FP8) asm volatile("s_nop 15\n\ts_nop 15" ::: "memory");
        if (wr == 0) PG8_BAR;
        const bool has_nn = has_next && S.next(ui + 2, nn);
        unsigned nnA[2][2];
        if (has_nn) PG8_AOFFS(nnA, nn);
        E(acc, cur, wr, wc, fr, fq);
        if (!has_next) break;
#pragma unroll
        for (int a = 0; a < 2; ++a)
#pragma unroll
            for (int b = 0; b < 2; ++b)
#pragma unroll
                for (int m = 0; m < 4; ++m)
#pragma unroll
                    for (int n = 0; n < 2; ++n) acc[a][b][m][n] = (f32x4){0.f, 0.f, 0.f, 0.f};
        cur = nxt; cA = nA; cB = nB; ++ui;
#pragma unroll
        for (int h = 0; h < 2; ++h)
#pragma unroll
            for (int i = 0; i < 2; ++i) { curA[h][i] = nxtA[h][i]; if (has_nn) nxtA[h][i] = nnA[h][i]; }
        nxt = nn; has_next = has_nn;
        if (wr == 1) PG8_BAR;
    }
    PG8_WAIT_V(0);
    PG8_BAR;
#undef PG8_SA
#undef PG8_SB
#undef PG8_STAGE
#undef PG8_LDA
#undef PG8_LDB
#undef PG8_MMA
#undef PG8_WAIT_V
#undef PG8_WAIT_L
#undef PG8_BAR
#undef PG8_SCHED
#undef PG8_AOFFS
#undef PG8_ABASE
#undef PG8_BBASE
}
}

struct Frame {
    LAS unsigned char* lds;
    int tid, lane, wave, vcu, G;
    const float* const* in;
    float* out;
    unsigned char* ws;
};
template <class Tp> __device__ __forceinline__ Tp* wsp(const Frame& F, size_t off) { return (Tp*)(F.ws + off); }

__device__ __forceinline__ int dest_row(int mode, int s) {
    if (mode == 0) return s;
    if (mode == 1) return (s & ~31) | (((s >> 2) & 1) << 4) | (((s >> 3) & 3) << 2) | (s & 3);
    const int half = s >> 10, j = s & 1023;
    return ((j >> 7) << 8) | (((j >> 6) & 1) << 7) | (((j >> 4) & 3) << 5) | (half << 4) | (j & 15);
}
__device__ __forceinline__ void transpose_item(const float* W, int K, int N, bf16* WT, int mode, int item, int lane) {
    const int nblk = N / 64, kb = item / nblk, nb = item % nblk, k0 = 64 * kb, n0 = 64 * nb;
    const float* src = W + (size_t)k0 * N + n0 + lane;
    float v[64];
#pragma unroll
    for (int i = 0; i < 64; ++i) v[i] = src[(size_t)i * N];
    bf16* dst = WT + (size_t)dest_row(mode, n0 + lane) * K + k0;
#pragma unroll
    for (int j = 0; j < 8; ++j) { u32x4 o; o.x = pk2(v[8 * j], v[8 * j + 1]); o.y = pk2(v[8 * j + 2], v[8 * j + 3]); o.z = pk2(v[8 * j + 4], v[8 * j + 5]); o.w = pk2(v[8 * j + 6], v[8 * j + 7]);
        *(u32x4*)(dst + 8 * j) = o; }
}
__device__ __forceinline__ void transpose_item8(const float* W, int K, int N, unsigned char* WT, int mode, int item, int lane) {
    const int nblk = N / 64, kb = item / nblk, nb = item % nblk, k0 = 64 * kb, n0 = 64 * nb;
    const float* src = W + (size_t)k0 * N + n0 + lane;
    float v[64];
#pragma unroll
    for (int i = 0; i < 64; ++i) v[i] = __builtin_nontemporal_load(src + (size_t)i * N) * 32.f;
    unsigned char* dst = WT + (size_t)dest_row(mode, n0 + lane) * K + k0;
#pragma unroll
    for (int j = 0; j < 4; ++j) { u32x4 o; o.x = pg8::pk4_fp8(v[16 * j], v[16 * j + 1], v[16 * j + 2], v[16 * j + 3]); o.y = pg8::pk4_fp8(v[16 * j + 4], v[16 * j + 5], v[16 * j + 6], v[16 * j + 7]);
        o.z = pg8::pk4_fp8(v[16 * j + 8], v[16 * j + 9], v[16 * j + 10], v[16 * j + 11]); o.w = pg8::pk4_fp8(v[16 * j + 12], v[16 * j + 13], v[16 * j + 14], v[16 * j + 15]);
        *(u32x4*)(dst + 16 * j) = o; }
}
constexpr int MOE_I1 = 16 * 32, MOE_I2 = 16 * 16, MOE_ITEMS = NE * (MOE_I1 + MOE_I2);
__device__ __forceinline__ void moe_weight_item(const Frame& F, int it) {
#if !MK_FP8
    if (it < NE * MOE_I1) { const int e = it / MOE_I1; transpose_item(F.in[24] + (size_t)e * 1024 * 2048, 1024, 2048, wsp<bf16>(F, WS_W1) + (size_t)e * 2048 * 1024, 2, it % MOE_I1, F.lane); }
    else { const int r = it - NE * MOE_I1, e = r / MOE_I2; transpose_item(F.in[26] + (size_t)e * 1024 * 1024, 1024, 1024, wsp<bf16>(F, WS_W2) + (size_t)e * 1024 * 1024, 1, r % MOE_I2, F.lane); }
#else
    if (it < NE * MOE_I1) { const int e = it / MOE_I1; transpose_item8(F.in[24] + (size_t)e * 1024 * 2048, 1024, 2048, wsp<unsigned char>(F, WS_W1) + (size_t)e * 2048 * 1024, 2, it % MOE_I1, F.lane); }
    else { const int r = it - NE * MOE_I1, e = r / MOE_I2; transpose_item8(F.in[26] + (size_t)e * 1024 * 1024, 1024, 1024, wsp<unsigned char>(F, WS_W2) + (size_t)e * 1024 * 1024, 1, r % MOE_I2, F.lane); }
#endif
}

__device__ __forceinline__ void phase0(const Frame& F) {
    if (F.vcu < 192) {
        LAS float* sl = (LAS float*)F.lds;
        LAS float* red = (LAS float*)(F.lds + 32768);
        const float* c = F.in[1];
        for (int idx = F.tid; idx < 8192; idx += 512) { const int b = idx & 7, k = idx >> 3; const float cv = c[b * 1024 + k]; sl[idx] = cv / (1.f + __expf(-cv)); }
        __syncthreads();
        const int cl = F.tid & 31, ks = F.tid >> 5, col = F.vcu * 32 + cl;
        const float* wa = F.in[2];
        float acc[8];
#pragma unroll
        for (int b = 0; b < 8; ++b) acc[b] = 0.f;
#pragma unroll 4
        for (int kk = 0; kk < 64; ++kk) { const int k = ks * 64 + kk; const float w = wa[(size_t)k * 6144 + col];
            const f32x4 s0 = *(const LAS f32x4*)(sl + k * 8), s1 = *(const LAS f32x4*)(sl + k * 8 + 4);
            acc[0] += s0[0] * w; acc[1] += s0[1] * w; acc[2] += s0[2] * w; acc[3] += s0[3] * w;
            acc[4] += s1[0] * w; acc[5] += s1[1] * w; acc[6] += s1[2] * w; acc[7] += s1[3] * w; }
#pragma unroll
        for (int b = 0; b < 8; ++b) red[(ks * 32 + cl) * 8 + b] = acc[b];
        __syncthreads();
        if (F.tid < 256) { const int b = F.tid >> 5; float s = F.in[3][col];
            for (int q = 0; q < 16; ++q) s += red[(q * 32 + cl) * 8 + b];
            wsp<float>(F, WS_MOD)[b * 6144 + col] = s; }
    }
    const int gw = F.vcu * 8 + F.wave, NGW = F.G * 8;
    constexpr int I_IN = 16 * 40, I_OUT = 16 * 16;
    constexpr int NITEMS = I_IN + I_OUT;
    for (int it = gw; it < NITEMS; it += NGW) {
        int r = it;
        if (r < I_IN) { transpose_item(F.in[5], 1024, 2560, wsp<bf16>(F, WS_WIN), 1, r, F.lane); continue; } r -= I_IN;
        transpose_item(F.in[20], 1024, 1024, wsp<bf16>(F, WS_WOUT), 1, r, F.lane);
    }
#if MK_CONV_WHERE == 0
    for (int it = gw; it < MOE_ITEMS; it += NGW) moe_weight_item(F, it);
#endif
    { bf16* LW = wsp<bf16>(F, WS_LW);
        for (int idx = F.vcu * 512 + F.tid; idx < 256 * 512; idx += F.G * 512) { const int k = idx >> 9, c = idx & 511;
            const float v = k < 64 ? F.in[8][k * 512 + c] : (k < 128 ? F.in[10][(k - 64) * 512 + c] : F.in[11][(k - 128) * 512 + c]);
            LW[c * 256 + k] = (bf16)f2bf(v); } }
}
template <bool OUT8 = false, bool IN16 = false>
__device__ __forceinline__ void norm_row(const Frame& F, const float* xrow, const float* g, const float* shift, const float* scale, bf16* orow, f32x4 (&h)[4]) {
    const f32x4* xr = (const f32x4*)xrow + F.lane; const u32x2* xr16 = (const u32x2*)xrow + F.lane;
    float ss = 0.f;
#pragma unroll
    for (int j = 0; j < 4; ++j) { if constexpr (IN16) { const u32x2 q = __builtin_nontemporal_load(xr16 + 64 * j); h[j] = (f32x4){bflo(q.x), bfhi(q.x), bflo(q.y), bfhi(q.y)}; } else h[j] = __builtin_nontemporal_load(xr + 64 * j); ss += (h[j][0] * h[j][0] + h[j][1] * h[j][1]) + (h[j][2] * h[j][2] + h[j][3] * h[j][3]); }
    const float rstd = rsqrtf(wave_sum(ss) * (1.f / D) + NORM_EPS);
    u32x2* o8 = (u32x2*)orow + F.lane;
#pragma unroll
    for (int j = 0; j < 4; ++j) { const int col = 4 * F.lane + 256 * j;
        const f32x4 gv = *(const f32x4*)(g + col), sh = *(const f32x4*)(shift + col), sc = *(const f32x4*)(scale + col);
        h[j] = h[j] * rstd * gv * (sc + 1.f) + sh;
        if constexpr (OUT8) ((unsigned*)orow)[F.lane + 64 * j] = pg8::pk4_fp8(h[j][0], h[j][1], h[j][2], h[j][3]);
        else { u32x2 w; w.x = pk2(h[j][0], h[j][1]); w.y = pk2(h[j][2], h[j][3]); o8[64 * j] = w; } }
}
__device__ __forceinline__ void phase1(const Frame& F) {
    const int gw = F.vcu * 8 + F.wave, NGW = F.G * 8;
    const float* mod = wsp<float>(F, WS_MOD);
    for (int row = gw; row < M; row += NGW) { const int b = row / T; f32x4 h[4];
        norm_row(F, F.in[0] + (size_t)row * D, F.in[4], mod + b * 6144, mod + b * 6144 + 1024, wsp<bf16>(F, WS_H) + (size_t)row * D, h); }
}

template <int CTRL> __device__ __forceinline__ float dpp_mov(float v) { return __builtin_bit_cast(float, __builtin_amdgcn_update_dpp(0, __builtin_bit_cast(int, v), CTRL, 0xf, 0xf, false)); }
__device__ __forceinline__ float reduce16(float v) { v += dpp_mov<0xB1>(v); v += dpp_mov<0x4E>(v); v += dpp_mov<0x141>(v); v += dpp_mov<0x140>(v); return v; }
__device__ __forceinline__ void lerp8(const bf16* P, const float* mu, int tok, int t, int col, float (&x)[8]) {
    const u32x4 c = *(const u32x4*)(P + (size_t)tok * IN_COLS + col);
    u32x4 p = (u32x4){0u, 0u, 0u, 0u};
    if (t > 0) p = *(const u32x4*)(P + (size_t)(tok - 1) * IN_COLS + col);
    const f32x4 m0 = *(const f32x4*)(mu + col), m1 = *(const f32x4*)(mu + col + 4);
    const float cf[8] = {bflo(c.x), bfhi(c.x), bflo(c.y), bfhi(c.y), bflo(c.z), bfhi(c.z), bflo(c.w), bfhi(c.w)};
    const float pf[8] = {bflo(p.x), bfhi(p.x), bflo(p.y), bfhi(p.y), bflo(p.z), bfhi(p.z), bflo(p.w), bfhi(p.w)};
    const float mf[8] = {m0[0], m0[1], m0[2], m0[3], m1[0], m1[1], m1[2], m1[3]};
#pragma unroll
    for (int j = 0; j < 8; ++j) x[j] = cf[j] + (pf[j] - cf[j]) * mf[j];
}
__device__ __forceinline__ f32x4 lerp4(const bf16* P, const float* mu, int tok, int t, int col) {
    const u32x2 c = *(const u32x2*)(P + (size_t)tok * IN_COLS + col);
    u32x2 p = (u32x2){0u, 0u};
    if (t > 0) p = *(const u32x2*)(P + (size_t)(tok - 1) * IN_COLS + col);
    const f32x4 m = *(const f32x4*)(mu + col);
    const f32x4 cf = (f32x4){bflo(c.x), bfhi(c.x), bflo(c.y), bfhi(c.y)}, pf = (f32x4){bflo(p.x), bfhi(p.x), bflo(p.y), bfhi(p.y)};
    return cf + (pf - cf) * m;
}
__device__ __forceinline__ bf16x8 pack8(const float (&x)[8]) { u32x4 w; w.x = pk2(x[0], x[1]); w.y = pk2(x[2], x[3]); w.z = pk2(x[4], x[5]); w.w = pk2(x[6], x[7]); return __builtin_bit_cast(bf16x8, w); }
__device__ __forceinline__ void phase3(const Frame& F) {
    const bf16* P = wsp<bf16>(F, WS_P); const bf16* LW = wsp<bf16>(F, WS_LW);
    const float* mu = F.in[6]; const float* w0 = F.in[7]; const float* a0 = F.in[9];
    const float* k_k = F.in[12]; const float* k_a = F.in[13]; const float* r_k = F.in[14];
    float* SCN = wsp<float>(F, WS_SCN); float* SV = wsp<float>(F, WS_SV); bf16* G = wsp<bf16>(F, WS_G); float* BON = wsp<float>(F, WS_BONUS);
    const int gw = F.vcu * 8 + F.wave, NGW = F.G * 8;
    const int cl = F.lane & 15, q = F.lane >> 4;
    for (int tile = gw; tile < M / 16; tile += NGW) {
        bf16x8 Aw[2], Aa[2], Ag[4];
        { const int tok = tile * 16 + cl, t = tok % T; float x[8];
#pragma unroll
            for (int s = 0; s < 2; ++s) { lerp8(P, mu, tok, t, 1536 + 32 * s + 8 * q, x);
#pragma unroll
                for (int j = 0; j < 8; ++j) x[j] = tanhf(x[j]);
                Aw[s] = pack8(x);
                lerp8(P, mu, tok, t, 1600 + 32 * s + 8 * q, x); Aa[s] = pack8(x); }
#pragma unroll
            for (int s = 0; s < 4; ++s) { lerp8(P, mu, tok, t, 1664 + 32 * s + 8 * q, x);
#pragma unroll
                for (int j = 0; j < 8; ++j) x[j] = sigmoidf_(x[j]);
                Ag[s] = pack8(x); } }
        const int tk0 = tile * 16 + 4 * q, b = tk0 / T, t0 = tk0 % T;
#pragma unroll 1
        for (int hh = 0; hh < RH; ++hh) {
            const int c0 = hh * 64 + cl * 4;
            f32x4 accw[4], acca[4], accg[4];
#pragma unroll
            for (int ct = 0; ct < 4; ++ct) { const bf16* lw = LW + (size_t)(c0 + ct) * 256 + 8 * q;
                f32x4 aw = (f32x4){0.f, 0.f, 0.f, 0.f}, aa = aw, ag = aw;
#pragma unroll
                for (int s = 0; s < 2; ++s) { aw = __builtin_amdgcn_mfma_f32_16x16x32_bf16(Aw[s], *(const bf16x8*)(lw + 32 * s), aw, 0, 0, 0);
                    aa = __builtin_amdgcn_mfma_f32_16x16x32_bf16(Aa[s], *(const bf16x8*)(lw + 64 + 32 * s), aa, 0, 0, 0); }
#pragma unroll
                for (int s = 0; s < 4; ++s) ag = __builtin_amdgcn_mfma_f32_16x16x32_bf16(Ag[s], *(const bf16x8*)(lw + 128 + 32 * s), ag, 0, 0, 0);
                accw[ct] = aw; acca[ct] = aa; accg[ct] = ag; }
            const f32x4 w0v = *(const f32x4*)(w0 + c0), a0v = *(const f32x4*)(a0 + c0), kkv = *(const f32x4*)(k_k + c0), kav = *(const f32x4*)(k_a + c0), rkv = *(const f32x4*)(r_k + c0);
#pragma unroll
            for (int i = 0; i < 4; ++i) { const int tk = tk0 + i, t = t0 + i;
                const f32x4 r4 = lerp4(P, mu, tk, t, c0), kr4 = lerp4(P, mu, tk, t, 512 + c0), v4 = lerp4(P, mu, tk, t, 1024 + c0);
                f32x4 dec, av, gv, kk4, k4;
                float ssq = 0.f, bon = 0.f;
#pragma unroll
                for (int ct = 0; ct < 4; ++ct) {
                    dec[ct] = __expf(-0.60653066f * sigmoidf_(w0v[ct] + accw[ct][i]));
                    av[ct] = sigmoidf_(a0v[ct] + acca[ct][i]);
                    gv[ct] = accg[ct][i];
                    kk4[ct] = kr4[ct] * kkv[ct]; ssq += kk4[ct] * kk4[ct];
                    k4[ct] = kr4[ct] * (1.f + (av[ct] - 1.f) * kav[ct]);
                    bon += r4[ct] * k4[ct] * rkv[ct]; }
                ssq = reduce16(ssq); bon = reduce16(bon);
                const float inv = __builtin_amdgcn_rcpf(fmaxf(sqrtf(ssq), 1e-12f));
                const f32x4 kkn = kk4 * inv, bb = kkn * av;
                const size_t so = ((size_t)(b * RH + hh) * T + t) * 64 + cl * 4;
                float* sc = SCN + ((size_t)(b * RH + hh) * T + t) * 320 + cl * 4;
                *(f32x4*)(sc) = dec; *(f32x4*)(sc + 64) = kkn; *(f32x4*)(sc + 128) = bb; *(f32x4*)(sc + 192) = k4; *(f32x4*)(sc + 256) = r4;
                *(f32x4*)(SV + so) = v4;
                u32x2 gw2; gw2.x = pk2(gv[0], gv[1]); gw2.y = pk2(gv[2], gv[3]);
                *(u32x2*)(G + (size_t)tk * 512 + c0) = gw2;
                if (cl == 0) BON[tk * 8 + hh] = bon; }
        }
    }
}

constexpr int CK = 32, NCHK = T / CK;
#define SC_SPIN_CAP (1 << 24)
#define MFMA32(a, b, c) __builtin_amdgcn_mfma_f32_32x32x16_bf16((a), (b), (c), 0, 0, 0)
__device__ __forceinline__ int crow(int i, int h) { return (i & 3) + 8 * (i >> 2) + 4 * h; }
template <int S_> __device__ __forceinline__ bf16x8 pack_acc(const f32x16& x) { u32x4 w; w.x = pk2(x[8 * S_], x[8 * S_ + 1]); w.y = pk2(x[8 * S_ + 2], x[8 * S_ + 3]); w.z = pk2(x[8 * S_ + 4], x[8 * S_ + 5]); w.w = pk2(x[8 * S_ + 6], x[8 * S_ + 7]); return __builtin_bit_cast(bf16x8, w); }
__device__ __forceinline__ bf16x8 rd_nat(const LAS bf16* img, int stride, int row, int k0) { return *(const LAS bf16x8*)(img + row * stride + k0); }
__device__ __forceinline__ bf16x8 rd_perm(const LAS bf16* img, int stride, int row, int kb, int h) {
    const u32x2 lo = *(const LAS u32x2*)(img + row * stride + kb + 4 * h), hi = *(const LAS u32x2*)(img + row * stride + kb + 8 + 4 * h);
    u32x4 w; w.x = lo.x; w.y = lo.y; w.z = hi.x; w.w = hi.y; return __builtin_bit_cast(bf16x8, w);
}
__device__ __forceinline__ f32x16 zero16() { f32x16 z; for (int i = 0; i < 16; ++i) z[i] = 0.f; return z; }
constexpr int CL_A = 0, CL_B = 4608, CL_K = 9216, CL_R = 13824, CL_AT = 18432, CL_BHT = 23552, CL_KHT = 28672, CL_VT = 33792, CL_GTOT = 38912, CL_GC = 39936,
              CL_L = 40192, CL_T = 44800, CL_FNRB = 47360, CL_CNRK = 49408, CL_FQM = 53504, CL_GROUP = 57600;
constexpr int RMS = 72, TRS = 40, LST = 36;
__device__ __forceinline__ void phase4a_summaries(const Frame& F) {
    const float* SCN = wsp<float>(F, WS_SCN); const float* SV = wsp<float>(F, WS_SV);
    bf16x8* PT = wsp<bf16x8>(F, WS_PT); f32x4* ZV = wsp<f32x4>(F, WS_ZV); bf16x8* RYT = wsp<bf16x8>(F, WS_RYT); f32x4* YVT = wsp<f32x4>(F, WS_YVT);
    const int grp = F.tid >> 8, gt = F.tid & 255, w4 = F.wave & 3, lane = F.lane, r = lane & 31, h = lane >> 5;
    LAS unsigned char* gl = F.lds + grp * CL_GROUP;
    LAS bf16* iA = (LAS bf16*)(gl + CL_A); LAS bf16* iB = (LAS bf16*)(gl + CL_B); LAS bf16* iK = (LAS bf16*)(gl + CL_K); LAS bf16* iR = (LAS bf16*)(gl + CL_R);
    LAS bf16* iAT = (LAS bf16*)(gl + CL_AT); LAS bf16* iBHT = (LAS bf16*)(gl + CL_BHT); LAS bf16* iKHT = (LAS bf16*)(gl + CL_KHT); LAS bf16* iVT = (LAS bf16*)(gl + CL_VT);
    LAS float* gtot = (LAS float*)(gl + CL_GTOT); LAS float* gcv = (LAS float*)(gl + CL_GC); LAS float* Lm = (LAS float*)(gl + CL_L); LAS bf16* Tm = (LAS bf16*)(gl + CL_T);
    LAS bf16x8* fnrb = (LAS bf16x8*)(gl + CL_FNRB); LAS float* cnrk = (LAS float*)(gl + CL_CNRK); LAS bf16x8* fqm = (LAS bf16x8*)(gl + CL_FQM);
    constexpr int NCHUNKS = NBATCH * RH * NCHK;
    for (int it = F.vcu; it < NCHUNKS / 2; it += F.G) {
        const int chunk = it * 2 + grp, bh = chunk / NCHK, c = chunk % NCHK, t0 = c * CK;
        __syncthreads();
        { const int k = gt & 63, tq = gt >> 6;
            float wv[8], kkv[8], bv[8], kv[8], rv[8], vv[8], lp[8];
#pragma unroll
            for (int i = 0; i < 8; ++i) { const size_t row = (size_t)bh * T + t0 + 8 * tq + i; const float* sc = SCN + row * 320 + k;
                wv[i] = sc[0]; kkv[i] = sc[64]; bv[i] = sc[128]; kv[i] = sc[192]; rv[i] = sc[256]; vv[i] = SV[row * 64 + k]; }
            lp[0] = wv[0];
#pragma unroll
            for (int i = 1; i < 8; ++i) lp[i] = lp[i - 1] * wv[i];
            gtot[tq * 64 + k] = lp[7];
            __syncthreads();
            const float g0 = gtot[k], g1 = gtot[64 + k], g2 = gtot[128 + k], g3 = gtot[192 + k];
            const float pre = tq == 0 ? 1.f : (tq == 1 ? g0 : (tq == 2 ? g0 * g1 : g0 * g1 * g2)), gC = (g0 * g1) * (g2 * g3);
            float at[8], bh8[8], kh8[8];
#pragma unroll
            for (int i = 0; i < 8; ++i) { const float g = pre * lp[i], gp = i == 0 ? pre : pre * lp[i - 1], ig = __builtin_amdgcn_rcpf(g);
                const float bt = bv[i] * ig, kt = kv[i] * ig; at[i] = -kkv[i] * gp; bh8[i] = bt * gC; kh8[i] = kt * gC;
                const int ro = (8 * tq + i) * RMS + k;
                iA[ro] = (bf16)f2bf(at[i]); iB[ro] = (bf16)f2bf(bt); iK[ro] = (bf16)f2bf(kt); iR[ro] = (bf16)f2bf(rv[i] * g); }
            *(LAS bf16x8*)(iAT + k * TRS + 8 * tq) = pack8(at); *(LAS bf16x8*)(iBHT + k * TRS + 8 * tq) = pack8(bh8); *(LAS bf16x8*)(iKHT + k * TRS + 8 * tq) = pack8(kh8);
            *(LAS bf16x8*)(iVT + k * TRS + 8 * tq) = pack8(vv);
            if (tq == 0) gcv[k] = gC; }
        __syncthreads();
        f32x16 lak = zero16();
        { const LAS bf16* ia = (w4 < 2) ? iA : (w4 == 2 ? iB : iK); const LAS bf16* ib = (w4 == 0) ? iB : (w4 == 1 ? iK : iR);
            f32x16 acc = zero16();
#pragma unroll
            for (int ks = 0; ks < 4; ++ks) acc = MFMA32(rd_nat(ia, RMS, r, 16 * ks + 8 * h), rd_nat(ib, RMS, r, 16 * ks + 8 * h), acc);
#pragma unroll
            for (int i = 0; i < 16; ++i) { const int row = crow(i, h); const bool keep = (w4 < 2) ? (r < row) : (row <= r); acc[i] = keep ? acc[i] : 0.f; }
            if (w4 == 0) {
#pragma unroll
                for (int i = 0; i < 16; ++i) Lm[crow(i, h) * LST + r] = acc[i]; }
            else if (w4 == 1) lak = acc;
            else if (w4 == 2) { fnrb[lane] = pack_acc<0>(acc); fnrb[64 + lane] = pack_acc<1>(acc); }
            else {
#pragma unroll
                for (int i = 0; i < 16; ++i) cnrk[i * 64 + lane] = acc[i]; } }
        __syncthreads();
        if (w4 == 0) { float Tr[32];
#pragma unroll
            for (int t = 0; t < 32; ++t) { float acc = (t == r) ? 1.f : 0.f;
#pragma unroll
                for (int s4 = 0; s4 < (t + 3) / 4; ++s4) { const f32x4 l4 = *(const LAS f32x4*)(Lm + t * LST + 4 * s4);
#pragma unroll
                    for (int q = 0; q < 4; ++q) if (4 * s4 + q < t) acc += l4[q] * Tr[4 * s4 + q]; }
                Tr[t] = acc; }
            if (lane < 32) {
#pragma unroll
                for (int t = 0; t < 32; ++t) Tm[t * TRS + r] = (bf16)f2bf(Tr[t]); } }
        __syncthreads();
        if (w4 == 0 || w4 == 2) { const int a = w4 >> 1;
            f32x16 x1 = zero16();
#pragma unroll
            for (int ks = 0; ks < 2; ++ks) x1 = MFMA32(rd_nat(Tm, TRS, r, 16 * ks + 8 * h), rd_nat(iAT, TRS, 32 * a + r, 16 * ks + 8 * h), x1);
            const bf16x8 xf0 = pack_acc<0>(x1), xf1 = pack_acc<1>(x1);
#pragma unroll
            for (int b = 0; b < 2; ++b) { f32x16 p = zero16();
                p = MFMA32(xf0, rd_perm(iBHT, TRS, 32 * b + r, 0, h), p); p = MFMA32(xf1, rd_perm(iBHT, TRS, 32 * b + r, 16, h), p);
                if (a == b) { const float gc = gcv[32 * a + r];
#pragma unroll
                    for (int i = 0; i < 16; ++i) p[i] += (crow(i, h) == r) ? gc : 0.f; }
                bf16x8* dst = PT + ((size_t)(chunk * 2 + a) * 2 + b) * 2 * 64 + lane; dst[0] = pack_acc<0>(p); dst[64] = pack_acc<1>(p); }
            f32x16 ry;
#pragma unroll
            for (int g = 0; g < 4; ++g) { const u32x2 rr = *(const LAS u32x2*)(iR + r * RMS + 32 * a + 8 * g + 4 * h);
                ry[4 * g] = bflo(rr.x); ry[4 * g + 1] = bfhi(rr.x); ry[4 * g + 2] = bflo(rr.y); ry[4 * g + 3] = bfhi(rr.y); }
            ry = MFMA32(xf0, fnrb[lane], ry); ry = MFMA32(xf1, fnrb[64 + lane], ry);
            bf16x8* dr = RYT + (size_t)(chunk * 2 + a) * 2 * 64 + lane; dr[0] = pack_acc<0>(ry); dr[64] = pack_acc<1>(ry);
        } else if (w4 == 1) {
            f32x16 x2 = zero16();
            x2 = MFMA32(rd_perm(Tm, TRS, r, 0, h), pack_acc<0>(lak), x2); x2 = MFMA32(rd_perm(Tm, TRS, r, 16, h), pack_acc<1>(lak), x2);
            const bf16x8 xf0 = pack_acc<0>(x2), xf1 = pack_acc<1>(x2);
#pragma unroll
            for (int b = 0; b < 2; ++b) { f32x16 qm;
#pragma unroll
                for (int g = 0; g < 4; ++g) { const u32x2 kk2 = *(const LAS u32x2*)(iKHT + (32 * b + r) * TRS + 8 * g + 4 * h);
                    qm[4 * g] = bflo(kk2.x); qm[4 * g + 1] = bfhi(kk2.x); qm[4 * g + 2] = bflo(kk2.y); qm[4 * g + 3] = bfhi(kk2.y); }
                qm = MFMA32(xf0, rd_perm(iBHT, TRS, 32 * b + r, 0, h), qm); qm = MFMA32(xf1, rd_perm(iBHT, TRS, 32 * b + r, 16, h), qm);
                fqm[(b * 2 + 0) * 64 + lane] = pack_acc<0>(qm); fqm[(b * 2 + 1) * 64 + lane] = pack_acc<1>(qm); }
            f32x16 gy;
#pragma unroll
            for (int i = 0; i < 16; ++i) gy[i] = cnrk[i * 64 + lane];
            gy = MFMA32(xf0, fnrb[lane], gy); gy = MFMA32(xf1, fnrb[64 + lane], gy);
            const bf16x8 gf0 = pack_acc<0>(gy), gf1 = pack_acc<1>(gy);
#pragma unroll
            for (int vh = 0; vh < 2; ++vh) { f32x16 yv = zero16();
                yv = MFMA32(rd_perm(iVT, TRS, 32 * vh + r, 0, h), gf0, yv); yv = MFMA32(rd_perm(iVT, TRS, 32 * vh + r, 16, h), gf1, yv);
                bf16x8* dy = (bf16x8*)YVT + ((size_t)(chunk * 2 + vh) * 64 + lane) * 2;
                dy[0] = pack_acc<0>(yv); dy[1] = pack_acc<1>(yv); }
        }
        __syncthreads();
        if (w4 == 3) {
#pragma unroll
            for (int b = 0; b < 2; ++b)
#pragma unroll
                for (int vh = 0; vh < 2; ++vh) { f32x16 zv = zero16();
                    zv = MFMA32(fqm[(b * 2 + 0) * 64 + lane], rd_perm(iVT, TRS, 32 * vh + r, 0, h), zv); zv = MFMA32(fqm[(b * 2 + 1) * 64 + lane], rd_perm(iVT, TRS, 32 * vh + r, 16, h), zv);
                    bf16x8* dz = (bf16x8*)ZV + (((size_t)(chunk * 2 + b) * 2 + vh) * 64 + lane) * 2;
                    dz[0] = pack_acc<0>(zv); dz[1] = pack_acc<1>(zv); }
        }
    }
}
constexpr int CL2_LA = 2 * CL_GROUP, LAS_STRIDE = 264;
static_assert(CL2_LA + 32 * LAS_STRIDE * 2 <= MISC_OFF, "fused summaries LDS map");
__device__ __forceinline__ void phase4a_fused(const Frame& F) {
    const bf16* P = wsp<bf16>(F, WS_P); const bf16* LW = wsp<bf16>(F, WS_LW);
    const float* mu = F.in[6]; const float* w0 = F.in[7]; const float* a0 = F.in[9]; const float* k_k = F.in[12]; const float* k_a = F.in[13]; const float* r_k = F.in[14];
    float* SV = wsp<float>(F, WS_SV); bf16* G = wsp<bf16>(F, WS_G); float* BON = wsp<float>(F, WS_BONUS);
    bf16x8* PT = wsp<bf16x8>(F, WS_PT); f32x4* ZV = wsp<f32x4>(F, WS_ZV); bf16x8* RYT = wsp<bf16x8>(F, WS_RYT); f32x4* YVT = wsp<f32x4>(F, WS_YVT);
    const int grp = F.tid >> 8, gt = F.tid & 255, w4 = F.wave & 3, lane = F.lane, r = lane & 31, h = lane >> 5;
    LAS unsigned char* gl = F.lds + grp * CL_GROUP;
    LAS bf16* iA = (LAS bf16*)(gl + CL_A); LAS bf16* iB = (LAS bf16*)(gl + CL_B); LAS bf16* iK = (LAS bf16*)(gl + CL_K); LAS bf16* iR = (LAS bf16*)(gl + CL_R);
    LAS bf16* iAT = (LAS bf16*)(gl + CL_AT); LAS bf16* iBHT = (LAS bf16*)(gl + CL_BHT); LAS bf16* iKHT = (LAS bf16*)(gl + CL_KHT); LAS bf16* iVT = (LAS bf16*)(gl + CL_VT);
    LAS float* gtot = (LAS float*)(gl + CL_GTOT); LAS float* gcv = (LAS float*)(gl + CL_GC); LAS float* Lm = (LAS float*)(gl + CL_L); LAS bf16* Tm = (LAS bf16*)(gl + CL_T);
    LAS bf16x8* fnrb = (LAS bf16x8*)(gl + CL_FNRB); LAS float* cnrk = (LAS float*)(gl + CL_CNRK); LAS bf16x8* fqm = (LAS bf16x8*)(gl + CL_FQM);
    LAS float* lwo_w = (LAS float*)(gl + CL_L); LAS float* lwo_a = lwo_w + 32 * 64;
    LAS bf16* LA = (LAS bf16*)(F.lds + CL2_LA);
    bf16 cr[9], ck[9], cv[9]; float cst[8]; bool tz;
#define S1_LOAD(tc_, hp_) do { const int _hh = 2 * (hp_) + grp, _cc = _hh * 64 + (gt & 63), _t0 = ((tc_) % NCHK) * CK + 8 * (gt >> 6); \
        const size_t _pr = ((size_t)_hh * M + (size_t)((tc_) / NCHK) * T + _t0) * 64 + (gt & 63); tz = _t0 > 0; const size_t _pp = tz ? _pr - 64 : _pr; \
        cr[0] = __builtin_nontemporal_load(P + _pp); ck[0] = __builtin_nontemporal_load(P + _pp + 8 * PL_SZ); cv[0] = __builtin_nontemporal_load(P + _pp + 16 * PL_SZ); \
        _Pragma("unroll") for (int _i = 0; _i < 8; ++_i) { cr[_i + 1] = __builtin_nontemporal_load(P + _pr + (size_t)_i * 64); ck[_i + 1] = __builtin_nontemporal_load(P + _pr + (size_t)_i * 64 + 8 * PL_SZ); cv[_i + 1] = __builtin_nontemporal_load(P + _pr + (size_t)_i * 64 + 16 * PL_SZ); } \
        cst[0] = mu[_cc]; cst[1] = mu[512 + _cc]; cst[2] = mu[1024 + _cc]; cst[3] = w0[_cc]; cst[4] = a0[_cc]; cst[5] = k_k[_cc]; cst[6] = k_a[_cc]; cst[7] = r_k[_cc]; } while (0)
    bf16x8 lwf[8];
#define LW_LOAD(hp_) do { const bf16* _lw = LW + (size_t)((2 * (hp_) + grp) * 64 + 32 * (w4 & 1) + r) * 256 + 8 * h + (w4 < 2 ? 0 : 128); \
        _Pragma("unroll") for (int _q = 0; _q < 8; ++_q) lwf[_q] = *(const bf16x8*)(_lw + 16 * _q); } while (0)
    S1_LOAD(F.vcu, 0);
    LW_LOAD(0);
    u32x4 sa_c[2], sa_p[2]; float sa_mu[2][8];
#pragma unroll
    for (int q8 = 0; q8 < 2; ++q8)
#pragma unroll
        for (int j = 0; j < 8; ++j) sa_mu[q8][j] = mu[1536 + (F.tid & 15) * 16 + 8 * q8 + j];
#define SA_LOAD(tc_) do { const int _tk = F.tid >> 4, _t = ((tc_) % NCHK) * CK + _tk; const size_t _row = (size_t)((tc_) / NCHK) * T + _t; \
        _Pragma("unroll") for (int _q = 0; _q < 2; ++_q) { const size_t _o = P_LORA + _row * 256 + (F.tid & 15) * 16 + 8 * _q; \
            sa_c[_q] = __builtin_nontemporal_load((const u32x4*)(P + _o)); sa_p[_q] = __builtin_nontemporal_load((const u32x4*)(P + (_t > 0 ? _o - 256 : _o))); } } while (0)
    SA_LOAD(F.vcu);
    for (int tc = F.vcu; tc < M / CK; tc += F.G) {
        const int b = tc / NCHK, c = tc % NCHK, t0 = c * CK, row0 = b * T + t0;
        lds_barrier();
        { const int tk = F.tid >> 4, cb = (F.tid & 15) * 16; float x[8];
#pragma unroll
            for (int q8 = 0; q8 < 2; ++q8) { const int col = cb + 8 * q8;
                { const u32x4 c_ = sa_c[q8], p_ = (t0 + tk > 0) ? sa_p[q8] : (u32x4){0u, 0u, 0u, 0u};
                    const float cf[8] = {bflo(c_.x), bfhi(c_.x), bflo(c_.y), bfhi(c_.y), bflo(c_.z), bfhi(c_.z), bflo(c_.w), bfhi(c_.w)};
                    const float pf[8] = {bflo(p_.x), bfhi(p_.x), bflo(p_.y), bfhi(p_.y), bflo(p_.z), bfhi(p_.z), bflo(p_.w), bfhi(p_.w)};
#pragma unroll
                    for (int j = 0; j < 8; ++j) x[j] = cf[j] + (pf[j] - cf[j]) * sa_mu[q8][j]; }
                if (col < 64) {
#pragma unroll
                    for (int j = 0; j < 8; ++j) x[j] = 2.f * sigmoidf_(2.f * x[j]) - 1.f; }
                else if (col >= 128) {
#pragma unroll
                    for (int j = 0; j < 8; ++j) x[j] = sigmoidf_(x[j]); }
                *(LAS bf16x8*)(LA + tk * LAS_STRIDE + col) = pack8(x); }
            const int ntc = (tc + F.G < M / CK) ? tc + F.G : tc; SA_LOAD(ntc); }
#pragma unroll 1
        for (int hp = 0; hp < 4; ++hp) {
            const int hh = 2 * hp + grp, bh = b * RH + hh, chunk = bh * NCHK + c;
            lds_barrier();
            { const int ct = w4 & 1;
                if (w4 < 2) {
                    f32x16 aw = zero16(), aa = zero16();
#pragma unroll
                    for (int ks = 0; ks < 4; ++ks) { aw = MFMA32(rd_nat(LA, LAS_STRIDE, r, 16 * ks + 8 * h), lwf[ks], aw); aa = MFMA32(rd_nat(LA, LAS_STRIDE, r, 64 + 16 * ks + 8 * h), lwf[4 + ks], aa); }
#pragma unroll
                    for (int i = 0; i < 16; ++i) { lwo_w[crow(i, h) * 64 + 32 * ct + r] = aw[i]; lwo_a[crow(i, h) * 64 + 32 * ct + r] = aa[i]; }
                } else {
                    f32x16 ag = zero16();
#pragma unroll
                    for (int ks = 0; ks < 8; ++ks) ag = MFMA32(rd_nat(LA, LAS_STRIDE, r, 128 + 16 * ks + 8 * h), lwf[ks], ag);
#pragma unroll
                    for (int i = 0; i < 16; ++i) G[(size_t)(row0 + crow(i, h)) * 512 + hh * 64 + 32 * ct + r] = (bf16)f2bf(ag[i]); } }
            LW_LOAD((hp + 1) & 3);
            lds_barrier();
            auto st1 = [&]() { const int k = gt & 63, tq = gt >> 6, cc = hh * 64 + k;
                float wv[8], kkv[8], bv[8], kv[8], rv[8], vv[8], lp[8];
                { const float mur = cst[0], muk = cst[1], muv = cst[2], w0c = cst[3], a0c = cst[4], kkc = cst[5], kac = cst[6], rkc = cst[7];
                    const int tl0 = 8 * tq;
                    if (!tz) { cr[0] = 0; ck[0] = 0; cv[0] = 0; }
                    float lw_[8], la_[8];
#pragma unroll
                    for (int i = 0; i < 8; ++i) { lw_[i] = lwo_w[(tl0 + i) * 64 + k]; la_[i] = lwo_a[(tl0 + i) * 64 + k]; }
                    float kk[8], ssq[8], bo[8], av[8];
#pragma unroll
                    for (int i = 0; i < 8; ++i) { const float c_r = bf2f(cr[i + 1]), c_k = bf2f(ck[i + 1]), c_v = bf2f(cv[i + 1]);
                        rv[i] = c_r + (bf2f(cr[i]) - c_r) * mur; const float kr = c_k + (bf2f(ck[i]) - c_k) * muk; vv[i] = c_v + (bf2f(cv[i]) - c_v) * muv;
                        wv[i] = __expf(-0.60653066f * sigmoidf_(w0c + lw_[i])); av[i] = sigmoidf_(a0c + la_[i]);
                        kk[i] = kr * kkc; ssq[i] = kk[i] * kk[i]; kv[i] = kr * (1.f + (av[i] - 1.f) * kac); bo[i] = rv[i] * kv[i] * rkc; }
#pragma unroll
                    for (int i = 0; i < 8; ++i) { ssq[i] = reduce16(ssq[i]); bo[i] = reduce16(bo[i]); }
#pragma unroll
                    for (int i = 0; i < 8; ++i) { ssq[i] += __shfl_xor(ssq[i], 16); bo[i] += __shfl_xor(bo[i], 16); }
#pragma unroll
                    for (int i = 0; i < 8; ++i) { ssq[i] += __shfl_xor(ssq[i], 32); bo[i] += __shfl_xor(bo[i], 32); }
#pragma unroll
                    for (int i = 0; i < 8; ++i) { kkv[i] = kk[i] * __builtin_amdgcn_rcpf(fmaxf(sqrtf(ssq[i]), 1e-12f)); bv[i] = kkv[i] * av[i];
                        ((bf16*)SV)[((size_t)bh * T + t0 + tl0 + i) * 64 + k] = (bf16)f2bf(vv[i]);
                        if (k == 0) BON[(row0 + tl0 + i) * 8 + hh] = bo[i]; } }
                lp[0] = wv[0];
#pragma unroll
                for (int i = 1; i < 8; ++i) lp[i] = lp[i - 1] * wv[i];
                gtot[tq * 64 + k] = lp[7];
                lds_barrier();
                const float g0 = gtot[k], g1 = gtot[64 + k], g2 = gtot[128 + k], g3 = gtot[192 + k];
                const float pre = tq == 0 ? 1.f : (tq == 1 ? g0 : (tq == 2 ? g0 * g1 : g0 * g1 * g2)), gC = (g0 * g1) * (g2 * g3);
                float at[8], bh8[8], kh8[8];
#pragma unroll
                for (int i = 0; i < 8; ++i) { const float g = pre * lp[i], gp = i == 0 ? pre : pre * lp[i - 1], ig = __builtin_amdgcn_rcpf(g);
                    const float bt = bv[i] * ig, kt = kv[i] * ig; at[i] = -kkv[i] * gp; bh8[i] = bt * gC; kh8[i] = kt * gC;
                    const int ro = (8 * tq + i) * RMS + k;
                    iA[ro] = (bf16)f2bf(at[i]); iB[ro] = (bf16)f2bf(bt); iK[ro] = (bf16)f2bf(kt); iR[ro] = (bf16)f2bf(rv[i] * g); }
                *(LAS bf16x8*)(iAT + k * TRS + 8 * tq) = pack8(at); *(LAS bf16x8*)(iBHT + k * TRS + 8 * tq) = pack8(bh8); *(LAS bf16x8*)(iKHT + k * TRS + 8 * tq) = pack8(kh8);
                *(LAS bf16x8*)(iVT + k * TRS + 8 * tq) = pack8(vv);
                if (tq == 0) gcv[k] = gC; };
            st1();
#if MK_DUP & 2
            lds_barrier(); asm volatile("" ::: "memory"); st1();
#endif
            { const int ntc = (hp < 3) ? tc : (tc + F.G < M / CK ? tc + F.G : tc), nhp = (hp < 3) ? hp + 1 : 0; S1_LOAD(ntc, nhp); }
            lds_barrier();
            f32x16 lak = zero16();
            { const LAS bf16* ia = (w4 < 2) ? iA : (w4 == 2 ? iB : iK); const LAS bf16* ib = (w4 == 0) ? iB : (w4 == 1 ? iK : iR);
                f32x16 acc = zero16();
#pragma unroll
                for (int ks = 0; ks < 4; ++ks) acc = MFMA32(rd_nat(ia, RMS, r, 16 * ks + 8 * h), rd_nat(ib, RMS, r, 16 * ks + 8 * h), acc);
#pragma unroll
                for (int i = 0; i < 16; ++i) { const int row = crow(i, h); const bool keep = (w4 < 2) ? (r < row) : (row <= r); acc[i] = keep ? acc[i] : 0.f; }
                if (w4 <= 1) lak = acc;
                else if (w4 == 2) { fnrb[lane] = pack_acc<0>(acc); fnrb[64 + lane] = pack_acc<1>(acc); }
                else {
#pragma unroll
                    for (int i = 0; i < 16; ++i) cnrk[i * 64 + lane] = acc[i]; } }
            lds_barrier();
            auto st3 = [&]() { if (w4 == 0) {
                LAS bf16* imgL = (LAS bf16*)(gl + CL_L);
                f32x16 Lp = lak, Tq = lak;
#pragma unroll
                for (int i = 0; i < 16; ++i) Tq[i] += (crow(i, h) == r) ? 1.f : 0.f;
#pragma unroll
                for (int st = 0; st < 4; ++st) {
#pragma unroll
                    for (int i = 0; i < 16; ++i) { imgL[crow(i, h) * TRS + r] = (bf16)f2bf(Lp[i]); Tm[crow(i, h) * TRS + r] = (bf16)f2bf(Tq[i]); }
                    asm volatile("s_waitcnt lgkmcnt(0)" ::: "memory");
                    const bf16x8 b0 = pack_acc<0>(Lp), b1 = pack_acc<1>(Lp);
                    f32x16 l2 = zero16(); l2 = MFMA32(rd_perm(imgL, TRS, r, 0, h), b0, l2); l2 = MFMA32(rd_perm(imgL, TRS, r, 16, h), b1, l2);
                    Lp = l2;
                    f32x16 mm = l2;
#pragma unroll
                    for (int i = 0; i < 16; ++i) mm[i] += (crow(i, h) == r) ? 1.f : 0.f;
                    const bf16x8 m0 = pack_acc<0>(mm), m1 = pack_acc<1>(mm);
                    f32x16 t2 = zero16(); t2 = MFMA32(rd_perm(Tm, TRS, r, 0, h), m0, t2); t2 = MFMA32(rd_perm(Tm, TRS, r, 16, h), m1, t2);
                    Tq = t2;
                    asm volatile("s_waitcnt lgkmcnt(0)" ::: "memory"); }
#pragma unroll
                for (int i = 0; i < 16; ++i) Tm[crow(i, h) * TRS + r] = (bf16)f2bf(Tq[i]); } };
            st3();
#if MK_DUP & 4
            asm volatile("" ::: "memory"); st3();
#endif
            lds_barrier();
            auto st4 = [&]() { if (w4 == 0 || w4 == 2) { const int a = w4 >> 1;
                f32x16 x1 = zero16();
#pragma unroll
                for (int ks = 0; ks < 2; ++ks) x1 = MFMA32(rd_nat(Tm, TRS, r, 16 * ks + 8 * h), rd_nat(iAT, TRS, 32 * a + r, 16 * ks + 8 * h), x1);
                const bf16x8 xf0 = pack_acc<0>(x1), xf1 = pack_acc<1>(x1);
#pragma unroll
                for (int b = 0; b < 2; ++b) { f32x16 p = zero16();
                    p = MFMA32(xf0, rd_perm(iBHT, TRS, 32 * b + r, 0, h), p); p = MFMA32(xf1, rd_perm(iBHT, TRS, 32 * b + r, 16, h), p);
                    if (a == b) { const float gc = gcv[32 * a + r];
#pragma unroll
                        for (int i = 0; i < 16; ++i) p[i] += (crow(i, h) == r) ? gc : 0.f; }
                    bf16x8* dst = PT + ((size_t)(chunk * 2 + a) * 2 + b) * 2 * 64 + lane; dst[0] = pack_acc<0>(p); dst[64] = pack_acc<1>(p); }
                f32x16 ry;
#pragma unroll
                for (int g = 0; g < 4; ++g) { const u32x2 rr = *(const LAS u32x2*)(iR + r * RMS + 32 * a + 8 * g + 4 * h);
                    ry[4 * g] = bflo(rr.x); ry[4 * g + 1] = bfhi(rr.x); ry[4 * g + 2] = bflo(rr.y); ry[4 * g + 3] = bfhi(rr.y); }
                ry = MFMA32(xf0, fnrb[lane], ry); ry = MFMA32(xf1, fnrb[64 + lane], ry);
                bf16x8* dr = RYT + (size_t)(chunk * 2 + a) * 2 * 64 + lane; dr[0] = pack_acc<0>(ry); dr[64] = pack_acc<1>(ry);
            } else if (w4 == 1) {
                f32x16 x2 = zero16();
                x2 = MFMA32(rd_perm(Tm, TRS, r, 0, h), pack_acc<0>(lak), x2); x2 = MFMA32(rd_perm(Tm, TRS, r, 16, h), pack_acc<1>(lak), x2);
                const bf16x8 xf0 = pack_acc<0>(x2), xf1 = pack_acc<1>(x2);
#pragma unroll
                for (int b = 0; b < 2; ++b) { f32x16 qm;
#pragma unroll
                    for (int g = 0; g < 4; ++g) { const u32x2 kk2 = *(const LAS u32x2*)(iKHT + (32 * b + r) * TRS + 8 * g + 4 * h);
                        qm[4 * g] = bflo(kk2.x); qm[4 * g + 1] = bfhi(kk2.x); qm[4 * g + 2] = bflo(kk2.y); qm[4 * g + 3] = bfhi(kk2.y); }
                    qm = MFMA32(xf0, rd_perm(iBHT, TRS, 32 * b + r, 0, h), qm); qm = MFMA32(xf1, rd_perm(iBHT, TRS, 32 * b + r, 16, h), qm);
                    fqm[(b * 2 + 0) * 64 + lane] = pack_acc<0>(qm); fqm[(b * 2 + 1) * 64 + lane] = pack_acc<1>(qm); }
                f32x16 gy;
#pragma unroll
                for (int i = 0; i < 16; ++i) gy[i] = cnrk[i * 64 + lane];
                gy = MFMA32(xf0, fnrb[lane], gy); gy = MFMA32(xf1, fnrb[64 + lane], gy);
                const bf16x8 gf0 = pack_acc<0>(gy), gf1 = pack_acc<1>(gy);
#pragma unroll
                for (int vh = 0; vh < 2; ++vh) { f32x16 yv = zero16();
                    yv = MFMA32(rd_perm(iVT, TRS, 32 * vh + r, 0, h), gf0, yv); yv = MFMA32(rd_perm(iVT, TRS, 32 * vh + r, 16, h), gf1, yv);
                    bf16x8* dy = (bf16x8*)YVT + ((size_t)(chunk * 2 + vh) * 64 + lane) * 2;
                    dy[0] = pack_acc<0>(yv); dy[1] = pack_acc<1>(yv); }
            } };
            st4();
#if MK_DUP & 8
            asm volatile("" ::: "memory"); st4();
#endif
            lds_barrier();
            if (w4 == 3) {
#pragma unroll
                for (int b = 0; b < 2; ++b)
#pragma unroll
                    for (int vh = 0; vh < 2; ++vh) { f32x16 zv = zero16();
                        zv = MFMA32(fqm[(b * 2 + 0) * 64 + lane], rd_perm(iVT, TRS, 32 * vh + r, 0, h), zv); zv = MFMA32(fqm[(b * 2 + 1) * 64 + lane], rd_perm(iVT, TRS, 32 * vh + r, 16, h), zv);
                        bf16x8* dz = (bf16x8*)ZV + (((size_t)(chunk * 2 + b) * 2 + vh) * 64 + lane) * 2;
                        dz[0] = pack_acc<0>(zv); dz[1] = pack_acc<1>(zv); }
            }
        }
    }
#undef S1_LOAD
#undef LW_LOAD
#undef SA_LOAD
}
constexpr int WRS = 68, WTS = 36;
constexpr int WL_A = 0, WL_B = 4352, WL_K = 8704, WL_R = 13056, WL_AT = 17408, WL_BHT = 22016, WL_KHT = 26624, WL_VT = 31232, WL_SIZE = 35840, WL_LA = 4 * WL_SIZE;
static_assert(WL_LA + 32 * LAS_STRIDE * 2 <= MISC_OFF, "wave-per-chunk LDS map");
__device__ __forceinline__ bf16x8 rd_nat2(const LAS bf16* img, int stride, int row, int k0) {
    const u32x2 lo = *(const LAS u32x2*)(img + row * stride + k0), hi = *(const LAS u32x2*)(img + row * stride + k0 + 4);
    u32x4 w; w.x = lo.x; w.y = lo.y; w.z = hi.x; w.w = hi.y; return __builtin_bit_cast(bf16x8, w);
}
__device__ __forceinline__ void phase4a_wave(const Frame& F) {
    const bf16* P = wsp<bf16>(F, WS_P); const bf16* LW = wsp<bf16>(F, WS_LW);
    const float* mu = F.in[6]; const float* w0 = F.in[7]; const float* a0 = F.in[9]; const float* k_k = F.in[12]; const float* k_a = F.in[13]; const float* r_k = F.in[14];
    float* SV = wsp<float>(F, WS_SV); bf16* G = wsp<bf16>(F, WS_G); float* BON = wsp<float>(F, WS_BONUS);
    bf16x8* PT = wsp<bf16x8>(F, WS_PT); f32x4* ZV = wsp<f32x4>(F, WS_ZV); bf16x8* RYT = wsp<bf16x8>(F, WS_RYT); f32x4* YVT = wsp<f32x4>(F, WS_YVT);
    const int wv_ = F.wave & 3;
    LAS unsigned char* gl = F.lds + wv_ * WL_SIZE;
    LAS bf16* iA = (LAS bf16*)(gl + WL_A); LAS bf16* iB = (LAS bf16*)(gl + WL_B); LAS bf16* iK = (LAS bf16*)(gl + WL_K); LAS bf16* iR = (LAS bf16*)(gl + WL_R);
    LAS bf16* iAT = (LAS bf16*)(gl + WL_AT); LAS bf16* iBHT = (LAS bf16*)(gl + WL_BHT); LAS bf16* iKHT = (LAS bf16*)(gl + WL_KHT); LAS bf16* iVT = (LAS bf16*)(gl + WL_VT);
    LAS bf16* imgL = iA; LAS bf16* Tm = iB;
    LAS bf16* LA = (LAS bf16*)(F.lds + WL_LA);
    for (int tc = F.vcu; tc < M / CK; tc += F.G) {
        const int b = tc / NCHK, c = tc % NCHK, t0 = c * CK, row0 = b * T + t0;
        lds_barrier();
        { const int tk = F.tid >> 4, cb = (F.tid & 15) * 16; float x[8];
#pragma unroll
            for (int q8 = 0; q8 < 2; ++q8) { const int col = cb + 8 * q8; lerp8(P, mu, row0 + tk, t0 + tk, 1536 + col, x);
                if (col < 64) {
#pragma unroll
                    for (int j = 0; j < 8; ++j) x[j] = 2.f * sigmoidf_(2.f * x[j]) - 1.f; }
                else if (col >= 128) {
#pragma unroll
                    for (int j = 0; j < 8; ++j) x[j] = sigmoidf_(x[j]); }
                *(LAS bf16x8*)(LA + tk * LAS_STRIDE + col) = pack8(x); } }
        lds_barrier();
        if (F.wave < 4) {
#pragma unroll 1
        for (int rnd = 0; rnd < 2; ++rnd) {
            int lane = F.lane; asm volatile("" : "+v"(lane));
            const int r = lane & 31, h = lane >> 5;
            const int hh = wv_ + 4 * rnd, bh = b * RH + hh, chunk = bh * NCHK + c, cc = hh * 64 + lane;
            f32x16 aw[2], aa[2];
#pragma unroll
            for (int ct = 0; ct < 2; ++ct) { const bf16* lw = LW + (size_t)(hh * 64 + 32 * ct + r) * 256 + 8 * h;
                { bf16x8 bf_[8];
#pragma unroll
                    for (int ks = 0; ks < 8; ++ks) bf_[ks] = *(const bf16x8*)(lw + 128 + 16 * ks);
                    f32x16 g_ = zero16();
#pragma unroll
                    for (int ks = 0; ks < 8; ++ks) g_ = MFMA32(rd_nat(LA, LAS_STRIDE, r, 128 + 16 * ks + 8 * h), bf_[ks], g_);
#pragma unroll
                    for (int i = 0; i < 16; ++i) if (MK_WMASK & 1) G[(size_t)(row0 + crow(i, h)) * 512 + hh * 64 + 32 * ct + r] = (bf16)f2bf(g_[i]); }
                { bf16x8 bf_[8];
#pragma unroll
                    for (int ks = 0; ks < 8; ++ks) bf_[ks] = *(const bf16x8*)(lw + 16 * ks);
                    f32x16 w_ = zero16(), a_ = zero16();
#pragma unroll
                    for (int ks = 0; ks < 4; ++ks) { w_ = MFMA32(rd_nat(LA, LAS_STRIDE, r, 16 * ks + 8 * h), bf_[ks], w_); a_ = MFMA32(rd_nat(LA, LAS_STRIDE, r, 64 + 16 * ks + 8 * h), bf_[4 + ks], a_); }
                    aw[ct] = w_; aa[ct] = a_; } }
            f32x16 wo, wr_, ao, ar_;
#pragma unroll
            for (int i = 0; i < 16; ++i) { wo[i] = h ? aw[1][i] : aw[0][i]; ao[i] = h ? aa[1][i] : aa[0][i];
                wr_[i] = __shfl_xor(h ? aw[0][i] : aw[1][i], 32); ar_[i] = __shfl_xor(h ? aa[0][i] : aa[1][i], 32); }
            const float mur = mu[cc], muk = mu[512 + cc], muv = mu[1024 + cc], w0c = w0[cc], a0c = a0[cc], kkc = k_k[cc], kac = k_a[cc], rkc = r_k[cc];
            float gam[32];
#pragma unroll
            for (int t = 0; t < 32; ++t) { const int i = (t & 3) + 4 * (t >> 3); const float wl = (((t >> 2) & 1) == h) ? wo[i] : wr_[i];
                const float dec = __expf(-0.60653066f * sigmoidf_(w0c + wl)); gam[t] = t ? gam[t - 1] * dec : dec; }
            const float gC = gam[31];
            const size_t pbase = (size_t)row0 * IN_COLS + cc;
            bf16 pr_ = 0, pk_ = 0, pv_ = 0;
            if (t0 > 0) { pr_ = P[pbase - IN_COLS]; pk_ = P[pbase - IN_COLS + 512]; pv_ = P[pbase - IN_COLS + 1024]; }
#pragma unroll
            for (int tb = 0; tb < 4; ++tb) {
                asm volatile("" ::: "memory");
                bf16 cr[8], ck[8], cv[8];
#pragma unroll
                for (int i = 0; i < 8; ++i) { const size_t o = pbase + (size_t)(8 * tb + i) * IN_COLS; cr[i] = P[o]; ck[i] = P[o + 512]; cv[i] = P[o + 1024]; }
                float rv[8], vv[8], kk[8], ssq[8], bo[8], av[8], kv[8];
#pragma unroll
                for (int i = 0; i < 8; ++i) { const int t = 8 * tb + i, ii = (t & 3) + 4 * (t >> 3);
                    const float c_r = bf2f(cr[i]), c_k = bf2f(ck[i]), c_v = bf2f(cv[i]);
                    const float p_r = bf2f(i ? cr[i - 1] : pr_), p_k = bf2f(i ? ck[i - 1] : pk_), p_v = bf2f(i ? cv[i - 1] : pv_);
                    rv[i] = c_r + (p_r - c_r) * mur; const float kr = c_k + (p_k - c_k) * muk; vv[i] = c_v + (p_v - c_v) * muv;
                    const float al = (((t >> 2) & 1) == h) ? ao[ii] : ar_[ii];
                    av[i] = sigmoidf_(a0c + al);
                    kk[i] = kr * kkc; ssq[i] = kk[i] * kk[i]; kv[i] = kr * (1.f + (av[i] - 1.f) * kac); bo[i] = rv[i] * kv[i] * rkc; }
                pr_ = cr[7]; pk_ = ck[7]; pv_ = cv[7];
#pragma unroll
                for (int i = 0; i < 8; ++i) { ssq[i] = reduce16(ssq[i]); bo[i] = reduce16(bo[i]); }
#pragma unroll
                for (int i = 0; i < 8; ++i) { ssq[i] += __shfl_xor(ssq[i], 16); bo[i] += __shfl_xor(bo[i], 16); }
#pragma unroll
                for (int i = 0; i < 8; ++i) { ssq[i] += __shfl_xor(ssq[i], 32); bo[i] += __shfl_xor(bo[i], 32); }
                float at[8], bh8[8], kh8[8];
#pragma unroll
                for (int i = 0; i < 8; ++i) { const int t = 8 * tb + i;
                    const float kkn = kk[i] * __builtin_amdgcn_rcpf(fmaxf(sqrtf(ssq[i]), 1e-12f)), bb = kkn * av[i];
                    const float g = gam[t], gp = t ? gam[t - 1] : 1.f, ig = __builtin_amdgcn_rcpf(g);
                    const float bt = bb * ig, kt = kv[i] * ig; at[i] = -kkn * gp; bh8[i] = bt * gC; kh8[i] = kt * gC;
                    const int ro = t * WRS + lane;
                    iA[ro] = (bf16)f2bf(at[i]); iB[ro] = (bf16)f2bf(bt); iK[ro] = (bf16)f2bf(kt); iR[ro] = (bf16)f2bf(rv[i] * g);
                    if (MK_WMASK & 2) { ((bf16*)SV)[((size_t)bh * T + t0 + t) * 64 + lane] = (bf16)f2bf(vv[i]);
                    if (lane == 0) BON[(row0 + t) * 8 + hh] = bo[i]; } }
#pragma unroll
                for (int q = 0; q < 2; ++q) { u32x2 w;
                    w.x = pk2(at[4 * q], at[4 * q + 1]); w.y = pk2(at[4 * q + 2], at[4 * q + 3]); *(LAS u32x2*)(iAT + lane * WTS + 8 * tb + 4 * q) = w;
                    w.x = pk2(bh8[4 * q], bh8[4 * q + 1]); w.y = pk2(bh8[4 * q + 2], bh8[4 * q + 3]); *(LAS u32x2*)(iBHT + lane * WTS + 8 * tb + 4 * q) = w;
                    w.x = pk2(kh8[4 * q], kh8[4 * q + 1]); w.y = pk2(kh8[4 * q + 2], kh8[4 * q + 3]); *(LAS u32x2*)(iKHT + lane * WTS + 8 * tb + 4 * q) = w;
                    w.x = pk2(vv[4 * q], vv[4 * q + 1]); w.y = pk2(vv[4 * q + 2], vv[4 * q + 3]); *(LAS u32x2*)(iVT + lane * WTS + 8 * tb + 4 * q) = w; }
            }
            asm volatile("s_waitcnt lgkmcnt(0)" ::: "memory");
            f32x16 lab = zero16(), lak = zero16(), nrb = zero16(), nrk = zero16();
#pragma unroll
            for (int ks = 0; ks < 4; ++ks) { const bf16x8 fa = rd_nat2(iA, WRS, r, 16 * ks + 8 * h), fb = rd_nat2(iB, WRS, r, 16 * ks + 8 * h), fk = rd_nat2(iK, WRS, r, 16 * ks + 8 * h), fr_ = rd_nat2(iR, WRS, r, 16 * ks + 8 * h);
                lab = MFMA32(fa, fb, lab); lak = MFMA32(fa, fk, lak); nrb = MFMA32(fb, fr_, nrb); nrk = MFMA32(fk, fr_, nrk); }
#pragma unroll
            for (int i = 0; i < 16; ++i) { const int row = crow(i, h); lab[i] = (r < row) ? lab[i] : 0.f; lak[i] = (r < row) ? lak[i] : 0.f; nrb[i] = (row <= r) ? nrb[i] : 0.f; nrk[i] = (row <= r) ? nrk[i] : 0.f; }
            const bf16x8 fn0 = pack_acc<0>(nrb), fn1 = pack_acc<1>(nrb);
            asm volatile("s_waitcnt lgkmcnt(0)" ::: "memory");
            { f32x16 Lp = lab, Tq = lab;
#pragma unroll
                for (int i = 0; i < 16; ++i) Tq[i] += (crow(i, h) == r) ? 1.f : 0.f;
#pragma unroll
                for (int st = 0; st < 4; ++st) {
#pragma unroll
                    for (int i = 0; i < 16; ++i) { imgL[crow(i, h) * WTS + r] = (bf16)f2bf(Lp[i]); Tm[crow(i, h) * WTS + r] = (bf16)f2bf(Tq[i]); }
                    asm volatile("s_waitcnt lgkmcnt(0)" ::: "memory");
                    const bf16x8 b0 = pack_acc<0>(Lp), b1 = pack_acc<1>(Lp);
                    f32x16 l2 = zero16(); l2 = MFMA32(rd_perm(imgL, WTS, r, 0, h), b0, l2); l2 = MFMA32(rd_perm(imgL, WTS, r, 16, h), b1, l2);
                    Lp = l2;
                    f32x16 mm = l2;
#pragma unroll
                    for (int i = 0; i < 16; ++i) mm[i] += (crow(i, h) == r) ? 1.f : 0.f;
                    const bf16x8 m0 = pack_acc<0>(mm), m1 = pack_acc<1>(mm);
                    f32x16 t2 = zero16(); t2 = MFMA32(rd_perm(Tm, WTS, r, 0, h), m0, t2); t2 = MFMA32(rd_perm(Tm, WTS, r, 16, h), m1, t2);
                    Tq = t2;
                    asm volatile("s_waitcnt lgkmcnt(0)" ::: "memory"); }
#pragma unroll
                for (int i = 0; i < 16; ++i) Tm[crow(i, h) * WTS + r] = (bf16)f2bf(Tq[i]);
                asm volatile("s_waitcnt lgkmcnt(0)" ::: "memory"); }
            const float gcd2[2] = {__shfl(gC, r), __shfl(gC, 32 + r)};
#pragma unroll
            for (int a = 0; a < 2; ++a) { f32x16 x1 = zero16();
#pragma unroll
                for (int ks = 0; ks < 2; ++ks) x1 = MFMA32(rd_nat2(Tm, WTS, r, 16 * ks + 8 * h), rd_nat2(iAT, WTS, 32 * a + r, 16 * ks + 8 * h), x1);
                const bf16x8 xf0 = pack_acc<0>(x1), xf1 = pack_acc<1>(x1);
#pragma unroll
                for (int b2 = 0; b2 < 2; ++b2) { f32x16 p = zero16();
                    p = MFMA32(xf0, rd_perm(iBHT, WTS, 32 * b2 + r, 0, h), p); p = MFMA32(xf1, rd_perm(iBHT, WTS, 32 * b2 + r, 16, h), p);
                    if (a == b2) { const float gcd = gcd2[a];
#pragma unroll
                        for (int i = 0; i < 16; ++i) p[i] += (crow(i, h) == r) ? gcd : 0.f; }
                    bf16x8* dst = PT + ((size_t)(chunk * 2 + a) * 2 + b2) * 2 * 64 + lane; if (MK_WMASK & 4) { dst[0] = pack_acc<0>(p); dst[64] = pack_acc<1>(p); } }
                f32x16 ry;
#pragma unroll
                for (int g = 0; g < 4; ++g) { const u32x2 rr = *(const LAS u32x2*)(iR + r * WRS + 32 * a + 8 * g + 4 * h);
                    ry[4 * g] = bflo(rr.x); ry[4 * g + 1] = bfhi(rr.x); ry[4 * g + 2] = bflo(rr.y); ry[4 * g + 3] = bfhi(rr.y); }
                ry = MFMA32(xf0, fn0, ry); ry = MFMA32(xf1, fn1, ry);
                bf16x8* dr = RYT + (size_t)(chunk * 2 + a) * 2 * 64 + lane; if (MK_WMASK & 8) { dr[0] = pack_acc<0>(ry); dr[64] = pack_acc<1>(ry); } }
            { f32x16 x2 = zero16();
                x2 = MFMA32(rd_perm(Tm, WTS, r, 0, h), pack_acc<0>(lak), x2); x2 = MFMA32(rd_perm(Tm, WTS, r, 16, h), pack_acc<1>(lak), x2);
                const bf16x8 xf0 = pack_acc<0>(x2), xf1 = pack_acc<1>(x2);
                bf16x8 fq[2][2];
#pragma unroll
                for (int b2 = 0; b2 < 2; ++b2) { f32x16 qm;
#pragma unroll
                    for (int g = 0; g < 4; ++g) { const u32x2 kk2 = *(const LAS u32x2*)(iKHT + (32 * b2 + r) * WTS + 8 * g + 4 * h);
                        qm[4 * g] = bflo(kk2.x); qm[4 * g + 1] = bfhi(kk2.x); qm[4 * g + 2] = bflo(kk2.y); qm[4 * g + 3] = bfhi(kk2.y); }
                    qm = MFMA32(xf0, rd_perm(iBHT, WTS, 32 * b2 + r, 0, h), qm); qm = MFMA32(xf1, rd_perm(iBHT, WTS, 32 * b2 + r, 16, h), qm);
                    fq[b2][0] = pack_acc<0>(qm); fq[b2][1] = pack_acc<1>(qm); }
                f32x16 gy = nrk;
                gy = MFMA32(xf0, fn0, gy); gy = MFMA32(xf1, fn1, gy);
                const bf16x8 gf0 = pack_acc<0>(gy), gf1 = pack_acc<1>(gy);
#pragma unroll
                for (int vh = 0; vh < 2; ++vh) { f32x16 yv = zero16();
                    yv = MFMA32(rd_perm(iVT, WTS, 32 * vh + r, 0, h), gf0, yv); yv = MFMA32(rd_perm(iVT, WTS, 32 * vh + r, 16, h), gf1, yv);
                    bf16x8* dy = (bf16x8*)YVT + ((size_t)(chunk * 2 + vh) * 64 + lane) * 2;
                    if (MK_WMASK & 16) { dy[0] = pack_acc<0>(yv); dy[1] = pack_acc<1>(yv); } }
#pragma unroll
                for (int b2 = 0; b2 < 2; ++b2)
#pragma unroll
                    for (int vh = 0; vh < 2; ++vh) { f32x16 zv = zero16();
                        zv = MFMA32(fq[b2][0], rd_perm(iVT, WTS, 32 * vh + r, 0, h), zv); zv = MFMA32(fq[b2][1], rd_perm(iVT, WTS, 32 * vh + r, 16, h), zv);
                        bf16x8* dz = (bf16x8*)ZV + (((size_t)(chunk * 2 + b2) * 2 + vh) * 64 + lane) * 2;
                        if (MK_WMASK & 32) { dz[0] = pack_acc<0>(zv); dz[1] = pack_acc<1>(zv); } } }
            asm volatile("s_waitcnt lgkmcnt(0)" ::: "memory");
        }
        }
    }
}

__device__ __forceinline__ void phase5_attn_part(const Frame& F, int first, int stride);
constexpr int SB_SLOT = 16384, SB_NSLOT = 7, SB_FLAGS = SB_NSLOT * SB_SLOT;
constexpr int CONV_4B = ((MK_CONV_WHERE == 9 || MK_CONV_WHERE == 8) && !MK_ATTN_IN_4B) ? 6144 : 0;
__device__ __forceinline__ void phase4b_states(const Frame& F) {
    volatile LAS unsigned* FULL = (volatile LAS unsigned*)(F.lds + SB_FLAGS);
    volatile LAS unsigned* DONEC = (volatile LAS unsigned*)(F.lds + SB_FLAGS + 64);
    __syncthreads();
    if (F.tid < 32) ((LAS unsigned*)(F.lds + SB_FLAGS))[F.tid] = 0u;
    __syncthreads();
    if (F.vcu < 128) {
        const int bh = F.vcu >> 1, vh = F.vcu & 1, lane = F.lane;
        if (F.wave == 0) {
            bf16x8* Z0 = wsp<bf16x8>(F, WS_Z0);
            f32x16 z0 = zero16(), z1 = zero16();
            bf16x8 pf[8]; u32x4 zq[2][2];
#define SB_FETCH(c_, slot_) do { { int sp = 0; while (FULL[slot_] < (unsigned)((c_) + 1)) { if (++sp > SC_SPIN_CAP) break; } } \
                __builtin_amdgcn_fence(__ATOMIC_ACQUIRE, "workgroup"); \
                const LAS unsigned char* sb = F.lds + (slot_) * SB_SLOT; const LAS bf16x8* p = (const LAS bf16x8*)sb + lane; \
                _Pragma("unroll") for (int q = 0; q < 8; ++q) pf[q] = p[q * 64]; \
                zq[0][0] = ((const LAS u32x4*)(sb + 8192) + lane * 2)[0]; zq[0][1] = ((const LAS u32x4*)(sb + 8192) + lane * 2)[1]; \
                zq[1][0] = ((const LAS u32x4*)(sb + 10240) + lane * 2)[0]; zq[1][1] = ((const LAS u32x4*)(sb + 10240) + lane * 2)[1]; \
                asm volatile("s_waitcnt lgkmcnt(0)" ::: "memory"); \
                if (lane == 0) DONEC[0] = (unsigned)((c_) + 1); } while (0)
            SB_FETCH(0, 0);
            int slot = 0;
            for (int c = 0; c < NCHK; ++c) { const int chunk = bh * NCHK + c;
                const bf16x8 f00 = pack_acc<0>(z0), f01 = pack_acc<1>(z0), f10 = pack_acc<0>(z1), f11 = pack_acc<1>(z1);
                bf16x8* dz = Z0 + (size_t)(chunk * 2 + vh) * 4 * 64 + lane; dz[0] = f00; dz[64] = f01; dz[128] = f10; dz[192] = f11;
                f32x16 n0, n1;
#pragma unroll
                for (int q = 0; q < 2; ++q) { const u32x4 u = zq[0][q], w = zq[1][q];
                    n0[8 * q] = bflo(u.x); n0[8 * q + 1] = bfhi(u.x); n0[8 * q + 2] = bflo(u.y); n0[8 * q + 3] = bfhi(u.y); n0[8 * q + 4] = bflo(u.z); n0[8 * q + 5] = bfhi(u.z); n0[8 * q + 6] = bflo(u.w); n0[8 * q + 7] = bfhi(u.w);
                    n1[8 * q] = bflo(w.x); n1[8 * q + 1] = bfhi(w.x); n1[8 * q + 2] = bflo(w.y); n1[8 * q + 3] = bfhi(w.y); n1[8 * q + 4] = bflo(w.z); n1[8 * q + 5] = bfhi(w.z); n1[8 * q + 6] = bflo(w.w); n1[8 * q + 7] = bfhi(w.w); }
                n0 = MFMA32(pf[0], f00, n0); n1 = MFMA32(pf[2], f00, n1); n0 = MFMA32(pf[1], f01, n0); n1 = MFMA32(pf[3], f01, n1);
                n0 = MFMA32(pf[4], f10, n0); n1 = MFMA32(pf[6], f10, n1); n0 = MFMA32(pf[5], f11, n0); n1 = MFMA32(pf[7], f11, n1);
                slot = (slot + 1 == SB_NSLOT) ? 0 : slot + 1;
                if (c + 1 < NCHK) SB_FETCH(c + 1, slot);
                z0 = n0; z1 = n1; }
#undef SB_FETCH
        } else {
            const int slot = F.wave - 1;
            const unsigned char* gpt = (const unsigned char*)wsp<bf16x8>(F, WS_PT) + lane * 16;
            const unsigned char* gzv = (const unsigned char*)wsp<f32x4>(F, WS_ZV) + lane * 16;
            LAS unsigned char* dst = F.lds + slot * SB_SLOT;
            for (int c = slot; c < NCHK; c += SB_NSLOT) { const int chunk = bh * NCHK + c;
                if (c >= SB_NSLOT) { const unsigned need = (unsigned)(c - SB_NSLOT + 1); int sp = 0;
                    while (DONEC[0] < need) { __builtin_amdgcn_s_sleep(1); if (++sp > SC_SPIN_CAP) break; }
                    __builtin_amdgcn_fence(__ATOMIC_ACQUIRE, "workgroup"); }
                const unsigned char* sp_ = gpt + (size_t)chunk * 8192;
#pragma unroll
                for (int j = 0; j < 8; ++j) __builtin_amdgcn_global_load_lds((const unsigned*)(sp_ + j * 1024), (LAS unsigned*)(dst + j * 1024), 16, 0, 0);
                const unsigned char* sz0 = gzv + ((size_t)(chunk * 2 + 0) * 2 + vh) * 2048; const unsigned char* sz1 = gzv + ((size_t)(chunk * 2 + 1) * 2 + vh) * 2048;
#pragma unroll
                for (int j = 0; j < 2; ++j) { __builtin_amdgcn_global_load_lds((const unsigned*)(sz0 + j * 1024), (LAS unsigned*)(dst + 8192 + j * 1024), 16, 0, 0);
                    __builtin_amdgcn_global_load_lds((const unsigned*)(sz1 + j * 1024), (LAS unsigned*)(dst + 10240 + j * 1024), 16, 0, 0); }
                asm volatile("s_waitcnt vmcnt(0)" ::: "memory");
                if (lane == 0) FULL[slot] = (unsigned)(c + 1); }
        }
    } else {
#if MK_ATTN_IN_4B
        phase5_attn_part(F, F.vcu - 128, 128);
#else
        for (int it = (F.vcu - 128) * 8 + F.wave; it < CONV_4B; it += 128 * 8) moe_weight_item(F, it);
#endif
    }
    __syncthreads();
}

__device__ __forceinline__ void phase4c_output(const Frame& F) {
    const bf16x8* Z0 = wsp<bf16x8>(F, WS_Z0); const bf16x8* RYT = wsp<bf16x8>(F, WS_RYT); const f32x4* YVT = wsp<f32x4>(F, WS_YVT);
    const float* SV = wsp<float>(F, WS_SV); const bf16* G = wsp<bf16>(F, WS_G); const float* BON = wsp<float>(F, WS_BONUS); bf16* CAT = wsp<bf16>(F, WS_CAT);
    const float* lg = F.in[15]; const float* lb = F.in[16];
    const int gw = F.vcu * 8 + F.wave, NGW = F.G * 8, lane = F.lane, r = lane & 31, h = lane >> 5;
    for (int tc = F.vcu; tc < M / CK; tc += F.G) {
        const int b = tc / NCHK, c = tc % NCHK, hh = F.wave, bh = b * RH + hh, chunk = bh * NCHK + c, t = c * CK + r, row = b * T + t;
        bf16x8 rf[4], zf[2][4]; u32x4 yv[2][2]; u32x2 vv[2][4], gr[2][4];
#pragma unroll
        for (int q = 0; q < 4; ++q) rf[q] = __builtin_nontemporal_load(RYT + (size_t)chunk * 4 * 64 + lane + q * 64);
#pragma unroll
        for (int vh = 0; vh < 2; ++vh)
#pragma unroll
            for (int q = 0; q < 4; ++q) { if (q < 2) yv[vh][q] = __builtin_nontemporal_load((const u32x4*)YVT + ((size_t)(chunk * 2 + vh) * 64 + lane) * 2 + q);
                zf[vh][q] = __builtin_nontemporal_load(Z0 + (size_t)(chunk * 2 + vh) * 4 * 64 + lane + q * 64); }
        const float bon = BON[row * 8 + hh];
#pragma unroll
        for (int vh = 0; vh < 2; ++vh)
#pragma unroll
            for (int g = 0; g < 4; ++g) { const int v0 = 32 * vh + 8 * g + 4 * h, c0 = hh * 64 + v0;
                vv[vh][g] = __builtin_nontemporal_load((const u32x2*)((const bf16*)SV + ((size_t)bh * T + t) * 64 + v0));
                gr[vh][g] = __builtin_nontemporal_load((const u32x2*)(G + (size_t)row * 512 + c0)); }
        f32x16 y[2];
#pragma unroll
        for (int vh = 0; vh < 2; ++vh) {
#pragma unroll
            for (int q = 0; q < 2; ++q) { const u32x4 u = yv[vh][q]; y[vh][8 * q] = bflo(u.x); y[vh][8 * q + 1] = bfhi(u.x); y[vh][8 * q + 2] = bflo(u.y); y[vh][8 * q + 3] = bfhi(u.y);
                y[vh][8 * q + 4] = bflo(u.z); y[vh][8 * q + 5] = bfhi(u.z); y[vh][8 * q + 6] = bflo(u.w); y[vh][8 * q + 7] = bfhi(u.w); }
#pragma unroll
            for (int q = 0; q < 4; ++q) y[vh] = MFMA32(zf[vh][q], rf[q], y[vh]); }
        float sm = 0.f;
#pragma unroll
        for (int vh = 0; vh < 2; ++vh)
#pragma unroll
            for (int i = 0; i < 16; ++i) sm += y[vh][i];
        sm += __shfl_xor(sm, 32);
        const float mean = sm * (1.f / 64.f); float qv = 0.f;
#pragma unroll
        for (int vh = 0; vh < 2; ++vh)
#pragma unroll
            for (int i = 0; i < 16; ++i) { y[vh][i] -= mean; qv += y[vh][i] * y[vh][i]; }
        qv += __shfl_xor(qv, 32);
        const float rstd = rsqrtf(qv * (1.f / 64.f) + GN_EPS);
#pragma unroll
        for (int vh = 0; vh < 2; ++vh)
#pragma unroll
            for (int g = 0; g < 4; ++g) { const int v0 = 32 * vh + 8 * g + 4 * h, c0 = hh * 64 + v0;
                const f32x4 lg4 = *(const f32x4*)(lg + c0), lb4 = *(const f32x4*)(lb + c0);
                const float gg[4] = {bflo(gr[vh][g].x), bfhi(gr[vh][g].x), bflo(gr[vh][g].y), bfhi(gr[vh][g].y)}; float o[4];
                const float vf[4] = {bflo(vv[vh][g].x), bfhi(vv[vh][g].x), bflo(vv[vh][g].y), bfhi(vv[vh][g].y)};
#pragma unroll
                for (int q = 0; q < 4; ++q) o[q] = (y[vh][4 * g + q] * rstd * lg4[q] + lb4[q] + bon * vf[q]) * gg[q];
                u32x2 w; w.x = pk2(o[0], o[1]); w.y = pk2(o[2], o[3]);
                *(u32x2*)(CAT + (size_t)row * D + c0) = w; }
    }
}

constexpr int SC_STEPS = 16, SC_NSLOT = 6, SC_SHARED = SC_STEPS * 1280, SC_SLOT = SC_SHARED + SC_STEPS * 64, SC_RING = SC_NSLOT * SC_SLOT;
constexpr int SC_FLAGS = SC_RING, SC_CONV = SC_RING + 256, SC_NCH = T / SC_STEPS;
static_assert(SC_CONV + 3 * 8704 <= LDS_BYTES, "scan LDS map");
__device__ __forceinline__ void phase4_scan(const Frame& F) {
    volatile LAS unsigned* READY = (volatile LAS unsigned*)(F.lds + SC_FLAGS);
    volatile LAS unsigned* DONE = (volatile LAS unsigned*)(F.lds + SC_FLAGS + 64);
    __syncthreads();
    if (F.tid < 64) ((LAS unsigned*)(F.lds + SC_FLAGS))[F.tid] = 0u;
    __syncthreads();
    const int bh = F.vcu >> 2, rg = F.vcu & 3, b = bh / RH, hh = bh % RH;
    if (F.wave < 4) {
        const int rl = F.lane >> 4, ks = F.lane & 15, rowl = F.wave * 4 + rl;
        float* yp = wsp<float>(F, WS_Y) + (size_t)b * T * 512 + hh * 64 + rg * 16 + rowl;
        f32x4 S = (f32x4){0.f, 0.f, 0.f, 0.f};
        int slot = 0;
        for (int c = 0; c < SC_NCH; ++c) {
#if MK_RWKV_MODE == 1
            if ((c & 1) == 0) {
                const int v = rg * 16 + rowl, chunk = bh * NCHK + (c >> 1);
                const bf16* zp = wsp<bf16>(F, WS_Z0) + ((((size_t)chunk * 2 + (v >> 5)) * 2 + (ks >> 3)) * 2 + ((ks >> 2) & 1)) * 512 + ((v & 31) + 32 * (ks & 1)) * 8 + 4 * ((ks >> 1) & 1);
                const u32x2 zz = *(const u32x2*)zp;
                S = (f32x4){bflo(zz.x), bfhi(zz.x), bflo(zz.y), bfhi(zz.y)}; }
#endif
            { int sp = 0; while (READY[slot] < (unsigned)(c + 1)) { if (++sp > SC_SPIN_CAP) break; } }
            __builtin_amdgcn_fence(__ATOMIC_ACQUIRE, "workgroup");
            const LAS unsigned char* sb = F.lds + slot * SC_SLOT;
            const LAS unsigned char* op = sb + ks * 16; const LAS float* vp = (const LAS float*)(sb + SC_SHARED) + rowl;
            f32x4 w4 = *(const LAS f32x4*)(op), kk4 = *(const LAS f32x4*)(op + 256), b4 = *(const LAS f32x4*)(op + 512), k4 = *(const LAS f32x4*)(op + 768), r4 = *(const LAS f32x4*)(op + 1024);
            float v = vp[0];
            float ykeep = 0.f;
#pragma unroll
            for (int s = 0; s < SC_STEPS; ++s) {
                const f32x4 cw = w4, ckk = kk4, cb = b4, ck = k4, cr = r4; const float cv = v;
                if (s + 1 < SC_STEPS) { const LAS unsigned char* o2 = op + (s + 1) * 1280;
                    w4 = *(const LAS f32x4*)(o2); kk4 = *(const LAS f32x4*)(o2 + 256); b4 = *(const LAS f32x4*)(o2 + 512); k4 = *(const LAS f32x4*)(o2 + 768); r4 = *(const LAS f32x4*)(o2 + 1024);
                    v = vp[(s + 1) * 16]; }
                if (s == SC_STEPS - 1) { asm volatile("s_waitcnt lgkmcnt(0)" ::: "memory"); if (F.lane == 0) DONE[F.wave] = (unsigned)(c + 1); }
                float p = (S[0] * ckk[0] + S[1] * ckk[1]) + (S[2] * ckk[2] + S[3] * ckk[3]);
                p = reduce16(p);
                const f32x4 tt = S * cw + ck * cv;
                S = tt - cb * p;
                float q = (S[0] * cr[0] + S[1] * cr[1]) + (S[2] * cr[2] + S[3] * cr[3]);
                q = reduce16(q);
                ykeep = (ks == s) ? q : ykeep;
            }
            yp[(size_t)(c * SC_STEPS + ks) * 512] = ykeep;
            slot = (slot + 1 == SC_NSLOT) ? 0 : slot + 1;
        }
    } else if (F.wave == 4) {
        const unsigned char* gs = (const unsigned char*)(wsp<float>(F, WS_SCN) + (size_t)bh * T * 320) + F.lane * 16;
        const unsigned char* gv = (const unsigned char*)(wsp<float>(F, WS_SV) + (size_t)bh * T * 64 + (F.lane >> 2) * 64 + rg * 16 + (F.lane & 3) * 4);
        int slot = 0;
        for (int c = 0; c < SC_NCH; ++c) {
            if (c >= SC_NSLOT) { const unsigned need = (unsigned)(c - SC_NSLOT + 1); int sp = 0;
                while (DONE[0] < need || DONE[1] < need || DONE[2] < need || DONE[3] < need) { __builtin_amdgcn_s_sleep(1); if (++sp > SC_SPIN_CAP) break; }
                __builtin_amdgcn_fence(__ATOMIC_ACQUIRE, "workgroup"); }
            LAS unsigned char* dst = F.lds + slot * SC_SLOT;
            const unsigned char* src = gs + (size_t)c * SC_SHARED;
#pragma unroll
            for (int j = 0; j < SC_SHARED / 1024; ++j) __builtin_amdgcn_global_load_lds((const unsigned*)(src + j * 1024), (LAS unsigned*)(dst + j * 1024), 16, 0, 0);
            __builtin_amdgcn_global_load_lds((const unsigned*)(gv + (size_t)c * SC_STEPS * 256), (LAS unsigned*)(dst + SC_SHARED), 16, 0, 0);
            if (c >= 2) { asm volatile("s_waitcnt vmcnt(42)" ::: "memory"); const int ps = (slot >= 2) ? slot - 2 : slot + SC_NSLOT - 2; if (F.lane == 0) READY[ps] = (unsigned)(c - 1); }
            slot = (slot + 1 == SC_NSLOT) ? 0 : slot + 1;
        }
        { asm volatile("s_waitcnt vmcnt(21)" ::: "memory"); const int ps = (slot >= 2) ? slot - 2 : slot + SC_NSLOT - 2; if (F.lane == 0) READY[ps] = (unsigned)(SC_NCH - 1); }
        { asm volatile("s_waitcnt vmcnt(0)" ::: "memory"); const int ps = (slot >= 1) ? slot - 1 : SC_NSLOT - 1; if (F.lane == 0) READY[ps] = (unsigned)(SC_NCH); }
    } else {
#if MK_CONV_IN_SCAN
        for (int it = F.vcu * 3 + (F.wave - 5); it < MOE_ITEMS; it += F.G * 3) moe_weight_item(F, it);
#endif
    }
    __syncthreads();
}

constexpr int KLD = 72;
constexpr int VLD = 260;
__device__ __forceinline__ void phase5_attn_part(const Frame& F, int first, int stride) {
    const bf16* P = wsp<bf16>(F, WS_P);
    bf16* CAT = wsp<bf16>(F, WS_CAT);
    const float* qg = F.in[17]; const float* kg = F.in[18]; const float* sinks = F.in[19];
    LAS bf16* Kl = (LAS bf16*)F.lds;
    LAS bf16* Vt = (LAS bf16*)(F.lds + 256 * KLD * 2);
    const int lane = F.lane, r = lane & 31, h = lane >> 5;
    for (int unit = first; unit < NBATCH * KVH * (T / 128); unit += stride) {
        const int blk = unit % (T / 128), kvh = (unit / (T / 128)) % KVH, b = unit / (T / 128 * KVH);
        const int kpos0 = blk * 128 - 128;
        __syncthreads();
        u32x4 kr4[4], vr4[4];
#pragma unroll
        for (int it = 0; it < 4; ++it) { const int ch = F.tid + 512 * it, key = ch >> 3, dc = ch & 7, kpos = kpos0 + key;
            const size_t ro = (size_t)(32 + kvh) * PL_SZ + (size_t)(b * T + (kpos >= 0 ? kpos : 0)) * 64 + dc * 8;
            kr4[it] = *(const u32x4*)(P + ro); vr4[it] = *(const u32x4*)(P + ro + 2 * PL_SZ); }
#pragma unroll
        for (int it = 0; it < 4; ++it) { const int ch = F.tid + 512 * it, key = ch >> 3, dc = ch & 7, kpos = kpos0 + key;
            u32x4 kraw = kr4[it], vraw = vr4[it];
            if (kpos < 0) { kraw = (u32x4){0u, 0u, 0u, 0u}; vraw = (u32x4){0u, 0u, 0u, 0u}; }
            float kf[8]; kf[0] = bflo(kraw.x); kf[1] = bfhi(kraw.x); kf[2] = bflo(kraw.y); kf[3] = bfhi(kraw.y); kf[4] = bflo(kraw.z); kf[5] = bfhi(kraw.z); kf[6] = bflo(kraw.w); kf[7] = bfhi(kraw.w);
            float ss = 0.f;
#pragma unroll
            for (int j = 0; j < 8; ++j) ss += kf[j] * kf[j];
            ss += __shfl_xor(ss, 1); ss += __shfl_xor(ss, 2); ss += __shfl_xor(ss, 4);
            const float rstd = rsqrtf(ss * (1.f / 64.f) + NORM_EPS);
            const f32x4 g0 = *(const f32x4*)(kg + dc * 8), g1 = *(const f32x4*)(kg + dc * 8 + 4);
            u32x4 ko; ko.x = pk2(kf[0] * rstd * g0[0], kf[1] * rstd * g0[1]); ko.y = pk2(kf[2] * rstd * g0[2], kf[3] * rstd * g0[3]);
            ko.z = pk2(kf[4] * rstd * g1[0], kf[5] * rstd * g1[1]); ko.w = pk2(kf[6] * rstd * g1[2], kf[7] * rstd * g1[3]);
            *(LAS u32x4*)(Kl + key * KLD + dc * 8) = ko;
            const unsigned vv[4] = {vraw.x, vraw.y, vraw.z, vraw.w};
#pragma unroll
            for (int j = 0; j < 4; ++j) { Vt[(dc * 8 + 2 * j) * VLD + key] = (bf16)(vv[j] & 0xffffu); Vt[(dc * 8 + 2 * j + 1) * VLD + key] = (bf16)(vv[j] >> 16); }
        }
        __syncthreads();
        for (int task = F.wave; task < 16; task += 8) {
            const int g = task & 3, qs = task >> 2, head = kvh * 4 + g;
            const int qrow = b * T + blk * 128 + qs * 32 + r;
            float qf[4][8]; float ss = 0.f;
#pragma unroll
            for (int s = 0; s < 4; ++s) { const u32x4 qr = *(const u32x4*)(P + (size_t)(24 + head) * PL_SZ + (size_t)qrow * 64 + 16 * s + 8 * h);
                qf[s][0] = bflo(qr.x); qf[s][1] = bfhi(qr.x); qf[s][2] = bflo(qr.y); qf[s][3] = bfhi(qr.y); qf[s][4] = bflo(qr.z); qf[s][5] = bfhi(qr.z); qf[s][6] = bflo(qr.w); qf[s][7] = bfhi(qr.w);
#pragma unroll
                for (int j = 0; j < 8; ++j) ss += qf[s][j] * qf[s][j]; }
            ss += __shfl_xor(ss, 32);
            const float qscale = rsqrtf(ss * (1.f / 64.f) + NORM_EPS) * 0.125f;
            bf16x8 qb[4];
#pragma unroll
            for (int s = 0; s < 4; ++s) { u32x4 w;
                const f32x4 g0 = *(const f32x4*)(qg + 16 * s + 8 * h), g1 = *(const f32x4*)(qg + 16 * s + 8 * h + 4);
                w.x = pk2(qf[s][0] * qscale * g0[0], qf[s][1] * qscale * g0[1]); w.y = pk2(qf[s][2] * qscale * g0[2], qf[s][3] * qscale * g0[3]);
                w.z = pk2(qf[s][4] * qscale * g1[0], qf[s][5] * qscale * g1[1]); w.w = pk2(qf[s][6] * qscale * g1[2], qf[s][7] * qscale * g1[3]);
                qb[s] = __builtin_bit_cast(bf16x8, w); }
            f32x16 st[5];
#pragma unroll
            for (int kt = 0; kt < 5; ++kt) {
#pragma unroll
                for (int i = 0; i < 16; ++i) st[kt][i] = 0.f;
#pragma unroll
                for (int s = 0; s < 4; ++s) { const bf16x8 ka = *(const LAS bf16x8*)(Kl + (32 * (qs + kt) + r) * KLD + 16 * s + 8 * h);
                    st[kt] = __builtin_amdgcn_mfma_f32_32x32x16_bf16(ka, qb[s], st[kt], 0, 0, 0); }
            }
            const int iq = 32 * qs + r;
            const float sink = sinks[head];
            float mx = sink;
#pragma unroll
            for (int kt = 0; kt < 5; ++kt)
#pragma unroll
                for (int i = 0; i < 16; ++i) { const int jw = 32 * (qs + kt) + (i & 3) + 8 * (i >> 2) + 4 * h;
                    const bool ok = (jw >= iq + 1) && (jw <= iq + 128) && (kpos0 + jw >= 0);
                    st[kt][i] = ok ? st[kt][i] : -INFINITY; mx = fmaxf(mx, st[kt][i]); }
            mx = fmaxf(mx, __shfl_xor(mx, 32));
            float lsum = 0.f;
#pragma unroll
            for (int kt = 0; kt < 5; ++kt)
#pragma unroll
                for (int i = 0; i < 16; ++i) { const float p = __expf(st[kt][i] - mx); st[kt][i] = p; lsum += p; }
            lsum += __shfl_xor(lsum, 32);
            const float linv = __builtin_amdgcn_rcpf(lsum + __expf(sink - mx));
            f32x16 o[2];
#pragma unroll
            for (int dt = 0; dt < 2; ++dt)
#pragma unroll
                for (int i = 0; i < 16; ++i) o[dt][i] = 0.f;
#pragma unroll
            for (int kt = 0; kt < 5; ++kt)
#pragma unroll
                for (int sp = 0; sp < 2; ++sp) { u32x4 pw;
                    pw.x = pk2(st[kt][8 * sp + 0] * linv, st[kt][8 * sp + 1] * linv); pw.y = pk2(st[kt][8 * sp + 2] * linv, st[kt][8 * sp + 3] * linv);
                    pw.z = pk2(st[kt][8 * sp + 4] * linv, st[kt][8 * sp + 5] * linv); pw.w = pk2(st[kt][8 * sp + 6] * linv, st[kt][8 * sp + 7] * linv);
                    const bf16x8 pa = __builtin_bit_cast(bf16x8, pw);
                    const int kb = 32 * (qs + kt) + 16 * sp + 4 * h;
#pragma unroll
                    for (int dt = 0; dt < 2; ++dt) { const LAS bf16* vp = Vt + (32 * dt + r) * VLD + kb;
                        const u32x2 lo = *(const LAS u32x2*)vp, hi = *(const LAS u32x2*)(vp + 8);
                        u32x4 vw; vw.x = lo.x; vw.y = lo.y; vw.z = hi.x; vw.w = hi.y;
                        o[dt] = __builtin_amdgcn_mfma_f32_32x32x16_bf16(pa, __builtin_bit_cast(bf16x8, vw), o[dt], 0, 0, 0); } }
            { LAS bf16* ot = (LAS bf16*)(F.lds + 256 * KLD * 2 + 64 * VLD * 2) + F.wave * (32 * 72);
#pragma unroll
                for (int dt = 0; dt < 2; ++dt)
#pragma unroll
                    for (int i = 0; i < 16; ++i) { const int qr = (i & 3) + 8 * (i >> 2) + 4 * h; ot[qr * 72 + 32 * dt + r] = (bf16)f2bf(o[dt][i]); }
                asm volatile("s_waitcnt lgkmcnt(0)" ::: "memory");
#pragma unroll
                for (int j = 0; j < 4; ++j) { const int id = lane + 64 * j, qr = id >> 3, pc = id & 7;
                    const u32x4 w = *(const LAS u32x4*)(ot + qr * 72 + pc * 8);
                    *(u32x4*)(CAT + (size_t)(b * T + blk * 128 + qs * 32 + qr) * D + 512 + head * 64 + pc * 8) = w; }
                asm volatile("s_waitcnt lgkmcnt(0)" ::: "memory"); }
        }
    }
}

__device__ __forceinline__ void phase5_attn(const Frame& F) { phase5_attn_part(F, F.vcu, F.G); }
__device__ __forceinline__ void phase6(const Frame& F) {
    const int gw = F.vcu * 8 + F.wave, NGW = F.G * 8;
    const float* Y = wsp<float>(F, WS_Y); const float* SV = wsp<float>(F, WS_SV); const bf16* G = wsp<bf16>(F, WS_G); const float* BON = wsp<float>(F, WS_BONUS);
    bf16* CAT = wsp<bf16>(F, WS_CAT);
    const float* lg = F.in[15]; const float* lb = F.in[16];
    const int hh = F.lane >> 3, n0 = (F.lane & 7) * 8, c0 = F.lane * 8;
    for (int row = gw; row < M; row += NGW) { const int b = row / T, t = row % T;
        const f32x4 y0 = *(const f32x4*)(Y + (size_t)row * 512 + c0), y1 = *(const f32x4*)(Y + (size_t)row * 512 + c0 + 4);
        float yv[8] = {y0[0], y0[1], y0[2], y0[3], y1[0], y1[1], y1[2], y1[3]};
        float s = 0.f;
#pragma unroll
        for (int j = 0; j < 8; ++j) s += yv[j];
        s += __shfl_xor(s, 1); s += __shfl_xor(s, 2); s += __shfl_xor(s, 4);
        const float mean = s * (1.f / 64.f); float q = 0.f;
#pragma unroll
        for (int j = 0; j < 8; ++j) { yv[j] -= mean; q += yv[j] * yv[j]; }
        q += __shfl_xor(q, 1); q += __shfl_xor(q, 2); q += __shfl_xor(q, 4);
        const float rstd = rsqrtf(q * (1.f / 64.f) + GN_EPS);
        const float bon = BON[row * 8 + hh];
        const float* vp = SV + ((size_t)(b * RH + hh) * T + t) * 64 + n0;
        const f32x4 v0 = *(const f32x4*)vp, v1 = *(const f32x4*)(vp + 4);
        const float vv[8] = {v0[0], v0[1], v0[2], v0[3], v1[0], v1[1], v1[2], v1[3]};
        const u32x4 graw = *(const u32x4*)(G + (size_t)row * 512 + c0);
        const float gg[8] = {bflo(graw.x), bfhi(graw.x), bflo(graw.y), bfhi(graw.y), bflo(graw.z), bfhi(graw.z), bflo(graw.w), bfhi(graw.w)};
        float ov[8];
#pragma unroll
        for (int j = 0; j < 8; ++j) ov[j] = (yv[j] * rstd * lg[c0 + j] + lb[c0 + j] + bon * vv[j]) * gg[j];
        u32x4 w; w.x = pk2(ov[0], ov[1]); w.y = pk2(ov[2], ov[3]); w.z = pk2(ov[4], ov[5]); w.w = pk2(ov[6], ov[7]);
        *(u32x4*)(CAT + (size_t)row * D + c0) = w; }
}

__device__ __forceinline__ float reduce32x64(float (&v)[32], int lane) {
#pragma unroll
    for (int i = 0; i < 16; ++i) { const bool hi = lane & 16; const float send = hi ? v[i] : v[i + 16], keep = hi ? v[i + 16] : v[i]; v[i] = keep + __shfl_xor(send, 16); }
#pragma unroll
    for (int i = 0; i < 8; ++i) { const bool hi = lane & 8; const float send = hi ? v[i] : v[i + 8], keep = hi ? v[i + 8] : v[i]; v[i] = keep + __shfl_xor(send, 8); }
#pragma unroll
    for (int i = 0; i < 4; ++i) { const bool hi = lane & 4; const float send = hi ? v[i] : v[i + 4], keep = hi ? v[i + 4] : v[i]; v[i] = keep + __shfl_xor(send, 4); }
#pragma unroll
    for (int i = 0; i < 2; ++i) { const bool hi = lane & 2; const float send = hi ? v[i] : v[i + 2], keep = hi ? v[i + 2] : v[i]; v[i] = keep + __shfl_xor(send, 2); }
    { const bool hi = lane & 1; const float send = hi ? v[0] : v[1], keep = hi ? v[1] : v[0]; v[0] = keep + __shfl_xor(send, 1); }
    return v[0] + __shfl_xor(v[0], 32);
}
__device__ __forceinline__ void phase8(const Frame& F) {
    const float* mod = wsp<float>(F, WS_MOD); const bf16* x1 = wsp<bf16>(F, WS_X1B);
    const float* wr_ = F.in[22]; const float* br = F.in[23];
    LAS float* Wt = (LAS float*)F.lds;
    LAS float* lgw = (LAS float*)(F.lds + 131072 + F.wave * 512);
    LAS int* cnt = (LAS int*)(F.lds + 131072 + 4096);
    __syncthreads();
    for (int idx = F.tid; idx < 8192; idx += 512) { const int k = idx >> 3, e4 = idx & 7; const f32x4 w = *(const f32x4*)(wr_ + k * 32 + e4 * 4);
        Wt[(4 * e4 + 0) * 1024 + k] = w[0]; Wt[(4 * e4 + 1) * 1024 + k] = w[1]; Wt[(4 * e4 + 2) * 1024 + k] = w[2]; Wt[(4 * e4 + 3) * 1024 + k] = w[3]; }
    if (F.tid < 32) cnt[F.tid] = 0;
    __syncthreads();
    int* RT_E = wsp<int>(F, WS_RT_E); int* RT_LP = wsp<int>(F, WS_RT_LP); float* RT_G = wsp<float>(F, WS_RT_G);
    const int e = F.lane & 31;
    const float bre = br[e];
    f32x4 shq[4], scq[4];
    { const int b = (F.vcu * 128) / T;
#pragma unroll
        for (int j = 0; j < 4; ++j) { const int col = 4 * F.lane + 256 * j; shq[j] = *(const f32x4*)(mod + b * 6144 + 3072 + col); scq[j] = (*(const f32x4*)(mod + b * 6144 + 4096 + col) + 1.f) * *(const f32x4*)(F.in[21] + col); } }
#if MK_CONV_WHERE == 8
    const int p_lo = F.wave < 4 ? 11 * F.wave : 44 + 10 * (F.wave - 4), p_n = F.wave < 4 ? 11 : 10;
    if (F.wave >= 6) { for (int it = CONV_4B + F.vcu * 2 + (F.wave - 6); it < MOE_ITEMS; it += F.G * 2) moe_weight_item(F, it); }
    else {
#else
    const int p_lo = 8 * F.wave, p_n = 8;
    {
#endif
    u32x2 xn[2][4];
#pragma unroll
    for (int q = 0; q < 2; ++q)
#pragma unroll
        for (int j = 0; j < 4; ++j) xn[q][j] = ((const u32x2*)(x1 + (size_t)(F.vcu * 128 + 2 * p_lo + q) * D))[F.lane + 64 * j];
    for (int pr = 0; pr < p_n; ++pr) { const int row0 = F.vcu * 128 + 2 * (p_lo + pr);
        f32x4 h0[4], h1[4];
        float ss0 = 0.f, ss1 = 0.f;
#pragma unroll
        for (int j = 0; j < 4; ++j) { h0[j] = (f32x4){bflo(xn[0][j].x), bfhi(xn[0][j].x), bflo(xn[0][j].y), bfhi(xn[0][j].y)}; h1[j] = (f32x4){bflo(xn[1][j].x), bfhi(xn[1][j].x), bflo(xn[1][j].y), bfhi(xn[1][j].y)};
            ss0 += (h0[j][0] * h0[j][0] + h0[j][1] * h0[j][1]) + (h0[j][2] * h0[j][2] + h0[j][3] * h0[j][3]); ss1 += (h1[j][0] * h1[j][0] + h1[j][1] * h1[j][1]) + (h1[j][2] * h1[j][2] + h1[j][3] * h1[j][3]); }
        { const int nr = row0 + (pr + 1 < p_n ? 2 : 0);
#pragma unroll
            for (int q = 0; q < 2; ++q)
#pragma unroll
                for (int j = 0; j < 4; ++j) xn[q][j] = ((const u32x2*)(x1 + (size_t)(nr + q) * D))[F.lane + 64 * j]; }
#pragma unroll
        for (int o = 1; o < 64; o <<= 1) { ss0 += __shfl_xor(ss0, o); ss1 += __shfl_xor(ss1, o); }
        const float rs0 = rsqrtf(ss0 * (1.f / D) + NORM_EPS), rs1 = rsqrtf(ss1 * (1.f / D) + NORM_EPS);
        unsigned char* o0 = wsp<unsigned char>(F, WS_H8) + (size_t)row0 * D * (MK_FP8 ? 1 : 2); unsigned char* o1 = o0 + (size_t)D * (MK_FP8 ? 1 : 2);
#pragma unroll
        for (int j = 0; j < 4; ++j) { h0[j] = h0[j] * rs0 * scq[j] + shq[j]; h1[j] = h1[j] * rs1 * scq[j] + shq[j];
#if MK_FP8
            ((unsigned*)o0)[F.lane + 64 * j] = pg8::pk4_fp8(h0[j][0], h0[j][1], h0[j][2], h0[j][3]); ((unsigned*)o1)[F.lane + 64 * j] = pg8::pk4_fp8(h1[j][0], h1[j][1], h1[j][2], h1[j][3]);
#else
            { u32x2 w; w.x = pk2(h0[j][0], h0[j][1]); w.y = pk2(h0[j][2], h0[j][3]); ((u32x2*)o0)[F.lane + 64 * j] = w; w.x = pk2(h1[j][0], h1[j][1]); w.y = pk2(h1[j][2], h1[j][3]); ((u32x2*)o1)[F.lane + 64 * j] = w; }
#endif
        }
        float pa0[32], pa1[32];
#pragma unroll
        for (int q = 0; q < 32; ++q) { float s0 = 0.f, s1 = 0.f;
#pragma unroll
            for (int j = 0; j < 4; ++j) { const f32x4 w4 = *(const LAS f32x4*)(Wt + q * 1024 + 4 * F.lane + 256 * j);
                s0 = fmaf(h0[j][0], w4[0], s0); s0 = fmaf(h0[j][1], w4[1], s0); s0 = fmaf(h0[j][2], w4[2], s0); s0 = fmaf(h0[j][3], w4[3], s0);
                s1 = fmaf(h1[j][0], w4[0], s1); s1 = fmaf(h1[j][1], w4[1], s1); s1 = fmaf(h1[j][2], w4[2], s1); s1 = fmaf(h1[j][3], w4[3], s1); }
            pa0[q] = s0; pa1[q] = s1; }
        const float lg0 = reduce32x64(pa0, F.lane) + bre, lg1 = reduce32x64(pa1, F.lane) + bre;
#pragma unroll
        for (int q = 0; q < 2; ++q) { const float logit = q ? lg1 : lg0; const int row = row0 + q; LAS float* lg32 = lgw + q * 64;
            if (F.lane < 32) lg32[e] = logit;
            asm volatile("s_waitcnt lgkmcnt(0)" ::: "memory");
            int rank = 0;
#pragma unroll 8
            for (int o = 0; o < 32; ++o) { const float ov = lg32[o]; rank += (ov > logit || (ov == logit && o < e)) ? 1 : 0; }
            if (F.lane < 32 && rank < 4) lg32[32 + rank] = logit;
            asm volatile("s_waitcnt lgkmcnt(0)" ::: "memory");
            const float t0 = lg32[32], t1 = lg32[33], t2 = lg32[34], t3 = lg32[35];
            const float den = 1.f + __expf(t1 - t0) + __expf(t2 - t0) + __expf(t3 - t0);
            if (F.lane < 32 && rank < 4) { const int lp = atomicAdd((int*)&cnt[e], 1);
                RT_E[row * 4 + rank] = e; RT_LP[row * 4 + rank] = lp; RT_G[row * 4 + rank] = __expf(logit - t0) / den; }
            asm volatile("s_waitcnt lgkmcnt(0)" ::: "memory"); }
    }
    }
    __syncthreads();
    if (F.tid < 32) wsp<int>(F, WS_BLKCNT)[F.vcu * 32 + F.tid] = cnt[F.tid];
}

__device__ __forceinline__ void phase9(const Frame& F) {
    LAS int* base = (LAS int*)F.lds;
    LAS int* tot = base + 32;
    LAS int* pst = base + 64;
    const int* BC = wsp<int>(F, WS_BLKCNT);
    { LAS int* ps = base + 128; LAS int* pm = ps + 512;
        const int e = F.tid & 31, seg = F.tid >> 5; int s = 0, mine = 0;
#pragma unroll
        for (int j = 0; j < 16; ++j) { const int bk = seg * 16 + j, v = BC[bk * 32 + e]; s += v; mine += (bk < F.vcu) ? v : 0; }
        ps[seg * 32 + e] = s; pm[seg * 32 + e] = mine; }
    __syncthreads();
    if (F.tid < 32) { int s = 0, mine = 0;
#pragma unroll
        for (int q = 0; q < 16; ++q) { s += base[128 + q * 32 + F.tid]; mine += base[128 + 512 + q * 32 + F.tid]; }
        base[F.tid] = mine; tot[F.tid] = s; }
    __syncthreads();
    if (F.tid == 0) { int s = 0; for (int e = 0; e < 32; ++e) { pst[e] = s; s += (tot[e] + 255) / 256 * 256; } pst[32] = s; }
    __syncthreads();
    int* SLOT_TOK = wsp<int>(F, WS_SLOTTOK); float* SLOT_GATE = wsp<float>(F, WS_SLOTGATE); int* TOK_SLOT = wsp<int>(F, WS_TOKSLOT);
    const int* RT_E = wsp<int>(F, WS_RT_E); const int* RT_LP = wsp<int>(F, WS_RT_LP); const float* RT_G = wsp<float>(F, WS_RT_G);
    { const int idx = F.vcu * 512 + F.tid;
        const int e = RT_E[idx], slot = pst[e] + base[e] + RT_LP[idx];
        SLOT_TOK[slot] = idx >> 2; SLOT_GATE[slot] = RT_G[idx]; TOK_SLOT[idx] = slot; }
    if (F.vcu < 32) { const int e = F.vcu; for (int s = pst[e] + tot[e] + F.tid; s < pst[e + 1]; s += 512) { SLOT_TOK[s] = 0; SLOT_GATE[s] = 0.f; } }
    if (F.vcu == 0) { unsigned* ctl = wsp<unsigned>(F, WS_CTL);
        if (F.tid == 0) ctl[CW_NTILES] = (unsigned)(pst[32] / 256);
        if (F.tid < 33) ctl[CW_PADSTART + F.tid] = (unsigned)pst[F.tid];
        int* TE = wsp<int>(F, WS_TILEE);
        for (int tl = F.tid; tl < MAX_TILES; tl += 512) { int e = 31; for (int q = 0; q < 32; ++q) if (tl * 256 < pst[q + 1]) { e = q; break; } TE[tl] = e; } }
#if MK_CONV_WHERE == 9
    for (int it = CONV_4B + F.vcu * 8 + F.wave; it < MOE_ITEMS; it += F.G * 8) moe_weight_item(F, it);
#endif
}

__device__ __forceinline__ void phase12(const Frame& F) {
    const int gw = F.vcu * 8 + F.wave, NGW = F.G * 8;
    const float* mod = wsp<float>(F, WS_MOD); const bf16* YS = wsp<bf16>(F, WS_YS); const int* TOK_SLOT = wsp<int>(F, WS_TOKSLOT); const bf16* X1B = wsp<bf16>(F, WS_X1B);
    for (int row = gw; row < M; row += 2 * NGW) {
        int sl[2][4]; u32x4 v[2][2][4], xb[2][2];
#pragma unroll
        for (int rr = 0; rr < 2; ++rr)
#pragma unroll
            for (int k = 0; k < 4; ++k) sl[rr][k] = TOK_SLOT[(row + rr * NGW) * 4 + k];
#pragma unroll
        for (int rr = 0; rr < 2; ++rr)
#pragma unroll
            for (int j = 0; j < 2; ++j) { const int col = 8 * F.lane + 512 * j;
#pragma unroll
                for (int k = 0; k < 4; ++k) v[rr][j][k] = __builtin_nontemporal_load((const u32x4*)(YS + (size_t)sl[rr][k] * D + col));
                xb[rr][j] = __builtin_nontemporal_load((const u32x4*)(X1B + (size_t)(row + rr * NGW) * D + col)); }
#pragma unroll
        for (int rr = 0; rr < 2; ++rr) { const int rw = row + rr * NGW, b = rw / T;
#pragma unroll
            for (int j = 0; j < 2; ++j) { const int col = 8 * F.lane + 512 * j;
                float a[8];
#pragma unroll
                for (int q = 0; q < 8; ++q) a[q] = 0.f;
#pragma unroll
                for (int k = 0; k < 4; ++k) { const u32x4 w = v[rr][j][k];
                    a[0] += bflo(w.x); a[1] += bfhi(w.x); a[2] += bflo(w.y); a[3] += bfhi(w.y); a[4] += bflo(w.z); a[5] += bfhi(w.z); a[6] += bflo(w.w); a[7] += bfhi(w.w); }
                const float* gp = mod + b * 6144 + 5120 + col;
                const f32x4 g0 = *(const f32x4*)gp, g1 = *(const f32x4*)(gp + 4);
                float* op = F.out + (size_t)rw * D + col;
                const u32x4 x = xb[rr][j];
                f32x4 x0 = (f32x4){bflo(x.x), bfhi(x.x), bflo(x.y), bfhi(x.y)}, x1v = (f32x4){bflo(x.z), bfhi(x.z), bflo(x.w), bfhi(x.w)};
                x0[0] += g0[0] * a[0]; x0[1] += g0[1] * a[1]; x0[2] += g0[2] * a[2]; x0[3] += g0[3] * a[3];
                x1v[0] += g1[0] * a[4]; x1v[1] += g1[1] * a[5]; x1v[2] += g1[2] * a[6]; x1v[3] += g1[3] * a[7];
                *(f32x4*)op = x0; *(f32x4*)(op + 4) = x1v; } }
    }
}

__device__ __forceinline__ void copy_x_to_out(const Frame& F) {
    const size_t n4 = (size_t)M * D / 4; const f32x4* s = (const f32x4*)F.in[0]; f32x4* d = (f32x4*)F.out;
    for (size_t i = (size_t)blockIdx.x * 512 + F.tid; i < n4; i += (size_t)gridDim.x * 512) d[i] = s[i];
}


#define XB_TMO      128
#define XB_XCNT(j)  (256  + 64 * (j))
#define XB_XSUB(j)  (1280 + 64 * (j))
#define XB_XGEN(j)  (2304 + 64 * (j))
#define XB_TOP      3328
#define XB_TOPGEN   3392
#define XCD_BAR_WORDS 3456
#define XB_SPIN_CAP (1u << 18)
__device__ __forceinline__ unsigned xb_ld(unsigned* p)              { return __hip_atomic_load(p, __ATOMIC_RELAXED, __HIP_MEMORY_SCOPE_AGENT); }
__device__ __forceinline__ unsigned xb_add(unsigned* p, unsigned v) { return __hip_atomic_fetch_add(p, v, __ATOMIC_RELAXED, __HIP_MEMORY_SCOPE_AGENT); }
__device__ __forceinline__ unsigned xb_xcc_id() { return (unsigned)__builtin_amdgcn_s_getreg((3 << 11) | 20) & 0xFu; }
#define XB_SPIN(cond, bar) do { unsigned _sp = 0; while (cond) { __builtin_amdgcn_s_sleep(1); \
    if ((++_sp & 255u) == 0u) { if (xb_ld(&(bar)[XB_TMO])) break; if (_sp > XB_SPIN_CAP) { atomicAdd(&(bar)[XB_TMO], 1u); break; } } } } while (0)
struct XcdBarrier { unsigned* bar; unsigned x; volatile LAS unsigned* st; };
__device__ __forceinline__ XcdBarrier xcd_barrier_post(unsigned* bar, volatile LAS unsigned* st) {
    XcdBarrier b; b.bar = bar; b.x = xb_xcc_id(); b.st = st;
    if (threadIdx.x == 0) (void)xb_add(&bar[XB_XCNT(b.x)], 1u);
    return b;
}
__device__ __forceinline__ void xcd_barrier_complete(unsigned* bar, unsigned x, unsigned& nloc, unsigned& nx) {
    const unsigned G = gridDim.x * gridDim.y * gridDim.z;
    unsigned sum, cnt, mine, sp = 0u;
    for (;;) {
        sum = 0u; cnt = 0u; mine = 0u;
#pragma unroll
        for (unsigned j = 0; j < 16; ++j) { const unsigned c = xb_ld(&bar[XB_XCNT(j)]); sum += c; cnt += (c > 0u) ? 1u : 0u; mine = (j == x) ? c : mine; }
        if (sum == G) break;
        __builtin_amdgcn_s_sleep(1);
        if ((++sp & 255u) == 0u) { if (xb_ld(&bar[XB_TMO])) break; if (sp > XB_SPIN_CAP) { atomicAdd(&bar[XB_TMO], 1u); break; } }
    }
    nloc = mine > 0u ? mine : 1u; nx = cnt > 0u ? cnt : 1u;
}
__device__ __forceinline__ void xcd_barrier(const XcdBarrier& b) {
    asm volatile("s_waitcnt vmcnt(0)" ::: "memory");
    __syncthreads();
    if (threadIdx.x == 0) {
        unsigned* bar = b.bar;
        __builtin_amdgcn_s_waitcnt(0);
        unsigned nloc = b.st[0], nx = b.st[1];
        if (nloc == 0u) { xcd_barrier_complete(bar, b.x, nloc, nx); b.st[0] = nloc; b.st[1] = nx; }
        const unsigned old = xb_add(&bar[XB_XSUB(b.x)], 1u);
        const unsigned gen = old / nloc;
        if (old + 1u == (gen + 1u) * nloc) {
            __builtin_amdgcn_fence(__ATOMIC_RELEASE, "agent");
            asm volatile("s_waitcnt vmcnt(0)" ::: "memory");
            const unsigned og = xb_add(&bar[XB_TOP], 1u);
            const unsigned tg = og / nx;
            if (og + 1u == (tg + 1u) * nx) xb_add(&bar[XB_TOPGEN], 1u);
            else XB_SPIN(xb_ld(&bar[XB_TOPGEN]) == tg, bar);
            __builtin_amdgcn_fence(__ATOMIC_ACQUIRE, "agent");
            xb_add(&bar[XB_XGEN(b.x)], 1u);
            asm volatile("s_waitcnt vmcnt(0)" ::: "memory");
        } else {
            XB_SPIN(xb_ld(&bar[XB_XGEN(b.x)]) == gen, bar);
            __builtin_amdgcn_fence(__ATOMIC_ACQUIRE, "agent");
            asm volatile("s_waitcnt vmcnt(0)" ::: "memory");
        }
    }
    __syncthreads();
}

struct Args { const float* in[28]; float* out; unsigned char* ws; int ph_lo, ph_hi; };
constexpr int N_PHASES = 13;

__global__ void __launch_bounds__(512, 2) mk_fwd(Args args) {
    extern __shared__ __attribute__((aligned(16))) unsigned char lds_raw[];
    Frame F;
    F.lds = (LAS unsigned char*)lds_raw;
    F.tid = threadIdx.x; F.lane = F.tid & 63; F.wave = __builtin_amdgcn_readfirstlane(F.tid >> 6);
    F.G = gridDim.x; { const int bx = blockIdx.x; F.vcu = (F.G % 8 == 0) ? (bx % 8) * (F.G / 8) + bx / 8 : bx; }
    F.in = args.in;
    F.out = args.out; F.ws = args.ws;
    cg::grid_group grid = cg::this_grid();
    const int lo = args.ph_lo, hi = args.ph_hi;
    volatile LAS unsigned* MISC = (volatile LAS unsigned*)(F.lds + MISC_OFF);
    if (F.tid < 16) MISC[F.tid] = 0u;
    __syncthreads();
    XcdBarrier bar; bar.bar = wsp<unsigned>(F, WS_CTL) + CW_BAR; bar.x = 0; bar.st = MISC;
    if (hi - lo > 1) bar = xcd_barrier_post(wsp<unsigned>(F, WS_CTL) + CW_BAR, MISC);
#define IN(k) (lo <= (k) && (k) < hi)
#define REP(k) for (int rep_ = 0; rep_ < 1 + ((MK_REPEAT_MASK >> (k)) & 1); ++rep_)
#define SEAM(k) do { if (IN(k) && IN((k) + 1)) { if ((MK_CG_SEAMS >> (k)) & 1) grid.sync(); else xcd_barrier(bar); } } while (0)

    if (IN(0)) REP(0) { phase0(F); } SEAM(0);
    if (IN(1)) REP(1) { phase1(F); } SEAM(1);
    if (IN(2)) REP(2) {
#if MK_CONV_WHERE == 2
        if ((int)blockIdx.x >= 192) { for (int it = ((int)blockIdx.x - 192) * 8 + F.wave; it < MOE_ITEMS; it += 64 * 8) moe_weight_item(F, it); }
        else {
        pg8::Gemm g{wsp<bf16>(F, WS_H), wsp<bf16>(F, WS_WIN), D, IN_COLS, nullptr};
        pg8::StaticOrder S; S.init(M, IN_COLS, 192, (int)blockIdx.x);
        pg8::EpiBf16P E{wsp<bf16>(F, WS_P), IN_COLS};
        pg8::gemm_phase<pg8::EpiBf16P, pg8::StaticOrder, false>(F.lds, g, S, E);
        }
#else
        pg8::Gemm g{wsp<bf16>(F, WS_H), wsp<bf16>(F, WS_WIN), D, IN_COLS, nullptr};
        pg8::StaticOrder S; S.init(M, IN_COLS, F.G, (int)blockIdx.x);
        pg8::EpiBf16P E{wsp<bf16>(F, WS_P), IN_COLS};
        pg8::gemm_phase<pg8::EpiBf16P, pg8::StaticOrder, false>(F.lds, g, S, E);
#endif
    } SEAM(2);
#if MK_RWKV_MODE < 3
    if (IN(3)) REP(3) { phase3(F); } SEAM(3);
#endif
    if (IN(4)) REP(4) {
#if MK_RWKV_MODE >= 1
#if MK_RWKV_MODE == 4
#if MK_WMASK != 63
        phase4a_fused(F); xcd_barrier(bar);
#endif
        for (int q_ = 0; q_ < 1 + (MK_REP4 & 1); ++q_) { phase4a_wave(F); xcd_barrier(bar); }
#elif MK_RWKV_MODE == 3
        for (int q_ = 0; q_ < 1 + (MK_REP4 & 1); ++q_) { phase4a_fused(F); xcd_barrier(bar); }
#else
        for (int q_ = 0; q_ < 1 + (MK_REP4 & 1); ++q_) { phase4a_summaries(F); xcd_barrier(bar); }
#endif
        for (int q_ = 0; q_ < 1 + ((MK_REP4 >> 1) & 1); ++q_) { phase4b_states(F); xcd_barrier(bar); }
#endif
#if MK_RWKV_MODE >= 2
        for (int q_ = 0; q_ < 1 + ((MK_REP4 >> 2) & 1); ++q_) phase4c_output(F);
#else
        phase4_scan(F);
#endif
        } SEAM(4);
#if !MK_ATTN_IN_4B
    if (IN(5)) REP(5) { phase5_attn(F); } SEAM(5);
#endif
#if MK_RWKV_MODE < 2
    if (IN(6)) REP(6) { phase6(F); } SEAM(6);
#endif
    if (IN(7)) REP(7) {
#if MK_LAST_PHASE >= 7
        pg8::Gemm g{wsp<bf16>(F, WS_CAT), wsp<bf16>(F, WS_WOUT), D, D, nullptr};
        pg8::StaticOrder S; S.init(M, D, F.G, (int)blockIdx.x);
        pg8::EpiOutProj E{F.in[0], wsp<bf16>(F, WS_X1B), wsp<float>(F, WS_MOD) + 2048};
        pg8::gemm_phase<pg8::EpiOutProj, pg8::StaticOrder, false>(F.lds, g, S, E);
#else
        copy_x_to_out(F);
#endif
    } SEAM(7);
    if (IN(8)) REP(8) { phase8(F); } SEAM(8);
    if (IN(9)) REP(9) { phase9(F); } SEAM(9);
    if (IN(10)) REP(10) {
        const unsigned* ctl = wsp<unsigned>(F, WS_CTL);
        pg8::Gemm g{wsp<bf16>(F, WS_H8), wsp<bf16>(F, WS_W1), MK_FP8 ? D / 2 : D, 2 * DE, wsp<int>(F, WS_SLOTTOK)};
        pg8::MoeOrder S{(int)ctl[CW_NTILES], 8, F.G, F.vcu, wsp<int>(F, WS_TILEE)};
        pg8::EpiMoe1 E{wsp<unsigned char>(F, WS_ACT), F.in[25]};
        pg8::gemm_phase<pg8::EpiMoe1, pg8::MoeOrder, true, MK_FP8 != 0>(F.lds, g, S, E);
    } SEAM(10);
    if (IN(11)) REP(11) {
        const unsigned* ctl = wsp<unsigned>(F, WS_CTL);
        pg8::Gemm g{wsp<bf16>(F, WS_ACT), wsp<bf16>(F, WS_W2), MK_FP8 ? DE / 2 : DE, D, nullptr};
        pg8::MoeOrder S{(int)ctl[CW_NTILES], 4, F.G, F.vcu, wsp<int>(F, WS_TILEE)};
        pg8::EpiMoe2 E{wsp<bf16>(F, WS_YS), F.in[27], wsp<float>(F, WS_SLOTGATE)};
        pg8::gemm_phase<pg8::EpiMoe2, pg8::MoeOrder, false, MK_FP8 != 0>(F.lds, g, S, E);
    } SEAM(11);
    if (IN(12)) { phase12(F); }
#undef IN
#undef SEAM
}

extern "C" void kernel_launch(void* const* d_in, const int* in_sizes, int n_in, void* d_out, int out_size, void* d_ws, size_t ws_size, hipStream_t stream) {
    static int grid = 0;
    if (grid == 0) {
        if (n_in != 28 || out_size != M * D || ws_size < WS_END) { fprintf(stderr, "kernel_launch: unexpected sizes (n_in %d out %d ws %zu, need %zu)\n", n_in, out_size, ws_size, (size_t)WS_END); grid = -1; return; }
        int dev = 0, cus = 0, per_cu = 0;
        (void)hipGetDevice(&dev); (void)hipDeviceGetAttribute(&cus, hipDeviceAttributeMultiprocessorCount, dev);
        (void)hipFuncSetAttribute((const void*)mk_fwd, hipFuncAttributeMaxDynamicSharedMemorySize, LDS_BYTES);
        (void)hipOccupancyMaxActiveBlocksPerMultiprocessor(&per_cu, (const void*)mk_fwd, 512, LDS_BYTES);
        if (per_cu < 1 || cus != 256) { fprintf(stderr, "kernel_launch: occupancy %d, CUs %d: this build needs 256 CUs x 1 block\n", per_cu, cus); grid = -1; return; }
        grid = cus;
    }
    if (grid < 0) return;
    (void)hipMemsetAsync((char*)d_ws + WS_CTL, 0, CTL_BYTES, stream);
    Args a{};
    for (int i = 0; i < 28; ++i) a.in[i] = (const float*)d_in[i];
    a.out = (float*)d_out; a.ws = (unsigned char*)d_ws;
    const int last = MK_LAST_PHASE + 1;
#if MK_ONE_LAUNCH
    a.ph_lo = 0; a.ph_hi = last;
#if MK_COOP
    void* kargs[] = {&a};
    hipError_t e = hipLaunchCooperativeKernel((const void*)mk_fwd, dim3(grid), dim3(512), kargs, LDS_BYTES, stream);
    if (e != hipSuccess) fprintf(stderr, "cooperative launch failed: %s\n", hipGetErrorString(e));
#else
    hipLaunchKernelGGL(mk_fwd, dim3(grid), dim3(512), LDS_BYTES, stream, a);
#endif
#else
    for (int p = 0; p < last; ++p) { a.ph_lo = p; a.ph_hi = p + 1; hipLaunchKernelGGL(mk_fwd, dim3(grid), dim3(512), LDS_BYTES, stream, a); }
#endif
}
```

```cpp
#include <hip/hip_runtime.h>
#include <hip/hip_cooperative_groups.h>
#include <cstdio>
#include <cstdint>
namespace cg = cooperative_groups;

#ifndef MK_ONE_LAUNCH
#define MK_ONE_LAUNCH 1
#endif
#ifndef MK_REPEAT_MASK
#define MK_REPEAT_MASK 0
#endif
#ifndef MK_CONV_WHERE
#define MK_CONV_WHERE 8
#endif
#define MK_CONV_IN_SCAN (MK_CONV_WHERE == 4)
#ifndef MK_RWKV_MODE
#define MK_RWKV_MODE 3
#endif
#ifndef MK_FP8
#define MK_FP8 1
#endif
#ifndef MK_DUP
#define MK_DUP 0
#endif
#ifndef MK_WMASK
#define MK_WMASK 63
#endif
#ifndef MK_ATTN_IN_4B
#define MK_ATTN_IN_4B 1
#endif
#ifndef MK_ROT_M
#define MK_ROT_M 1
#endif
#ifndef MK_ROT_S
#define MK_ROT_S 0
#endif
#ifndef MK_NOLOAD_PROBE
#define MK_NOLOAD_PROBE 0
#endif
#ifndef MK_VM_RELAX
#define MK_VM_RELAX 1
#endif
#ifndef MK_REP4
#define MK_REP4 0
#endif
#ifndef MK_CG_SEAMS
#define MK_CG_SEAMS 0
#endif
#ifndef MK_COOP
#define MK_COOP 0
#endif
#ifndef MK_LAST_PHASE
#define MK_LAST_PHASE 12
#endif

constexpr int D = 1024, NBATCH = 8, T = 4096, M = NBATCH * T;
constexpr int HD = 64, RW = 512, RH = 8, AW = 512, QH = 8, KVH = 2, WIN = 128;
constexpr int RWKV_COLS = 1792, IN_COLS = 2560;
constexpr int COL_Q = 1792, COL_K = 1792 + 512, COL_V = 1792 + 512 + 128;
constexpr size_t PL_SZ = (size_t)M * 64, P_LORA = 36 * PL_SZ;
constexpr int NE = 32, TOPK = 4, DE = 1024;
constexpr int MAX_TILES = 544;
constexpr int MAX_SLOTS = MAX_TILES * 256;
constexpr float NORM_EPS = 1e-6f, GN_EPS = 64e-5f;

#define GAS __attribute__((address_space(1)))
#define LAS __attribute__((address_space(3)))
typedef unsigned short bf16;
typedef short bf16x8 __attribute__((ext_vector_type(8)));
typedef float f32x4 __attribute__((ext_vector_type(4)));
typedef float f32x2 __attribute__((ext_vector_type(2)));
typedef float f32x16 __attribute__((ext_vector_type(16)));
typedef unsigned u32x4 __attribute__((ext_vector_type(4)));
typedef unsigned u32x2 __attribute__((ext_vector_type(2)));
typedef int i32x8 __attribute__((ext_vector_type(8)));
typedef int i32x4 __attribute__((ext_vector_type(4)));

constexpr size_t MiB = 1u << 20;
constexpr size_t WS_CTL = 0, CTL_BYTES = 64 * 1024;
constexpr size_t WS_MOD = 1 * MiB;
constexpr size_t WS_BON = 1 * MiB + 256 * 1024;
constexpr size_t WS_RT_E = 2 * MiB;
constexpr size_t WS_RT_LP = 2 * MiB + 512 * 1024;
constexpr size_t WS_RT_G = 3 * MiB;
constexpr size_t WS_TOKSLOT = 3 * MiB + 512 * 1024;
constexpr size_t WS_SLOTTOK = 4 * MiB;
constexpr size_t WS_SLOTGATE = 5 * MiB;
constexpr size_t WS_BLKCNT = 6 * MiB;
constexpr size_t WS_TILEE = 6 * MiB + 64 * 1024;
constexpr size_t WS_BONUS = 7 * MiB;
constexpr size_t WS_LW = 9 * MiB;
constexpr size_t WS_WIN = 10 * MiB;
constexpr size_t WS_WOUT = 16 * MiB;
constexpr size_t WS_W1 = 20 * MiB;
constexpr size_t WS_W2 = 148 * MiB;
constexpr size_t WS_H = 212 * MiB;
constexpr size_t WS_R2 = 276 * MiB;
constexpr size_t WS_P = WS_R2;
constexpr size_t WS_SCN = WS_R2 + 160 * MiB;
constexpr size_t WS_SV = WS_SCN + 320 * MiB;
constexpr size_t WS_G = WS_SV + 64 * MiB;
constexpr size_t WS_Y = WS_G + 32 * MiB;
constexpr size_t WS_CAT = WS_Y + 64 * MiB;
constexpr size_t WS_ACT = WS_R2;
constexpr size_t WS_YS = WS_R2 + 272 * MiB;
constexpr size_t WS_END = 1012 * MiB;
constexpr size_t WS_X1B = WS_H;
constexpr size_t WS_H8 = WS_Y;
constexpr size_t WS_PT = 436 * MiB;
constexpr size_t WS_ZV = 500 * MiB;
constexpr size_t WS_Z0 = 628 * MiB;
constexpr size_t WS_RYT = 692 * MiB;
constexpr size_t WS_YVT = WS_Y;
static_assert(WS_END <= 1024 * MiB, "workspace map");
static_assert(WS_YS + 272 * MiB <= WS_CAT, "YS must not overlay CAT");
constexpr int CW_NTILES = 16;
constexpr int CW_PADSTART = 64;
constexpr int CW_BAR = 4096;
constexpr int MISC_OFF = 160 * 1024 - 64;

constexpr int LDS_BYTES = 160 * 1024;

__device__ __forceinline__ unsigned f2bf(float f) { unsigned u = __builtin_bit_cast(unsigned, f); return (u + 0x7fffu + ((u >> 16) & 1u)) >> 16; }
typedef __bf16 bf16x2_t __attribute__((ext_vector_type(2)));
__device__ __forceinline__ unsigned pk2(float lo, float hi) { const f32x2 v = {lo, hi}; return __builtin_bit_cast(unsigned, __builtin_convertvector(v, bf16x2_t)); }
__device__ __forceinline__ float bf2f(unsigned short b) { return __builtin_bit_cast(float, ((unsigned)b) << 16); }
__device__ __forceinline__ float bflo(unsigned u) { return __builtin_bit_cast(float, u << 16); }
__device__ __forceinline__ float bfhi(unsigned u) { return __builtin_bit_cast(float, u & 0xffff0000u); }
__device__ __forceinline__ float wave_sum(float v) {
#pragma unroll
    for (int o = 1; o < 64; o <<= 1) v += __shfl_xor(v, o);
    return v;
}
__device__ __forceinline__ void lds_barrier() { asm volatile("s_waitcnt lgkmcnt(0)" ::: "memory"); __builtin_amdgcn_s_barrier(); asm volatile("" ::: "memory"); }
__device__ __forceinline__ float sigmoidf_(float x) { return __builtin_amdgcn_rcpf(1.f + __expf(-x)); }

namespace pg8 {
#define PG8_LAS __attribute__((address_space(3)))
constexpr int BM = 256, BK = 64, HALF = 128, HTB = HALF * BK * 2, STAGE_BYTES = 8 * HTB, NXCD = 8, WGM = 8;
__host__ __device__ __forceinline__ int lds_byte(int r, int c) { const int st = (r >> 4) * 2 + (c >> 5), rr = r & 15, cc = c & 31, ob = rr * 64 + cc * 2; return st * 1024 + (ob ^ (((ob >> 9) & 1) << 5)); }
__host__ __device__ __forceinline__ void stage_rc(int b, int& R, int& C) { const int st = b / 1024, sb = b % 1024, swz = sb ^ (((sb >> 9) & 1) << 5); R = (st >> 1) * 16 + swz / 64; C = (st & 1) * 32 + (swz % 64) / 2; }

struct Unit { int pm, pn, e, rot; };
struct Gemm { const bf16* A; const bf16* Bt; int K, N; const int* rowmap; };

struct StaticOrder {
    int nM, nN, nwg, G, c;
    __device__ void init(int M_, int N_, int G_, int c_) { nM = M_ / BM; nN = N_ / BM; nwg = nM * nN; G = G_; c = c_; }
    __device__ bool next(int i, Unit& u) const {
        const long L = (long)i * G + c; if (L >= nwg) return false;
        int wgid = (int)L; { const int q = nwg / NXCD, r = nwg % NXCD, xcd = wgid % NXCD, off = wgid / NXCD; wgid = (xcd < r ? xcd * (q + 1) : r * (q + 1) + (xcd - r) * q) + off; }
        const int nig = WGM * nN, gid = wgid / nig, fm = gid * WGM, gsz = (nM - fm) < WGM ? (nM - fm) : WGM;
        u.pm = fm + ((wgid % nig) % gsz); u.pn = (wgid % nig) / gsz; u.e = 0; u.rot = MK_ROT_S ? (4 * u.pn + u.pm) : 0; return true;
    }
};
struct MoeOrder {
    int nMt, nN, G, c; const int* tile_e;
    __device__ bool next(int i, Unit& u) const {
        const long L = (long)i * G + c; if (L >= (long)nMt * nN) return false;
        u.pm = (int)(L / nN); u.pn = (int)(L % nN); u.e = tile_e[u.pm]; u.rot = MK_ROT_M ? (nN == 8 ? u.pn + 2 * u.pm : 2 * u.pn + u.pm) : 0; return true;
    }
};

__device__ __forceinline__ unsigned cvt_pk_bf16(float lo, float hi) { unsigned r; asm volatile("v_cvt_pk_bf16_f32 %0, %1, %2" : "=v"(r) : "v"(lo), "v"(hi)); return r; }

struct EpiBf16P {
    bf16* O; int ldc;
    __device__ __forceinline__ void operator()(const f32x4 (&acc)[2][2][4][2], const Unit& u, int wr, int wc, int fr, int fq) const {
        const int row0 = u.pm * BM + wr * 64 + fr, col0 = u.pn * BM + wc * 32 + 8 * fq;
        const bool lora = u.pn == 6; const int ld = lora ? 256 : 64; size_t off[2];
#pragma unroll
        for (int bj = 0; bj < 2; ++bj) { const int c = col0 + bj * HALF;
            off[bj] = lora ? P_LORA + (size_t)(c - 1536) : (size_t)((c < 1536 ? c : c - 256) >> 6) * PL_SZ + (size_t)(c & 63); }
#pragma unroll
        for (int ai = 0; ai < 2; ++ai)
#pragma unroll
            for (int m = 0; m < 4; ++m) { const size_t ro = (size_t)(row0 + ai * HALF + m * 16) * ld;
#pragma unroll
                for (int bj = 0; bj < 2; ++bj) { const f32x4 v0 = acc[ai][bj][m][0], v1 = acc[ai][bj][m][1];
                    u32x4 w; w.x = cvt_pk_bf16(v0[0], v0[1]); w.y = cvt_pk_bf16(v0[2], v0[3]); w.z = cvt_pk_bf16(v1[0], v1[1]); w.w = cvt_pk_bf16(v1[2], v1[3]);
                    *(u32x4*)(O + ro + off[bj]) = w; } }
    }
};
struct EpiOutProj {
    const float* x; bf16* out; const float* gate;
    __device__ __forceinline__ void operator()(const f32x4 (&acc)[2][2][4][2], const Unit& u, int wr, int wc, int fr, int fq) const {
        const int row0 = u.pm * BM + wr * 64 + fr, col0 = u.pn * BM + wc * 32 + 8 * fq;
        const int b = (u.pm * BM) / T;
        f32x4 gv[2][2];
#pragma unroll
        for (int bj = 0; bj < 2; ++bj)
#pragma unroll
            for (int n = 0; n < 2; ++n) gv[bj][n] = *(const f32x4*)(gate + (size_t)b * 6144 + col0 + bj * HALF + 4 * n);
#pragma unroll
        for (int ai = 0; ai < 2; ++ai)
#pragma unroll
            for (int m = 0; m < 4; ++m) { const size_t ro = (size_t)(row0 + ai * HALF + m * 16) * D + col0;
#pragma unroll
                for (int bj = 0; bj < 2; ++bj) { const f32x4 x0 = __builtin_nontemporal_load((const f32x4*)(x + ro + bj * HALF)), x1 = __builtin_nontemporal_load((const f32x4*)(x + ro + bj * HALF + 4));
                    const f32x4 v0 = x0 + gv[bj][0] * acc[ai][bj][m][0], v1 = x1 + gv[bj][1] * acc[ai][bj][m][1];
                    u32x4 w; w.x = cvt_pk_bf16(v0[0], v0[1]); w.y = cvt_pk_bf16(v0[2], v0[3]); w.z = cvt_pk_bf16(v1[0], v1[1]); w.w = cvt_pk_bf16(v1[2], v1[3]);
                    *(u32x4*)(out + ro + bj * HALF) = w; } }
    }
};
__device__ __forceinline__ unsigned pk4_fp8(float a, float b, float c, float d) { int w = 0; w = __builtin_amdgcn_cvt_pk_fp8_f32(a, b, w, false); w = __builtin_amdgcn_cvt_pk_fp8_f32(c, d, w, true); return (unsigned)w; }
constexpr float W8_SCALE = 32.f, W8_INV = 1.f / 32.f;
struct EpiMoe1 {
    unsigned char* act; const float* b1;
    __device__ __forceinline__ void operator()(const f32x4 (&acc)[2][2][4][2], const Unit& u, int wr, int wc, int fr, int fq) const {
        const int row0 = u.pm * BM + wr * 64 + fr, j0 = u.pn * 128 + wc * 16 + 4 * fq;
        const float* bb = b1 + (size_t)u.e * 2048;
        f32x4 bg[2], bl[2];
#pragma unroll
        for (int bj = 0; bj < 2; ++bj) { bg[bj] = *(const f32x4*)(bb + j0 + bj * 64); bl[bj] = *(const f32x4*)(bb + 1024 + j0 + bj * 64); }
#pragma unroll
        for (int ai = 0; ai < 2; ++ai)
#pragma unroll
            for (int m = 0; m < 4; ++m) { unsigned char* rowp = act + ((size_t)(row0 + ai * HALF + m * 16) * DE + j0) * (MK_FP8 ? 1 : 2);
#pragma unroll
                for (int bj = 0; bj < 2; ++bj) { const f32x4 g4 = acc[ai][bj][m][0] * (MK_FP8 ? W8_INV : 1.f) + bg[bj], l4 = acc[ai][bj][m][1] * (MK_FP8 ? W8_INV : 1.f) + bl[bj]; float a[4];
#pragma unroll
                    for (int q = 0; q < 4; ++q) { const float gl = fminf(g4[q], 7.0f), li = fminf(fmaxf(l4[q], -7.0f), 7.0f);
                        a[q] = gl * __builtin_amdgcn_rcpf(1.f + __expf(-1.702f * gl)) * (li + 1.f); }
#if MK_FP8
                    *(unsigned*)(rowp + bj * 64) = pk4_fp8(a[0], a[1], a[2], a[3]);
#else
                    u32x2 w; w.x = cvt_pk_bf16(a[0], a[1]); w.y = cvt_pk_bf16(a[2], a[3]); *(u32x2*)(rowp + bj * 128) = w;
#endif
                } }
    }
};
constexpr float YS_SCALE = 16.f, YS_INV = 1.f / 16.f;
struct EpiMoe2 {
    unsigned char* ys; const float* b2; const float* sgate;
    __device__ __forceinline__ void operator()(const f32x4 (&acc)[2][2][4][2], const Unit& u, int wr, int wc, int fr, int fq) const {
        const int row0 = u.pm * BM + wr * 64 + fr, col0 = u.pn * BM + wc * 64 + 16 * fq;
        const float* bb = b2 + (size_t)u.e * 1024 + col0;
        f32x4 bv[2][2];
#pragma unroll
        for (int bj = 0; bj < 2; ++bj)
#pragma unroll
            for (int n = 0; n < 2; ++n) bv[bj][n] = *(const f32x4*)(bb + 8 * bj + 4 * n) * YS_SCALE;
#pragma unroll
        for (int ai = 0; ai < 2; ++ai)
#pragma unroll
            for (int m = 0; m < 4; ++m) { const int row = row0 + ai * HALF + m * 16; const float gt = sgate[row], gs = gt * (YS_SCALE * W8_INV); u32x4 w;
                { const f32x4 v = acc[ai][0][m][0] * gs + bv[0][0] * gt; w.x = pk4_fp8(v[0], v[1], v[2], v[3]); }
                { const f32x4 v = acc[ai][0][m][1] * gs + bv[0][1] * gt; w.y = pk4_fp8(v[0], v[1], v[2], v[3]); }
                { const f32x4 v = acc[ai][1][m][0] * gs + bv[1][0] * gt; w.z = pk4_fp8(v[0], v[1], v[2], v[3]); }
                { const f32x4 v = acc[ai][1][m][1] * gs + bv[1][1] * gt; w.w = pk4_fp8(v[0], v[1], v[2], v[3]); }
                *(u32x4*)(ys + (size_t)row * D + col0) = w; }
    }
};

template <class Epi, class Sched, bool GATHER, bool FP8 = false, bool NOLOAD = false>
__device__ __forceinline__ void gemm_phase(PG8_LAS unsigned char* lds, const Gemm g, const Sched& S, const Epi& E) {
    const int tid = threadIdx.x, wid = __builtin_amdgcn_readfirstlane(tid >> 6), lane = tid & 63, wr = wid >> 2, wc = wid & 3, fr = lane & 15, fq = lane >> 4;
    const int K = g.K, nt = K / BK, ntm = nt - 1;
    int Rr[2], Cc[2]; unsigned voffB[2];
#pragma unroll
    for (int i = 0; i < 2; ++i) { stage_rc(tid * 16 + i * 8192, Rr[i], Cc[i]); voffB[i] = (unsigned)(Rr[i] * K + Cc[i]) * 2u; }
    const size_t kstep = (size_t)(BK * 2);
    const size_t hstep = (size_t)HALF * K * 2;
    const size_t tstep = 2 * hstep;
    const unsigned ldsw = (unsigned)wid * 1024u;
    const int aoff = lds_byte(wr * 64 + fr, fq * 8), boff = lds_byte(wc * 32 + fr, fq * 8);
#define PG8_SA(b, h) (((b) * 2 + (h)) * HTB)
#define PG8_SB(b, h) ((4 + (b) * 2 + (h)) * HTB)
#define PG8_STAGE(bufoff, gbase, voff) do { if constexpr (!NOLOAD) _Pragma("unroll") for (int _i = 0; _i < 2; ++_i) \
        __builtin_amdgcn_global_load_lds((const unsigned*)((const char*)(gbase) + (voff)[_i]), (PG8_LAS unsigned*)(lds + (bufoff) + ldsw + _i * 8192), 16, 0, 0); } while (0)
#define PG8_LDA(dst, b, h) do { _Pragma("unroll") for (int m = 0; m < 4; ++m) { const PG8_LAS i32x4* _p = (const PG8_LAS i32x4*)(lds + PG8_SA(b, h) + aoff + m * 2048); \
        dst[m] = __builtin_shufflevector(_p[0], _p[64], 0, 1, 2, 3, 4, 5, 6, 7); } } while (0)
#define PG8_LDB(dst, b, h) do { _Pragma("unroll") for (int n = 0; n < 2; ++n) { const PG8_LAS i32x4* _p = (const PG8_LAS i32x4*)(lds + PG8_SB(b, h) + boff + n * 2048); \
        dst[n] = __builtin_shufflevector(_p[0], _p[64], 0, 1, 2, 3, 4, 5, 6, 7); } } while (0)
#define PG8_MMA(ai, bj, At, Bt) do { __builtin_amdgcn_s_setprio(1); _Pragma("unroll") for (int m = 0; m < 4; ++m) _Pragma("unroll") for (int n = 0; n < 2; ++n) { \
        if constexpr (FP8)   \
            asm volatile("v_mfma_scale_f32_16x16x128_f8f6f4 %0, %1, %2, %0, %3, %3 op_sel_hi:[0,0,0]" : "+v"(acc[ai][bj][m][n]) : "v"(Bt[n]), "v"(At[m]), "v"(0x7F7F7F7F)); \
        else { acc[ai][bj][m][n] = __builtin_amdgcn_mfma_f32_16x16x32_bf16(__builtin_bit_cast(bf16x8, __builtin_shufflevector(Bt[n], Bt[n], 0, 1, 2, 3)), __builtin_bit_cast(bf16x8, __builtin_shufflevector(At[m], At[m], 0, 1, 2, 3)), acc[ai][bj][m][n], 0, 0, 0); \
               acc[ai][bj][m][n] = __builtin_amdgcn_mfma_f32_16x16x32_bf16(__builtin_bit_cast(bf16x8, __builtin_shufflevector(Bt[n], Bt[n], 4, 5, 6, 7)), __builtin_bit_cast(bf16x8, __builtin_shufflevector(At[m], At[m], 4, 5, 6, 7)), acc[ai][bj][m][n], 0, 0, 0); } } \
        __builtin_amdgcn_s_setprio(0); \
        if constexpr (FP8) asm volatile("" : "+v"(acc[ai][bj][0][0]), "+v"(acc[ai][bj][0][1]), "+v"(acc[ai][bj][1][0]), "+v"(acc[ai][bj][1][1]), "+v"(acc[ai][bj][2][0]), "+v"(acc[ai][bj][2][1]), "+v"(acc[ai][bj][3][0]), "+v"(acc[ai][bj][3][1]));   \
        } while (0)
#define PG8_WAIT_V(n) asm volatile("s_waitcnt vmcnt(" #n ")" ::: "memory")
#define PG8_WAIT_L(n) asm volatile("s_waitcnt lgkmcnt(" #n ")" ::: "memory")
#define PG8_WAIT_V8R(rel) do { if (rel) asm volatile("s_waitcnt vmcnt(24)" ::: "memory"); else asm volatile("s_waitcnt vmcnt(8)" ::: "memory"); } while (0)
#define PG8_BAR __builtin_amdgcn_s_barrier()
#define PG8_SCHED __builtin_amdgcn_sched_barrier(0)
#define PG8_AOFFS(dst, u) do { _Pragma("unroll") for (int _h = 0; _h < 2; ++_h) _Pragma("unroll") for (int _i = 0; _i < 2; ++_i) { int _R, _C; stage_rc((int)threadIdx.x * 16 + _i * 8192, _R, _C); \
        if constexpr (GATHER) { const int _tok = g.rowmap[(u).pm * BM + _h * HALF + _R]; dst[_h][_i] = (unsigned)(_tok * K + _C) * 2u; } \
        else dst[_h][_i] = (unsigned)((_h * HALF + _R) * K + _C) * 2u; } } while (0)
#define PG8_ABASE(u) (GATHER ? (const char*)g.A : (const char*)g.A + (size_t)(u).pm * tstep)
#define PG8_BBASE(u) ((const char*)g.Bt + ((size_t)(u).e * g.N + (size_t)(u).pn * BM) * K * 2)
    Unit cur, nxt, nn; int ui = 0;
    if (!S.next(0, cur)) return;
    bool has_next = S.next(1, nxt);
    unsigned curA[2][2], nxtA[2][2];
    PG8_AOFFS(curA, cur);
    if (has_next) PG8_AOFFS(nxtA, nxt); else {
#pragma unroll
        for (int h = 0; h < 2; ++h)
#pragma unroll
            for (int i = 0; i < 2; ++i) nxtA[h][i] = curA[h][i]; }
    f32x4 acc[2][2][4][2];
#pragma unroll
    for (int a = 0; a < 2; ++a)
#pragma unroll
        for (int b = 0; b < 2; ++b)
#pragma unroll
            for (int m = 0; m < 4; ++m)
#pragma unroll
                for (int n = 0; n < 2; ++n) acc[a][b][m][n] = (f32x4){0.f, 0.f, 0.f, 0.f};
    i32x8 At[4], B0[2], B1[2];
    const char* cA = PG8_ABASE(cur); const char* cB = PG8_BBASE(cur);
    { const size_t k0 = (size_t)(cur.rot & ntm) * kstep, k1 = (size_t)((cur.rot + 1) & ntm) * kstep;
    PG8_STAGE(PG8_SB(0, 0), cB + k0, voffB); PG8_STAGE(PG8_SB(0, 1), cB + hstep + k0, voffB); PG8_STAGE(PG8_SA(0, 0), cA + k0, curA[0]); PG8_STAGE(PG8_SA(0, 1), cA + k0, curA[1]);
    if (wr == 1) PG8_BAR;
    PG8_WAIT_V(2); PG8_BAR;
    PG8_STAGE(PG8_SB(1, 0), cB + k1, voffB); PG8_STAGE(PG8_SA(1, 0), cA + k1, curA[0]); PG8_STAGE(PG8_SB(1, 1), cB + hstep + k1, voffB); }
    PG8_WAIT_V(6); PG8_BAR;
    for (;;) {
        const char* nA = has_next ? PG8_ABASE(nxt) : cA; const char* nB = has_next ? PG8_BBASE(nxt) : cB;
#pragma unroll 1
        for (int t = 0; t < nt; t += 2) {
            const bool last = (t == nt - 2);
            const int rc = cur.rot + t, rn = nxt.rot;
            const size_t k1 = (size_t)((rc + 1) & ntm) * kstep, k2 = (size_t)((last ? rn : rc + 2) & ntm) * kstep, k3 = (size_t)((last ? rn + 1 : rc + 3) & ntm) * kstep;
            const char* a1 = cA + k1;
            const char* a2 = (last ? nA : cA) + k2; const char* b2 = (last ? nB : cB) + k2;
            const char* a3 = (last ? nA : cA) + k3; const char* b3 = (last ? nB : cB) + k3;
            unsigned o2[2][2];
#pragma unroll
            for (int h = 0; h < 2; ++h)
#pragma unroll
                for (int i = 0; i < 2; ++i) o2[h][i] = last ? nxtA[h][i] : curA[h][i];
            const bool rel = MK_VM_RELAX && t == 0 && ui > 0;
            PG8_LDB(B0, 0, 0); PG8_LDB(B1, 0, 1); PG8_SCHED; PG8_LDA(At, 0, 0); PG8_STAGE(PG8_SA(1, 1), a1, curA[1]);
            PG8_WAIT_V8R(rel); PG8_WAIT_L(0); PG8_BAR; PG8_MMA(0, 0, At, B0); PG8_MMA(0, 1, At, B1); PG8_BAR; PG8_SCHED;
            PG8_LDA(At, 0, 1); PG8_STAGE(PG8_SB(0, 0), b2, voffB); PG8_STAGE(PG8_SB(0, 1), b2 + hstep, voffB); PG8_STAGE(PG8_SA(0, 0), a2, o2[0]);
            PG8_WAIT_V8R(rel); PG8_WAIT_L(0); PG8_BAR; PG8_MMA(1, 0, At, B0); PG8_MMA(1, 1, At, B1); PG8_BAR; PG8_SCHED;
            PG8_LDB(B0, 1, 0); PG8_LDB(B1, 1, 1); PG8_SCHED; PG8_LDA(At, 1, 0); PG8_STAGE(PG8_SA(0, 1), a2, o2[1]);
            PG8_WAIT_V(8); PG8_WAIT_L(0); PG8_BAR; PG8_MMA(0, 0, At, B0); PG8_MMA(0, 1, At, B1); PG8_BAR; PG8_SCHED;
            PG8_LDA(At, 1, 1); PG8_STAGE(PG8_SB(1, 0), b3, voffB); PG8_STAGE(PG8_SB(1, 1), b3 + hstep, voffB); PG8_STAGE(PG8_SA(1, 0), a3, o2[0]);
            PG8_WAIT_V(8); PG8_WAIT_L(0); PG8_BAR; PG8_MMA(1, 0, At, B0); PG8_MMA(1, 1, At, B1); PG8_BAR; PG8_SCHED;
        }
        if constexpr (FP8) asm volatile("s_nop 15\n\ts_nop 15" ::: "memory");
        if (wr == 0) PG8_BAR;
        const bool has_nn = has_next && S.next(ui + 2, nn);
        unsigned nnA[2][2];
        if (has_nn) PG8_AOFFS(nnA, nn);
        E(acc, cur, wr, wc, fr, fq);
        if (!has_next) break;
#pragma unroll
        for (int a = 0; a < 2; ++a)
#pragma unroll
            for (int b = 0; b < 2; ++b)
#pragma unroll
                for (int m = 0; m < 4; ++m)
#pragma unroll
                    for (int n = 0; n < 2; ++n) acc[a][b][m][n] = (f32x4){0.f, 0.f, 0.f, 0.f};
        cur = nxt; cA = nA; cB = nB; ++ui;
#pragma unroll
        for (int h = 0; h < 2; ++h)
#pragma unroll
            for (int i = 0; i < 2; ++i) { curA[h][i] = nxtA[h][i]; if (has_nn) nxtA[h][i] = nnA[h][i]; }
        nxt = nn; has_next = has_nn;
        if (wr == 1) PG8_BAR;
    }
    PG8_WAIT_V(0);
    PG8_BAR;
#undef PG8_SA
#undef PG8_SB
#undef PG8_STAGE
#undef PG8_LDA
#undef PG8_LDB
#undef PG8_MMA
#undef PG8_WAIT_V
#undef PG8_WAIT_L
#undef PG8_BAR
#undef PG8_SCHED
#undef PG8_AOFFS
#undef PG8_ABASE
#undef PG8_BBASE
}
}

struct Frame {
    LAS unsigned char* lds;
    int tid, lane, wave, vcu, G;
    const float* const* in;
    float* out;
    unsigned char* ws;
};
template <class Tp> __device__ __forceinline__ Tp* wsp(const Frame& F, size_t off) { return (Tp*)(F.ws + off); }

__device__ __forceinline__ int dest_row(int mode, int s) {
    if (mode == 0) return s;
    if (mode == 1) return (s & ~31) | (((s >> 2) & 1) << 4) | (((s >> 3) & 3) << 2) | (s & 3);
    if (mode == 3) return (s & ~255) | (((s >> 3) & 1) << 7) | (((s >> 6) & 3) << 5) | (((s >> 2) & 1) << 4) | (((s >> 4) & 3) << 2) | (s & 3);
    const int half = s >> 10, j = s & 1023;
    return ((j >> 7) << 8) | (((j >> 6) & 1) << 7) | (((j >> 4) & 3) << 5) | (half << 4) | (j & 15);
}
__device__ __forceinline__ void transpose_item(const float* W, int K, int N, bf16* WT, int mode, int item, int lane) {
    const int nblk = N / 64, kb = item / nblk, nb = item % nblk, k0 = 64 * kb, n0 = 64 * nb;
    const float* src = W + (size_t)k0 * N + n0 + lane;
    float v[64];
#pragma unroll
    for (int i = 0; i < 64; ++i) v[i] = src[(size_t)i * N];
    bf16* dst = WT + (size_t)dest_row(mode, n0 + lane) * K + k0;
#pragma unroll
    for (int j = 0; j < 8; ++j) { u32x4 o; o.x = pk2(v[8 * j], v[8 * j + 1]); o.y = pk2(v[8 * j + 2], v[8 * j + 3]); o.z = pk2(v[8 * j + 4], v[8 * j + 5]); o.w = pk2(v[8 * j + 6], v[8 * j + 7]);
        *(u32x4*)(dst + 8 * j) = o; }
}
__device__ __forceinline__ void transpose_item8(const float* W, int K, int N, unsigned char* WT, int mode, int item, int lane) {
    const int nblk = N / 64, kb = item / nblk, nb = item % nblk, k0 = 64 * kb, n0 = 64 * nb;
    const float* src = W + (size_t)k0 * N + n0 + lane;
    float v[64];
#pragma unroll
    for (int i = 0; i < 64; ++i) v[i] = __builtin_nontemporal_load(src + (size_t)i * N) * 32.f;
    unsigned char* dst = WT + (size_t)dest_row(mode, n0 + lane) * K + k0;
#pragma unroll
    for (int j = 0; j < 4; ++j) { u32x4 o; o.x = pg8::pk4_fp8(v[16 * j], v[16 * j + 1], v[16 * j + 2], v[16 * j + 3]); o.y = pg8::pk4_fp8(v[16 * j + 4], v[16 * j + 5], v[16 * j + 6], v[16 * j + 7]);
        o.z = pg8::pk4_fp8(v[16 * j + 8], v[16 * j + 9], v[16 * j + 10], v[16 * j + 11]); o.w = pg8::pk4_fp8(v[16 * j + 12], v[16 * j + 13], v[16 * j + 14], v[16 * j + 15]);
        *(u32x4*)(dst + 16 * j) = o; }
}
constexpr int MOE_I1 = 16 * 32, MOE_I2 = 16 * 16, MOE_ITEMS = NE * (MOE_I1 + MOE_I2);
__device__ __forceinline__ void moe_weight_item(const Frame& F, int it) {
#if !MK_FP8
    if (it < NE * MOE_I1) { const int e = it / MOE_I1; transpose_item(F.in[24] + (size_t)e * 1024 * 2048, 1024, 2048, wsp<bf16>(F, WS_W1) + (size_t)e * 2048 * 1024, 2, it % MOE_I1, F.lane); }
    else { const int r = it - NE * MOE_I1, e = r / MOE_I2; transpose_item(F.in[26] + (size_t)e * 1024 * 1024, 1024, 1024, wsp<bf16>(F, WS_W2) + (size_t)e * 1024 * 1024, 1, r % MOE_I2, F.lane); }
#else
    if (it < NE * MOE_I1) { const int e = it / MOE_I1; transpose_item8(F.in[24] + (size_t)e * 1024 * 2048, 1024, 2048, wsp<unsigned char>(F, WS_W1) + (size_t)e * 2048 * 1024, 2, it % MOE_I1, F.lane); }
    else { const int r = it - NE * MOE_I1, e = r / MOE_I2; transpose_item8(F.in[26] + (size_t)e * 1024 * 1024, 1024, 1024, wsp<unsigned char>(F, WS_W2) + (size_t)e * 1024 * 1024, 3, r % MOE_I2, F.lane); }
#endif
}

__device__ __forceinline__ void phase0(const Frame& F) {
    if (F.vcu < 192) {
        LAS float* sl = (LAS float*)F.lds;
        LAS float* red = (LAS float*)(F.lds + 32768);
        const float* c = F.in[1];
        for (int idx = F.tid; idx < 8192; idx += 512) { const int b = idx & 7, k = idx >> 3; const float cv = c[b * 1024 + k]; sl[idx] = cv / (1.f + __expf(-cv)); }
        __syncthreads();
        const int cl = F.tid & 31, ks = F.tid >> 5, col = F.vcu * 32 + cl;
        const float* wa = F.in[2];
        float acc[8];
#pragma unroll
        for (int b = 0; b < 8; ++b) acc[b] = 0.f;
#pragma unroll 4
        for (int kk = 0; kk < 64; ++kk) { const int k = ks * 64 + kk; const float w = wa[(size_t)k * 6144 + col];
            const f32x4 s0 = *(const LAS f32x4*)(sl + k * 8), s1 = *(const LAS f32x4*)(sl + k * 8 + 4);
            acc[0] += s0[0] * w; acc[1] += s0[1] * w; acc[2] += s0[2] * w; acc[3] += s0[3] * w;
            acc[4] += s1[0] * w; acc[5] += s1[1] * w; acc[6] += s1[2] * w; acc[7] += s1[3] * w; }
#pragma unroll
        for (int b = 0; b < 8; ++b) red[(ks * 32 + cl) * 8 + b] = acc[b];
        __syncthreads();
        if (F.tid < 256) { const int b = F.tid >> 5; float s = F.in[3][col];
            for (int q = 0; q < 16; ++q) s += red[(q * 32 + cl) * 8 + b];
            wsp<float>(F, WS_MOD)[b * 6144 + col] = s; }
    }
    const int gw = F.vcu * 8 + F.wave, NGW = F.G * 8;
    constexpr int I_IN = 16 * 40, I_OUT = 16 * 16;
    constexpr int NITEMS = I_IN + I_OUT;
    for (int it = gw; it < NITEMS; it += NGW) {
        int r = it;
        if (r < I_IN) { transpose_item(F.in[5], 1024, 2560, wsp<bf16>(F, WS_WIN), 1, r, F.lane); continue; } r -= I_IN;
        transpose_item(F.in[20], 1024, 1024, wsp<bf16>(F, WS_WOUT), 1, r, F.lane);
    }
#if MK_CONV_WHERE == 0
    for (int it = gw; it < MOE_ITEMS; it += NGW) moe_weight_item(F, it);
#endif
    { bf16* LW = wsp<bf16>(F, WS_LW);
        for (int idx = F.vcu * 512 + F.tid; idx < 256 * 512; idx += F.G * 512) { const int k = idx >> 9, c = idx & 511;
            const float v = k < 64 ? F.in[8][k * 512 + c] : (k < 128 ? F.in[10][(k - 64) * 512 + c] : F.in[11][(k - 128) * 512 + c]);
            LW[c * 256 + k] = (bf16)f2bf(v); } }
}
template <bool OUT8 = false, bool IN16 = false>
__device__ __forceinline__ void norm_row(const Frame& F, const float* xrow, const float* g, const float* shift, const float* scale, bf16* orow, f32x4 (&h)[4]) {
    const f32x4* xr = (const f32x4*)xrow + F.lane; const u32x2* xr16 = (const u32x2*)xrow + F.lane;
    float ss = 0.f;
#pragma unroll
    for (int j = 0; j < 4; ++j) { if constexpr (IN16) { const u32x2 q = __builtin_nontemporal_load(xr16 + 64 * j); h[j] = (f32x4){bflo(q.x), bfhi(q.x), bflo(q.y), bfhi(q.y)}; } else h[j] = __builtin_nontemporal_load(xr + 64 * j); ss += (h[j][0] * h[j][0] + h[j][1] * h[j][1]) + (h[j][2] * h[j][2] + h[j][3] * h[j][3]); }
    const float rstd = rsqrtf(wave_sum(ss) * (1.f / D) + NORM_EPS);
    u32x2* o8 = (u32x2*)orow + F.lane;
#pragma unroll
    for (int j = 0; j < 4; ++j) { const int col = 4 * F.lane + 256 * j;
        const f32x4 gv = *(const f32x4*)(g + col), sh = *(const f32x4*)(shift + col), sc = *(const f32x4*)(scale + col);
        h[j] = h[j] * rstd * gv * (sc + 1.f) + sh;
        if constexpr (OUT8) ((unsigned*)orow)[F.lane + 64 * j] = pg8::pk4_fp8(h[j][0], h[j][1], h[j][2], h[j][3]);
        else { u32x2 w; w.x = pk2(h[j][0], h[j][1]); w.y = pk2(h[j][2], h[j][3]); o8[64 * j] = w; } }
}
__device__ __forceinline__ void phase1(const Frame& F) {
    const int gw = F.vcu * 8 + F.wave, NGW = F.G * 8;
    const float* mod = wsp<float>(F, WS_MOD);
    for (int row = gw; row < M; row += NGW) { const int b = row / T; f32x4 h[4];
        norm_row(F, F.in[0] + (size_t)row * D, F.in[4], mod + b * 6144, mod + b * 6144 + 1024, wsp<bf16>(F, WS_H) + (size_t)row * D, h); }
}

template <int CTRL> __device__ __forceinline__ float dpp_mov(float v) { return __builtin_bit_cast(float, __builtin_amdgcn_update_dpp(0, __builtin_bit_cast(int, v), CTRL, 0xf, 0xf, false)); }
__device__ __forceinline__ float reduce16(float v) { v += dpp_mov<0xB1>(v); v += dpp_mov<0x4E>(v); v += dpp_mov<0x141>(v); v += dpp_mov<0x140>(v); return v; }
__device__ __forceinline__ void lerp8(const bf16* P, const float* mu, int tok, int t, int col, float (&x)[8]) {
    const u32x4 c = *(const u32x4*)(P + (size_t)tok * IN_COLS + col);
    u32x4 p = (u32x4){0u, 0u, 0u, 0u};
    if (t > 0) p = *(const u32x4*)(P + (size_t)(tok - 1) * IN_COLS + col);
    const f32x4 m0 = *(const f32x4*)(mu + col), m1 = *(const f32x4*)(mu + col + 4);
    const float cf[8] = {bflo(c.x), bfhi(c.x), bflo(c.y), bfhi(c.y), bflo(c.z), bfhi(c.z), bflo(c.w), bfhi(c.w)};
    const float pf[8] = {bflo(p.x), bfhi(p.x), bflo(p.y), bfhi(p.y), bflo(p.z), bfhi(p.z), bflo(p.w), bfhi(p.w)};
    const float mf[8] = {m0[0], m0[1], m0[2], m0[3], m1[0], m1[1], m1[2], m1[3]};
#pragma unroll
    for (int j = 0; j < 8; ++j) x[j] = cf[j] + (pf[j] - cf[j]) * mf[j];
}
__device__ __forceinline__ f32x4 lerp4(const bf16* P, const float* mu, int tok, int t, int col) {
    const u32x2 c = *(const u32x2*)(P + (size_t)tok * IN_COLS + col);
    u32x2 p = (u32x2){0u, 0u};
    if (t > 0) p = *(const u32x2*)(P + (size_t)(tok - 1) * IN_COLS + col);
    const f32x4 m = *(const f32x4*)(mu + col);
    const f32x4 cf = (f32x4){bflo(c.x), bfhi(c.x), bflo(c.y), bfhi(c.y)}, pf = (f32x4){bflo(p.x), bfhi(p.x), bflo(p.y), bfhi(p.y)};
    return cf + (pf - cf) * m;
}
__device__ __forceinline__ bf16x8 pack8(const float (&x)[8]) { u32x4 w; w.x = pk2(x[0], x[1]); w.y = pk2(x[2], x[3]); w.z = pk2(x[4], x[5]); w.w = pk2(x[6], x[7]); return __builtin_bit_cast(bf16x8, w); }
__device__ __forceinline__ void phase3(const Frame& F) {
    const bf16* P = wsp<bf16>(F, WS_P); const bf16* LW = wsp<bf16>(F, WS_LW);
    const float* mu = F.in[6]; const float* w0 = F.in[7]; const float* a0 = F.in[9];
    const float* k_k = F.in[12]; const float* k_a = F.in[13]; const float* r_k = F.in[14];
    float* SCN = wsp<float>(F, WS_SCN); float* SV = wsp<float>(F, WS_SV); bf16* G = wsp<bf16>(F, WS_G); float* BON = wsp<float>(F, WS_BONUS);
    const int gw = F.vcu * 8 + F.wave, NGW = F.G * 8;
    const int cl = F.lane & 15, q = F.lane >> 4;
    for (int tile = gw; tile < M / 16; tile += NGW) {
        bf16x8 Aw[2], Aa[2], Ag[4];
        { const int tok = tile * 16 + cl, t = tok % T; float x[8];
#pragma unroll
            for (int s = 0; s < 2; ++s) { lerp8(P, mu, tok, t, 1536 + 32 * s + 8 * q, x);
#pragma unroll
                for (int j = 0; j < 8; ++j) x[j] = tanhf(x[j]);
                Aw[s] = pack8(x);
                lerp8(P, mu, tok, t, 1600 + 32 * s + 8 * q, x); Aa[s] = pack8(x); }
#pragma unroll
            for (int s = 0; s < 4; ++s) { lerp8(P, mu, tok, t, 1664 + 32 * s + 8 * q, x);
#pragma unroll
                for (int j = 0; j < 8; ++j) x[j] = sigmoidf_(x[j]);
                Ag[s] = pack8(x); } }
        const int tk0 = tile * 16 + 4 * q, b = tk0 / T, t0 = tk0 % T;
#pragma unroll 1
        for (int hh = 0; hh < RH; ++hh) {
            const int c0 = hh * 64 + cl * 4;
            f32x4 accw[4], acca[4], accg[4];
#pragma unroll
            for (int ct = 0; ct < 4; ++ct) { const bf16* lw = LW + (size_t)(c0 + ct) * 256 + 8 * q;
                f32x4 aw = (f32x4){0.f, 0.f, 0.f, 0.f}, aa = aw, ag = aw;
#pragma unroll
                for (int s = 0; s < 2; ++s) { aw = __builtin_amdgcn_mfma_f32_16x16x32_bf16(Aw[s], *(const bf16x8*)(lw + 32 * s), aw, 0, 0, 0);
                    aa = __builtin_amdgcn_mfma_f32_16x16x32_bf16(Aa[s], *(const bf16x8*)(lw + 64 + 32 * s), aa, 0, 0, 0); }
#pragma unroll
                for (int s = 0; s < 4; ++s) ag = __builtin_amdgcn_mfma_f32_16x16x32_bf16(Ag[s], *(const bf16x8*)(lw + 128 + 32 * s), ag, 0, 0, 0);
                accw[ct] = aw; acca[ct] = aa; accg[ct] = ag; }
            const f32x4 w0v = *(const f32x4*)(w0 + c0), a0v = *(const f32x4*)(a0 + c0), kkv = *(const f32x4*)(k_k + c0), kav = *(const f32x4*)(k_a + c0), rkv = *(const f32x4*)(r_k + c0);
#pragma unroll
            for (int i = 0; i < 4; ++i) { const int tk = tk0 + i, t = t0 + i;
                const f32x4 r4 = lerp4(P, mu, tk, t, c0), kr4 = lerp4(P, mu, tk, t, 512 + c0), v4 = lerp4(P, mu, tk, t, 1024 + c0);
                f32x4 dec, av, gv, kk4, k4;
                float ssq = 0.f, bon = 0.f;
#pragma unroll
                for (int ct = 0; ct < 4; ++ct) {
                    dec[ct] = __expf(-0.60653066f * sigmoidf_(w0v[ct] + accw[ct][i]));
                    av[ct] = sigmoidf_(a0v[ct] + acca[ct][i]);
                    gv[ct] = accg[ct][i];
                    kk4[ct] = kr4[ct] * kkv[ct]; ssq += kk4[ct] * kk4[ct];
                    k4[ct] = kr4[ct] * (1.f + (av[ct] - 1.f) * kav[ct]);
                    bon += r4[ct] * k4[ct] * rkv[ct]; }
                ssq = reduce16(ssq); bon = reduce16(bon);
                const float inv = __builtin_amdgcn_rcpf(fmaxf(sqrtf(ssq), 1e-12f));
                const f32x4 kkn = kk4 * inv, bb = kkn * av;
                const size_t so = ((size_t)(b * RH + hh) * T + t) * 64 + cl * 4;
                float* sc = SCN + ((size_t)(b * RH + hh) * T + t) * 320 + cl * 4;
                *(f32x4*)(sc) = dec; *(f32x4*)(sc + 64) = kkn; *(f32x4*)(sc + 128) = bb; *(f32x4*)(sc + 192) = k4; *(f32x4*)(sc + 256) = r4;
                *(f32x4*)(SV + so) = v4;
                u32x2 gw2; gw2.x = pk2(gv[0], gv[1]); gw2.y = pk2(gv[2], gv[3]);
                *(u32x2*)(G + (size_t)tk * 512 + c0) = gw2;
                if (cl == 0) BON[tk * 8 + hh] = bon; }
        }
    }
}

constexpr int CK = 32, NCHK = T / CK;
#define SC_SPIN_CAP (1 << 24)
#define MFMA32(a, b, c) __builtin_amdgcn_mfma_f32_32x32x16_bf16((a), (b), (c), 0, 0, 0)
__device__ __forceinline__ int crow(int i, int h) { return (i & 3) + 8 * (i >> 2) + 4 * h; }
template <int S_> __device__ __forceinline__ bf16x8 pack_acc(const f32x16& x) { u32x4 w; w.x = pk2(x[8 * S_], x[8 * S_ + 1]); w.y = pk2(x[8 * S_ + 2], x[8 * S_ + 3]); w.z = pk2(x[8 * S_ + 4], x[8 * S_ + 5]); w.w = pk2(x[8 * S_ + 6], x[8 * S_ + 7]); return __builtin_bit_cast(bf16x8, w); }
__device__ __forceinline__ bf16x8 rd_nat(const LAS bf16* img, int stride, int row, int k0) { return *(const LAS bf16x8*)(img + row * stride + k0); }
__device__ __forceinline__ bf16x8 rd_perm(const LAS bf16* img, int stride, int row, int kb, int h) {
    const u32x2 lo = *(const LAS u32x2*)(img + row * stride + kb + 4 * h), hi = *(const LAS u32x2*)(img + row * stride + kb + 8 + 4 * h);
    u32x4 w; w.x = lo.x; w.y = lo.y; w.z = hi.x; w.w = hi.y; return __builtin_bit_cast(bf16x8, w);
}
__device__ __forceinline__ f32x16 zero16() { f32x16 z; for (int i = 0; i < 16; ++i) z[i] = 0.f; return z; }
constexpr int CL_A = 0, CL_B = 4608, CL_K = 9216, CL_R = 13824, CL_AT = 18432, CL_BHT = 23552, CL_KHT = 28672, CL_VT = 33792, CL_GTOT = 38912, CL_GC = 39936,
              CL_L = 40192, CL_T = 44800, CL_FNRB = 47360, CL_CNRK = 49408, CL_FQM = 53504, CL_GROUP = 57600;
constexpr int RMS = 72, TRS = 40, LST = 36;
__device__ __forceinline__ void phase4a_summaries(const Frame& F) {
    const float* SCN = wsp<float>(F, WS_SCN); const float* SV = wsp<float>(F, WS_SV);
    bf16x8* PT = wsp<bf16x8>(F, WS_PT); f32x4* ZV = wsp<f32x4>(F, WS_ZV); bf16x8* RYT = wsp<bf16x8>(F, WS_RYT); f32x4* YVT = wsp<f32x4>(F, WS_YVT);
    const int grp = F.tid >> 8, gt = F.tid & 255, w4 = F.wave & 3, lane = F.lane, r = lane & 31, h = lane >> 5;
    LAS unsigned char* gl = F.lds + grp * CL_GROUP;
    LAS bf16* iA = (LAS bf16*)(gl + CL_A); LAS bf16* iB = (LAS bf16*)(gl + CL_B); LAS bf16* iK = (LAS bf16*)(gl + CL_K); LAS bf16* iR = (LAS bf16*)(gl + CL_R);
    LAS bf16* iAT = (LAS bf16*)(gl + CL_AT); LAS bf16* iBHT = (LAS bf16*)(gl + CL_BHT); LAS bf16* iKHT = (LAS bf16*)(gl + CL_KHT); LAS bf16* iVT = (LAS bf16*)(gl + CL_VT);
    LAS float* gtot = (LAS float*)(gl + CL_GTOT); LAS float* gcv = (LAS float*)(gl + CL_GC); LAS float* Lm = (LAS float*)(gl + CL_L); LAS bf16* Tm = (LAS bf16*)(gl + CL_T);
    LAS bf16x8* fnrb = (LAS bf16x8*)(gl + CL_FNRB); LAS float* cnrk = (LAS float*)(gl + CL_CNRK); LAS bf16x8* fqm = (LAS bf16x8*)(gl + CL_FQM);
    constexpr int NCHUNKS = NBATCH * RH * NCHK;
    for (int it = F.vcu; it < NCHUNKS / 2; it += F.G) {
        const int chunk = it * 2 + grp, bh = chunk / NCHK, c = chunk % NCHK, t0 = c * CK;
        __syncthreads();
        { const int k = gt & 63, tq = gt >> 6;
            float wv[8], kkv[8], bv[8], kv[8], rv[8], vv[8], lp[8];
#pragma unroll
            for (int i = 0; i < 8; ++i) { const size_t row = (size_t)bh * T + t0 + 8 * tq + i; const float* sc = SCN + row * 320 + k;
                wv[i] = sc[0]; kkv[i] = sc[64]; bv[i] = sc[128]; kv[i] = sc[192]; rv[i] = sc[256]; vv[i] = SV[row * 64 + k]; }
            lp[0] = wv[0];
#pragma unroll
            for (int i = 1; i < 8; ++i) lp[i] = lp[i - 1] * wv[i];
            gtot[tq * 64 + k] = lp[7];
            __syncthreads();
            const float g0 = gtot[k], g1 = gtot[64 + k], g2 = gtot[128 + k], g3 = gtot[192 + k];
            const float pre = tq == 0 ? 1.f : (tq == 1 ? g0 : (tq == 2 ? g0 * g1 : g0 * g1 * g2)), gC = (g0 * g1) * (g2 * g3);
            float at[8], bh8[8], kh8[8];
#pragma unroll
            for (int i = 0; i < 8; ++i) { const float g = pre * lp[i], gp = i == 0 ? pre : pre * lp[i - 1], ig = __builtin_amdgcn_rcpf(g);
                const float bt = bv[i] * ig, kt = kv[i] * ig; at[i] = -kkv[i] * gp; bh8[i] = bt * gC; kh8[i] = kt * gC;
                const int ro = (8 * tq + i) * RMS + k;
                iA[ro] = (bf16)f2bf(at[i]); iB[ro] = (bf16)f2bf(bt); iK[ro] = (bf16)f2bf(kt); iR[ro] = (bf16)f2bf(rv[i] * g); }
            *(LAS bf16x8*)(iAT + k * TRS + 8 * tq) = pack8(at); *(LAS bf16x8*)(iBHT + k * TRS + 8 * tq) = pack8(bh8); *(LAS bf16x8*)(iKHT + k * TRS + 8 * tq) = pack8(kh8);
            *(LAS bf16x8*)(iVT + k * TRS + 8 * tq) = pack8(vv);
            if (tq == 0) gcv[k] = gC; }
        __syncthreads();
        f32x16 lak = zero16();
        { const LAS bf16* ia = (w4 < 2) ? iA : (w4 == 2 ? iB : iK); const LAS bf16* ib = (w4 == 0) ? iB : (w4 == 1 ? iK : iR);
            f32x16 acc = zero16();
#pragma unroll
            for (int ks = 0; ks < 4; ++ks) acc = MFMA32(rd_nat(ia, RMS, r, 16 * ks + 8 * h), rd_nat(ib, RMS, r, 16 * ks + 8 * h), acc);
#pragma unroll
            for (int i = 0; i < 16; ++i) { const int row = crow(i, h); const bool keep = (w4 < 2) ? (r < row) : (row <= r); acc[i] = keep ? acc[i] : 0.f; }
            if (w4 == 0) {
#pragma unroll
                for (int i = 0; i < 16; ++i) Lm[crow(i, h) * LST + r] = acc[i]; }
            else if (w4 == 1) lak = acc;
            else if (w4 == 2) { fnrb[lane] = pack_acc<0>(acc); fnrb[64 + lane] = pack_acc<1>(acc); }
            else {
#pragma unroll
                for (int i = 0; i < 16; ++i) cnrk[i * 64 + lane] = acc[i]; } }
        __syncthreads();
        if (w4 == 0) { float Tr[32];
#pragma unroll
            for (int t = 0; t < 32; ++t) { float acc = (t == r) ? 1.f : 0.f;
#pragma unroll
                for (int s4 = 0; s4 < (t + 3) / 4; ++s4) { const f32x4 l4 = *(const LAS f32x4*)(Lm + t * LST + 4 * s4);
#pragma unroll
                    for (int q = 0; q < 4; ++q) if (4 * s4 + q < t) acc += l4[q] * Tr[4 * s4 + q]; }
                Tr[t] = acc; }
            if (lane < 32) {
#pragma unroll
                for (int t = 0; t < 32; ++t) Tm[t * TRS + r] = (bf16)f2bf(Tr[t]); } }
        __syncthreads();
        if (w4 == 0 || w4 == 2) { const int a = w4 >> 1;
            f32x16 x1 = zero16();
#pragma unroll
            for (int ks = 0; ks < 2; ++ks) x1 = MFMA32(rd_nat(Tm, TRS, r, 16 * ks + 8 * h), rd_nat(iAT, TRS, 32 * a + r, 16 * ks + 8 * h), x1);
            const bf16x8 xf0 = pack_acc<0>(x1), xf1 = pack_acc<1>(x1);
#pragma unroll
            for (int b = 0; b < 2; ++b) { f32x16 p = zero16();
                p = MFMA32(xf0, rd_perm(iBHT, TRS, 32 * b + r, 0, h), p); p = MFMA32(xf1, rd_perm(iBHT, TRS, 32 * b + r, 16, h), p);
                if (a == b) { const float gc = gcv[32 * a + r];
#pragma unroll
                    for (int i = 0; i < 16; ++i) p[i] += (crow(i, h) == r) ? gc : 0.f; }
                bf16x8* dst = PT + ((size_t)(chunk * 2 + a) * 2 + b) * 2 * 64 + lane; dst[0] = pack_acc<0>(p); dst[64] = pack_acc<1>(p); }
            f32x16 ry;
#pragma unroll
            for (int g = 0; g < 4; ++g) { const u32x2 rr = *(const LAS u32x2*)(iR + r * RMS + 32 * a + 8 * g + 4 * h);
                ry[4 * g] = bflo(rr.x); ry[4 * g + 1] = bfhi(rr.x); ry[4 * g + 2] = bflo(rr.y); ry[4 * g + 3] = bfhi(rr.y); }
            ry = MFMA32(xf0, fnrb[lane], ry); ry = MFMA32(xf1, fnrb[64 + lane], ry);
            bf16x8* dr = RYT + (size_t)(chunk * 2 + a) * 2 * 64 + lane; dr[0] = pack_acc<0>(ry); dr[64] = pack_acc<1>(ry);
        } else if (w4 == 1) {
            f32x16 x2 = zero16();
            x2 = MFMA32(rd_perm(Tm, TRS, r, 0, h), pack_acc<0>(lak), x2); x2 = MFMA32(rd_perm(Tm, TRS, r, 16, h), pack_acc<1>(lak), x2);
            const bf16x8 xf0 = pack_acc<0>(x2), xf1 = pack_acc<1>(x2);
#pragma unroll
            for (int b = 0; b < 2; ++b) { f32x16 qm;
#pragma unroll
                for (int g = 0; g < 4; ++g) { const u32x2 kk2 = *(const LAS u32x2*)(iKHT + (32 * b + r) * TRS + 8 * g + 4 * h);
                    qm[4 * g] = bflo(kk2.x); qm[4 * g + 1] = bfhi(kk2.x); qm[4 * g + 2] = bflo(kk2.y); qm[4 * g + 3] = bfhi(kk2.y); }
                qm = MFMA32(xf0, rd_perm(iBHT, TRS, 32 * b + r, 0, h), qm); qm = MFMA32(xf1, rd_perm(iBHT, TRS, 32 * b + r, 16, h), qm);
                fqm[(b * 2 + 0) * 64 + lane] = pack_acc<0>(qm); fqm[(b * 2 + 1) * 64 + lane] = pack_acc<1>(qm); }
            f32x16 gy;
#pragma unroll
            for (int i = 0; i < 16; ++i) gy[i] = cnrk[i * 64 + lane];
            gy = MFMA32(xf0, fnrb[lane], gy); gy = MFMA32(xf1, fnrb[64 + lane], gy);
            const bf16x8 gf0 = pack_acc<0>(gy), gf1 = pack_acc<1>(gy);
#pragma unroll
            for (int vh = 0; vh < 2; ++vh) { f32x16 yv = zero16();
                yv = MFMA32(rd_perm(iVT, TRS, 32 * vh + r, 0, h), gf0, yv); yv = MFMA32(rd_perm(iVT, TRS, 32 * vh + r, 16, h), gf1, yv);
                bf16x8* dy = (bf16x8*)YVT + ((size_t)(chunk * 2 + vh) * 64 + lane) * 2;
                dy[0] = pack_acc<0>(yv); dy[1] = pack_acc<1>(yv); }
        }
        __syncthreads();
        if (w4 == 3) {
#pragma unroll
            for (int b = 0; b < 2; ++b)
#pragma unroll
                for (int vh = 0; vh < 2; ++vh) { f32x16 zv = zero16();
                    zv = MFMA32(fqm[(b * 2 + 0) * 64 + lane], rd_perm(iVT, TRS, 32 * vh + r, 0, h), zv); zv = MFMA32(fqm[(b * 2 + 1) * 64 + lane], rd_perm(iVT, TRS, 32 * vh + r, 16, h), zv);
                    bf16x8* dz = (bf16x8*)ZV + (((size_t)(chunk * 2 + b) * 2 + vh) * 64 + lane) * 2;
                    dz[0] = pack_acc<0>(zv); dz[1] = pack_acc<1>(zv); }
        }
    }
}
constexpr int CL2_LA = 2 * CL_GROUP, LAS_STRIDE = 264;
static_assert(CL2_LA + 32 * LAS_STRIDE * 2 <= MISC_OFF, "fused summaries LDS map");
__device__ __forceinline__ void phase4a_fused(const Frame& F) {
    const bf16* P = wsp<bf16>(F, WS_P); const bf16* LW = wsp<bf16>(F, WS_LW);
    const float* mu = F.in[6]; const float* w0 = F.in[7]; const float* a0 = F.in[9]; const float* k_k = F.in[12]; const float* k_a = F.in[13]; const float* r_k = F.in[14];
    float* SV = wsp<float>(F, WS_SV); bf16* G = wsp<bf16>(F, WS_G); float* BON = wsp<float>(F, WS_BONUS);
    bf16x8* PT = wsp<bf16x8>(F, WS_PT); f32x4* ZV = wsp<f32x4>(F, WS_ZV); bf16x8* RYT = wsp<bf16x8>(F, WS_RYT); f32x4* YVT = wsp<f32x4>(F, WS_YVT);
    const int grp = F.tid >> 8, gt = F.tid & 255, w4 = F.wave & 3, lane = F.lane, r = lane & 31, h = lane >> 5;
    LAS unsigned char* gl = F.lds + grp * CL_GROUP;
    LAS bf16* iA = (LAS bf16*)(gl + CL_A); LAS bf16* iB = (LAS bf16*)(gl + CL_B); LAS bf16* iK = (LAS bf16*)(gl + CL_K); LAS bf16* iR = (LAS bf16*)(gl + CL_R);
    LAS bf16* iAT = (LAS bf16*)(gl + CL_AT); LAS bf16* iBHT = (LAS bf16*)(gl + CL_BHT); LAS bf16* iKHT = (LAS bf16*)(gl + CL_KHT); LAS bf16* iVT = (LAS bf16*)(gl + CL_VT);
    LAS float* gtot = (LAS float*)(gl + CL_GTOT); LAS float* gcv = (LAS float*)(gl + CL_GC); LAS float* Lm = (LAS float*)(gl + CL_L); LAS bf16* Tm = (LAS bf16*)(gl + CL_T);
    LAS bf16x8* fnrb = (LAS bf16x8*)(gl + CL_FNRB); LAS float* cnrk = (LAS float*)(gl + CL_CNRK); LAS bf16x8* fqm = (LAS bf16x8*)(gl + CL_FQM);
    LAS float* lwo_w = (LAS float*)(gl + CL_L); LAS float* lwo_a = lwo_w + 32 * 64;
    LAS bf16* LA = (LAS bf16*)(F.lds + CL2_LA);
    bf16 cr[9], ck[9], cv[9]; float cst[8]; bool tz;
#define S1_LOAD(tc_, hp_) do { const int _hh = 2 * (hp_) + grp, _cc = _hh * 64 + (gt & 63), _t0 = ((tc_) % NCHK) * CK + 8 * (gt >> 6); \
        const size_t _pr = ((size_t)_hh * M + (size_t)((tc_) / NCHK) * T + _t0) * 64 + (gt & 63); tz = _t0 > 0; const size_t _pp = tz ? _pr - 64 : _pr; \
        cr[0] = __builtin_nontemporal_load(P + _pp); ck[0] = __builtin_nontemporal_load(P + _pp + 8 * PL_SZ); cv[0] = __builtin_nontemporal_load(P + _pp + 16 * PL_SZ); \
        _Pragma("unroll") for (int _i = 0; _i < 8; ++_i) { cr[_i + 1] = __builtin_nontemporal_load(P + _pr + (size_t)_i * 64); ck[_i + 1] = __builtin_nontemporal_load(P + _pr + (size_t)_i * 64 + 8 * PL_SZ); cv[_i + 1] = __builtin_nontemporal_load(P + _pr + (size_t)_i * 64 + 16 * PL_SZ); } \
        cst[0] = mu[_cc]; cst[1] = mu[512 + _cc]; cst[2] = mu[1024 + _cc]; cst[3] = w0[_cc]; cst[4] = a0[_cc]; cst[5] = k_k[_cc]; cst[6] = k_a[_cc]; cst[7] = r_k[_cc]; } while (0)
    bf16x8 lwf[8];
#define LW_LOAD(hp_) do { const bf16* _lw = LW + (size_t)((2 * (hp_) + grp) * 64 + 32 * (w4 & 1) + r) * 256 + 8 * h + (w4 < 2 ? 0 : 128); \
        _Pragma("unroll") for (int _q = 0; _q < 8; ++_q) lwf[_q] = *(const bf16x8*)(_lw + 16 * _q); } while (0)
    S1_LOAD(F.vcu, 0);
    LW_LOAD(0);
    u32x4 sa_c[2], sa_p[2]; float sa_mu[2][8];
#pragma unroll
    for (int q8 = 0; q8 < 2; ++q8)
#pragma unroll
        for (int j = 0; j < 8; ++j) sa_mu[q8][j] = mu[1536 + (F.tid & 15) * 16 + 8 * q8 + j];
#define SA_LOAD(tc_) do { const int _tk = F.tid >> 4, _t = ((tc_) % NCHK) * CK + _tk; const size_t _row = (size_t)((tc_) / NCHK) * T + _t; \
        _Pragma("unroll") for (int _q = 0; _q < 2; ++_q) { const size_t _o = P_LORA + _row * 256 + (F.tid & 15) * 16 + 8 * _q; \
            sa_c[_q] = __builtin_nontemporal_load((const u32x4*)(P + _o)); sa_p[_q] = __builtin_nontemporal_load((const u32x4*)(P + (_t > 0 ? _o - 256 : _o))); } } while (0)
    SA_LOAD(F.vcu);
    for (int tc = F.vcu; tc < M / CK; tc += F.G) {
        const int b = tc / NCHK, c = tc % NCHK, t0 = c * CK, row0 = b * T + t0;
        lds_barrier();
        { const int tk = F.tid >> 4, cb = (F.tid & 15) * 16; float x[8];
#pragma unroll
            for (int q8 = 0; q8 < 2; ++q8) { const int col = cb + 8 * q8;
                { const u32x4 c_ = sa_c[q8], p_ = (t0 + tk > 0) ? sa_p[q8] : (u32x4){0u, 0u, 0u, 0u};
                    const float cf[8] = {bflo(c_.x), bfhi(c_.x), bflo(c_.y), bfhi(c_.y), bflo(c_.z), bfhi(c_.z), bflo(c_.w), bfhi(c_.w)};
                    const float pf[8] = {bflo(p_.x), bfhi(p_.x), bflo(p_.y), bfhi(p_.y), bflo(p_.z), bfhi(p_.z), bflo(p_.w), bfhi(p_.w)};
#pragma unroll
                    for (int j = 0; j < 8; ++j) x[j] = cf[j] + (pf[j] - cf[j]) * sa_mu[q8][j]; }
                if (col < 64) {
#pragma unroll
                    for (int j = 0; j < 8; ++j) x[j] = 2.f * sigmoidf_(2.f * x[j]) - 1.f; }
                else if (col >= 128) {
#pragma unroll
                    for (int j = 0; j < 8; ++j) x[j] = sigmoidf_(x[j]); }
                *(LAS bf16x8*)(LA + tk * LAS_STRIDE + col) = pack8(x); }
            const int ntc = (tc + F.G < M / CK) ? tc + F.G : tc; SA_LOAD(ntc); }
#pragma unroll 1
        for (int hp = 0; hp < 4; ++hp) {
            const int hh = 2 * hp + grp, bh = b * RH + hh, chunk = bh * NCHK + c;
            lds_barrier();
            { const int ct = w4 & 1;
                if (w4 < 2) {
                    f32x16 aw = zero16(), aa = zero16();
#pragma unroll
                    for (int ks = 0; ks < 4; ++ks) { aw = MFMA32(rd_nat(LA, LAS_STRIDE, r, 16 * ks + 8 * h), lwf[ks], aw); aa = MFMA32(rd_nat(LA, LAS_STRIDE, r, 64 + 16 * ks + 8 * h), lwf[4 + ks], aa); }
#pragma unroll
                    for (int i = 0; i < 16; ++i) { lwo_w[crow(i, h) * 64 + 32 * ct + r] = aw[i]; lwo_a[crow(i, h) * 64 + 32 * ct + r] = aa[i]; }
                } else {
                    f32x16 ag = zero16();
#pragma unroll
                    for (int ks = 0; ks < 8; ++ks) ag = MFMA32(rd_nat(LA, LAS_STRIDE, r, 128 + 16 * ks + 8 * h), lwf[ks], ag);
#pragma unroll
                    for (int i = 0; i < 16; ++i) G[(size_t)(row0 + crow(i, h)) * 512 + hh * 64 + 32 * ct + r] = (bf16)f2bf(ag[i]); } }
            LW_LOAD((hp + 1) & 3);
            lds_barrier();
            auto st1 = [&]() { const int k = gt & 63, tq = gt >> 6, cc = hh * 64 + k;
                float wv[8], kkv[8], bv[8], kv[8], rv[8], vv[8], lp[8];
                { const float mur = cst[0], muk = cst[1], muv = cst[2], w0c = cst[3], a0c = cst[4], kkc = cst[5], kac = cst[6], rkc = cst[7];
                    const int tl0 = 8 * tq;
                    if (!tz) { cr[0] = 0; ck[0] = 0; cv[0] = 0; }
                    float lw_[8], la_[8];
#pragma unroll
                    for (int i = 0; i < 8; ++i) { lw_[i] = lwo_w[(tl0 + i) * 64 + k]; la_[i] = lwo_a[(tl0 + i) * 64 + k]; }
                    float kk[8], ssq[8], bo[8], av[8];
#pragma unroll
                    for (int i = 0; i < 8; ++i) { const float c_r = bf2f(cr[i + 1]), c_k = bf2f(ck[i + 1]), c_v = bf2f(cv[i + 1]);
                        rv[i] = c_r + (bf2f(cr[i]) - c_r) * mur; const float kr = c_k + (bf2f(ck[i]) - c_k) * muk; vv[i] = c_v + (bf2f(cv[i]) - c_v) * muv;
                        wv[i] = __expf(-0.60653066f * sigmoidf_(w0c + lw_[i])); av[i] = sigmoidf_(a0c + la_[i]);
                        kk[i] = kr * kkc; ssq[i] = kk[i] * kk[i]; kv[i] = kr * (1.f + (av[i] - 1.f) * kac); bo[i] = rv[i] * kv[i] * rkc; }
#pragma unroll
                    for (int i = 0; i < 8; ++i) { ssq[i] = reduce16(ssq[i]); bo[i] = reduce16(bo[i]); }
#pragma unroll
                    for (int i = 0; i < 8; ++i) { ssq[i] += __shfl_xor(ssq[i], 16); bo[i] += __shfl_xor(bo[i], 16); }
#pragma unroll
                    for (int i = 0; i < 8; ++i) { ssq[i] += __shfl_xor(ssq[i], 32); bo[i] += __shfl_xor(bo[i], 32); }
#pragma unroll
                    for (int i = 0; i < 8; ++i) { kkv[i] = kk[i] * __builtin_amdgcn_rcpf(fmaxf(sqrtf(ssq[i]), 1e-12f)); bv[i] = kkv[i] * av[i];
                        ((bf16*)SV)[((size_t)bh * T + t0 + tl0 + i) * 64 + k] = (bf16)f2bf(vv[i]);
                        if (k == 0) BON[(row0 + tl0 + i) * 8 + hh] = bo[i]; } }
                lp[0] = wv[0];
#pragma unroll
                for (int i = 1; i < 8; ++i) lp[i] = lp[i - 1] * wv[i];
                gtot[tq * 64 + k] = lp[7];
                lds_barrier();
                const float g0 = gtot[k], g1 = gtot[64 + k], g2 = gtot[128 + k], g3 = gtot[192 + k];
                const float pre = tq == 0 ? 1.f : (tq == 1 ? g0 : (tq == 2 ? g0 * g1 : g0 * g1 * g2)), gC = (g0 * g1) * (g2 * g3);
                float at[8], bh8[8], kh8[8];
#pragma unroll
                for (int i = 0; i < 8; ++i) { const float g = pre * lp[i], gp = i == 0 ? pre : pre * lp[i - 1], ig = __builtin_amdgcn_rcpf(g);
                    const float bt = bv[i] * ig, kt = kv[i] * ig; at[i] = -kkv[i] * gp; bh8[i] = bt * gC; kh8[i] = kt * gC;
                    const int ro = (8 * tq + i) * RMS + k;
                    iA[ro] = (bf16)f2bf(at[i]); iB[ro] = (bf16)f2bf(bt); iK[ro] = (bf16)f2bf(kt); iR[ro] = (bf16)f2bf(rv[i] * g); }
                *(LAS bf16x8*)(iAT + k * TRS + 8 * tq) = pack8(at); *(LAS bf16x8*)(iBHT + k * TRS + 8 * tq) = pack8(bh8); *(LAS bf16x8*)(iKHT + k * TRS + 8 * tq) = pack8(kh8);
                *(LAS bf16x8*)(iVT + k * TRS + 8 * tq) = pack8(vv);
                if (tq == 0) gcv[k] = gC; };
            st1();
#if MK_DUP & 2
            lds_barrier(); asm volatile("" ::: "memory"); st1();
#endif
            { const int ntc = (hp < 3) ? tc : (tc + F.G < M / CK ? tc + F.G : tc), nhp = (hp < 3) ? hp + 1 : 0; S1_LOAD(ntc, nhp); }
            lds_barrier();
            f32x16 lak = zero16();
            { const LAS bf16* ia = (w4 < 2) ? iA : (w4 == 2 ? iB : iK); const LAS bf16* ib = (w4 == 0) ? iB : (w4 == 1 ? iK : iR);
                f32x16 acc = zero16();
#pragma unroll
                for (int ks = 0; ks < 4; ++ks) acc = MFMA32(rd_nat(ia, RMS, r, 16 * ks + 8 * h), rd_nat(ib, RMS, r, 16 * ks + 8 * h), acc);
#pragma unroll
                for (int i = 0; i < 16; ++i) { const int row = crow(i, h); const bool keep = (w4 < 2) ? (r < row) : (row <= r); acc[i] = keep ? acc[i] : 0.f; }
                if (w4 <= 1) lak = acc;
                else if (w4 == 2) { fnrb[lane] = pack_acc<0>(acc); fnrb[64 + lane] = pack_acc<1>(acc); }
                else {
#pragma unroll
                    for (int i = 0; i < 16; ++i) cnrk[i * 64 + lane] = acc[i]; } }
            lds_barrier();
            auto st3 = [&]() { if (w4 == 0) {
                LAS bf16* imgL = (LAS bf16*)(gl + CL_L);
                f32x16 Lp = lak, Tq = lak;
#pragma unroll
                for (int i = 0; i < 16; ++i) Tq[i] += (crow(i, h) == r) ? 1.f : 0.f;
#pragma unroll
                for (int st = 0; st < 4; ++st) {
#pragma unroll
                    for (int i = 0; i < 16; ++i) { imgL[crow(i, h) * TRS + r] = (bf16)f2bf(Lp[i]); Tm[crow(i, h) * TRS + r] = (bf16)f2bf(Tq[i]); }
                    asm volatile("s_waitcnt lgkmcnt(0)" ::: "memory");
                    const bf16x8 b0 = pack_acc<0>(Lp), b1 = pack_acc<1>(Lp);
                    f32x16 l2 = zero16(); l2 = MFMA32(rd_perm(imgL, TRS, r, 0, h), b0, l2); l2 = MFMA32(rd_perm(imgL, TRS, r, 16, h), b1, l2);
                    Lp = l2;
                    f32x16 mm = l2;
#pragma unroll
                    for (int i = 0; i < 16; ++i) mm[i] += (crow(i, h) == r) ? 1.f : 0.f;
                    const bf16x8 m0 = pack_acc<0>(mm), m1 = pack_acc<1>(mm);
                    f32x16 t2 = zero16(); t2 = MFMA32(rd_perm(Tm, TRS, r, 0, h), m0, t2); t2 = MFMA32(rd_perm(Tm, TRS, r, 16, h), m1, t2);
                    Tq = t2;
                    asm volatile("s_waitcnt lgkmcnt(0)" ::: "memory"); }
#pragma unroll
                for (int i = 0; i < 16; ++i) Tm[crow(i, h) * TRS + r] = (bf16)f2bf(Tq[i]); } };
            st3();
#if MK_DUP & 4
            asm volatile("" ::: "memory"); st3();
#endif
            lds_barrier();
            auto st4 = [&]() { if (w4 == 0 || w4 == 2) { const int a = w4 >> 1;
                f32x16 x1 = zero16();
#pragma unroll
                for (int ks = 0; ks < 2; ++ks) x1 = MFMA32(rd_nat(Tm, TRS, r, 16 * ks + 8 * h), rd_nat(iAT, TRS, 32 * a + r, 16 * ks + 8 * h), x1);
                const bf16x8 xf0 = pack_acc<0>(x1), xf1 = pack_acc<1>(x1);
#pragma unroll
                for (int b = 0; b < 2; ++b) { f32x16 p = zero16();
                    p = MFMA32(xf0, rd_perm(iBHT, TRS, 32 * b + r, 0, h), p); p = MFMA32(xf1, rd_perm(iBHT, TRS, 32 * b + r, 16, h), p);
                    if (a == b) { const float gc = gcv[32 * a + r];
#pragma unroll
                        for (int i = 0; i < 16; ++i) p[i] += (crow(i, h) == r) ? gc : 0.f; }
                    bf16x8* dst = PT + ((size_t)(chunk * 2 + a) * 2 + b) * 2 * 64 + lane; dst[0] = pack_acc<0>(p); dst[64] = pack_acc<1>(p); }
                f32x16 ry;
#pragma unroll
                for (int g = 0; g < 4; ++g) { const u32x2 rr = *(const LAS u32x2*)(iR + r * RMS + 32 * a + 8 * g + 4 * h);
                    ry[4 * g] = bflo(rr.x); ry[4 * g + 1] = bfhi(rr.x); ry[4 * g + 2] = bflo(rr.y); ry[4 * g + 3] = bfhi(rr.y); }
                ry = MFMA32(xf0, fnrb[lane], ry); ry = MFMA32(xf1, fnrb[64 + lane], ry);
                bf16x8* dr = RYT + (size_t)(chunk * 2 + a) * 2 * 64 + lane; dr[0] = pack_acc<0>(ry); dr[64] = pack_acc<1>(ry);
            } else if (w4 == 1) {
                f32x16 x2 = zero16();
                x2 = MFMA32(rd_perm(Tm, TRS, r, 0, h), pack_acc<0>(lak), x2); x2 = MFMA32(rd_perm(Tm, TRS, r, 16, h), pack_acc<1>(lak), x2);
                const bf16x8 xf0 = pack_acc<0>(x2), xf1 = pack_acc<1>(x2);
#pragma unroll
                for (int b = 0; b < 2; ++b) { f32x16 qm;
#pragma unroll
                    for (int g = 0; g < 4; ++g) { const u32x2 kk2 = *(const LAS u32x2*)(iKHT + (32 * b + r) * TRS + 8 * g + 4 * h);
                        qm[4 * g] = bflo(kk2.x); qm[4 * g + 1] = bfhi(kk2.x); qm[4 * g + 2] = bflo(kk2.y); qm[4 * g + 3] = bfhi(kk2.y); }
                    qm = MFMA32(xf0, rd_perm(iBHT, TRS, 32 * b + r, 0, h), qm); qm = MFMA32(xf1, rd_perm(iBHT, TRS, 32 * b + r, 16, h), qm);
                    fqm[(b * 2 + 0) * 64 + lane] = pack_acc<0>(qm); fqm[(b * 2 + 1) * 64 + lane] = pack_acc<1>(qm); }
                f32x16 gy;
#pragma unroll
                for (int i = 0; i < 16; ++i) gy[i] = cnrk[i * 64 + lane];
                gy = MFMA32(xf0, fnrb[lane], gy); gy = MFMA32(xf1, fnrb[64 + lane], gy);
                const bf16x8 gf0 = pack_acc<0>(gy), gf1 = pack_acc<1>(gy);
#pragma unroll
                for (int vh = 0; vh < 2; ++vh) { f32x16 yv = zero16();
                    yv = MFMA32(rd_perm(iVT, TRS, 32 * vh + r, 0, h), gf0, yv); yv = MFMA32(rd_perm(iVT, TRS, 32 * vh + r, 16, h), gf1, yv);
                    bf16x8* dy = (bf16x8*)YVT + ((size_t)(chunk * 2 + vh) * 64 + lane) * 2;
                    dy[0] = pack_acc<0>(yv); dy[1] = pack_acc<1>(yv); }
            } };
            st4();
#if MK_DUP & 8
            asm volatile("" ::: "memory"); st4();
#endif
            lds_barrier();
            if (w4 == 3) {
#pragma unroll
                for (int b = 0; b < 2; ++b)
#pragma unroll
                    for (int vh = 0; vh < 2; ++vh) { f32x16 zv = zero16();
                        zv = MFMA32(fqm[(b * 2 + 0) * 64 + lane], rd_perm(iVT, TRS, 32 * vh + r, 0, h), zv); zv = MFMA32(fqm[(b * 2 + 1) * 64 + lane], rd_perm(iVT, TRS, 32 * vh + r, 16, h), zv);
                        bf16x8* dz = (bf16x8*)ZV + (((size_t)(chunk * 2 + b) * 2 + vh) * 64 + lane) * 2;
                        dz[0] = pack_acc<0>(zv); dz[1] = pack_acc<1>(zv); }
            }
        }
    }
#undef S1_LOAD
#undef LW_LOAD
#undef SA_LOAD
}
constexpr int WRS = 68, WTS = 36;
constexpr int WL_A = 0, WL_B = 4352, WL_K = 8704, WL_R = 13056, WL_AT = 17408, WL_BHT = 22016, WL_KHT = 26624, WL_VT = 31232, WL_SIZE = 35840, WL_LA = 4 * WL_SIZE;
static_assert(WL_LA + 32 * LAS_STRIDE * 2 <= MISC_OFF, "wave-per-chunk LDS map");
__device__ __forceinline__ bf16x8 rd_nat2(const LAS bf16* img, int stride, int row, int k0) {
    const u32x2 lo = *(const LAS u32x2*)(img + row * stride + k0), hi = *(const LAS u32x2*)(img + row * stride + k0 + 4);
    u32x4 w; w.x = lo.x; w.y = lo.y; w.z = hi.x; w.w = hi.y; return __builtin_bit_cast(bf16x8, w);
}
__device__ __forceinline__ void phase4a_wave(const Frame& F) {
    const bf16* P = wsp<bf16>(F, WS_P); const bf16* LW = wsp<bf16>(F, WS_LW);
    const float* mu = F.in[6]; const float* w0 = F.in[7]; const float* a0 = F.in[9]; const float* k_k = F.in[12]; const float* k_a = F.in[13]; const float* r_k = F.in[14];
    float* SV = wsp<float>(F, WS_SV); bf16* G = wsp<bf16>(F, WS_G); float* BON = wsp<float>(F, WS_BONUS);
    bf16x8* PT = wsp<bf16x8>(F, WS_PT); f32x4* ZV = wsp<f32x4>(F, WS_ZV); bf16x8* RYT = wsp<bf16x8>(F, WS_RYT); f32x4* YVT = wsp<f32x4>(F, WS_YVT);
    const int wv_ = F.wave & 3;
    LAS unsigned char* gl = F.lds + wv_ * WL_SIZE;
    LAS bf16* iA = (LAS bf16*)(gl + WL_A); LAS bf16* iB = (LAS bf16*)(gl + WL_B); LAS bf16* iK = (LAS bf16*)(gl + WL_K); LAS bf16* iR = (LAS bf16*)(gl + WL_R);
    LAS bf16* iAT = (LAS bf16*)(gl + WL_AT); LAS bf16* iBHT = (LAS bf16*)(gl + WL_BHT); LAS bf16* iKHT = (LAS bf16*)(gl + WL_KHT); LAS bf16* iVT = (LAS bf16*)(gl + WL_VT);
    LAS bf16* imgL = iA; LAS bf16* Tm = iB;
    LAS bf16* LA = (LAS bf16*)(F.lds + WL_LA);
    for (int tc = F.vcu; tc < M / CK; tc += F.G) {
        const int b = tc / NCHK, c = tc % NCHK, t0 = c * CK, row0 = b * T + t0;
        lds_barrier();
        { const int tk = F.tid >> 4, cb = (F.tid & 15) * 16; float x[8];
#pragma unroll
            for (int q8 = 0; q8 < 2; ++q8) { const int col = cb + 8 * q8; lerp8(P, mu, row0 + tk, t0 + tk, 1536 + col, x);
                if (col < 64) {
#pragma unroll
                    for (int j = 0; j < 8; ++j) x[j] = 2.f * sigmoidf_(2.f * x[j]) - 1.f; }
                else if (col >= 128) {
#pragma unroll
                    for (int j = 0; j < 8; ++j) x[j] = sigmoidf_(x[j]); }
                *(LAS bf16x8*)(LA + tk * LAS_STRIDE + col) = pack8(x); } }
        lds_barrier();
        if (F.wave < 4) {
#pragma unroll 1
        for (int rnd = 0; rnd < 2; ++rnd) {
            int lane = F.lane; asm volatile("" : "+v"(lane));
            const int r = lane & 31, h = lane >> 5;
            const int hh = wv_ + 4 * rnd, bh = b * RH + hh, chunk = bh * NCHK + c, cc = hh * 64 + lane;
            f32x16 aw[2], aa[2];
#pragma unroll
            for (int ct = 0; ct < 2; ++ct) { const bf16* lw = LW + (size_t)(hh * 64 + 32 * ct + r) * 256 + 8 * h;
                { bf16x8 bf_[8];
#pragma unroll
                    for (int ks = 0; ks < 8; ++ks) bf_[ks] = *(const bf16x8*)(lw + 128 + 16 * ks);
                    f32x16 g_ = zero16();
#pragma unroll
                    for (int ks = 0; ks < 8; ++ks) g_ = MFMA32(rd_nat(LA, LAS_STRIDE, r, 128 + 16 * ks + 8 * h), bf_[ks], g_);
#pragma unroll
                    for (int i = 0; i < 16; ++i) if (MK_WMASK & 1) G[(size_t)(row0 + crow(i, h)) * 512 + hh * 64 + 32 * ct + r] = (bf16)f2bf(g_[i]); }
                { bf16x8 bf_[8];
#pragma unroll
                    for (int ks = 0; ks < 8; ++ks) bf_[ks] = *(const bf16x8*)(lw + 16 * ks);
                    f32x16 w_ = zero16(), a_ = zero16();
#pragma unroll
                    for (int ks = 0; ks < 4; ++ks) { w_ = MFMA32(rd_nat(LA, LAS_STRIDE, r, 16 * ks + 8 * h), bf_[ks], w_); a_ = MFMA32(rd_nat(LA, LAS_STRIDE, r, 64 + 16 * ks + 8 * h), bf_[4 + ks], a_); }
                    aw[ct] = w_; aa[ct] = a_; } }
            f32x16 wo, wr_, ao, ar_;
#pragma unroll
            for (int i = 0; i < 16; ++i) { wo[i] = h ? aw[1][i] : aw[0][i]; ao[i] = h ? aa[1][i] : aa[0][i];
                wr_[i] = __shfl_xor(h ? aw[0][i] : aw[1][i], 32); ar_[i] = __shfl_xor(h ? aa[0][i] : aa[1][i], 32); }
            const float mur = mu[cc], muk = mu[512 + cc], muv = mu[1024 + cc], w0c = w0[cc], a0c = a0[cc], kkc = k_k[cc], kac = k_a[cc], rkc = r_k[cc];
            float gam[32];
#pragma unroll
            for (int t = 0; t < 32; ++t) { const int i = (t & 3) + 4 * (t >> 3); const float wl = (((t >> 2) & 1) == h) ? wo[i] : wr_[i];
                const float dec = __expf(-0.60653066f * sigmoidf_(w0c + wl)); gam[t] = t ? gam[t - 1] * dec : dec; }
            const float gC = gam[31];
            const size_t pbase = (size_t)row0 * IN_COLS + cc;
            bf16 pr_ = 0, pk_ = 0, pv_ = 0;
            if (t0 > 0) { pr_ = P[pbase - IN_COLS]; pk_ = P[pbase - IN_COLS + 512]; pv_ = P[pbase - IN_COLS + 1024]; }
#pragma unroll
            for (int tb = 0; tb < 4; ++tb) {
                asm volatile("" ::: "memory");
                bf16 cr[8], ck[8], cv[8];
#pragma unroll
                for (int i = 0; i < 8; ++i) { const size_t o = pbase + (size_t)(8 * tb + i) * IN_COLS; cr[i] = P[o]; ck[i] = P[o + 512]; cv[i] = P[o + 1024]; }
                float rv[8], vv[8], kk[8], ssq[8], bo[8], av[8], kv[8];
#pragma unroll
                for (int i = 0; i < 8; ++i) { const int t = 8 * tb + i, ii = (t & 3) + 4 * (t >> 3);
                    const float c_r = bf2f(cr[i]), c_k = bf2f(ck[i]), c_v = bf2f(cv[i]);
                    const float p_r = bf2f(i ? cr[i - 1] : pr_), p_k = bf2f(i ? ck[i - 1] : pk_), p_v = bf2f(i ? cv[i - 1] : pv_);
                    rv[i] = c_r + (p_r - c_r) * mur; const float kr = c_k + (p_k - c_k) * muk; vv[i] = c_v + (p_v - c_v) * muv;
                    const float al = (((t >> 2) & 1) == h) ? ao[ii] : ar_[ii];
                    av[i] = sigmoidf_(a0c + al);
                    kk[i] = kr * kkc; ssq[i] = kk[i] * kk[i]; kv[i] = kr * (1.f + (av[i] - 1.f) * kac); bo[i] = rv[i] * kv[i] * rkc; }
                pr_ = cr[7]; pk_ = ck[7]; pv_ = cv[7];
#pragma unroll
                for (int i = 0; i < 8; ++i) { ssq[i] = reduce16(ssq[i]); bo[i] = reduce16(bo[i]); }
#pragma unroll
                for (int i = 0; i < 8; ++i) { ssq[i] += __shfl_xor(ssq[i], 16); bo[i] += __shfl_xor(bo[i], 16); }
#pragma unroll
                for (int i = 0; i < 8; ++i) { ssq[i] += __shfl_xor(ssq[i], 32); bo[i] += __shfl_xor(bo[i], 32); }
                float at[8], bh8[8], kh8[8];
#pragma unroll
                for (int i = 0; i < 8; ++i) { const int t = 8 * tb + i;
                    const float kkn = kk[i] * __builtin_amdgcn_rcpf(fmaxf(sqrtf(ssq[i]), 1e-12f)), bb = kkn * av[i];
                    const float g = gam[t], gp = t ? gam[t - 1] : 1.f, ig = __builtin_amdgcn_rcpf(g);
                    const float bt = bb * ig, kt = kv[i] * ig; at[i] = -kkn * gp; bh8[i] = bt * gC; kh8[i] = kt * gC;
                    const int ro = t * WRS + lane;
                    iA[ro] = (bf16)f2bf(at[i]); iB[ro] = (bf16)f2bf(bt); iK[ro] = (bf16)f2bf(kt); iR[ro] = (bf16)f2bf(rv[i] * g);
                    if (MK_WMASK & 2) { ((bf16*)SV)[((size_t)bh * T + t0 + t) * 64 + lane] = (bf16)f2bf(vv[i]);
                    if (lane == 0) BON[(row0 + t) * 8 + hh] = bo[i]; } }
#pragma unroll
                for (int q = 0; q < 2; ++q) { u32x2 w;
                    w.x = pk2(at[4 * q], at[4 * q + 1]); w.y = pk2(at[4 * q + 2], at[4 * q + 3]); *(LAS u32x2*)(iAT + lane * WTS + 8 * tb + 4 * q) = w;
                    w.x = pk2(bh8[4 * q], bh8[4 * q + 1]); w.y = pk2(bh8[4 * q + 2], bh8[4 * q + 3]); *(LAS u32x2*)(iBHT + lane * WTS + 8 * tb + 4 * q) = w;
                    w.x = pk2(kh8[4 * q], kh8[4 * q + 1]); w.y = pk2(kh8[4 * q + 2], kh8[4 * q + 3]); *(LAS u32x2*)(iKHT + lane * WTS + 8 * tb + 4 * q) = w;
                    w.x = pk2(vv[4 * q], vv[4 * q + 1]); w.y = pk2(vv[4 * q + 2], vv[4 * q + 3]); *(LAS u32x2*)(iVT + lane * WTS + 8 * tb + 4 * q) = w; }
            }
            asm volatile("s_waitcnt lgkmcnt(0)" ::: "memory");
            f32x16 lab = zero16(), lak = zero16(), nrb = zero16(), nrk = zero16();
#pragma unroll
            for (int ks = 0; ks < 4; ++ks) { const bf16x8 fa = rd_nat2(iA, WRS, r, 16 * ks + 8 * h), fb = rd_nat2(iB, WRS, r, 16 * ks + 8 * h), fk = rd_nat2(iK, WRS, r, 16 * ks + 8 * h), fr_ = rd_nat2(iR, WRS, r, 16 * ks + 8 * h);
                lab = MFMA32(fa, fb, lab); lak = MFMA32(fa, fk, lak); nrb = MFMA32(fb, fr_, nrb); nrk = MFMA32(fk, fr_, nrk); }
#pragma unroll
            for (int i = 0; i < 16; ++i) { const int row = crow(i, h); lab[i] = (r < row) ? lab[i] : 0.f; lak[i] = (r < row) ? lak[i] : 0.f; nrb[i] = (row <= r) ? nrb[i] : 0.f; nrk[i] = (row <= r) ? nrk[i] : 0.f; }
            const bf16x8 fn0 = pack_acc<0>(nrb), fn1 = pack_acc<1>(nrb);
            asm volatile("s_waitcnt lgkmcnt(0)" ::: "memory");
            { f32x16 Lp = lab, Tq = lab;
#pragma unroll
                for (int i = 0; i < 16; ++i) Tq[i] += (crow(i, h) == r) ? 1.f : 0.f;
#pragma unroll
                for (int st = 0; st < 4; ++st) {
#pragma unroll
                    for (int i = 0; i < 16; ++i) { imgL[crow(i, h) * WTS + r] = (bf16)f2bf(Lp[i]); Tm[crow(i, h) * WTS + r] = (bf16)f2bf(Tq[i]); }
                    asm volatile("s_waitcnt lgkmcnt(0)" ::: "memory");
                    const bf16x8 b0 = pack_acc<0>(Lp), b1 = pack_acc<1>(Lp);
                    f32x16 l2 = zero16(); l2 = MFMA32(rd_perm(imgL, WTS, r, 0, h), b0, l2); l2 = MFMA32(rd_perm(imgL, WTS, r, 16, h), b1, l2);
                    Lp = l2;
                    f32x16 mm = l2;
#pragma unroll
                    for (int i = 0; i < 16; ++i) mm[i] += (crow(i, h) == r) ? 1.f : 0.f;
                    const bf16x8 m0 = pack_acc<0>(mm), m1 = pack_acc<1>(mm);
                    f32x16 t2 = zero16(); t2 = MFMA32(rd_perm(Tm, WTS, r, 0, h), m0, t2); t2 = MFMA32(rd_perm(Tm, WTS, r, 16, h), m1, t2);
                    Tq = t2;
                    asm volatile("s_waitcnt lgkmcnt(0)" ::: "memory"); }
#pragma unroll
                for (int i = 0; i < 16; ++i) Tm[crow(i, h) * WTS + r] = (bf16)f2bf(Tq[i]);
                asm volatile("s_waitcnt lgkmcnt(0)" ::: "memory"); }
            const float gcd2[2] = {__shfl(gC, r), __shfl(gC, 32 + r)};
#pragma unroll
            for (int a = 0; a < 2; ++a) { f32x16 x1 = zero16();
#pragma unroll
                for (int ks = 0; ks < 2; ++ks) x1 = MFMA32(rd_nat2(Tm, WTS, r, 16 * ks + 8 * h), rd_nat2(iAT, WTS, 32 * a + r, 16 * ks + 8 * h), x1);
                const bf16x8 xf0 = pack_acc<0>(x1), xf1 = pack_acc<1>(x1);
#pragma unroll
                for (int b2 = 0; b2 < 2; ++b2) { f32x16 p = zero16();
                    p = MFMA32(xf0, rd_perm(iBHT, WTS, 32 * b2 + r, 0, h), p); p = MFMA32(xf1, rd_perm(iBHT, WTS, 32 * b2 + r, 16, h), p);
                    if (a == b2) { const float gcd = gcd2[a];
#pragma unroll
                        for (int i = 0; i < 16; ++i) p[i] += (crow(i, h) == r) ? gcd : 0.f; }
                    bf16x8* dst = PT + ((size_t)(chunk * 2 + a) * 2 + b2) * 2 * 64 + lane; if (MK_WMASK & 4) { dst[0] = pack_acc<0>(p); dst[64] = pack_acc<1>(p); } }
                f32x16 ry;
#pragma unroll
                for (int g = 0; g < 4; ++g) { const u32x2 rr = *(const LAS u32x2*)(iR + r * WRS + 32 * a + 8 * g + 4 * h);
                    ry[4 * g] = bflo(rr.x); ry[4 * g + 1] = bfhi(rr.x); ry[4 * g + 2] = bflo(rr.y); ry[4 * g + 3] = bfhi(rr.y); }
                ry = MFMA32(xf0, fn0, ry); ry = MFMA32(xf1, fn1, ry);
                bf16x8* dr = RYT + (size_t)(chunk * 2 + a) * 2 * 64 + lane; if (MK_WMASK & 8) { dr[0] = pack_acc<0>(ry); dr[64] = pack_acc<1>(ry); } }
            { f32x16 x2 = zero16();
                x2 = MFMA32(rd_perm(Tm, WTS, r, 0, h), pack_acc<0>(lak), x2); x2 = MFMA32(rd_perm(Tm, WTS, r, 16, h), pack_acc<1>(lak), x2);
                const bf16x8 xf0 = pack_acc<0>(x2), xf1 = pack_acc<1>(x2);
                bf16x8 fq[2][2];
#pragma unroll
                for (int b2 = 0; b2 < 2; ++b2) { f32x16 qm;
#pragma unroll
                    for (int g = 0; g < 4; ++g) { const u32x2 kk2 = *(const LAS u32x2*)(iKHT + (32 * b2 + r) * WTS + 8 * g + 4 * h);
                        qm[4 * g] = bflo(kk2.x); qm[4 * g + 1] = bfhi(kk2.x); qm[4 * g + 2] = bflo(kk2.y); qm[4 * g + 3] = bfhi(kk2.y); }
                    qm = MFMA32(xf0, rd_perm(iBHT, WTS, 32 * b2 + r, 0, h), qm); qm = MFMA32(xf1, rd_perm(iBHT, WTS, 32 * b2 + r, 16, h), qm);
                    fq[b2][0] = pack_acc<0>(qm); fq[b2][1] = pack_acc<1>(qm); }
                f32x16 gy = nrk;
                gy = MFMA32(xf0, fn0, gy); gy = MFMA32(xf1, fn1, gy);
                const bf16x8 gf0 = pack_acc<0>(gy), gf1 = pack_acc<1>(gy);
#pragma unroll
                for (int vh = 0; vh < 2; ++vh) { f32x16 yv = zero16();
                    yv = MFMA32(rd_perm(iVT, WTS, 32 * vh + r, 0, h), gf0, yv); yv = MFMA32(rd_perm(iVT, WTS, 32 * vh + r, 16, h), gf1, yv);
                    bf16x8* dy = (bf16x8*)YVT + ((size_t)(chunk * 2 + vh) * 64 + lane) * 2;
                    if (MK_WMASK & 16) { dy[0] = pack_acc<0>(yv); dy[1] = pack_acc<1>(yv); } }
#pragma unroll
                for (int b2 = 0; b2 < 2; ++b2)
#pragma unroll
                    for (int vh = 0; vh < 2; ++vh) { f32x16 zv = zero16();
                        zv = MFMA32(fq[b2][0], rd_perm(iVT, WTS, 32 * vh + r, 0, h), zv); zv = MFMA32(fq[b2][1], rd_perm(iVT, WTS, 32 * vh + r, 16, h), zv);
                        bf16x8* dz = (bf16x8*)ZV + (((size_t)(chunk * 2 + b2) * 2 + vh) * 64 + lane) * 2;
                        if (MK_WMASK & 32) { dz[0] = pack_acc<0>(zv); dz[1] = pack_acc<1>(zv); } } }
            asm volatile("s_waitcnt lgkmcnt(0)" ::: "memory");
        }
        }
    }
}

__device__ __forceinline__ void phase5_attn_part(const Frame& F, int first, int stride);
constexpr int SB_SLOT = 16384, SB_NSLOT = 7, SB_FLAGS = SB_NSLOT * SB_SLOT;
constexpr int CONV_4B = ((MK_CONV_WHERE == 9 || MK_CONV_WHERE == 8) && !MK_ATTN_IN_4B) ? 6144 : 0;
__device__ __forceinline__ void phase4b_states(const Frame& F) {
    volatile LAS unsigned* FULL = (volatile LAS unsigned*)(F.lds + SB_FLAGS);
    volatile LAS unsigned* DONEC = (volatile LAS unsigned*)(F.lds + SB_FLAGS + 64);
    __syncthreads();
    if (F.tid < 32) ((LAS unsigned*)(F.lds + SB_FLAGS))[F.tid] = 0u;
    __syncthreads();
    if (F.vcu < 128) {
        const int bh = F.vcu >> 1, vh = F.vcu & 1, lane = F.lane;
        if (F.wave == 0) {
            bf16x8* Z0 = wsp<bf16x8>(F, WS_Z0);
            f32x16 z0 = zero16(), z1 = zero16();
            bf16x8 pf[8]; u32x4 zq[2][2];
#define SB_FETCH(c_, slot_) do { { int sp = 0; while (FULL[slot_] < (unsigned)((c_) + 1)) { if (++sp > SC_SPIN_CAP) break; } } \
                __builtin_amdgcn_fence(__ATOMIC_ACQUIRE, "workgroup"); \
                const LAS unsigned char* sb = F.lds + (slot_) * SB_SLOT; const LAS bf16x8* p = (const LAS bf16x8*)sb + lane; \
                _Pragma("unroll") for (int q = 0; q < 8; ++q) pf[q] = p[q * 64]; \
                zq[0][0] = ((const LAS u32x4*)(sb + 8192) + lane * 2)[0]; zq[0][1] = ((const LAS u32x4*)(sb + 8192) + lane * 2)[1]; \
                zq[1][0] = ((const LAS u32x4*)(sb + 10240) + lane * 2)[0]; zq[1][1] = ((const LAS u32x4*)(sb + 10240) + lane * 2)[1]; \
                asm volatile("s_waitcnt lgkmcnt(0)" ::: "memory"); \
                if (lane == 0) DONEC[0] = (unsigned)((c_) + 1); } while (0)
            SB_FETCH(0, 0);
            int slot = 0;
            for (int c = 0; c < NCHK; ++c) { const int chunk = bh * NCHK + c;
                const bf16x8 f00 = pack_acc<0>(z0), f01 = pack_acc<1>(z0), f10 = pack_acc<0>(z1), f11 = pack_acc<1>(z1);
                bf16x8* dz = Z0 + (size_t)(chunk * 2 + vh) * 4 * 64 + lane; dz[0] = f00; dz[64] = f01; dz[128] = f10; dz[192] = f11;
                f32x16 n0, n1;
#pragma unroll
                for (int q = 0; q < 2; ++q) { const u32x4 u = zq[0][q], w = zq[1][q];
                    n0[8 * q] = bflo(u.x); n0[8 * q + 1] = bfhi(u.x); n0[8 * q + 2] = bflo(u.y); n0[8 * q + 3] = bfhi(u.y); n0[8 * q + 4] = bflo(u.z); n0[8 * q + 5] = bfhi(u.z); n0[8 * q + 6] = bflo(u.w); n0[8 * q + 7] = bfhi(u.w);
                    n1[8 * q] = bflo(w.x); n1[8 * q + 1] = bfhi(w.x); n1[8 * q + 2] = bflo(w.y); n1[8 * q + 3] = bfhi(w.y); n1[8 * q + 4] = bflo(w.z); n1[8 * q + 5] = bfhi(w.z); n1[8 * q + 6] = bflo(w.w); n1[8 * q + 7] = bfhi(w.w); }
                n0 = MFMA32(pf[0], f00, n0); n1 = MFMA32(pf[2], f00, n1); n0 = MFMA32(pf[1], f01, n0); n1 = MFMA32(pf[3], f01, n1);
                n0 = MFMA32(pf[4], f10, n0); n1 = MFMA32(pf[6], f10, n1); n0 = MFMA32(pf[5], f11, n0); n1 = MFMA32(pf[7], f11, n1);
                slot = (slot + 1 == SB_NSLOT) ? 0 : slot + 1;
                if (c + 1 < NCHK) SB_FETCH(c + 1, slot);
                z0 = n0; z1 = n1; }
#undef SB_FETCH
        } else {
            const int slot = F.wave - 1;
            const unsigned char* gpt = (const unsigned char*)wsp<bf16x8>(F, WS_PT) + lane * 16;
            const unsigned char* gzv = (const unsigned char*)wsp<f32x4>(F, WS_ZV) + lane * 16;
            LAS unsigned char* dst = F.lds + slot * SB_SLOT;
            for (int c = slot; c < NCHK; c += SB_NSLOT) { const int chunk = bh * NCHK + c;
                if (c >= SB_NSLOT) { const unsigned need = (unsigned)(c - SB_NSLOT + 1); int sp = 0;
                    while (DONEC[0] < need) { __builtin_amdgcn_s_sleep(1); if (++sp > SC_SPIN_CAP) break; }
                    __builtin_amdgcn_fence(__ATOMIC_ACQUIRE, "workgroup"); }
                const unsigned char* sp_ = gpt + (size_t)chunk * 8192;
#pragma unroll
                for (int j = 0; j < 8; ++j) __builtin_amdgcn_global_load_lds((const unsigned*)(sp_ + j * 1024), (LAS unsigned*)(dst + j * 1024), 16, 0, 0);
                const unsigned char* sz0 = gzv + ((size_t)(chunk * 2 + 0) * 2 + vh) * 2048; const unsigned char* sz1 = gzv + ((size_t)(chunk * 2 + 1) * 2 + vh) * 2048;
#pragma unroll
                for (int j = 0; j < 2; ++j) { __builtin_amdgcn_global_load_lds((const unsigned*)(sz0 + j * 1024), (LAS unsigned*)(dst + 8192 + j * 1024), 16, 0, 0);
                    __builtin_amdgcn_global_load_lds((const unsigned*)(sz1 + j * 1024), (LAS unsigned*)(dst + 10240 + j * 1024), 16, 0, 0); }
                asm volatile("s_waitcnt vmcnt(0)" ::: "memory");
                if (lane == 0) FULL[slot] = (unsigned)(c + 1); }
        }
    } else {
#if MK_ATTN_IN_4B
        phase5_attn_part(F, F.vcu - 128, 128);
#else
        for (int it = (F.vcu - 128) * 8 + F.wave; it < CONV_4B; it += 128 * 8) moe_weight_item(F, it);
#endif
    }
    __syncthreads();
}

__device__ __forceinline__ void phase4c_output(const Frame& F) {
    const bf16x8* Z0 = wsp<bf16x8>(F, WS_Z0); const bf16x8* RYT = wsp<bf16x8>(F, WS_RYT); const f32x4* YVT = wsp<f32x4>(F, WS_YVT);
    const float* SV = wsp<float>(F, WS_SV); const bf16* G = wsp<bf16>(F, WS_G); const float* BON = wsp<float>(F, WS_BONUS); bf16* CAT = wsp<bf16>(F, WS_CAT);
    const float* lg = F.in[15]; const float* lb = F.in[16];
    const int gw = F.vcu * 8 + F.wave, NGW = F.G * 8, lane = F.lane, r = lane & 31, h = lane >> 5;
    for (int tc = F.vcu; tc < M / CK; tc += F.G) {
        const int b = tc / NCHK, c = tc % NCHK, hh = F.wave, bh = b * RH + hh, chunk = bh * NCHK + c, t = c * CK + r, row = b * T + t;
        bf16x8 rf[4], zf[2][4]; u32x4 yv[2][2]; u32x2 vv[2][4], gr[2][4];
#pragma unroll
        for (int q = 0; q < 4; ++q) rf[q] = __builtin_nontemporal_load(RYT + (size_t)chunk * 4 * 64 + lane + q * 64);
#pragma unroll
        for (int vh = 0; vh < 2; ++vh)
#pragma unroll
            for (int q = 0; q < 4; ++q) { if (q < 2) yv[vh][q] = __builtin_nontemporal_load((const u32x4*)YVT + ((size_t)(chunk * 2 + vh) * 64 + lane) * 2 + q);
                zf[vh][q] = __builtin_nontemporal_load(Z0 + (size_t)(chunk * 2 + vh) * 4 * 64 + lane + q * 64); }
        const float bon = BON[row * 8 + hh];
#pragma unroll
        for (int vh = 0; vh < 2; ++vh)
#pragma unroll
            for (int g = 0; g < 4; ++g) { const int v0 = 32 * vh + 8 * g + 4 * h, c0 = hh * 64 + v0;
                vv[vh][g] = __builtin_nontemporal_load((const u32x2*)((const bf16*)SV + ((size_t)bh * T + t) * 64 + v0));
                gr[vh][g] = __builtin_nontemporal_load((const u32x2*)(G + (size_t)row * 512 + c0)); }
        f32x16 y[2];
#pragma unroll
        for (int vh = 0; vh < 2; ++vh) {
#pragma unroll
            for (int q = 0; q < 2; ++q) { const u32x4 u = yv[vh][q]; y[vh][8 * q] = bflo(u.x); y[vh][8 * q + 1] = bfhi(u.x); y[vh][8 * q + 2] = bflo(u.y); y[vh][8 * q + 3] = bfhi(u.y);
                y[vh][8 * q + 4] = bflo(u.z); y[vh][8 * q + 5] = bfhi(u.z); y[vh][8 * q + 6] = bflo(u.w); y[vh][8 * q + 7] = bfhi(u.w); }
#pragma unroll
            for (int q = 0; q < 4; ++q) y[vh] = MFMA32(zf[vh][q], rf[q], y[vh]); }
        float sm = 0.f;
#pragma unroll
        for (int vh = 0; vh < 2; ++vh)
#pragma unroll
            for (int i = 0; i < 16; ++i) sm += y[vh][i];
        sm += __shfl_xor(sm, 32);
        const float mean = sm * (1.f / 64.f); float qv = 0.f;
#pragma unroll
        for (int vh = 0; vh < 2; ++vh)
#pragma unroll
            for (int i = 0; i < 16; ++i) { y[vh][i] -= mean; qv += y[vh][i] * y[vh][i]; }
        qv += __shfl_xor(qv, 32);
        const float rstd = rsqrtf(qv * (1.f / 64.f) + GN_EPS);
#pragma unroll
        for (int vh = 0; vh < 2; ++vh)
#pragma unroll
            for (int g = 0; g < 4; ++g) { const int v0 = 32 * vh + 8 * g + 4 * h, c0 = hh * 64 + v0;
                const f32x4 lg4 = *(const f32x4*)(lg + c0), lb4 = *(const f32x4*)(lb + c0);
                const float gg[4] = {bflo(gr[vh][g].x), bfhi(gr[vh][g].x), bflo(gr[vh][g].y), bfhi(gr[vh][g].y)}; float o[4];
                const float vf[4] = {bflo(vv[vh][g].x), bfhi(vv[vh][g].x), bflo(vv[vh][g].y), bfhi(vv[vh][g].y)};
#pragma unroll
                for (int q = 0; q < 4; ++q) o[q] = (y[vh][4 * g + q] * rstd * lg4[q] + lb4[q] + bon * vf[q]) * gg[q];
                u32x2 w; w.x = pk2(o[0], o[1]); w.y = pk2(o[2], o[3]);
                *(u32x2*)(CAT + (size_t)row * D + c0) = w; }
    }
}

constexpr int SC_STEPS = 16, SC_NSLOT = 6, SC_SHARED = SC_STEPS * 1280, SC_SLOT = SC_SHARED + SC_STEPS * 64, SC_RING = SC_NSLOT * SC_SLOT;
constexpr int SC_FLAGS = SC_RING, SC_CONV = SC_RING + 256, SC_NCH = T / SC_STEPS;
static_assert(SC_CONV + 3 * 8704 <= LDS_BYTES, "scan LDS map");
__device__ __forceinline__ void phase4_scan(const Frame& F) {
    volatile LAS unsigned* READY = (volatile LAS unsigned*)(F.lds + SC_FLAGS);
    volatile LAS unsigned* DONE = (volatile LAS unsigned*)(F.lds + SC_FLAGS + 64);
    __syncthreads();
    if (F.tid < 64) ((LAS unsigned*)(F.lds + SC_FLAGS))[F.tid] = 0u;
    __syncthreads();
    const int bh = F.vcu >> 2, rg = F.vcu & 3, b = bh / RH, hh = bh % RH;
    if (F.wave < 4) {
        const int rl = F.lane >> 4, ks = F.lane & 15, rowl = F.wave * 4 + rl;
        float* yp = wsp<float>(F, WS_Y) + (size_t)b * T * 512 + hh * 64 + rg * 16 + rowl;
        f32x4 S = (f32x4){0.f, 0.f, 0.f, 0.f};
        int slot = 0;
        for (int c = 0; c < SC_NCH; ++c) {
#if MK_RWKV_MODE == 1
            if ((c & 1) == 0) {
                const int v = rg * 16 + rowl, chunk = bh * NCHK + (c >> 1);
                const bf16* zp = wsp<bf16>(F, WS_Z0) + ((((size_t)chunk * 2 + (v >> 5)) * 2 + (ks >> 3)) * 2 + ((ks >> 2) & 1)) * 512 + ((v & 31) + 32 * (ks & 1)) * 8 + 4 * ((ks >> 1) & 1);
                const u32x2 zz = *(const u32x2*)zp;
                S = (f32x4){bflo(zz.x), bfhi(zz.x), bflo(zz.y), bfhi(zz.y)}; }
#endif
            { int sp = 0; while (READY[slot] < (unsigned)(c + 1)) { if (++sp > SC_SPIN_CAP) break; } }
            __builtin_amdgcn_fence(__ATOMIC_ACQUIRE, "workgroup");
            const LAS unsigned char* sb = F.lds + slot * SC_SLOT;
            const LAS unsigned char* op = sb + ks * 16; const LAS float* vp = (const LAS float*)(sb + SC_SHARED) + rowl;
            f32x4 w4 = *(const LAS f32x4*)(op), kk4 = *(const LAS f32x4*)(op + 256), b4 = *(const LAS f32x4*)(op + 512), k4 = *(const LAS f32x4*)(op + 768), r4 = *(const LAS f32x4*)(op + 1024);
            float v = vp[0];
            float ykeep = 0.f;
#pragma unroll
            for (int s = 0; s < SC_STEPS; ++s) {
                const f32x4 cw = w4, ckk = kk4, cb = b4, ck = k4, cr = r4; const float cv = v;
                if (s + 1 < SC_STEPS) { const LAS unsigned char* o2 = op + (s + 1) * 1280;
                    w4 = *(const LAS f32x4*)(o2); kk4 = *(const LAS f32x4*)(o2 + 256); b4 = *(const LAS f32x4*)(o2 + 512); k4 = *(const LAS f32x4*)(o2 + 768); r4 = *(const LAS f32x4*)(o2 + 1024);
                    v = vp[(s + 1) * 16]; }
                if (s == SC_STEPS - 1) { asm volatile("s_waitcnt lgkmcnt(0)" ::: "memory"); if (F.lane == 0) DONE[F.wave] = (unsigned)(c + 1); }
                float p = (S[0] * ckk[0] + S[1] * ckk[1]) + (S[2] * ckk[2] + S[3] * ckk[3]);
                p = reduce16(p);
                const f32x4 tt = S * cw + ck * cv;
                S = tt - cb * p;
                float q = (S[0] * cr[0] + S[1] * cr[1]) + (S[2] * cr[2] + S[3] * cr[3]);
                q = reduce16(q);
                ykeep = (ks == s) ? q : ykeep;
            }
            yp[(size_t)(c * SC_STEPS + ks) * 512] = ykeep;
            slot = (slot + 1 == SC_NSLOT) ? 0 : slot + 1;
        }
    } else if (F.wave == 4) {
        const unsigned char* gs = (const unsigned char*)(wsp<float>(F, WS_SCN) + (size_t)bh * T * 320) + F.lane * 16;
        const unsigned char* gv = (const unsigned char*)(wsp<float>(F, WS_SV) + (size_t)bh * T * 64 + (F.lane >> 2) * 64 + rg * 16 + (F.lane & 3) * 4);
        int slot = 0;
        for (int c = 0; c < SC_NCH; ++c) {
            if (c >= SC_NSLOT) { const unsigned need = (unsigned)(c - SC_NSLOT + 1); int sp = 0;
                while (DONE[0] < need || DONE[1] < need || DONE[2] < need || DONE[3] < need) { __builtin_amdgcn_s_sleep(1); if (++sp > SC_SPIN_CAP) break; }
                __builtin_amdgcn_fence(__ATOMIC_ACQUIRE, "workgroup"); }
            LAS unsigned char* dst = F.lds + slot * SC_SLOT;
            const unsigned char* src = gs + (size_t)c * SC_SHARED;
#pragma unroll
            for (int j = 0; j < SC_SHARED / 1024; ++j) __builtin_amdgcn_global_load_lds((const unsigned*)(src + j * 1024), (LAS unsigned*)(dst + j * 1024), 16, 0, 0);
            __builtin_amdgcn_global_load_lds((const unsigned*)(gv + (size_t)c * SC_STEPS * 256), (LAS unsigned*)(dst + SC_SHARED), 16, 0, 0);
            if (c >= 2) { asm volatile("s_waitcnt vmcnt(42)" ::: "memory"); const int ps = (slot >= 2) ? slot - 2 : slot + SC_NSLOT - 2; if (F.lane == 0) READY[ps] = (unsigned)(c - 1); }
            slot = (slot + 1 == SC_NSLOT) ? 0 : slot + 1;
        }
        { asm volatile("s_waitcnt vmcnt(21)" ::: "memory"); const int ps = (slot >= 2) ? slot - 2 : slot + SC_NSLOT - 2; if (F.lane == 0) READY[ps] = (unsigned)(SC_NCH - 1); }
        { asm volatile("s_waitcnt vmcnt(0)" ::: "memory"); const int ps = (slot >= 1) ? slot - 1 : SC_NSLOT - 1; if (F.lane == 0) READY[ps] = (unsigned)(SC_NCH); }
    } else {
#if MK_CONV_IN_SCAN
        for (int it = F.vcu * 3 + (F.wave - 5); it < MOE_ITEMS; it += F.G * 3) moe_weight_item(F, it);
#endif
    }
    __syncthreads();
}

constexpr int KLD = 72;
constexpr int VLD = 260;
__device__ __forceinline__ void phase5_attn_part(const Frame& F, int first, int stride) {
    const bf16* P = wsp<bf16>(F, WS_P);
    bf16* CAT = wsp<bf16>(F, WS_CAT);
    const float* qg = F.in[17]; const float* kg = F.in[18]; const float* sinks = F.in[19];
    LAS bf16* Kl = (LAS bf16*)F.lds;
    LAS bf16* Vt = (LAS bf16*)(F.lds + 256 * KLD * 2);
    const int lane = F.lane, r = lane & 31, h = lane >> 5;
    for (int unit = first; unit < NBATCH * KVH * (T / 128); unit += stride) {
        const int blk = unit % (T / 128), kvh = (unit / (T / 128)) % KVH, b = unit / (T / 128 * KVH);
        const int kpos0 = blk * 128 - 128;
        __syncthreads();
        u32x4 kr4[4], vr4[4];
#pragma unroll
        for (int it = 0; it < 4; ++it) { const int ch = F.tid + 512 * it, key = ch >> 3, dc = ch & 7, kpos = kpos0 + key;
            const size_t ro = (size_t)(32 + kvh) * PL_SZ + (size_t)(b * T + (kpos >= 0 ? kpos : 0)) * 64 + dc * 8;
            kr4[it] = *(const u32x4*)(P + ro); vr4[it] = *(const u32x4*)(P + ro + 2 * PL_SZ); }
#pragma unroll
        for (int it = 0; it < 4; ++it) { const int ch = F.tid + 512 * it, key = ch >> 3, dc = ch & 7, kpos = kpos0 + key;
            u32x4 kraw = kr4[it], vraw = vr4[it];
            if (kpos < 0) { kraw = (u32x4){0u, 0u, 0u, 0u}; vraw = (u32x4){0u, 0u, 0u, 0u}; }
            float kf[8]; kf[0] = bflo(kraw.x); kf[1] = bfhi(kraw.x); kf[2] = bflo(kraw.y); kf[3] = bfhi(kraw.y); kf[4] = bflo(kraw.z); kf[5] = bfhi(kraw.z); kf[6] = bflo(kraw.w); kf[7] = bfhi(kraw.w);
            float ss = 0.f;
#pragma unroll
            for (int j = 0; j < 8; ++j) ss += kf[j] * kf[j];
            ss += __shfl_xor(ss, 1); ss += __shfl_xor(ss, 2); ss += __shfl_xor(ss, 4);
            const float rstd = rsqrtf(ss * (1.f / 64.f) + NORM_EPS);
            const f32x4 g0 = *(const f32x4*)(kg + dc * 8), g1 = *(const f32x4*)(kg + dc * 8 + 4);
            u32x4 ko; ko.x = pk2(kf[0] * rstd * g0[0], kf[1] * rstd * g0[1]); ko.y = pk2(kf[2] * rstd * g0[2], kf[3] * rstd * g0[3]);
            ko.z = pk2(kf[4] * rstd * g1[0], kf[5] * rstd * g1[1]); ko.w = pk2(kf[6] * rstd * g1[2], kf[7] * rstd * g1[3]);
            *(LAS u32x4*)(Kl + key * KLD + dc * 8) = ko;
            const unsigned vv[4] = {vraw.x, vraw.y, vraw.z, vraw.w};
#pragma unroll
            for (int j = 0; j < 4; ++j) { Vt[(dc * 8 + 2 * j) * VLD + key] = (bf16)(vv[j] & 0xffffu); Vt[(dc * 8 + 2 * j + 1) * VLD + key] = (bf16)(vv[j] >> 16); }
        }
        __syncthreads();
        for (int task = F.wave; task < 16; task += 8) {
            const int g = task & 3, qs = task >> 2, head = kvh * 4 + g;
            const int qrow = b * T + blk * 128 + qs * 32 + r;
            float qf[4][8]; float ss = 0.f;
#pragma unroll
            for (int s = 0; s < 4; ++s) { const u32x4 qr = *(const u32x4*)(P + (size_t)(24 + head) * PL_SZ + (size_t)qrow * 64 + 16 * s + 8 * h);
                qf[s][0] = bflo(qr.x); qf[s][1] = bfhi(qr.x); qf[s][2] = bflo(qr.y); qf[s][3] = bfhi(qr.y); qf[s][4] = bflo(qr.z); qf[s][5] = bfhi(qr.z); qf[s][6] = bflo(qr.w); qf[s][7] = bfhi(qr.w);
#pragma unroll
                for (int j = 0; j < 8; ++j) ss += qf[s][j] * qf[s][j]; }
            ss += __shfl_xor(ss, 32);
            const float qscale = rsqrtf(ss * (1.f / 64.f) + NORM_EPS) * 0.125f;
            bf16x8 qb[4];
#pragma unroll
            for (int s = 0; s < 4; ++s) { u32x4 w;
                const f32x4 g0 = *(const f32x4*)(qg + 16 * s + 8 * h), g1 = *(const f32x4*)(qg + 16 * s + 8 * h + 4);
                w.x = pk2(qf[s][0] * qscale * g0[0], qf[s][1] * qscale * g0[1]); w.y = pk2(qf[s][2] * qscale * g0[2], qf[s][3] * qscale * g0[3]);
                w.z = pk2(qf[s][4] * qscale * g1[0], qf[s][5] * qscale * g1[1]); w.w = pk2(qf[s][6] * qscale * g1[2], qf[s][7] * qscale * g1[3]);
                qb[s] = __builtin_bit_cast(bf16x8, w); }
            f32x16 st[5];
#pragma unroll
            for (int kt = 0; kt < 5; ++kt) {
#pragma unroll
                for (int i = 0; i < 16; ++i) st[kt][i] = 0.f;
#pragma unroll
                for (int s = 0; s < 4; ++s) { const bf16x8 ka = *(const LAS bf16x8*)(Kl + (32 * (qs + kt) + r) * KLD + 16 * s + 8 * h);
                    st[kt] = __builtin_amdgcn_mfma_f32_32x32x16_bf16(ka, qb[s], st[kt], 0, 0, 0); }
            }
            const int iq = 32 * qs + r;
            const float sink = sinks[head];
            float mx = sink;
#pragma unroll
            for (int kt = 0; kt < 5; ++kt)
#pragma unroll
                for (int i = 0; i < 16; ++i) { const int jw = 32 * (qs + kt) + (i & 3) + 8 * (i >> 2) + 4 * h;
                    const bool ok = (jw >= iq + 1) && (jw <= iq + 128) && (kpos0 + jw >= 0);
                    st[kt][i] = ok ? st[kt][i] : -INFINITY; mx = fmaxf(mx, st[kt][i]); }
            mx = fmaxf(mx, __shfl_xor(mx, 32));
            float lsum = 0.f;
#pragma unroll
            for (int kt = 0; kt < 5; ++kt)
#pragma unroll
                for (int i = 0; i < 16; ++i) { const float p = __expf(st[kt][i] - mx); st[kt][i] = p; lsum += p; }
            lsum += __shfl_xor(lsum, 32);
            const float linv = __builtin_amdgcn_rcpf(lsum + __expf(sink - mx));
            f32x16 o[2];
#pragma unroll
            for (int dt = 0; dt < 2; ++dt)
#pragma unroll
                for (int i = 0; i < 16; ++i) o[dt][i] = 0.f;
#pragma unroll
            for (int kt = 0; kt < 5; ++kt)
#pragma unroll
                for (int sp = 0; sp < 2; ++sp) { u32x4 pw;
                    pw.x = pk2(st[kt][8 * sp + 0] * linv, st[kt][8 * sp + 1] * linv); pw.y = pk2(st[kt][8 * sp + 2] * linv, st[kt][8 * sp + 3] * linv);
                    pw.z = pk2(st[kt][8 * sp + 4] * linv, st[kt][8 * sp + 5] * linv); pw.w = pk2(st[kt][8 * sp + 6] * linv, st[kt][8 * sp + 7] * linv);
                    const bf16x8 pa = __builtin_bit_cast(bf16x8, pw);
                    const int kb = 32 * (qs + kt) + 16 * sp + 4 * h;
#pragma unroll
                    for (int dt = 0; dt < 2; ++dt) { const LAS bf16* vp = Vt + (32 * dt + r) * VLD + kb;
                        const u32x2 lo = *(const LAS u32x2*)vp, hi = *(const LAS u32x2*)(vp + 8);
                        u32x4 vw; vw.x = lo.x; vw.y = lo.y; vw.z = hi.x; vw.w = hi.y;
                        o[dt] = __builtin_amdgcn_mfma_f32_32x32x16_bf16(pa, __builtin_bit_cast(bf16x8, vw), o[dt], 0, 0, 0); } }
            { LAS bf16* ot = (LAS bf16*)(F.lds + 256 * KLD * 2 + 64 * VLD * 2) + F.wave * (32 * 72);
#pragma unroll
                for (int dt = 0; dt < 2; ++dt)
#pragma unroll
                    for (int i = 0; i < 16; ++i) { const int qr = (i & 3) + 8 * (i >> 2) + 4 * h; ot[qr * 72 + 32 * dt + r] = (bf16)f2bf(o[dt][i]); }
                asm volatile("s_waitcnt lgkmcnt(0)" ::: "memory");
#pragma unroll
                for (int j = 0; j < 4; ++j) { const int id = lane + 64 * j, qr = id >> 3, pc = id & 7;
                    const u32x4 w = *(const LAS u32x4*)(ot + qr * 72 + pc * 8);
                    *(u32x4*)(CAT + (size_t)(b * T + blk * 128 + qs * 32 + qr) * D + 512 + head * 64 + pc * 8) = w; }
                asm volatile("s_waitcnt lgkmcnt(0)" ::: "memory"); }
        }
    }
}

__device__ __forceinline__ void phase5_attn(const Frame& F) { phase5_attn_part(F, F.vcu, F.G); }
__device__ __forceinline__ void phase6(const Frame& F) {
    const int gw = F.vcu * 8 + F.wave, NGW = F.G * 8;
    const float* Y = wsp<float>(F, WS_Y); const float* SV = wsp<float>(F, WS_SV); const bf16* G = wsp<bf16>(F, WS_G); const float* BON = wsp<float>(F, WS_BONUS);
    bf16* CAT = wsp<bf16>(F, WS_CAT);
    const float* lg = F.in[15]; const float* lb = F.in[16];
    const int hh = F.lane >> 3, n0 = (F.lane & 7) * 8, c0 = F.lane * 8;
    for (int row = gw; row < M; row += NGW) { const int b = row / T, t = row % T;
        const f32x4 y0 = *(const f32x4*)(Y + (size_t)row * 512 + c0), y1 = *(const f32x4*)(Y + (size_t)row * 512 + c0 + 4);
        float yv[8] = {y0[0], y0[1], y0[2], y0[3], y1[0], y1[1], y1[2], y1[3]};
        float s = 0.f;
#pragma unroll
        for (int j = 0; j < 8; ++j) s += yv[j];
        s += __shfl_xor(s, 1); s += __shfl_xor(s, 2); s += __shfl_xor(s, 4);
        const float mean = s * (1.f / 64.f); float q = 0.f;
#pragma unroll
        for (int j = 0; j < 8; ++j) { yv[j] -= mean; q += yv[j] * yv[j]; }
        q += __shfl_xor(q, 1); q += __shfl_xor(q, 2); q += __shfl_xor(q, 4);
        const float rstd = rsqrtf(q * (1.f / 64.f) + GN_EPS);
        const float bon = BON[row * 8 + hh];
        const float* vp = SV + ((size_t)(b * RH + hh) * T + t) * 64 + n0;
        const f32x4 v0 = *(const f32x4*)vp, v1 = *(const f32x4*)(vp + 4);
        const float vv[8] = {v0[0], v0[1], v0[2], v0[3], v1[0], v1[1], v1[2], v1[3]};
        const u32x4 graw = *(const u32x4*)(G + (size_t)row * 512 + c0);
        const float gg[8] = {bflo(graw.x), bfhi(graw.x), bflo(graw.y), bfhi(graw.y), bflo(graw.z), bfhi(graw.z), bflo(graw.w), bfhi(graw.w)};
        float ov[8];
#pragma unroll
        for (int j = 0; j < 8; ++j) ov[j] = (yv[j] * rstd * lg[c0 + j] + lb[c0 + j] + bon * vv[j]) * gg[j];
        u32x4 w; w.x = pk2(ov[0], ov[1]); w.y = pk2(ov[2], ov[3]); w.z = pk2(ov[4], ov[5]); w.w = pk2(ov[6], ov[7]);
        *(u32x4*)(CAT + (size_t)row * D + c0) = w; }
}

__device__ __forceinline__ float reduce32x64(float (&v)[32], int lane) {
#pragma unroll
    for (int i = 0; i < 16; ++i) { const bool hi = lane & 16; const float send = hi ? v[i] : v[i + 16], keep = hi ? v[i + 16] : v[i]; v[i] = keep + __shfl_xor(send, 16); }
#pragma unroll
    for (int i = 0; i < 8; ++i) { const bool hi = lane & 8; const float send = hi ? v[i] : v[i + 8], keep = hi ? v[i + 8] : v[i]; v[i] = keep + __shfl_xor(send, 8); }
#pragma unroll
    for (int i = 0; i < 4; ++i) { const bool hi = lane & 4; const float send = hi ? v[i] : v[i + 4], keep = hi ? v[i + 4] : v[i]; v[i] = keep + __shfl_xor(send, 4); }
#pragma unroll
    for (int i = 0; i < 2; ++i) { const bool hi = lane & 2; const float send = hi ? v[i] : v[i + 2], keep = hi ? v[i + 2] : v[i]; v[i] = keep + __shfl_xor(send, 2); }
    { const bool hi = lane & 1; const float send = hi ? v[0] : v[1], keep = hi ? v[1] : v[0]; v[0] = keep + __shfl_xor(send, 1); }
    return v[0] + __shfl_xor(v[0], 32);
}
__device__ __forceinline__ void phase8(const Frame& F) {
    const float* mod = wsp<float>(F, WS_MOD); const bf16* x1 = wsp<bf16>(F, WS_X1B);
    const float* wr_ = F.in[22]; const float* br = F.in[23];
    LAS float* Wt = (LAS float*)F.lds;
    LAS float* lgw = (LAS float*)(F.lds + 131072 + F.wave * 512);
    LAS int* cnt = (LAS int*)(F.lds + 131072 + 4096);
    __syncthreads();
    for (int idx = F.tid; idx < 8192; idx += 512) { const int k = idx >> 3, e4 = idx & 7; const f32x4 w = *(const f32x4*)(wr_ + k * 32 + e4 * 4);
        Wt[(4 * e4 + 0) * 1024 + k] = w[0]; Wt[(4 * e4 + 1) * 1024 + k] = w[1]; Wt[(4 * e4 + 2) * 1024 + k] = w[2]; Wt[(4 * e4 + 3) * 1024 + k] = w[3]; }
    if (F.tid < 32) cnt[F.tid] = 0;
    __syncthreads();
    int* RT_E = wsp<int>(F, WS_RT_E); int* RT_LP = wsp<int>(F, WS_RT_LP); float* RT_G = wsp<float>(F, WS_RT_G);
    const int e = F.lane & 31;
    const float bre = br[e];
    f32x4 shq[4], scq[4];
    { const int b = (F.vcu * 128) / T;
#pragma unroll
        for (int j = 0; j < 4; ++j) { const int col = 4 * F.lane + 256 * j; shq[j] = *(const f32x4*)(mod + b * 6144 + 3072 + col); scq[j] = (*(const f32x4*)(mod + b * 6144 + 4096 + col) + 1.f) * *(const f32x4*)(F.in[21] + col); } }
#if MK_CONV_WHERE == 8
    const int p_lo = F.wave < 4 ? 11 * F.wave : 44 + 10 * (F.wave - 4), p_n = F.wave < 4 ? 11 : 10;
    if (F.wave >= 6) { for (int it = CONV_4B + F.vcu * 2 + (F.wave - 6); it < MOE_ITEMS; it += F.G * 2) moe_weight_item(F, it); }
    else {
#else
    const int p_lo = 8 * F.wave, p_n = 8;
    {
#endif
    u32x2 xn[2][4];
#pragma unroll
    for (int q = 0; q < 2; ++q)
#pragma unroll
        for (int j = 0; j < 4; ++j) xn[q][j] = ((const u32x2*)(x1 + (size_t)(F.vcu * 128 + 2 * p_lo + q) * D))[F.lane + 64 * j];
    for (int pr = 0; pr < p_n; ++pr) { const int row0 = F.vcu * 128 + 2 * (p_lo + pr);
        f32x4 h0[4], h1[4];
        float ss0 = 0.f, ss1 = 0.f;
#pragma unroll
        for (int j = 0; j < 4; ++j) { h0[j] = (f32x4){bflo(xn[0][j].x), bfhi(xn[0][j].x), bflo(xn[0][j].y), bfhi(xn[0][j].y)}; h1[j] = (f32x4){bflo(xn[1][j].x), bfhi(xn[1][j].x), bflo(xn[1][j].y), bfhi(xn[1][j].y)};
            ss0 += (h0[j][0] * h0[j][0] + h0[j][1] * h0[j][1]) + (h0[j][2] * h0[j][2] + h0[j][3] * h0[j][3]); ss1 += (h1[j][0] * h1[j][0] + h1[j][1] * h1[j][1]) + (h1[j][2] * h1[j][2] + h1[j][3] * h1[j][3]); }
        { const int nr = row0 + (pr + 1 < p_n ? 2 : 0);
#pragma unroll
            for (int q = 0; q < 2; ++q)
#pragma unroll
                for (int j = 0; j < 4; ++j) xn[q][j] = ((const u32x2*)(x1 + (size_t)(nr + q) * D))[F.lane + 64 * j]; }
#pragma unroll
        for (int o = 1; o < 64; o <<= 1) { ss0 += __shfl_xor(ss0, o); ss1 += __shfl_xor(ss1, o); }
        const float rs0 = rsqrtf(ss0 * (1.f / D) + NORM_EPS), rs1 = rsqrtf(ss1 * (1.f / D) + NORM_EPS);
        unsigned char* o0 = wsp<unsigned char>(F, WS_H8) + (size_t)row0 * D * (MK_FP8 ? 1 : 2); unsigned char* o1 = o0 + (size_t)D * (MK_FP8 ? 1 : 2);
#pragma unroll
        for (int j = 0; j < 4; ++j) { h0[j] = h0[j] * rs0 * scq[j] + shq[j]; h1[j] = h1[j] * rs1 * scq[j] + shq[j];
#if MK_FP8
            ((unsigned*)o0)[F.lane + 64 * j] = pg8::pk4_fp8(h0[j][0], h0[j][1], h0[j][2], h0[j][3]); ((unsigned*)o1)[F.lane + 64 * j] = pg8::pk4_fp8(h1[j][0], h1[j][1], h1[j][2], h1[j][3]);
#else
            { u32x2 w; w.x = pk2(h0[j][0], h0[j][1]); w.y = pk2(h0[j][2], h0[j][3]); ((u32x2*)o0)[F.lane + 64 * j] = w; w.x = pk2(h1[j][0], h1[j][1]); w.y = pk2(h1[j][2], h1[j][3]); ((u32x2*)o1)[F.lane + 64 * j] = w; }
#endif
        }
        float pa0[32], pa1[32];
#pragma unroll
        for (int q = 0; q < 32; ++q) { float s0 = 0.f, s1 = 0.f;
#pragma unroll
            for (int j = 0; j < 4; ++j) { const f32x4 w4 = *(const LAS f32x4*)(Wt + q * 1024 + 4 * F.lane + 256 * j);
                s0 = fmaf(h0[j][0], w4[0], s0); s0 = fmaf(h0[j][1], w4[1], s0); s0 = fmaf(h0[j][2], w4[2], s0); s0 = fmaf(h0[j][3], w4[3], s0);
                s1 = fmaf(h1[j][0], w4[0], s1); s1 = fmaf(h1[j][1], w4[1], s1); s1 = fmaf(h1[j][2], w4[2], s1); s1 = fmaf(h1[j][3], w4[3], s1); }
            pa0[q] = s0; pa1[q] = s1; }
        const float lg0 = reduce32x64(pa0, F.lane) + bre, lg1 = reduce32x64(pa1, F.lane) + bre;
#pragma unroll
        for (int q = 0; q < 2; ++q) { const float logit = q ? lg1 : lg0; const int row = row0 + q; LAS float* lg32 = lgw + q * 64;
            if (F.lane < 32) lg32[e] = logit;
            asm volatile("s_waitcnt lgkmcnt(0)" ::: "memory");
            int rank = 0;
#pragma unroll 8
            for (int o = 0; o < 32; ++o) { const float ov = lg32[o]; rank += (ov > logit || (ov == logit && o < e)) ? 1 : 0; }
            if (F.lane < 32 && rank < 4) lg32[32 + rank] = logit;
            asm volatile("s_waitcnt lgkmcnt(0)" ::: "memory");
            const float t0 = lg32[32], t1 = lg32[33], t2 = lg32[34], t3 = lg32[35];
            const float den = 1.f + __expf(t1 - t0) + __expf(t2 - t0) + __expf(t3 - t0);
            if (F.lane < 32 && rank < 4) { const int lp = atomicAdd((int*)&cnt[e], 1);
                RT_E[row * 4 + rank] = e; RT_LP[row * 4 + rank] = lp; RT_G[row * 4 + rank] = __expf(logit - t0) / den; }
            asm volatile("s_waitcnt lgkmcnt(0)" ::: "memory"); }
    }
    }
    __syncthreads();
    if (F.tid < 32) wsp<int>(F, WS_BLKCNT)[F.vcu * 32 + F.tid] = cnt[F.tid];
}

__device__ __forceinline__ void phase9(const Frame& F) {
    LAS int* base = (LAS int*)F.lds;
    LAS int* tot = base + 32;
    LAS int* pst = base + 64;
    const int* BC = wsp<int>(F, WS_BLKCNT);
    { LAS int* ps = base + 128; LAS int* pm = ps + 512;
        const int e = F.tid & 31, seg = F.tid >> 5; int s = 0, mine = 0;
#pragma unroll
        for (int j = 0; j < 16; ++j) { const int bk = seg * 16 + j, v = BC[bk * 32 + e]; s += v; mine += (bk < F.vcu) ? v : 0; }
        ps[seg * 32 + e] = s; pm[seg * 32 + e] = mine; }
    __syncthreads();
    if (F.tid < 32) { int s = 0, mine = 0;
#pragma unroll
        for (int q = 0; q < 16; ++q) { s += base[128 + q * 32 + F.tid]; mine += base[128 + 512 + q * 32 + F.tid]; }
        base[F.tid] = mine; tot[F.tid] = s; }
    __syncthreads();
    if (F.tid == 0) { int s = 0; for (int e = 0; e < 32; ++e) { pst[e] = s; s += (tot[e] + 255) / 256 * 256; } pst[32] = s; }
    __syncthreads();
    int* SLOT_TOK = wsp<int>(F, WS_SLOTTOK); float* SLOT_GATE = wsp<float>(F, WS_SLOTGATE); int* TOK_SLOT = wsp<int>(F, WS_TOKSLOT);
    const int* RT_E = wsp<int>(F, WS_RT_E); const int* RT_LP = wsp<int>(F, WS_RT_LP); const float* RT_G = wsp<float>(F, WS_RT_G);
    { const int idx = F.vcu * 512 + F.tid;
        const int e = RT_E[idx], slot = pst[e] + base[e] + RT_LP[idx];
        SLOT_TOK[slot] = idx >> 2; SLOT_GATE[slot] = RT_G[idx]; TOK_SLOT[idx] = slot; }
    if (F.vcu < 32) { const int e = F.vcu; for (int s = pst[e] + tot[e] + F.tid; s < pst[e + 1]; s += 512) { SLOT_TOK[s] = 0; SLOT_GATE[s] = 0.f; } }
    if (F.vcu == 0) { unsigned* ctl = wsp<unsigned>(F, WS_CTL);
        if (F.tid == 0) ctl[CW_NTILES] = (unsigned)(pst[32] / 256);
        if (F.tid < 33) ctl[CW_PADSTART + F.tid] = (unsigned)pst[F.tid];
        int* TE = wsp<int>(F, WS_TILEE);
        for (int tl = F.tid; tl < MAX_TILES; tl += 512) { int e = 31; for (int q = 0; q < 32; ++q) if (tl * 256 < pst[q + 1]) { e = q; break; } TE[tl] = e; } }
#if MK_CONV_WHERE == 9
    for (int it = CONV_4B + F.vcu * 8 + F.wave; it < MOE_ITEMS; it += F.G * 8) moe_weight_item(F, it);
#endif
}

__device__ __forceinline__ void phase12(const Frame& F) {
    const int gw = F.vcu * 8 + F.wave, NGW = F.G * 8;
    const float* mod = wsp<float>(F, WS_MOD); const unsigned char* YS = wsp<unsigned char>(F, WS_YS); const int* TOK_SLOT = wsp<int>(F, WS_TOKSLOT); const bf16* X1B = wsp<bf16>(F, WS_X1B);
    const int col = 16 * F.lane;
    for (int row = gw; row < M; row += 2 * NGW) {
        int sl[2][4]; u32x4 v[2][4], xb[2][2];
#pragma unroll
        for (int rr = 0; rr < 2; ++rr)
#pragma unroll
            for (int k = 0; k < 4; ++k) sl[rr][k] = TOK_SLOT[(row + rr * NGW) * 4 + k];
#pragma unroll
        for (int rr = 0; rr < 2; ++rr) {
#pragma unroll
            for (int k = 0; k < 4; ++k) v[rr][k] = __builtin_nontemporal_load((const u32x4*)(YS + (size_t)sl[rr][k] * D + col));
#pragma unroll
            for (int j = 0; j < 2; ++j) xb[rr][j] = __builtin_nontemporal_load((const u32x4*)(X1B + (size_t)(row + rr * NGW) * D + col + 8 * j)); }
#pragma unroll
        for (int rr = 0; rr < 2; ++rr) { const int rw = row + rr * NGW, b = rw / T;
            const float* gp = mod + b * 6144 + 5120 + col;
            float* op = F.out + (size_t)rw * D + col;
#pragma unroll
            for (int c4 = 0; c4 < 4; ++c4) {
                f32x4 a = (f32x4){0.f, 0.f, 0.f, 0.f};
#pragma unroll
                for (int k = 0; k < 4; ++k) { const int w = (int)v[rr][k][c4];
                    const f32x2 lo = __builtin_amdgcn_cvt_pk_f32_fp8(w, false), hi = __builtin_amdgcn_cvt_pk_f32_fp8(w, true);
                    a[0] += lo[0]; a[1] += lo[1]; a[2] += hi[0]; a[3] += hi[1]; }
                const f32x4 g = *(const f32x4*)(gp + 4 * c4) * pg8::YS_INV;
                const unsigned x01 = xb[rr][c4 >> 1][(c4 & 1) * 2], x23 = xb[rr][c4 >> 1][(c4 & 1) * 2 + 1];
                f32x4 o = (f32x4){bflo(x01), bfhi(x01), bflo(x23), bfhi(x23)};
                o += g * a;
                *(f32x4*)(op + 4 * c4) = o; } }
    }
}

__device__ __forceinline__ void copy_x_to_out(const Frame& F) {
    const size_t n4 = (size_t)M * D / 4; const f32x4* s = (const f32x4*)F.in[0]; f32x4* d = (f32x4*)F.out;
    for (size_t i = (size_t)blockIdx.x * 512 + F.tid; i < n4; i += (size_t)gridDim.x * 512) d[i] = s[i];
}


#define XB_TMO      128
#define XB_XCNT(j)  (256  + 64 * (j))
#define XB_XSUB(j)  (1280 + 64 * (j))
#define XB_XGEN(j)  (2304 + 64 * (j))
#define XB_TOP      3328
#define XB_TOPGEN   3392
#define XCD_BAR_WORDS 3456
#define XB_SPIN_CAP (1u << 18)
__device__ __forceinline__ unsigned xb_ld(unsigned* p)              { return __hip_atomic_load(p, __ATOMIC_RELAXED, __HIP_MEMORY_SCOPE_AGENT); }
__device__ __forceinline__ unsigned xb_add(unsigned* p, unsigned v) { return __hip_atomic_fetch_add(p, v, __ATOMIC_RELAXED, __HIP_MEMORY_SCOPE_AGENT); }
__device__ __forceinline__ unsigned xb_xcc_id() { return (unsigned)__builtin_amdgcn_s_getreg((3 << 11) | 20) & 0xFu; }
#define XB_SPIN(cond, bar) do { unsigned _sp = 0; while (cond) { __builtin_amdgcn_s_sleep(1); \
    if ((++_sp & 255u) == 0u) { if (xb_ld(&(bar)[XB_TMO])) break; if (_sp > XB_SPIN_CAP) { atomicAdd(&(bar)[XB_TMO], 1u); break; } } } } while (0)
struct XcdBarrier { unsigned* bar; unsigned x; volatile LAS unsigned* st; };
__device__ __forceinline__ XcdBarrier xcd_barrier_post(unsigned* bar, volatile LAS unsigned* st) {
    XcdBarrier b; b.bar = bar; b.x = xb_xcc_id(); b.st = st;
    if (threadIdx.x == 0) (void)xb_add(&bar[XB_XCNT(b.x)], 1u);
    return b;
}
__device__ __forceinline__ void xcd_barrier_complete(unsigned* bar, unsigned x, unsigned& nloc, unsigned& nx) {
    const unsigned G = gridDim.x * gridDim.y * gridDim.z;
    unsigned sum, cnt, mine, sp = 0u;
    for (;;) {
        sum = 0u; cnt = 0u; mine = 0u;
#pragma unroll
        for (unsigned j = 0; j < 16; ++j) { const unsigned c = xb_ld(&bar[XB_XCNT(j)]); sum += c; cnt += (c > 0u) ? 1u : 0u; mine = (j == x) ? c : mine; }
        if (sum == G) break;
        __builtin_amdgcn_s_sleep(1);
        if ((++sp & 255u) == 0u) { if (xb_ld(&bar[XB_TMO])) break; if (sp > XB_SPIN_CAP) { atomicAdd(&bar[XB_TMO], 1u); break; } }
    }
    nloc = mine > 0u ? mine : 1u; nx = cnt > 0u ? cnt : 1u;
}
__device__ __forceinline__ void xcd_barrier(const XcdBarrier& b) {
    asm volatile("s_waitcnt vmcnt(0)" ::: "memory");
    __syncthreads();
    if (threadIdx.x == 0) {
        unsigned* bar = b.bar;
        __builtin_amdgcn_s_waitcnt(0);
        unsigned nloc = b.st[0], nx = b.st[1];
        if (nloc == 0u) { xcd_barrier_complete(bar, b.x, nloc, nx); b.st[0] = nloc; b.st[1] = nx; }
        const unsigned old = xb_add(&bar[XB_XSUB(b.x)], 1u);
        const unsigned gen = old / nloc;
        if (old + 1u == (gen + 1u) * nloc) {
            __builtin_amdgcn_fence(__ATOMIC_RELEASE, "agent");
            asm volatile("s_waitcnt vmcnt(0)" ::: "memory");
            const unsigned og = xb_add(&bar[XB_TOP], 1u);
            const unsigned tg = og / nx;
            if (og + 1u == (tg + 1u) * nx) xb_add(&bar[XB_TOPGEN], 1u);
            else XB_SPIN(xb_ld(&bar[XB_TOPGEN]) == tg, bar);
            __builtin_amdgcn_fence(__ATOMIC_ACQUIRE, "agent");
            xb_add(&bar[XB_XGEN(b.x)], 1u);
            asm volatile("s_waitcnt vmcnt(0)" ::: "memory");
        } else {
            XB_SPIN(xb_ld(&bar[XB_XGEN(b.x)]) == gen, bar);
            __builtin_amdgcn_fence(__ATOMIC_ACQUIRE, "agent");
            asm volatile("s_waitcnt vmcnt(0)" ::: "memory");
        }
    }
    __syncthreads();
}

struct Args { const float* in[28]; float* out; unsigned char* ws; int ph_lo, ph_hi; };
constexpr int N_PHASES = 13;

__global__ void __launch_bounds__(512, 2) mk_fwd(Args args) {
    extern __shared__ __attribute__((aligned(16))) unsigned char lds_raw[];
    Frame F;
    F.lds = (LAS unsigned char*)lds_raw;
    F.tid = threadIdx.x; F.lane = F.tid & 63; F.wave = __builtin_amdgcn_readfirstlane(F.tid >> 6);
    F.G = gridDim.x; { const int bx = blockIdx.x; F.vcu = (F.G % 8 == 0) ? (bx % 8) * (F.G / 8) + bx / 8 : bx; }
    F.in = args.in;
    F.out = args.out; F.ws = args.ws;
    cg::grid_group grid = cg::this_grid();
    const int lo = args.ph_lo, hi = args.ph_hi;
    volatile LAS unsigned* MISC = (volatile LAS unsigned*)(F.lds + MISC_OFF);
    if (F.tid < 16) MISC[F.tid] = 0u;
    __syncthreads();
    XcdBarrier bar; bar.bar = wsp<unsigned>(F, WS_CTL) + CW_BAR; bar.x = 0; bar.st = MISC;
    if (hi - lo > 1) bar = xcd_barrier_post(wsp<unsigned>(F, WS_CTL) + CW_BAR, MISC);
#define IN(k) (lo <= (k) && (k) < hi)
#define REP(k) for (int rep_ = 0; rep_ < 1 + ((MK_REPEAT_MASK >> (k)) & 1); ++rep_)
#define SEAM(k) do { if (IN(k) && IN((k) + 1)) { if ((MK_CG_SEAMS >> (k)) & 1) grid.sync(); else xcd_barrier(bar); } } while (0)

    if (IN(0)) REP(0) { phase0(F); } SEAM(0);
    if (IN(1)) REP(1) { phase1(F); } SEAM(1);
    if (IN(2)) REP(2) {
#if MK_CONV_WHERE == 2
        if ((int)blockIdx.x >= 192) { for (int it = ((int)blockIdx.x - 192) * 8 + F.wave; it < MOE_ITEMS; it += 64 * 8) moe_weight_item(F, it); }
        else {
        pg8::Gemm g{wsp<bf16>(F, WS_H), wsp<bf16>(F, WS_WIN), D, IN_COLS, nullptr};
        pg8::StaticOrder S; S.init(M, IN_COLS, 192, (int)blockIdx.x);
        pg8::EpiBf16P E{wsp<bf16>(F, WS_P), IN_COLS};
        pg8::gemm_phase<pg8::EpiBf16P, pg8::StaticOrder, false>(F.lds, g, S, E);
        }
#else
        pg8::Gemm g{wsp<bf16>(F, WS_H), wsp<bf16>(F, WS_WIN), D, IN_COLS, nullptr};
        pg8::StaticOrder S; S.init(M, IN_COLS, F.G, (int)blockIdx.x);
        pg8::EpiBf16P E{wsp<bf16>(F, WS_P), IN_COLS};
        pg8::gemm_phase<pg8::EpiBf16P, pg8::StaticOrder, false>(F.lds, g, S, E);
#endif
    } SEAM(2);
#if MK_RWKV_MODE < 3
    if (IN(3)) REP(3) { phase3(F); } SEAM(3);
#endif
    if (IN(4)) REP(4) {
#if MK_RWKV_MODE >= 1
#if MK_RWKV_MODE == 4
#if MK_WMASK != 63
        phase4a_fused(F); xcd_barrier(bar);
#endif
        for (int q_ = 0; q_ < 1 + (MK_REP4 & 1); ++q_) { phase4a_wave(F); xcd_barrier(bar); }
#elif MK_RWKV_MODE == 3
        for (int q_ = 0; q_ < 1 + (MK_REP4 & 1); ++q_) { phase4a_fused(F); xcd_barrier(bar); }
#else
        for (int q_ = 0; q_ < 1 + (MK_REP4 & 1); ++q_) { phase4a_summaries(F); xcd_barrier(bar); }
#endif
        for (int q_ = 0; q_ < 1 + ((MK_REP4 >> 1) & 1); ++q_) { phase4b_states(F); xcd_barrier(bar); }
#endif
#if MK_RWKV_MODE >= 2
        for (int q_ = 0; q_ < 1 + ((MK_REP4 >> 2) & 1); ++q_) phase4c_output(F);
#else
        phase4_scan(F);
#endif
        } SEAM(4);
#if !MK_ATTN_IN_4B
    if (IN(5)) REP(5) { phase5_attn(F); } SEAM(5);
#endif
#if MK_RWKV_MODE < 2
    if (IN(6)) REP(6) { phase6(F); } SEAM(6);
#endif
    if (IN(7)) REP(7) {
#if MK_LAST_PHASE >= 7
        pg8::Gemm g{wsp<bf16>(F, WS_CAT), wsp<bf16>(F, WS_WOUT), D, D, nullptr};
        pg8::StaticOrder S; S.init(M, D, F.G, (int)blockIdx.x);
        pg8::EpiOutProj E{F.in[0], wsp<bf16>(F, WS_X1B), wsp<float>(F, WS_MOD) + 2048};
        pg8::gemm_phase<pg8::EpiOutProj, pg8::StaticOrder, false>(F.lds, g, S, E);
#else
        copy_x_to_out(F);
#endif
    } SEAM(7);
    if (IN(8)) REP(8) { phase8(F); } SEAM(8);
    if (IN(9)) REP(9) { phase9(F); } SEAM(9);
    if (IN(10)) REP(10) {
        const unsigned* ctl = wsp<unsigned>(F, WS_CTL);
        pg8::Gemm g{wsp<bf16>(F, WS_H8), wsp<bf16>(F, WS_W1), MK_FP8 ? D / 2 : D, 2 * DE, wsp<int>(F, WS_SLOTTOK)};
        pg8::MoeOrder S{(int)ctl[CW_NTILES], 8, F.G, F.vcu, wsp<int>(F, WS_TILEE)};
        pg8::EpiMoe1 E{wsp<unsigned char>(F, WS_ACT), F.in[25]};
#if MK_NOLOAD_PROBE & 1
        pg8::gemm_phase<pg8::EpiMoe1, pg8::MoeOrder, true, MK_FP8 != 0, true>(F.lds, g, S, E);
#endif
        pg8::gemm_phase<pg8::EpiMoe1, pg8::MoeOrder, true, MK_FP8 != 0>(F.lds, g, S, E);
    } SEAM(10);
    if (IN(11)) REP(11) {
        const unsigned* ctl = wsp<unsigned>(F, WS_CTL);
        pg8::Gemm g{wsp<bf16>(F, WS_ACT), wsp<bf16>(F, WS_W2), MK_FP8 ? DE / 2 : DE, D, nullptr};
        pg8::MoeOrder S{(int)ctl[CW_NTILES], 4, F.G, F.vcu, wsp<int>(F, WS_TILEE)};
        pg8::EpiMoe2 E{wsp<unsigned char>(F, WS_YS), F.in[27], wsp<float>(F, WS_SLOTGATE)};
#if MK_NOLOAD_PROBE & 2
        pg8::gemm_phase<pg8::EpiMoe2, pg8::MoeOrder, false, MK_FP8 != 0, true>(F.lds, g, S, E);
#endif
        pg8::gemm_phase<pg8::EpiMoe2, pg8::MoeOrder, false, MK_FP8 != 0>(F.lds, g, S, E);
    } SEAM(11);
    if (IN(12)) { phase12(F); }
#undef IN
#undef SEAM
}

extern "C" void kernel_launch(void* const* d_in, const int* in_sizes, int n_in, void* d_out, int out_size, void* d_ws, size_t ws_size, hipStream_t stream) {
    static int grid = 0;
    if (grid == 0) {
        if (n_in != 28 || out_size != M * D || ws_size < WS_END) { fprintf(stderr, "kernel_launch: unexpected sizes (n_in %d out %d ws %zu, need %zu)\n", n_in, out_size, ws_size, (size_t)WS_END); grid = -1; return; }
        int dev = 0, cus = 0, per_cu = 0;
        (void)hipGetDevice(&dev); (void)hipDeviceGetAttribute(&cus, hipDeviceAttributeMultiprocessorCount, dev);
        (void)hipFuncSetAttribute((const void*)mk_fwd, hipFuncAttributeMaxDynamicSharedMemorySize, LDS_BYTES);
        (void)hipOccupancyMaxActiveBlocksPerMultiprocessor(&per_cu, (const void*)mk_fwd, 512, LDS_BYTES);
        if (per_cu < 1 || cus != 256) { fprintf(stderr, "kernel_launch: occupancy %d, CUs %d: this build needs 256 CUs x 1 block\n", per_cu, cus); grid = -1; return; }
        grid = cus;
    }
    if (grid < 0) return;
    (void)hipMemsetAsync((char*)d_ws + WS_CTL, 0, CTL_BYTES, stream);
    Args a{};
    for (int i = 0; i < 28; ++i) a.in[i] = (const float*)d_in[i];
    a.out = (float*)d_out; a.ws = (unsigned char*)d_ws;
    const int last = MK_LAST_PHASE + 1;
#if MK_ONE_LAUNCH
    a.ph_lo = 0; a.ph_hi = last;
#if MK_COOP
    void* kargs[] = {&a};
    hipError_t e = hipLaunchCooperativeKernel((const void*)mk_fwd, dim3(grid), dim3(512), kargs, LDS_BYTES, stream);
    if (e != hipSuccess) fprintf(stderr, "cooperative launch failed: %s\n", hipGetErrorString(e));
#else
    hipLaunchKernelGGL(mk_fwd, dim3(grid), dim3(512), LDS_BYTES, stream, a);
#endif
#else
    for (int p = 0; p < last; ++p) { a.ph_lo = p; a.ph_hi = p + 1; hipLaunchKernelGGL(mk_fwd, dim3(grid), dim3(512), LDS_BYTES, stream, a); }
#endif
}
```
